# Optimizing an MI355X kernel written in HIP

```python
import jax
import jax.numpy as jnp
from jax import lax
import numpy as np

D_MODEL = 1024
BATCH = 8
SEQ = 4096
DEPTH = 2

N_MEM = 256
HEAD_DIM = 64
ROPE_THETA = 500000.0
ROPE_FRACTION = 4
RMS_EPS = 1e-6
NEG_INF = -1e30
TINY = 1e-20

DSA_HEADS = 8
DSA_IDX_HEADS = 8
DSA_IDX_DIM = 32
DSA_TOPK = 256
DSA_QBLOCK = 128

MOBA_HEADS = 8
MOBA_BLOCK = 256
MOBA_TOPK = 3
MOBA_QBLOCK = 32

NSA_HEADS = 16
NSA_GROUPS = 4
NSA_CMP_LEN = 32
NSA_CMP_STRIDE = 16
NSA_SEL_LEN = 64
NSA_SEL_TOPK = 16
NSA_WINDOW = 512
NSA_QBLOCK = 32
NSA_FORCE = 1e4

MEM_HEADS = 4
MEM_HEAD_DIM = 128

D_FF = ((8 * D_MODEL + 3 * 256 - 1) // (3 * 256)) * 256

AB_SIZES = (DSA_HEADS * HEAD_DIM, HEAD_DIM, HEAD_DIM, DSA_IDX_HEADS * DSA_IDX_DIM, DSA_IDX_DIM, DSA_IDX_HEADS, MOBA_HEADS * HEAD_DIM, MOBA_HEADS * HEAD_DIM, MOBA_HEADS * HEAD_DIM)
AB_WIDTH = sum(AB_SIZES)
AB_MIX_WIDTH = (DSA_HEADS + MOBA_HEADS) * HEAD_DIM
C_SIZES = (NSA_HEADS * HEAD_DIM,) + (NSA_GROUPS * HEAD_DIM,) * 6 + (NSA_HEADS * 3,)
C_WIDTH = sum(C_SIZES)
C_MIX_WIDTH = NSA_HEADS * HEAD_DIM

kernel_name = 'hybrid_dsa_moba_nsa_mem_block'


def rms_norm(x, gain):
    xf = x.astype(jnp.float32)
    y = xf * lax.rsqrt(jnp.mean(xf * xf, axis=-1, keepdims=True) + RMS_EPS)
    return (y * gain.astype(jnp.float32)).astype(x.dtype)


def partial_rope(x, positions):
    dh = x.shape[-1]
    rot = dh // ROPE_FRACTION
    half = rot // 2
    inv_freq = ROPE_THETA ** (-(jnp.arange(half, dtype=jnp.float32) * 2.0 / rot))
    ang = positions.astype(jnp.float32)[:, :, None] * inv_freq
    cos = jnp.cos(ang)[:, :, None, :]
    sin = jnp.sin(ang)[:, :, None, :]
    xf = x.astype(jnp.float32)
    x1 = xf[..., :half]
    x2 = xf[..., half:rot]
    out = jnp.concatenate([x1 * cos - x2 * sin, x2 * cos + x1 * sin, xf[..., rot:]], axis=-1)
    return out.astype(x.dtype)


def masked_softmax(s, mask):
    s = jnp.where(mask, s, NEG_INF)
    m = jnp.max(s, axis=-1, keepdims=True)
    p = jnp.where(mask, jnp.exp(s - m), 0.0)
    return p / jnp.maximum(jnp.sum(p, axis=-1, keepdims=True), TINY)


def _rows(t, start, size):
    return lax.dynamic_slice_in_dim(t, start, size, axis=1)


def _split(x, sizes):
    out = []
    start = 0
    for n in sizes:
        out.append(x[..., start:start + n])
        start += n
    return out


def _sweep_queries(fn, n_blocks):
    out = lax.map(fn, jnp.arange(n_blocks, dtype=jnp.int32))
    out = jnp.moveaxis(out, 0, 1)
    return out.reshape((out.shape[0], -1) + out.shape[3:])


def dsa_attention(q, k, v, q_idx, k_idx, w_idx):
    B, S, H, Dh = q.shape
    k_top = min(DSA_TOPK, S // 4)
    key_pos = jnp.arange(S)
    b_idx = jnp.arange(B)[:, None, None]
    scale = Dh ** -0.5

    def block(c):
        t0 = c * DSA_QBLOCK
        qpos = t0 + jnp.arange(DSA_QBLOCK)
        logits = jnp.einsum('bqhd,bsd->bqhs', _rows(q_idx, t0, DSA_QBLOCK), k_idx).astype(jnp.float32)
        score = jnp.einsum('bqh,bqhs->bqs', _rows(w_idx, t0, DSA_QBLOCK).astype(jnp.float32), jax.nn.relu(logits))
        score = jnp.where(key_pos[None, None, :] <= qpos[None, :, None], score, NEG_INF)
        _, sel = lax.top_k(score, k_top)
        k_sel = k[b_idx, sel]
        v_sel = v[b_idx, sel]
        s = jnp.einsum('bqhd,bqkd->bhqk', _rows(q, t0, DSA_QBLOCK), k_sel).astype(jnp.float32) * scale
        p = masked_softmax(s, (sel <= qpos[None, :, None])[:, None])
        return jnp.einsum('bhqk,bqkd->bqhd', p.astype(v.dtype), v_sel)

    return _sweep_queries(block, S // DSA_QBLOCK)


def moba_attention(q, k, v):
    B, S, H, Dh = q.shape
    n_blk = -(-S // MOBA_BLOCK)
    pad = n_blk * MOBA_BLOCK - S
    k_pad = jnp.pad(k, ((0, 0), (0, pad), (0, 0), (0, 0)))
    v_pad = jnp.pad(v, ((0, 0), (0, pad), (0, 0), (0, 0)))
    k_blk = k_pad.reshape(B, n_blk, MOBA_BLOCK, H, Dh).transpose(0, 3, 1, 2, 4)
    v_blk = v_pad.reshape(B, n_blk, MOBA_BLOCK, H, Dh).transpose(0, 3, 1, 2, 4)
    k_mean = jnp.mean(k_blk.astype(jnp.float32), axis=3)
    n_top = max(1, min(MOBA_TOPK, n_blk - 1))
    n_past = n_top * MOBA_BLOCK
    b_idx = jnp.arange(B)[:, None, None, None]
    h_idx = jnp.arange(H)[None, :, None, None]
    blk_ids = jnp.arange(n_blk)
    scale = Dh ** -0.5

    def block(c):
        t0 = c * MOBA_QBLOCK
        qpos = t0 + jnp.arange(MOBA_QBLOCK)
        own = t0 // MOBA_BLOCK
        qc = _rows(q, t0, MOBA_QBLOCK)
        gate = jnp.einsum('bqhd,bhnd->bhqn', qc.astype(jnp.float32), k_mean)
        gate = jnp.where(blk_ids < own, gate, NEG_INF)
        _, sel = lax.top_k(gate, n_top)
        k_sel = k_blk[b_idx, h_idx, sel]
        v_sel = v_blk[b_idx, h_idx, sel]
        s_past = jnp.einsum('bqhd,bhqnkd->bhqnk', qc, k_sel).astype(jnp.float32)
        m_past = jnp.broadcast_to((sel < own)[..., None], s_past.shape)
        k_own = _rows(k_pad, own * MOBA_BLOCK, MOBA_BLOCK)
        v_own = _rows(v_pad, own * MOBA_BLOCK, MOBA_BLOCK)
        kpos = own * MOBA_BLOCK + jnp.arange(MOBA_BLOCK)
        s_own = jnp.einsum('bqhd,bkhd->bhqk', qc, k_own).astype(jnp.float32)
        m_own = jnp.broadcast_to(kpos[None, :] <= qpos[:, None], s_own.shape)
        s = jnp.concatenate([s_past.reshape(B, H, MOBA_QBLOCK, n_past), s_own], axis=-1) * scale
        m = jnp.concatenate([m_past.reshape(B, H, MOBA_QBLOCK, n_past), m_own], axis=-1)
        p = masked_softmax(s, m).astype(v.dtype)
        p_past = p[..., :n_past].reshape(B, H, MOBA_QBLOCK, n_top, MOBA_BLOCK)
        return (jnp.einsum('bhqnk,bhqnkd->bqhd', p_past, v_sel)
                + jnp.einsum('bhqk,bkhd->bqhd', p[..., n_past:], v_own))

    return _sweep_queries(block, S // MOBA_QBLOCK)


def nsa_compress(x, pos_emb, w1, w2):
    B, S, G, Dh = x.shape
    n_cmp = (S - NSA_CMP_LEN) // NSA_CMP_STRIDE + 1
    idx = jnp.arange(n_cmp)[:, None] * NSA_CMP_STRIDE + jnp.arange(NSA_CMP_LEN)[None, :]
    blk = x[:, idx] + pos_emb[None, None, :, None, :]
    blk = blk.transpose(0, 1, 3, 2, 4).reshape(B, n_cmp, G, NSA_CMP_LEN * Dh)
    return jax.nn.silu(blk @ w1) @ w2


def nsa_attention(q, q_rot, k_cmp, v_cmp, k_sel, v_sel, k_win, v_win, gates):
    B, S, H, Dh = q.shape
    G = k_sel.shape[2]
    HG = H // G
    qg = q.reshape(B, S, G, HG, Dh)
    qr = q_rot.reshape(B, S, G, HG, Dh)
    n_cmp = k_cmp.shape[1]
    cmp_start = jnp.arange(n_cmp) * NSA_CMP_STRIDE
    cmp_end = cmp_start + NSA_CMP_LEN - 1
    n_sel = S // NSA_SEL_LEN
    n_top = min(NSA_SEL_TOPK, n_sel)
    sel_start = jnp.arange(n_sel) * NSA_SEL_LEN
    cover = ((cmp_start[:, None] < sel_start[None, :] + NSA_SEL_LEN)
             & (cmp_start[:, None] + NSA_CMP_LEN > sel_start[None, :])).astype(jnp.float32)
    ks_blk = k_sel.reshape(B, n_sel, NSA_SEL_LEN, G, Dh).transpose(0, 3, 1, 2, 4)
    vs_blk = v_sel.reshape(B, n_sel, NSA_SEL_LEN, G, Dh).transpose(0, 3, 1, 2, 4)
    kw_pad = jnp.pad(k_win, ((0, 0), (NSA_WINDOW, 0), (0, 0), (0, 0)))
    vw_pad = jnp.pad(v_win, ((0, 0), (NSA_WINDOW, 0), (0, 0), (0, 0)))
    b_idx = jnp.arange(B)[:, None, None, None]
    g_idx = jnp.arange(G)[None, :, None, None]
    blk_ids = jnp.arange(n_sel)[None, :]
    scale = Dh ** -0.5
    n_gather = n_top * NSA_SEL_LEN

    def block(c):
        t0 = c * NSA_QBLOCK
        qpos = t0 + jnp.arange(NSA_QBLOCK)
        qp = _rows(qg, t0, NSA_QBLOCK)
        qrc = _rows(qr, t0, NSA_QBLOCK)
        gc = _rows(gates, t0, NSA_QBLOCK)
        s_c = jnp.einsum('bqgjd,bngd->bgjqn', qp, k_cmp).astype(jnp.float32) * scale
        p_c = masked_softmax(s_c, cmp_end[None, :] <= qpos[:, None])
        o_c = jnp.einsum('bgjqn,bngd->bqgjd', p_c.astype(v_cmp.dtype), v_cmp)
        imp = jnp.einsum('bgjqn,ns->bgqs', p_c, cover)
        cur = (qpos // NSA_SEL_LEN)[:, None]
        forced = (blk_ids == 0) | (blk_ids == cur) | (blk_ids == cur - 1)
        imp = jnp.where(forced, NSA_FORCE, imp)
        imp = jnp.where(blk_ids <= cur, imp, NEG_INF)
        _, sel = lax.top_k(imp, n_top)
        kg = ks_blk[b_idx, g_idx, sel].reshape(B, G, NSA_QBLOCK, n_gather, Dh)
        vg = vs_blk[b_idx, g_idx, sel].reshape(B, G, NSA_QBLOCK, n_gather, Dh)
        kpos = (sel[..., None] * NSA_SEL_LEN + jnp.arange(NSA_SEL_LEN)).reshape(B, G, NSA_QBLOCK, n_gather)
        s_s = jnp.einsum('bqgjd,bgqmd->bgjqm', qrc, kg).astype(jnp.float32) * scale
        p_s = masked_softmax(s_s, (kpos <= qpos[None, None, :, None])[:, :, None])
        o_s = jnp.einsum('bgjqm,bgqmd->bqgjd', p_s.astype(vg.dtype), vg)
        kw = _rows(kw_pad, t0, NSA_WINDOW + NSA_QBLOCK)
        vw = _rows(vw_pad, t0, NSA_WINDOW + NSA_QBLOCK)
        wpos = t0 - NSA_WINDOW + jnp.arange(NSA_WINDOW + NSA_QBLOCK)
        dist = qpos[:, None] - wpos[None, :]
        m_w = (dist >= 0) & (dist < NSA_WINDOW) & (wpos[None, :] >= 0)
        s_w = jnp.einsum('bqgjd,bkgd->bgjqk', qrc, kw).astype(jnp.float32) * scale
        p_w = masked_softmax(s_w, m_w)
        o_w = jnp.einsum('bgjqk,bkgd->bqgjd', p_w.astype(vw.dtype), vw)
        o = gc[..., 0:1] * o_c + gc[..., 1:2] * o_s + gc[..., 2:3] * o_w
        return o.reshape(B, NSA_QBLOCK, H, Dh)

    return _sweep_queries(block, S // NSA_QBLOCK)


def dsa_moba_mixer(h, positions, w_in, w_out, a_q_norm, a_k_norm, b_q_norm, b_k_norm):
    B, S, _ = h.shape
    aq, ak, av, iq, ik, iw, bq, bk, bv = _split(h @ w_in, AB_SIZES)
    aq = partial_rope(rms_norm(aq.reshape(B, S, DSA_HEADS, HEAD_DIM), a_q_norm), positions)
    ak = partial_rope(rms_norm(ak.reshape(B, S, 1, HEAD_DIM), a_k_norm), positions)[:, :, 0]
    iq = partial_rope(iq.reshape(B, S, DSA_IDX_HEADS, DSA_IDX_DIM), positions)
    ik = partial_rope(ik.reshape(B, S, 1, DSA_IDX_DIM), positions)[:, :, 0]
    o_a = dsa_attention(aq, ak, av, iq, ik, iw)
    bq = partial_rope(rms_norm(bq.reshape(B, S, MOBA_HEADS, HEAD_DIM), b_q_norm), positions)
    bk = partial_rope(rms_norm(bk.reshape(B, S, MOBA_HEADS, HEAD_DIM), b_k_norm), positions)
    o_b = moba_attention(bq, bk, bv.reshape(B, S, MOBA_HEADS, HEAD_DIM))
    o = jnp.concatenate([o_a.reshape(B, S, -1), o_b.reshape(B, S, -1)], axis=-1)
    return o @ w_out


def nsa_mixer(h, positions, w_in, w_out, q_norm, kcmp_norm, ksel_norm, kwin_norm,
              pos_k, pos_v, w1_k, w2_k, w1_v, w2_v):
    B, S, _ = h.shape
    G = NSA_GROUPS
    HG = NSA_HEADS // NSA_GROUPS
    q, kc, vc, ks, vs, kw, vw, gt = _split(h @ w_in, C_SIZES)
    grp = lambda t: t.reshape(B, S, G, HEAD_DIM)
    q = rms_norm(q.reshape(B, S, NSA_HEADS, HEAD_DIM), q_norm)
    q_rot = partial_rope(q, positions)
    kc = rms_norm(nsa_compress(grp(kc), pos_k, w1_k, w2_k), kcmp_norm)
    vc = nsa_compress(grp(vc), pos_v, w1_v, w2_v)
    ks = partial_rope(rms_norm(grp(ks), ksel_norm), positions)
    kw = partial_rope(rms_norm(grp(kw), kwin_norm), positions)
    gates = jax.nn.sigmoid(gt.astype(jnp.float32)).reshape(B, S, G, HG, 3).astype(h.dtype)
    o = nsa_attention(q, q_rot, kc, vc, ks, grp(vs), kw, grp(vw), gates)
    return o.reshape(B, S, C_MIX_WIDTH) @ w_out


def memory_cross_attention(h, m, w_q, w_kv, w_o, q_norm, k_norm):
    B, S, _ = h.shape
    M = m.shape[1]
    q = rms_norm((h @ w_q).reshape(B, S, MEM_HEADS, MEM_HEAD_DIM), q_norm)
    k, v = _split(m @ w_kv, (MEM_HEADS * MEM_HEAD_DIM, MEM_HEADS * MEM_HEAD_DIM))
    k = rms_norm(k.reshape(B, M, MEM_HEADS, MEM_HEAD_DIM), k_norm)
    v = v.reshape(B, M, MEM_HEADS, MEM_HEAD_DIM)
    s = jnp.einsum('bshd,bmhd->bhsm', q, k).astype(jnp.float32) * (MEM_HEAD_DIM ** -0.5)
    p = jax.nn.softmax(s, axis=-1).astype(v.dtype)
    o = jnp.einsum('bhsm,bmhd->bshd', p, v).reshape(B, S, MEM_HEADS * MEM_HEAD_DIM)
    return o @ w_o


def swiglu(h, w_in, w_out):
    g, u = _split(h @ w_in, (D_FF, D_FF))
    return (jax.nn.silu(g) * u) @ w_out


def setup_inputs(seed: int = 0) -> dict:
    key = jax.random.key(seed)
    keys = jax.random.split(key, 48)
    ctr = [0]

    def nxt():
        k = keys[ctr[0]]
        ctr[0] += 1
        return k

    def nrm(shape, scale):
        return scale * jax.random.normal(nxt(), shape, jnp.float32)

    def gain(shape):
        return 1.0 + 0.02 * jax.random.normal(nxt(), shape, jnp.float32)

    n_even = (DEPTH + 1) // 2
    n_odd = DEPTH // 2
    d = D_MODEL
    x = nrm((BATCH, SEQ, d), 1.0)
    mem = nrm((BATCH, N_MEM, d), 1.0)
    offset = jax.random.randint(nxt(), (BATCH, 1), 0, SEQ)
    positions = (offset + jnp.arange(SEQ)[None, :]).astype(jnp.int32)
    cmp_in = NSA_CMP_LEN * HEAD_DIM
    return {
        'x': x,
        'mem': mem,
        'positions': positions,
        'norm_mix': gain((DEPTH, d)),
        'norm_mem': gain((DEPTH, d)),
        'norm_mem_src': gain((DEPTH, d)),
        'norm_ffn': gain((DEPTH, d)),
        'ab_w_in': nrm((n_even, d, AB_WIDTH), d ** -0.5),
        'ab_w_out': nrm((n_even, AB_MIX_WIDTH, d), AB_MIX_WIDTH ** -0.5),
        'dsa_q_norm': gain((n_even, HEAD_DIM)),
        'dsa_k_norm': gain((n_even, HEAD_DIM)),
        'moba_q_norm': gain((n_even, HEAD_DIM)),
        'moba_k_norm': gain((n_even, HEAD_DIM)),
        'nsa_w_in': nrm((n_odd, d, C_WIDTH), d ** -0.5),
        'nsa_w_out': nrm((n_odd, C_MIX_WIDTH, d), C_MIX_WIDTH ** -0.5),
        'nsa_q_norm': gain((n_odd, HEAD_DIM)),
        'nsa_kcmp_norm': gain((n_odd, HEAD_DIM)),
        'nsa_ksel_norm': gain((n_odd, HEAD_DIM)),
        'nsa_kwin_norm': gain((n_odd, HEAD_DIM)),
        'nsa_cmp_pos_k': nrm((n_odd, NSA_CMP_LEN, HEAD_DIM), 0.1),
        'nsa_cmp_pos_v': nrm((n_odd, NSA_CMP_LEN, HEAD_DIM), 0.1),
        'nsa_cmp_w1_k': nrm((n_odd, cmp_in, HEAD_DIM), cmp_in ** -0.5),
        'nsa_cmp_w2_k': nrm((n_odd, HEAD_DIM, HEAD_DIM), HEAD_DIM ** -0.5),
        'nsa_cmp_w1_v': nrm((n_odd, cmp_in, HEAD_DIM), cmp_in ** -0.5),
        'nsa_cmp_w2_v': nrm((n_odd, HEAD_DIM, HEAD_DIM), HEAD_DIM ** -0.5),
        'mem_w_q': nrm((DEPTH, d, MEM_HEADS * MEM_HEAD_DIM), d ** -0.5),
        'mem_w_kv': nrm((DEPTH, d, 2 * MEM_HEADS * MEM_HEAD_DIM), d ** -0.5),
        'mem_w_o': nrm((DEPTH, MEM_HEADS * MEM_HEAD_DIM, d), (MEM_HEADS * MEM_HEAD_DIM) ** -0.5),
        'mem_q_norm': gain((DEPTH, MEM_HEAD_DIM)),
        'mem_k_norm': gain((DEPTH, MEM_HEAD_DIM)),
        'ffn_w_in': nrm((DEPTH, d, 2 * D_FF), d ** -0.5),
        'ffn_w_out': nrm((DEPTH, D_FF, d), D_FF ** -0.5),
    }


def reference(x, mem, positions, norm_mix, norm_mem, norm_mem_src, norm_ffn,
              ab_w_in, ab_w_out, dsa_q_norm, dsa_k_norm, moba_q_norm, moba_k_norm,
              nsa_w_in, nsa_w_out, nsa_q_norm, nsa_kcmp_norm, nsa_ksel_norm, nsa_kwin_norm,
              nsa_cmp_pos_k, nsa_cmp_pos_v, nsa_cmp_w1_k, nsa_cmp_w2_k, nsa_cmp_w1_v, nsa_cmp_w2_v,
              mem_w_q, mem_w_kv, mem_w_o, mem_q_norm, mem_k_norm, ffn_w_in, ffn_w_out):
    for i in range(DEPTH):
        j = i // 2
        h = rms_norm(x, norm_mix[i])
        if i % 2 == 0:
            x = x + dsa_moba_mixer(h, positions, ab_w_in[j], ab_w_out[j], dsa_q_norm[j], dsa_k_norm[j],
                                   moba_q_norm[j], moba_k_norm[j])
        else:
            x = x + nsa_mixer(h, positions, nsa_w_in[j], nsa_w_out[j], nsa_q_norm[j], nsa_kcmp_norm[j],
                              nsa_ksel_norm[j], nsa_kwin_norm[j], nsa_cmp_pos_k[j], nsa_cmp_pos_v[j],
                              nsa_cmp_w1_k[j], nsa_cmp_w2_k[j], nsa_cmp_w1_v[j], nsa_cmp_w2_v[j])
        x = x + memory_cross_attention(rms_norm(x, norm_mem[i]), rms_norm(mem, norm_mem_src[i]),
                                       mem_w_q[i], mem_w_kv[i], mem_w_o[i], mem_q_norm[i], mem_k_norm[i])
        x = x + swiglu(rms_norm(x, norm_ffn[i]), ffn_w_in[i], ffn_w_out[i])
    return x
```

```cpp
#include <hip/hip_runtime.h>
#include <cstdio>
#include <cstdint>
#include <type_traits>

#define LAS __attribute__((address_space(3)))
#define GAS __attribute__((address_space(1)))
typedef unsigned short bf16_t;
typedef short bf16x8 __attribute__((ext_vector_type(8)));
typedef short s16x4 __attribute__((ext_vector_type(4)));
typedef float f32x4 __attribute__((ext_vector_type(4)));
typedef float f32x2 __attribute__((ext_vector_type(2)));
typedef float f32x16 __attribute__((ext_vector_type(16)));
typedef unsigned u32x4 __attribute__((ext_vector_type(4)));
typedef unsigned u32x2 __attribute__((ext_vector_type(2)));
typedef __bf16 bf16x2_t __attribute__((ext_vector_type(2)));

constexpr int BATCH = 8, SEQ = 4096, DM = 1024, MTOK = BATCH * SEQ;
constexpr int NMEM = 256, MMEM = BATCH * NMEM;
constexpr int DFF = 2816;
constexpr int AB_W = 2472, AB_WP = 2560;
constexpr int C_W = 2608, C_WP = 2816;
constexpr float RMS_EPS = 1e-6f;
constexpr float LOG2E = 1.4426950408889634f;

namespace pg8 {
constexpr int BM = 256, BK = 64, HALF = 128, HTB = HALF * BK * 2, STAGE_BYTES = 8 * HTB, NXCD = 8, WGM = 8;
__host__ __device__ __forceinline__ int lds_byte(int r, int c) { const int st = (r >> 4) * 2 + (c >> 5), rr = r & 15, cc = c & 31, ob = rr * 64 + cc * 2; return st * 1024 + (ob ^ (((ob >> 9) & 1) << 5)); }
__host__ __device__ __forceinline__ void stage_rc(int b, int& R, int& C) { const int st = b / 1024, sb = b % 1024, swz = sb ^ (((sb >> 9) & 1) << 5); R = (st >> 1) * 16 + swz / 64; C = (st & 1) * 32 + (swz % 64) / 2; }
__host__ __device__ __forceinline__ int perm32(int rho) { const int n = rho >> 4, i = rho & 15; return 8 * (i >> 2) + 4 * n + (i & 3); }
struct Unit { int pm, pn; };
struct Gemm { const bf16_t* A; const bf16_t* Bt; int M, N, K; };
struct StaticOrder {
    int nM, nN, nwg, G, c;
    __host__ __device__ void init(int M, int N, int G_, int c_) { nM = M / BM; nN = N / BM; nwg = nM * nN; G = G_; c = c_; }
    __host__ __device__ bool next(int i, Unit& u) const {
        const long L = (long)i * G + c; if (L >= nwg) return false;
        int wgid = (int)L; { const int q = nwg / NXCD, r = nwg % NXCD, xcd = wgid % NXCD, off = wgid / NXCD; wgid = (xcd < r ? xcd * (q + 1) : r * (q + 1) + (xcd - r) * q) + off; }
        const int nig = WGM * nN, gid = wgid / nig, fm = gid * WGM, gsz = (nM - fm) < WGM ? (nM - fm) : WGM;
        u.pm = fm + ((wgid % nig) % gsz); u.pn = (wgid % nig) / gsz; return true;
    }
    __device__ __forceinline__ void a_ready(const Unit&) const {}
    __device__ __forceinline__ void done(const Unit&) const {}
};
__device__ __forceinline__ unsigned cvt_pk_bf16(float lo, float hi) { unsigned r; asm volatile("v_cvt_pk_bf16_f32 %0, %1, %2" : "=v"(r) : "v"(lo), "v"(hi)); return r; }

struct EpiPlain {
    static constexpr bool PERM = true, AFTER_DRAIN = false;
    bf16_t* O; int ldc;
    __device__ __forceinline__ void operator()(const f32x4 (&acc)[2][2][4][2], const Unit& u, int wr, int wc, int fr, int fq) const {
        const int row0 = u.pm * BM + wr * 64 + fr, col0 = u.pn * BM + wc * 32 + 8 * fq;
#pragma unroll
        for (int ai = 0; ai < 2; ++ai)
#pragma unroll
            for (int m = 0; m < 4; ++m) { bf16_t* rowp = O + (size_t)(row0 + ai * HALF + m * 16) * ldc + col0;
#pragma unroll
                for (int bj = 0; bj < 2; ++bj) { const f32x4 v0 = acc[ai][bj][m][0], v1 = acc[ai][bj][m][1];
                    u32x4 w; w.x = cvt_pk_bf16(v0[0], v0[1]); w.y = cvt_pk_bf16(v0[2], v0[3]); w.z = cvt_pk_bf16(v1[0], v1[1]); w.w = cvt_pk_bf16(v1[2], v1[3]);
                    *(u32x4*)(rowp + bj * HALF) = w; } }
    }
};
template <bool FINAL> struct EpiResid {
    static constexpr bool PERM = true, AFTER_DRAIN = false;
    float* out; bf16_t* xb; float* rsq;
    __device__ __forceinline__ void operator()(const f32x4 (&acc)[2][2][4][2], const Unit& u, int wr, int wc, int fr, int fq) const {
        const int col0 = u.pn * BM + wc * 32 + 8 * fq;
#pragma unroll
        for (int ai = 0; ai < 2; ++ai) {
            u32x4 rb[4][2];
#pragma unroll
            for (int m = 0; m < 4; ++m)
#pragma unroll
                for (int bj = 0; bj < 2; ++bj) rb[m][bj] = *(const u32x4*)(xb + (size_t)(u.pm * BM + ai * HALF + wr * 64 + m * 16 + fr) * 1024 + col0 + bj * HALF);
#pragma unroll
            for (int m = 0; m < 4; ++m) { const int row = u.pm * BM + ai * HALF + wr * 64 + m * 16 + fr; const size_t off = (size_t)row * 1024 + col0; float ss = 0.f;
#pragma unroll
                for (int bj = 0; bj < 2; ++bj) { const size_t o = off + bj * HALF; const u32x4 r4 = rb[m][bj]; float v[8];
#pragma unroll
                    for (int k = 0; k < 4; ++k) { v[2 * k] = acc[ai][bj][m][k >> 1][(2 * k) & 3] + __builtin_bit_cast(float, r4[k] << 16); v[2 * k + 1] = acc[ai][bj][m][k >> 1][(2 * k + 1) & 3] + __builtin_bit_cast(float, r4[k] & 0xffff0000u); }
                    if (FINAL) { *(f32x4*)(out + o) = (f32x4){v[0], v[1], v[2], v[3]}; *(f32x4*)(out + o + 4) = (f32x4){v[4], v[5], v[6], v[7]}; }
                    else { u32x4 w; w.x = cvt_pk_bf16(v[0], v[1]); w.y = cvt_pk_bf16(v[2], v[3]); w.z = cvt_pk_bf16(v[4], v[5]); w.w = cvt_pk_bf16(v[6], v[7]); *(u32x4*)(xb + o) = w;
#pragma unroll
                        for (int k = 0; k < 4; ++k) { const float r0 = __builtin_bit_cast(float, w[k] << 16), r1 = __builtin_bit_cast(float, w[k] & 0xffff0000u); ss += r0 * r0 + r1 * r1; } } }
                if (!FINAL) { ss += __shfl_xor(ss, 16); ss += __shfl_xor(ss, 32);
                    if (fq == 0) rsq[(size_t)row * 16 + u.pn * 4 + wc] = ss; } }
            asm volatile("" ::: "memory");
        }
    }
};
struct EpiSwiGLU {
    static constexpr bool PERM = true, AFTER_DRAIN = false;
    const float* rsq; bf16_t* hid;
    __device__ __forceinline__ void operator()(const f32x4 (&acc)[2][2][4][2], const Unit& u, int wr, int wc, int fr, int fq) const {
        const int col0 = u.pn * 128 + wc * 32 + 8 * fq;
        f32x4 pr[2][4];
#pragma unroll
        for (int ai = 0; ai < 2; ++ai)
#pragma unroll
            for (int m = 0; m < 4; ++m) pr[ai][m] = *(const f32x4*)(rsq + (size_t)(u.pm * BM + ai * HALF + wr * 64 + m * 16 + fr) * 16 + 4 * fq);
#pragma unroll
        for (int ai = 0; ai < 2; ++ai)
#pragma unroll
            for (int m = 0; m < 4; ++m) { const int row = u.pm * BM + ai * HALF + wr * 64 + m * 16 + fr;
                float ss = (pr[ai][m][0] + pr[ai][m][1]) + (pr[ai][m][2] + pr[ai][m][3]);
                ss += __shfl_xor(ss, 16); ss += __shfl_xor(ss, 32);
                const float c = __builtin_amdgcn_rsqf(ss * (1.0f / 1024.0f) + RMS_EPS);
                float h[8];
#pragma unroll
                for (int n = 0; n < 2; ++n)
#pragma unroll
                    for (int e = 0; e < 4; ++e) { const float g = acc[ai][0][m][n][e] * c, uu = acc[ai][1][m][n][e] * c;
                        const float sg = g * __builtin_amdgcn_rcpf(1.0f + __builtin_amdgcn_exp2f(-g * LOG2E)); h[n * 4 + e] = sg * uu; }
                u32x4 w; w.x = cvt_pk_bf16(h[0], h[1]); w.y = cvt_pk_bf16(h[2], h[3]); w.z = cvt_pk_bf16(h[4], h[5]); w.w = cvt_pk_bf16(h[6], h[7]);
                *(u32x4*)(hid + (size_t)row * DFF + col0) = w; }
    }
};

struct ProjUnit { int kind; const float* gain; float scale; bool rope; };
template <int L> struct EpiProj {
    static constexpr bool PERM = true, AFTER_DRAIN = false;
    bf16_t* O; int ldc; const float* rsq; const float* rope64; const float* rope32; const float* g0; const float* g1; const float* g2; const float* g3; float* aux;
    __device__ __forceinline__ ProjUnit classify(int unit) const {
        constexpr float C2 = 0.125f * LOG2E;
        if (L == 0) {
            if (unit < 8) return {1, g0, C2, true}; if (unit == 8) return {1, g1, 1.f, true}; if (unit == 9) return {2, nullptr, 1.f, false};
            if (unit < 14) return {4, nullptr, 1.f, false}; if (unit == 14) return {5, nullptr, 1.f, false};
            if (unit < 23) return {1, g2, C2, true}; if (unit < 31) return {1, g3, 1.f, true}; if (unit < 39) return {2, nullptr, 1.f, false}; return {0, nullptr, 1.f, false};
        } else {
            if (unit < 16) return {1, g0, C2, false}; if (unit < 24) return {3, nullptr, 1.f, false};
            if (unit < 28) return {1, g1, 1.f, true}; if (unit < 32) return {2, nullptr, 1.f, false}; if (unit < 36) return {1, g2, 1.f, true}; if (unit < 40) return {2, nullptr, 1.f, false};
            if (unit == 40) return {6, nullptr, 1.f, false}; return {0, nullptr, 1.f, false};
        }
    }
    __device__ __forceinline__ void operator()(const f32x4 (&acc)[2][2][4][2], const Unit& u, int wr, int wc, int fr, int fq) const {
        const int unit = 4 * u.pn + wc; const ProjUnit pu = classify(unit);
        if (pu.kind == 0) return;
        float gl[2][8];
        if (pu.kind == 1) {
#pragma unroll
            for (int bj = 0; bj < 2; ++bj) { const f32x4 a = *(const f32x4*)(pu.gain + 8 * (2 * fq + bj)), b = *(const f32x4*)(pu.gain + 8 * (2 * fq + bj) + 4);
#pragma unroll
                for (int x = 0; x < 4; ++x) { gl[bj][x] = a[x] * pu.scale; gl[bj][4 + x] = b[x] * pu.scale; } }
        }
        float rsv[2][4];
        if (pu.kind != 3) { f32x4 pr[2][4];
#pragma unroll
            for (int ai = 0; ai < 2; ++ai)
#pragma unroll
                for (int m = 0; m < 4; ++m) pr[ai][m] = *(const f32x4*)(rsq + (size_t)(u.pm * BM + ai * HALF + wr * 64 + m * 16 + fr) * 16 + 4 * fq);
#pragma unroll
            for (int ai = 0; ai < 2; ++ai)
#pragma unroll
                for (int m = 0; m < 4; ++m) { float ss = (pr[ai][m][0] + pr[ai][m][1]) + (pr[ai][m][2] + pr[ai][m][3]); ss += __shfl_xor(ss, 16); ss += __shfl_xor(ss, 32);
                    rsv[ai][m] = __builtin_amdgcn_rsqf(ss * (1.0f / 1024.0f) + RMS_EPS); } }
        else {
#pragma unroll
            for (int ai = 0; ai < 2; ++ai)
#pragma unroll
                for (int m = 0; m < 4; ++m) rsv[ai][m] = 1.f; }
#pragma unroll
        for (int ai = 0; ai < 2; ++ai)
#pragma unroll
            for (int m = 0; m < 4; ++m) { const int row = u.pm * BM + ai * HALF + wr * 64 + m * 16 + fr;
                const float rs = rsv[ai][m];
                float v[2][8];
#pragma unroll
                for (int bj = 0; bj < 2; ++bj)
#pragma unroll
                    for (int e = 0; e < 8; ++e) v[bj][e] = acc[ai][bj][m][e >> 2][e & 3] * rs;
                if (pu.kind == 1) {
                    float ss = 0.f;
#pragma unroll
                    for (int bj = 0; bj < 2; ++bj)
#pragma unroll
                        for (int e = 0; e < 8; ++e) ss += v[bj][e] * v[bj][e];
                    ss += __shfl_xor(ss, 16); ss += __shfl_xor(ss, 32);
                    const float rn = __builtin_amdgcn_rsqf(ss * (1.0f / 64.0f) + RMS_EPS);
#pragma unroll
                    for (int bj = 0; bj < 2; ++bj)
#pragma unroll
                        for (int e = 0; e < 8; ++e) v[bj][e] = v[bj][e] * rn * gl[bj][e];
                    if (pu.rope && fq == 0) {
                        const float* cs = rope64 + (size_t)row * 16; const f32x4 c0 = *(const f32x4*)cs, c1 = *(const f32x4*)(cs + 4), s0 = *(const f32x4*)(cs + 8), s1 = *(const f32x4*)(cs + 12);
#pragma unroll
                        for (int e = 0; e < 8; ++e) { const float c = e < 4 ? c0[e & 3] : c1[e & 3], sn = e < 4 ? s0[e & 3] : s1[e & 3]; const float x1 = v[0][e], x2 = v[1][e];
                            v[0][e] = x1 * c - x2 * sn; v[1][e] = x2 * c + x1 * sn; }
                    }
                }
                if (pu.kind == 4 || pu.kind == 5) {
                    if (fq == 0 || (fq == 2 && pu.kind == 4)) { const float* cs = rope32 + (size_t)row * 8; const f32x4 c = *(const f32x4*)cs, sn = *(const f32x4*)(cs + 4);
#pragma unroll
                        for (int x = 0; x < 4; ++x) { const float a = v[0][x], b = v[0][4 + x]; v[0][x] = a * c[x] - b * sn[x]; v[0][4 + x] = b * c[x] + a * sn[x]; } }
                    if (pu.kind == 5 && fq == 2) { *(f32x4*)(aux + (size_t)row * 8) = (f32x4){v[0][0], v[0][1], v[0][2], v[0][3]}; *(f32x4*)(aux + (size_t)row * 8 + 4) = (f32x4){v[0][4], v[0][5], v[0][6], v[0][7]}; }
                }
                if (pu.kind == 6) {
#pragma unroll
                    for (int bj = 0; bj < 2; ++bj) if (2 * fq + bj < 6) {
#pragma unroll
                        for (int e = 0; e < 8; ++e) v[bj][e] = __builtin_amdgcn_rcpf(1.0f + __builtin_amdgcn_exp2f(-v[bj][e] * LOG2E));
                        float* ap = aux + (size_t)row * 48 + 8 * (2 * fq + bj);
                        *(f32x4*)ap = (f32x4){v[bj][0], v[bj][1], v[bj][2], v[bj][3]}; *(f32x4*)(ap + 4) = (f32x4){v[bj][4], v[bj][5], v[bj][6], v[bj][7]}; }
                } else {
                    bf16_t* orow = O + (size_t)row * ldc + 64 * unit + 16 * fq;
                    u32x4 w0, w1;
                    w0.x = cvt_pk_bf16(v[0][0], v[0][1]); w0.y = cvt_pk_bf16(v[0][2], v[0][3]); w0.z = cvt_pk_bf16(v[0][4], v[0][5]); w0.w = cvt_pk_bf16(v[0][6], v[0][7]);
                    w1.x = cvt_pk_bf16(v[1][0], v[1][1]); w1.y = cvt_pk_bf16(v[1][2], v[1][3]); w1.z = cvt_pk_bf16(v[1][4], v[1][5]); w1.w = cvt_pk_bf16(v[1][6], v[1][7]);
                    *(u32x4*)orow = w0; *(u32x4*)(orow + 8) = w1;
                }
                if (m & 1) asm volatile("" ::: "memory"); }
    }
};

template <class Epi, class Sched, bool ALIGN_EPI = false, bool SP2 = false>
__device__ __forceinline__ void gemm_phase(LAS unsigned char* lds, const Gemm g, const Sched& S, const Epi& E, const int wave_id) {
    int tid = wave_id * 64 + (int)__builtin_amdgcn_mbcnt_hi(~0u, __builtin_amdgcn_mbcnt_lo(~0u, 0u)); asm volatile("" : "+v"(tid));
    const int wid = wave_id, lane = tid & 63, wr = wid >> 2, wc = wid & 3, fr = lane & 15, fq = lane >> 4;
    const int K = g.K, nt = K / BK;
    unsigned voffA[2], voffB[2];
#pragma unroll
    for (int i = 0; i < 2; ++i) { int R, C; stage_rc(tid * 16 + i * 8192, R, C); const int Rb = Epi::PERM ? ((R & ~31) + perm32(R & 31)) : R;
        voffA[i] = (unsigned)(R * K + C) * 2u; voffB[i] = (unsigned)(Rb * K + C) * 2u; }
    const size_t kstep = (size_t)(BK * 2);
    const size_t hstep = (size_t)HALF * K * 2;
    const size_t tstep = 2 * hstep;
    const unsigned ldsw = (unsigned)wid * 1024u;
    const int aoff = lds_byte(wr * 64 + fr, fq * 8), boff = lds_byte(wc * 32 + fr, fq * 8);
#define PG8_SA(b, h) (((b) * 2 + (h)) * HTB)
#define PG8_SB(b, h) ((4 + (b) * 2 + (h)) * HTB)
#define PG8_STAGE(bufoff, gbase, voff) do { _Pragma("unroll") for (int _i = 0; _i < 2; ++_i) \
        __builtin_amdgcn_global_load_lds((const unsigned*)((const char*)(gbase) + (voff)[_i]), (LAS unsigned*)(lds + (bufoff) + ldsw + _i * 8192), 16, 0, 0); } while (0)
#define PG8_LDA(dst, b, h) do { _Pragma("unroll") for (int m = 0; m < 4; ++m) _Pragma("unroll") for (int k = 0; k < 2; ++k) dst[m][k] = *(const LAS bf16x8*)(lds + PG8_SA(b, h) + aoff + m * 2048 + k * 1024); } while (0)
#define PG8_LDB(dst, b, h) do { _Pragma("unroll") for (int n = 0; n < 2; ++n) _Pragma("unroll") for (int k = 0; k < 2; ++k) dst[n][k] = *(const LAS bf16x8*)(lds + PG8_SB(b, h) + boff + n * 2048 + k * 1024); } while (0)
#define PG8_MMA(ai, bj, At, Bt) do { __builtin_amdgcn_s_setprio(1); _Pragma("unroll") for (int m = 0; m < 4; ++m) _Pragma("unroll") for (int n = 0; n < 2; ++n) _Pragma("unroll") for (int k = 0; k < 2; ++k) \
        acc[ai][bj][m][n] = __builtin_amdgcn_mfma_f32_16x16x32_bf16(Bt[n][k], At[m][k], acc[ai][bj][m][n], 0, 0, 0); __builtin_amdgcn_s_setprio(0); } while (0)
#define PG8_WAIT_V(n) asm volatile("s_waitcnt vmcnt(" #n ")" ::: "memory")
#define PG8_WAIT_L(n) asm volatile("s_waitcnt lgkmcnt(" #n ")" ::: "memory")
#define PG8_BAR __builtin_amdgcn_s_barrier()
#define PG8_SCHED __builtin_amdgcn_sched_barrier(0)
    Unit cur, nxt; int ui = 0;
    if (!S.next(0, cur)) return;
    f32x4 acc[2][2][4][2];
#pragma unroll
    for (int a = 0; a < 2; ++a)
#pragma unroll
        for (int b = 0; b < 2; ++b)
#pragma unroll
            for (int m = 0; m < 4; ++m)
#pragma unroll
                for (int n = 0; n < 2; ++n) acc[a][b][m][n] = (f32x4){0.f, 0.f, 0.f, 0.f};
    bf16x8 At[4][2], B0[2][2], B1[2][2];
    const char* cA = (const char*)g.A + (size_t)cur.pm * tstep; const char* cB = (const char*)g.Bt + (size_t)cur.pn * tstep;
    S.a_ready(cur);
    if constexpr (SP2) {
        PG8_STAGE(PG8_SB(0, 0), cB, voffB); PG8_STAGE(PG8_SB(0, 1), cB + hstep, voffB); PG8_STAGE(PG8_SA(0, 0), cA, voffA); PG8_STAGE(PG8_SA(0, 1), cA + hstep, voffA);
        if (wr == 1) PG8_BAR;
        PG8_WAIT_V(2); PG8_BAR;
        PG8_STAGE(PG8_SB(1, 0), cB + kstep, voffB); PG8_STAGE(PG8_SA(1, 0), cA + kstep, voffA); PG8_STAGE(PG8_SB(1, 1), cB + hstep + kstep, voffB);
        PG8_WAIT_V(6); PG8_BAR;
    } else {
        PG8_STAGE(PG8_SB(0, 0), cB, voffB); PG8_STAGE(PG8_SA(0, 0), cA, voffA); PG8_STAGE(PG8_SB(0, 1), cB + hstep, voffB); PG8_STAGE(PG8_SA(0, 1), cA + hstep, voffA);
        if (wr == 1) PG8_BAR;
        PG8_WAIT_V(4); PG8_BAR;
        PG8_STAGE(PG8_SB(1, 0), cB + kstep, voffB); PG8_STAGE(PG8_SA(1, 0), cA + kstep, voffA); PG8_STAGE(PG8_SB(1, 1), cB + hstep + kstep, voffB);
        PG8_WAIT_V(6); PG8_BAR;
    }
    for (;;) {
        const bool has_next = S.next(ui + 1, nxt);
        const char* nA = has_next ? (const char*)g.A + (size_t)nxt.pm * tstep : cA; const char* nB = has_next ? (const char*)g.Bt + (size_t)nxt.pn * tstep : cB;
        for (int t = 0; t < nt; t += 2) {
            const bool last = (t == nt - 2);
            const char* a1 = cA + (size_t)(t + 1) * kstep;
            const char* a2 = last ? nA : cA + (size_t)(t + 2) * kstep; const char* b2 = last ? nB : cB + (size_t)(t + 2) * kstep;
            const char* a3 = a2 + kstep; const char* b3 = b2 + kstep;
            if (last && has_next) S.a_ready(nxt);
            if constexpr (SP2) {
            PG8_LDB(B0, 0, 0); PG8_LDB(B1, 0, 1); PG8_SCHED; PG8_LDA(At, 0, 0); PG8_STAGE(PG8_SA(1, 1), a1 + hstep, voffA);
            PG8_WAIT_V(8); PG8_WAIT_L(0); PG8_BAR; PG8_MMA(0, 0, At, B0); PG8_MMA(0, 1, At, B1); PG8_BAR; PG8_SCHED;
            PG8_LDA(At, 0, 1); PG8_STAGE(PG8_SB(0, 0), b2, voffB); PG8_STAGE(PG8_SB(0, 1), b2 + hstep, voffB); PG8_STAGE(PG8_SA(0, 0), a2, voffA);
            PG8_WAIT_V(8); PG8_WAIT_L(0); PG8_BAR; PG8_MMA(1, 0, At, B0); PG8_MMA(1, 1, At, B1); PG8_BAR; PG8_SCHED;
            PG8_LDB(B0, 1, 0); PG8_LDB(B1, 1, 1); PG8_SCHED; PG8_LDA(At, 1, 0); PG8_STAGE(PG8_SA(0, 1), a2 + hstep, voffA);
            PG8_WAIT_V(8); PG8_WAIT_L(0); PG8_BAR; PG8_MMA(0, 0, At, B0); PG8_MMA(0, 1, At, B1); PG8_BAR; PG8_SCHED;
            PG8_LDA(At, 1, 1); PG8_STAGE(PG8_SB(1, 0), b3, voffB); PG8_STAGE(PG8_SB(1, 1), b3 + hstep, voffB); PG8_STAGE(PG8_SA(1, 0), a3, voffA);
            PG8_WAIT_V(8); PG8_WAIT_L(0); PG8_BAR; PG8_MMA(1, 0, At, B0); PG8_MMA(1, 1, At, B1); PG8_BAR; PG8_SCHED;
            } else {
            PG8_LDB(B0, 0, 0); PG8_SCHED; PG8_LDA(At, 0, 0); PG8_STAGE(PG8_SA(1, 1), a1 + hstep, voffA);
            PG8_WAIT_L(8); PG8_BAR; PG8_WAIT_L(0); PG8_MMA(0, 0, At, B0); PG8_BAR; PG8_SCHED;
            PG8_LDB(B1, 0, 1); PG8_STAGE(PG8_SB(0, 0), b2, voffB);
            PG8_BAR; PG8_WAIT_L(0); PG8_MMA(0, 1, At, B1); PG8_BAR;
            PG8_LDA(At, 0, 1); PG8_STAGE(PG8_SA(0, 0), a2, voffA);
            PG8_BAR; PG8_WAIT_L(0); PG8_MMA(1, 0, At, B0); PG8_BAR; PG8_SCHED;
            PG8_STAGE(PG8_SB(0, 1), b2 + hstep, voffB);
            PG8_WAIT_V(6); PG8_BAR; PG8_MMA(1, 1, At, B1); PG8_BAR;
            PG8_LDB(B0, 1, 0); PG8_SCHED; PG8_LDA(At, 1, 0); PG8_STAGE(PG8_SA(0, 1), a2 + hstep, voffA);
            PG8_WAIT_L(8); PG8_BAR; PG8_WAIT_L(0); PG8_MMA(0, 0, At, B0); PG8_BAR; PG8_SCHED;
            PG8_LDB(B1, 1, 1); PG8_STAGE(PG8_SB(1, 0), b3, voffB);
            PG8_BAR; PG8_WAIT_L(0); PG8_MMA(0, 1, At, B1); PG8_BAR;
            PG8_LDA(At, 1, 1); PG8_STAGE(PG8_SA(1, 0), a3, voffA);
            PG8_BAR; PG8_WAIT_L(0); PG8_MMA(1, 0, At, B0); PG8_BAR; PG8_SCHED;
            PG8_STAGE(PG8_SB(1, 1), b3 + hstep, voffB);
            PG8_WAIT_V(6); PG8_BAR; PG8_MMA(1, 1, At, B1); PG8_BAR;
            }
        }
        if constexpr (ALIGN_EPI) { if (wr == 0) PG8_BAR; }
        if constexpr (!Epi::AFTER_DRAIN) { E(acc, cur, wr, wc, fr, fq); S.done(cur); }
        if (!has_next) break;
#pragma unroll
        for (int a = 0; a < 2; ++a)
#pragma unroll
            for (int b = 0; b < 2; ++b)
#pragma unroll
                for (int m = 0; m < 4; ++m)
#pragma unroll
                    for (int n = 0; n < 2; ++n) acc[a][b][m][n] = (f32x4){0.f, 0.f, 0.f, 0.f};
        cur = nxt; cA = nA; cB = nB; ++ui;
        if constexpr (ALIGN_EPI) { if (wr == 1) PG8_BAR; }
    }
    PG8_WAIT_V(0);
    if constexpr (!ALIGN_EPI) { if (wr == 0) PG8_BAR; }
    PG8_BAR;
#undef PG8_SA
#undef PG8_SB
#undef PG8_STAGE
#undef PG8_LDA
#undef PG8_LDB
#undef PG8_MMA
#undef PG8_WAIT_V
#undef PG8_WAIT_L
#undef PG8_BAR
#undef PG8_SCHED
}
}

#define XB_TMO      128
#define XB_XCNT(j)  (256  + 64 * (j))
#define XB_XSUB(j)  (1280 + 64 * (j))
#define XB_XGEN(j)  (2304 + 64 * (j))
#define XB_TOP      3328
#define XB_TOPGEN   3392
#define XCD_BAR_WORDS 3456
#define XB_SPIN_CAP (1u << 18)
__device__ __forceinline__ unsigned xb_ld(unsigned* p)              { return __hip_atomic_load(p, __ATOMIC_RELAXED, __HIP_MEMORY_SCOPE_AGENT); }
__device__ __forceinline__ unsigned xb_add(unsigned* p, unsigned v) { return __hip_atomic_fetch_add(p, v, __ATOMIC_RELAXED, __HIP_MEMORY_SCOPE_AGENT); }
__device__ __forceinline__ unsigned xb_xcc_id() { return (unsigned)__builtin_amdgcn_s_getreg((3 << 11) | 20) & 0xFu; }
#define XB_SPIN(cond, bar) do { unsigned _sp = 0; while (cond) { __builtin_amdgcn_s_sleep(1); \
    if ((++_sp & 255u) == 0u) { if (xb_ld(&(bar)[XB_TMO])) break; if (_sp > XB_SPIN_CAP) { atomicAdd(&(bar)[XB_TMO], 1u); break; } } } } while (0)
struct XcdBarrier { unsigned* bar; unsigned x; volatile LAS unsigned* st; };
__device__ __forceinline__ XcdBarrier xcd_barrier_post(unsigned* bar, volatile LAS unsigned* st) {
    XcdBarrier b; b.bar = bar; b.x = xb_xcc_id(); b.st = st;
    if (threadIdx.x == 0) (void)xb_add(&bar[XB_XCNT(b.x)], 1u);
    return b;
}
__device__ __forceinline__ void xcd_barrier_complete(unsigned* bar, unsigned x, unsigned& nloc, unsigned& nx) {
    const unsigned G = gridDim.x * gridDim.y * gridDim.z;
    unsigned sum, cnt, mine, sp = 0u;
    for (;;) {
        sum = 0u; cnt = 0u; mine = 0u;
#pragma unroll
        for (unsigned j = 0; j < 16; ++j) { const unsigned c = xb_ld(&bar[XB_XCNT(j)]); sum += c; cnt += (c > 0u) ? 1u : 0u; mine = (j == x) ? c : mine; }
        if (sum == G) break;
        __builtin_amdgcn_s_sleep(1);
        if ((++sp & 255u) == 0u) { if (xb_ld(&bar[XB_TMO])) break; if (sp > XB_SPIN_CAP) { atomicAdd(&bar[XB_TMO], 1u); break; } }
    }
    nloc = mine > 0u ? mine : 1u; nx = cnt > 0u ? cnt : 1u;
}
__device__ __forceinline__ void xcd_barrier(const XcdBarrier& b) {
    asm volatile("s_waitcnt vmcnt(0)" ::: "memory");
    __syncthreads();
    if (threadIdx.x == 0) {
        unsigned* bar = b.bar;
        __builtin_amdgcn_s_waitcnt(0);
        unsigned nloc = b.st[0], nx = b.st[1];
        if (nloc == 0u) { xcd_barrier_complete(bar, b.x, nloc, nx); b.st[0] = nloc; b.st[1] = nx; }
        const unsigned old = xb_add(&bar[XB_XSUB(b.x)], 1u);
        const unsigned gen = old / nloc;
        if (old + 1u == (gen + 1u) * nloc) {
            __builtin_amdgcn_fence(__ATOMIC_RELEASE, "agent");
            asm volatile("s_waitcnt vmcnt(0)" ::: "memory");
            const unsigned og = xb_add(&bar[XB_TOP], 1u);
            const unsigned tg = og / nx;
            if (og + 1u == (tg + 1u) * nx) xb_add(&bar[XB_TOPGEN], 1u);
            else XB_SPIN(xb_ld(&bar[XB_TOPGEN]) == tg, bar);
            __builtin_amdgcn_fence(__ATOMIC_ACQUIRE, "agent");
            xb_add(&bar[XB_XGEN(b.x)], 1u);
            asm volatile("s_waitcnt vmcnt(0)" ::: "memory");
        } else {
            XB_SPIN(xb_ld(&bar[XB_XGEN(b.x)]) == gen, bar);
            __builtin_amdgcn_fence(__ATOMIC_ACQUIRE, "agent");
            asm volatile("s_waitcnt vmcnt(0)" ::: "memory");
        }
    }
    __syncthreads();
}

constexpr size_t MiB = 1u << 20;
constexpr size_t WS_CTL = 0, CTL_ZERO_BYTES = 1 * MiB;
constexpr int CW_BAR = 4096;
constexpr size_t WS_WAB = 1 * MiB;
constexpr size_t WS_WC = WS_WAB + (size_t)AB_WP * DM * 2;
constexpr size_t WS_WABO = WS_WC + (size_t)C_WP * DM * 2;
constexpr size_t WS_WCO = WS_WABO + (size_t)DM * DM * 2;
constexpr size_t WS_WMQ = WS_WCO + (size_t)DM * DM * 2;
constexpr size_t WS_WKV = WS_WMQ + (size_t)2 * 512 * DM * 2;
constexpr size_t WS_WMO = WS_WKV + (size_t)2048 * DM * 2;
constexpr size_t WS_WFI = WS_WMO + (size_t)2 * DM * 512 * 2;
constexpr size_t WS_WFO = WS_WFI + (size_t)2 * 5632 * DM * 2;
constexpr size_t WS_WEND = WS_WFO + (size_t)2 * DM * DFF * 2;
constexpr size_t WS_MISC = 64 * MiB;
static_assert(WS_WEND <= WS_MISC, "weights fit");
constexpr size_t WS_ROPE64 = WS_MISC;
constexpr size_t WS_ROPE32 = WS_ROPE64 + (size_t)MTOK * 16 * 4;
constexpr size_t WS_RSQ = WS_ROPE32 + (size_t)MTOK * 8 * 4;
constexpr size_t WS_MRS = WS_RSQ + (size_t)MTOK * 16 * 4;
constexpr size_t WS_MEMB = WS_MRS + 8192;
constexpr size_t WS_KVRAW = WS_MEMB + (size_t)MMEM * DM * 2;
constexpr size_t WS_W1T = WS_KVRAW + (size_t)MMEM * 2048 * 2;
constexpr size_t WS_POSW1 = WS_W1T + (size_t)2 * 64 * 2048 * 2;
constexpr size_t WS_KCMP = WS_POSW1 + 512;
constexpr size_t WS_VCMP = WS_KCMP + (size_t)BATCH * 4 * 256 * 64 * 2;
constexpr size_t WS_MISCEND = WS_VCMP + (size_t)BATCH * 4 * 256 * 64 * 2;
constexpr size_t WS_XB = 96 * MiB;
static_assert(WS_MISCEND <= WS_XB, "misc fits");
constexpr size_t WS_R1 = 160 * MiB;
constexpr size_t WS_OATT = 336 * MiB;
constexpr size_t WS_R3 = 400 * MiB;
constexpr size_t WS_GT = WS_R3;
constexpr size_t WS_MQ = WS_R3;
constexpr size_t WS_OMEM = WS_R3 + (size_t)MTOK * 512 * 2;
constexpr size_t WS_SC = WS_OATT;
constexpr size_t WS_BM = 464 * MiB;
constexpr size_t WS_KM = 480 * MiB;
constexpr size_t WS_ISG = 481 * MiB;
constexpr size_t WS_END = 512 * MiB;
static_assert(WS_R1 + (size_t)MTOK * C_WP * 2 <= WS_OATT, "R1 fits");

constexpr int LDS_BYTES = 155648;
constexpr int LDS_MISC = 151552;
constexpr int NWAVES = 8;

__device__ __forceinline__ unsigned f2bf(float f) { unsigned u = __builtin_bit_cast(unsigned, f); return (u + 0x7fffu + ((u >> 16) & 1u)) >> 16; }
__device__ __forceinline__ unsigned pk2(float lo, float hi) { f32x2 v = {lo, hi}; bf16x2_t b = __builtin_convertvector(v, bf16x2_t); return __builtin_bit_cast(unsigned, b); }
__device__ __forceinline__ float bf2f(unsigned short b) { return __builtin_bit_cast(float, (unsigned)b << 16); }
__device__ __forceinline__ float wave_sum(float v) {
#pragma unroll
    for (int o = 1; o < 64; o <<= 1) v += __shfl_xor(v, o);
    return v;
}


namespace att {
constexpr float NEG_INF = -__builtin_huge_valf();
template <int HD> struct Geo { static constexpr int PK = HD * 2 + 16, PV = (HD == 64 ? 192 : 320), KB = 64 * PK, VB = 64 * PV, BUF = KB + VB; };
template <int HD> struct State { f32x16 o[HD / 32]; float m, l;
    __device__ __forceinline__ void init() {
#pragma unroll
        for (int d = 0; d < HD / 32; ++d)
#pragma unroll
            for (int i = 0; i < 16; ++i) o[d][i] = 0.f;
        m = NEG_INF; l = 0.f; } };
template <int HD> struct TileRegs { u32x4 k[HD / 64], v[HD / 64]; };
template <int HD> __device__ __forceinline__ void load_tile(TileRegs<HD>& tr, const bf16_t* kb, size_t kp, const bf16_t* vb, size_t vp, int tid) {
#pragma unroll
    for (int i = 0; i < HD / 64; ++i) { const int idx = tid + 512 * i, row = idx / (HD / 8), c = idx % (HD / 8);
        tr.k[i] = *(const u32x4*)(kb + (size_t)row * kp + c * 8); tr.v[i] = *(const u32x4*)(vb + (size_t)row * vp + c * 8); }
}
template <int HD> __device__ __forceinline__ void store_tile(const TileRegs<HD>& tr, LAS unsigned char* buf, int tid) {
#pragma unroll
    for (int i = 0; i < HD / 64; ++i) { const int idx = tid + 512 * i, row = idx / (HD / 8), c = idx % (HD / 8);
        *(LAS u32x4*)(buf + row * Geo<HD>::PK + c * 16) = tr.k[i]; *(LAS u32x4*)(buf + Geo<HD>::KB + row * Geo<HD>::PV + c * 16) = tr.v[i]; }
}
__device__ __forceinline__ s16x4 tr_read(const LAS unsigned char* p) { typedef short v4i16_t __attribute__((ext_vector_type(4)));
    return __builtin_bit_cast(s16x4, __builtin_amdgcn_ds_read_tr16_b64_v4i16((LAS v4i16_t*)p)); }
__device__ __forceinline__ bf16x8 pack8(const f32x16& x, int s8) {
    u32x4 w; w.x = pk2(x[s8], x[s8 + 1]); w.y = pk2(x[s8 + 2], x[s8 + 3]); w.z = pk2(x[s8 + 4], x[s8 + 5]); w.w = pk2(x[s8 + 6], x[s8 + 7]); return __builtin_bit_cast(bf16x8, w); }
template <int HD> __device__ __forceinline__ void tile_scores(f32x16 (&p)[2], const bf16x8 (&qf)[HD / 16], const LAS unsigned char* buf, int lane) {
    const int r = lane & 31, h = lane >> 5;
#pragma unroll
    for (int kt = 0; kt < 2; ++kt) { f32x16 x;
#pragma unroll
        for (int i = 0; i < 16; ++i) x[i] = 0.f;
#pragma unroll
        for (int s = 0; s < HD / 16; ++s) { const bf16x8 kf = *(const LAS bf16x8*)(buf + (32 * kt + r) * Geo<HD>::PK + 32 * s + 16 * h); x = __builtin_amdgcn_mfma_f32_32x32x16_bf16(kf, qf[s], x, 0, 0, 0); }
        p[kt] = x; }
}
template <int HD> __device__ __forceinline__ void tile_pv(f32x16 (&o)[HD / 32], const f32x16 (&p)[2], const LAS unsigned char* buf, int lane) {
    const int h = lane >> 5, blk = (lane >> 4) & 1, q = (lane & 15) >> 2, pp = lane & 3;
    const LAS unsigned char* vb = buf + Geo<HD>::KB + (4 * h + q) * Geo<HD>::PV + 32 * blk + 8 * pp;
#pragma unroll
    for (int kt = 0; kt < 2; ++kt)
#pragma unroll
        for (int s = 0; s < 2; ++s) { const bf16x8 pb = pack8(p[kt], 8 * s);
#pragma unroll
            for (int dh = 0; dh < HD / 32; ++dh) { const LAS unsigned char* a = vb + (32 * kt + 16 * s) * Geo<HD>::PV + 64 * dh;
                const s16x4 lo = tr_read(a), hi = tr_read(a + 8 * Geo<HD>::PV);
                const bf16x8 vf = __builtin_shufflevector(lo, hi, 0, 1, 2, 3, 4, 5, 6, 7);
                o[dh] = __builtin_amdgcn_mfma_f32_32x32x16_bf16(vf, pb, o[dh], 0, 0, 0); } }
}
template <int HD, class MaskF> __device__ __forceinline__ void tile_step(State<HD>& st, const bf16x8 (&qf)[HD / 16], const LAS unsigned char* buf, int lane, MaskF valid) {
    f32x16 p[2]; tile_scores<HD>(p, qf, buf, lane);
    float mx = NEG_INF;
#pragma unroll
    for (int kt = 0; kt < 2; ++kt)
#pragma unroll
        for (int i = 0; i < 16; ++i) { const int koff = 32 * kt + (i & 3) + 8 * (i >> 2); const float v = valid(koff) ? p[kt][i] : NEG_INF; p[kt][i] = v; mx = fmaxf(mx, v); }
    mx = fmaxf(mx, __shfl_xor(mx, 32));
    const float mnew = fmaxf(st.m, mx), muse = (mnew == NEG_INF) ? 0.f : mnew;
    const float alpha = __builtin_amdgcn_exp2f(st.m - muse);
    float ls = 0.f;
#pragma unroll
    for (int kt = 0; kt < 2; ++kt)
#pragma unroll
        for (int i = 0; i < 16; ++i) { const float e = __builtin_amdgcn_exp2f(p[kt][i] - muse); p[kt][i] = e; ls += e; }
    st.l = st.l * alpha + ls; st.m = mnew;
#pragma unroll
    for (int dh = 0; dh < HD / 32; ++dh)
#pragma unroll
        for (int i = 0; i < 16; ++i) st.o[dh][i] *= alpha;
    tile_pv<HD>(st.o, p, buf, lane);
}
template <int HD, class SrcF, class CompF> __device__ __forceinline__ void kv_pipeline(LAS unsigned char* lds, int nt, int tid, SrcF src, CompF comp) {
    TileRegs<HD> tr; const bf16_t *kb, *vb; size_t kp, vp;
    __syncthreads();
    if (nt <= 0) return;
    src(0, kb, kp, vb, vp); load_tile<HD>(tr, kb, kp, vb, vp, tid); store_tile<HD>(tr, lds, tid);
    __syncthreads();
    for (int t = 0; t < nt; ++t) {
        if (t + 1 < nt) { src(t + 1, kb, kp, vb, vp); load_tile<HD>(tr, kb, kp, vb, vp, tid); }
        comp(t, lds + (t & 1) * Geo<HD>::BUF);
        if (t + 1 < nt) store_tile<HD>(tr, lds + ((t + 1) & 1) * Geo<HD>::BUF, tid);
        __syncthreads();
    }
}

template <int HD, bool PIPE, class SrcF, class ActF, class FinF> __device__ __forceinline__ void kv_pipeline3(LAS unsigned char* lds, int nt, int tid, int lane, const bf16x8 (&qf)[HD / 16], SrcF src, ActF act, FinF fin) {
    TileRegs<HD> tr; const bf16_t *kb, *vb; size_t kp, vp;
    __syncthreads();
    if (nt <= 0) return;
    src(0, kb, kp, vb, vp); load_tile<HD>(tr, kb, kp, vb, vp, tid); store_tile<HD>(tr, lds, tid);
    if (nt > 1) { src(1, kb, kp, vb, vp); load_tile<HD>(tr, kb, kp, vb, vp, tid); store_tile<HD>(tr, lds + Geo<HD>::BUF, tid); }
    __syncthreads();
    f32x16 pc[2], pn[2];
    if constexpr (PIPE) { if (act(0)) tile_scores<HD>(pc, qf, lds, lane); }
    int b0 = 0, b1 = 1, b2 = 2;
    for (int t = 0; t < nt; ++t) {
        if (t + 2 < nt) { src(t + 2, kb, kp, vb, vp); load_tile<HD>(tr, kb, kp, vb, vp, tid); }
        if constexpr (PIPE) {
            const bool an = (t + 1 < nt) && act(t + 1);
            if (an) tile_scores<HD>(pn, qf, lds + b1 * Geo<HD>::BUF, lane);
            if (act(t)) fin(t, pc, lds + b0 * Geo<HD>::BUF);
        } else {
            if (act(t)) { tile_scores<HD>(pc, qf, lds + b0 * Geo<HD>::BUF, lane); fin(t, pc, lds + b0 * Geo<HD>::BUF); }
        }
        if (t + 2 < nt) store_tile<HD>(tr, lds + b2 * Geo<HD>::BUF, tid);
        __syncthreads();
        if constexpr (PIPE) {
#pragma unroll
            for (int k = 0; k < 2; ++k) pc[k] = pn[k]; }
        const int tb = b0; b0 = b1; b1 = b2; b2 = tb;
    }
}
template <int HD, class MaskF> __device__ __forceinline__ void tile_finish(State<HD>& st, f32x16 (&p)[2], const LAS unsigned char* buf, int lane, bool lane_ok, bool elem, MaskF valid) {
    float mx = fmaxf(p[0][0], p[1][0]);
#pragma unroll
    for (int i = 1; i < 16; ++i) mx = fmaxf(mx, fmaxf(p[0][i], p[1][i]));
    mx = fmaxf(mx, __shfl_xor(mx, 32));
    if (__any(mx > st.m)) {
        const float mnew = fmaxf(st.m, mx), alpha = __builtin_amdgcn_exp2f(st.m - mnew);
        st.l *= alpha; st.m = mnew;
#pragma unroll
        for (int dh = 0; dh < HD / 32; ++dh)
#pragma unroll
            for (int i = 0; i < 16; ++i) st.o[dh][i] *= alpha;
    }
    const float sub = lane_ok ? st.m : __builtin_huge_valf();
#pragma unroll
    for (int kt = 0; kt < 2; ++kt)
#pragma unroll
        for (int i = 0; i < 16; ++i) p[kt][i] = __builtin_amdgcn_exp2f(p[kt][i] - sub);
    if (elem) {
#pragma unroll
        for (int kt = 0; kt < 2; ++kt)
#pragma unroll
            for (int i = 0; i < 16; ++i) { const int koff = 32 * kt + (i & 3) + 8 * (i >> 2); p[kt][i] = valid(koff) ? p[kt][i] : 0.f; }
    }
    float ls = 0.f;
#pragma unroll
    for (int i = 0; i < 16; ++i) ls += p[0][i] + p[1][i];
    st.l += ls;
    tile_pv<HD>(st.o, p, buf, lane);
}

template <int HD, bool ELEM, class MaskF> __device__ __forceinline__ void tile_fused(State<HD>& st, f32x16 (&p)[2], const LAS unsigned char* buf, int lane, bool lane_ok, MaskF valid,
                                                                                 const bf16x8 (&qf)[HD / 16], const LAS unsigned char* nbuf, f32x16 (&pn)[2]) {
    float mx = fmaxf(p[0][0], p[1][0]);
#pragma unroll
    for (int i = 1; i < 16; ++i) mx = fmaxf(mx, fmaxf(p[0][i], p[1][i]));
    mx = fmaxf(mx, __shfl_xor(mx, 32));
    if (__any(mx > st.m)) {
        const float mnew = fmaxf(st.m, mx), alpha = __builtin_amdgcn_exp2f(st.m - mnew);
        st.l *= alpha; st.m = mnew;
#pragma unroll
        for (int dh = 0; dh < HD / 32; ++dh)
#pragma unroll
            for (int i = 0; i < 16; ++i) st.o[dh][i] *= alpha;
    }
    const float sub = lane_ok ? st.m : __builtin_huge_valf();
    asm volatile("" : "+v"(lane));
    const int r = lane & 31, h = lane >> 5, blk = (lane >> 4) & 1, q4 = (lane & 15) >> 2, pp = lane & 3;
    const LAS unsigned char* kl = nbuf + r * Geo<HD>::PK + 16 * h;
    const LAS unsigned char* vl = buf + Geo<HD>::KB + (4 * h + q4) * Geo<HD>::PV + 32 * blk + 8 * pp;
#pragma unroll
    for (int i = 0; i < 16; ++i) { pn[0][i] = 0.f; pn[1][i] = 0.f; }
    float ls = 0.f;
#pragma unroll
    for (int c = 0; c < 4; ++c) {
        const int kt = c >> 1, s2 = c & 1;
#pragma unroll
        for (int ss = 0; ss < HD / 32; ++ss) { const int sk = (HD / 32) * s2 + ss; const bf16x8 kf = *(const LAS bf16x8*)(kl + (32 * kt) * Geo<HD>::PK + 32 * sk);
            pn[kt] = __builtin_amdgcn_mfma_f32_32x32x16_bf16(kf, qf[sk], pn[kt], 0, 0, 0); }
#pragma unroll
        for (int j = 0; j < 8; ++j) { const int i = 8 * s2 + j; float e = __builtin_amdgcn_exp2f(p[kt][i] - sub);
            if (ELEM) { const int koff = 32 * kt + (i & 3) + 8 * (i >> 2); e = valid(koff) ? e : 0.f; }
            p[kt][i] = e; ls += e; }
        const bf16x8 pb = pack8(p[kt], 8 * s2);
#pragma unroll
        for (int dh = 0; dh < HD / 32; ++dh) { const LAS unsigned char* a = vl + (32 * kt + 16 * s2) * Geo<HD>::PV + 64 * dh;
            const s16x4 lo = tr_read(a), hi = tr_read(a + 8 * Geo<HD>::PV);
            const bf16x8 vf = __builtin_shufflevector(lo, hi, 0, 1, 2, 3, 4, 5, 6, 7);
            st.o[dh] = __builtin_amdgcn_mfma_f32_32x32x16_bf16(vf, pb, st.o[dh], 0, 0, 0); }
        __builtin_amdgcn_sched_barrier(0);
    }
    st.l += ls;
}
struct NoPre { __device__ __forceinline__ void operator()(int) const {} };
template <int HD, class SrcF, class FinF, class PreF = NoPre> __device__ __forceinline__ void kv_pipeline4(LAS unsigned char* lds, int nt, int tid, int lane, const bf16x8 (&qf)[HD / 16], SrcF src, FinF fin, PreF pre = PreF()) {
    TileRegs<HD> tr; const bf16_t *kb, *vb; size_t kp, vp;
    __syncthreads();
    if (nt <= 0) return;
    src(0, kb, kp, vb, vp); load_tile<HD>(tr, kb, kp, vb, vp, tid); store_tile<HD>(tr, lds, tid);
    if (nt > 1) { src(1, kb, kp, vb, vp); load_tile<HD>(tr, kb, kp, vb, vp, tid); store_tile<HD>(tr, lds + Geo<HD>::BUF, tid); }
    __syncthreads();
    f32x16 pc[2], pn[2];
    tile_scores<HD>(pc, qf, lds, lane);
    int b0 = 0, b1 = 1, b2 = 2;
    for (int t = 0; t < nt; ++t) {
        pre(t + 1);
        if (t + 2 < nt) { src(t + 2, kb, kp, vb, vp); load_tile<HD>(tr, kb, kp, vb, vp, tid); }
        const int bn = (t + 1 < nt) ? b1 : b0;
        fin(t, pc, lds + b0 * Geo<HD>::BUF, lds + bn * Geo<HD>::BUF, pn);
        if (t + 2 < nt) store_tile<HD>(tr, lds + b2 * Geo<HD>::BUF, tid);
        __syncthreads();
#pragma unroll
        for (int k = 0; k < 2; ++k) pc[k] = pn[k];
        const int tb = b0; b0 = b1; b1 = b2; b2 = tb;
    }
}

constexpr int DBUF = 16384;
__device__ __forceinline__ void dma_tile(LAS unsigned char* buf, const bf16_t* kb, size_t kp, const bf16_t* vb, size_t vp, int wave, int lane) {
    const int row = 8 * wave + (lane >> 3), cp = lane & 7;
    const bf16_t* gk = kb + (size_t)row * kp + ((cp ^ ((row >> 1) & 7)) * 8);
    const bf16_t* gv = vb + (size_t)row * vp + ((cp ^ (4 * ((row >> 1) & 1))) * 8);
    __builtin_amdgcn_global_load_lds((const unsigned*)gk, (LAS unsigned*)(buf + wave * 1024), 16, 0, 0);
    __builtin_amdgcn_global_load_lds((const unsigned*)gv, (LAS unsigned*)(buf + 8192 + wave * 1024), 16, 0, 0);
}
__device__ __forceinline__ void scores_d(f32x16 (&p)[2], const bf16x8 (&qf)[4], const LAS unsigned char* buf, int lane) {
    const int r = lane & 31, h = lane >> 5;
#pragma unroll
    for (int kt = 0; kt < 2; ++kt) { f32x16 x;
#pragma unroll
        for (int i = 0; i < 16; ++i) x[i] = 0.f;
        const int row = 32 * kt + r; const LAS unsigned char* kr = buf + row * 128; const int sw = (row >> 1) & 7;
#pragma unroll
        for (int s = 0; s < 4; ++s) { const bf16x8 kf = *(const LAS bf16x8*)(kr + (((2 * s + h) ^ sw) * 16)); x = __builtin_amdgcn_mfma_f32_32x32x16_bf16(kf, qf[s], x, 0, 0, 0); }
        p[kt] = x; }
}
template <bool ELEM, class MaskF> __device__ __forceinline__ void fused_d(State<64>& st, f32x16 (&p)[2], const LAS unsigned char* buf, int lane, bool lane_ok, MaskF valid,
                                                                        const bf16x8 (&qf)[4], const LAS unsigned char* nbuf, f32x16 (&pn)[2]) {
    float mx = fmaxf(p[0][0], p[1][0]);
#pragma unroll
    for (int i = 1; i < 16; ++i) mx = fmaxf(mx, fmaxf(p[0][i], p[1][i]));
    mx = fmaxf(mx, __shfl_xor(mx, 32));
    if (__any(mx > st.m)) {
        const float mnew = fmaxf(st.m, mx), alpha = __builtin_amdgcn_exp2f(st.m - mnew);
        st.l *= alpha; st.m = mnew;
#pragma unroll
        for (int dh = 0; dh < 2; ++dh)
#pragma unroll
            for (int i = 0; i < 16; ++i) st.o[dh][i] *= alpha;
    }
    const float sub = lane_ok ? st.m : __builtin_huge_valf();
    asm volatile("" : "+v"(lane));
    const int r = lane & 31, h = lane >> 5, blk = (lane >> 4) & 1, q4 = (lane & 15) >> 2, pp = lane & 3;
    const int ksw = (r >> 1) & 7;
    const LAS unsigned char* kl = nbuf + r * 128;
    const int vsw = 4 * ((q4 >> 1) & 1);
    const LAS unsigned char* vl = buf + 8192 + (4 * h + q4) * 128 + 8 * (pp & 1);
    const int vc0 = ((2 * blk + (pp >> 1)) ^ vsw) * 16, vc1 = ((4 + 2 * blk + (pp >> 1)) ^ vsw) * 16;
#pragma unroll
    for (int i = 0; i < 16; ++i) { pn[0][i] = 0.f; pn[1][i] = 0.f; }
    float ls = 0.f;
#pragma unroll
    for (int c = 0; c < 4; ++c) {
        const int kt = c >> 1, s2 = c & 1;
        s16x4 l0, h0, l1, h1;
        { const unsigned a0 = (unsigned)(size_t)(vl + (32 * kt + 16 * s2) * 128 + vc0), a1 = (unsigned)(size_t)(vl + (32 * kt + 16 * s2) * 128 + vc1);
          asm volatile("ds_read_b64_tr_b16 %0, %4\n\tds_read_b64_tr_b16 %1, %4 offset:1024\n\tds_read_b64_tr_b16 %2, %5\n\tds_read_b64_tr_b16 %3, %5 offset:1024"
                       : "=&v"(l0), "=&v"(h0), "=&v"(l1), "=&v"(h1) : "v"(a0), "v"(a1) : "memory"); }
#pragma unroll
        for (int ss = 0; ss < 2; ++ss) { const int sk = 2 * s2 + ss; const bf16x8 kf = *(const LAS bf16x8*)(kl + kt * 4096 + (((2 * sk + h) ^ ksw) * 16));
            pn[kt] = __builtin_amdgcn_mfma_f32_32x32x16_bf16(kf, qf[sk], pn[kt], 0, 0, 0); }
#pragma unroll
        for (int j = 0; j < 8; ++j) { const int i = 8 * s2 + j; float e = __builtin_amdgcn_exp2f(p[kt][i] - sub);
            if (ELEM) { const int koff = 32 * kt + (i & 3) + 8 * (i >> 2); e = valid(koff) ? e : 0.f; }
            p[kt][i] = e; ls += e; }
        const bf16x8 pb = pack8(p[kt], 8 * s2);
        asm volatile("s_waitcnt lgkmcnt(0)" ::: "memory"); __builtin_amdgcn_sched_barrier(0);
        st.o[0] = __builtin_amdgcn_mfma_f32_32x32x16_bf16(__builtin_shufflevector(l0, h0, 0, 1, 2, 3, 4, 5, 6, 7), pb, st.o[0], 0, 0, 0);
        st.o[1] = __builtin_amdgcn_mfma_f32_32x32x16_bf16(__builtin_shufflevector(l1, h1, 0, 1, 2, 3, 4, 5, 6, 7), pb, st.o[1], 0, 0, 0);
        __builtin_amdgcn_sched_barrier(0);
    }
    st.l += ls;
}
template <int XTRA, class SrcF, class FinF, class XtraF> __device__ __forceinline__ void kv_pipeline_dma(LAS unsigned char* lds, int nt, int wave, int lane, const bf16x8 (&qf)[4], SrcF src, FinF fin, XtraF xtra) {
    const bf16_t *kb, *vb; size_t kp, vp;
    asm volatile("s_waitcnt vmcnt(0) lgkmcnt(0)" ::: "memory"); __builtin_amdgcn_s_barrier();
    if (nt <= 0) return;
#pragma unroll
    for (int i = 0; i < 3; ++i) if (i < nt) { src(i, kb, kp, vb, vp); dma_tile(lds + i * DBUF, kb, kp, vb, vp, wave, lane); xtra(i, i); }
    if (nt >= 3) { if (XTRA) asm volatile("s_waitcnt vmcnt(3)" ::: "memory"); else asm volatile("s_waitcnt vmcnt(2)" ::: "memory"); }
    else asm volatile("s_waitcnt vmcnt(0)" ::: "memory");
    __builtin_amdgcn_s_barrier();
    f32x16 pc[2], pn[2];
    scores_d(pc, qf, lds, lane);
    for (int t = 0; t < nt; ++t) {
        if (t + 3 < nt) { src(t + 3, kb, kp, vb, vp); dma_tile(lds + ((t + 3) & 3) * DBUF, kb, kp, vb, vp, wave, lane); xtra(t + 3, (t + 3) & 3); }
        const int bn = (t + 1 < nt) ? ((t + 1) & 3) : (t & 3);
        fin(t, pc, lds + (t & 3) * DBUF, lds + bn * DBUF, pn, t & 3);
        if (t + 3 < nt) { if (XTRA) asm volatile("s_waitcnt vmcnt(3) lgkmcnt(0)" ::: "memory"); else asm volatile("s_waitcnt vmcnt(2) lgkmcnt(0)" ::: "memory"); }
        else asm volatile("s_waitcnt vmcnt(0) lgkmcnt(0)" ::: "memory");
        __builtin_amdgcn_s_barrier();
#pragma unroll
        for (int k = 0; k < 2; ++k) pc[k] = pn[k];
    }
}
struct NoXtra { __device__ __forceinline__ void operator()(int, int) const {} };

template <int MODE, bool HS, class MaskF> __device__ __forceinline__ void fused_np(f32x16 (&o)[2], float& l, const f32x16 (&p)[2], const LAS unsigned char* buf, int lane, bool lane_ok, float shift, MaskF valid, unsigned wlo, unsigned whi,
                                                                        const bf16x8 (&qf)[4], const LAS unsigned char* nbuf, f32x16 (&pn)[2]) {
    asm volatile("" : "+v"(lane));
    const int r = lane & 31, h = lane >> 5, blk = (lane >> 4) & 1, q4 = (lane & 15) >> 2, pp = lane & 3;
    const int ksw = (r >> 1) & 7;
    const LAS unsigned char* kl = nbuf + r * 128;
    const int vsw = 4 * ((q4 >> 1) & 1);
    const LAS unsigned char* vl = buf + 8192 + (4 * h + q4) * 128 + 8 * (pp & 1);
    const unsigned vb0 = (unsigned)(size_t)vl + ((2 * blk + (pp >> 1)) ^ vsw) * 16, vb1 = (unsigned)(size_t)vl + ((4 + 2 * blk + (pp >> 1)) ^ vsw) * 16;
    const unsigned lmask = lane_ok ? 0xffffffffu : 0u;
    float ls = 0.f;
#pragma unroll
    for (int c = 0; c < 4; ++c) {
        const int kt = c >> 1, s2 = c & 1;
        s16x4 l0, h0, l1, h1;
        asm volatile("ds_read_b64_tr_b16 %0, %4 offset:%c6\n\tds_read_b64_tr_b16 %1, %4 offset:%c7\n\tds_read_b64_tr_b16 %2, %5 offset:%c6\n\tds_read_b64_tr_b16 %3, %5 offset:%c7"
                     : "=&v"(l0), "=&v"(h0), "=&v"(l1), "=&v"(h1) : "v"(vb0), "v"(vb1), "i"((32 * (c >> 1) + 16 * (c & 1)) * 128), "i"((32 * (c >> 1) + 16 * (c & 1)) * 128 + 1024) : "memory");
#pragma unroll
        for (int ss = 0; ss < 2; ++ss) { const int sk = 2 * s2 + ss; const bf16x8 kf = *(const LAS bf16x8*)(kl + kt * 4096 + (((2 * sk + h) ^ ksw) * 16));
            if (sk == 0) { f32x16 z;
#pragma unroll
                for (int i = 0; i < 16; ++i) z[i] = 0.f;
                pn[kt] = __builtin_amdgcn_mfma_f32_32x32x16_bf16(kf, qf[sk], z, 0, 0, 0); }
            else pn[kt] = __builtin_amdgcn_mfma_f32_32x32x16_bf16(kf, qf[sk], pn[kt], 0, 0, 0); }
        float e[8];
#pragma unroll
        for (int j = 0; j < 8; ++j) { const int i = 8 * s2 + j; const int koff = 32 * kt + (i & 3) + 8 * (i >> 2); float x = __builtin_amdgcn_exp2f(HS ? p[kt][i] - shift : p[kt][i]);
            if (MODE == 1) x = valid(koff) ? x : 0.f;
            if (MODE == 2) { int tb; asm("v_bfe_i32 %0, %1, %2, 1" : "=v"(tb) : "v"(kt ? whi : wlo), "n"(koff & 31)); x = __builtin_bit_cast(float, __builtin_bit_cast(unsigned, x) & (unsigned)tb); }
            e[j] = x; }
        u32x4 pw; pw.x = pk2(e[0], e[1]) & lmask; pw.y = pk2(e[2], e[3]) & lmask; pw.z = pk2(e[4], e[5]) & lmask; pw.w = pk2(e[6], e[7]) & lmask;
#pragma unroll
        for (int j = 0; j < 8; ++j) ls += lane_ok ? e[j] : 0.f;
        const bf16x8 pb = __builtin_bit_cast(bf16x8, pw);
        asm volatile("s_waitcnt lgkmcnt(0)" ::: "memory"); __builtin_amdgcn_sched_barrier(0);
        o[0] = __builtin_amdgcn_mfma_f32_32x32x16_bf16(__builtin_shufflevector(l0, h0, 0, 1, 2, 3, 4, 5, 6, 7), pb, o[0], 0, 0, 0);
        o[1] = __builtin_amdgcn_mfma_f32_32x32x16_bf16(__builtin_shufflevector(l1, h1, 0, 1, 2, 3, 4, 5, 6, 7), pb, o[1], 0, 0, 0);
        __builtin_amdgcn_sched_barrier(0);
    }
    l += ls;
}
template <int MODE, bool HS, class MaskF> __device__ __forceinline__ void fused_lp(f32x16 (&o)[2], float& l, const f32x16 (&p)[2], const LAS unsigned char* buf, int lane, bool lane_ok, float shift, MaskF valid, unsigned wlo, unsigned whi,
                                                                        const bf16x8 (&qf)[4], const LAS unsigned char* nbuf, f32x16 (&pn)[2]) {
    asm volatile("" : "+v"(lane));
    const int r = lane & 31, h = lane >> 5, blk = (lane >> 4) & 1, q4 = (lane & 15) >> 2, pp = lane & 3;
    const int ksw = (r >> 1) & 7;
    const unsigned kl = (unsigned)(size_t)(nbuf + r * 128);
    const unsigned kx0 = ((h ^ ksw) * 16), kx1 = (((2 + h) ^ ksw) * 16);
    const unsigned kA0 = kl + kx0, kA1 = kl + kx1, kB0 = kl + (kx0 ^ 64u), kB1 = kl + (kx1 ^ 64u);
    const int vsw = 4 * ((q4 >> 1) & 1);
    const unsigned vl = (unsigned)(size_t)(buf + 8192 + (4 * h + q4) * 128 + 8 * (pp & 1));
    const unsigned vb0 = vl + ((2 * blk + (pp >> 1)) ^ vsw) * 16, vb1 = vl + ((4 + 2 * blk + (pp >> 1)) ^ vsw) * 16;
    const unsigned lmask = lane_ok ? 0xffffffffu : 0u;
    bf16x8 kf[2][2]; s16x4 vf[3][4]; bf16x8 pbp = {0, 0, 0, 0, 0, 0, 0, 0};
#define FE_ISSUE(c_, KS_, VS_) do { constexpr int kt_ = (c_) >> 1, s2_ = (c_) & 1; \
        asm volatile("ds_read_b128 %0, %6 offset:%c10\n\tds_read_b128 %1, %7 offset:%c10\n\tds_read_b64_tr_b16 %2, %8 offset:%c11\n\tds_read_b64_tr_b16 %3, %8 offset:%c12\n\tds_read_b64_tr_b16 %4, %9 offset:%c11\n\tds_read_b64_tr_b16 %5, %9 offset:%c12" \
                     : "=&v"(kf[KS_][0]), "=&v"(kf[KS_][1]), "=&v"(vf[VS_][0]), "=&v"(vf[VS_][1]), "=&v"(vf[VS_][2]), "=&v"(vf[VS_][3]) \
                     : "v"(s2_ ? kB0 : kA0), "v"(s2_ ? kB1 : kA1), "v"(vb0), "v"(vb1), "i"(kt_ * 4096), "i"((32 * kt_ + 16 * s2_) * 128), "i"((32 * kt_ + 16 * s2_) * 128 + 1024) : "memory"); } while (0)
    FE_ISSUE(0, 0, 0);
    float ls = 0.f;
#pragma unroll
    for (int c = 0; c < 4; ++c) {
        const int kt = c >> 1, s2 = c & 1, KS = c & 1, VS = c % 3, VP = (c + 2) % 3;
        asm volatile("s_waitcnt lgkmcnt(0)" ::: "memory"); __builtin_amdgcn_sched_barrier(0);
        if (c < 3) { if (c == 0) FE_ISSUE(1, 1, 1); else if (c == 1) FE_ISSUE(2, 0, 2); else FE_ISSUE(3, 1, 0); }
        if (s2 == 0) { f32x16 z;
#pragma unroll
            for (int i = 0; i < 16; ++i) z[i] = 0.f;
            pn[kt] = __builtin_amdgcn_mfma_f32_32x32x16_bf16(kf[KS][0], qf[0], z, 0, 0, 0); pn[kt] = __builtin_amdgcn_mfma_f32_32x32x16_bf16(kf[KS][1], qf[1], pn[kt], 0, 0, 0); }
        else { pn[kt] = __builtin_amdgcn_mfma_f32_32x32x16_bf16(kf[KS][0], qf[2], pn[kt], 0, 0, 0); pn[kt] = __builtin_amdgcn_mfma_f32_32x32x16_bf16(kf[KS][1], qf[3], pn[kt], 0, 0, 0); }
        if (c > 0) {
            o[0] = __builtin_amdgcn_mfma_f32_32x32x16_bf16(__builtin_shufflevector(vf[VP][0], vf[VP][1], 0, 1, 2, 3, 4, 5, 6, 7), pbp, o[0], 0, 0, 0);
            o[1] = __builtin_amdgcn_mfma_f32_32x32x16_bf16(__builtin_shufflevector(vf[VP][2], vf[VP][3], 0, 1, 2, 3, 4, 5, 6, 7), pbp, o[1], 0, 0, 0); }
        float e[8];
#pragma unroll
        for (int j = 0; j < 8; ++j) { const int i = 8 * s2 + j; const int koff = 32 * kt + (i & 3) + 8 * (i >> 2); float x = __builtin_amdgcn_exp2f(HS ? p[kt][i] - shift : p[kt][i]);
            if (MODE == 1) x = valid(koff) ? x : 0.f;
            if (MODE == 2) { int tb; asm("v_bfe_i32 %0, %1, %2, 1" : "=v"(tb) : "v"(kt ? whi : wlo), "n"(koff & 31)); x = __builtin_bit_cast(float, __builtin_bit_cast(unsigned, x) & (unsigned)tb); }
            e[j] = x; }
        u32x4 pw; pw.x = pk2(e[0], e[1]) & lmask; pw.y = pk2(e[2], e[3]) & lmask; pw.z = pk2(e[4], e[5]) & lmask; pw.w = pk2(e[6], e[7]) & lmask;
#pragma unroll
        for (int j = 0; j < 8; ++j) ls += lane_ok ? e[j] : 0.f;
#pragma unroll
        for (int g = 0; g < 4; ++g) { __builtin_amdgcn_sched_group_barrier(0x008, 1, 0); __builtin_amdgcn_sched_group_barrier(0x002, 9, 0); }
        __builtin_amdgcn_sched_barrier(0);
        pbp = __builtin_bit_cast(bf16x8, pw);
    }
    o[0] = __builtin_amdgcn_mfma_f32_32x32x16_bf16(__builtin_shufflevector(vf[0][0], vf[0][1], 0, 1, 2, 3, 4, 5, 6, 7), pbp, o[0], 0, 0, 0);
    o[1] = __builtin_amdgcn_mfma_f32_32x32x16_bf16(__builtin_shufflevector(vf[0][2], vf[0][3], 0, 1, 2, 3, 4, 5, 6, 7), pbp, o[1], 0, 0, 0);
#undef FE_ISSUE
    l += ls;
}
template <int MODE, bool HS, bool LP, class MaskF> __device__ __forceinline__ void fused_e(f32x16 (&o)[2], float& l, const f32x16 (&p)[2], const LAS unsigned char* buf, int lane, bool lane_ok, float shift, MaskF valid, unsigned wlo, unsigned whi,
                                                                        const bf16x8 (&qf)[4], const LAS unsigned char* nbuf, f32x16 (&pn)[2]) {
    if constexpr (LP) fused_lp<MODE, HS>(o, l, p, buf, lane, lane_ok, shift, valid, wlo, whi, qf, nbuf, pn); else fused_np<MODE, HS>(o, l, p, buf, lane, lane_ok, shift, valid, wlo, whi, qf, nbuf, pn);
}
template <int XTRA, class SrcF, class FinF, class XtraF> __device__ __forceinline__ void kv_pipeline_dma2(LAS unsigned char* lds, int nt, int wave, int lane, const bf16x8 (&qf)[4], SrcF src, FinF fin, XtraF xtra) {
    const bf16_t *kb, *vb; size_t kp, vp;
    asm volatile("s_waitcnt vmcnt(0) lgkmcnt(0)" ::: "memory"); __builtin_amdgcn_s_barrier();
    if (nt <= 0) return;
#pragma unroll
    for (int i = 0; i < 3; ++i) if (i < nt) { src(i, kb, kp, vb, vp); dma_tile(lds + i * DBUF, kb, kp, vb, vp, wave, lane); xtra(i, i); }
    if (nt >= 3) { if (XTRA) asm volatile("s_waitcnt vmcnt(3)" ::: "memory"); else asm volatile("s_waitcnt vmcnt(2)" ::: "memory"); }
    else asm volatile("s_waitcnt vmcnt(0)" ::: "memory");
    __builtin_amdgcn_s_barrier();
    f32x16 pa[2], pb[2];
    scores_d(pa, qf, lds, lane);
#define KVD2_STEP(PC, PN) do { \
        if (t + 3 < nt) { src(t + 3, kb, kp, vb, vp); dma_tile(lds + ((t + 3) & 3) * DBUF, kb, kp, vb, vp, wave, lane); xtra(t + 3, (t + 3) & 3); } \
        const int bn_ = (t + 1 < nt) ? ((t + 1) & 3) : (t & 3); \
        fin(t, PC, lds + (t & 3) * DBUF, lds + bn_ * DBUF, PN, t & 3); \
        if (t + 3 < nt) { if (XTRA) asm volatile("s_waitcnt vmcnt(3) lgkmcnt(0)" ::: "memory"); else asm volatile("s_waitcnt vmcnt(2) lgkmcnt(0)" ::: "memory"); } \
        else asm volatile("s_waitcnt vmcnt(0) lgkmcnt(0)" ::: "memory"); \
        __builtin_amdgcn_s_barrier(); ++t; } while (0)
    int t = 0;
    while (t < nt) { KVD2_STEP(pa, pb); if (t >= nt) break; KVD2_STEP(pb, pa); }
#undef KVD2_STEP
}
__device__ __forceinline__ float gain_max64(const float* g) { float m = 0.f; for (int i = 0; i < 64; ++i) m = fmaxf(m, fabsf(g[i])); return m; }
__device__ __forceinline__ float softmax_shift(float gq, float gk) { const float B = 8.0f * LOG2E * gq * gk * 1.02f; return B > 60.f ? B - 60.f : 0.f; }

template <int MODE, bool HS, class MaskF> __device__ __forceinline__ void half_v(u32x4 (&pw)[4], float& l, const f32x16 (&p)[2], bool lane_ok, float shift, MaskF valid, unsigned wlo, unsigned whi) {
    const unsigned lmask = lane_ok ? 0xffffffffu : 0u; float ls = 0.f;
#pragma unroll
    for (int c = 0; c < 4; ++c) { const int kt = c >> 1, s2 = c & 1; float e[8];
#pragma unroll
        for (int j = 0; j < 8; ++j) { const int i = 8 * s2 + j; const int koff = 32 * kt + (i & 3) + 8 * (i >> 2); float x = __builtin_amdgcn_exp2f(HS ? p[kt][i] - shift : p[kt][i]);
            if (MODE == 1) x = valid(koff) ? x : 0.f;
            if (MODE == 2) { int tb; asm("v_bfe_i32 %0, %1, %2, 1" : "=v"(tb) : "v"(kt ? whi : wlo), "n"(koff & 31)); x = __builtin_bit_cast(float, __builtin_bit_cast(unsigned, x) & (unsigned)tb); }
            e[j] = x; ls += x; }
        pw[c].x = pk2(e[0], e[1]) & lmask; pw[c].y = pk2(e[2], e[3]) & lmask; pw[c].z = pk2(e[4], e[5]) & lmask; pw[c].w = pk2(e[6], e[7]) & lmask; }
    l += lane_ok ? ls : 0.f;
}
__device__ __forceinline__ void half_m(f32x16 (&o)[2], const u32x4 (&pw)[4], const LAS unsigned char* buf, const LAS unsigned char* nbuf, const bf16x8 (&qf)[4], f32x16 (&pn)[2], bool do_scores, int lane) {
    asm volatile("" : "+v"(lane));
    const int r = lane & 31, h = lane >> 5, blk = (lane >> 4) & 1, q4 = (lane & 15) >> 2, pp = lane & 3;
    const int ksw = (r >> 1) & 7;
    const unsigned kl = (unsigned)(size_t)(nbuf + r * 128);
    const unsigned kx0 = ((h ^ ksw) * 16), kx1 = (((2 + h) ^ ksw) * 16);
    const unsigned kA0 = kl + kx0, kA1 = kl + kx1, kB0 = kl + (kx0 ^ 64u), kB1 = kl + (kx1 ^ 64u);
    const int vsw = 4 * ((q4 >> 1) & 1);
    const unsigned vl = (unsigned)(size_t)(buf + 8192 + (4 * h + q4) * 128 + 8 * (pp & 1));
    const unsigned vb0 = vl + ((2 * blk + (pp >> 1)) ^ vsw) * 16, vb1 = vl + ((4 + 2 * blk + (pp >> 1)) ^ vsw) * 16;
    bf16x8 kf[8]; s16x4 vf[16];
    if (do_scores) {
        asm volatile("ds_read_b128 %0, %8\n\tds_read_b128 %1, %9\n\tds_read_b128 %2, %10\n\tds_read_b128 %3, %11\n\tds_read_b128 %4, %8 offset:4096\n\tds_read_b128 %5, %9 offset:4096\n\tds_read_b128 %6, %10 offset:4096\n\tds_read_b128 %7, %11 offset:4096"
                     : "=&v"(kf[0]), "=&v"(kf[1]), "=&v"(kf[2]), "=&v"(kf[3]), "=&v"(kf[4]), "=&v"(kf[5]), "=&v"(kf[6]), "=&v"(kf[7]) : "v"(kA0), "v"(kA1), "v"(kB0), "v"(kB1) : "memory");
    }
#define HM_V(c_) asm volatile("ds_read_b64_tr_b16 %0, %4 offset:%c6\n\tds_read_b64_tr_b16 %1, %4 offset:%c7\n\tds_read_b64_tr_b16 %2, %5 offset:%c6\n\tds_read_b64_tr_b16 %3, %5 offset:%c7" \
                     : "=&v"(vf[4 * (c_)]), "=&v"(vf[4 * (c_) + 1]), "=&v"(vf[4 * (c_) + 2]), "=&v"(vf[4 * (c_) + 3]) : "v"(vb0), "v"(vb1), "i"((32 * ((c_) >> 1) + 16 * ((c_) & 1)) * 128), "i"((32 * ((c_) >> 1) + 16 * ((c_) & 1)) * 128 + 1024) : "memory")
    asm volatile("s_waitcnt lgkmcnt(0)" ::: "memory"); __builtin_amdgcn_sched_barrier(0);
    HM_V(0); HM_V(1); HM_V(2); HM_V(3);
#undef HM_V
    if (do_scores) {
#pragma unroll
        for (int kt = 0; kt < 2; ++kt) { f32x16 z;
#pragma unroll
            for (int i = 0; i < 16; ++i) z[i] = 0.f;
            z = __builtin_amdgcn_mfma_f32_32x32x16_bf16(kf[4 * kt + 0], qf[0], z, 0, 0, 0);
            z = __builtin_amdgcn_mfma_f32_32x32x16_bf16(kf[4 * kt + 1], qf[1], z, 0, 0, 0);
            z = __builtin_amdgcn_mfma_f32_32x32x16_bf16(kf[4 * kt + 2], qf[2], z, 0, 0, 0);
            z = __builtin_amdgcn_mfma_f32_32x32x16_bf16(kf[4 * kt + 3], qf[3], z, 0, 0, 0);
            pn[kt] = z; }
    }
    asm volatile("s_waitcnt lgkmcnt(0)" ::: "memory"); __builtin_amdgcn_sched_barrier(0);
#pragma unroll
    for (int c = 0; c < 4; ++c) { const bf16x8 pb = __builtin_bit_cast(bf16x8, pw[c]);
        o[0] = __builtin_amdgcn_mfma_f32_32x32x16_bf16(__builtin_shufflevector(vf[4 * c], vf[4 * c + 1], 0, 1, 2, 3, 4, 5, 6, 7), pb, o[0], 0, 0, 0);
        o[1] = __builtin_amdgcn_mfma_f32_32x32x16_bf16(__builtin_shufflevector(vf[4 * c + 2], vf[4 * c + 3], 0, 1, 2, 3, 4, 5, 6, 7), pb, o[1], 0, 0, 0); }
}
template <int XTRA, class SrcF, class VF, class XtraF> __device__ __forceinline__ void kv_pipeline_ab(LAS unsigned char* lds, int nt, int wave, int lane, const bf16x8 (&qf)[4], f32x16 (&o)[2], SrcF src, VF vhalf, XtraF xtra) {
    const bf16_t *kb, *vb; size_t kp, vp;
    asm volatile("s_waitcnt vmcnt(0) lgkmcnt(0)" ::: "memory"); __builtin_amdgcn_s_barrier();
    if (nt <= 0) return;
#pragma unroll
    for (int i = 0; i < 3; ++i) if (i < nt) { src(i, kb, kp, vb, vp); dma_tile(lds + i * DBUF, kb, kp, vb, vp, wave, lane); xtra(i, i); }
    if (nt >= 3) { if (XTRA) asm volatile("s_waitcnt vmcnt(3)" ::: "memory"); else asm volatile("s_waitcnt vmcnt(2)" ::: "memory"); }
    else asm volatile("s_waitcnt vmcnt(0)" ::: "memory");
    __builtin_amdgcn_s_barrier();
    f32x16 pc[2]; scores_d(pc, qf, lds, lane);
    asm volatile("s_waitcnt lgkmcnt(0)" ::: "memory");
    const bool grpB = (wave & 4) != 0;
    if (grpB) __builtin_amdgcn_s_barrier();
    u32x4 pw[4];
    for (int t = 0; t < nt; ++t) {
        vhalf(t, pc, pw, t & 3);
        asm volatile("s_waitcnt lgkmcnt(0)" ::: "memory"); __builtin_amdgcn_s_barrier();
        if (t + 3 < nt) { src(t + 3, kb, kp, vb, vp); dma_tile(lds + ((t + 3) & 3) * DBUF, kb, kp, vb, vp, wave, lane); xtra(t + 3, (t + 3) & 3); }
        half_m(o, pw, lds + (t & 3) * DBUF, lds + ((t + 1) & 3) * DBUF, qf, pc, t + 1 < nt, lane);
        if (t + 3 < nt) { if (XTRA) asm volatile("s_waitcnt vmcnt(3) lgkmcnt(0)" ::: "memory"); else asm volatile("s_waitcnt vmcnt(2) lgkmcnt(0)" ::: "memory"); }
        else asm volatile("s_waitcnt vmcnt(0) lgkmcnt(0)" ::: "memory");
        __builtin_amdgcn_s_barrier();
    }
    if (!grpB) __builtin_amdgcn_s_barrier();
}
template <int HD> __device__ __forceinline__ void store_o(const f32x16 (&o)[HD / 32], float f, bf16_t* orow, int lane) {
    const int h = lane >> 5;
#pragma unroll
    for (int dh = 0; dh < HD / 32; ++dh)
#pragma unroll
        for (int g = 0; g < 4; ++g) { u32x2 w; w.x = pk2(o[dh][4 * g] * f, o[dh][4 * g + 1] * f); w.y = pk2(o[dh][4 * g + 2] * f, o[dh][4 * g + 3] * f);
            *(u32x2*)(orow + 32 * dh + 8 * g + 4 * h) = w; }
}

template <int HD> __device__ __forceinline__ void store_o_t(const f32x16 (&o)[HD / 32], float f, bf16_t* base, size_t ld, LAS unsigned char* scr, int lane) {
    constexpr int PITCH = HD * 2 + 16;
    asm volatile("" : "+v"(lane));
    const int r = lane & 31, h = lane >> 5;
#pragma unroll
    for (int dh = 0; dh < HD / 32; ++dh)
#pragma unroll
        for (int g = 0; g < 4; ++g) { u32x2 w; w.x = pk2(o[dh][4 * g] * f, o[dh][4 * g + 1] * f); w.y = pk2(o[dh][4 * g + 2] * f, o[dh][4 * g + 3] * f);
            *(LAS u32x2*)(scr + r * PITCH + (32 * dh + 8 * g + 4 * h) * 2) = w; }
    asm volatile("s_waitcnt lgkmcnt(0)" ::: "memory");
    constexpr int CPR = HD / 8;
#pragma unroll
    for (int i = 0; i < (32 * CPR) / 64; ++i) { const int idx = lane + 64 * i, row = idx / CPR, c = idx % CPR;
        const u32x4 v = *(const LAS u32x4*)(scr + row * PITCH + c * 16);
        *(u32x4*)(base + (size_t)row * ld + c * 8) = v; }
}
}


__device__ __forceinline__ float row_rstd(const float* rsq, int row) {
    const f32x4* pr = (const f32x4*)(rsq + (size_t)row * 16); const f32x4 a = pr[0], b = pr[1], c = pr[2], d = pr[3];
    const float ss = (((a[0] + a[1]) + (a[2] + a[3])) + ((b[0] + b[1]) + (b[2] + b[3]))) + (((c[0] + c[1]) + (c[2] + c[3])) + ((d[0] + d[1]) + (d[2] + d[3])));
    return __builtin_amdgcn_rsqf(ss * (1.0f / 1024.0f) + RMS_EPS);
}
__device__ __forceinline__ void unpack8(const u32x4 w, float (&f)[8]) {
#pragma unroll
    for (int j = 0; j < 4; ++j) { f[2 * j] = __builtin_bit_cast(float, w[j] << 16); f[2 * j + 1] = __builtin_bit_cast(float, w[j] & 0xffff0000u); } }
__device__ __forceinline__ u32x4 pack8f(const float (&f)[8]) { u32x4 o; o.x = pk2(f[0], f[1]); o.y = pk2(f[2], f[3]); o.z = pk2(f[4], f[5]); o.w = pk2(f[6], f[7]); return o; }
__device__ __forceinline__ void head_norm64(float (&f)[8], const float* gain, float extra, int lane) {
    float ss = 0.f;
#pragma unroll
    for (int j = 0; j < 8; ++j) ss += f[j] * f[j];
    ss += __shfl_xor(ss, 1); ss += __shfl_xor(ss, 2); ss += __shfl_xor(ss, 4);
    const float rn = __builtin_amdgcn_rsqf(ss * (1.0f / 64.0f) + RMS_EPS) * extra; const float* gn = gain + (lane & 7) * 8;
#pragma unroll
    for (int j = 0; j < 8; ++j) f[j] = f[j] * rn * gn[j];
}
__device__ __forceinline__ void head_rope64(float (&f)[8], const float* cs, int lane) {
    float oth[8];
#pragma unroll
    for (int j = 0; j < 8; ++j) oth[j] = __shfl_xor(f[j], 1);
    const int li = lane & 7;
    if (li < 2) {
#pragma unroll
        for (int j = 0; j < 8; ++j) { const float c = cs[j], sn = cs[8 + j]; f[j] = (li == 0) ? f[j] * c - oth[j] * sn : f[j] * c + oth[j] * sn; }
    }
}

__device__ __forceinline__ int wave_sum_i(int x) {
    x += __builtin_amdgcn_update_dpp(0, x, 0x111, 0xf, 0xf, true);
    x += __builtin_amdgcn_update_dpp(0, x, 0x112, 0xf, 0xf, true);
    x += __builtin_amdgcn_update_dpp(0, x, 0x114, 0xf, 0xf, true);
    x += __builtin_amdgcn_update_dpp(0, x, 0x118, 0xf, 0xf, true);
    x += __builtin_amdgcn_update_dpp(0, x, 0x142, 0xa, 0xf, true);
    x += __builtin_amdgcn_update_dpp(0, x, 0x143, 0xc, 0xf, true);
    return __builtin_amdgcn_readlane(x, 63);
}

__device__ __forceinline__ int cnt_ge(unsigned u, unsigned cand, int c) {
    int r; asm("v_cmp_ge_u32 vcc, %1, %2\n\tv_addc_co_u32 %0, vcc, 0, %3, vcc" : "=v"(r) : "v"(u), "v"(cand), "v"(c) : "vcc"); return r; }

__device__ __forceinline__ int cnt_ge16(const unsigned* u, unsigned cand, int c) {
    asm("v_cmp_ge_u32 vcc, %1, %17\n\tv_addc_co_u32 %0, vcc, 0, %0, vcc\n\tv_cmp_ge_u32 vcc, %2, %17\n\tv_addc_co_u32 %0, vcc, 0, %0, vcc\n\t"
        "v_cmp_ge_u32 vcc, %3, %17\n\tv_addc_co_u32 %0, vcc, 0, %0, vcc\n\tv_cmp_ge_u32 vcc, %4, %17\n\tv_addc_co_u32 %0, vcc, 0, %0, vcc\n\t"
        "v_cmp_ge_u32 vcc, %5, %17\n\tv_addc_co_u32 %0, vcc, 0, %0, vcc\n\tv_cmp_ge_u32 vcc, %6, %17\n\tv_addc_co_u32 %0, vcc, 0, %0, vcc\n\t"
        "v_cmp_ge_u32 vcc, %7, %17\n\tv_addc_co_u32 %0, vcc, 0, %0, vcc\n\tv_cmp_ge_u32 vcc, %8, %17\n\tv_addc_co_u32 %0, vcc, 0, %0, vcc\n\t"
        "v_cmp_ge_u32 vcc, %9, %17\n\tv_addc_co_u32 %0, vcc, 0, %0, vcc\n\tv_cmp_ge_u32 vcc, %10, %17\n\tv_addc_co_u32 %0, vcc, 0, %0, vcc\n\t"
        "v_cmp_ge_u32 vcc, %11, %17\n\tv_addc_co_u32 %0, vcc, 0, %0, vcc\n\tv_cmp_ge_u32 vcc, %12, %17\n\tv_addc_co_u32 %0, vcc, 0, %0, vcc\n\t"
        "v_cmp_ge_u32 vcc, %13, %17\n\tv_addc_co_u32 %0, vcc, 0, %0, vcc\n\tv_cmp_ge_u32 vcc, %14, %17\n\tv_addc_co_u32 %0, vcc, 0, %0, vcc\n\t"
        "v_cmp_ge_u32 vcc, %15, %17\n\tv_addc_co_u32 %0, vcc, 0, %0, vcc\n\tv_cmp_ge_u32 vcc, %16, %17\n\tv_addc_co_u32 %0, vcc, 0, %0, vcc"
        : "+v"(c) : "v"(u[0]), "v"(u[1]), "v"(u[2]), "v"(u[3]), "v"(u[4]), "v"(u[5]), "v"(u[6]), "v"(u[7]), "v"(u[8]), "v"(u[9]), "v"(u[10]), "v"(u[11]), "v"(u[12]), "v"(u[13]), "v"(u[14]), "v"(u[15]), "v"(cand) : "vcc");
    return c;
}
struct Args { const void* in[32]; float* out; unsigned char* ws; int ph_lo, ph_hi, li, pad; };

template <class CMap>
__device__ __forceinline__ void transpose_item(const float* W, int K, int N, bf16_t* WT, const float* gain, LAS float* scr, int kb, int nb, int lane, CMap cmap) {
    const int k0 = 64 * kb, n0 = 32 * nb, n4 = (lane & 7) * 4; const int c = cmap(n0 + n4);
    f32x4 v[8]; float gk[8];
#pragma unroll
    for (int i = 0; i < 8; ++i) { const int kk = (lane >> 3) + 8 * i; v[i] = (f32x4){0.f, 0.f, 0.f, 0.f}; gk[i] = 1.f;
        if (c >= 0) { v[i] = *(const f32x4*)(W + (size_t)(k0 + kk) * N + c); if (gain) gk[i] = gain[k0 + kk]; } }
#pragma unroll
    for (int i = 0; i < 8; ++i) { const int kk = (lane >> 3) + 8 * i; *(LAS f32x4*)(scr + kk * 36 + n4) = v[i] * gk[i]; }
    asm volatile("s_waitcnt lgkmcnt(0)" ::: "memory");
    const int ch = lane & 7;
#pragma unroll
    for (int j = 0; j < 4; ++j) { const int n = (lane >> 3) + 8 * j; const LAS float* s = scr + (8 * ch) * 36 + n;
        u32x4 o; o.x = pk2(s[0 * 36], s[1 * 36]); o.y = pk2(s[2 * 36], s[3 * 36]); o.z = pk2(s[4 * 36], s[5 * 36]); o.w = pk2(s[6 * 36], s[7 * 36]);
        *(u32x4*)(WT + (size_t)(n0 + n) * K + k0 + 8 * ch) = o; }
    asm volatile("s_waitcnt lgkmcnt(0)" ::: "memory");
}

struct CMapId { int n; __device__ __forceinline__ int operator()(int p) const { return p < n ? p : -1; } };
struct CMapProj0 { __device__ __forceinline__ int operator()(int p) const { const int o = p & 255, c = 64 * (4 * (p >> 8) + ((o >> 5) & 3)) + 8 * (2 * ((o >> 3) & 3) + (o >> 7)) + (o & 7);
    if (c < 936) return c; if (c < 960) return -1; return (c - 24 < AB_W) ? c - 24 : -1; } };
struct CMapProj1 { __device__ __forceinline__ int operator()(int p) const { const int o = p & 255, c = 64 * (4 * (p >> 8) + ((o >> 5) & 3)) + 8 * (2 * ((o >> 3) & 3) + (o >> 7)) + (o & 7); return c < C_W ? c : -1; } };
struct CMapFfn { __device__ __forceinline__ int operator()(int p) const { const int t = p >> 8, r = p & 255; return r < 128 ? t * 128 + r : DFF + t * 128 + (r - 128); } };

#ifndef PIPE_MEM
#define PIPE_MEM false
#endif
#ifndef PIPE_DSA
#define PIPE_DSA true
#endif
#ifndef PIPE_MOBA
#define PIPE_MOBA false
#endif
#ifndef PIPE_SEL
#define PIPE_SEL true
#endif
#ifndef PIPE_WIN
#define PIPE_WIN true
#endif
#ifndef LP_L0
#define LP_L0 true
#endif
#ifndef LP_NSA
#define LP_NSA false
#endif
#ifndef AB_L0
#define AB_L0 0
#endif
#ifndef PROBE_MASK
#define PROBE_MASK 0u
#endif
#define REPS(k) (((PROBE_MASK >> (k)) & 1u) ? 2 : 1)
#define RUN(k) (lo <= (k) && (k) < hi)
#define SEAM(k) do { if ((k) + 1 < hi) xcd_barrier(bar); } while (0)
#define INF_(k) ((const float*)args.in[k])
#define x_in INF_(0)
#define mem_in INF_(1)
#define positions ((const int*)args.in[2])
#define norm_mix INF_(3)
#define norm_mem INF_(4)
#define norm_mem_src INF_(5)
#define norm_ffn INF_(6)
#define ab_w_in INF_(7)
#define ab_w_out INF_(8)
#define nsa_w_in INF_(13)
#define nsa_w_out INF_(14)
#define mem_w_q INF_(25)
#define mem_w_kv INF_(26)
#define mem_w_o INF_(27)
#define ffn_w_in INF_(30)
#define ffn_w_out INF_(31)
#define out (args.out)
#define WSB(off) ((bf16_t*)(args.ws + (off)))
#define W_AB WSB(WS_WAB)
#define W_C WSB(WS_WC)
#define W_ABO WSB(WS_WABO)
#define W_CO WSB(WS_WCO)
#define W_MQ WSB(WS_WMQ)
#define W_KV WSB(WS_WKV)
#define W_MO WSB(WS_WMO)
#define W_FI WSB(WS_WFI)
#define W_FO WSB(WS_WFO)
#define XB WSB(WS_XB)
#define RSQ ((float*)(args.ws + WS_RSQ))
#define HID WSB(WS_R1)
#define MEMB WSB(WS_MEMB)
#define KVRAW WSB(WS_KVRAW)
#define MRS ((float*)(args.ws + WS_MRS))
#define MQB WSB(WS_MQ)
#define OMEM WSB(WS_OMEM)
#define mem_q_norm INF_(28)
#define RAW WSB(WS_R1)
#define OATT WSB(WS_OATT)
#define ROPE64 ((float*)(args.ws + WS_ROPE64))
#define ROPE32 ((float*)(args.ws + WS_ROPE32))
#define W1T WSB(WS_W1T)
#define POSW1 ((float*)(args.ws + WS_POSW1))
#define KCMP WSB(WS_KCMP)
#define VCMP WSB(WS_VCMP)
#define GT ((float*)(args.ws + WS_GT))
#define SCR ((float*)(args.ws + WS_SC))
#define BMK ((unsigned long long*)(args.ws + WS_BM))
#define KMEAN ((float*)(args.ws + WS_KM))
#define IWB ((float*)(args.ws + WS_ISG))
#define dsa_q_norm INF_(9)
#define dsa_k_norm INF_(10)
#define moba_q_norm INF_(11)
#define moba_k_norm INF_(12)
#define nsa_q_norm INF_(15)
#define nsa_kcmp_norm INF_(16)
#define nsa_ksel_norm INF_(17)
#define nsa_kwin_norm INF_(18)
#define nsa_cmp_pos_k INF_(19)
#define nsa_cmp_pos_v INF_(20)
#define nsa_cmp_w1_k INF_(21)
#define nsa_cmp_w2_k INF_(22)
#define nsa_cmp_w1_v INF_(23)
#define nsa_cmp_w2_v INF_(24)
#define mem_k_norm INF_(29)
template <int L> __device__ __forceinline__ void layer_phases(const Args& args, LAS unsigned char* lds, const XcdBarrier& bar, const int lo, const int hi, const int wave) {
    const int G = gridDim.x, bid = blockIdx.x;
    constexpr int pb = 1 + 10 * L;
        if (RUN(pb + 0)) for (int rep_ = 0; rep_ < REPS(pb + 0); ++rep_) {
            int lane = (int)__builtin_amdgcn_mbcnt_hi(~0u, __builtin_amdgcn_mbcnt_lo(~0u, 0u)); asm volatile("" : "+v"(lane)); const int tid = wave * 64 + lane;
            if (L == 0) {
                pg8::Gemm g{MEMB, W_KV, MMEM, 2048, DM}; pg8::StaticOrder S; S.init(MMEM, 2048, G, bid);
                pg8::EpiPlain E{KVRAW, 2048};
                pg8::gemm_phase<pg8::EpiPlain, pg8::StaticOrder, true, true>(lds, g, S, E, wave);
            }
            if (L == 0) {
                pg8::Gemm g{XB, W_AB, MTOK, AB_WP, DM}; pg8::StaticOrder S; S.init(MTOK, AB_WP, G, bid);
                pg8::EpiProj<0> E{RAW, AB_WP, RSQ, ROPE64, ROPE32, dsa_q_norm, dsa_k_norm, moba_q_norm, moba_k_norm, IWB};
                pg8::gemm_phase<pg8::EpiProj<0>, pg8::StaticOrder, true, true>(lds, g, S, E, wave);
            }
            if (L == 1) {
                pg8::Gemm g{XB, W_C, MTOK, C_WP, DM}; pg8::StaticOrder S; S.init(MTOK, C_WP, G, bid);
                pg8::EpiProj<1> E{RAW, C_WP, RSQ, ROPE64, ROPE32, nsa_q_norm, nsa_ksel_norm, nsa_kwin_norm, nullptr, GT};
                pg8::gemm_phase<pg8::EpiProj<1>, pg8::StaticOrder, true, true>(lds, g, S, E, wave);
            }
            SEAM(pb + 0);
        }
        if (RUN(pb + 1)) for (int rep_ = 0; rep_ < REPS(pb + 1); ++rep_) {
            int lane = (int)__builtin_amdgcn_mbcnt_hi(~0u, __builtin_amdgcn_mbcnt_lo(~0u, 0u)); asm volatile("" : "+v"(lane)); const int tid = wave * 64 + lane;
            if (L == 1) {
                LAS float* PART = (LAS float*)lds;
                LAS float* HB = (LAS float*)(lds + 65536);
                LAS float* W2S = (LAS float*)(lds + 65536 + 8448);
                for (int u = bid; u < BATCH * 4 * 2 * 8; u += G) {
                    const int ch = u & 7, kv = (u >> 3) & 1, g = (u >> 4) & 3, b = u >> 6;
                    const int r = lane & 31, h = lane >> 5, n0 = ch * 32;
                    const bf16_t* xb0 = RAW + (size_t)(b * SEQ + 16 * (n0 + r)) * C_WP + (kv ? 1280 : 1024) + g * 64 + 8 * h;
                    const bf16_t* wt = W1T + (size_t)kv * 64 * 2048 + 8 * h;
                    f32x16 acc[2];
#pragma unroll
                    for (int i = 0; i < 16; ++i) { acc[0][i] = 0.f; acc[1][i] = 0.f; }
                    const bool rowok = (n0 + r) < 255;
                    float rsl[4];
#pragma unroll
                    for (int li = 0; li < 4; ++li) rsl[li] = rowok ? row_rstd(RSQ, b * SEQ + 16 * (n0 + r) + wave * 4 + li) : 0.f;
#pragma unroll
                    for (int li = 0; li < 4; ++li) { const int l = wave * 4 + li;
#pragma unroll
                        for (int s2 = 0; s2 < 4; ++s2) {
                            bf16x8 a = {0, 0, 0, 0, 0, 0, 0, 0};
                            if (rowok) { float f[8]; unpack8(*(const u32x4*)(xb0 + (size_t)l * C_WP + 16 * s2), f);
#pragma unroll
                                for (int j = 0; j < 8; ++j) f[j] *= rsl[li];
                                a = __builtin_bit_cast(bf16x8, pack8f(f)); }
                            const bf16x8 b0 = *(const bf16x8*)(wt + (size_t)r * 2048 + l * 64 + 16 * s2), b1 = *(const bf16x8*)(wt + (size_t)(32 + r) * 2048 + l * 64 + 16 * s2);
                            acc[0] = __builtin_amdgcn_mfma_f32_32x32x16_bf16(a, b0, acc[0], 0, 0, 0); acc[1] = __builtin_amdgcn_mfma_f32_32x32x16_bf16(a, b1, acc[1], 0, 0, 0); } }
                    __syncthreads();
#pragma unroll
                    for (int nh = 0; nh < 2; ++nh)
#pragma unroll
                        for (int i = 0; i < 16; ++i) PART[wave * 2048 + ((i & 3) + 8 * (i >> 2) + 4 * h) * 64 + nh * 32 + r] = acc[nh][i];
                    { const float* w2 = kv ? nsa_cmp_w2_v : nsa_cmp_w2_k; const f32x4 wa = *(const f32x4*)(w2 + tid * 4), wb = *(const f32x4*)(w2 + 2048 + tid * 4);
                      *(LAS f32x4*)(W2S + tid * 4) = wa; *(LAS f32x4*)(W2S + 2048 + tid * 4) = wb; }
                    __syncthreads();
                    const float pw1 = POSW1[kv * 64 + (tid & 63)];
                    for (int i = tid; i < 2048; i += 512) { float a = pw1;
#pragma unroll
                        for (int w = 0; w < 8; ++w) a += PART[w * 2048 + i];
                        HB[(i >> 6) * 65 + (i & 63)] = a / (1.0f + __expf(-a)); }
                    __syncthreads();
                    { const int n = tid >> 4, c4 = (tid & 15) * 4; float o[4] = {0.f, 0.f, 0.f, 0.f};
                        for (int c = 0; c < 64; ++c) { const float hv = HB[n * 65 + c]; const f32x4 w = *(const LAS f32x4*)(W2S + c * 64 + c4); o[0] += hv * w[0]; o[1] += hv * w[1]; o[2] += hv * w[2]; o[3] += hv * w[3]; }
                        if (kv == 0) { float ss = (o[0] * o[0] + o[1] * o[1]) + (o[2] * o[2] + o[3] * o[3]);
                            ss += __shfl_xor(ss, 1); ss += __shfl_xor(ss, 2); ss += __shfl_xor(ss, 4); ss += __shfl_xor(ss, 8);
                            const float rn = __builtin_amdgcn_rsqf(ss * (1.0f / 64.0f) + RMS_EPS);
#pragma unroll
                            for (int j = 0; j < 4; ++j) o[j] = o[j] * rn * nsa_kcmp_norm[c4 + j]; }
                        if (n0 + n >= 255) { o[0] = o[1] = o[2] = o[3] = 0.f; }
                        u32x2 w; w.x = pk2(o[0], o[1]); w.y = pk2(o[2], o[3]);
                        *(u32x2*)((kv ? VCMP : KCMP) + ((size_t)(b * 4 + g) * 256 + n0 + n) * 64 + c4) = w; }
                    __syncthreads();
                }
            }
            if (L == 1) SEAM(pb + 1);
        }
        if (RUN(pb + 2)) for (int rep_ = 0; rep_ < REPS(pb + 2); ++rep_) {
            int lane = (int)__builtin_amdgcn_mbcnt_hi(~0u, __builtin_amdgcn_mbcnt_lo(~0u, 0u)); asm volatile("" : "+v"(lane)); const int tid = wave * 64 + lane;
            if (L == 0 && rep_ == 0) {
                const int gw = bid * NWAVES + wave, NGW = G * NWAVES;
                for (int m = gw; m < MMEM; m += NGW) {
                    const float rs = MRS[m]; bf16_t* row = KVRAW + (size_t)m * 2048;
#pragma unroll
                    for (int st = 0; st < 4; ++st) {
                        u32x4 w = *(const u32x4*)(row + st * 512 + lane * 8); float f[8];
#pragma unroll
                        for (int j = 0; j < 4; ++j) { f[2 * j] = __builtin_bit_cast(float, w[j] << 16) * rs; f[2 * j + 1] = __builtin_bit_cast(float, w[j] & 0xffff0000u) * rs; }
                        if ((st & 1) == 0) {
                            float ss = 0.f;
#pragma unroll
                            for (int j = 0; j < 8; ++j) ss += f[j] * f[j];
                            ss += __shfl_xor(ss, 1); ss += __shfl_xor(ss, 2); ss += __shfl_xor(ss, 4); ss += __shfl_xor(ss, 8);
                            const float rn = __builtin_amdgcn_rsqf(ss * (1.0f / 128.0f) + RMS_EPS);
                            const float* gn = mem_k_norm + (st >> 1) * 128 + (lane & 15) * 8;
#pragma unroll
                            for (int j = 0; j < 8; ++j) f[j] = f[j] * rn * gn[j];
                        }
                        u32x4 o; o.x = pk2(f[0], f[1]); o.y = pk2(f[2], f[3]); o.z = pk2(f[4], f[5]); o.w = pk2(f[6], f[7]);
                        *(u32x4*)(row + st * 512 + lane * 8) = o;
                    }
                }
            }
            if (L == 0) {
                { const int gw = bid * NWAVES + wave, NGW = G * NWAVES;
                  for (int u = gw; u < BATCH * 8 * 16; u += NGW) { const int n = u & 15, hm = (u >> 4) & 7, b = u >> 7;
                      const bf16_t* kb = RAW + (size_t)(b * SEQ + 256 * n + (lane >> 3)) * AB_WP + 1472 + hm * 64 + (lane & 7) * 8; float a[8] = {0.f, 0.f, 0.f, 0.f, 0.f, 0.f, 0.f, 0.f};
                      for (int i0 = 0; i0 < 32; i0 += 8) { u32x4 rw[8];
#pragma unroll
                          for (int i = 0; i < 8; ++i) rw[i] = *(const u32x4*)(kb + (size_t)(8 * (i0 + i)) * AB_WP);
#pragma unroll
                          for (int i = 0; i < 8; ++i) { float f[8]; unpack8(rw[i], f);
#pragma unroll
                              for (int j = 0; j < 8; ++j) a[j] += f[j]; } }
#pragma unroll
                      for (int j = 0; j < 8; ++j) { a[j] += __shfl_xor(a[j], 8); a[j] += __shfl_xor(a[j], 16); a[j] += __shfl_xor(a[j], 32); }
                      if (lane < 8) { float* o = KMEAN + (size_t)u * 64 + lane * 8;
#pragma unroll
                          for (int j = 0; j < 8; ++j) o[j] = a[j] * (1.0f / 256.0f); } } }
                LAS float* SCL = (LAS float*)lds;
#if defined(PROBE_IDX) && PROBE_IDX == 2
                if (rep_ == 0)
#endif
                for (int ui = bid; ui < BATCH * 256; ui += G) {
                    const int rr = ui >> 8, pos = ui & 255; const int qi = 32 * rr + ((rr & 1) ? 31 - (pos >> 3) : (pos >> 3)), b = pos & 7;
                    const int t0 = qi * 16, tmax = t0 + 15, nchunk = (tmax >> 10) + 1, nreg = (tmax >> 6) + 1;
                    const int ql = lane & 15, kq = lane >> 4;
                    const size_t qrow = (size_t)b * SEQ + t0 + ql;
                    typedef float f32x4v __attribute__((ext_vector_type(4)));
                    bf16x8 qf[8];
#pragma unroll
                    for (int hi = 0; hi < 8; ++hi) qf[hi] = *(const bf16x8*)(RAW + qrow * AB_WP + 640 + hi * 32 + 8 * kq);
                    const f32x4 iw0 = *(const f32x4*)(IWB + qrow * 8), iw1 = *(const f32x4*)(IWB + qrow * 8 + 4);
                    unsigned uu[2][64];
#pragma unroll
                    for (int rg = 0; rg < 64; ++rg) { uu[0][rg] = 0u; uu[1][rg] = 0u; }
#pragma unroll
                    for (int c = 0; c < 4; ++c) if (c < nchunk) {
                        const int ntile = ((tmax - 1024 * c) >> 4) + 1 < 64 ? ((tmax - 1024 * c) >> 4) + 1 : 64;
                        __syncthreads();
                        const bf16_t* kfp = RAW + (size_t)(b * SEQ + 1024 * c + ql) * AB_WP + 896 + 8 * kq;
                        bf16x8 kfn = *(const bf16x8*)(kfp + (size_t)(16 * (wave < ntile ? wave : 0)) * AB_WP);
                        for (int tile = wave; tile < ntile; tile += 8) {
                            const bf16x8 kf = kfn; { const int tn = tile + 8 < ntile ? tile + 8 : tile; kfn = *(const bf16x8*)(kfp + (size_t)(16 * tn) * AB_WP); }
                            f32x4v sc = {0.f, 0.f, 0.f, 0.f};
#pragma unroll
                            for (int hi = 0; hi < 8; ++hi) { f32x4v x = {0.f, 0.f, 0.f, 0.f}; x = __builtin_amdgcn_mfma_f32_16x16x32_bf16(kf, qf[hi], x, 0, 0, 0);
                                const float sf = hi < 4 ? iw0[hi & 3] : iw1[hi & 3];
#pragma unroll
                                for (int i = 0; i < 4; ++i) sc[i] += sf * fmaxf(x[i], 0.f); }
                            *(LAS f32x4v*)(SCL + ql * 1028 + 16 * tile + 4 * kq) = sc;
                        }
                        __syncthreads();
#pragma unroll
                        for (int qq = 0; qq < 2; ++qq) { const int t = t0 + 2 * wave + qq;
#pragma unroll
                            for (int rl = 0; rl < 16; ++rl) { const int key = 1024 * c + 64 * rl + lane; const unsigned bits = __builtin_bit_cast(unsigned, SCL[(2 * wave + qq) * 1028 + 64 * rl + lane]);
                                const unsigned mono = bits ^ ((bits >> 31) ? 0xffffffffu : 0x80000000u); uu[qq][16 * c + rl] = (key <= t) ? mono : 0u; } }
                    }
#if defined(PROBE_IDX) && PROBE_IDX == 1
                    if (rep_) { if (uu[0][3] == 12345u && uu[1][40] == 777u) BMK[0] = 1ull; continue; }
#endif
                    int lb = lane; asm volatile("" : "+v"(lb));
                    unsigned long long word[2] = {0ull, 0ull};
                    unsigned T[2] = {0u, 0u}; bool done[2], exact[2] = {false, false};
                    done[0] = (t0 + 2 * wave) < 256; done[1] = (t0 + 2 * wave + 1) < 256;
                    for (int bit = 31; bit >= 0 && !(done[0] && done[1]); --bit) {
                        const unsigned c0 = T[0] | (1u << bit), c1 = T[1] | (1u << bit); int n0 = 0, n1 = 0;
#pragma unroll
                        for (int ch = 0; ch < 4; ++ch) if (16 * ch < nreg) {
#pragma unroll
                            for (int dummy_ = 0; dummy_ < 1; ++dummy_) { n0 = cnt_ge16(&uu[0][16 * ch], c0, n0); n1 = cnt_ge16(&uu[1][16 * ch], c1, n1); } }
                        const int s0 = wave_sum_i(n0), s1 = wave_sum_i(n1);
                        if (!done[0]) { if (s0 >= 256) T[0] = c0; if (s0 == 256) { done[0] = true; exact[0] = true; } }
                        if (!done[1]) { if (s1 >= 256) T[1] = c1; if (s1 == 256) { done[1] = true; exact[1] = true; } }
                    }
#pragma unroll
                    for (int qq = 0; qq < 2; ++qq) { const int t = t0 + 2 * wave + qq; unsigned long long myword = 0ull;
                        if (t < 256) {
#pragma unroll
                            for (int rg = 0; rg < 4; ++rg) { const unsigned long long w = __ballot(64 * rg + lb <= t); if (lb == rg) myword = w; }
                        } else if (exact[qq]) {
#pragma unroll
                            for (int rg = 0; rg < 64; ++rg) { const unsigned long long w = __ballot(uu[qq][rg] >= T[qq]); if (lb == rg) myword = w; __builtin_amdgcn_sched_barrier(0); }
                        } else {
                            int cg = 0;
#pragma unroll
                            for (int rg = 0; rg < 64; ++rg) cg = cnt_ge(uu[qq][rg], T[qq] + 1u, cg);
                            int need = 256 - wave_sum_i(cg);
#pragma unroll
                            for (int rg = 0; rg < 64; ++rg) {
                                unsigned long long w = __ballot(uu[qq][rg] > T[qq]), eq = __ballot(uu[qq][rg] == T[qq]); const int ne = __builtin_popcountll(eq);
                                if (ne <= need) { w |= eq; need -= ne; } else { while (need > 0) { const unsigned long long low = eq & (0ull - eq); w |= low; eq ^= low; --need; } }
                                if (lb == rg) myword = w; __builtin_amdgcn_sched_barrier(0); }
                        }
                        BMK[((size_t)(b * 128 + (t >> 5)) * 64 + lb) * 32 + (t & 31)] = myword;
                    }
                }
            }
            if (L == 0) SEAM(pb + 2);
        }
        if (RUN(pb + 3)) for (int rep_ = 0; rep_ < REPS(pb + 3); ++rep_) {
            int lane = (int)__builtin_amdgcn_mbcnt_hi(~0u, __builtin_amdgcn_mbcnt_lo(~0u, 0u)); asm volatile("" : "+v"(lane)); const int tid = wave * 64 + lane;
            if (L == 0) {
                const float shiftA = att::softmax_shift(att::gain_max64(dsa_q_norm), att::gain_max64(dsa_k_norm)), shiftB = att::softmax_shift(att::gain_max64(moba_q_norm), att::gain_max64(moba_k_norm));
                for (int ui = bid; ui < BATCH * 128; ui += G) {
                    const int rr = ui >> 8, pos = ui & 255; const int qt = 32 * rr + ((rr & 1) ? 31 - (pos >> 3) : (pos >> 3)), b = pos & 7;
                    const int r = lane & 31, h = lane >> 5; const size_t row = (size_t)b * SEQ + qt * 32 + r;
                    bf16x8 qf[4];
                    { const bf16_t* qrow = RAW + row * AB_WP + wave * 64 + 8 * h;
#pragma unroll
                      for (int s2 = 0; s2 < 4; ++s2) qf[s2] = *(const bf16x8*)(qrow + 16 * s2); }
                    f32x16 oo[2]; float ll = 0.f;
#pragma unroll
                    for (int i = 0; i < 16; ++i) { oo[0][i] = 0.f; oo[1][i] = 0.f; }
                    const bf16_t* kbase = RAW + (size_t)b * SEQ * AB_WP + 512; const unsigned long long* bm = BMK + (size_t)(b * 128 + qt) * 64 * 32;
                    LAS unsigned char* MSL = lds + 4 * att::DBUF;
{ auto go_ = [&](auto hs_) { constexpr bool HS = decltype(hs_)::value;
#if AB_L0
                    att::kv_pipeline_ab<1>(lds, (qt >> 1) + 1, wave, lane, qf, oo,
                        [&](int tt, const bf16_t*& kb, size_t& kp, const bf16_t*& vb, size_t& vp) { kb = kbase + (size_t)(64 * tt) * AB_WP; kp = AB_WP; vb = kb + 64; vp = AB_WP; },
                        [&](int tt, const f32x16 (&p)[2], u32x4 (&pw)[4], int slot) {
                            const unsigned long long w = *(const LAS unsigned long long*)(MSL + (slot * 8 + wave) * 256 + r * 8) >> (4 * h);
                            att::half_v<2, HS>(pw, ll, p, true, shiftA, [](int) { return true; }, (unsigned)w, (unsigned)(w >> 32)); },
                        [&](int tt, int slot) { __builtin_amdgcn_global_load_lds((const unsigned*)(bm + (size_t)tt * 32) + lane, (LAS unsigned*)(MSL + (slot * 8 + wave) * 256), 4, 0, 0); });
#else
                    att::kv_pipeline_dma2<1>(lds, (qt >> 1) + 1, wave, lane, qf,
                        [&](int tt, const bf16_t*& kb, size_t& kp, const bf16_t*& vb, size_t& vp) { kb = kbase + (size_t)(64 * tt) * AB_WP; kp = AB_WP; vb = kb + 64; vp = AB_WP; },
                        [&](int tt, f32x16 (&p)[2], const LAS unsigned char* buf, const LAS unsigned char* nbuf, f32x16 (&pn)[2], int slot) {
                            const unsigned long long w = *(const LAS unsigned long long*)(MSL + (slot * 8 + wave) * 256 + r * 8) >> (4 * h);
#if defined(PROBE_SKEL) && PROBE_SKEL == 2
                            if (rep_ == 0)
#endif
                            att::fused_e<2, HS, LP_L0>(oo, ll, p, buf, lane, true, shiftA, [](int) { return true; }, (unsigned)w, (unsigned)(w >> 32), qf, nbuf, pn); },
                        [&](int tt, int slot) { __builtin_amdgcn_global_load_lds((const unsigned*)(bm + (size_t)tt * 32) + lane, (LAS unsigned*)(MSL + (slot * 8 + wave) * 256), 4, 0, 0); });
#endif
 }; if (shiftA == 0.f) go_(std::false_type{}); else go_(std::true_type{}); }
                    const float lt = ll + __shfl_xor(ll, 32);
#if defined(PROBE_SKEL) && PROBE_SKEL == 2
                    if (rep_ == 0)
#endif
                    att::store_o_t<64>(oo, lt > 0.f ? 1.0f / lt : 0.f, OATT + ((size_t)b * SEQ + qt * 32) * 1024 + wave * 64, 1024, lds + wave * 4608, lane);
                }
                LAS unsigned* UNI = (LAS unsigned*)(lds + 4 * att::DBUF); LAS int* TL = (LAS int*)(lds + 4 * att::DBUF + 16); LAS float* KMS = (LAS float*)(lds + 4 * att::DBUF + 256);
#if defined(PROBE_SKEL)
                if (rep_ == 0)
#endif
                for (int ui = bid; ui < BATCH * 8 * 16; ui += G) {
                    const int rr = ui >> 8, pos = ui & 255; const int xk = pos >> 3, cmb = rr * 16 + (pos & 7) * 2 + (xk >> 4);
                    const int own = (rr & 1) ? 15 - (xk & 15) : (xk & 15), b = cmb >> 3, hm = cmb & 7;
                    const int r = lane & 31, h = lane >> 5; const int tl = wave * 32 + r; const size_t row = (size_t)b * SEQ + own * 256 + tl;
                    bf16x8 qf[4];
                    { const bf16_t* qrow = RAW + row * AB_WP + 960 + hm * 64 + 8 * h;
#pragma unroll
                      for (int s2 = 0; s2 < 4; ++s2) qf[s2] = *(const bf16x8*)(qrow + 16 * s2); }
                    if (tid == 0) UNI[0] = 0u;
                    { const f32x2 kmv = *(const f32x2*)(KMEAN + (size_t)(b * 8 + hm) * 1024 + tid * 2); *(LAS f32x2*)(KMS + tid * 2) = kmv; }
                    __syncthreads();
                    unsigned msk = 0u;
                    { float b0 = att::NEG_INF, b1 = att::NEG_INF, b2 = att::NEG_INF; int i0 = -1, i1 = -1, i2 = -1;
                      float qv[32];
#pragma unroll
                      for (int s2 = 0; s2 < 4; ++s2) { float f[8]; unpack8(__builtin_bit_cast(u32x4, qf[s2]), f);
#pragma unroll
                          for (int j = 0; j < 8; ++j) qv[8 * s2 + j] = f[j]; }
                      for (int n = 0; n < own; ++n) { const LAS float* km = KMS + n * 64 + 8 * h; float a = 0.f;
#pragma unroll
                          for (int s2 = 0; s2 < 4; ++s2) { const f32x4 k0 = *(const LAS f32x4*)(km + 16 * s2), k1 = *(const LAS f32x4*)(km + 16 * s2 + 4);
                              a += qv[8 * s2] * k0[0] + qv[8 * s2 + 1] * k0[1] + qv[8 * s2 + 2] * k0[2] + qv[8 * s2 + 3] * k0[3] + qv[8 * s2 + 4] * k1[0] + qv[8 * s2 + 5] * k1[1] + qv[8 * s2 + 6] * k1[2] + qv[8 * s2 + 7] * k1[3]; }
                          a += __shfl_xor(a, 32);
                          if (a > b0) { b2 = b1; i2 = i1; b1 = b0; i1 = i0; b0 = a; i0 = n; } else if (a > b1) { b2 = b1; i2 = i1; b1 = a; i1 = n; } else if (a > b2) { b2 = a; i2 = n; } }
                      if (i0 >= 0) msk |= 1u << i0; if (i1 >= 0) msk |= 1u << i1; if (i2 >= 0) msk |= 1u << i2; }
                    { unsigned um = msk;
#pragma unroll
                      for (int o = 1; o < 64; o <<= 1) um |= __shfl_xor(um, o);
                      if (lane == 0) __hip_atomic_fetch_or(UNI, um, __ATOMIC_RELAXED, __HIP_MEMORY_SCOPE_WORKGROUP); }
                    __syncthreads();
                    const unsigned U = (unsigned)__builtin_amdgcn_readfirstlane((int)UNI[0]);
                    const int npast = __builtin_popcount(U);
                    if (wave == 0 && lane < 16 && ((U >> lane) & 1u)) TL[__builtin_amdgcn_mbcnt_lo(U, 0u)] = lane;
                    f32x16 oo[2]; float ll = 0.f;
#pragma unroll
                    for (int i = 0; i < 16; ++i) { oo[0][i] = 0.f; oo[1][i] = 0.f; }
                    const bf16_t* kbase = RAW + (size_t)b * SEQ * AB_WP + 1472 + hm * 64;
                    __syncthreads();
{ auto go_ = [&](auto hs_) { constexpr bool HS = decltype(hs_)::value;
#if AB_L0
                    att::kv_pipeline_ab<0>(lds, 4 * npast + 4, wave, lane, qf, oo,
                        [&](int tt, const bf16_t*& kb, size_t& kp, const bf16_t*& vb, size_t& vp) {
                            const int blk = (tt < 4 * npast) ? __builtin_amdgcn_readfirstlane(TL[tt >> 2]) : own, sub = (tt < 4 * npast) ? (tt & 3) : tt - 4 * npast;
                            kb = kbase + (size_t)(256 * blk + 64 * sub) * AB_WP; kp = AB_WP; vb = kb + 512; vp = AB_WP; },
                        [&](int tt, const f32x16 (&p)[2], u32x4 (&pw)[4], int) {
                            if (tt < 4 * npast) { const int blk = __builtin_amdgcn_readfirstlane(TL[tt >> 2]); const bool sel = (msk >> blk) & 1u;
                                att::half_v<0, HS>(pw, ll, p, sel, shiftB, [](int) { return true; }, 0u, 0u); }
                            else { const int sub = tt - 4 * npast; const int lim = tl - 64 * sub - 4 * h;
                                att::half_v<1, HS>(pw, ll, p, true, shiftB, [&](int koff) { return koff <= lim; }, 0u, 0u); } },
                        att::NoXtra());
#else
                    att::kv_pipeline_dma2<0>(lds, 4 * npast + 4, wave, lane, qf,
                        [&](int tt, const bf16_t*& kb, size_t& kp, const bf16_t*& vb, size_t& vp) {
                            const int blk = (tt < 4 * npast) ? __builtin_amdgcn_readfirstlane(TL[tt >> 2]) : own, sub = (tt < 4 * npast) ? (tt & 3) : tt - 4 * npast;
                            kb = kbase + (size_t)(256 * blk + 64 * sub) * AB_WP; kp = AB_WP; vb = kb + 512; vp = AB_WP; },
                        [&](int tt, f32x16 (&p)[2], const LAS unsigned char* buf, const LAS unsigned char* nbuf, f32x16 (&pn)[2], int) {
                            if (tt < 4 * npast) { const int blk = __builtin_amdgcn_readfirstlane(TL[tt >> 2]); const bool sel = (msk >> blk) & 1u;
                                att::fused_e<0, HS, LP_L0>(oo, ll, p, buf, lane, sel, shiftB, [](int) { return true; }, 0u, 0u, qf, nbuf, pn); }
                            else { const int sub = tt - 4 * npast; const int lim = tl - 64 * sub - 4 * h;
                                att::fused_e<1, HS, LP_L0>(oo, ll, p, buf, lane, true, shiftB, [&](int koff) { return koff <= lim; }, 0u, 0u, qf, nbuf, pn); } },
                        att::NoXtra());
#endif
 }; if (shiftB == 0.f) go_(std::false_type{}); else go_(std::true_type{}); }
                    const float lt = ll + __shfl_xor(ll, 32);
                    att::store_o_t<64>(oo, lt > 0.f ? 1.0f / lt : 0.f, OATT + ((size_t)b * SEQ + own * 256 + wave * 32) * 1024 + 512 + hm * 64, 1024, lds + wave * 4608, lane);
                    __syncthreads();
                }
            }
            if (L == 1) {
                const float shiftS = att::softmax_shift(att::gain_max64(nsa_q_norm), att::gain_max64(nsa_ksel_norm)), shiftW = att::softmax_shift(att::gain_max64(nsa_q_norm), att::gain_max64(nsa_kwin_norm));
                LAS unsigned* IMP = (LAS unsigned*)(lds + 86016);
                LAS unsigned long long* SELM = (LAS unsigned long long*)(lds + 4 * att::DBUF); LAS int* TL = (LAS int*)(lds + 4 * att::DBUF + 528);
                for (int ui = bid; ui < BATCH * 4 * 64; ui += G) {
                    const int rr = ui >> 8, pos = ui & 255;
                    const int pr = (pos & 7) * 4 + (rr >> 1), xk = pos >> 3, qt = (rr & 1) ? 63 - xk : xk, b = pr >> 2, g = pr & 3;
                    const int r = lane & 31, h = lane >> 5, j = wave & 3, qs = wave >> 2, hd = g * 4 + j;
                    const int t = qt * 64 + qs * 32 + r, ql = qs * 32 + r; const size_t row = (size_t)b * SEQ + t;
                    bf16x8 qf[4];
                    { const bf16_t* qrow = RAW + row * C_WP + hd * 64 + 8 * h;
#pragma unroll
                      for (int s2 = 0; s2 < 4; ++s2) qf[s2] = *(const bf16x8*)(qrow + 16 * s2); }
                    for (int i = tid; i < ((qt >> 4) + 1) * 64 * 64 / 4; i += 512) ((LAS u32x4*)IMP)[i] = (u32x4){0u, 0u, 0u, 0u};
                    f32x16 oacc[2];
                    const float* gt = GT + row * 48 + hd * 3; const float g0 = gt[0];
                    const int nvalid = t >= 31 ? ((t - 31) >> 4) + 1 : 0;
                    const int ntc = (qt >> 4) + 1;
                    { const bf16_t* kcb = KCMP + (size_t)(b * 4 + g) * 256 * 64; const bf16_t* vcb = VCMP + (size_t)(b * 4 + g) * 256 * 64;
                      for (int idx = tid; idx < 64 * 8 * ntc; idx += 512) { const int rw = idx >> 3, c = idx & 7;
                          *(LAS u32x4*)(lds + rw * 144 + c * 16) = *(const u32x4*)(kcb + rw * 64 + c * 8);
                          *(LAS u32x4*)(lds + 36864 + rw * 192 + c * 16) = *(const u32x4*)(vcb + rw * 64 + c * 8); } }
                    __syncthreads();
                    float mc = att::NEG_INF, lc = 0.f;
#pragma unroll 1
                    for (int tt = 0; tt < ntc; ++tt) {
                        f32x16 p[2]; att::tile_scores<64>(p, qf, lds + tt * 9216, lane); const int lim = nvalid - 64 * tt - 4 * h; float mx = att::NEG_INF;
#pragma unroll
                        for (int kt = 0; kt < 2; ++kt)
#pragma unroll
                            for (int i = 0; i < 16; ++i) { const int koff = 32 * kt + (i & 3) + 8 * (i >> 2); const float v = (koff < lim) ? p[kt][i] : att::NEG_INF; p[kt][i] = v; mx = fmaxf(mx, v); }
                        mx = fmaxf(mx, __shfl_xor(mx, 32));
                        const float mnew = fmaxf(mc, mx), muse = (mnew == att::NEG_INF) ? 0.f : mnew; float ls = 0.f;
#pragma unroll
                        for (int kt = 0; kt < 2; ++kt)
#pragma unroll
                            for (int i = 0; i < 16; ++i) ls += __builtin_amdgcn_exp2f(p[kt][i] - muse);
                        lc = lc * __builtin_amdgcn_exp2f(mc - muse) + ls; mc = mnew; }
                    lc += __shfl_xor(lc, 32);
                    const float invl = lc > 0.f ? 1.0f / lc : 0.f, mcu = (mc == att::NEG_INF) ? 0.f : mc;
#pragma unroll
                    for (int i = 0; i < 16; ++i) { oacc[0][i] = 0.f; oacc[1][i] = 0.f; }
#pragma unroll 1
                    for (int tt = 0; tt < ntc; ++tt) {
                        f32x16 p[2]; att::tile_scores<64>(p, qf, lds + tt * 9216, lane); const int lim = nvalid - 64 * tt - 4 * h;
#pragma unroll
                        for (int kt = 0; kt < 2; ++kt)
#pragma unroll
                            for (int i = 0; i < 16; ++i) { const int koff = 32 * kt + (i & 3) + 8 * (i >> 2); const float pv = (koff < lim) ? __builtin_amdgcn_exp2f(p[kt][i] - mcu) * invl : 0.f; p[kt][i] = pv;
                                __hip_atomic_fetch_add(IMP + (64 * tt + koff + 4 * h) * 64 + ql, (unsigned)(pv * 134217728.0f + 0.5f), __ATOMIC_RELAXED, __HIP_MEMORY_SCOPE_WORKGROUP);
                                if ((i & 3) == 3) __builtin_amdgcn_sched_barrier(0); }
                        __builtin_amdgcn_sched_barrier(0);
                        att::tile_pv<64>(oacc, p, lds + 36864 + tt * 12288 - 9216, lane); }
#pragma unroll
                    for (int i = 0; i < 16; ++i) { oacc[0][i] *= g0; oacc[1][i] *= g0; }
                    LAS float* STASH = (LAS float*)IMP + wave * 2048 + lane;
                    __syncthreads();
                    {
                        int l2 = lane; asm volatile("" : "+v"(l2));
                        const int qq = l2 >> 3, seg = l2 & 7, q = wave * 8 + qq, cur = qt;
                        unsigned key[8];
#pragma unroll
                        for (int k = 0; k < 8; ++k) { const int sb = 8 * seg + k; unsigned v = 0u;
#pragma unroll
                            for (int dn = -1; dn <= 3; ++dn) { const int n = 4 * sb + dn; if (n >= 0 && n < 255) v += IMP[n * 64 + q]; }
                            const bool forced = (sb == 0) || (sb == cur) || (sb == cur - 1);
                            key[k] = (sb <= cur) ? ((forced ? 0xffffff80u : ((v >> 7) << 7)) | (unsigned)(64 - sb)) : 0u; __builtin_amdgcn_sched_barrier(0); }
                        unsigned T = 0u;
                        for (int bit = 31; bit >= 0; --bit) { const unsigned cand = T | (1u << bit); int c = 0;
#pragma unroll
                            for (int k = 0; k < 8; ++k) c += (key[k] >= cand) ? 1 : 0;
                            c += __builtin_amdgcn_update_dpp(0, c, 0xB1, 0xf, 0xf, false);
                            c += __builtin_amdgcn_update_dpp(0, c, 0x4E, 0xf, 0xf, false);
                            c += __builtin_amdgcn_update_dpp(0, c, 0x141, 0xf, 0xf, false);
                            if (c >= 16) T = cand; }
                        unsigned byte = 0u;
#pragma unroll
                        for (int k = 0; k < 8; ++k) byte |= (key[k] != 0u && key[k] >= T) ? (1u << k) : 0u;
                        ((LAS unsigned char*)SELM)[q * 8 + seg] = (unsigned char)byte;
                    }
                    __syncthreads();
#pragma unroll
                    for (int i = 0; i < 16; ++i) { STASH[i * 64] = oacc[0][i]; STASH[(16 + i) * 64] = oacc[1][i]; }
                    { float own[8], oth[8]; const float* cs = ROPE64 + row * 16; u32x4 w = __builtin_bit_cast(u32x4, qf[0]); unpack8(w, own);
#pragma unroll
                      for (int jj = 0; jj < 8; ++jj) oth[jj] = __shfl_xor(own[jj], 32);
#pragma unroll
                      for (int jj = 0; jj < 8; ++jj) own[jj] = h ? own[jj] * cs[jj] + oth[jj] * cs[8 + jj] : own[jj] * cs[jj] - oth[jj] * cs[8 + jj];
                      qf[0] = __builtin_bit_cast(bf16x8, pack8f(own)); }
                    {
                        const unsigned long long mymask = SELM[ql]; const unsigned long long un0 = SELM[lane];
                        unsigned ul = (unsigned)un0, uh = (unsigned)(un0 >> 32);
#pragma unroll
                        for (int o = 1; o < 64; o <<= 1) { ul |= __shfl_xor(ul, o); uh |= __shfl_xor(uh, o); }
                        const unsigned ulo = (unsigned)__builtin_amdgcn_readfirstlane((int)ul), uhi = (unsigned)__builtin_amdgcn_readfirstlane((int)uh);
                        const unsigned long long U = ((unsigned long long)uhi << 32) | ulo;
                        if (wave == 0 && ((U >> lane) & 1ull)) TL[__builtin_amdgcn_mbcnt_hi(uhi, __builtin_amdgcn_mbcnt_lo(ulo, 0u))] = lane;
                        f32x16 oo[2]; float ll = 0.f;
#pragma unroll
                        for (int i = 0; i < 16; ++i) { oo[0][i] = 0.f; oo[1][i] = 0.f; }
                        const bf16_t* kbase = RAW + (size_t)b * SEQ * C_WP + 1536 + g * 64;
                        __syncthreads();
{ auto go_ = [&](auto hs_) { constexpr bool HS = decltype(hs_)::value;
                        att::kv_pipeline_dma2<0>(lds, __builtin_popcountll(U), wave, lane, qf,
                            [&](int tt, const bf16_t*& kb, size_t& kp, const bf16_t*& vb, size_t& vp) { const int sblk = __builtin_amdgcn_readfirstlane(TL[tt]); kb = kbase + (size_t)(64 * sblk) * C_WP; kp = C_WP; vb = kb + 256; vp = C_WP; },
                            [&](int tt, f32x16 (&p)[2], const LAS unsigned char* buf, const LAS unsigned char* nbuf, f32x16 (&pn)[2], int) { const int sblk = __builtin_amdgcn_readfirstlane(TL[tt]);
                                const bool sel = (mymask >> sblk) & 1ull; const int lim = t - 64 * sblk - 4 * h;
                                if (sblk == qt) att::fused_e<1, HS, LP_NSA>(oo, ll, p, buf, lane, sel, shiftS, [&](int koff) { return koff <= lim; }, 0u, 0u, qf, nbuf, pn);
                                else att::fused_e<0, HS, LP_NSA>(oo, ll, p, buf, lane, sel, shiftS, [](int) { return true; }, 0u, 0u, qf, nbuf, pn); },
                            att::NoXtra());
 }; if (shiftS == 0.f) go_(std::false_type{}); else go_(std::true_type{}); }
                        const float lt = ll + __shfl_xor(ll, 32); const float f = lt > 0.f ? GT[row * 48 + hd * 3 + 1] / lt : 0.f;
#pragma unroll
                        for (int i = 0; i < 16; ++i) { STASH[i * 64] += oo[0][i] * f; STASH[(16 + i) * 64] += oo[1][i] * f; }
                    }
                    {
                        const int tw0 = qt >= 8 ? qt - 8 : 0, ntw = qt - tw0 + 1;
                        f32x16 oo[2]; float ll = 0.f;
#pragma unroll
                        for (int i = 0; i < 16; ++i) { oo[0][i] = 0.f; oo[1][i] = 0.f; }
                        const bf16_t* kbase = RAW + (size_t)b * SEQ * C_WP + 2048 + g * 64;
{ auto go_ = [&](auto hs_) { constexpr bool HS = decltype(hs_)::value;
                        att::kv_pipeline_dma2<0>(lds, ntw, wave, lane, qf,
                            [&](int tt, const bf16_t*& kb, size_t& kp, const bf16_t*& vb, size_t& vp) { kb = kbase + (size_t)(64 * (tw0 + tt)) * C_WP; kp = C_WP; vb = kb + 256; vp = C_WP; },
                            [&](int tt, f32x16 (&p)[2], const LAS unsigned char* buf, const LAS unsigned char* nbuf, f32x16 (&pn)[2], int) { const int tw = tw0 + tt; const int d0 = t - 64 * tw - 4 * h;
                                if (tw == qt || (qt >= 8 && tw == qt - 8)) att::fused_e<1, HS, LP_NSA>(oo, ll, p, buf, lane, true, shiftW, [&](int koff) { const int dist = d0 - koff; return dist >= 0 && dist < 512; }, 0u, 0u, qf, nbuf, pn);
                                else att::fused_e<0, HS, LP_NSA>(oo, ll, p, buf, lane, true, shiftW, [](int) { return true; }, 0u, 0u, qf, nbuf, pn); },
                            att::NoXtra());
 }; if (shiftW == 0.f) go_(std::false_type{}); else go_(std::true_type{}); }
                        const float lt = ll + __shfl_xor(ll, 32); const float f = lt > 0.f ? GT[row * 48 + hd * 3 + 2] / lt : 0.f;
#pragma unroll
                        for (int i = 0; i < 16; ++i) { oo[0][i] = STASH[i * 64] + oo[0][i] * f; oo[1][i] = STASH[(16 + i) * 64] + oo[1][i] * f; }
#if defined(PROBE_NSA)
                        if (rep_ == 0)
#endif
                        att::store_o_t<64>(oo, 1.0f, OATT + ((size_t)b * SEQ + qt * 64 + qs * 32) * 1024 + hd * 64, 1024, lds + wave * 4608, lane);
                    }
                    __syncthreads();
                }
            }
            SEAM(pb + 3);
        }
        if (RUN(pb + 4)) for (int rep_ = 0; rep_ < REPS(pb + 4); ++rep_) {
            int lane = (int)__builtin_amdgcn_mbcnt_hi(~0u, __builtin_amdgcn_mbcnt_lo(~0u, 0u)); asm volatile("" : "+v"(lane)); const int tid = wave * 64 + lane;
            if (L == 0) {
                pg8::Gemm g{OATT, W_ABO, MTOK, DM, DM}; pg8::StaticOrder S; S.init(MTOK, DM, G, bid);
                pg8::EpiResid<false> E{out, XB, RSQ};
                pg8::gemm_phase<pg8::EpiResid<false>, pg8::StaticOrder, true, true>(lds, g, S, E, wave);
            }
            if (L == 1) {
                pg8::Gemm g{OATT, W_CO, MTOK, DM, DM}; pg8::StaticOrder S; S.init(MTOK, DM, G, bid);
                pg8::EpiResid<false> E{out, XB, RSQ};
                pg8::gemm_phase<pg8::EpiResid<false>, pg8::StaticOrder, true, true>(lds, g, S, E, wave);
            }
            SEAM(pb + 4);
        }
        if (RUN(pb + 5)) for (int rep_ = 0; rep_ < REPS(pb + 5); ++rep_) {
            int lane = (int)__builtin_amdgcn_mbcnt_hi(~0u, __builtin_amdgcn_mbcnt_lo(~0u, 0u)); asm volatile("" : "+v"(lane)); const int tid = wave * 64 + lane;
            pg8::Gemm g{XB, W_MQ + (size_t)L * 512 * DM, MTOK, 512, DM}; pg8::StaticOrder S; S.init(MTOK, 512, G, bid);
            pg8::EpiPlain E{MQB, 512};
            pg8::gemm_phase<pg8::EpiPlain, pg8::StaticOrder, true, true>(lds, g, S, E, wave);
            SEAM(pb + 5);
        }
        if (RUN(pb + 6)) for (int rep_ = 0; rep_ < REPS(pb + 6); ++rep_) {
            int lane = (int)__builtin_amdgcn_mbcnt_hi(~0u, __builtin_amdgcn_mbcnt_lo(~0u, 0u)); asm volatile("" : "+v"(lane)); const int tid = wave * 64 + lane;
            const float shiftM = [&] { float gq = 0.f, gk = 0.f; for (int i = 0; i < 128; ++i) { gq = fmaxf(gq, fabsf(mem_q_norm[L * 128 + i])); gk = fmaxf(gk, fabsf(mem_k_norm[L * 128 + i])); }
                                       const float B = 11.3137085f * LOG2E * gq * gk * 1.02f; return B > 60.f ? B - 60.f : 0.f; }();
            const int upb = (512 % G == 0) ? 512 / G : 0; int cur_pair = -1;
            for (int k = 0; ; ++k) {
                const int u = upb ? bid * upb + k : bid + k * G; if ((upb && k >= upb) || u >= BATCH * 4 * 16) break;
                const int b = u >> 6, hh = (u >> 4) & 3, qb = u & 15;
                const int r = lane & 31, h = lane >> 5;
                const int row = b * SEQ + qb * 256 + wave * 32 + r;
                if ((u >> 4) != cur_pair) { cur_pair = u >> 4;
                    __syncthreads();
                    const bf16_t* kbase = KVRAW + (size_t)(b * NMEM) * 2048 + L * 1024 + hh * 128;
#pragma unroll
                    for (int i = 0; i < 8; ++i) { const int idx = tid + 512 * i, rw = idx >> 4, c = idx & 15;
                        *(LAS u32x4*)(lds + rw * 272 + c * 16) = *(const u32x4*)(kbase + (size_t)rw * 2048 + c * 8);
                        *(LAS u32x4*)(lds + 69632 + rw * 320 + c * 16) = *(const u32x4*)(kbase + (size_t)rw * 2048 + 512 + c * 8); }
                    __syncthreads(); }
                const float rs = row_rstd(RSQ, row);
                bf16x8 qf[8]; float ssq = 0.f;
                const bf16_t* qrow = MQB + (size_t)row * 512 + hh * 128 + 8 * h;
#pragma unroll
                for (int s2 = 0; s2 < 8; ++s2) { qf[s2] = *(const bf16x8*)(qrow + 16 * s2);
#pragma unroll
                    for (int j = 0; j < 8; ++j) { const float f = bf2f((unsigned short)qf[s2][j]) * rs; ssq += f * f; } }
                ssq += __shfl_xor(ssq, 32);
                const float qs = rs * __builtin_amdgcn_rsqf(ssq * (1.0f / 128.0f) + RMS_EPS) * (0.08838834764831845f * LOG2E);
#pragma unroll
                for (int s2 = 0; s2 < 8; ++s2) { const float* gn = mem_q_norm + L * 128 + 16 * s2 + 8 * h; const f32x4 ga = *(const f32x4*)gn, gb = *(const f32x4*)(gn + 4); u32x4 w;
#pragma unroll
                    for (int j = 0; j < 4; ++j) { const float g0_ = j < 2 ? ga[2 * j] : gb[2 * j - 4], g1_ = j < 2 ? ga[2 * j + 1] : gb[2 * j - 3];
                        w[j] = pk2(bf2f((unsigned short)qf[s2][2 * j]) * qs * g0_, bf2f((unsigned short)qf[s2][2 * j + 1]) * qs * g1_); }
                    qf[s2] = __builtin_bit_cast(bf16x8, w); }
                f32x16 oo[4]; float ll = 0.f;
#pragma unroll
                for (int d = 0; d < 4; ++d)
#pragma unroll
                    for (int i = 0; i < 16; ++i) oo[d][i] = 0.f;
#pragma unroll 1
                for (int tt = 0; tt < 4; ++tt) {
                    f32x16 p[2]; att::tile_scores<128>(p, qf, lds + tt * 64 * 272, lane);
                    float ls = 0.f;
#pragma unroll
                    for (int kt = 0; kt < 2; ++kt)
#pragma unroll
                        for (int i = 0; i < 16; ++i) { const float e = __builtin_amdgcn_exp2f(p[kt][i] - shiftM); p[kt][i] = e; ls += e; }
                    ll += ls;
                    att::tile_pv<128>(oo, p, lds + 69632 + tt * 64 * 320 - att::Geo<128>::KB, lane); }
                const float lt = ll + __shfl_xor(ll, 32);
                att::store_o<128>(oo, 1.0f / lt, OMEM + (size_t)row * 512 + hh * 128, lane);
            }
            SEAM(pb + 6);
        }
        if (RUN(pb + 7)) for (int rep_ = 0; rep_ < REPS(pb + 7); ++rep_) {
            int lane = (int)__builtin_amdgcn_mbcnt_hi(~0u, __builtin_amdgcn_mbcnt_lo(~0u, 0u)); asm volatile("" : "+v"(lane)); const int tid = wave * 64 + lane;
            pg8::Gemm g{OMEM, W_MO + (size_t)L * DM * 512, MTOK, DM, 512}; pg8::StaticOrder S; S.init(MTOK, DM, G, bid);
            pg8::EpiResid<false> E{out, XB, RSQ};
            pg8::gemm_phase<pg8::EpiResid<false>, pg8::StaticOrder, true, true>(lds, g, S, E, wave);
            SEAM(pb + 7);
        }
        if (RUN(pb + 8)) for (int rep_ = 0; rep_ < REPS(pb + 8); ++rep_) {
            int lane = (int)__builtin_amdgcn_mbcnt_hi(~0u, __builtin_amdgcn_mbcnt_lo(~0u, 0u)); asm volatile("" : "+v"(lane)); const int tid = wave * 64 + lane;
            pg8::Gemm g{XB, W_FI + (size_t)L * 5632 * DM, MTOK, 5632, DM}; pg8::StaticOrder S; S.init(MTOK, 5632, G, bid);
            pg8::EpiSwiGLU E{RSQ, HID};
            pg8::gemm_phase<pg8::EpiSwiGLU, pg8::StaticOrder, true, true>(lds, g, S, E, wave);
#ifdef PROBE_DUP_FFN
            if (L == 0) { __syncthreads(); pg8::gemm_phase<pg8::EpiSwiGLU, pg8::StaticOrder, true, true>(lds, g, S, E, wave); }
#endif
            SEAM(pb + 8);
        }
        if (RUN(pb + 9)) for (int rep_ = 0; rep_ < REPS(pb + 9); ++rep_) {
            int lane = (int)__builtin_amdgcn_mbcnt_hi(~0u, __builtin_amdgcn_mbcnt_lo(~0u, 0u)); asm volatile("" : "+v"(lane)); const int tid = wave * 64 + lane;
            pg8::Gemm g{HID, W_FO + (size_t)L * DM * DFF, MTOK, DM, DFF}; pg8::StaticOrder S; S.init(MTOK, DM, G, bid);
            if (L == 0) { pg8::EpiResid<false> E{out, XB, RSQ}; pg8::gemm_phase<pg8::EpiResid<false>, pg8::StaticOrder, true, true>(lds, g, S, E, wave); }
            else { pg8::EpiResid<true> E{out, XB, RSQ}; pg8::gemm_phase<pg8::EpiResid<true>, pg8::StaticOrder, true, true>(lds, g, S, E, wave); }
            SEAM(pb + 9);
        }
}

__global__ void __launch_bounds__(NWAVES * 64, 2) fwd_kernel(Args args) {
    extern __shared__ __attribute__((aligned(16))) unsigned char lds_raw[];
    LAS unsigned char* lds = (LAS unsigned char*)(unsigned)__builtin_amdgcn_readfirstlane((int)(unsigned)(size_t)(LAS unsigned char*)lds_raw);
    volatile LAS unsigned* MISC = (volatile LAS unsigned*)(lds + LDS_MISC);
    const int tid = threadIdx.x, lane = tid & 63, wave = __builtin_amdgcn_readfirstlane(tid >> 6);
    const int G = gridDim.x, bid = blockIdx.x;
    unsigned* ctl = (unsigned*)(args.ws + WS_CTL);
    for (int u = tid; u < (LDS_BYTES - LDS_MISC) / 4; u += NWAVES * 64) ((LAS unsigned*)(lds + LDS_MISC))[u] = 0u;
    __syncthreads();
    XcdBarrier bar = xcd_barrier_post(ctl + CW_BAR + args.li * XCD_BAR_WORDS, MISC + 8);
    const int lo = args.ph_lo, hi = args.ph_hi;

    if (RUN(0)) for (int rep_ = 0; rep_ < REPS(0); ++rep_) {
        LAS float* scr = (LAS float*)(lds + wave * 16384);
        const int gw = bid * NWAVES + wave, NGW = G * NWAVES;
        constexpr int I_AB = 16 * (AB_WP / 32), I_C = 16 * (C_WP / 32), I_O = 16 * 32, I_MQ = 16 * 16, I_KV = 16 * 32, I_MO = 8 * 32, I_FI = 16 * (5632 / 32), I_FO = (DFF / 64) * 32;
        constexpr int NITEMS = I_AB + I_C + 2 * I_O + 2 * I_MQ + 2 * I_KV + 2 * I_MO + 2 * I_FI + 2 * I_FO;
        for (int it = gw; it < NITEMS; it += NGW) {
            int r = it;
            if (r < I_AB) { const int nbn = AB_WP / 32; transpose_item(ab_w_in, DM, AB_W, W_AB, norm_mix, scr, r / nbn, r % nbn, lane, CMapProj0{}); continue; } r -= I_AB;
            if (r < I_C) { const int nbn = C_WP / 32; transpose_item(nsa_w_in, DM, C_W, W_C, norm_mix + DM, scr, r / nbn, r % nbn, lane, CMapProj1{}); continue; } r -= I_C;
            if (r < I_O) { transpose_item(ab_w_out, DM, DM, W_ABO, nullptr, scr, r / 32, r % 32, lane, CMapId{DM}); continue; } r -= I_O;
            if (r < I_O) { transpose_item(nsa_w_out, DM, DM, W_CO, nullptr, scr, r / 32, r % 32, lane, CMapId{DM}); continue; } r -= I_O;
            if (r < 2 * I_MQ) { const int L = r / I_MQ; r %= I_MQ; transpose_item(mem_w_q + (size_t)L * DM * 512, DM, 512, W_MQ + (size_t)L * 512 * DM, norm_mem + L * DM, scr, r / 16, r % 16, lane, CMapId{512}); continue; } r -= 2 * I_MQ;
            if (r < 2 * I_KV) { const int L = r / I_KV; r %= I_KV; transpose_item(mem_w_kv + (size_t)L * DM * 1024, DM, 1024, W_KV + (size_t)L * 1024 * DM, norm_mem_src + L * DM, scr, r / 32, r % 32, lane, CMapId{1024}); continue; } r -= 2 * I_KV;
            if (r < 2 * I_MO) { const int L = r / I_MO; r %= I_MO; transpose_item(mem_w_o + (size_t)L * 512 * DM, 512, DM, W_MO + (size_t)L * DM * 512, nullptr, scr, r / 32, r % 32, lane, CMapId{DM}); continue; } r -= 2 * I_MO;
            if (r < 2 * I_FI) { const int L = r / I_FI; r %= I_FI; const int nbn = 5632 / 32; transpose_item(ffn_w_in + (size_t)L * DM * 5632, DM, 5632, W_FI + (size_t)L * 5632 * DM, norm_ffn + L * DM, scr, r / nbn, r % nbn, lane, CMapFfn{}); continue; } r -= 2 * I_FI;
            { const int L = r / I_FO; r %= I_FO; transpose_item(ffn_w_out + (size_t)L * DFF * DM, DFF, DM, W_FO + (size_t)L * DM * DFF, nullptr, scr, r / 32, r % 32, lane, CMapId{DM}); }
        }
        for (int m = gw; m < MTOK; m += 4 * NGW) {
            int mr[4]; f32x4 v[4][4]; float sq[4];
#pragma unroll
            for (int q = 0; q < 4; ++q) { mr[q] = m + q * NGW < MTOK ? m + q * NGW : m; const f32x4* xr = (const f32x4*)(x_in + (size_t)mr[q] * DM) + lane;
#pragma unroll
                for (int j = 0; j < 4; ++j) v[q][j] = xr[64 * j]; }
#pragma unroll
            for (int q = 0; q < 4; ++q) { float a = 0.f;
#pragma unroll
                for (int j = 0; j < 4; ++j) a += (v[q][j][0] * v[q][j][0] + v[q][j][1] * v[q][j][1]) + (v[q][j][2] * v[q][j][2] + v[q][j][3] * v[q][j][3]);
                sq[q] = a; }
#pragma unroll
            for (int o = 1; o < 64; o <<= 1) {
#pragma unroll
                for (int q = 0; q < 4; ++q) sq[q] += __shfl_xor(sq[q], o); }
#pragma unroll
            for (int q = 0; q < 4; ++q) { u32x2* xbr = (u32x2*)(XB + (size_t)mr[q] * DM) + lane;
#pragma unroll
                for (int j = 0; j < 4; ++j) { u32x2 w; w.x = pk2(v[q][j][0], v[q][j][1]); w.y = pk2(v[q][j][2], v[q][j][3]); xbr[64 * j] = w; }
                if (lane < 16) RSQ[(size_t)mr[q] * 16 + lane] = (lane == 0) ? sq[q] : 0.f; }
        }
        for (int i = bid * 512 + tid; i < MTOK * 12; i += G * 512) {
            const int m = i / 12, k = i % 12;
            const float f64t[8] = {1.0f, 0.19392274474868576f, 0.03760603093086393f, 0.007292664737217109f, 0.001414213562373095f, 0.0002742481756762073f, 5.318295896944988e-05f, 1.031338537721246e-05f};
            float fr;
            if (k < 8) fr = f64t[k]; else { const int q = k - 8; fr = (q == 0) ? 1.0f : (q == 1) ? 0.03760603093086393f : (q == 2) ? 0.001414213562373095f : 5.318295896944988e-05f; }
            const float ang = (float)positions[m] * fr;
            const double rev = (double)ang * 0.15915494309189535; const float frac = (float)(rev - __builtin_rint(rev));
            const float c = __builtin_amdgcn_cosf(frac), sn = __builtin_amdgcn_sinf(frac);
            if (k < 8) { ROPE64[(size_t)m * 16 + k] = c; ROPE64[(size_t)m * 16 + 8 + k] = sn; } else { ROPE32[(size_t)m * 8 + (k - 8)] = c; ROPE32[(size_t)m * 8 + 4 + (k - 8)] = sn; }
        }
        for (int it = gw; it < 128; it += NGW) { const int kv = it >> 6, r = it & 63;
            transpose_item(kv ? nsa_cmp_w1_v : nsa_cmp_w1_k, 2048, 64, W1T + (size_t)kv * 64 * 2048, nullptr, scr, r >> 1, r & 1, lane, CMapId{64}); }
        for (int it = (NGW - 1 - gw); it < 128; it += NGW) { const int kv = it >> 6, c = it & 63; const float* pe = kv ? nsa_cmp_pos_v : nsa_cmp_pos_k; const float* w1 = kv ? nsa_cmp_w1_v : nsa_cmp_w1_k;
            float a = 0.f;
            for (int k0 = 0; k0 < 2048; k0 += 512) { float pv[8], wv[8];
#pragma unroll
                for (int j = 0; j < 8; ++j) { const int k = k0 + 64 * j + lane; pv[j] = pe[k]; wv[j] = w1[(size_t)k * 64 + c]; }
#pragma unroll
                for (int j = 0; j < 8; ++j) a += pv[j] * wv[j]; }
            a = wave_sum(a); if (lane == 0) POSW1[kv * 64 + c] = a; }
        for (int m = gw; m < MMEM; m += NGW) {
            const f32x4* xr = (const f32x4*)(mem_in + (size_t)m * DM) + lane; f32x4 v[4]; float s = 0.f;
#pragma unroll
            for (int j = 0; j < 4; ++j) { v[j] = xr[64 * j]; s += (v[j][0] * v[j][0] + v[j][1] * v[j][1]) + (v[j][2] * v[j][2] + v[j][3] * v[j][3]); }
            s = wave_sum(s);
            u32x2* xbr = (u32x2*)(MEMB + (size_t)m * DM) + lane;
#pragma unroll
            for (int j = 0; j < 4; ++j) { u32x2 w; w.x = pk2(v[j][0], v[j][1]); w.y = pk2(v[j][2], v[j][3]); xbr[64 * j] = w; }
            if (lane == 0) MRS[m] = __builtin_amdgcn_rsqf(s * (1.0f / 1024.0f) + RMS_EPS);
        }
        SEAM(0);
    }

    layer_phases<0>(args, lds, bar, lo, hi, wave);
    layer_phases<1>(args, lds, bar, lo, hi, wave);
#undef RUN
#undef SEAM
}
#undef INF_
#undef x_in
#undef mem_in
#undef positions
#undef norm_mix
#undef norm_mem
#undef norm_mem_src
#undef norm_ffn
#undef ab_w_in
#undef ab_w_out
#undef nsa_w_in
#undef nsa_w_out
#undef mem_w_q
#undef mem_w_kv
#undef mem_w_o
#undef ffn_w_in
#undef ffn_w_out
#undef out
#undef WSB
#undef W_AB
#undef W_C
#undef W_ABO
#undef W_CO
#undef W_MQ
#undef W_KV
#undef W_MO
#undef W_FI
#undef W_FO
#undef XB
#undef RSQ
#undef HID
#undef MEMB
#undef KVRAW
#undef MRS
#undef MQB
#undef OMEM
#undef mem_q_norm
#undef RAW
#undef OATT
#undef ROPE64
#undef ROPE32
#undef W1T
#undef POSW1
#undef KCMP
#undef VCMP
#undef GT
#undef nsa_q_norm
#undef SCR
#undef BMK
#undef KMEAN
#undef IWB
#undef dsa_q_norm
#undef dsa_k_norm
#undef moba_q_norm
#undef moba_k_norm
#undef nsa_kcmp_norm
#undef nsa_ksel_norm
#undef nsa_kwin_norm
#undef nsa_cmp_pos_k
#undef nsa_cmp_pos_v
#undef nsa_cmp_w1_k
#undef nsa_cmp_w2_k
#undef nsa_cmp_w1_v
#undef nsa_cmp_w2_v
#undef mem_k_norm

extern "C" void kernel_launch(void* const* d_in, const int* in_sizes, int n_in, void* d_out, int out_size, void* d_ws, size_t ws_size, hipStream_t stream) {
    static int grid = 0;
    if (grid == 0) {
        if (n_in != 32 || out_size != MTOK * DM || ws_size < WS_END) { fprintf(stderr, "kernel_launch: unexpected shapes (n_in %d out %d ws %zu)\n", n_in, out_size, ws_size); grid = -1; return; }
        int dev = 0, cus = 0, per_cu = 0;
        if (hipGetDevice(&dev) != hipSuccess || hipDeviceGetAttribute(&cus, hipDeviceAttributeMultiprocessorCount, dev) != hipSuccess) { grid = -1; return; }
        if (hipFuncSetAttribute((const void*)fwd_kernel, hipFuncAttributeMaxDynamicSharedMemorySize, LDS_BYTES) != hipSuccess) { fprintf(stderr, "kernel_launch: hipFuncSetAttribute failed\n"); grid = -1; return; }
        if (hipOccupancyMaxActiveBlocksPerMultiprocessor(&per_cu, (const void*)fwd_kernel, NWAVES * 64, LDS_BYTES) != hipSuccess || per_cu < 1) fprintf(stderr, "kernel_launch: occupancy query says %d\n", per_cu);
        (void)hipGetLastError();
        grid = cus;
    }
    if (grid < 0) return;
    if (hipMemsetAsync((char*)d_ws + WS_CTL, 0, CTL_ZERO_BYTES, stream) != hipSuccess) return;
    Args a{};
    for (int i = 0; i < 32; ++i) a.in[i] = d_in[i];
    a.out = (float*)d_out; a.ws = (unsigned char*)d_ws; a.pad = 0;
    const int NPH = 21;
#if 0
    for (int p = 0; p < NPH; ++p) { a.ph_lo = p; a.ph_hi = p + 1; a.li = 0; hipLaunchKernelGGL(fwd_kernel, dim3(grid), dim3(NWAVES * 64), LDS_BYTES, stream, a); }
#else
    a.ph_lo = 0; a.ph_hi = NPH; a.li = 0; hipLaunchKernelGGL(fwd_kernel, dim3(grid), dim3(NWAVES * 64), LDS_BYTES, stream, a);
#endif
}
```

```cpp
#include <hip/hip_runtime.h>
#include <cstdio>
#include <cstdint>
#include <type_traits>

#define LAS __attribute__((address_space(3)))
#define GAS __attribute__((address_space(1)))
typedef unsigned short bf16_t;
typedef short bf16x8 __attribute__((ext_vector_type(8)));
typedef short s16x4 __attribute__((ext_vector_type(4)));
typedef float f32x4 __attribute__((ext_vector_type(4)));
typedef float f32x2 __attribute__((ext_vector_type(2)));
typedef float f32x16 __attribute__((ext_vector_type(16)));
typedef unsigned u32x4 __attribute__((ext_vector_type(4)));
typedef unsigned u32x2 __attribute__((ext_vector_type(2)));
typedef __bf16 bf16x2_t __attribute__((ext_vector_type(2)));

constexpr int BATCH = 8, SEQ = 4096, DM = 1024, MTOK = BATCH * SEQ;
constexpr int NMEM = 256, MMEM = BATCH * NMEM;
constexpr int DFF = 2816;
constexpr int AB_W = 2472, AB_WP = 2560;
constexpr int C_W = 2608, C_WP = 2816;
constexpr float RMS_EPS = 1e-6f;
constexpr float LOG2E = 1.4426950408889634f;

namespace pg8 {
constexpr int BM = 256, BK = 64, HALF = 128, HTB = HALF * BK * 2, STAGE_BYTES = 8 * HTB, NXCD = 8, WGM = 8;
__host__ __device__ __forceinline__ int lds_byte(int r, int c) { const int st = (r >> 4) * 2 + (c >> 5), rr = r & 15, cc = c & 31, ob = rr * 64 + cc * 2; return st * 1024 + (ob ^ (((ob >> 9) & 1) << 5)); }
__host__ __device__ __forceinline__ void stage_rc(int b, int& R, int& C) { const int st = b / 1024, sb = b % 1024, swz = sb ^ (((sb >> 9) & 1) << 5); R = (st >> 1) * 16 + swz / 64; C = (st & 1) * 32 + (swz % 64) / 2; }
__host__ __device__ __forceinline__ int perm32(int rho) { const int n = rho >> 4, i = rho & 15; return 8 * (i >> 2) + 4 * n + (i & 3); }
struct Unit { int pm, pn; };
struct Gemm { const bf16_t* A; const bf16_t* Bt; int M, N, K; };
struct StaticOrder {
    int nM, nN, nwg, G, c;
    __host__ __device__ void init(int M, int N, int G_, int c_) { nM = M / BM; nN = N / BM; nwg = nM * nN; G = G_; c = c_; }
    __host__ __device__ bool next(int i, Unit& u) const {
        const long L = (long)i * G + c; if (L >= nwg) return false;
        int wgid = (int)L; { const int q = nwg / NXCD, r = nwg % NXCD, xcd = wgid % NXCD, off = wgid / NXCD; wgid = (xcd < r ? xcd * (q + 1) : r * (q + 1) + (xcd - r) * q) + off; }
        const int nig = WGM * nN, gid = wgid / nig, fm = gid * WGM, gsz = (nM - fm) < WGM ? (nM - fm) : WGM;
        u.pm = fm + ((wgid % nig) % gsz); u.pn = (wgid % nig) / gsz; return true;
    }
    __device__ __forceinline__ void a_ready(const Unit&) const {}
    __device__ __forceinline__ void done(const Unit&) const {}
};
__device__ __forceinline__ unsigned cvt_pk_bf16(float lo, float hi) { unsigned r; asm volatile("v_cvt_pk_bf16_f32 %0, %1, %2" : "=v"(r) : "v"(lo), "v"(hi)); return r; }

struct EpiPlain {
    static constexpr bool PERM = true, AFTER_DRAIN = false;
    bf16_t* O; int ldc;
    __device__ __forceinline__ void operator()(const f32x4 (&acc)[2][2][4][2], const Unit& u, int wr, int wc, int fr, int fq) const {
        const int row0 = u.pm * BM + wr * 64 + fr, col0 = u.pn * BM + wc * 32 + 8 * fq;
#pragma unroll
        for (int ai = 0; ai < 2; ++ai)
#pragma unroll
            for (int m = 0; m < 4; ++m) { bf16_t* rowp = O + (size_t)(row0 + ai * HALF + m * 16) * ldc + col0;
#pragma unroll
                for (int bj = 0; bj < 2; ++bj) { const f32x4 v0 = acc[ai][bj][m][0], v1 = acc[ai][bj][m][1];
                    u32x4 w; w.x = cvt_pk_bf16(v0[0], v0[1]); w.y = cvt_pk_bf16(v0[2], v0[3]); w.z = cvt_pk_bf16(v1[0], v1[1]); w.w = cvt_pk_bf16(v1[2], v1[3]);
                    *(u32x4*)(rowp + bj * HALF) = w; } }
    }
};
template <bool FINAL> struct EpiResid {
    static constexpr bool PERM = true, AFTER_DRAIN = false;
    float* out; bf16_t* xb; float* rsq;
    __device__ __forceinline__ void operator()(const f32x4 (&acc)[2][2][4][2], const Unit& u, int wr, int wc, int fr, int fq) const {
        const int col0 = u.pn * BM + wc * 32 + 8 * fq;
#pragma unroll
        for (int ai = 0; ai < 2; ++ai) {
            u32x4 rb[4][2];
#pragma unroll
            for (int m = 0; m < 4; ++m)
#pragma unroll
                for (int bj = 0; bj < 2; ++bj) rb[m][bj] = *(const u32x4*)(xb + (size_t)(u.pm * BM + ai * HALF + wr * 64 + m * 16 + fr) * 1024 + col0 + bj * HALF);
#pragma unroll
            for (int m = 0; m < 4; ++m) { const int row = u.pm * BM + ai * HALF + wr * 64 + m * 16 + fr; const size_t off = (size_t)row * 1024 + col0; float ss = 0.f;
#pragma unroll
                for (int bj = 0; bj < 2; ++bj) { const size_t o = off + bj * HALF; const u32x4 r4 = rb[m][bj]; float v[8];
#pragma unroll
                    for (int k = 0; k < 4; ++k) { v[2 * k] = acc[ai][bj][m][k >> 1][(2 * k) & 3] + __builtin_bit_cast(float, r4[k] << 16); v[2 * k + 1] = acc[ai][bj][m][k >> 1][(2 * k + 1) & 3] + __builtin_bit_cast(float, r4[k] & 0xffff0000u); }
                    if (FINAL) { *(f32x4*)(out + o) = (f32x4){v[0], v[1], v[2], v[3]}; *(f32x4*)(out + o + 4) = (f32x4){v[4], v[5], v[6], v[7]}; }
                    else { u32x4 w; w.x = cvt_pk_bf16(v[0], v[1]); w.y = cvt_pk_bf16(v[2], v[3]); w.z = cvt_pk_bf16(v[4], v[5]); w.w = cvt_pk_bf16(v[6], v[7]); *(u32x4*)(xb + o) = w;
#pragma unroll
                        for (int k = 0; k < 4; ++k) { const float r0 = __builtin_bit_cast(float, w[k] << 16), r1 = __builtin_bit_cast(float, w[k] & 0xffff0000u); ss += r0 * r0 + r1 * r1; } } }
                if (!FINAL) { ss += __shfl_xor(ss, 16); ss += __shfl_xor(ss, 32);
                    if (fq == 0) rsq[(size_t)row * 16 + u.pn * 4 + wc] = ss; } }
            asm volatile("" ::: "memory");
        }
    }
};
struct EpiSwiGLU {
    static constexpr bool PERM = true, AFTER_DRAIN = false;
    const float* rsq; bf16_t* hid;
    __device__ __forceinline__ void operator()(const f32x4 (&acc)[2][2][4][2], const Unit& u, int wr, int wc, int fr, int fq) const {
        const int col0 = u.pn * 128 + wc * 32 + 8 * fq;
        f32x4 pr[2][4];
#pragma unroll
        for (int ai = 0; ai < 2; ++ai)
#pragma unroll
            for (int m = 0; m < 4; ++m) pr[ai][m] = *(const f32x4*)(rsq + (size_t)(u.pm * BM + ai * HALF + wr * 64 + m * 16 + fr) * 16 + 4 * fq);
#pragma unroll
        for (int ai = 0; ai < 2; ++ai)
#pragma unroll
            for (int m = 0; m < 4; ++m) { const int row = u.pm * BM + ai * HALF + wr * 64 + m * 16 + fr;
                float ss = (pr[ai][m][0] + pr[ai][m][1]) + (pr[ai][m][2] + pr[ai][m][3]);
                ss += __shfl_xor(ss, 16); ss += __shfl_xor(ss, 32);
                const float c = __builtin_amdgcn_rsqf(ss * (1.0f / 1024.0f) + RMS_EPS);
                float h[8];
#pragma unroll
                for (int n = 0; n < 2; ++n)
#pragma unroll
                    for (int e = 0; e < 4; ++e) { const float g = acc[ai][0][m][n][e] * c, uu = acc[ai][1][m][n][e] * c;
                        const float sg = g * __builtin_amdgcn_rcpf(1.0f + __builtin_amdgcn_exp2f(-g * LOG2E)); h[n * 4 + e] = sg * uu; }
                u32x4 w; w.x = cvt_pk_bf16(h[0], h[1]); w.y = cvt_pk_bf16(h[2], h[3]); w.z = cvt_pk_bf16(h[4], h[5]); w.w = cvt_pk_bf16(h[6], h[7]);
                *(u32x4*)(hid + (size_t)row * DFF + col0) = w; }
    }
};

struct ProjUnit { int kind; const float* gain; float scale; bool rope; };
template <int L> struct EpiProj {
    static constexpr bool PERM = true, AFTER_DRAIN = false;
    bf16_t* O; int ldc; const float* rsq; const float* rope64; const float* rope32; const float* g0; const float* g1; const float* g2; const float* g3; float* aux;
    __device__ __forceinline__ ProjUnit classify(int unit) const {
        constexpr float C2 = 0.125f * LOG2E;
        if (L == 0) {
            if (unit < 8) return {1, g0, C2, true}; if (unit == 8) return {1, g1, 1.f, true}; if (unit == 9) return {2, nullptr, 1.f, false};
            if (unit < 14) return {4, nullptr, 1.f, false}; if (unit == 14) return {5, nullptr, 1.f, false};
            if (unit < 23) return {1, g2, C2, true}; if (unit < 31) return {1, g3, 1.f, true}; if (unit < 39) return {2, nullptr, 1.f, false}; return {0, nullptr, 1.f, false};
        } else {
            if (unit < 16) return {1, g0, C2, false}; if (unit < 24) return {3, nullptr, 1.f, false};
            if (unit < 28) return {1, g1, 1.f, true}; if (unit < 32) return {2, nullptr, 1.f, false}; if (unit < 36) return {1, g2, 1.f, true}; if (unit < 40) return {2, nullptr, 1.f, false};
            if (unit == 40) return {6, nullptr, 1.f, false}; return {0, nullptr, 1.f, false};
        }
    }
    __device__ __forceinline__ void operator()(const f32x4 (&acc)[2][2][4][2], const Unit& u, int wr, int wc, int fr, int fq) const {
        const int unit = 4 * u.pn + wc; const ProjUnit pu = classify(unit);
        if (pu.kind == 0) return;
        float gl[2][8];
        if (pu.kind == 1) {
#pragma unroll
            for (int bj = 0; bj < 2; ++bj) { const f32x4 a = *(const f32x4*)(pu.gain + 8 * (2 * fq + bj)), b = *(const f32x4*)(pu.gain + 8 * (2 * fq + bj) + 4);
#pragma unroll
                for (int x = 0; x < 4; ++x) { gl[bj][x] = a[x] * pu.scale; gl[bj][4 + x] = b[x] * pu.scale; } }
        }
        float rsv[2][4];
        if (pu.kind != 3) { f32x4 pr[2][4];
#pragma unroll
            for (int ai = 0; ai < 2; ++ai)
#pragma unroll
                for (int m = 0; m < 4; ++m) pr[ai][m] = *(const f32x4*)(rsq + (size_t)(u.pm * BM + ai * HALF + wr * 64 + m * 16 + fr) * 16 + 4 * fq);
#pragma unroll
            for (int ai = 0; ai < 2; ++ai)
#pragma unroll
                for (int m = 0; m < 4; ++m) { float ss = (pr[ai][m][0] + pr[ai][m][1]) + (pr[ai][m][2] + pr[ai][m][3]); ss += __shfl_xor(ss, 16); ss += __shfl_xor(ss, 32);
                    rsv[ai][m] = __builtin_amdgcn_rsqf(ss * (1.0f / 1024.0f) + RMS_EPS); } }
        else {
#pragma unroll
            for (int ai = 0; ai < 2; ++ai)
#pragma unroll
                for (int m = 0; m < 4; ++m) rsv[ai][m] = 1.f; }
#pragma unroll
        for (int ai = 0; ai < 2; ++ai)
#pragma unroll
            for (int m = 0; m < 4; ++m) { const int row = u.pm * BM + ai * HALF + wr * 64 + m * 16 + fr;
                const float rs = rsv[ai][m];
                float v[2][8];
#pragma unroll
                for (int bj = 0; bj < 2; ++bj)
#pragma unroll
                    for (int e = 0; e < 8; ++e) v[bj][e] = acc[ai][bj][m][e >> 2][e & 3] * rs;
                if (pu.kind == 1) {
                    float ss = 0.f;
#pragma unroll
                    for (int bj = 0; bj < 2; ++bj)
#pragma unroll
                        for (int e = 0; e < 8; ++e) ss += v[bj][e] * v[bj][e];
                    ss += __shfl_xor(ss, 16); ss += __shfl_xor(ss, 32);
                    const float rn = __builtin_amdgcn_rsqf(ss * (1.0f / 64.0f) + RMS_EPS);
#pragma unroll
                    for (int bj = 0; bj < 2; ++bj)
#pragma unroll
                        for (int e = 0; e < 8; ++e) v[bj][e] = v[bj][e] * rn * gl[bj][e];
                    if (pu.rope && fq == 0) {
                        const float* cs = rope64 + (size_t)row * 16; const f32x4 c0 = *(const f32x4*)cs, c1 = *(const f32x4*)(cs + 4), s0 = *(const f32x4*)(cs + 8), s1 = *(const f32x4*)(cs + 12);
#pragma unroll
                        for (int e = 0; e < 8; ++e) { const float c = e < 4 ? c0[e & 3] : c1[e & 3], sn = e < 4 ? s0[e & 3] : s1[e & 3]; const float x1 = v[0][e], x2 = v[1][e];
                            v[0][e] = x1 * c - x2 * sn; v[1][e] = x2 * c + x1 * sn; }
                    }
                }
                if (pu.kind == 4 || pu.kind == 5) {
                    if (fq == 0 || (fq == 2 && pu.kind == 4)) { const float* cs = rope32 + (size_t)row * 8; const f32x4 c = *(const f32x4*)cs, sn = *(const f32x4*)(cs + 4);
#pragma unroll
                        for (int x = 0; x < 4; ++x) { const float a = v[0][x], b = v[0][4 + x]; v[0][x] = a * c[x] - b * sn[x]; v[0][4 + x] = b * c[x] + a * sn[x]; } }
                    if (pu.kind == 5 && fq == 2) { *(f32x4*)(aux + (size_t)row * 8) = (f32x4){v[0][0], v[0][1], v[0][2], v[0][3]}; *(f32x4*)(aux + (size_t)row * 8 + 4) = (f32x4){v[0][4], v[0][5], v[0][6], v[0][7]}; }
                }
                if (pu.kind == 6) {
#pragma unroll
                    for (int bj = 0; bj < 2; ++bj) if (2 * fq + bj < 6) {
#pragma unroll
                        for (int e = 0; e < 8; ++e) v[bj][e] = __builtin_amdgcn_rcpf(1.0f + __builtin_amdgcn_exp2f(-v[bj][e] * LOG2E));
                        float* ap = aux + (size_t)row * 48 + 8 * (2 * fq + bj);
                        *(f32x4*)ap = (f32x4){v[bj][0], v[bj][1], v[bj][2], v[bj][3]}; *(f32x4*)(ap + 4) = (f32x4){v[bj][4], v[bj][5], v[bj][6], v[bj][7]}; }
                } else {
                    bf16_t* orow = O + (size_t)row * ldc + 64 * unit + 16 * fq;
                    u32x4 w0, w1;
                    w0.x = cvt_pk_bf16(v[0][0], v[0][1]); w0.y = cvt_pk_bf16(v[0][2], v[0][3]); w0.z = cvt_pk_bf16(v[0][4], v[0][5]); w0.w = cvt_pk_bf16(v[0][6], v[0][7]);
                    w1.x = cvt_pk_bf16(v[1][0], v[1][1]); w1.y = cvt_pk_bf16(v[1][2], v[1][3]); w1.z = cvt_pk_bf16(v[1][4], v[1][5]); w1.w = cvt_pk_bf16(v[1][6], v[1][7]);
                    *(u32x4*)orow = w0; *(u32x4*)(orow + 8) = w1;
                }
                if (m & 1) asm volatile("" ::: "memory"); }
    }
};

template <class Epi, class Sched, bool ALIGN_EPI = false, bool SP2 = false>
__device__ __forceinline__ void gemm_phase(LAS unsigned char* lds, const Gemm g, const Sched& S, const Epi& E, const int wave_id) {
    int tid = wave_id * 64 + (int)__builtin_amdgcn_mbcnt_hi(~0u, __builtin_amdgcn_mbcnt_lo(~0u, 0u)); asm volatile("" : "+v"(tid));
    const int wid = wave_id, lane = tid & 63, wr = wid >> 2, wc = wid & 3, fr = lane & 15, fq = lane >> 4;
    const int K = g.K, nt = K / BK;
    unsigned voffA[2], voffB[2];
#pragma unroll
    for (int i = 0; i < 2; ++i) { int R, C; stage_rc(tid * 16 + i * 8192, R, C); const int Rb = Epi::PERM ? ((R & ~31) + perm32(R & 31)) : R;
        voffA[i] = (unsigned)(R * K + C) * 2u; voffB[i] = (unsigned)(Rb * K + C) * 2u; }
    const size_t kstep = (size_t)(BK * 2);
    const size_t hstep = (size_t)HALF * K * 2;
    const size_t tstep = 2 * hstep;
    const unsigned ldsw = (unsigned)wid * 1024u;
    const int aoff = lds_byte(wr * 64 + fr, fq * 8), boff = lds_byte(wc * 32 + fr, fq * 8);
#define PG8_SA(b, h) (((b) * 2 + (h)) * HTB)
#define PG8_SB(b, h) ((4 + (b) * 2 + (h)) * HTB)
#define PG8_STAGE(bufoff, gbase, voff) do { _Pragma("unroll") for (int _i = 0; _i < 2; ++_i) \
        __builtin_amdgcn_global_load_lds((const unsigned*)((const char*)(gbase) + (voff)[_i]), (LAS unsigned*)(lds + (bufoff) + ldsw + _i * 8192), 16, 0, 0); } while (0)
#define PG8_LDA(dst, b, h) do { _Pragma("unroll") for (int m = 0; m < 4; ++m) _Pragma("unroll") for (int k = 0; k < 2; ++k) dst[m][k] = *(const LAS bf16x8*)(lds + PG8_SA(b, h) + aoff + m * 2048 + k * 1024); } while (0)
#define PG8_LDB(dst, b, h) do { _Pragma("unroll") for (int n = 0; n < 2; ++n) _Pragma("unroll") for (int k = 0; k < 2; ++k) dst[n][k] = *(const LAS bf16x8*)(lds + PG8_SB(b, h) + boff + n * 2048 + k * 1024); } while (0)
#define PG8_MMA(ai, bj, At, Bt) do { __builtin_amdgcn_s_setprio(1); _Pragma("unroll") for (int m = 0; m < 4; ++m) _Pragma("unroll") for (int n = 0; n < 2; ++n) _Pragma("unroll") for (int k = 0; k < 2; ++k) \
        acc[ai][bj][m][n] = __builtin_amdgcn_mfma_f32_16x16x32_bf16(Bt[n][k], At[m][k], acc[ai][bj][m][n], 0, 0, 0); __builtin_amdgcn_s_setprio(0); } while (0)
#define PG8_WAIT_V(n) asm volatile("s_waitcnt vmcnt(" #n ")" ::: "memory")
#define PG8_WAIT_L(n) asm volatile("s_waitcnt lgkmcnt(" #n ")" ::: "memory")
#define PG8_BAR __builtin_amdgcn_s_barrier()
#define PG8_SCHED __builtin_amdgcn_sched_barrier(0)
    Unit cur, nxt; int ui = 0;
    if (!S.next(0, cur)) return;
    f32x4 acc[2][2][4][2];
#pragma unroll
    for (int a = 0; a < 2; ++a)
#pragma unroll
        for (int b = 0; b < 2; ++b)
#pragma unroll
            for (int m = 0; m < 4; ++m)
#pragma unroll
                for (int n = 0; n < 2; ++n) acc[a][b][m][n] = (f32x4){0.f, 0.f, 0.f, 0.f};
    bf16x8 At[4][2], B0[2][2], B1[2][2];
    const char* cA = (const char*)g.A + (size_t)cur.pm * tstep; const char* cB = (const char*)g.Bt + (size_t)cur.pn * tstep;
    S.a_ready(cur);
    if constexpr (SP2) {
        PG8_STAGE(PG8_SB(0, 0), cB, voffB); PG8_STAGE(PG8_SB(0, 1), cB + hstep, voffB); PG8_STAGE(PG8_SA(0, 0), cA, voffA); PG8_STAGE(PG8_SA(0, 1), cA + hstep, voffA);
        if (wr == 1) PG8_BAR;
        PG8_WAIT_V(2); PG8_BAR;
        PG8_STAGE(PG8_SB(1, 0), cB + kstep, voffB); PG8_STAGE(PG8_SA(1, 0), cA + kstep, voffA); PG8_STAGE(PG8_SB(1, 1), cB + hstep + kstep, voffB);
        PG8_WAIT_V(6); PG8_BAR;
    } else {
        PG8_STAGE(PG8_SB(0, 0), cB, voffB); PG8_STAGE(PG8_SA(0, 0), cA, voffA); PG8_STAGE(PG8_SB(0, 1), cB + hstep, voffB); PG8_STAGE(PG8_SA(0, 1), cA + hstep, voffA);
        if (wr == 1) PG8_BAR;
        PG8_WAIT_V(4); PG8_BAR;
        PG8_STAGE(PG8_SB(1, 0), cB + kstep, voffB); PG8_STAGE(PG8_SA(1, 0), cA + kstep, voffA); PG8_STAGE(PG8_SB(1, 1), cB + hstep + kstep, voffB);
        PG8_WAIT_V(6); PG8_BAR;
    }
    for (;;) {
        const bool has_next = S.next(ui + 1, nxt);
        const char* nA = has_next ? (const char*)g.A + (size_t)nxt.pm * tstep : cA; const char* nB = has_next ? (const char*)g.Bt + (size_t)nxt.pn * tstep : cB;
        for (int t = 0; t < nt; t += 2) {
            const bool last = (t == nt - 2);
            const char* a1 = cA + (size_t)(t + 1) * kstep;
            const char* a2 = last ? nA : cA + (size_t)(t + 2) * kstep; const char* b2 = last ? nB : cB + (size_t)(t + 2) * kstep;
            const char* a3 = a2 + kstep; const char* b3 = b2 + kstep;
            if (last && has_next) S.a_ready(nxt);
            if constexpr (SP2) {
            PG8_LDB(B0, 0, 0); PG8_LDB(B1, 0, 1); PG8_SCHED; PG8_LDA(At, 0, 0); PG8_STAGE(PG8_SA(1, 1), a1 + hstep, voffA);
            PG8_WAIT_V(8); PG8_WAIT_L(0); PG8_BAR; PG8_MMA(0, 0, At, B0); PG8_MMA(0, 1, At, B1); PG8_BAR; PG8_SCHED;
            PG8_LDA(At, 0, 1); PG8_STAGE(PG8_SB(0, 0), b2, voffB); PG8_STAGE(PG8_SB(0, 1), b2 + hstep, voffB); PG8_STAGE(PG8_SA(0, 0), a2, voffA);
            PG8_WAIT_V(8); PG8_WAIT_L(0); PG8_BAR; PG8_MMA(1, 0, At, B0); PG8_MMA(1, 1, At, B1); PG8_BAR; PG8_SCHED;
            PG8_LDB(B0, 1, 0); PG8_LDB(B1, 1, 1); PG8_SCHED; PG8_LDA(At, 1, 0); PG8_STAGE(PG8_SA(0, 1), a2 + hstep, voffA);
            PG8_WAIT_V(8); PG8_WAIT_L(0); PG8_BAR; PG8_MMA(0, 0, At, B0); PG8_MMA(0, 1, At, B1); PG8_BAR; PG8_SCHED;
            PG8_LDA(At, 1, 1); PG8_STAGE(PG8_SB(1, 0), b3, voffB); PG8_STAGE(PG8_SB(1, 1), b3 + hstep, voffB); PG8_STAGE(PG8_SA(1, 0), a3, voffA);
            PG8_WAIT_V(8); PG8_WAIT_L(0); PG8_BAR; PG8_MMA(1, 0, At, B0); PG8_MMA(1, 1, At, B1); PG8_BAR; PG8_SCHED;
            } else {
            PG8_LDB(B0, 0, 0); PG8_SCHED; PG8_LDA(At, 0, 0); PG8_STAGE(PG8_SA(1, 1), a1 + hstep, voffA);
            PG8_WAIT_L(8); PG8_BAR; PG8_WAIT_L(0); PG8_MMA(0, 0, At, B0); PG8_BAR; PG8_SCHED;
            PG8_LDB(B1, 0, 1); PG8_STAGE(PG8_SB(0, 0), b2, voffB);
            PG8_BAR; PG8_WAIT_L(0); PG8_MMA(0, 1, At, B1); PG8_BAR;
            PG8_LDA(At, 0, 1); PG8_STAGE(PG8_SA(0, 0), a2, voffA);
            PG8_BAR; PG8_WAIT_L(0); PG8_MMA(1, 0, At, B0); PG8_BAR; PG8_SCHED;
            PG8_STAGE(PG8_SB(0, 1), b2 + hstep, voffB);
            PG8_WAIT_V(6); PG8_BAR; PG8_MMA(1, 1, At, B1); PG8_BAR;
            PG8_LDB(B0, 1, 0); PG8_SCHED; PG8_LDA(At, 1, 0); PG8_STAGE(PG8_SA(0, 1), a2 + hstep, voffA);
            PG8_WAIT_L(8); PG8_BAR; PG8_WAIT_L(0); PG8_MMA(0, 0, At, B0); PG8_BAR; PG8_SCHED;
            PG8_LDB(B1, 1, 1); PG8_STAGE(PG8_SB(1, 0), b3, voffB);
            PG8_BAR; PG8_WAIT_L(0); PG8_MMA(0, 1, At, B1); PG8_BAR;
            PG8_LDA(At, 1, 1); PG8_STAGE(PG8_SA(1, 0), a3, voffA);
            PG8_BAR; PG8_WAIT_L(0); PG8_MMA(1, 0, At, B0); PG8_BAR; PG8_SCHED;
            PG8_STAGE(PG8_SB(1, 1), b3 + hstep, voffB);
            PG8_WAIT_V(6); PG8_BAR; PG8_MMA(1, 1, At, B1); PG8_BAR;
            }
        }
        if constexpr (ALIGN_EPI) { if (wr == 0) PG8_BAR; }
        if constexpr (!Epi::AFTER_DRAIN) { E(acc, cur, wr, wc, fr, fq); S.done(cur); }
        if (!has_next) break;
#pragma unroll
        for (int a = 0; a < 2; ++a)
#pragma unroll
            for (int b = 0; b < 2; ++b)
#pragma unroll
                for (int m = 0; m < 4; ++m)
#pragma unroll
                    for (int n = 0; n < 2; ++n) acc[a][b][m][n] = (f32x4){0.f, 0.f, 0.f, 0.f};
        cur = nxt; cA = nA; cB = nB; ++ui;
        if constexpr (ALIGN_EPI) { if (wr == 1) PG8_BAR; }
    }
    PG8_WAIT_V(0);
    if constexpr (!ALIGN_EPI) { if (wr == 0) PG8_BAR; }
    PG8_BAR;
#undef PG8_SA
#undef PG8_SB
#undef PG8_STAGE
#undef PG8_LDA
#undef PG8_LDB
#undef PG8_MMA
#undef PG8_WAIT_V
#undef PG8_WAIT_L
#undef PG8_BAR
#undef PG8_SCHED
}
}

#define XB_TMO      128
#define XB_XCNT(j)  (256  + 64 * (j))
#define XB_XSUB(j)  (1280 + 64 * (j))
#define XB_XGEN(j)  (2304 + 64 * (j))
#define XB_TOP      3328
#define XB_TOPGEN   3392
#define XCD_BAR_WORDS 3456
#define XB_SPIN_CAP (1u << 18)
__device__ __forceinline__ unsigned xb_ld(unsigned* p)              { return __hip_atomic_load(p, __ATOMIC_RELAXED, __HIP_MEMORY_SCOPE_AGENT); }
__device__ __forceinline__ unsigned xb_add(unsigned* p, unsigned v) { return __hip_atomic_fetch_add(p, v, __ATOMIC_RELAXED, __HIP_MEMORY_SCOPE_AGENT); }
__device__ __forceinline__ unsigned xb_xcc_id() { return (unsigned)__builtin_amdgcn_s_getreg((3 << 11) | 20) & 0xFu; }
#define XB_SPIN(cond, bar) do { unsigned _sp = 0; while (cond) { __builtin_amdgcn_s_sleep(1); \
    if ((++_sp & 255u) == 0u) { if (xb_ld(&(bar)[XB_TMO])) break; if (_sp > XB_SPIN_CAP) { atomicAdd(&(bar)[XB_TMO], 1u); break; } } } } while (0)
struct XcdBarrier { unsigned* bar; unsigned x; volatile LAS unsigned* st; };
__device__ __forceinline__ XcdBarrier xcd_barrier_post(unsigned* bar, volatile LAS unsigned* st) {
    XcdBarrier b; b.bar = bar; b.x = xb_xcc_id(); b.st = st;
    if (threadIdx.x == 0) (void)xb_add(&bar[XB_XCNT(b.x)], 1u);
    return b;
}
__device__ __forceinline__ void xcd_barrier_complete(unsigned* bar, unsigned x, unsigned& nloc, unsigned& nx) {
    const unsigned G = gridDim.x * gridDim.y * gridDim.z;
    unsigned sum, cnt, mine, sp = 0u;
    for (;;) {
        sum = 0u; cnt = 0u; mine = 0u;
#pragma unroll
        for (unsigned j = 0; j < 16; ++j) { const unsigned c = xb_ld(&bar[XB_XCNT(j)]); sum += c; cnt += (c > 0u) ? 1u : 0u; mine = (j == x) ? c : mine; }
        if (sum == G) break;
        __builtin_amdgcn_s_sleep(1);
        if ((++sp & 255u) == 0u) { if (xb_ld(&bar[XB_TMO])) break; if (sp > XB_SPIN_CAP) { atomicAdd(&bar[XB_TMO], 1u); break; } }
    }
    nloc = mine > 0u ? mine : 1u; nx = cnt > 0u ? cnt : 1u;
}
__device__ __forceinline__ void xcd_barrier(const XcdBarrier& b) {
    asm volatile("s_waitcnt vmcnt(0)" ::: "memory");
    __syncthreads();
    if (threadIdx.x == 0) {
        unsigned* bar = b.bar;
        __builtin_amdgcn_s_waitcnt(0);
        unsigned nloc = b.st[0], nx = b.st[1];
        if (nloc == 0u) { xcd_barrier_complete(bar, b.x, nloc, nx); b.st[0] = nloc; b.st[1] = nx; }
        const unsigned old = xb_add(&bar[XB_XSUB(b.x)], 1u);
        const unsigned gen = old / nloc;
        if (old + 1u == (gen + 1u) * nloc) {
            __builtin_amdgcn_fence(__ATOMIC_RELEASE, "agent");
            asm volatile("s_waitcnt vmcnt(0)" ::: "memory");
            const unsigned og = xb_add(&bar[XB_TOP], 1u);
            const unsigned tg = og / nx;
            if (og + 1u == (tg + 1u) * nx) xb_add(&bar[XB_TOPGEN], 1u);
            else XB_SPIN(xb_ld(&bar[XB_TOPGEN]) == tg, bar);
            __builtin_amdgcn_fence(__ATOMIC_ACQUIRE, "agent");
            xb_add(&bar[XB_XGEN(b.x)], 1u);
            asm volatile("s_waitcnt vmcnt(0)" ::: "memory");
        } else {
            XB_SPIN(xb_ld(&bar[XB_XGEN(b.x)]) == gen, bar);
            __builtin_amdgcn_fence(__ATOMIC_ACQUIRE, "agent");
            asm volatile("s_waitcnt vmcnt(0)" ::: "memory");
        }
    }
    __syncthreads();
}

constexpr size_t MiB = 1u << 20;
constexpr size_t WS_CTL = 0, CTL_ZERO_BYTES = 1 * MiB;
constexpr int CW_BAR = 4096;
constexpr size_t WS_WAB = 1 * MiB;
constexpr size_t WS_WC = WS_WAB + (size_t)AB_WP * DM * 2;
constexpr size_t WS_WABO = WS_WC + (size_t)C_WP * DM * 2;
constexpr size_t WS_WCO = WS_WABO + (size_t)DM * DM * 2;
constexpr size_t WS_WMQ = WS_WCO + (size_t)DM * DM * 2;
constexpr size_t WS_WKV = WS_WMQ + (size_t)2 * 512 * DM * 2;
constexpr size_t WS_WMO = WS_WKV + (size_t)2048 * DM * 2;
constexpr size_t WS_WFI = WS_WMO + (size_t)2 * DM * 512 * 2;
constexpr size_t WS_WFO = WS_WFI + (size_t)2 * 5632 * DM * 2;
constexpr size_t WS_WEND = WS_WFO + (size_t)2 * DM * DFF * 2;
constexpr size_t WS_MISC = 64 * MiB;
static_assert(WS_WEND <= WS_MISC, "weights fit");
constexpr size_t WS_ROPE64 = WS_MISC;
constexpr size_t WS_ROPE32 = WS_ROPE64 + (size_t)MTOK * 16 * 4;
constexpr size_t WS_RSQ = WS_ROPE32 + (size_t)MTOK * 8 * 4;
constexpr size_t WS_MRS = WS_RSQ + (size_t)MTOK * 16 * 4;
constexpr size_t WS_MEMB = WS_MRS + 8192;
constexpr size_t WS_KVRAW = WS_MEMB + (size_t)MMEM * DM * 2;
constexpr size_t WS_W1T = WS_KVRAW + (size_t)MMEM * 2048 * 2;
constexpr size_t WS_POSW1 = WS_W1T + (size_t)2 * 64 * 2048 * 2;
constexpr size_t WS_KCMP = WS_POSW1 + 512;
constexpr size_t WS_VCMP = WS_KCMP + (size_t)BATCH * 4 * 256 * 64 * 2;
constexpr size_t WS_MISCEND = WS_VCMP + (size_t)BATCH * 4 * 256 * 64 * 2;
constexpr size_t WS_XB = 96 * MiB;
static_assert(WS_MISCEND <= WS_XB, "misc fits");
constexpr size_t WS_R1 = 160 * MiB;
constexpr size_t WS_OATT = 336 * MiB;
constexpr size_t WS_R3 = 400 * MiB;
constexpr size_t WS_GT = WS_R3;
constexpr size_t WS_MQ = WS_R3;
constexpr size_t WS_OMEM = WS_R3 + (size_t)MTOK * 512 * 2;
constexpr size_t WS_SC = WS_OATT;
constexpr size_t WS_BM = 464 * MiB;
constexpr size_t WS_KM = 480 * MiB;
constexpr size_t WS_ISG = 481 * MiB;
constexpr size_t WS_END = 512 * MiB;
static_assert(WS_R1 + (size_t)MTOK * C_WP * 2 <= WS_OATT, "R1 fits");

constexpr int LDS_BYTES = 155648;
constexpr int LDS_MISC = 151552;
constexpr int NWAVES = 8;

__device__ __forceinline__ unsigned f2bf(float f) { unsigned u = __builtin_bit_cast(unsigned, f); return (u + 0x7fffu + ((u >> 16) & 1u)) >> 16; }
__device__ __forceinline__ unsigned pk2(float lo, float hi) { f32x2 v = {lo, hi}; bf16x2_t b = __builtin_convertvector(v, bf16x2_t); return __builtin_bit_cast(unsigned, b); }
__device__ __forceinline__ float bf2f(unsigned short b) { return __builtin_bit_cast(float, (unsigned)b << 16); }
__device__ __forceinline__ float wave_sum(float v) {
#pragma unroll
    for (int o = 1; o < 64; o <<= 1) v += __shfl_xor(v, o);
    return v;
}


namespace att {
constexpr float NEG_INF = -__builtin_huge_valf();
template <int HD> struct Geo { static constexpr int PK = HD * 2 + 16, PV = (HD == 64 ? 192 : 320), KB = 64 * PK, VB = 64 * PV, BUF = KB + VB; };
template <int HD> struct State { f32x16 o[HD / 32]; float m, l;
    __device__ __forceinline__ void init() {
#pragma unroll
        for (int d = 0; d < HD / 32; ++d)
#pragma unroll
            for (int i = 0; i < 16; ++i) o[d][i] = 0.f;
        m = NEG_INF; l = 0.f; } };
template <int HD> struct TileRegs { u32x4 k[HD / 64], v[HD / 64]; };
template <int HD> __device__ __forceinline__ void load_tile(TileRegs<HD>& tr, const bf16_t* kb, size_t kp, const bf16_t* vb, size_t vp, int tid) {
#pragma unroll
    for (int i = 0; i < HD / 64; ++i) { const int idx = tid + 512 * i, row = idx / (HD / 8), c = idx % (HD / 8);
        tr.k[i] = *(const u32x4*)(kb + (size_t)row * kp + c * 8); tr.v[i] = *(const u32x4*)(vb + (size_t)row * vp + c * 8); }
}
template <int HD> __device__ __forceinline__ void store_tile(const TileRegs<HD>& tr, LAS unsigned char* buf, int tid) {
#pragma unroll
    for (int i = 0; i < HD / 64; ++i) { const int idx = tid + 512 * i, row = idx / (HD / 8), c = idx % (HD / 8);
        *(LAS u32x4*)(buf + row * Geo<HD>::PK + c * 16) = tr.k[i]; *(LAS u32x4*)(buf + Geo<HD>::KB + row * Geo<HD>::PV + c * 16) = tr.v[i]; }
}
__device__ __forceinline__ s16x4 tr_read(const LAS unsigned char* p) { typedef short v4i16_t __attribute__((ext_vector_type(4)));
    return __builtin_bit_cast(s16x4, __builtin_amdgcn_ds_read_tr16_b64_v4i16((LAS v4i16_t*)p)); }
__device__ __forceinline__ bf16x8 pack8(const f32x16& x, int s8) {
    u32x4 w; w.x = pk2(x[s8], x[s8 + 1]); w.y = pk2(x[s8 + 2], x[s8 + 3]); w.z = pk2(x[s8 + 4], x[s8 + 5]); w.w = pk2(x[s8 + 6], x[s8 + 7]); return __builtin_bit_cast(bf16x8, w); }
template <int HD> __device__ __forceinline__ void tile_scores(f32x16 (&p)[2], const bf16x8 (&qf)[HD / 16], const LAS unsigned char* buf, int lane) {
    const int r = lane & 31, h = lane >> 5;
#pragma unroll
    for (int kt = 0; kt < 2; ++kt) { f32x16 x;
#pragma unroll
        for (int i = 0; i < 16; ++i) x[i] = 0.f;
#pragma unroll
        for (int s = 0; s < HD / 16; ++s) { const bf16x8 kf = *(const LAS bf16x8*)(buf + (32 * kt + r) * Geo<HD>::PK + 32 * s + 16 * h); x = __builtin_amdgcn_mfma_f32_32x32x16_bf16(kf, qf[s], x, 0, 0, 0); }
        p[kt] = x; }
}
template <int HD> __device__ __forceinline__ void tile_pv(f32x16 (&o)[HD / 32], const f32x16 (&p)[2], const LAS unsigned char* buf, int lane) {
    const int h = lane >> 5, blk = (lane >> 4) & 1, q = (lane & 15) >> 2, pp = lane & 3;
    const LAS unsigned char* vb = buf + Geo<HD>::KB + (4 * h + q) * Geo<HD>::PV + 32 * blk + 8 * pp;
#pragma unroll
    for (int kt = 0; kt < 2; ++kt)
#pragma unroll
        for (int s = 0; s < 2; ++s) { const bf16x8 pb = pack8(p[kt], 8 * s);
#pragma unroll
            for (int dh = 0; dh < HD / 32; ++dh) { const LAS unsigned char* a = vb + (32 * kt + 16 * s) * Geo<HD>::PV + 64 * dh;
                const s16x4 lo = tr_read(a), hi = tr_read(a + 8 * Geo<HD>::PV);
                const bf16x8 vf = __builtin_shufflevector(lo, hi, 0, 1, 2, 3, 4, 5, 6, 7);
                o[dh] = __builtin_amdgcn_mfma_f32_32x32x16_bf16(vf, pb, o[dh], 0, 0, 0); } }
}
template <int HD, class MaskF> __device__ __forceinline__ void tile_step(State<HD>& st, const bf16x8 (&qf)[HD / 16], const LAS unsigned char* buf, int lane, MaskF valid) {
    f32x16 p[2]; tile_scores<HD>(p, qf, buf, lane);
    float mx = NEG_INF;
#pragma unroll
    for (int kt = 0; kt < 2; ++kt)
#pragma unroll
        for (int i = 0; i < 16; ++i) { const int koff = 32 * kt + (i & 3) + 8 * (i >> 2); const float v = valid(koff) ? p[kt][i] : NEG_INF; p[kt][i] = v; mx = fmaxf(mx, v); }
    mx = fmaxf(mx, __shfl_xor(mx, 32));
    const float mnew = fmaxf(st.m, mx), muse = (mnew == NEG_INF) ? 0.f : mnew;
    const float alpha = __builtin_amdgcn_exp2f(st.m - muse);
    float ls = 0.f;
#pragma unroll
    for (int kt = 0; kt < 2; ++kt)
#pragma unroll
        for (int i = 0; i < 16; ++i) { const float e = __builtin_amdgcn_exp2f(p[kt][i] - muse); p[kt][i] = e; ls += e; }
    st.l = st.l * alpha + ls; st.m = mnew;
#pragma unroll
    for (int dh = 0; dh < HD / 32; ++dh)
#pragma unroll
        for (int i = 0; i < 16; ++i) st.o[dh][i] *= alpha;
    tile_pv<HD>(st.o, p, buf, lane);
}
template <int HD, class SrcF, class CompF> __device__ __forceinline__ void kv_pipeline(LAS unsigned char* lds, int nt, int tid, SrcF src, CompF comp) {
    TileRegs<HD> tr; const bf16_t *kb, *vb; size_t kp, vp;
    __syncthreads();
    if (nt <= 0) return;
    src(0, kb, kp, vb, vp); load_tile<HD>(tr, kb, kp, vb, vp, tid); store_tile<HD>(tr, lds, tid);
    __syncthreads();
    for (int t = 0; t < nt; ++t) {
        if (t + 1 < nt) { src(t + 1, kb, kp, vb, vp); load_tile<HD>(tr, kb, kp, vb, vp, tid); }
        comp(t, lds + (t & 1) * Geo<HD>::BUF);
        if (t + 1 < nt) store_tile<HD>(tr, lds + ((t + 1) & 1) * Geo<HD>::BUF, tid);
        __syncthreads();
    }
}

template <int HD, bool PIPE, class SrcF, class ActF, class FinF> __device__ __forceinline__ void kv_pipeline3(LAS unsigned char* lds, int nt, int tid, int lane, const bf16x8 (&qf)[HD / 16], SrcF src, ActF act, FinF fin) {
    TileRegs<HD> tr; const bf16_t *kb, *vb; size_t kp, vp;
    __syncthreads();
    if (nt <= 0) return;
    src(0, kb, kp, vb, vp); load_tile<HD>(tr, kb, kp, vb, vp, tid); store_tile<HD>(tr, lds, tid);
    if (nt > 1) { src(1, kb, kp, vb, vp); load_tile<HD>(tr, kb, kp, vb, vp, tid); store_tile<HD>(tr, lds + Geo<HD>::BUF, tid); }
    __syncthreads();
    f32x16 pc[2], pn[2];
    if constexpr (PIPE) { if (act(0)) tile_scores<HD>(pc, qf, lds, lane); }
    int b0 = 0, b1 = 1, b2 = 2;
    for (int t = 0; t < nt; ++t) {
        if (t + 2 < nt) { src(t + 2, kb, kp, vb, vp); load_tile<HD>(tr, kb, kp, vb, vp, tid); }
        if constexpr (PIPE) {
            const bool an = (t + 1 < nt) && act(t + 1);
            if (an) tile_scores<HD>(pn, qf, lds + b1 * Geo<HD>::BUF, lane);
            if (act(t)) fin(t, pc, lds + b0 * Geo<HD>::BUF);
        } else {
            if (act(t)) { tile_scores<HD>(pc, qf, lds + b0 * Geo<HD>::BUF, lane); fin(t, pc, lds + b0 * Geo<HD>::BUF); }
        }
        if (t + 2 < nt) store_tile<HD>(tr, lds + b2 * Geo<HD>::BUF, tid);
        __syncthreads();
        if constexpr (PIPE) {
#pragma unroll
            for (int k = 0; k < 2; ++k) pc[k] = pn[k]; }
        const int tb = b0; b0 = b1; b1 = b2; b2 = tb;
    }
}
template <int HD, class MaskF> __device__ __forceinline__ void tile_finish(State<HD>& st, f32x16 (&p)[2], const LAS unsigned char* buf, int lane, bool lane_ok, bool elem, MaskF valid) {
    float mx = fmaxf(p[0][0], p[1][0]);
#pragma unroll
    for (int i = 1; i < 16; ++i) mx = fmaxf(mx, fmaxf(p[0][i], p[1][i]));
    mx = fmaxf(mx, __shfl_xor(mx, 32));
    if (__any(mx > st.m)) {
        const float mnew = fmaxf(st.m, mx), alpha = __builtin_amdgcn_exp2f(st.m - mnew);
        st.l *= alpha; st.m = mnew;
#pragma unroll
        for (int dh = 0; dh < HD / 32; ++dh)
#pragma unroll
            for (int i = 0; i < 16; ++i) st.o[dh][i] *= alpha;
    }
    const float sub = lane_ok ? st.m : __builtin_huge_valf();
#pragma unroll
    for (int kt = 0; kt < 2; ++kt)
#pragma unroll
        for (int i = 0; i < 16; ++i) p[kt][i] = __builtin_amdgcn_exp2f(p[kt][i] - sub);
    if (elem) {
#pragma unroll
        for (int kt = 0; kt < 2; ++kt)
#pragma unroll
            for (int i = 0; i < 16; ++i) { const int koff = 32 * kt + (i & 3) + 8 * (i >> 2); p[kt][i] = valid(koff) ? p[kt][i] : 0.f; }
    }
    float ls = 0.f;
#pragma unroll
    for (int i = 0; i < 16; ++i) ls += p[0][i] + p[1][i];
    st.l += ls;
    tile_pv<HD>(st.o, p, buf, lane);
}

template <int HD, bool ELEM, class MaskF> __device__ __forceinline__ void tile_fused(State<HD>& st, f32x16 (&p)[2], const LAS unsigned char* buf, int lane, bool lane_ok, MaskF valid,
                                                                                 const bf16x8 (&qf)[HD / 16], const LAS unsigned char* nbuf, f32x16 (&pn)[2]) {
    float mx = fmaxf(p[0][0], p[1][0]);
#pragma unroll
    for (int i = 1; i < 16; ++i) mx = fmaxf(mx, fmaxf(p[0][i], p[1][i]));
    mx = fmaxf(mx, __shfl_xor(mx, 32));
    if (__any(mx > st.m)) {
        const float mnew = fmaxf(st.m, mx), alpha = __builtin_amdgcn_exp2f(st.m - mnew);
        st.l *= alpha; st.m = mnew;
#pragma unroll
        for (int dh = 0; dh < HD / 32; ++dh)
#pragma unroll
            for (int i = 0; i < 16; ++i) st.o[dh][i] *= alpha;
    }
    const float sub = lane_ok ? st.m : __builtin_huge_valf();
    asm volatile("" : "+v"(lane));
    const int r = lane & 31, h = lane >> 5, blk = (lane >> 4) & 1, q4 = (lane & 15) >> 2, pp = lane & 3;
    const LAS unsigned char* kl = nbuf + r * Geo<HD>::PK + 16 * h;
    const LAS unsigned char* vl = buf + Geo<HD>::KB + (4 * h + q4) * Geo<HD>::PV + 32 * blk + 8 * pp;
#pragma unroll
    for (int i = 0; i < 16; ++i) { pn[0][i] = 0.f; pn[1][i] = 0.f; }
    float ls = 0.f;
#pragma unroll
    for (int c = 0; c < 4; ++c) {
        const int kt = c >> 1, s2 = c & 1;
#pragma unroll
        for (int ss = 0; ss < HD / 32; ++ss) { const int sk = (HD / 32) * s2 + ss; const bf16x8 kf = *(const LAS bf16x8*)(kl + (32 * kt) * Geo<HD>::PK + 32 * sk);
            pn[kt] = __builtin_amdgcn_mfma_f32_32x32x16_bf16(kf, qf[sk], pn[kt], 0, 0, 0); }
#pragma unroll
        for (int j = 0; j < 8; ++j) { const int i = 8 * s2 + j; float e = __builtin_amdgcn_exp2f(p[kt][i] - sub);
            if (ELEM) { const int koff = 32 * kt + (i & 3) + 8 * (i >> 2); e = valid(koff) ? e : 0.f; }
            p[kt][i] = e; ls += e; }
        const bf16x8 pb = pack8(p[kt], 8 * s2);
#pragma unroll
        for (int dh = 0; dh < HD / 32; ++dh) { const LAS unsigned char* a = vl + (32 * kt + 16 * s2) * Geo<HD>::PV + 64 * dh;
            const s16x4 lo = tr_read(a), hi = tr_read(a + 8 * Geo<HD>::PV);
            const bf16x8 vf = __builtin_shufflevector(lo, hi, 0, 1, 2, 3, 4, 5, 6, 7);
            st.o[dh] = __builtin_amdgcn_mfma_f32_32x32x16_bf16(vf, pb, st.o[dh], 0, 0, 0); }
        __builtin_amdgcn_sched_barrier(0);
    }
    st.l += ls;
}
struct NoPre { __device__ __forceinline__ void operator()(int) const {} };
template <int HD, class SrcF, class FinF, class PreF = NoPre> __device__ __forceinline__ void kv_pipeline4(LAS unsigned char* lds, int nt, int tid, int lane, const bf16x8 (&qf)[HD / 16], SrcF src, FinF fin, PreF pre = PreF()) {
    TileRegs<HD> tr; const bf16_t *kb, *vb; size_t kp, vp;
    __syncthreads();
    if (nt <= 0) return;
    src(0, kb, kp, vb, vp); load_tile<HD>(tr, kb, kp, vb, vp, tid); store_tile<HD>(tr, lds, tid);
    if (nt > 1) { src(1, kb, kp, vb, vp); load_tile<HD>(tr, kb, kp, vb, vp, tid); store_tile<HD>(tr, lds + Geo<HD>::BUF, tid); }
    __syncthreads();
    f32x16 pc[2], pn[2];
    tile_scores<HD>(pc, qf, lds, lane);
    int b0 = 0, b1 = 1, b2 = 2;
    for (int t = 0; t < nt; ++t) {
        pre(t + 1);
        if (t + 2 < nt) { src(t + 2, kb, kp, vb, vp); load_tile<HD>(tr, kb, kp, vb, vp, tid); }
        const int bn = (t + 1 < nt) ? b1 : b0;
        fin(t, pc, lds + b0 * Geo<HD>::BUF, lds + bn * Geo<HD>::BUF, pn);
        if (t + 2 < nt) store_tile<HD>(tr, lds + b2 * Geo<HD>::BUF, tid);
        __syncthreads();
#pragma unroll
        for (int k = 0; k < 2; ++k) pc[k] = pn[k];
        const int tb = b0; b0 = b1; b1 = b2; b2 = tb;
    }
}

constexpr int DBUF = 16384;
__device__ __forceinline__ void dma_tile(LAS unsigned char* buf, const bf16_t* kb, size_t kp, const bf16_t* vb, size_t vp, int wave, int lane) {
    const int row = 8 * wave + (lane >> 3), cp = lane & 7;
    const bf16_t* gk = kb + (size_t)row * kp + ((cp ^ ((row >> 1) & 7)) * 8);
    const bf16_t* gv = vb + (size_t)row * vp + ((cp ^ (4 * ((row >> 1) & 1))) * 8);
    __builtin_amdgcn_global_load_lds((const unsigned*)gk, (LAS unsigned*)(buf + wave * 1024), 16, 0, 0);
    __builtin_amdgcn_global_load_lds((const unsigned*)gv, (LAS unsigned*)(buf + 8192 + wave * 1024), 16, 0, 0);
}
__device__ __forceinline__ void scores_d(f32x16 (&p)[2], const bf16x8 (&qf)[4], const LAS unsigned char* buf, int lane) {
    const int r = lane & 31, h = lane >> 5;
#pragma unroll
    for (int kt = 0; kt < 2; ++kt) { f32x16 x;
#pragma unroll
        for (int i = 0; i < 16; ++i) x[i] = 0.f;
        const int row = 32 * kt + r; const LAS unsigned char* kr = buf + row * 128; const int sw = (row >> 1) & 7;
#pragma unroll
        for (int s = 0; s < 4; ++s) { const bf16x8 kf = *(const LAS bf16x8*)(kr + (((2 * s + h) ^ sw) * 16)); x = __builtin_amdgcn_mfma_f32_32x32x16_bf16(kf, qf[s], x, 0, 0, 0); }
        p[kt] = x; }
}
template <bool ELEM, class MaskF> __device__ __forceinline__ void fused_d(State<64>& st, f32x16 (&p)[2], const LAS unsigned char* buf, int lane, bool lane_ok, MaskF valid,
                                                                        const bf16x8 (&qf)[4], const LAS unsigned char* nbuf, f32x16 (&pn)[2]) {
    float mx = fmaxf(p[0][0], p[1][0]);
#pragma unroll
    for (int i = 1; i < 16; ++i) mx = fmaxf(mx, fmaxf(p[0][i], p[1][i]));
    mx = fmaxf(mx, __shfl_xor(mx, 32));
    if (__any(mx > st.m)) {
        const float mnew = fmaxf(st.m, mx), alpha = __builtin_amdgcn_exp2f(st.m - mnew);
        st.l *= alpha; st.m = mnew;
#pragma unroll
        for (int dh = 0; dh < 2; ++dh)
#pragma unroll
            for (int i = 0; i < 16; ++i) st.o[dh][i] *= alpha;
    }
    const float sub = lane_ok ? st.m : __builtin_huge_valf();
    asm volatile("" : "+v"(lane));
    const int r = lane & 31, h = lane >> 5, blk = (lane >> 4) & 1, q4 = (lane & 15) >> 2, pp = lane & 3;
    const int ksw = (r >> 1) & 7;
    const LAS unsigned char* kl = nbuf + r * 128;
    const int vsw = 4 * ((q4 >> 1) & 1);
    const LAS unsigned char* vl = buf + 8192 + (4 * h + q4) * 128 + 8 * (pp & 1);
    const int vc0 = ((2 * blk + (pp >> 1)) ^ vsw) * 16, vc1 = ((4 + 2 * blk + (pp >> 1)) ^ vsw) * 16;
#pragma unroll
    for (int i = 0; i < 16; ++i) { pn[0][i] = 0.f; pn[1][i] = 0.f; }
    float ls = 0.f;
#pragma unroll
    for (int c = 0; c < 4; ++c) {
        const int kt = c >> 1, s2 = c & 1;
        s16x4 l0, h0, l1, h1;
        { const unsigned a0 = (unsigned)(size_t)(vl + (32 * kt + 16 * s2) * 128 + vc0), a1 = (unsigned)(size_t)(vl + (32 * kt + 16 * s2) * 128 + vc1);
          asm volatile("ds_read_b64_tr_b16 %0, %4\n\tds_read_b64_tr_b16 %1, %4 offset:1024\n\tds_read_b64_tr_b16 %2, %5\n\tds_read_b64_tr_b16 %3, %5 offset:1024"
                       : "=&v"(l0), "=&v"(h0), "=&v"(l1), "=&v"(h1) : "v"(a0), "v"(a1) : "memory"); }
#pragma unroll
        for (int ss = 0; ss < 2; ++ss) { const int sk = 2 * s2 + ss; const bf16x8 kf = *(const LAS bf16x8*)(kl + kt * 4096 + (((2 * sk + h) ^ ksw) * 16));
            pn[kt] = __builtin_amdgcn_mfma_f32_32x32x16_bf16(kf, qf[sk], pn[kt], 0, 0, 0); }
#pragma unroll
        for (int j = 0; j < 8; ++j) { const int i = 8 * s2 + j; float e = __builtin_amdgcn_exp2f(p[kt][i] - sub);
            if (ELEM) { const int koff = 32 * kt + (i & 3) + 8 * (i >> 2); e = valid(koff) ? e : 0.f; }
            p[kt][i] = e; ls += e; }
        const bf16x8 pb = pack8(p[kt], 8 * s2);
        asm volatile("s_waitcnt lgkmcnt(0)" ::: "memory"); __builtin_amdgcn_sched_barrier(0);
        st.o[0] = __builtin_amdgcn_mfma_f32_32x32x16_bf16(__builtin_shufflevector(l0, h0, 0, 1, 2, 3, 4, 5, 6, 7), pb, st.o[0], 0, 0, 0);
        st.o[1] = __builtin_amdgcn_mfma_f32_32x32x16_bf16(__builtin_shufflevector(l1, h1, 0, 1, 2, 3, 4, 5, 6, 7), pb, st.o[1], 0, 0, 0);
        __builtin_amdgcn_sched_barrier(0);
    }
    st.l += ls;
}
template <int XTRA, class SrcF, class FinF, class XtraF> __device__ __forceinline__ void kv_pipeline_dma(LAS unsigned char* lds, int nt, int wave, int lane, const bf16x8 (&qf)[4], SrcF src, FinF fin, XtraF xtra) {
    const bf16_t *kb, *vb; size_t kp, vp;
    asm volatile("s_waitcnt vmcnt(0) lgkmcnt(0)" ::: "memory"); __builtin_amdgcn_s_barrier();
    if (nt <= 0) return;
#pragma unroll
    for (int i = 0; i < 3; ++i) if (i < nt) { src(i, kb, kp, vb, vp); dma_tile(lds + i * DBUF, kb, kp, vb, vp, wave, lane); xtra(i, i); }
    if (nt >= 3) { if (XTRA) asm volatile("s_waitcnt vmcnt(3)" ::: "memory"); else asm volatile("s_waitcnt vmcnt(2)" ::: "memory"); }
    else asm volatile("s_waitcnt vmcnt(0)" ::: "memory");
    __builtin_amdgcn_s_barrier();
    f32x16 pc[2], pn[2];
    scores_d(pc, qf, lds, lane);
    for (int t = 0; t < nt; ++t) {
        if (t + 3 < nt) { src(t + 3, kb, kp, vb, vp); dma_tile(lds + ((t + 3) & 3) * DBUF, kb, kp, vb, vp, wave, lane); xtra(t + 3, (t + 3) & 3); }
        const int bn = (t + 1 < nt) ? ((t + 1) & 3) : (t & 3);
        fin(t, pc, lds + (t & 3) * DBUF, lds + bn * DBUF, pn, t & 3);
        if (t + 3 < nt) { if (XTRA) asm volatile("s_waitcnt vmcnt(3) lgkmcnt(0)" ::: "memory"); else asm volatile("s_waitcnt vmcnt(2) lgkmcnt(0)" ::: "memory"); }
        else asm volatile("s_waitcnt vmcnt(0) lgkmcnt(0)" ::: "memory");
        __builtin_amdgcn_s_barrier();
#pragma unroll
        for (int k = 0; k < 2; ++k) pc[k] = pn[k];
    }
}
struct NoXtra { __device__ __forceinline__ void operator()(int, int) const {} };

template <int MODE, bool HS, class MaskF> __device__ __forceinline__ void fused_np(f32x16 (&o)[2], float& l, const f32x16 (&p)[2], const LAS unsigned char* buf, int lane, bool lane_ok, float shift, MaskF valid, unsigned wlo, unsigned whi,
                                                                        const bf16x8 (&qf)[4], const LAS unsigned char* nbuf, f32x16 (&pn)[2]) {
    asm volatile("" : "+v"(lane));
    const int r = lane & 31, h = lane >> 5, blk = (lane >> 4) & 1, q4 = (lane & 15) >> 2, pp = lane & 3;
    const int ksw = (r >> 1) & 7;
    const LAS unsigned char* kl = nbuf + r * 128;
    const int vsw = 4 * ((q4 >> 1) & 1);
    const LAS unsigned char* vl = buf + 8192 + (4 * h + q4) * 128 + 8 * (pp & 1);
    const unsigned vb0 = (unsigned)(size_t)vl + ((2 * blk + (pp >> 1)) ^ vsw) * 16, vb1 = (unsigned)(size_t)vl + ((4 + 2 * blk + (pp >> 1)) ^ vsw) * 16;
    const unsigned lmask = lane_ok ? 0xffffffffu : 0u;
    float ls = 0.f;
#pragma unroll
    for (int c = 0; c < 4; ++c) {
        const int kt = c >> 1, s2 = c & 1;
        s16x4 l0, h0, l1, h1;
        asm volatile("ds_read_b64_tr_b16 %0, %4 offset:%c6\n\tds_read_b64_tr_b16 %1, %4 offset:%c7\n\tds_read_b64_tr_b16 %2, %5 offset:%c6\n\tds_read_b64_tr_b16 %3, %5 offset:%c7"
                     : "=&v"(l0), "=&v"(h0), "=&v"(l1), "=&v"(h1) : "v"(vb0), "v"(vb1), "i"((32 * (c >> 1) + 16 * (c & 1)) * 128), "i"((32 * (c >> 1) + 16 * (c & 1)) * 128 + 1024) : "memory");
#pragma unroll
        for (int ss = 0; ss < 2; ++ss) { const int sk = 2 * s2 + ss; const bf16x8 kf = *(const LAS bf16x8*)(kl + kt * 4096 + (((2 * sk + h) ^ ksw) * 16));
            if (sk == 0) { f32x16 z;
#pragma unroll
                for (int i = 0; i < 16; ++i) z[i] = 0.f;
                pn[kt] = __builtin_amdgcn_mfma_f32_32x32x16_bf16(kf, qf[sk], z, 0, 0, 0); }
            else pn[kt] = __builtin_amdgcn_mfma_f32_32x32x16_bf16(kf, qf[sk], pn[kt], 0, 0, 0); }
        float e[8];
#pragma unroll
        for (int j = 0; j < 8; ++j) { const int i = 8 * s2 + j; const int koff = 32 * kt + (i & 3) + 8 * (i >> 2); float x = __builtin_amdgcn_exp2f(HS ? p[kt][i] - shift : p[kt][i]);
            if (MODE == 1) x = valid(koff) ? x : 0.f;
            if (MODE == 2) { int tb; asm("v_bfe_i32 %0, %1, %2, 1" : "=v"(tb) : "v"(kt ? whi : wlo), "n"(koff & 31)); x = __builtin_bit_cast(float, __builtin_bit_cast(unsigned, x) & (unsigned)tb); }
            e[j] = x; }
        u32x4 pw; pw.x = pk2(e[0], e[1]) & lmask; pw.y = pk2(e[2], e[3]) & lmask; pw.z = pk2(e[4], e[5]) & lmask; pw.w = pk2(e[6], e[7]) & lmask;
#pragma unroll
        for (int j = 0; j < 8; ++j) ls += lane_ok ? e[j] : 0.f;
        const bf16x8 pb = __builtin_bit_cast(bf16x8, pw);
        asm volatile("s_waitcnt lgkmcnt(0)" ::: "memory"); __builtin_amdgcn_sched_barrier(0);
        o[0] = __builtin_amdgcn_mfma_f32_32x32x16_bf16(__builtin_shufflevector(l0, h0, 0, 1, 2, 3, 4, 5, 6, 7), pb, o[0], 0, 0, 0);
        o[1] = __builtin_amdgcn_mfma_f32_32x32x16_bf16(__builtin_shufflevector(l1, h1, 0, 1, 2, 3, 4, 5, 6, 7), pb, o[1], 0, 0, 0);
        __builtin_amdgcn_sched_barrier(0);
    }
    l += ls;
}
template <int MODE, bool HS, class MaskF> __device__ __forceinline__ void fused_lp(f32x16 (&o)[2], float& l, const f32x16 (&p)[2], const LAS unsigned char* buf, int lane, bool lane_ok, float shift, MaskF valid, unsigned wlo, unsigned whi,
                                                                        const bf16x8 (&qf)[4], const LAS unsigned char* nbuf, f32x16 (&pn)[2]) {
    asm volatile("" : "+v"(lane));
    const int r = lane & 31, h = lane >> 5, blk = (lane >> 4) & 1, q4 = (lane & 15) >> 2, pp = lane & 3;
    const int ksw = (r >> 1) & 7;
    const unsigned kl = (unsigned)(size_t)(nbuf + r * 128);
    const unsigned kx0 = ((h ^ ksw) * 16), kx1 = (((2 + h) ^ ksw) * 16);
    const unsigned kA0 = kl + kx0, kA1 = kl + kx1, kB0 = kl + (kx0 ^ 64u), kB1 = kl + (kx1 ^ 64u);
    const int vsw = 4 * ((q4 >> 1) & 1);
    const unsigned vl = (unsigned)(size_t)(buf + 8192 + (4 * h + q4) * 128 + 8 * (pp & 1));
    const unsigned vb0 = vl + ((2 * blk + (pp >> 1)) ^ vsw) * 16, vb1 = vl + ((4 + 2 * blk + (pp >> 1)) ^ vsw) * 16;
    const unsigned lmask = lane_ok ? 0xffffffffu : 0u;
    bf16x8 kf[2][2]; s16x4 vf[3][4]; bf16x8 pbp = {0, 0, 0, 0, 0, 0, 0, 0};
#define FE_ISSUE(c_, KS_, VS_) do { constexpr int kt_ = (c_) >> 1, s2_ = (c_) & 1; \
        asm volatile("ds_read_b128 %0, %6 offset:%c10\n\tds_read_b128 %1, %7 offset:%c10\n\tds_read_b64_tr_b16 %2, %8 offset:%c11\n\tds_read_b64_tr_b16 %3, %8 offset:%c12\n\tds_read_b64_tr_b16 %4, %9 offset:%c11\n\tds_read_b64_tr_b16 %5, %9 offset:%c12" \
                     : "=&v"(kf[KS_][0]), "=&v"(kf[KS_][1]), "=&v"(vf[VS_][0]), "=&v"(vf[VS_][1]), "=&v"(vf[VS_][2]), "=&v"(vf[VS_][3]) \
                     : "v"(s2_ ? kB0 : kA0), "v"(s2_ ? kB1 : kA1), "v"(vb0), "v"(vb1), "i"(kt_ * 4096), "i"((32 * kt_ + 16 * s2_) * 128), "i"((32 * kt_ + 16 * s2_) * 128 + 1024) : "memory"); } while (0)
    FE_ISSUE(0, 0, 0);
    float ls = 0.f;
#pragma unroll
    for (int c = 0; c < 4; ++c) {
        const int kt = c >> 1, s2 = c & 1, KS = c & 1, VS = c % 3, VP = (c + 2) % 3;
        asm volatile("s_waitcnt lgkmcnt(0)" ::: "memory"); __builtin_amdgcn_sched_barrier(0);
        if (c < 3) { if (c == 0) FE_ISSUE(1, 1, 1); else if (c == 1) FE_ISSUE(2, 0, 2); else FE_ISSUE(3, 1, 0); }
        if (s2 == 0) { f32x16 z;
#pragma unroll
            for (int i = 0; i < 16; ++i) z[i] = 0.f;
            pn[kt] = __builtin_amdgcn_mfma_f32_32x32x16_bf16(kf[KS][0], qf[0], z, 0, 0, 0); pn[kt] = __builtin_amdgcn_mfma_f32_32x32x16_bf16(kf[KS][1], qf[1], pn[kt], 0, 0, 0); }
        else { pn[kt] = __builtin_amdgcn_mfma_f32_32x32x16_bf16(kf[KS][0], qf[2], pn[kt], 0, 0, 0); pn[kt] = __builtin_amdgcn_mfma_f32_32x32x16_bf16(kf[KS][1], qf[3], pn[kt], 0, 0, 0); }
        if (c > 0) {
            o[0] = __builtin_amdgcn_mfma_f32_32x32x16_bf16(__builtin_shufflevector(vf[VP][0], vf[VP][1], 0, 1, 2, 3, 4, 5, 6, 7), pbp, o[0], 0, 0, 0);
            o[1] = __builtin_amdgcn_mfma_f32_32x32x16_bf16(__builtin_shufflevector(vf[VP][2], vf[VP][3], 0, 1, 2, 3, 4, 5, 6, 7), pbp, o[1], 0, 0, 0); }
        float e[8];
#pragma unroll
        for (int j = 0; j < 8; ++j) { const int i = 8 * s2 + j; const int koff = 32 * kt + (i & 3) + 8 * (i >> 2); float x = __builtin_amdgcn_exp2f(HS ? p[kt][i] - shift : p[kt][i]);
            if (MODE == 1) x = valid(koff) ? x : 0.f;
            if (MODE == 2) { int tb; asm("v_bfe_i32 %0, %1, %2, 1" : "=v"(tb) : "v"(kt ? whi : wlo), "n"(koff & 31)); x = __builtin_bit_cast(float, __builtin_bit_cast(unsigned, x) & (unsigned)tb); }
            e[j] = x; }
        u32x4 pw; pw.x = pk2(e[0], e[1]) & lmask; pw.y = pk2(e[2], e[3]) & lmask; pw.z = pk2(e[4], e[5]) & lmask; pw.w = pk2(e[6], e[7]) & lmask;
#pragma unroll
        for (int j = 0; j < 8; ++j) ls += lane_ok ? e[j] : 0.f;
#pragma unroll
        for (int g = 0; g < 4; ++g) { __builtin_amdgcn_sched_group_barrier(0x008, 1, 0); __builtin_amdgcn_sched_group_barrier(0x002, 9, 0); }
        __builtin_amdgcn_sched_barrier(0);
        pbp = __builtin_bit_cast(bf16x8, pw);
    }
    o[0] = __builtin_amdgcn_mfma_f32_32x32x16_bf16(__builtin_shufflevector(vf[0][0], vf[0][1], 0, 1, 2, 3, 4, 5, 6, 7), pbp, o[0], 0, 0, 0);
    o[1] = __builtin_amdgcn_mfma_f32_32x32x16_bf16(__builtin_shufflevector(vf[0][2], vf[0][3], 0, 1, 2, 3, 4, 5, 6, 7), pbp, o[1], 0, 0, 0);
#undef FE_ISSUE
    l += ls;
}
template <int MODE, bool HS, bool LP, class MaskF> __device__ __forceinline__ void fused_e(f32x16 (&o)[2], float& l, const f32x16 (&p)[2], const LAS unsigned char* buf, int lane, bool lane_ok, float shift, MaskF valid, unsigned wlo, unsigned whi,
                                                                        const bf16x8 (&qf)[4], const LAS unsigned char* nbuf, f32x16 (&pn)[2]) {
    if constexpr (LP) fused_lp<MODE, HS>(o, l, p, buf, lane, lane_ok, shift, valid, wlo, whi, qf, nbuf, pn); else fused_np<MODE, HS>(o, l, p, buf, lane, lane_ok, shift, valid, wlo, whi, qf, nbuf, pn);
}
template <int XTRA, class SrcF, class FinF, class XtraF> __device__ __forceinline__ void kv_pipeline_dma2(LAS unsigned char* lds, int nt, int wave, int lane, const bf16x8 (&qf)[4], SrcF src, FinF fin, XtraF xtra) {
    const bf16_t *kb, *vb; size_t kp, vp;
    asm volatile("s_waitcnt vmcnt(0) lgkmcnt(0)" ::: "memory"); __builtin_amdgcn_s_barrier();
    if (nt <= 0) return;
#pragma unroll
    for (int i = 0; i < 3; ++i) if (i < nt) { src(i, kb, kp, vb, vp); dma_tile(lds + i * DBUF, kb, kp, vb, vp, wave, lane); xtra(i, i); }
    if (nt >= 3) { if (XTRA) asm volatile("s_waitcnt vmcnt(3)" ::: "memory"); else asm volatile("s_waitcnt vmcnt(2)" ::: "memory"); }
    else asm volatile("s_waitcnt vmcnt(0)" ::: "memory");
    __builtin_amdgcn_s_barrier();
    f32x16 pa[2], pb[2];
    scores_d(pa, qf, lds, lane);
#define KVD2_STEP(PC, PN) do { \
        if (t + 3 < nt) { src(t + 3, kb, kp, vb, vp); dma_tile(lds + ((t + 3) & 3) * DBUF, kb, kp, vb, vp, wave, lane); xtra(t + 3, (t + 3) & 3); } \
        const int bn_ = (t + 1 < nt) ? ((t + 1) & 3) : (t & 3); \
        fin(t, PC, lds + (t & 3) * DBUF, lds + bn_ * DBUF, PN, t & 3); \
        if (t + 3 < nt) { if (XTRA) asm volatile("s_waitcnt vmcnt(3) lgkmcnt(0)" ::: "memory"); else asm volatile("s_waitcnt vmcnt(2) lgkmcnt(0)" ::: "memory"); } \
        else asm volatile("s_waitcnt vmcnt(0) lgkmcnt(0)" ::: "memory"); \
        __builtin_amdgcn_s_barrier(); ++t; } while (0)
    int t = 0;
    while (t < nt) { KVD2_STEP(pa, pb); if (t >= nt) break; KVD2_STEP(pb, pa); }
#undef KVD2_STEP
}
__device__ __forceinline__ float gain_max64(const float* g) { float m = 0.f; for (int i = 0; i < 64; ++i) m = fmaxf(m, fabsf(g[i])); return m; }
__device__ __forceinline__ float softmax_shift(float gq, float gk) { const float B = 8.0f * LOG2E * gq * gk * 1.02f; return B > 60.f ? B - 60.f : 0.f; }

template <int MODE, bool HS, class MaskF> __device__ __forceinline__ void half_v(u32x4 (&pw)[4], float& l, const f32x16 (&p)[2], bool lane_ok, float shift, MaskF valid, unsigned wlo, unsigned whi) {
    const unsigned lmask = lane_ok ? 0xffffffffu : 0u; float ls = 0.f;
#pragma unroll
    for (int c = 0; c < 4; ++c) { const int kt = c >> 1, s2 = c & 1; float e[8];
#pragma unroll
        for (int j = 0; j < 8; ++j) { const int i = 8 * s2 + j; const int koff = 32 * kt + (i & 3) + 8 * (i >> 2); float x = __builtin_amdgcn_exp2f(HS ? p[kt][i] - shift : p[kt][i]);
            if (MODE == 1) x = valid(koff) ? x : 0.f;
            if (MODE == 2) { int tb; asm("v_bfe_i32 %0, %1, %2, 1" : "=v"(tb) : "v"(kt ? whi : wlo), "n"(koff & 31)); x = __builtin_bit_cast(float, __builtin_bit_cast(unsigned, x) & (unsigned)tb); }
            e[j] = x; ls += x; }
        pw[c].x = pk2(e[0], e[1]) & lmask; pw[c].y = pk2(e[2], e[3]) & lmask; pw[c].z = pk2(e[4], e[5]) & lmask; pw[c].w = pk2(e[6], e[7]) & lmask; }
    l += lane_ok ? ls : 0.f;
}
__device__ __forceinline__ void half_m(f32x16 (&o)[2], const u32x4 (&pw)[4], const LAS unsigned char* buf, const LAS unsigned char* nbuf, const bf16x8 (&qf)[4], f32x16 (&pn)[2], bool do_scores, int lane) {
    asm volatile("" : "+v"(lane));
    const int r = lane & 31, h = lane >> 5, blk = (lane >> 4) & 1, q4 = (lane & 15) >> 2, pp = lane & 3;
    const int ksw = (r >> 1) & 7;
    const unsigned kl = (unsigned)(size_t)(nbuf + r * 128);
    const unsigned kx0 = ((h ^ ksw) * 16), kx1 = (((2 + h) ^ ksw) * 16);
    const unsigned kA0 = kl + kx0, kA1 = kl + kx1, kB0 = kl + (kx0 ^ 64u), kB1 = kl + (kx1 ^ 64u);
    const int vsw = 4 * ((q4 >> 1) & 1);
    const unsigned vl = (unsigned)(size_t)(buf + 8192 + (4 * h + q4) * 128 + 8 * (pp & 1));
    const unsigned vb0 = vl + ((2 * blk + (pp >> 1)) ^ vsw) * 16, vb1 = vl + ((4 + 2 * blk + (pp >> 1)) ^ vsw) * 16;
    bf16x8 kf[8]; s16x4 vf[16];
    if (do_scores) {
        asm volatile("ds_read_b128 %0, %8\n\tds_read_b128 %1, %9\n\tds_read_b128 %2, %10\n\tds_read_b128 %3, %11\n\tds_read_b128 %4, %8 offset:4096\n\tds_read_b128 %5, %9 offset:4096\n\tds_read_b128 %6, %10 offset:4096\n\tds_read_b128 %7, %11 offset:4096"
                     : "=&v"(kf[0]), "=&v"(kf[1]), "=&v"(kf[2]), "=&v"(kf[3]), "=&v"(kf[4]), "=&v"(kf[5]), "=&v"(kf[6]), "=&v"(kf[7]) : "v"(kA0), "v"(kA1), "v"(kB0), "v"(kB1) : "memory");
    }
#define HM_V(c_) asm volatile("ds_read_b64_tr_b16 %0, %4 offset:%c6\n\tds_read_b64_tr_b16 %1, %4 offset:%c7\n\tds_read_b64_tr_b16 %2, %5 offset:%c6\n\tds_read_b64_tr_b16 %3, %5 offset:%c7" \
                     : "=&v"(vf[4 * (c_)]), "=&v"(vf[4 * (c_) + 1]), "=&v"(vf[4 * (c_) + 2]), "=&v"(vf[4 * (c_) + 3]) : "v"(vb0), "v"(vb1), "i"((32 * ((c_) >> 1) + 16 * ((c_) & 1)) * 128), "i"((32 * ((c_) >> 1) + 16 * ((c_) & 1)) * 128 + 1024) : "memory")
    asm volatile("s_waitcnt lgkmcnt(0)" ::: "memory"); __builtin_amdgcn_sched_barrier(0);
    HM_V(0); HM_V(1); HM_V(2); HM_V(3);
#undef HM_V
    if (do_scores) {
#pragma unroll
        for (int kt = 0; kt < 2; ++kt) { f32x16 z;
#pragma unroll
            for (int i = 0; i < 16; ++i) z[i] = 0.f;
            z = __builtin_amdgcn_mfma_f32_32x32x16_bf16(kf[4 * kt + 0], qf[0], z, 0, 0, 0);
            z = __builtin_amdgcn_mfma_f32_32x32x16_bf16(kf[4 * kt + 1], qf[1], z, 0, 0, 0);
            z = __builtin_amdgcn_mfma_f32_32x32x16_bf16(kf[4 * kt + 2], qf[2], z, 0, 0, 0);
            z = __builtin_amdgcn_mfma_f32_32x32x16_bf16(kf[4 * kt + 3], qf[3], z, 0, 0, 0);
            pn[kt] = z; }
    }
    asm volatile("s_waitcnt lgkmcnt(0)" ::: "memory"); __builtin_amdgcn_sched_barrier(0);
#pragma unroll
    for (int c = 0; c < 4; ++c) { const bf16x8 pb = __builtin_bit_cast(bf16x8, pw[c]);
        o[0] = __builtin_amdgcn_mfma_f32_32x32x16_bf16(__builtin_shufflevector(vf[4 * c], vf[4 * c + 1], 0, 1, 2, 3, 4, 5, 6, 7), pb, o[0], 0, 0, 0);
        o[1] = __builtin_amdgcn_mfma_f32_32x32x16_bf16(__builtin_shufflevector(vf[4 * c + 2], vf[4 * c + 3], 0, 1, 2, 3, 4, 5, 6, 7), pb, o[1], 0, 0, 0); }
}
template <int XTRA, class SrcF, class VF, class XtraF> __device__ __forceinline__ void kv_pipeline_ab(LAS unsigned char* lds, int nt, int wave, int lane, const bf16x8 (&qf)[4], f32x16 (&o)[2], SrcF src, VF vhalf, XtraF xtra) {
    const bf16_t *kb, *vb; size_t kp, vp;
    asm volatile("s_waitcnt vmcnt(0) lgkmcnt(0)" ::: "memory"); __builtin_amdgcn_s_barrier();
    if (nt <= 0) return;
#pragma unroll
    for (int i = 0; i < 3; ++i) if (i < nt) { src(i, kb, kp, vb, vp); dma_tile(lds + i * DBUF, kb, kp, vb, vp, wave, lane); xtra(i, i); }
    if (nt >= 3) { if (XTRA) asm volatile("s_waitcnt vmcnt(3)" ::: "memory"); else asm volatile("s_waitcnt vmcnt(2)" ::: "memory"); }
    else asm volatile("s_waitcnt vmcnt(0)" ::: "memory");
    __builtin_amdgcn_s_barrier();
    f32x16 pc[2]; scores_d(pc, qf, lds, lane);
    asm volatile("s_waitcnt lgkmcnt(0)" ::: "memory");
    const bool grpB = (wave & 4) != 0;
    if (grpB) __builtin_amdgcn_s_barrier();
    u32x4 pw[4];
    for (int t = 0; t < nt; ++t) {
        vhalf(t, pc, pw, t & 3);
        asm volatile("s_waitcnt lgkmcnt(0)" ::: "memory"); __builtin_amdgcn_s_barrier();
        if (t + 3 < nt) { src(t + 3, kb, kp, vb, vp); dma_tile(lds + ((t + 3) & 3) * DBUF, kb, kp, vb, vp, wave, lane); xtra(t + 3, (t + 3) & 3); }
        half_m(o, pw, lds + (t & 3) * DBUF, lds + ((t + 1) & 3) * DBUF, qf, pc, t + 1 < nt, lane);
        if (t + 3 < nt) { if (XTRA) asm volatile("s_waitcnt vmcnt(3) lgkmcnt(0)" ::: "memory"); else asm volatile("s_waitcnt vmcnt(2) lgkmcnt(0)" ::: "memory"); }
        else asm volatile("s_waitcnt vmcnt(0) lgkmcnt(0)" ::: "memory");
        __builtin_amdgcn_s_barrier();
    }
    if (!grpB) __builtin_amdgcn_s_barrier();
}

template <int XTRA, class SrcF, class FinF, class XtraF> __device__ __forceinline__ void kv_pipeline_dma8(LAS unsigned char* lds, int nt, int wave, int lane, const bf16x8 (&qf)[4], SrcF src, FinF fin, XtraF xtra) {
    const bf16_t *kb, *vb; size_t kp, vp;
    asm volatile("s_waitcnt vmcnt(0) lgkmcnt(0)" ::: "memory"); __builtin_amdgcn_s_barrier();
    if (nt <= 0) return;
#define KV8_WAIT(n_) do { const int na_ = (n_); \
        if (XTRA) { if (na_ >= 3) asm volatile("s_waitcnt vmcnt(9) lgkmcnt(0)" ::: "memory"); else if (na_ == 2) asm volatile("s_waitcnt vmcnt(6) lgkmcnt(0)" ::: "memory"); else if (na_ == 1) asm volatile("s_waitcnt vmcnt(3) lgkmcnt(0)" ::: "memory"); else asm volatile("s_waitcnt vmcnt(0) lgkmcnt(0)" ::: "memory"); } \
        else { if (na_ >= 3) asm volatile("s_waitcnt vmcnt(6) lgkmcnt(0)" ::: "memory"); else if (na_ == 2) asm volatile("s_waitcnt vmcnt(4) lgkmcnt(0)" ::: "memory"); else if (na_ == 1) asm volatile("s_waitcnt vmcnt(2) lgkmcnt(0)" ::: "memory"); else asm volatile("s_waitcnt vmcnt(0) lgkmcnt(0)" ::: "memory"); } } while (0)
#pragma unroll
    for (int i = 0; i < 6; ++i) if (i < nt) { src(i, kb, kp, vb, vp); dma_tile(lds + i * DBUF, kb, kp, vb, vp, wave, lane); xtra(i, i); }
    { const int iss = nt < 6 ? nt : 6; KV8_WAIT(iss > 3 ? iss - 3 : 0); }
    __builtin_amdgcn_s_barrier();
    f32x16 pa[2], pb[2];
    scores_d(pa, qf, lds, lane);
    int t = 0;
    while (true) {
        if (t + 6 < nt) { src(t + 6, kb, kp, vb, vp); dma_tile(lds + ((t + 6) & 7) * DBUF, kb, kp, vb, vp, wave, lane); xtra(t + 6, (t + 6) & 7); }
        { const int bn_ = (t + 1 < nt) ? ((t + 1) & 7) : (t & 7); fin(t, pa, lds + (t & 7) * DBUF, lds + bn_ * DBUF, pb, t & 7); }
        if (t + 1 >= nt) break;
        if (t + 7 < nt) { src(t + 7, kb, kp, vb, vp); dma_tile(lds + ((t + 7) & 7) * DBUF, kb, kp, vb, vp, wave, lane); xtra(t + 7, (t + 7) & 7); }
        { const int bn_ = (t + 2 < nt) ? ((t + 2) & 7) : ((t + 1) & 7); fin(t + 1, pb, lds + ((t + 1) & 7) * DBUF, lds + bn_ * DBUF, pa, (t + 1) & 7); }
        { const int rem = nt - (t + 5); KV8_WAIT(rem < 0 ? 0 : (rem > 3 ? 3 : rem)); }
        __builtin_amdgcn_s_barrier();
        t += 2; if (t >= nt) break;
    }
    asm volatile("s_waitcnt vmcnt(0) lgkmcnt(0)" ::: "memory"); __builtin_amdgcn_s_barrier();
#undef KV8_WAIT
}
template <int HD> __device__ __forceinline__ void store_o(const f32x16 (&o)[HD / 32], float f, bf16_t* orow, int lane) {
    const int h = lane >> 5;
#pragma unroll
    for (int dh = 0; dh < HD / 32; ++dh)
#pragma unroll
        for (int g = 0; g < 4; ++g) { u32x2 w; w.x = pk2(o[dh][4 * g] * f, o[dh][4 * g + 1] * f); w.y = pk2(o[dh][4 * g + 2] * f, o[dh][4 * g + 3] * f);
            *(u32x2*)(orow + 32 * dh + 8 * g + 4 * h) = w; }
}

template <int HD> __device__ __forceinline__ void store_o_t(const f32x16 (&o)[HD / 32], float f, bf16_t* base, size_t ld, LAS unsigned char* scr, int lane) {
    constexpr int PITCH = HD * 2 + 16;
    asm volatile("" : "+v"(lane));
    const int r = lane & 31, h = lane >> 5;
#pragma unroll
    for (int dh = 0; dh < HD / 32; ++dh)
#pragma unroll
        for (int g = 0; g < 4; ++g) { u32x2 w; w.x = pk2(o[dh][4 * g] * f, o[dh][4 * g + 1] * f); w.y = pk2(o[dh][4 * g + 2] * f, o[dh][4 * g + 3] * f);
            *(LAS u32x2*)(scr + r * PITCH + (32 * dh + 8 * g + 4 * h) * 2) = w; }
    asm volatile("s_waitcnt lgkmcnt(0)" ::: "memory");
    constexpr int CPR = HD / 8;
#pragma unroll
    for (int i = 0; i < (32 * CPR) / 64; ++i) { const int idx = lane + 64 * i, row = idx / CPR, c = idx % CPR;
        const u32x4 v = *(const LAS u32x4*)(scr + row * PITCH + c * 16);
        *(u32x4*)(base + (size_t)row * ld + c * 8) = v; }
}
}


__device__ __forceinline__ float row_rstd(const float* rsq, int row) {
    const f32x4* pr = (const f32x4*)(rsq + (size_t)row * 16); const f32x4 a = pr[0], b = pr[1], c = pr[2], d = pr[3];
    const float ss = (((a[0] + a[1]) + (a[2] + a[3])) + ((b[0] + b[1]) + (b[2] + b[3]))) + (((c[0] + c[1]) + (c[2] + c[3])) + ((d[0] + d[1]) + (d[2] + d[3])));
    return __builtin_amdgcn_rsqf(ss * (1.0f / 1024.0f) + RMS_EPS);
}
__device__ __forceinline__ void unpack8(const u32x4 w, float (&f)[8]) {
#pragma unroll
    for (int j = 0; j < 4; ++j) { f[2 * j] = __builtin_bit_cast(float, w[j] << 16); f[2 * j + 1] = __builtin_bit_cast(float, w[j] & 0xffff0000u); } }
__device__ __forceinline__ u32x4 pack8f(const float (&f)[8]) { u32x4 o; o.x = pk2(f[0], f[1]); o.y = pk2(f[2], f[3]); o.z = pk2(f[4], f[5]); o.w = pk2(f[6], f[7]); return o; }
__device__ __forceinline__ void head_norm64(float (&f)[8], const float* gain, float extra, int lane) {
    float ss = 0.f;
#pragma unroll
    for (int j = 0; j < 8; ++j) ss += f[j] * f[j];
    ss += __shfl_xor(ss, 1); ss += __shfl_xor(ss, 2); ss += __shfl_xor(ss, 4);
    const float rn = __builtin_amdgcn_rsqf(ss * (1.0f / 64.0f) + RMS_EPS) * extra; const float* gn = gain + (lane & 7) * 8;
#pragma unroll
    for (int j = 0; j < 8; ++j) f[j] = f[j] * rn * gn[j];
}
__device__ __forceinline__ void head_rope64(float (&f)[8], const float* cs, int lane) {
    float oth[8];
#pragma unroll
    for (int j = 0; j < 8; ++j) oth[j] = __shfl_xor(f[j], 1);
    const int li = lane & 7;
    if (li < 2) {
#pragma unroll
        for (int j = 0; j < 8; ++j) { const float c = cs[j], sn = cs[8 + j]; f[j] = (li == 0) ? f[j] * c - oth[j] * sn : f[j] * c + oth[j] * sn; }
    }
}

__device__ __forceinline__ int wave_sum_i(int x) {
    x += __builtin_amdgcn_update_dpp(0, x, 0x111, 0xf, 0xf, true);
    x += __builtin_amdgcn_update_dpp(0, x, 0x112, 0xf, 0xf, true);
    x += __builtin_amdgcn_update_dpp(0, x, 0x114, 0xf, 0xf, true);
    x += __builtin_amdgcn_update_dpp(0, x, 0x118, 0xf, 0xf, true);
    x += __builtin_amdgcn_update_dpp(0, x, 0x142, 0xa, 0xf, true);
    x += __builtin_amdgcn_update_dpp(0, x, 0x143, 0xc, 0xf, true);
    return __builtin_amdgcn_readlane(x, 63);
}

__device__ __forceinline__ int cnt_ge(unsigned u, unsigned cand, int c) {
    int r; asm("v_cmp_ge_u32 vcc, %1, %2\n\tv_addc_co_u32 %0, vcc, 0, %3, vcc" : "=v"(r) : "v"(u), "v"(cand), "v"(c) : "vcc"); return r; }

__device__ __forceinline__ int cnt_ge16(const unsigned* u, unsigned cand, int c) {
    asm("v_cmp_ge_u32 vcc, %1, %17\n\tv_addc_co_u32 %0, vcc, 0, %0, vcc\n\tv_cmp_ge_u32 vcc, %2, %17\n\tv_addc_co_u32 %0, vcc, 0, %0, vcc\n\t"
        "v_cmp_ge_u32 vcc, %3, %17\n\tv_addc_co_u32 %0, vcc, 0, %0, vcc\n\tv_cmp_ge_u32 vcc, %4, %17\n\tv_addc_co_u32 %0, vcc, 0, %0, vcc\n\t"
        "v_cmp_ge_u32 vcc, %5, %17\n\tv_addc_co_u32 %0, vcc, 0, %0, vcc\n\tv_cmp_ge_u32 vcc, %6, %17\n\tv_addc_co_u32 %0, vcc, 0, %0, vcc\n\t"
        "v_cmp_ge_u32 vcc, %7, %17\n\tv_addc_co_u32 %0, vcc, 0, %0, vcc\n\tv_cmp_ge_u32 vcc, %8, %17\n\tv_addc_co_u32 %0, vcc, 0, %0, vcc\n\t"
        "v_cmp_ge_u32 vcc, %9, %17\n\tv_addc_co_u32 %0, vcc, 0, %0, vcc\n\tv_cmp_ge_u32 vcc, %10, %17\n\tv_addc_co_u32 %0, vcc, 0, %0, vcc\n\t"
        "v_cmp_ge_u32 vcc, %11, %17\n\tv_addc_co_u32 %0, vcc, 0, %0, vcc\n\tv_cmp_ge_u32 vcc, %12, %17\n\tv_addc_co_u32 %0, vcc, 0, %0, vcc\n\t"
        "v_cmp_ge_u32 vcc, %13, %17\n\tv_addc_co_u32 %0, vcc, 0, %0, vcc\n\tv_cmp_ge_u32 vcc, %14, %17\n\tv_addc_co_u32 %0, vcc, 0, %0, vcc\n\t"
        "v_cmp_ge_u32 vcc, %15, %17\n\tv_addc_co_u32 %0, vcc, 0, %0, vcc\n\tv_cmp_ge_u32 vcc, %16, %17\n\tv_addc_co_u32 %0, vcc, 0, %0, vcc"
        : "+v"(c) : "v"(u[0]), "v"(u[1]), "v"(u[2]), "v"(u[3]), "v"(u[4]), "v"(u[5]), "v"(u[6]), "v"(u[7]), "v"(u[8]), "v"(u[9]), "v"(u[10]), "v"(u[11]), "v"(u[12]), "v"(u[13]), "v"(u[14]), "v"(u[15]), "v"(cand) : "vcc");
    return c;
}
struct Args { const void* in[32]; float* out; unsigned char* ws; int ph_lo, ph_hi, li, pad; };

template <class CMap>
__device__ __forceinline__ void transpose_item(const float* W, int K, int N, bf16_t* WT, const float* gain, LAS float* scr, int kb, int nb, int lane, CMap cmap) {
    const int k0 = 64 * kb, n0 = 32 * nb, n4 = (lane & 7) * 4; const int c = cmap(n0 + n4);
    f32x4 v[8]; float gk[8];
#pragma unroll
    for (int i = 0; i < 8; ++i) { const int kk = (lane >> 3) + 8 * i; v[i] = (f32x4){0.f, 0.f, 0.f, 0.f}; gk[i] = 1.f;
        if (c >= 0) { v[i] = *(const f32x4*)(W + (size_t)(k0 + kk) * N + c); if (gain) gk[i] = gain[k0 + kk]; } }
#pragma unroll
    for (int i = 0; i < 8; ++i) { const int kk = (lane >> 3) + 8 * i; *(LAS f32x4*)(scr + kk * 36 + n4) = v[i] * gk[i]; }
    asm volatile("s_waitcnt lgkmcnt(0)" ::: "memory");
    const int ch = lane & 7;
#pragma unroll
    for (int j = 0; j < 4; ++j) { const int n = (lane >> 3) + 8 * j; const LAS float* s = scr + (8 * ch) * 36 + n;
        u32x4 o; o.x = pk2(s[0 * 36], s[1 * 36]); o.y = pk2(s[2 * 36], s[3 * 36]); o.z = pk2(s[4 * 36], s[5 * 36]); o.w = pk2(s[6 * 36], s[7 * 36]);
        *(u32x4*)(WT + (size_t)(n0 + n) * K + k0 + 8 * ch) = o; }
    asm volatile("s_waitcnt lgkmcnt(0)" ::: "memory");
}

struct CMapId { int n; __device__ __forceinline__ int operator()(int p) const { return p < n ? p : -1; } };
struct CMapProj0 { __device__ __forceinline__ int operator()(int p) const { const int o = p & 255, c = 64 * (4 * (p >> 8) + ((o >> 5) & 3)) + 8 * (2 * ((o >> 3) & 3) + (o >> 7)) + (o & 7);
    if (c < 936) return c; if (c < 960) return -1; return (c - 24 < AB_W) ? c - 24 : -1; } };
struct CMapProj1 { __device__ __forceinline__ int operator()(int p) const { const int o = p & 255, c = 64 * (4 * (p >> 8) + ((o >> 5) & 3)) + 8 * (2 * ((o >> 3) & 3) + (o >> 7)) + (o & 7); return c < C_W ? c : -1; } };
struct CMapFfn { __device__ __forceinline__ int operator()(int p) const { const int t = p >> 8, r = p & 255; return r < 128 ? t * 128 + r : DFF + t * 128 + (r - 128); } };

#ifndef PIPE_MEM
#define PIPE_MEM false
#endif
#ifndef PIPE_DSA
#define PIPE_DSA true
#endif
#ifndef PIPE_MOBA
#define PIPE_MOBA false
#endif
#ifndef PIPE_SEL
#define PIPE_SEL true
#endif
#ifndef PIPE_WIN
#define PIPE_WIN true
#endif
#ifndef LP_L0
#define LP_L0 true
#endif
#ifndef LP_NSA
#define LP_NSA false
#endif
#ifndef AB_L0
#define AB_L0 0
#endif
#ifndef PROBE_MASK
#define PROBE_MASK 0u
#endif
#define REPS(k) (((PROBE_MASK >> (k)) & 1u) ? 2 : 1)
#define RUN(k) (lo <= (k) && (k) < hi)
#define SEAM(k) do { if ((k) + 1 < hi) xcd_barrier(bar); } while (0)
#define INF_(k) ((const float*)args.in[k])
#define x_in INF_(0)
#define mem_in INF_(1)
#define positions ((const int*)args.in[2])
#define norm_mix INF_(3)
#define norm_mem INF_(4)
#define norm_mem_src INF_(5)
#define norm_ffn INF_(6)
#define ab_w_in INF_(7)
#define ab_w_out INF_(8)
#define nsa_w_in INF_(13)
#define nsa_w_out INF_(14)
#define mem_w_q INF_(25)
#define mem_w_kv INF_(26)
#define mem_w_o INF_(27)
#define ffn_w_in INF_(30)
#define ffn_w_out INF_(31)
#define out (args.out)
#define WSB(off) ((bf16_t*)(args.ws + (off)))
#define W_AB WSB(WS_WAB)
#define W_C WSB(WS_WC)
#define W_ABO WSB(WS_WABO)
#define W_CO WSB(WS_WCO)
#define W_MQ WSB(WS_WMQ)
#define W_KV WSB(WS_WKV)
#define W_MO WSB(WS_WMO)
#define W_FI WSB(WS_WFI)
#define W_FO WSB(WS_WFO)
#define XB WSB(WS_XB)
#define RSQ ((float*)(args.ws + WS_RSQ))
#define HID WSB(WS_R1)
#define MEMB WSB(WS_MEMB)
#define KVRAW WSB(WS_KVRAW)
#define MRS ((float*)(args.ws + WS_MRS))
#define MQB WSB(WS_MQ)
#define OMEM WSB(WS_OMEM)
#define mem_q_norm INF_(28)
#define RAW WSB(WS_R1)
#define OATT WSB(WS_OATT)
#define ROPE64 ((float*)(args.ws + WS_ROPE64))
#define ROPE32 ((float*)(args.ws + WS_ROPE32))
#define W1T WSB(WS_W1T)
#define POSW1 ((float*)(args.ws + WS_POSW1))
#define KCMP WSB(WS_KCMP)
#define VCMP WSB(WS_VCMP)
#define GT ((float*)(args.ws + WS_GT))
#define SCR ((float*)(args.ws + WS_SC))
#define BMK ((unsigned long long*)(args.ws + WS_BM))
#define KMEAN ((float*)(args.ws + WS_KM))
#define IWB ((float*)(args.ws + WS_ISG))
#define dsa_q_norm INF_(9)
#define dsa_k_norm INF_(10)
#define moba_q_norm INF_(11)
#define moba_k_norm INF_(12)
#define nsa_q_norm INF_(15)
#define nsa_kcmp_norm INF_(16)
#define nsa_ksel_norm INF_(17)
#define nsa_kwin_norm INF_(18)
#define nsa_cmp_pos_k INF_(19)
#define nsa_cmp_pos_v INF_(20)
#define nsa_cmp_w1_k INF_(21)
#define nsa_cmp_w2_k INF_(22)
#define nsa_cmp_w1_v INF_(23)
#define nsa_cmp_w2_v INF_(24)
#define mem_k_norm INF_(29)
template <int L> __device__ __forceinline__ void layer_phases(const Args& args, LAS unsigned char* lds, const XcdBarrier& bar, const int lo, const int hi, const int wave) {
    const int G = gridDim.x, bid = blockIdx.x;
    constexpr int pb = 1 + 10 * L;
        if (RUN(pb + 0)) for (int rep_ = 0; rep_ < REPS(pb + 0); ++rep_) {
            int lane = (int)__builtin_amdgcn_mbcnt_hi(~0u, __builtin_amdgcn_mbcnt_lo(~0u, 0u)); asm volatile("" : "+v"(lane)); const int tid = wave * 64 + lane;
            if (L == 0) {
                pg8::Gemm g{MEMB, W_KV, MMEM, 2048, DM}; pg8::StaticOrder S; S.init(MMEM, 2048, G, bid);
                pg8::EpiPlain E{KVRAW, 2048};
                pg8::gemm_phase<pg8::EpiPlain, pg8::StaticOrder, true, true>(lds, g, S, E, wave);
            }
            if (L == 0) {
                pg8::Gemm g{XB, W_AB, MTOK, AB_WP, DM}; pg8::StaticOrder S; S.init(MTOK, AB_WP, G, bid);
                pg8::EpiProj<0> E{RAW, AB_WP, RSQ, ROPE64, ROPE32, dsa_q_norm, dsa_k_norm, moba_q_norm, moba_k_norm, IWB};
                pg8::gemm_phase<pg8::EpiProj<0>, pg8::StaticOrder, true, true>(lds, g, S, E, wave);
            }
            if (L == 1) {
                pg8::Gemm g{XB, W_C, MTOK, C_WP, DM}; pg8::StaticOrder S; S.init(MTOK, C_WP, G, bid);
                pg8::EpiProj<1> E{RAW, C_WP, RSQ, ROPE64, ROPE32, nsa_q_norm, nsa_ksel_norm, nsa_kwin_norm, nullptr, GT};
                pg8::gemm_phase<pg8::EpiProj<1>, pg8::StaticOrder, true, true>(lds, g, S, E, wave);
            }
            SEAM(pb + 0);
        }
        if (RUN(pb + 1)) for (int rep_ = 0; rep_ < REPS(pb + 1); ++rep_) {
            int lane = (int)__builtin_amdgcn_mbcnt_hi(~0u, __builtin_amdgcn_mbcnt_lo(~0u, 0u)); asm volatile("" : "+v"(lane)); const int tid = wave * 64 + lane;
            if (L == 1) {
                LAS float* PART = (LAS float*)lds;
                LAS float* HB = (LAS float*)(lds + 65536);
                LAS float* W2S = (LAS float*)(lds + 65536 + 8448);
                for (int u = bid; u < BATCH * 4 * 2 * 8; u += G) {
                    const int ch = u & 7, kv = (u >> 3) & 1, g = (u >> 4) & 3, b = u >> 6;
                    const int r = lane & 31, h = lane >> 5, n0 = ch * 32;
                    const bf16_t* xb0 = RAW + (size_t)(b * SEQ + 16 * (n0 + r)) * C_WP + (kv ? 1280 : 1024) + g * 64 + 8 * h;
                    const bf16_t* wt = W1T + (size_t)kv * 64 * 2048 + 8 * h;
                    f32x16 acc[2];
#pragma unroll
                    for (int i = 0; i < 16; ++i) { acc[0][i] = 0.f; acc[1][i] = 0.f; }
                    const bool rowok = (n0 + r) < 255;
                    float rsl[4];
#pragma unroll
                    for (int li = 0; li < 4; ++li) rsl[li] = rowok ? row_rstd(RSQ, b * SEQ + 16 * (n0 + r) + wave * 4 + li) : 0.f;
#pragma unroll
                    for (int li = 0; li < 4; ++li) { const int l = wave * 4 + li;
#pragma unroll
                        for (int s2 = 0; s2 < 4; ++s2) {
                            bf16x8 a = {0, 0, 0, 0, 0, 0, 0, 0};
                            if (rowok) { float f[8]; unpack8(*(const u32x4*)(xb0 + (size_t)l * C_WP + 16 * s2), f);
#pragma unroll
                                for (int j = 0; j < 8; ++j) f[j] *= rsl[li];
                                a = __builtin_bit_cast(bf16x8, pack8f(f)); }
                            const bf16x8 b0 = *(const bf16x8*)(wt + (size_t)r * 2048 + l * 64 + 16 * s2), b1 = *(const bf16x8*)(wt + (size_t)(32 + r) * 2048 + l * 64 + 16 * s2);
                            acc[0] = __builtin_amdgcn_mfma_f32_32x32x16_bf16(a, b0, acc[0], 0, 0, 0); acc[1] = __builtin_amdgcn_mfma_f32_32x32x16_bf16(a, b1, acc[1], 0, 0, 0); } }
                    __syncthreads();
#pragma unroll
                    for (int nh = 0; nh < 2; ++nh)
#pragma unroll
                        for (int i = 0; i < 16; ++i) PART[wave * 2048 + ((i & 3) + 8 * (i >> 2) + 4 * h) * 64 + nh * 32 + r] = acc[nh][i];
                    { const float* w2 = kv ? nsa_cmp_w2_v : nsa_cmp_w2_k; const f32x4 wa = *(const f32x4*)(w2 + tid * 4), wb = *(const f32x4*)(w2 + 2048 + tid * 4);
                      *(LAS f32x4*)(W2S + tid * 4) = wa; *(LAS f32x4*)(W2S + 2048 + tid * 4) = wb; }
                    __syncthreads();
                    const float pw1 = POSW1[kv * 64 + (tid & 63)];
                    for (int i = tid; i < 2048; i += 512) { float a = pw1;
#pragma unroll
                        for (int w = 0; w < 8; ++w) a += PART[w * 2048 + i];
                        HB[(i >> 6) * 65 + (i & 63)] = a / (1.0f + __expf(-a)); }
                    __syncthreads();
                    { const int n = tid >> 4, c4 = (tid & 15) * 4; float o[4] = {0.f, 0.f, 0.f, 0.f};
                        for (int c = 0; c < 64; ++c) { const float hv = HB[n * 65 + c]; const f32x4 w = *(const LAS f32x4*)(W2S + c * 64 + c4); o[0] += hv * w[0]; o[1] += hv * w[1]; o[2] += hv * w[2]; o[3] += hv * w[3]; }
                        if (kv == 0) { float ss = (o[0] * o[0] + o[1] * o[1]) + (o[2] * o[2] + o[3] * o[3]);
                            ss += __shfl_xor(ss, 1); ss += __shfl_xor(ss, 2); ss += __shfl_xor(ss, 4); ss += __shfl_xor(ss, 8);
                            const float rn = __builtin_amdgcn_rsqf(ss * (1.0f / 64.0f) + RMS_EPS);
#pragma unroll
                            for (int j = 0; j < 4; ++j) o[j] = o[j] * rn * nsa_kcmp_norm[c4 + j]; }
                        if (n0 + n >= 255) { o[0] = o[1] = o[2] = o[3] = 0.f; }
                        u32x2 w; w.x = pk2(o[0], o[1]); w.y = pk2(o[2], o[3]);
                        *(u32x2*)((kv ? VCMP : KCMP) + ((size_t)(b * 4 + g) * 256 + n0 + n) * 64 + c4) = w; }
                    __syncthreads();
                }
            }
            if (L == 1) SEAM(pb + 1);
        }
        if (RUN(pb + 2)) for (int rep_ = 0; rep_ < REPS(pb + 2); ++rep_) {
            int lane = (int)__builtin_amdgcn_mbcnt_hi(~0u, __builtin_amdgcn_mbcnt_lo(~0u, 0u)); asm volatile("" : "+v"(lane)); const int tid = wave * 64 + lane;
            if (L == 0 && rep_ == 0) {
                const int gw = bid * NWAVES + wave, NGW = G * NWAVES;
                for (int m = gw; m < MMEM; m += NGW) {
                    const float rs = MRS[m]; bf16_t* row = KVRAW + (size_t)m * 2048;
#pragma unroll
                    for (int st = 0; st < 4; ++st) {
                        u32x4 w = *(const u32x4*)(row + st * 512 + lane * 8); float f[8];
#pragma unroll
                        for (int j = 0; j < 4; ++j) { f[2 * j] = __builtin_bit_cast(float, w[j] << 16) * rs; f[2 * j + 1] = __builtin_bit_cast(float, w[j] & 0xffff0000u) * rs; }
                        if ((st & 1) == 0) {
                            float ss = 0.f;
#pragma unroll
                            for (int j = 0; j < 8; ++j) ss += f[j] * f[j];
                            ss += __shfl_xor(ss, 1); ss += __shfl_xor(ss, 2); ss += __shfl_xor(ss, 4); ss += __shfl_xor(ss, 8);
                            const float rn = __builtin_amdgcn_rsqf(ss * (1.0f / 128.0f) + RMS_EPS);
                            const float* gn = mem_k_norm + (st >> 1) * 128 + (lane & 15) * 8;
#pragma unroll
                            for (int j = 0; j < 8; ++j) f[j] = f[j] * rn * gn[j];
                        }
                        u32x4 o; o.x = pk2(f[0], f[1]); o.y = pk2(f[2], f[3]); o.z = pk2(f[4], f[5]); o.w = pk2(f[6], f[7]);
                        *(u32x4*)(row + st * 512 + lane * 8) = o;
                    }
                }
            }
            if (L == 0) {
                { const int gw = bid * NWAVES + wave, NGW = G * NWAVES;
                  for (int u = gw; u < BATCH * 8 * 16; u += NGW) { const int n = u & 15, hm = (u >> 4) & 7, b = u >> 7;
                      const bf16_t* kb = RAW + (size_t)(b * SEQ + 256 * n + (lane >> 3)) * AB_WP + 1472 + hm * 64 + (lane & 7) * 8; float a[8] = {0.f, 0.f, 0.f, 0.f, 0.f, 0.f, 0.f, 0.f};
                      for (int i0 = 0; i0 < 32; i0 += 8) { u32x4 rw[8];
#pragma unroll
                          for (int i = 0; i < 8; ++i) rw[i] = *(const u32x4*)(kb + (size_t)(8 * (i0 + i)) * AB_WP);
#pragma unroll
                          for (int i = 0; i < 8; ++i) { float f[8]; unpack8(rw[i], f);
#pragma unroll
                              for (int j = 0; j < 8; ++j) a[j] += f[j]; } }
#pragma unroll
                      for (int j = 0; j < 8; ++j) { a[j] += __shfl_xor(a[j], 8); a[j] += __shfl_xor(a[j], 16); a[j] += __shfl_xor(a[j], 32); }
                      if (lane < 8) { float* o = KMEAN + (size_t)u * 64 + lane * 8;
#pragma unroll
                          for (int j = 0; j < 8; ++j) o[j] = a[j] * (1.0f / 256.0f); } } }
                LAS float* SCL = (LAS float*)lds;
#if defined(PROBE_IDX) && PROBE_IDX == 2
                if (rep_ == 0)
#endif
                for (int ui = bid; ui < BATCH * 256; ui += G) {
                    const int rr = ui >> 8, pos = ui & 255; const int qi = 32 * rr + ((rr & 1) ? 31 - (pos >> 3) : (pos >> 3)), b = pos & 7;
                    const int t0 = qi * 16, tmax = t0 + 15, nchunk = (tmax >> 10) + 1, nreg = (tmax >> 6) + 1;
                    const int ql = lane & 15, kq = lane >> 4;
                    const size_t qrow = (size_t)b * SEQ + t0 + ql;
                    typedef float f32x4v __attribute__((ext_vector_type(4)));
                    bf16x8 qf[8];
#pragma unroll
                    for (int hi = 0; hi < 8; ++hi) qf[hi] = *(const bf16x8*)(RAW + qrow * AB_WP + 640 + hi * 32 + 8 * kq);
                    const f32x4 iw0 = *(const f32x4*)(IWB + qrow * 8), iw1 = *(const f32x4*)(IWB + qrow * 8 + 4);
                    unsigned uu[2][64];
#pragma unroll
                    for (int rg = 0; rg < 64; ++rg) { uu[0][rg] = 0u; uu[1][rg] = 0u; }
#pragma unroll
                    for (int c = 0; c < 4; ++c) if (c < nchunk) {
                        const int ntile = ((tmax - 1024 * c) >> 4) + 1 < 64 ? ((tmax - 1024 * c) >> 4) + 1 : 64;
                        __syncthreads();
                        const bf16_t* kfp = RAW + (size_t)(b * SEQ + 1024 * c + ql) * AB_WP + 896 + 8 * kq;
                        bf16x8 kfn = *(const bf16x8*)(kfp + (size_t)(16 * (wave < ntile ? wave : 0)) * AB_WP);
                        for (int tile = wave; tile < ntile; tile += 8) {
                            const bf16x8 kf = kfn; { const int tn = tile + 8 < ntile ? tile + 8 : tile; kfn = *(const bf16x8*)(kfp + (size_t)(16 * tn) * AB_WP); }
                            f32x4v sc = {0.f, 0.f, 0.f, 0.f};
#pragma unroll
                            for (int hi = 0; hi < 8; ++hi) { f32x4v x = {0.f, 0.f, 0.f, 0.f}; x = __builtin_amdgcn_mfma_f32_16x16x32_bf16(kf, qf[hi], x, 0, 0, 0);
                                const float sf = hi < 4 ? iw0[hi & 3] : iw1[hi & 3];
#pragma unroll
                                for (int i = 0; i < 4; ++i) sc[i] += sf * fmaxf(x[i], 0.f); }
                            *(LAS f32x4v*)(SCL + ql * 1028 + 16 * tile + 4 * kq) = sc;
                        }
                        __syncthreads();
#pragma unroll
                        for (int qq = 0; qq < 2; ++qq) { const int t = t0 + 2 * wave + qq;
#pragma unroll
                            for (int rl = 0; rl < 16; ++rl) { const int key = 1024 * c + 64 * rl + lane; const unsigned bits = __builtin_bit_cast(unsigned, SCL[(2 * wave + qq) * 1028 + 64 * rl + lane]);
                                const unsigned mono = bits ^ ((bits >> 31) ? 0xffffffffu : 0x80000000u); uu[qq][16 * c + rl] = (key <= t) ? mono : 0u; } }
                    }
#if defined(PROBE_IDX) && PROBE_IDX == 1
                    if (rep_) { if (uu[0][3] == 12345u && uu[1][40] == 777u) BMK[0] = 1ull; continue; }
#endif
                    int lb = lane; asm volatile("" : "+v"(lb));
                    unsigned long long word[2] = {0ull, 0ull};
                    unsigned T[2] = {0u, 0u}; bool done[2], exact[2] = {false, false};
                    done[0] = (t0 + 2 * wave) < 256; done[1] = (t0 + 2 * wave + 1) < 256;
                    for (int bit = 31; bit >= 0 && !(done[0] && done[1]); --bit) {
                        const unsigned c0 = T[0] | (1u << bit), c1 = T[1] | (1u << bit); int n0 = 0, n1 = 0;
#pragma unroll
                        for (int ch = 0; ch < 4; ++ch) if (16 * ch < nreg) {
#pragma unroll
                            for (int dummy_ = 0; dummy_ < 1; ++dummy_) { n0 = cnt_ge16(&uu[0][16 * ch], c0, n0); n1 = cnt_ge16(&uu[1][16 * ch], c1, n1); } }
                        const int s0 = wave_sum_i(n0), s1 = wave_sum_i(n1);
                        if (!done[0]) { if (s0 >= 256) T[0] = c0; if (s0 == 256) { done[0] = true; exact[0] = true; } }
                        if (!done[1]) { if (s1 >= 256) T[1] = c1; if (s1 == 256) { done[1] = true; exact[1] = true; } }
                    }
#pragma unroll
                    for (int qq = 0; qq < 2; ++qq) { const int t = t0 + 2 * wave + qq; unsigned long long myword = 0ull;
                        if (t < 256) {
#pragma unroll
                            for (int rg = 0; rg < 4; ++rg) { const unsigned long long w = __ballot(64 * rg + lb <= t); if (lb == rg) myword = w; }
                        } else if (exact[qq]) {
#pragma unroll
                            for (int rg = 0; rg < 64; ++rg) { const unsigned long long w = __ballot(uu[qq][rg] >= T[qq]); if (lb == rg) myword = w; __builtin_amdgcn_sched_barrier(0); }
                        } else {
                            int cg = 0;
#pragma unroll
                            for (int rg = 0; rg < 64; ++rg) cg = cnt_ge(uu[qq][rg], T[qq] + 1u, cg);
                            int need = 256 - wave_sum_i(cg);
#pragma unroll
                            for (int rg = 0; rg < 64; ++rg) {
                                unsigned long long w = __ballot(uu[qq][rg] > T[qq]), eq = __ballot(uu[qq][rg] == T[qq]); const int ne = __builtin_popcountll(eq);
                                if (ne <= need) { w |= eq; need -= ne; } else { while (need > 0) { const unsigned long long low = eq & (0ull - eq); w |= low; eq ^= low; --need; } }
                                if (lb == rg) myword = w; __builtin_amdgcn_sched_barrier(0); }
                        }
                        BMK[((size_t)(b * 128 + (t >> 5)) * 64 + lb) * 32 + (t & 31)] = myword;
                    }
                }
            }
            if (L == 0) SEAM(pb + 2);
        }
        if (RUN(pb + 3)) for (int rep_ = 0; rep_ < REPS(pb + 3); ++rep_) {
            int lane = (int)__builtin_amdgcn_mbcnt_hi(~0u, __builtin_amdgcn_mbcnt_lo(~0u, 0u)); asm volatile("" : "+v"(lane)); const int tid = wave * 64 + lane;
            if (L == 0) {
                const float shiftA = att::softmax_shift(att::gain_max64(dsa_q_norm), att::gain_max64(dsa_k_norm)), shiftB = att::softmax_shift(att::gain_max64(moba_q_norm), att::gain_max64(moba_k_norm));
                for (int ui = bid; ui < BATCH * 128; ui += G) {
                    const int rr = ui >> 8, pos = ui & 255; const int qt = 32 * rr + ((rr & 1) ? 31 - (pos >> 3) : (pos >> 3)), b = pos & 7;
                    const int r = lane & 31, h = lane >> 5; const size_t row = (size_t)b * SEQ + qt * 32 + r;
                    bf16x8 qf[4];
                    { const bf16_t* qrow = RAW + row * AB_WP + wave * 64 + 8 * h;
#pragma unroll
                      for (int s2 = 0; s2 < 4; ++s2) qf[s2] = *(const bf16x8*)(qrow + 16 * s2); }
                    f32x16 oo[2]; float ll = 0.f;
#pragma unroll
                    for (int i = 0; i < 16; ++i) { oo[0][i] = 0.f; oo[1][i] = 0.f; }
                    const bf16_t* kbase = RAW + (size_t)b * SEQ * AB_WP + 512; const unsigned long long* bm = BMK + (size_t)(b * 128 + qt) * 64 * 32;
                    LAS unsigned char* MSL = lds + 8 * att::DBUF;
{ auto go_ = [&](auto hs_) { constexpr bool HS = decltype(hs_)::value;
#if AB_L0
                    att::kv_pipeline_ab<1>(lds, (qt >> 1) + 1, wave, lane, qf, oo,
                        [&](int tt, const bf16_t*& kb, size_t& kp, const bf16_t*& vb, size_t& vp) { kb = kbase + (size_t)(64 * tt) * AB_WP; kp = AB_WP; vb = kb + 64; vp = AB_WP; },
                        [&](int tt, const f32x16 (&p)[2], u32x4 (&pw)[4], int slot) {
                            const unsigned long long w = *(const LAS unsigned long long*)(MSL + (slot * 8 + wave) * 256 + r * 8) >> (4 * h);
                            att::half_v<2, HS>(pw, ll, p, true, shiftA, [](int) { return true; }, (unsigned)w, (unsigned)(w >> 32)); },
                        [&](int tt, int slot) { __builtin_amdgcn_global_load_lds((const unsigned*)(bm + (size_t)tt * 32) + lane, (LAS unsigned*)(MSL + (slot * 8 + wave) * 256), 4, 0, 0); });
#else
                    att::kv_pipeline_dma8<1>(lds, (qt >> 1) + 1, wave, lane, qf,
                        [&](int tt, const bf16_t*& kb, size_t& kp, const bf16_t*& vb, size_t& vp) { kb = kbase + (size_t)(64 * tt) * AB_WP; kp = AB_WP; vb = kb + 64; vp = AB_WP; },
                        [&](int tt, f32x16 (&p)[2], const LAS unsigned char* buf, const LAS unsigned char* nbuf, f32x16 (&pn)[2], int slot) {
                            const unsigned long long w = *(const LAS unsigned long long*)(MSL + (slot * 8 + wave) * 256 + r * 8) >> (4 * h);
#if defined(PROBE_SKEL) && PROBE_SKEL == 2
                            if (rep_ == 0)
#endif
                            att::fused_e<2, HS, LP_L0>(oo, ll, p, buf, lane, true, shiftA, [](int) { return true; }, (unsigned)w, (unsigned)(w >> 32), qf, nbuf, pn); },
                        [&](int tt, int slot) { __builtin_amdgcn_global_load_lds((const unsigned*)(bm + (size_t)tt * 32) + lane, (LAS unsigned*)(MSL + (slot * 8 + wave) * 256), 4, 0, 0); });
#endif
 }; if (shiftA == 0.f) go_(std::false_type{}); else go_(std::true_type{}); }
                    const float lt = ll + __shfl_xor(ll, 32);
#if defined(PROBE_SKEL) && PROBE_SKEL == 2
                    if (rep_ == 0)
#endif
                    att::store_o_t<64>(oo, lt > 0.f ? 1.0f / lt : 0.f, OATT + ((size_t)b * SEQ + qt * 32) * 1024 + wave * 64, 1024, lds + wave * 4608, lane);
                }
                LAS unsigned* UNI = (LAS unsigned*)(lds + 8 * att::DBUF); LAS int* TL = (LAS int*)(lds + 8 * att::DBUF + 16); LAS float* KMS = (LAS float*)(lds + 8 * att::DBUF + 256);
#if defined(PROBE_SKEL)
                if (rep_ == 0)
#endif
                for (int ui = bid; ui < BATCH * 8 * 16; ui += G) {
                    const int rr = ui >> 8, pos = ui & 255; const int xk = pos >> 3, cmb = rr * 16 + (pos & 7) * 2 + (xk >> 4);
                    const int own = (rr & 1) ? 15 - (xk & 15) : (xk & 15), b = cmb >> 3, hm = cmb & 7;
                    const int r = lane & 31, h = lane >> 5; const int tl = wave * 32 + r; const size_t row = (size_t)b * SEQ + own * 256 + tl;
                    bf16x8 qf[4];
                    { const bf16_t* qrow = RAW + row * AB_WP + 960 + hm * 64 + 8 * h;
#pragma unroll
                      for (int s2 = 0; s2 < 4; ++s2) qf[s2] = *(const bf16x8*)(qrow + 16 * s2); }
                    if (tid == 0) UNI[0] = 0u;
                    { const f32x2 kmv = *(const f32x2*)(KMEAN + (size_t)(b * 8 + hm) * 1024 + tid * 2); *(LAS f32x2*)(KMS + tid * 2) = kmv; }
                    __syncthreads();
                    unsigned msk = 0u;
                    { float b0 = att::NEG_INF, b1 = att::NEG_INF, b2 = att::NEG_INF; int i0 = -1, i1 = -1, i2 = -1;
                      float qv[32];
#pragma unroll
                      for (int s2 = 0; s2 < 4; ++s2) { float f[8]; unpack8(__builtin_bit_cast(u32x4, qf[s2]), f);
#pragma unroll
                          for (int j = 0; j < 8; ++j) qv[8 * s2 + j] = f[j]; }
                      for (int n = 0; n < own; ++n) { const LAS float* km = KMS + n * 64 + 8 * h; float a = 0.f;
#pragma unroll
                          for (int s2 = 0; s2 < 4; ++s2) { const f32x4 k0 = *(const LAS f32x4*)(km + 16 * s2), k1 = *(const LAS f32x4*)(km + 16 * s2 + 4);
                              a += qv[8 * s2] * k0[0] + qv[8 * s2 + 1] * k0[1] + qv[8 * s2 + 2] * k0[2] + qv[8 * s2 + 3] * k0[3] + qv[8 * s2 + 4] * k1[0] + qv[8 * s2 + 5] * k1[1] + qv[8 * s2 + 6] * k1[2] + qv[8 * s2 + 7] * k1[3]; }
                          a += __shfl_xor(a, 32);
                          if (a > b0) { b2 = b1; i2 = i1; b1 = b0; i1 = i0; b0 = a; i0 = n; } else if (a > b1) { b2 = b1; i2 = i1; b1 = a; i1 = n; } else if (a > b2) { b2 = a; i2 = n; } }
                      if (i0 >= 0) msk |= 1u << i0; if (i1 >= 0) msk |= 1u << i1; if (i2 >= 0) msk |= 1u << i2; }
                    { unsigned um = msk;
#pragma unroll
                      for (int o = 1; o < 64; o <<= 1) um |= __shfl_xor(um, o);
                      if (lane == 0) __hip_atomic_fetch_or(UNI, um, __ATOMIC_RELAXED, __HIP_MEMORY_SCOPE_WORKGROUP); }
                    __syncthreads();
                    const unsigned U = (unsigned)__builtin_amdgcn_readfirstlane((int)UNI[0]);
                    const int npast = __builtin_popcount(U);
                    if (wave == 0 && lane < 16 && ((U >> lane) & 1u)) TL[__builtin_amdgcn_mbcnt_lo(U, 0u)] = lane;
                    f32x16 oo[2]; float ll = 0.f;
#pragma unroll
                    for (int i = 0; i < 16; ++i) { oo[0][i] = 0.f; oo[1][i] = 0.f; }
                    const bf16_t* kbase = RAW + (size_t)b * SEQ * AB_WP + 1472 + hm * 64;
                    __syncthreads();
{ auto go_ = [&](auto hs_) { constexpr bool HS = decltype(hs_)::value;
#if AB_L0
                    att::kv_pipeline_ab<0>(lds, 4 * npast + 4, wave, lane, qf, oo,
                        [&](int tt, const bf16_t*& kb, size_t& kp, const bf16_t*& vb, size_t& vp) {
                            const int blk = (tt < 4 * npast) ? __builtin_amdgcn_readfirstlane(TL[tt >> 2]) : own, sub = (tt < 4 * npast) ? (tt & 3) : tt - 4 * npast;
                            kb = kbase + (size_t)(256 * blk + 64 * sub) * AB_WP; kp = AB_WP; vb = kb + 512; vp = AB_WP; },
                        [&](int tt, const f32x16 (&p)[2], u32x4 (&pw)[4], int) {
                            if (tt < 4 * npast) { const int blk = __builtin_amdgcn_readfirstlane(TL[tt >> 2]); const bool sel = (msk >> blk) & 1u;
                                att::half_v<0, HS>(pw, ll, p, sel, shiftB, [](int) { return true; }, 0u, 0u); }
                            else { const int sub = tt - 4 * npast; const int lim = tl - 64 * sub - 4 * h;
                                att::half_v<1, HS>(pw, ll, p, true, shiftB, [&](int koff) { return koff <= lim; }, 0u, 0u); } },
                        att::NoXtra());
#else
                    att::kv_pipeline_dma8<0>(lds, 4 * npast + 4, wave, lane, qf,
                        [&](int tt, const bf16_t*& kb, size_t& kp, const bf16_t*& vb, size_t& vp) {
                            const int blk = (tt < 4 * npast) ? __builtin_amdgcn_readfirstlane(TL[tt >> 2]) : own, sub = (tt < 4 * npast) ? (tt & 3) : tt - 4 * npast;
                            kb = kbase + (size_t)(256 * blk + 64 * sub) * AB_WP; kp = AB_WP; vb = kb + 512; vp = AB_WP; },
                        [&](int tt, f32x16 (&p)[2], const LAS unsigned char* buf, const LAS unsigned char* nbuf, f32x16 (&pn)[2], int) {
                            if (tt < 4 * npast) { const int blk = __builtin_amdgcn_readfirstlane(TL[tt >> 2]); const bool sel = (msk >> blk) & 1u;
                                att::fused_e<0, HS, LP_L0>(oo, ll, p, buf, lane, sel, shiftB, [](int) { return true; }, 0u, 0u, qf, nbuf, pn); }
                            else { const int sub = tt - 4 * npast; const int lim = tl - 64 * sub - 4 * h;
                                att::fused_e<1, HS, LP_L0>(oo, ll, p, buf, lane, true, shiftB, [&](int koff) { return koff <= lim; }, 0u, 0u, qf, nbuf, pn); } },
                        att::NoXtra());
#endif
 }; if (shiftB == 0.f) go_(std::false_type{}); else go_(std::true_type{}); }
                    const float lt = ll + __shfl_xor(ll, 32);
                    att::store_o_t<64>(oo, lt > 0.f ? 1.0f / lt : 0.f, OATT + ((size_t)b * SEQ + own * 256 + wave * 32) * 1024 + 512 + hm * 64, 1024, lds + wave * 4608, lane);
                    __syncthreads();
                }
            }
            if (L == 1) {
                const float shiftS = att::softmax_shift(att::gain_max64(nsa_q_norm), att::gain_max64(nsa_ksel_norm)), shiftW = att::softmax_shift(att::gain_max64(nsa_q_norm), att::gain_max64(nsa_kwin_norm));
                LAS unsigned* IMP = (LAS unsigned*)(lds + 86016);
                LAS unsigned long long* SELM = (LAS unsigned long long*)(lds + 4 * att::DBUF); LAS int* TL = (LAS int*)(lds + 4 * att::DBUF + 528);
                for (int ui = bid; ui < BATCH * 4 * 64; ui += G) {
                    const int rr = ui >> 8, pos = ui & 255;
                    const int pr = (pos & 7) * 4 + (rr >> 1), xk = pos >> 3, qt = (rr & 1) ? 63 - xk : xk, b = pr >> 2, g = pr & 3;
                    const int r = lane & 31, h = lane >> 5, j = wave & 3, qs = wave >> 2, hd = g * 4 + j;
                    const int t = qt * 64 + qs * 32 + r, ql = qs * 32 + r; const size_t row = (size_t)b * SEQ + t;
                    bf16x8 qf[4];
                    { const bf16_t* qrow = RAW + row * C_WP + hd * 64 + 8 * h;
#pragma unroll
                      for (int s2 = 0; s2 < 4; ++s2) qf[s2] = *(const bf16x8*)(qrow + 16 * s2); }
                    for (int i = tid; i < ((qt >> 4) + 1) * 64 * 64 / 4; i += 512) ((LAS u32x4*)IMP)[i] = (u32x4){0u, 0u, 0u, 0u};
                    f32x16 oacc[2];
                    const float* gt = GT + row * 48 + hd * 3; const float g0 = gt[0];
                    const int nvalid = t >= 31 ? ((t - 31) >> 4) + 1 : 0;
                    const int ntc = (qt >> 4) + 1;
                    { const bf16_t* kcb = KCMP + (size_t)(b * 4 + g) * 256 * 64; const bf16_t* vcb = VCMP + (size_t)(b * 4 + g) * 256 * 64;
                      for (int idx = tid; idx < 64 * 8 * ntc; idx += 512) { const int rw = idx >> 3, c = idx & 7;
                          *(LAS u32x4*)(lds + rw * 144 + c * 16) = *(const u32x4*)(kcb + rw * 64 + c * 8);
                          *(LAS u32x4*)(lds + 36864 + rw * 192 + c * 16) = *(const u32x4*)(vcb + rw * 64 + c * 8); } }
                    __syncthreads();
                    float mc = att::NEG_INF, lc = 0.f;
#pragma unroll 1
                    for (int tt = 0; tt < ntc; ++tt) {
                        f32x16 p[2]; att::tile_scores<64>(p, qf, lds + tt * 9216, lane); const int lim = nvalid - 64 * tt - 4 * h; float mx = att::NEG_INF;
#pragma unroll
                        for (int kt = 0; kt < 2; ++kt)
#pragma unroll
                            for (int i = 0; i < 16; ++i) { const int koff = 32 * kt + (i & 3) + 8 * (i >> 2); const float v = (koff < lim) ? p[kt][i] : att::NEG_INF; p[kt][i] = v; mx = fmaxf(mx, v); }
                        mx = fmaxf(mx, __shfl_xor(mx, 32));
                        const float mnew = fmaxf(mc, mx), muse = (mnew == att::NEG_INF) ? 0.f : mnew; float ls = 0.f;
#pragma unroll
                        for (int kt = 0; kt < 2; ++kt)
#pragma unroll
                            for (int i = 0; i < 16; ++i) ls += __builtin_amdgcn_exp2f(p[kt][i] - muse);
                        lc = lc * __builtin_amdgcn_exp2f(mc - muse) + ls; mc = mnew; }
                    lc += __shfl_xor(lc, 32);
                    const float invl = lc > 0.f ? 1.0f / lc : 0.f, mcu = (mc == att::NEG_INF) ? 0.f : mc;
#pragma unroll
                    for (int i = 0; i < 16; ++i) { oacc[0][i] = 0.f; oacc[1][i] = 0.f; }
#pragma unroll 1
                    for (int tt = 0; tt < ntc; ++tt) {
                        f32x16 p[2]; att::tile_scores<64>(p, qf, lds + tt * 9216, lane); const int lim = nvalid - 64 * tt - 4 * h;
#pragma unroll
                        for (int kt = 0; kt < 2; ++kt)
#pragma unroll
                            for (int i = 0; i < 16; ++i) { const int koff = 32 * kt + (i & 3) + 8 * (i >> 2); const float pv = (koff < lim) ? __builtin_amdgcn_exp2f(p[kt][i] - mcu) * invl : 0.f; p[kt][i] = pv;
                                __hip_atomic_fetch_add(IMP + (64 * tt + koff + 4 * h) * 64 + ql, (unsigned)(pv * 134217728.0f + 0.5f), __ATOMIC_RELAXED, __HIP_MEMORY_SCOPE_WORKGROUP);
                                if ((i & 3) == 3) __builtin_amdgcn_sched_barrier(0); }
                        __builtin_amdgcn_sched_barrier(0);
                        att::tile_pv<64>(oacc, p, lds + 36864 + tt * 12288 - 9216, lane); }
#pragma unroll
                    for (int i = 0; i < 16; ++i) { oacc[0][i] *= g0; oacc[1][i] *= g0; }
                    LAS float* STASH = (LAS float*)IMP + wave * 2048 + lane;
                    __syncthreads();
                    {
                        int l2 = lane; asm volatile("" : "+v"(l2));
                        const int qq = l2 >> 3, seg = l2 & 7, q = wave * 8 + qq, cur = qt;
                        unsigned key[8];
#pragma unroll
                        for (int k = 0; k < 8; ++k) { const int sb = 8 * seg + k; unsigned v = 0u;
#pragma unroll
                            for (int dn = -1; dn <= 3; ++dn) { const int n = 4 * sb + dn; if (n >= 0 && n < 255) v += IMP[n * 64 + q]; }
                            const bool forced = (sb == 0) || (sb == cur) || (sb == cur - 1);
                            key[k] = (sb <= cur) ? ((forced ? 0xffffff80u : ((v >> 7) << 7)) | (unsigned)(64 - sb)) : 0u; __builtin_amdgcn_sched_barrier(0); }
                        unsigned T = 0u;
                        for (int bit = 31; bit >= 0; --bit) { const unsigned cand = T | (1u << bit); int c = 0;
#pragma unroll
                            for (int k = 0; k < 8; ++k) c += (key[k] >= cand) ? 1 : 0;
                            c += __builtin_amdgcn_update_dpp(0, c, 0xB1, 0xf, 0xf, false);
                            c += __builtin_amdgcn_update_dpp(0, c, 0x4E, 0xf, 0xf, false);
                            c += __builtin_amdgcn_update_dpp(0, c, 0x141, 0xf, 0xf, false);
                            if (c >= 16) T = cand; }
                        unsigned byte = 0u;
#pragma unroll
                        for (int k = 0; k < 8; ++k) byte |= (key[k] != 0u && key[k] >= T) ? (1u << k) : 0u;
                        ((LAS unsigned char*)SELM)[q * 8 + seg] = (unsigned char)byte;
                    }
                    __syncthreads();
#pragma unroll
                    for (int i = 0; i < 16; ++i) { STASH[i * 64] = oacc[0][i]; STASH[(16 + i) * 64] = oacc[1][i]; }
                    { float own[8], oth[8]; const float* cs = ROPE64 + row * 16; u32x4 w = __builtin_bit_cast(u32x4, qf[0]); unpack8(w, own);
#pragma unroll
                      for (int jj = 0; jj < 8; ++jj) oth[jj] = __shfl_xor(own[jj], 32);
#pragma unroll
                      for (int jj = 0; jj < 8; ++jj) own[jj] = h ? own[jj] * cs[jj] + oth[jj] * cs[8 + jj] : own[jj] * cs[jj] - oth[jj] * cs[8 + jj];
                      qf[0] = __builtin_bit_cast(bf16x8, pack8f(own)); }
                    {
                        const unsigned long long mymask = SELM[ql]; const unsigned long long un0 = SELM[lane];
                        unsigned ul = (unsigned)un0, uh = (unsigned)(un0 >> 32);
#pragma unroll
                        for (int o = 1; o < 64; o <<= 1) { ul |= __shfl_xor(ul, o); uh |= __shfl_xor(uh, o); }
                        const unsigned ulo = (unsigned)__builtin_amdgcn_readfirstlane((int)ul), uhi = (unsigned)__builtin_amdgcn_readfirstlane((int)uh);
                        const unsigned long long U = ((unsigned long long)uhi << 32) | ulo;
                        if (wave == 0 && ((U >> lane) & 1ull)) TL[__builtin_amdgcn_mbcnt_hi(uhi, __builtin_amdgcn_mbcnt_lo(ulo, 0u))] = lane;
                        f32x16 oo[2]; float ll = 0.f;
#pragma unroll
                        for (int i = 0; i < 16; ++i) { oo[0][i] = 0.f; oo[1][i] = 0.f; }
                        const bf16_t* kbase = RAW + (size_t)b * SEQ * C_WP + 1536 + g * 64;
                        __syncthreads();
{ auto go_ = [&](auto hs_) { constexpr bool HS = decltype(hs_)::value;
                        att::kv_pipeline_dma2<0>(lds, __builtin_popcountll(U), wave, lane, qf,
                            [&](int tt, const bf16_t*& kb, size_t& kp, const bf16_t*& vb, size_t& vp) { const int sblk = __builtin_amdgcn_readfirstlane(TL[tt]); kb = kbase + (size_t)(64 * sblk) * C_WP; kp = C_WP; vb = kb + 256; vp = C_WP; },
                            [&](int tt, f32x16 (&p)[2], const LAS unsigned char* buf, const LAS unsigned char* nbuf, f32x16 (&pn)[2], int) { const int sblk = __builtin_amdgcn_readfirstlane(TL[tt]);
                                const bool sel = (mymask >> sblk) & 1ull; const int lim = t - 64 * sblk - 4 * h;
                                if (sblk == qt) att::fused_e<1, HS, LP_NSA>(oo, ll, p, buf, lane, sel, shiftS, [&](int koff) { return koff <= lim; }, 0u, 0u, qf, nbuf, pn);
                                else att::fused_e<0, HS, LP_NSA>(oo, ll, p, buf, lane, sel, shiftS, [](int) { return true; }, 0u, 0u, qf, nbuf, pn); },
                            att::NoXtra());
 }; if (shiftS == 0.f) go_(std::false_type{}); else go_(std::true_type{}); }
                        const float lt = ll + __shfl_xor(ll, 32); const float f = lt > 0.f ? GT[row * 48 + hd * 3 + 1] / lt : 0.f;
#pragma unroll
                        for (int i = 0; i < 16; ++i) { STASH[i * 64] += oo[0][i] * f; STASH[(16 + i) * 64] += oo[1][i] * f; }
                    }
                    {
                        const int tw0 = qt >= 8 ? qt - 8 : 0, ntw = qt - tw0 + 1;
                        f32x16 oo[2]; float ll = 0.f;
#pragma unroll
                        for (int i = 0; i < 16; ++i) { oo[0][i] = 0.f; oo[1][i] = 0.f; }
                        const bf16_t* kbase = RAW + (size_t)b * SEQ * C_WP + 2048 + g * 64;
{ auto go_ = [&](auto hs_) { constexpr bool HS = decltype(hs_)::value;
                        att::kv_pipeline_dma2<0>(lds, ntw, wave, lane, qf,
                            [&](int tt, const bf16_t*& kb, size_t& kp, const bf16_t*& vb, size_t& vp) { kb = kbase + (size_t)(64 * (tw0 + tt)) * C_WP; kp = C_WP; vb = kb + 256; vp = C_WP; },
                            [&](int tt, f32x16 (&p)[2], const LAS unsigned char* buf, const LAS unsigned char* nbuf, f32x16 (&pn)[2], int) { const int tw = tw0 + tt; const int d0 = t - 64 * tw - 4 * h;
                                if (tw == qt || (qt >= 8 && tw == qt - 8)) att::fused_e<1, HS, LP_NSA>(oo, ll, p, buf, lane, true, shiftW, [&](int koff) { const int dist = d0 - koff; return dist >= 0 && dist < 512; }, 0u, 0u, qf, nbuf, pn);
                                else att::fused_e<0, HS, LP_NSA>(oo, ll, p, buf, lane, true, shiftW, [](int) { return true; }, 0u, 0u, qf, nbuf, pn); },
                            att::NoXtra());
 }; if (shiftW == 0.f) go_(std::false_type{}); else go_(std::true_type{}); }
                        const float lt = ll + __shfl_xor(ll, 32); const float f = lt > 0.f ? GT[row * 48 + hd * 3 + 2] / lt : 0.f;
#pragma unroll
                        for (int i = 0; i < 16; ++i) { oo[0][i] = STASH[i * 64] + oo[0][i] * f; oo[1][i] = STASH[(16 + i) * 64] + oo[1][i] * f; }
#if defined(PROBE_NSA)
                        if (rep_ == 0)
#endif
                        att::store_o_t<64>(oo, 1.0f, OATT + ((size_t)b * SEQ + qt * 64 + qs * 32) * 1024 + hd * 64, 1024, lds + wave * 4608, lane);
                    }
                    __syncthreads();
                }
            }
            SEAM(pb + 3);
        }
        if (RUN(pb + 4)) for (int rep_ = 0; rep_ < REPS(pb + 4); ++rep_) {
            int lane = (int)__builtin_amdgcn_mbcnt_hi(~0u, __builtin_amdgcn_mbcnt_lo(~0u, 0u)); asm volatile("" : "+v"(lane)); const int tid = wave * 64 + lane;
            if (L == 0) {
                pg8::Gemm g{OATT, W_ABO, MTOK, DM, DM}; pg8::StaticOrder S; S.init(MTOK, DM, G, bid);
                pg8::EpiResid<false> E{out, XB, RSQ};
                pg8::gemm_phase<pg8::EpiResid<false>, pg8::StaticOrder, true, true>(lds, g, S, E, wave);
            }
            if (L == 1) {
                pg8::Gemm g{OATT, W_CO, MTOK, DM, DM}; pg8::StaticOrder S; S.init(MTOK, DM, G, bid);
                pg8::EpiResid<false> E{out, XB, RSQ};
                pg8::gemm_phase<pg8::EpiResid<false>, pg8::StaticOrder, true, true>(lds, g, S, E, wave);
            }
            SEAM(pb + 4);
        }
        if (RUN(pb + 5)) for (int rep_ = 0; rep_ < REPS(pb + 5); ++rep_) {
            int lane = (int)__builtin_amdgcn_mbcnt_hi(~0u, __builtin_amdgcn_mbcnt_lo(~0u, 0u)); asm volatile("" : "+v"(lane)); const int tid = wave * 64 + lane;
            pg8::Gemm g{XB, W_MQ + (size_t)L * 512 * DM, MTOK, 512, DM}; pg8::StaticOrder S; S.init(MTOK, 512, G, bid);
            pg8::EpiPlain E{MQB, 512};
            pg8::gemm_phase<pg8::EpiPlain, pg8::StaticOrder, true, true>(lds, g, S, E, wave);
            SEAM(pb + 5);
        }
        if (RUN(pb + 6)) for (int rep_ = 0; rep_ < REPS(pb + 6); ++rep_) {
            int lane = (int)__builtin_amdgcn_mbcnt_hi(~0u, __builtin_amdgcn_mbcnt_lo(~0u, 0u)); asm volatile("" : "+v"(lane)); const int tid = wave * 64 + lane;
            const float shiftM = [&] { float gq = 0.f, gk = 0.f; for (int i = 0; i < 128; ++i) { gq = fmaxf(gq, fabsf(mem_q_norm[L * 128 + i])); gk = fmaxf(gk, fabsf(mem_k_norm[L * 128 + i])); }
                                       const float B = 11.3137085f * LOG2E * gq * gk * 1.02f; return B > 60.f ? B - 60.f : 0.f; }();
            const int upb = (512 % G == 0) ? 512 / G : 0; int cur_pair = -1;
            for (int k = 0; ; ++k) {
                const int u = upb ? bid * upb + k : bid + k * G; if ((upb && k >= upb) || u >= BATCH * 4 * 16) break;
                const int b = u >> 6, hh = (u >> 4) & 3, qb = u & 15;
                const int r = lane & 31, h = lane >> 5;
                const int row = b * SEQ + qb * 256 + wave * 32 + r;
                if ((u >> 4) != cur_pair) { cur_pair = u >> 4;
                    __syncthreads();
                    const bf16_t* kbase = KVRAW + (size_t)(b * NMEM) * 2048 + L * 1024 + hh * 128;
#pragma unroll
                    for (int i = 0; i < 8; ++i) { const int idx = tid + 512 * i, rw = idx >> 4, c = idx & 15;
                        *(LAS u32x4*)(lds + rw * 272 + c * 16) = *(const u32x4*)(kbase + (size_t)rw * 2048 + c * 8);
                        *(LAS u32x4*)(lds + 69632 + rw * 320 + c * 16) = *(const u32x4*)(kbase + (size_t)rw * 2048 + 512 + c * 8); }
                    __syncthreads(); }
                const float rs = row_rstd(RSQ, row);
                bf16x8 qf[8]; float ssq = 0.f;
                const bf16_t* qrow = MQB + (size_t)row * 512 + hh * 128 + 8 * h;
#pragma unroll
                for (int s2 = 0; s2 < 8; ++s2) { qf[s2] = *(const bf16x8*)(qrow + 16 * s2);
#pragma unroll
                    for (int j = 0; j < 8; ++j) { const float f = bf2f((unsigned short)qf[s2][j]) * rs; ssq += f * f; } }
                ssq += __shfl_xor(ssq, 32);
                const float qs = rs * __builtin_amdgcn_rsqf(ssq * (1.0f / 128.0f) + RMS_EPS) * (0.08838834764831845f * LOG2E);
#pragma unroll
                for (int s2 = 0; s2 < 8; ++s2) { const float* gn = mem_q_norm + L * 128 + 16 * s2 + 8 * h; const f32x4 ga = *(const f32x4*)gn, gb = *(const f32x4*)(gn + 4); u32x4 w;
#pragma unroll
                    for (int j = 0; j < 4; ++j) { const float g0_ = j < 2 ? ga[2 * j] : gb[2 * j - 4], g1_ = j < 2 ? ga[2 * j + 1] : gb[2 * j - 3];
                        w[j] = pk2(bf2f((unsigned short)qf[s2][2 * j]) * qs * g0_, bf2f((unsigned short)qf[s2][2 * j + 1]) * qs * g1_); }
                    qf[s2] = __builtin_bit_cast(bf16x8, w); }
                f32x16 oo[4]; float ll = 0.f;
#pragma unroll
                for (int d = 0; d < 4; ++d)
#pragma unroll
                    for (int i = 0; i < 16; ++i) oo[d][i] = 0.f;
#pragma unroll 1
                for (int tt = 0; tt < 4; ++tt) {
                    f32x16 p[2]; att::tile_scores<128>(p, qf, lds + tt * 64 * 272, lane);
                    float ls = 0.f;
#pragma unroll
                    for (int kt = 0; kt < 2; ++kt)
#pragma unroll
                        for (int i = 0; i < 16; ++i) { const float e = __builtin_amdgcn_exp2f(p[kt][i] - shiftM); p[kt][i] = e; ls += e; }
                    ll += ls;
                    att::tile_pv<128>(oo, p, lds + 69632 + tt * 64 * 320 - att::Geo<128>::KB, lane); }
                const float lt = ll + __shfl_xor(ll, 32);
                att::store_o<128>(oo, 1.0f / lt, OMEM + (size_t)row * 512 + hh * 128, lane);
            }
            SEAM(pb + 6);
        }
        if (RUN(pb + 7)) for (int rep_ = 0; rep_ < REPS(pb + 7); ++rep_) {
            int lane = (int)__builtin_amdgcn_mbcnt_hi(~0u, __builtin_amdgcn_mbcnt_lo(~0u, 0u)); asm volatile("" : "+v"(lane)); const int tid = wave * 64 + lane;
            pg8::Gemm g{OMEM, W_MO + (size_t)L * DM * 512, MTOK, DM, 512}; pg8::StaticOrder S; S.init(MTOK, DM, G, bid);
            pg8::EpiResid<false> E{out, XB, RSQ};
            pg8::gemm_phase<pg8::EpiResid<false>, pg8::StaticOrder, true, true>(lds, g, S, E, wave);
            SEAM(pb + 7);
        }
        if (RUN(pb + 8)) for (int rep_ = 0; rep_ < REPS(pb + 8); ++rep_) {
            int lane = (int)__builtin_amdgcn_mbcnt_hi(~0u, __builtin_amdgcn_mbcnt_lo(~0u, 0u)); asm volatile("" : "+v"(lane)); const int tid = wave * 64 + lane;
            pg8::Gemm g{XB, W_FI + (size_t)L * 5632 * DM, MTOK, 5632, DM}; pg8::StaticOrder S; S.init(MTOK, 5632, G, bid);
            pg8::EpiSwiGLU E{RSQ, HID};
            pg8::gemm_phase<pg8::EpiSwiGLU, pg8::StaticOrder, true, true>(lds, g, S, E, wave);
#ifdef PROBE_DUP_FFN
            if (L == 0) { __syncthreads(); pg8::gemm_phase<pg8::EpiSwiGLU, pg8::StaticOrder, true, true>(lds, g, S, E, wave); }
#endif
            SEAM(pb + 8);
        }
        if (RUN(pb + 9)) for (int rep_ = 0; rep_ < REPS(pb + 9); ++rep_) {
            int lane = (int)__builtin_amdgcn_mbcnt_hi(~0u, __builtin_amdgcn_mbcnt_lo(~0u, 0u)); asm volatile("" : "+v"(lane)); const int tid = wave * 64 + lane;
            pg8::Gemm g{HID, W_FO + (size_t)L * DM * DFF, MTOK, DM, DFF}; pg8::StaticOrder S; S.init(MTOK, DM, G, bid);
            if (L == 0) { pg8::EpiResid<false> E{out, XB, RSQ}; pg8::gemm_phase<pg8::EpiResid<false>, pg8::StaticOrder, true, true>(lds, g, S, E, wave); }
            else { pg8::EpiResid<true> E{out, XB, RSQ}; pg8::gemm_phase<pg8::EpiResid<true>, pg8::StaticOrder, true, true>(lds, g, S, E, wave); }
            SEAM(pb + 9);
        }
}

__global__ void __launch_bounds__(NWAVES * 64, 2) fwd_kernel(Args args) {
    extern __shared__ __attribute__((aligned(16))) unsigned char lds_raw[];
    LAS unsigned char* lds = (LAS unsigned char*)(unsigned)__builtin_amdgcn_readfirstlane((int)(unsigned)(size_t)(LAS unsigned char*)lds_raw);
    volatile LAS unsigned* MISC = (volatile LAS unsigned*)(lds + LDS_MISC);
    const int tid = threadIdx.x, lane = tid & 63, wave = __builtin_amdgcn_readfirstlane(tid >> 6);
    const int G = gridDim.x, bid = blockIdx.x;
    unsigned* ctl = (unsigned*)(args.ws + WS_CTL);
    for (int u = tid; u < (LDS_BYTES - LDS_MISC) / 4; u += NWAVES * 64) ((LAS unsigned*)(lds + LDS_MISC))[u] = 0u;
    __syncthreads();
    XcdBarrier bar = xcd_barrier_post(ctl + CW_BAR + args.li * XCD_BAR_WORDS, MISC + 8);
    const int lo = args.ph_lo, hi = args.ph_hi;

    if (RUN(0)) for (int rep_ = 0; rep_ < REPS(0); ++rep_) {
        LAS float* scr = (LAS float*)(lds + wave * 16384);
        const int gw = bid * NWAVES + wave, NGW = G * NWAVES;
        constexpr int I_AB = 16 * (AB_WP / 32), I_C = 16 * (C_WP / 32), I_O = 16 * 32, I_MQ = 16 * 16, I_KV = 16 * 32, I_MO = 8 * 32, I_FI = 16 * (5632 / 32), I_FO = (DFF / 64) * 32;
        constexpr int NITEMS = I_AB + I_C + 2 * I_O + 2 * I_MQ + 2 * I_KV + 2 * I_MO + 2 * I_FI + 2 * I_FO;
        for (int it = gw; it < NITEMS; it += NGW) {
            int r = it;
            if (r < I_AB) { const int nbn = AB_WP / 32; transpose_item(ab_w_in, DM, AB_W, W_AB, norm_mix, scr, r / nbn, r % nbn, lane, CMapProj0{}); continue; } r -= I_AB;
            if (r < I_C) { const int nbn = C_WP / 32; transpose_item(nsa_w_in, DM, C_W, W_C, norm_mix + DM, scr, r / nbn, r % nbn, lane, CMapProj1{}); continue; } r -= I_C;
            if (r < I_O) { transpose_item(ab_w_out, DM, DM, W_ABO, nullptr, scr, r / 32, r % 32, lane, CMapId{DM}); continue; } r -= I_O;
            if (r < I_O) { transpose_item(nsa_w_out, DM, DM, W_CO, nullptr, scr, r / 32, r % 32, lane, CMapId{DM}); continue; } r -= I_O;
            if (r < 2 * I_MQ) { const int L = r / I_MQ; r %= I_MQ; transpose_item(mem_w_q + (size_t)L * DM * 512, DM, 512, W_MQ + (size_t)L * 512 * DM, norm_mem + L * DM, scr, r / 16, r % 16, lane, CMapId{512}); continue; } r -= 2 * I_MQ;
            if (r < 2 * I_KV) { const int L = r / I_KV; r %= I_KV; transpose_item(mem_w_kv + (size_t)L * DM * 1024, DM, 1024, W_KV + (size_t)L * 1024 * DM, norm_mem_src + L * DM, scr, r / 32, r % 32, lane, CMapId{1024}); continue; } r -= 2 * I_KV;
            if (r < 2 * I_MO) { const int L = r / I_MO; r %= I_MO; transpose_item(mem_w_o + (size_t)L * 512 * DM, 512, DM, W_MO + (size_t)L * DM * 512, nullptr, scr, r / 32, r % 32, lane, CMapId{DM}); continue; } r -= 2 * I_MO;
            if (r < 2 * I_FI) { const int L = r / I_FI; r %= I_FI; const int nbn = 5632 / 32; transpose_item(ffn_w_in + (size_t)L * DM * 5632, DM, 5632, W_FI + (size_t)L * 5632 * DM, norm_ffn + L * DM, scr, r / nbn, r % nbn, lane, CMapFfn{}); continue; } r -= 2 * I_FI;
            { const int L = r / I_FO; r %= I_FO; transpose_item(ffn_w_out + (size_t)L * DFF * DM, DFF, DM, W_FO + (size_t)L * DM * DFF, nullptr, scr, r / 32, r % 32, lane, CMapId{DM}); }
        }
        for (int m = gw; m < MTOK; m += 4 * NGW) {
            int mr[4]; f32x4 v[4][4]; float sq[4];
#pragma unroll
            for (int q = 0; q < 4; ++q) { mr[q] = m + q * NGW < MTOK ? m + q * NGW : m; const f32x4* xr = (const f32x4*)(x_in + (size_t)mr[q] * DM) + lane;
#pragma unroll
                for (int j = 0; j < 4; ++j) v[q][j] = xr[64 * j]; }
#pragma unroll
            for (int q = 0; q < 4; ++q) { float a = 0.f;
#pragma unroll
                for (int j = 0; j < 4; ++j) a += (v[q][j][0] * v[q][j][0] + v[q][j][1] * v[q][j][1]) + (v[q][j][2] * v[q][j][2] + v[q][j][3] * v[q][j][3]);
                sq[q] = a; }
#pragma unroll
            for (int o = 1; o < 64; o <<= 1) {
#pragma unroll
                for (int q = 0; q < 4; ++q) sq[q] += __shfl_xor(sq[q], o); }
#pragma unroll
            for (int q = 0; q < 4; ++q) { u32x2* xbr = (u32x2*)(XB + (size_t)mr[q] * DM) + lane;
#pragma unroll
                for (int j = 0; j < 4; ++j) { u32x2 w; w.x = pk2(v[q][j][0], v[q][j][1]); w.y = pk2(v[q][j][2], v[q][j][3]); xbr[64 * j] = w; }
                if (lane < 16) RSQ[(size_t)mr[q] * 16 + lane] = (lane == 0) ? sq[q] : 0.f; }
        }
        for (int i = bid * 512 + tid; i < MTOK * 12; i += G * 512) {
            const int m = i / 12, k = i % 12;
            const float f64t[8] = {1.0f, 0.19392274474868576f, 0.03760603093086393f, 0.007292664737217109f, 0.001414213562373095f, 0.0002742481756762073f, 5.318295896944988e-05f, 1.031338537721246e-05f};
            float fr;
            if (k < 8) fr = f64t[k]; else { const int q = k - 8; fr = (q == 0) ? 1.0f : (q == 1) ? 0.03760603093086393f : (q == 2) ? 0.001414213562373095f : 5.318295896944988e-05f; }
            const float ang = (float)positions[m] * fr;
            const double rev = (double)ang * 0.15915494309189535; const float frac = (float)(rev - __builtin_rint(rev));
            const float c = __builtin_amdgcn_cosf(frac), sn = __builtin_amdgcn_sinf(frac);
            if (k < 8) { ROPE64[(size_t)m * 16 + k] = c; ROPE64[(size_t)m * 16 + 8 + k] = sn; } else { ROPE32[(size_t)m * 8 + (k - 8)] = c; ROPE32[(size_t)m * 8 + 4 + (k - 8)] = sn; }
        }
        for (int it = gw; it < 128; it += NGW) { const int kv = it >> 6, r = it & 63;
            transpose_item(kv ? nsa_cmp_w1_v : nsa_cmp_w1_k, 2048, 64, W1T + (size_t)kv * 64 * 2048, nullptr, scr, r >> 1, r & 1, lane, CMapId{64}); }
        for (int it = (NGW - 1 - gw); it < 128; it += NGW) { const int kv = it >> 6, c = it & 63; const float* pe = kv ? nsa_cmp_pos_v : nsa_cmp_pos_k; const float* w1 = kv ? nsa_cmp_w1_v : nsa_cmp_w1_k;
            float a = 0.f;
            for (int k0 = 0; k0 < 2048; k0 += 512) { float pv[8], wv[8];
#pragma unroll
                for (int j = 0; j < 8; ++j) { const int k = k0 + 64 * j + lane; pv[j] = pe[k]; wv[j] = w1[(size_t)k * 64 + c]; }
#pragma unroll
                for (int j = 0; j < 8; ++j) a += pv[j] * wv[j]; }
            a = wave_sum(a); if (lane == 0) POSW1[kv * 64 + c] = a; }
        for (int m = gw; m < MMEM; m += NGW) {
            const f32x4* xr = (const f32x4*)(mem_in + (size_t)m * DM) + lane; f32x4 v[4]; float s = 0.f;
#pragma unroll
            for (int j = 0; j < 4; ++j) { v[j] = xr[64 * j]; s += (v[j][0] * v[j][0] + v[j][1] * v[j][1]) + (v[j][2] * v[j][2] + v[j][3] * v[j][3]); }
            s = wave_sum(s);
            u32x2* xbr = (u32x2*)(MEMB + (size_t)m * DM) + lane;
#pragma unroll
            for (int j = 0; j < 4; ++j) { u32x2 w; w.x = pk2(v[j][0], v[j][1]); w.y = pk2(v[j][2], v[j][3]); xbr[64 * j] = w; }
            if (lane == 0) MRS[m] = __builtin_amdgcn_rsqf(s * (1.0f / 1024.0f) + RMS_EPS);
        }
        SEAM(0);
    }

    layer_phases<0>(args, lds, bar, lo, hi, wave);
    layer_phases<1>(args, lds, bar, lo, hi, wave);
#undef RUN
#undef SEAM
}
#undef INF_
#undef x_in
#undef mem_in
#undef positions
#undef norm_mix
#undef norm_mem
#undef norm_mem_src
#undef norm_ffn
#undef ab_w_in
#undef ab_w_out
#undef nsa_w_in
#undef nsa_w_out
#undef mem_w_q
#undef mem_w_kv
#undef mem_w_o
#undef ffn_w_in
#undef ffn_w_out
#undef out
#undef WSB
#undef W_AB
#undef W_C
#undef W_ABO
#undef W_CO
#undef W_MQ
#undef W_KV
#undef W_MO
#undef W_FI
#undef W_FO
#undef XB
#undef RSQ
#undef HID
#undef MEMB
#undef KVRAW
#undef MRS
#undef MQB
#undef OMEM
#undef mem_q_norm
#undef RAW
#undef OATT
#undef ROPE64
#undef ROPE32
#undef W1T
#undef POSW1
#undef KCMP
#undef VCMP
#undef GT
#undef nsa_q_norm
#undef SCR
#undef BMK
#undef KMEAN
#undef IWB
#undef dsa_q_norm
#undef dsa_k_norm
#undef moba_q_norm
#undef moba_k_norm
#undef nsa_kcmp_norm
#undef nsa_ksel_norm
#undef nsa_kwin_norm
#undef nsa_cmp_pos_k
#undef nsa_cmp_pos_v
#undef nsa_cmp_w1_k
#undef nsa_cmp_w2_k
#undef nsa_cmp_w1_v
#undef nsa_cmp_w2_v
#undef mem_k_norm

extern "C" void kernel_launch(void* const* d_in, const int* in_sizes, int n_in, void* d_out, int out_size, void* d_ws, size_t ws_size, hipStream_t stream) {
    static int grid = 0;
    if (grid == 0) {
        if (n_in != 32 || out_size != MTOK * DM || ws_size < WS_END) { fprintf(stderr, "kernel_launch: unexpected shapes (n_in %d out %d ws %zu)\n", n_in, out_size, ws_size); grid = -1; return; }
        int dev = 0, cus = 0, per_cu = 0;
        if (hipGetDevice(&dev) != hipSuccess || hipDeviceGetAttribute(&cus, hipDeviceAttributeMultiprocessorCount, dev) != hipSuccess) { grid = -1; return; }
        if (hipFuncSetAttribute((const void*)fwd_kernel, hipFuncAttributeMaxDynamicSharedMemorySize, LDS_BYTES) != hipSuccess) { fprintf(stderr, "kernel_launch: hipFuncSetAttribute failed\n"); grid = -1; return; }
        if (hipOccupancyMaxActiveBlocksPerMultiprocessor(&per_cu, (const void*)fwd_kernel, NWAVES * 64, LDS_BYTES) != hipSuccess || per_cu < 1) fprintf(stderr, "kernel_launch: occupancy query says %d\n", per_cu);
        (void)hipGetLastError();
        grid = cus;
    }
    if (grid < 0) return;
    if (hipMemsetAsync((char*)d_ws + WS_CTL, 0, CTL_ZERO_BYTES, stream) != hipSuccess) return;
    Args a{};
    for (int i = 0; i < 32; ++i) a.in[i] = d_in[i];
    a.out = (float*)d_out; a.ws = (unsigned char*)d_ws; a.pad = 0;
    const int NPH = 21;
#if 0
    for (int p = 0; p < NPH; ++p) { a.ph_lo = p; a.ph_hi = p + 1; a.li = 0; hipLaunchKernelGGL(fwd_kernel, dim3(grid), dim3(NWAVES * 64), LDS_BYTES, stream, a); }
#else
    a.ph_lo = 0; a.ph_hi = NPH; a.li = 0; hipLaunchKernelGGL(fwd_kernel, dim3(grid), dim3(NWAVES * 64), LDS_BYTES, stream, a);
#endif
}
```

```cpp
#include <hip/hip_runtime.h>
#include <cstdio>
#include <cstdint>
#include <type_traits>

#define LAS __attribute__((address_space(3)))
#define GAS __attribute__((address_space(1)))
typedef unsigned short bf16_t;
typedef short bf16x8 __attribute__((ext_vector_type(8)));
typedef short s16x4 __attribute__((ext_vector_type(4)));
typedef float f32x4 __attribute__((ext_vector_type(4)));
typedef float f32x2 __attribute__((ext_vector_type(2)));
typedef float f32x16 __attribute__((ext_vector_type(16)));
typedef unsigned u32x4 __attribute__((ext_vector_type(4)));
typedef unsigned u32x2 __attribute__((ext_vector_type(2)));
typedef __bf16 bf16x2_t __attribute__((ext_vector_type(2)));

constexpr int BATCH = 8, SEQ = 4096, DM = 1024, MTOK = BATCH * SEQ;
constexpr int NMEM = 256, MMEM = BATCH * NMEM;
constexpr int DFF = 2816;
constexpr int AB_W = 2472, AB_WP = 2560;
constexpr int C_W = 2608, C_WP = 2816;
constexpr float RMS_EPS = 1e-6f;
constexpr float LOG2E = 1.4426950408889634f;

namespace pg8 {
constexpr int BM = 256, BK = 64, HALF = 128, HTB = HALF * BK * 2, STAGE_BYTES = 8 * HTB, NXCD = 8, WGM = 8;
__host__ __device__ __forceinline__ int lds_byte(int r, int c) { const int st = (r >> 4) * 2 + (c >> 5), rr = r & 15, cc = c & 31, ob = rr * 64 + cc * 2; return st * 1024 + (ob ^ (((ob >> 9) & 1) << 5)); }
__host__ __device__ __forceinline__ void stage_rc(int b, int& R, int& C) { const int st = b / 1024, sb = b % 1024, swz = sb ^ (((sb >> 9) & 1) << 5); R = (st >> 1) * 16 + swz / 64; C = (st & 1) * 32 + (swz % 64) / 2; }
__host__ __device__ __forceinline__ int perm32(int rho) { const int n = rho >> 4, i = rho & 15; return 8 * (i >> 2) + 4 * n + (i & 3); }
struct Unit { int pm, pn; };
struct Gemm { const bf16_t* A; const bf16_t* Bt; int M, N, K; };
struct StaticOrder {
    int nM, nN, nwg, G, c;
    __host__ __device__ void init(int M, int N, int G_, int c_) { nM = M / BM; nN = N / BM; nwg = nM * nN; G = G_; c = c_; }
    __host__ __device__ bool next(int i, Unit& u) const {
        const long L = (long)i * G + c; if (L >= nwg) return false;
        int wgid = (int)L; { const int q = nwg / NXCD, r = nwg % NXCD, xcd = wgid % NXCD, off = wgid / NXCD; wgid = (xcd < r ? xcd * (q + 1) : r * (q + 1) + (xcd - r) * q) + off; }
        const int nig = WGM * nN, gid = wgid / nig, fm = gid * WGM, gsz = (nM - fm) < WGM ? (nM - fm) : WGM;
        u.pm = fm + ((wgid % nig) % gsz); u.pn = (wgid % nig) / gsz; return true;
    }
    __device__ __forceinline__ void a_ready(const Unit&) const {}
    __device__ __forceinline__ void done(const Unit&) const {}
};
__device__ __forceinline__ unsigned cvt_pk_bf16(float lo, float hi) { unsigned r; asm volatile("v_cvt_pk_bf16_f32 %0, %1, %2" : "=v"(r) : "v"(lo), "v"(hi)); return r; }

struct EpiPlain {
    static constexpr bool PERM = true, AFTER_DRAIN = false;
    bf16_t* O; int ldc;
    __device__ __forceinline__ void operator()(const f32x4 (&acc)[2][2][4][2], const Unit& u, int wr, int wc, int fr, int fq) const {
        const int row0 = u.pm * BM + wr * 64 + fr, col0 = u.pn * BM + wc * 32 + 8 * fq;
#pragma unroll
        for (int ai = 0; ai < 2; ++ai)
#pragma unroll
            for (int m = 0; m < 4; ++m) { bf16_t* rowp = O + (size_t)(row0 + ai * HALF + m * 16) * ldc + col0;
#pragma unroll
                for (int bj = 0; bj < 2; ++bj) { const f32x4 v0 = acc[ai][bj][m][0], v1 = acc[ai][bj][m][1];
                    u32x4 w; w.x = cvt_pk_bf16(v0[0], v0[1]); w.y = cvt_pk_bf16(v0[2], v0[3]); w.z = cvt_pk_bf16(v1[0], v1[1]); w.w = cvt_pk_bf16(v1[2], v1[3]);
                    *(u32x4*)(rowp + bj * HALF) = w; } }
    }
};
template <bool FINAL> struct EpiResid {
    static constexpr bool PERM = true, AFTER_DRAIN = false;
    float* out; bf16_t* xb; float* rsq;
    __device__ __forceinline__ void operator()(const f32x4 (&acc)[2][2][4][2], const Unit& u, int wr, int wc, int fr, int fq) const {
        const int col0 = u.pn * BM + wc * 32 + 8 * fq;
#pragma unroll
        for (int ai = 0; ai < 2; ++ai) {
            u32x4 rb[4][2];
#pragma unroll
            for (int m = 0; m < 4; ++m)
#pragma unroll
                for (int bj = 0; bj < 2; ++bj) rb[m][bj] = *(const u32x4*)(xb + (size_t)(u.pm * BM + ai * HALF + wr * 64 + m * 16 + fr) * 1024 + col0 + bj * HALF);
#pragma unroll
            for (int m = 0; m < 4; ++m) { const int row = u.pm * BM + ai * HALF + wr * 64 + m * 16 + fr; const size_t off = (size_t)row * 1024 + col0; float ss = 0.f;
#pragma unroll
                for (int bj = 0; bj < 2; ++bj) { const size_t o = off + bj * HALF; const u32x4 r4 = rb[m][bj]; float v[8];
#pragma unroll
                    for (int k = 0; k < 4; ++k) { v[2 * k] = acc[ai][bj][m][k >> 1][(2 * k) & 3] + __builtin_bit_cast(float, r4[k] << 16); v[2 * k + 1] = acc[ai][bj][m][k >> 1][(2 * k + 1) & 3] + __builtin_bit_cast(float, r4[k] & 0xffff0000u); }
                    if (FINAL) { *(f32x4*)(out + o) = (f32x4){v[0], v[1], v[2], v[3]}; *(f32x4*)(out + o + 4) = (f32x4){v[4], v[5], v[6], v[7]}; }
                    else { u32x4 w; w.x = cvt_pk_bf16(v[0], v[1]); w.y = cvt_pk_bf16(v[2], v[3]); w.z = cvt_pk_bf16(v[4], v[5]); w.w = cvt_pk_bf16(v[6], v[7]); *(u32x4*)(xb + o) = w;
#pragma unroll
                        for (int k = 0; k < 4; ++k) { const float r0 = __builtin_bit_cast(float, w[k] << 16), r1 = __builtin_bit_cast(float, w[k] & 0xffff0000u); ss += r0 * r0 + r1 * r1; } } }
                if (!FINAL) { ss += __shfl_xor(ss, 16); ss += __shfl_xor(ss, 32);
                    if (fq == 0) rsq[(size_t)row * 16 + u.pn * 4 + wc] = ss; } }
            asm volatile("" ::: "memory");
        }
    }
};
struct EpiSwiGLU {
    static constexpr bool PERM = true, AFTER_DRAIN = false;
    const float* rsq; bf16_t* hid;
    __device__ __forceinline__ void operator()(const f32x4 (&acc)[2][2][4][2], const Unit& u, int wr, int wc, int fr, int fq) const {
        const int col0 = u.pn * 128 + wc * 32 + 8 * fq;
        f32x4 pr[2][4];
#pragma unroll
        for (int ai = 0; ai < 2; ++ai)
#pragma unroll
            for (int m = 0; m < 4; ++m) pr[ai][m] = *(const f32x4*)(rsq + (size_t)(u.pm * BM + ai * HALF + wr * 64 + m * 16 + fr) * 16 + 4 * fq);
#pragma unroll
        for (int ai = 0; ai < 2; ++ai)
#pragma unroll
            for (int m = 0; m < 4; ++m) { const int row = u.pm * BM + ai * HALF + wr * 64 + m * 16 + fr;
                float ss = (pr[ai][m][0] + pr[ai][m][1]) + (pr[ai][m][2] + pr[ai][m][3]);
                ss += __shfl_xor(ss, 16); ss += __shfl_xor(ss, 32);
                const float c = __builtin_amdgcn_rsqf(ss * (1.0f / 1024.0f) + RMS_EPS);
                float h[8];
#pragma unroll
                for (int n = 0; n < 2; ++n)
#pragma unroll
                    for (int e = 0; e < 4; ++e) { const float g = acc[ai][0][m][n][e] * c, uu = acc[ai][1][m][n][e] * c;
                        const float sg = g * __builtin_amdgcn_rcpf(1.0f + __builtin_amdgcn_exp2f(-g * LOG2E)); h[n * 4 + e] = sg * uu; }
                u32x4 w; w.x = cvt_pk_bf16(h[0], h[1]); w.y = cvt_pk_bf16(h[2], h[3]); w.z = cvt_pk_bf16(h[4], h[5]); w.w = cvt_pk_bf16(h[6], h[7]);
                *(u32x4*)(hid + (size_t)row * DFF + col0) = w; }
    }
};

struct ProjUnit { int kind; const float* gain; float scale; bool rope; };
template <int L> struct EpiProj {
    static constexpr bool PERM = true, AFTER_DRAIN = false;
    bf16_t* O; int ldc; const float* rsq; const float* rope64; const float* rope32; const float* g0; const float* g1; const float* g2; const float* g3; float* aux;
    __device__ __forceinline__ ProjUnit classify(int unit) const {
        constexpr float C2 = 0.125f * LOG2E;
        if (L == 0) {
            if (unit < 8) return {1, g0, C2, true}; if (unit == 8) return {1, g1, 1.f, true}; if (unit == 9) return {2, nullptr, 1.f, false};
            if (unit < 14) return {4, nullptr, 1.f, false}; if (unit == 14) return {5, nullptr, 1.f, false};
            if (unit < 23) return {1, g2, C2, true}; if (unit < 31) return {1, g3, 1.f, true}; if (unit < 39) return {2, nullptr, 1.f, false}; return {0, nullptr, 1.f, false};
        } else {
            if (unit < 16) return {1, g0, C2, false}; if (unit < 24) return {3, nullptr, 1.f, false};
            if (unit < 28) return {1, g1, 1.f, true}; if (unit < 32) return {2, nullptr, 1.f, false}; if (unit < 36) return {1, g2, 1.f, true}; if (unit < 40) return {2, nullptr, 1.f, false};
            if (unit == 40) return {6, nullptr, 1.f, false}; return {0, nullptr, 1.f, false};
        }
    }
    __device__ __forceinline__ void operator()(const f32x4 (&acc)[2][2][4][2], const Unit& u, int wr, int wc, int fr, int fq) const {
        const int unit = 4 * u.pn + wc; const ProjUnit pu = classify(unit);
        if (pu.kind == 0) return;
        float gl[2][8];
        if (pu.kind == 1) {
#pragma unroll
            for (int bj = 0; bj < 2; ++bj) { const f32x4 a = *(const f32x4*)(pu.gain + 8 * (2 * fq + bj)), b = *(const f32x4*)(pu.gain + 8 * (2 * fq + bj) + 4);
#pragma unroll
                for (int x = 0; x < 4; ++x) { gl[bj][x] = a[x] * pu.scale; gl[bj][4 + x] = b[x] * pu.scale; } }
        }
        float rsv[2][4];
        if (pu.kind != 3) { f32x4 pr[2][4];
#pragma unroll
            for (int ai = 0; ai < 2; ++ai)
#pragma unroll
                for (int m = 0; m < 4; ++m) pr[ai][m] = *(const f32x4*)(rsq + (size_t)(u.pm * BM + ai * HALF + wr * 64 + m * 16 + fr) * 16 + 4 * fq);
#pragma unroll
            for (int ai = 0; ai < 2; ++ai)
#pragma unroll
                for (int m = 0; m < 4; ++m) { float ss = (pr[ai][m][0] + pr[ai][m][1]) + (pr[ai][m][2] + pr[ai][m][3]); ss += __shfl_xor(ss, 16); ss += __shfl_xor(ss, 32);
                    rsv[ai][m] = __builtin_amdgcn_rsqf(ss * (1.0f / 1024.0f) + RMS_EPS); } }
        else {
#pragma unroll
            for (int ai = 0; ai < 2; ++ai)
#pragma unroll
                for (int m = 0; m < 4; ++m) rsv[ai][m] = 1.f; }
#pragma unroll
        for (int ai = 0; ai < 2; ++ai)
#pragma unroll
            for (int m = 0; m < 4; ++m) { const int row = u.pm * BM + ai * HALF + wr * 64 + m * 16 + fr;
                const float rs = rsv[ai][m];
                float v[2][8];
#pragma unroll
                for (int bj = 0; bj < 2; ++bj)
#pragma unroll
                    for (int e = 0; e < 8; ++e) v[bj][e] = acc[ai][bj][m][e >> 2][e & 3] * rs;
                if (pu.kind == 1) {
                    float ss = 0.f;
#pragma unroll
                    for (int bj = 0; bj < 2; ++bj)
#pragma unroll
                        for (int e = 0; e < 8; ++e) ss += v[bj][e] * v[bj][e];
                    ss += __shfl_xor(ss, 16); ss += __shfl_xor(ss, 32);
                    const float rn = __builtin_amdgcn_rsqf(ss * (1.0f / 64.0f) + RMS_EPS);
#pragma unroll
                    for (int bj = 0; bj < 2; ++bj)
#pragma unroll
                        for (int e = 0; e < 8; ++e) v[bj][e] = v[bj][e] * rn * gl[bj][e];
                    if (pu.rope && fq == 0) {
                        const float* cs = rope64 + (size_t)row * 16; const f32x4 c0 = *(const f32x4*)cs, c1 = *(const f32x4*)(cs + 4), s0 = *(const f32x4*)(cs + 8), s1 = *(const f32x4*)(cs + 12);
#pragma unroll
                        for (int e = 0; e < 8; ++e) { const float c = e < 4 ? c0[e & 3] : c1[e & 3], sn = e < 4 ? s0[e & 3] : s1[e & 3]; const float x1 = v[0][e], x2 = v[1][e];
                            v[0][e] = x1 * c - x2 * sn; v[1][e] = x2 * c + x1 * sn; }
                    }
                }
                if (pu.kind == 4 || pu.kind == 5) {
                    if (fq == 0 || (fq == 2 && pu.kind == 4)) { const float* cs = rope32 + (size_t)row * 8; const f32x4 c = *(const f32x4*)cs, sn = *(const f32x4*)(cs + 4);
#pragma unroll
                        for (int x = 0; x < 4; ++x) { const float a = v[0][x], b = v[0][4 + x]; v[0][x] = a * c[x] - b * sn[x]; v[0][4 + x] = b * c[x] + a * sn[x]; } }
                    if (pu.kind == 5 && fq == 2) { *(f32x4*)(aux + (size_t)row * 8) = (f32x4){v[0][0], v[0][1], v[0][2], v[0][3]}; *(f32x4*)(aux + (size_t)row * 8 + 4) = (f32x4){v[0][4], v[0][5], v[0][6], v[0][7]}; }
                }
                if (pu.kind == 6) {
#pragma unroll
                    for (int bj = 0; bj < 2; ++bj) if (2 * fq + bj < 6) {
#pragma unroll
                        for (int e = 0; e < 8; ++e) v[bj][e] = __builtin_amdgcn_rcpf(1.0f + __builtin_amdgcn_exp2f(-v[bj][e] * LOG2E));
                        float* ap = aux + (size_t)row * 48 + 8 * (2 * fq + bj);
                        *(f32x4*)ap = (f32x4){v[bj][0], v[bj][1], v[bj][2], v[bj][3]}; *(f32x4*)(ap + 4) = (f32x4){v[bj][4], v[bj][5], v[bj][6], v[bj][7]}; }
                } else {
                    bf16_t* orow = O + (size_t)row * ldc + 64 * unit + 16 * fq;
                    u32x4 w0, w1;
                    w0.x = cvt_pk_bf16(v[0][0], v[0][1]); w0.y = cvt_pk_bf16(v[0][2], v[0][3]); w0.z = cvt_pk_bf16(v[0][4], v[0][5]); w0.w = cvt_pk_bf16(v[0][6], v[0][7]);
                    w1.x = cvt_pk_bf16(v[1][0], v[1][1]); w1.y = cvt_pk_bf16(v[1][2], v[1][3]); w1.z = cvt_pk_bf16(v[1][4], v[1][5]); w1.w = cvt_pk_bf16(v[1][6], v[1][7]);
                    *(u32x4*)orow = w0; *(u32x4*)(orow + 8) = w1;
                }
                if (m & 1) asm volatile("" ::: "memory"); }
    }
};

template <class Epi, class Sched, bool ALIGN_EPI = false, bool SP2 = false>
__device__ __forceinline__ void gemm_phase(LAS unsigned char* lds, const Gemm g, const Sched& S, const Epi& E, const int wave_id) {
    int tid = wave_id * 64 + (int)__builtin_amdgcn_mbcnt_hi(~0u, __builtin_amdgcn_mbcnt_lo(~0u, 0u)); asm volatile("" : "+v"(tid));
    const int wid = wave_id, lane = tid & 63, wr = wid >> 2, wc = wid & 3, fr = lane & 15, fq = lane >> 4;
    const int K = g.K, nt = K / BK;
    unsigned voffA[2], voffB[2];
#pragma unroll
    for (int i = 0; i < 2; ++i) { int R, C; stage_rc(tid * 16 + i * 8192, R, C); const int Rb = Epi::PERM ? ((R & ~31) + perm32(R & 31)) : R;
        voffA[i] = (unsigned)(R * K + C) * 2u; voffB[i] = (unsigned)(Rb * K + C) * 2u; }
    const size_t kstep = (size_t)(BK * 2);
    const size_t hstep = (size_t)HALF * K * 2;
    const size_t tstep = 2 * hstep;
    const unsigned ldsw = (unsigned)wid * 1024u;
    const int aoff = lds_byte(wr * 64 + fr, fq * 8), boff = lds_byte(wc * 32 + fr, fq * 8);
#define PG8_SA(b, h) (((b) * 2 + (h)) * HTB)
#define PG8_SB(b, h) ((4 + (b) * 2 + (h)) * HTB)
#define PG8_STAGE(bufoff, gbase, voff) do { _Pragma("unroll") for (int _i = 0; _i < 2; ++_i) \
        __builtin_amdgcn_global_load_lds((const unsigned*)((const char*)(gbase) + (voff)[_i]), (LAS unsigned*)(lds + (bufoff) + ldsw + _i * 8192), 16, 0, 0); } while (0)
#define PG8_LDA(dst, b, h) do { _Pragma("unroll") for (int m = 0; m < 4; ++m) _Pragma("unroll") for (int k = 0; k < 2; ++k) dst[m][k] = *(const LAS bf16x8*)(lds + PG8_SA(b, h) + aoff + m * 2048 + k * 1024); } while (0)
#define PG8_LDB(dst, b, h) do { _Pragma("unroll") for (int n = 0; n < 2; ++n) _Pragma("unroll") for (int k = 0; k < 2; ++k) dst[n][k] = *(const LAS bf16x8*)(lds + PG8_SB(b, h) + boff + n * 2048 + k * 1024); } while (0)
#define PG8_MMA(ai, bj, At, Bt) do { __builtin_amdgcn_s_setprio(1); _Pragma("unroll") for (int m = 0; m < 4; ++m) _Pragma("unroll") for (int n = 0; n < 2; ++n) _Pragma("unroll") for (int k = 0; k < 2; ++k) \
        acc[ai][bj][m][n] = __builtin_amdgcn_mfma_f32_16x16x32_bf16(Bt[n][k], At[m][k], acc[ai][bj][m][n], 0, 0, 0); __builtin_amdgcn_s_setprio(0); } while (0)
#define PG8_WAIT_V(n) asm volatile("s_waitcnt vmcnt(" #n ")" ::: "memory")
#define PG8_WAIT_L(n) asm volatile("s_waitcnt lgkmcnt(" #n ")" ::: "memory")
#define PG8_BAR __builtin_amdgcn_s_barrier()
#define PG8_SCHED __builtin_amdgcn_sched_barrier(0)
    Unit cur, nxt; int ui = 0;
    if (!S.next(0, cur)) return;
    f32x4 acc[2][2][4][2];
#pragma unroll
    for (int a = 0; a < 2; ++a)
#pragma unroll
        for (int b = 0; b < 2; ++b)
#pragma unroll
            for (int m = 0; m < 4; ++m)
#pragma unroll
                for (int n = 0; n < 2; ++n) acc[a][b][m][n] = (f32x4){0.f, 0.f, 0.f, 0.f};
    bf16x8 At[4][2], B0[2][2], B1[2][2];
    const char* cA = (const char*)g.A + (size_t)cur.pm * tstep; const char* cB = (const char*)g.Bt + (size_t)cur.pn * tstep;
    S.a_ready(cur);
    if constexpr (SP2) {
        PG8_STAGE(PG8_SB(0, 0), cB, voffB); PG8_STAGE(PG8_SB(0, 1), cB + hstep, voffB); PG8_STAGE(PG8_SA(0, 0), cA, voffA); PG8_STAGE(PG8_SA(0, 1), cA + hstep, voffA);
        if (wr == 1) PG8_BAR;
        PG8_WAIT_V(2); PG8_BAR;
        PG8_STAGE(PG8_SB(1, 0), cB + kstep, voffB); PG8_STAGE(PG8_SA(1, 0), cA + kstep, voffA); PG8_STAGE(PG8_SB(1, 1), cB + hstep + kstep, voffB);
        PG8_WAIT_V(6); PG8_BAR;
    } else {
        PG8_STAGE(PG8_SB(0, 0), cB, voffB); PG8_STAGE(PG8_SA(0, 0), cA, voffA); PG8_STAGE(PG8_SB(0, 1), cB + hstep, voffB); PG8_STAGE(PG8_SA(0, 1), cA + hstep, voffA);
        if (wr == 1) PG8_BAR;
        PG8_WAIT_V(4); PG8_BAR;
        PG8_STAGE(PG8_SB(1, 0), cB + kstep, voffB); PG8_STAGE(PG8_SA(1, 0), cA + kstep, voffA); PG8_STAGE(PG8_SB(1, 1), cB + hstep + kstep, voffB);
        PG8_WAIT_V(6); PG8_BAR;
    }
    for (;;) {
        const bool has_next = S.next(ui + 1, nxt);
        const char* nA = has_next ? (const char*)g.A + (size_t)nxt.pm * tstep : cA; const char* nB = has_next ? (const char*)g.Bt + (size_t)nxt.pn * tstep : cB;
        for (int t = 0; t < nt; t += 2) {
            const bool last = (t == nt - 2);
            const char* a1 = cA + (size_t)(t + 1) * kstep;
            const char* a2 = last ? nA : cA + (size_t)(t + 2) * kstep; const char* b2 = last ? nB : cB + (size_t)(t + 2) * kstep;
            const char* a3 = a2 + kstep; const char* b3 = b2 + kstep;
            if (last && has_next) S.a_ready(nxt);
            if constexpr (SP2) {
            PG8_LDB(B0, 0, 0); PG8_LDB(B1, 0, 1); PG8_SCHED; PG8_LDA(At, 0, 0); PG8_STAGE(PG8_SA(1, 1), a1 + hstep, voffA);
            PG8_WAIT_V(8); PG8_WAIT_L(0); PG8_BAR; PG8_MMA(0, 0, At, B0); PG8_MMA(0, 1, At, B1); PG8_BAR; PG8_SCHED;
            PG8_LDA(At, 0, 1); PG8_STAGE(PG8_SB(0, 0), b2, voffB); PG8_STAGE(PG8_SB(0, 1), b2 + hstep, voffB); PG8_STAGE(PG8_SA(0, 0), a2, voffA);
            PG8_WAIT_V(8); PG8_WAIT_L(0); PG8_BAR; PG8_MMA(1, 0, At, B0); PG8_MMA(1, 1, At, B1); PG8_BAR; PG8_SCHED;
            PG8_LDB(B0, 1, 0); PG8_LDB(B1, 1, 1); PG8_SCHED; PG8_LDA(At, 1, 0); PG8_STAGE(PG8_SA(0, 1), a2 + hstep, voffA);
            PG8_WAIT_V(8); PG8_WAIT_L(0); PG8_BAR; PG8_MMA(0, 0, At, B0); PG8_MMA(0, 1, At, B1); PG8_BAR; PG8_SCHED;
            PG8_LDA(At, 1, 1); PG8_STAGE(PG8_SB(1, 0), b3, voffB); PG8_STAGE(PG8_SB(1, 1), b3 + hstep, voffB); PG8_STAGE(PG8_SA(1, 0), a3, voffA);
            PG8_WAIT_V(8); PG8_WAIT_L(0); PG8_BAR; PG8_MMA(1, 0, At, B0); PG8_MMA(1, 1, At, B1); PG8_BAR; PG8_SCHED;
            } else {
            PG8_LDB(B0, 0, 0); PG8_SCHED; PG8_LDA(At, 0, 0); PG8_STAGE(PG8_SA(1, 1), a1 + hstep, voffA);
            PG8_WAIT_L(8); PG8_BAR; PG8_WAIT_L(0); PG8_MMA(0, 0, At, B0); PG8_BAR; PG8_SCHED;
            PG8_LDB(B1, 0, 1); PG8_STAGE(PG8_SB(0, 0), b2, voffB);
            PG8_BAR; PG8_WAIT_L(0); PG8_MMA(0, 1, At, B1); PG8_BAR;
            PG8_LDA(At, 0, 1); PG8_STAGE(PG8_SA(0, 0), a2, voffA);
            PG8_BAR; PG8_WAIT_L(0); PG8_MMA(1, 0, At, B0); PG8_BAR; PG8_SCHED;
            PG8_STAGE(PG8_SB(0, 1), b2 + hstep, voffB);
            PG8_WAIT_V(6); PG8_BAR; PG8_MMA(1, 1, At, B1); PG8_BAR;
            PG8_LDB(B0, 1, 0); PG8_SCHED; PG8_LDA(At, 1, 0); PG8_STAGE(PG8_SA(0, 1), a2 + hstep, voffA);
            PG8_WAIT_L(8); PG8_BAR; PG8_WAIT_L(0); PG8_MMA(0, 0, At, B0); PG8_BAR; PG8_SCHED;
            PG8_LDB(B1, 1, 1); PG8_STAGE(PG8_SB(1, 0), b3, voffB);
            PG8_BAR; PG8_WAIT_L(0); PG8_MMA(0, 1, At, B1); PG8_BAR;
            PG8_LDA(At, 1, 1); PG8_STAGE(PG8_SA(1, 0), a3, voffA);
            PG8_BAR; PG8_WAIT_L(0); PG8_MMA(1, 0, At, B0); PG8_BAR; PG8_SCHED;
            PG8_STAGE(PG8_SB(1, 1), b3 + hstep, voffB);
            PG8_WAIT_V(6); PG8_BAR; PG8_MMA(1, 1, At, B1); PG8_BAR;
            }
        }
        if constexpr (ALIGN_EPI) { if (wr == 0) PG8_BAR; }
        if constexpr (!Epi::AFTER_DRAIN) { E(acc, cur, wr, wc, fr, fq); S.done(cur); }
        if (!has_next) break;
#pragma unroll
        for (int a = 0; a < 2; ++a)
#pragma unroll
            for (int b = 0; b < 2; ++b)
#pragma unroll
                for (int m = 0; m < 4; ++m)
#pragma unroll
                    for (int n = 0; n < 2; ++n) acc[a][b][m][n] = (f32x4){0.f, 0.f, 0.f, 0.f};
        cur = nxt; cA = nA; cB = nB; ++ui;
        if constexpr (ALIGN_EPI) { if (wr == 1) PG8_BAR; }
    }
    PG8_WAIT_V(0);
    if constexpr (!ALIGN_EPI) { if (wr == 0) PG8_BAR; }
    PG8_BAR;
#undef PG8_SA
#undef PG8_SB
#undef PG8_STAGE
#undef PG8_LDA
#undef PG8_LDB
#undef PG8_MMA
#undef PG8_WAIT_V
#undef PG8_WAIT_L
#undef PG8_BAR
#undef PG8_SCHED
}
}

#define XB_TMO      128
#define XB_XCNT(j)  (256  + 64 * (j))
#define XB_XSUB(j)  (1280 + 64 * (j))
#define XB_XGEN(j)  (2304 + 64 * (j))
#define XB_TOP      3328
#define XB_TOPGEN   3392
#define XCD_BAR_WORDS 3456
#define XB_SPIN_CAP (1u << 18)
__device__ __forceinline__ unsigned xb_ld(unsigned* p)              { return __hip_atomic_load(p, __ATOMIC_RELAXED, __HIP_MEMORY_SCOPE_AGENT); }
__device__ __forceinline__ unsigned xb_add(unsigned* p, unsigned v) { return __hip_atomic_fetch_add(p, v, __ATOMIC_RELAXED, __HIP_MEMORY_SCOPE_AGENT); }
__device__ __forceinline__ unsigned xb_xcc_id() { return (unsigned)__builtin_amdgcn_s_getreg((3 << 11) | 20) & 0xFu; }
#define XB_SPIN(cond, bar) do { unsigned _sp = 0; while (cond) { __builtin_amdgcn_s_sleep(1); \
    if ((++_sp & 255u) == 0u) { if (xb_ld(&(bar)[XB_TMO])) break; if (_sp > XB_SPIN_CAP) { atomicAdd(&(bar)[XB_TMO], 1u); break; } } } } while (0)
struct XcdBarrier { unsigned* bar; unsigned x; volatile LAS unsigned* st; };
__device__ __forceinline__ XcdBarrier xcd_barrier_post(unsigned* bar, volatile LAS unsigned* st) {
    XcdBarrier b; b.bar = bar; b.x = xb_xcc_id(); b.st = st;
    if (threadIdx.x == 0) (void)xb_add(&bar[XB_XCNT(b.x)], 1u);
    return b;
}
__device__ __forceinline__ void xcd_barrier_complete(unsigned* bar, unsigned x, unsigned& nloc, unsigned& nx) {
    const unsigned G = gridDim.x * gridDim.y * gridDim.z;
    unsigned sum, cnt, mine, sp = 0u;
    for (;;) {
        sum = 0u; cnt = 0u; mine = 0u;
#pragma unroll
        for (unsigned j = 0; j < 16; ++j) { const unsigned c = xb_ld(&bar[XB_XCNT(j)]); sum += c; cnt += (c > 0u) ? 1u : 0u; mine = (j == x) ? c : mine; }
        if (sum == G) break;
        __builtin_amdgcn_s_sleep(1);
        if ((++sp & 255u) == 0u) { if (xb_ld(&bar[XB_TMO])) break; if (sp > XB_SPIN_CAP) { atomicAdd(&bar[XB_TMO], 1u); break; } }
    }
    nloc = mine > 0u ? mine : 1u; nx = cnt > 0u ? cnt : 1u;
}
__device__ __forceinline__ void xcd_barrier(const XcdBarrier& b) {
    asm volatile("s_waitcnt vmcnt(0)" ::: "memory");
    __syncthreads();
    if (threadIdx.x == 0) {
        unsigned* bar = b.bar;
        __builtin_amdgcn_s_waitcnt(0);
        unsigned nloc = b.st[0], nx = b.st[1];
        if (nloc == 0u) { xcd_barrier_complete(bar, b.x, nloc, nx); b.st[0] = nloc; b.st[1] = nx; }
        const unsigned old = xb_add(&bar[XB_XSUB(b.x)], 1u);
        const unsigned gen = old / nloc;
        if (old + 1u == (gen + 1u) * nloc) {
            __builtin_amdgcn_fence(__ATOMIC_RELEASE, "agent");
            asm volatile("s_waitcnt vmcnt(0)" ::: "memory");
            const unsigned og = xb_add(&bar[XB_TOP], 1u);
            const unsigned tg = og / nx;
            if (og + 1u == (tg + 1u) * nx) xb_add(&bar[XB_TOPGEN], 1u);
            else XB_SPIN(xb_ld(&bar[XB_TOPGEN]) == tg, bar);
            __builtin_amdgcn_fence(__ATOMIC_ACQUIRE, "agent");
            xb_add(&bar[XB_XGEN(b.x)], 1u);
            asm volatile("s_waitcnt vmcnt(0)" ::: "memory");
        } else {
            XB_SPIN(xb_ld(&bar[XB_XGEN(b.x)]) == gen, bar);
            __builtin_amdgcn_fence(__ATOMIC_ACQUIRE, "agent");
            asm volatile("s_waitcnt vmcnt(0)" ::: "memory");
        }
    }
    __syncthreads();
}

constexpr size_t MiB = 1u << 20;
constexpr size_t WS_CTL = 0, CTL_ZERO_BYTES = 1 * MiB;
constexpr int CW_BAR = 4096;
constexpr size_t WS_WAB = 1 * MiB;
constexpr size_t WS_WC = WS_WAB + (size_t)AB_WP * DM * 2;
constexpr size_t WS_WABO = WS_WC + (size_t)C_WP * DM * 2;
constexpr size_t WS_WCO = WS_WABO + (size_t)DM * DM * 2;
constexpr size_t WS_WMQ = WS_WCO + (size_t)DM * DM * 2;
constexpr size_t WS_WKV = WS_WMQ + (size_t)2 * 512 * DM * 2;
constexpr size_t WS_WMO = WS_WKV + (size_t)2048 * DM * 2;
constexpr size_t WS_WFI = WS_WMO + (size_t)2 * DM * 512 * 2;
constexpr size_t WS_WFO = WS_WFI + (size_t)2 * 5632 * DM * 2;
constexpr size_t WS_WEND = WS_WFO + (size_t)2 * DM * DFF * 2;
constexpr size_t WS_MISC = 64 * MiB;
static_assert(WS_WEND <= WS_MISC, "weights fit");
constexpr size_t WS_ROPE64 = WS_MISC;
constexpr size_t WS_ROPE32 = WS_ROPE64 + (size_t)MTOK * 16 * 4;
constexpr size_t WS_RSQ = WS_ROPE32 + (size_t)MTOK * 8 * 4;
constexpr size_t WS_MRS = WS_RSQ + (size_t)MTOK * 16 * 4;
constexpr size_t WS_MEMB = WS_MRS + 8192;
constexpr size_t WS_KVRAW = WS_MEMB + (size_t)MMEM * DM * 2;
constexpr size_t WS_W1T = WS_KVRAW + (size_t)MMEM * 2048 * 2;
constexpr size_t WS_POSW1 = WS_W1T + (size_t)2 * 64 * 2048 * 2;
constexpr size_t WS_KCMP = WS_POSW1 + 512;
constexpr size_t WS_VCMP = WS_KCMP + (size_t)BATCH * 4 * 256 * 64 * 2;
constexpr size_t WS_MISCEND = WS_VCMP + (size_t)BATCH * 4 * 256 * 64 * 2;
constexpr size_t WS_XB = 96 * MiB;
static_assert(WS_MISCEND <= WS_XB, "misc fits");
constexpr size_t WS_R1 = 160 * MiB;
constexpr size_t WS_OATT = 336 * MiB;
constexpr size_t WS_R3 = 400 * MiB;
constexpr size_t WS_GT = WS_R3;
constexpr size_t WS_MQ = WS_R3;
constexpr size_t WS_OMEM = WS_R3 + (size_t)MTOK * 512 * 2;
constexpr size_t WS_SC = WS_OATT;
constexpr size_t WS_BM = 464 * MiB;
constexpr size_t WS_KM = 480 * MiB;
constexpr size_t WS_ISG = 481 * MiB;
constexpr size_t WS_END = 512 * MiB;
static_assert(WS_R1 + (size_t)MTOK * C_WP * 2 <= WS_OATT, "R1 fits");

constexpr int LDS_BYTES = 155648;
constexpr int LDS_MISC = 151552;
constexpr int NWAVES = 8;

__device__ __forceinline__ unsigned f2bf(float f) { unsigned u = __builtin_bit_cast(unsigned, f); return (u + 0x7fffu + ((u >> 16) & 1u)) >> 16; }
__device__ __forceinline__ unsigned pk2(float lo, float hi) { f32x2 v = {lo, hi}; bf16x2_t b = __builtin_convertvector(v, bf16x2_t); return __builtin_bit_cast(unsigned, b); }
__device__ __forceinline__ float bf2f(unsigned short b) { return __builtin_bit_cast(float, (unsigned)b << 16); }
__device__ __forceinline__ float wave_sum(float v) {
#pragma unroll
    for (int o = 1; o < 64; o <<= 1) v += __shfl_xor(v, o);
    return v;
}


namespace att {
constexpr float NEG_INF = -__builtin_huge_valf();
template <int HD> struct Geo { static constexpr int PK = HD * 2 + 16, PV = (HD == 64 ? 192 : 320), KB = 64 * PK, VB = 64 * PV, BUF = KB + VB; };
template <int HD> struct State { f32x16 o[HD / 32]; float m, l;
    __device__ __forceinline__ void init() {
#pragma unroll
        for (int d = 0; d < HD / 32; ++d)
#pragma unroll
            for (int i = 0; i < 16; ++i) o[d][i] = 0.f;
        m = NEG_INF; l = 0.f; } };
template <int HD> struct TileRegs { u32x4 k[HD / 64], v[HD / 64]; };
template <int HD> __device__ __forceinline__ void load_tile(TileRegs<HD>& tr, const bf16_t* kb, size_t kp, const bf16_t* vb, size_t vp, int tid) {
#pragma unroll
    for (int i = 0; i < HD / 64; ++i) { const int idx = tid + 512 * i, row = idx / (HD / 8), c = idx % (HD / 8);
        tr.k[i] = *(const u32x4*)(kb + (size_t)row * kp + c * 8); tr.v[i] = *(const u32x4*)(vb + (size_t)row * vp + c * 8); }
}
template <int HD> __device__ __forceinline__ void store_tile(const TileRegs<HD>& tr, LAS unsigned char* buf, int tid) {
#pragma unroll
    for (int i = 0; i < HD / 64; ++i) { const int idx = tid + 512 * i, row = idx / (HD / 8), c = idx % (HD / 8);
        *(LAS u32x4*)(buf + row * Geo<HD>::PK + c * 16) = tr.k[i]; *(LAS u32x4*)(buf + Geo<HD>::KB + row * Geo<HD>::PV + c * 16) = tr.v[i]; }
}
__device__ __forceinline__ s16x4 tr_read(const LAS unsigned char* p) { typedef short v4i16_t __attribute__((ext_vector_type(4)));
    return __builtin_bit_cast(s16x4, __builtin_amdgcn_ds_read_tr16_b64_v4i16((LAS v4i16_t*)p)); }
__device__ __forceinline__ bf16x8 pack8(const f32x16& x, int s8) {
    u32x4 w; w.x = pk2(x[s8], x[s8 + 1]); w.y = pk2(x[s8 + 2], x[s8 + 3]); w.z = pk2(x[s8 + 4], x[s8 + 5]); w.w = pk2(x[s8 + 6], x[s8 + 7]); return __builtin_bit_cast(bf16x8, w); }
template <int HD> __device__ __forceinline__ void tile_scores(f32x16 (&p)[2], const bf16x8 (&qf)[HD / 16], const LAS unsigned char* buf, int lane) {
    const int r = lane & 31, h = lane >> 5;
#pragma unroll
    for (int kt = 0; kt < 2; ++kt) { f32x16 x;
#pragma unroll
        for (int i = 0; i < 16; ++i) x[i] = 0.f;
#pragma unroll
        for (int s = 0; s < HD / 16; ++s) { const bf16x8 kf = *(const LAS bf16x8*)(buf + (32 * kt + r) * Geo<HD>::PK + 32 * s + 16 * h); x = __builtin_amdgcn_mfma_f32_32x32x16_bf16(kf, qf[s], x, 0, 0, 0); }
        p[kt] = x; }
}
template <int HD> __device__ __forceinline__ void tile_pv(f32x16 (&o)[HD / 32], const f32x16 (&p)[2], const LAS unsigned char* buf, int lane) {
    const int h = lane >> 5, blk = (lane >> 4) & 1, q = (lane & 15) >> 2, pp = lane & 3;
    const LAS unsigned char* vb = buf + Geo<HD>::KB + (4 * h + q) * Geo<HD>::PV + 32 * blk + 8 * pp;
#pragma unroll
    for (int kt = 0; kt < 2; ++kt)
#pragma unroll
        for (int s = 0; s < 2; ++s) { const bf16x8 pb = pack8(p[kt], 8 * s);
#pragma unroll
            for (int dh = 0; dh < HD / 32; ++dh) { const LAS unsigned char* a = vb + (32 * kt + 16 * s) * Geo<HD>::PV + 64 * dh;
                const s16x4 lo = tr_read(a), hi = tr_read(a + 8 * Geo<HD>::PV);
                const bf16x8 vf = __builtin_shufflevector(lo, hi, 0, 1, 2, 3, 4, 5, 6, 7);
                o[dh] = __builtin_amdgcn_mfma_f32_32x32x16_bf16(vf, pb, o[dh], 0, 0, 0); } }
}
template <int HD, class MaskF> __device__ __forceinline__ void tile_step(State<HD>& st, const bf16x8 (&qf)[HD / 16], const LAS unsigned char* buf, int lane, MaskF valid) {
    f32x16 p[2]; tile_scores<HD>(p, qf, buf, lane);
    float mx = NEG_INF;
#pragma unroll
    for (int kt = 0; kt < 2; ++kt)
#pragma unroll
        for (int i = 0; i < 16; ++i) { const int koff = 32 * kt + (i & 3) + 8 * (i >> 2); const float v = valid(koff) ? p[kt][i] : NEG_INF; p[kt][i] = v; mx = fmaxf(mx, v); }
    mx = fmaxf(mx, __shfl_xor(mx, 32));
    const float mnew = fmaxf(st.m, mx), muse = (mnew == NEG_INF) ? 0.f : mnew;
    const float alpha = __builtin_amdgcn_exp2f(st.m - muse);
    float ls = 0.f;
#pragma unroll
    for (int kt = 0; kt < 2; ++kt)
#pragma unroll
        for (int i = 0; i < 16; ++i) { const float e = __builtin_amdgcn_exp2f(p[kt][i] - muse); p[kt][i] = e; ls += e; }
    st.l = st.l * alpha + ls; st.m = mnew;
#pragma unroll
    for (int dh = 0; dh < HD / 32; ++dh)
#pragma unroll
        for (int i = 0; i < 16; ++i) st.o[dh][i] *= alpha;
    tile_pv<HD>(st.o, p, buf, lane);
}
template <int HD, class SrcF, class CompF> __device__ __forceinline__ void kv_pipeline(LAS unsigned char* lds, int nt, int tid, SrcF src, CompF comp) {
    TileRegs<HD> tr; const bf16_t *kb, *vb; size_t kp, vp;
    __syncthreads();
    if (nt <= 0) return;
    src(0, kb, kp, vb, vp); load_tile<HD>(tr, kb, kp, vb, vp, tid); store_tile<HD>(tr, lds, tid);
    __syncthreads();
    for (int t = 0; t < nt; ++t) {
        if (t + 1 < nt) { src(t + 1, kb, kp, vb, vp); load_tile<HD>(tr, kb, kp, vb, vp, tid); }
        comp(t, lds + (t & 1) * Geo<HD>::BUF);
        if (t + 1 < nt) store_tile<HD>(tr, lds + ((t + 1) & 1) * Geo<HD>::BUF, tid);
        __syncthreads();
    }
}

template <int HD, bool PIPE, class SrcF, class ActF, class FinF> __device__ __forceinline__ void kv_pipeline3(LAS unsigned char* lds, int nt, int tid, int lane, const bf16x8 (&qf)[HD / 16], SrcF src, ActF act, FinF fin) {
    TileRegs<HD> tr; const bf16_t *kb, *vb; size_t kp, vp;
    __syncthreads();
    if (nt <= 0) return;
    src(0, kb, kp, vb, vp); load_tile<HD>(tr, kb, kp, vb, vp, tid); store_tile<HD>(tr, lds, tid);
    if (nt > 1) { src(1, kb, kp, vb, vp); load_tile<HD>(tr, kb, kp, vb, vp, tid); store_tile<HD>(tr, lds + Geo<HD>::BUF, tid); }
    __syncthreads();
    f32x16 pc[2], pn[2];
    if constexpr (PIPE) { if (act(0)) tile_scores<HD>(pc, qf, lds, lane); }
    int b0 = 0, b1 = 1, b2 = 2;
    for (int t = 0; t < nt; ++t) {
        if (t + 2 < nt) { src(t + 2, kb, kp, vb, vp); load_tile<HD>(tr, kb, kp, vb, vp, tid); }
        if constexpr (PIPE) {
            const bool an = (t + 1 < nt) && act(t + 1);
            if (an) tile_scores<HD>(pn, qf, lds + b1 * Geo<HD>::BUF, lane);
            if (act(t)) fin(t, pc, lds + b0 * Geo<HD>::BUF);
        } else {
            if (act(t)) { tile_scores<HD>(pc, qf, lds + b0 * Geo<HD>::BUF, lane); fin(t, pc, lds + b0 * Geo<HD>::BUF); }
        }
        if (t + 2 < nt) store_tile<HD>(tr, lds + b2 * Geo<HD>::BUF, tid);
        __syncthreads();
        if constexpr (PIPE) {
#pragma unroll
            for (int k = 0; k < 2; ++k) pc[k] = pn[k]; }
        const int tb = b0; b0 = b1; b1 = b2; b2 = tb;
    }
}
template <int HD, class MaskF> __device__ __forceinline__ void tile_finish(State<HD>& st, f32x16 (&p)[2], const LAS unsigned char* buf, int lane, bool lane_ok, bool elem, MaskF valid) {
    float mx = fmaxf(p[0][0], p[1][0]);
#pragma unroll
    for (int i = 1; i < 16; ++i) mx = fmaxf(mx, fmaxf(p[0][i], p[1][i]));
    mx = fmaxf(mx, __shfl_xor(mx, 32));
    if (__any(mx > st.m)) {
        const float mnew = fmaxf(st.m, mx), alpha = __builtin_amdgcn_exp2f(st.m - mnew);
        st.l *= alpha; st.m = mnew;
#pragma unroll
        for (int dh = 0; dh < HD / 32; ++dh)
#pragma unroll
            for (int i = 0; i < 16; ++i) st.o[dh][i] *= alpha;
    }
    const float sub = lane_ok ? st.m : __builtin_huge_valf();
#pragma unroll
    for (int kt = 0; kt < 2; ++kt)
#pragma unroll
        for (int i = 0; i < 16; ++i) p[kt][i] = __builtin_amdgcn_exp2f(p[kt][i] - sub);
    if (elem) {
#pragma unroll
        for (int kt = 0; kt < 2; ++kt)
#pragma unroll
            for (int i = 0; i < 16; ++i) { const int koff = 32 * kt + (i & 3) + 8 * (i >> 2); p[kt][i] = valid(koff) ? p[kt][i] : 0.f; }
    }
    float ls = 0.f;
#pragma unroll
    for (int i = 0; i < 16; ++i) ls += p[0][i] + p[1][i];
    st.l += ls;
    tile_pv<HD>(st.o, p, buf, lane);
}

template <int HD, bool ELEM, class MaskF> __device__ __forceinline__ void tile_fused(State<HD>& st, f32x16 (&p)[2], const LAS unsigned char* buf, int lane, bool lane_ok, MaskF valid,
                                                                                 const bf16x8 (&qf)[HD / 16], const LAS unsigned char* nbuf, f32x16 (&pn)[2]) {
    float mx = fmaxf(p[0][0], p[1][0]);
#pragma unroll
    for (int i = 1; i < 16; ++i) mx = fmaxf(mx, fmaxf(p[0][i], p[1][i]));
    mx = fmaxf(mx, __shfl_xor(mx, 32));
    if (__any(mx > st.m)) {
        const float mnew = fmaxf(st.m, mx), alpha = __builtin_amdgcn_exp2f(st.m - mnew);
        st.l *= alpha; st.m = mnew;
#pragma unroll
        for (int dh = 0; dh < HD / 32; ++dh)
#pragma unroll
            for (int i = 0; i < 16; ++i) st.o[dh][i] *= alpha;
    }
    const float sub = lane_ok ? st.m : __builtin_huge_valf();
    asm volatile("" : "+v"(lane));
    const int r = lane & 31, h = lane >> 5, blk = (lane >> 4) & 1, q4 = (lane & 15) >> 2, pp = lane & 3;
    const LAS unsigned char* kl = nbuf + r * Geo<HD>::PK + 16 * h;
    const LAS unsigned char* vl = buf + Geo<HD>::KB + (4 * h + q4) * Geo<HD>::PV + 32 * blk + 8 * pp;
#pragma unroll
    for (int i = 0; i < 16; ++i) { pn[0][i] = 0.f; pn[1][i] = 0.f; }
    float ls = 0.f;
#pragma unroll
    for (int c = 0; c < 4; ++c) {
        const int kt = c >> 1, s2 = c & 1;
#pragma unroll
        for (int ss = 0; ss < HD / 32; ++ss) { const int sk = (HD / 32) * s2 + ss; const bf16x8 kf = *(const LAS bf16x8*)(kl + (32 * kt) * Geo<HD>::PK + 32 * sk);
            pn[kt] = __builtin_amdgcn_mfma_f32_32x32x16_bf16(kf, qf[sk], pn[kt], 0, 0, 0); }
#pragma unroll
        for (int j = 0; j < 8; ++j) { const int i = 8 * s2 + j; float e = __builtin_amdgcn_exp2f(p[kt][i] - sub);
            if (ELEM) { const int koff = 32 * kt + (i & 3) + 8 * (i >> 2); e = valid(koff) ? e : 0.f; }
            p[kt][i] = e; ls += e; }
        const bf16x8 pb = pack8(p[kt], 8 * s2);
#pragma unroll
        for (int dh = 0; dh < HD / 32; ++dh) { const LAS unsigned char* a = vl + (32 * kt + 16 * s2) * Geo<HD>::PV + 64 * dh;
            const s16x4 lo = tr_read(a), hi = tr_read(a + 8 * Geo<HD>::PV);
            const bf16x8 vf = __builtin_shufflevector(lo, hi, 0, 1, 2, 3, 4, 5, 6, 7);
            st.o[dh] = __builtin_amdgcn_mfma_f32_32x32x16_bf16(vf, pb, st.o[dh], 0, 0, 0); }
        __builtin_amdgcn_sched_barrier(0);
    }
    st.l += ls;
}
struct NoPre { __device__ __forceinline__ void operator()(int) const {} };
template <int HD, class SrcF, class FinF, class PreF = NoPre> __device__ __forceinline__ void kv_pipeline4(LAS unsigned char* lds, int nt, int tid, int lane, const bf16x8 (&qf)[HD / 16], SrcF src, FinF fin, PreF pre = PreF()) {
    TileRegs<HD> tr; const bf16_t *kb, *vb; size_t kp, vp;
    __syncthreads();
    if (nt <= 0) return;
    src(0, kb, kp, vb, vp); load_tile<HD>(tr, kb, kp, vb, vp, tid); store_tile<HD>(tr, lds, tid);
    if (nt > 1) { src(1, kb, kp, vb, vp); load_tile<HD>(tr, kb, kp, vb, vp, tid); store_tile<HD>(tr, lds + Geo<HD>::BUF, tid); }
    __syncthreads();
    f32x16 pc[2], pn[2];
    tile_scores<HD>(pc, qf, lds, lane);
    int b0 = 0, b1 = 1, b2 = 2;
    for (int t = 0; t < nt; ++t) {
        pre(t + 1);
        if (t + 2 < nt) { src(t + 2, kb, kp, vb, vp); load_tile<HD>(tr, kb, kp, vb, vp, tid); }
        const int bn = (t + 1 < nt) ? b1 : b0;
        fin(t, pc, lds + b0 * Geo<HD>::BUF, lds + bn * Geo<HD>::BUF, pn);
        if (t + 2 < nt) store_tile<HD>(tr, lds + b2 * Geo<HD>::BUF, tid);
        __syncthreads();
#pragma unroll
        for (int k = 0; k < 2; ++k) pc[k] = pn[k];
        const int tb = b0; b0 = b1; b1 = b2; b2 = tb;
    }
}

constexpr int DBUF = 16384;
__device__ __forceinline__ void dma_tile(LAS unsigned char* buf, const bf16_t* kb, size_t kp, const bf16_t* vb, size_t vp, int wave, int lane) {
    const int row = 8 * wave + (lane >> 3), cp = lane & 7;
    const bf16_t* gk = kb + (size_t)row * kp + ((cp ^ ((row >> 1) & 7)) * 8);
    const bf16_t* gv = vb + (size_t)row * vp + ((cp ^ (4 * ((row >> 1) & 1))) * 8);
    __builtin_amdgcn_global_load_lds((const unsigned*)gk, (LAS unsigned*)(buf + wave * 1024), 16, 0, 0);
    __builtin_amdgcn_global_load_lds((const unsigned*)gv, (LAS unsigned*)(buf + 8192 + wave * 1024), 16, 0, 0);
}
__device__ __forceinline__ void dma_tile_o(LAS unsigned char* buf, const bf16_t* kb, const bf16_t* vb, unsigned gko, unsigned gvo, int wave) {
    __builtin_amdgcn_global_load_lds((const unsigned*)((const char*)kb + gko), (LAS unsigned*)(buf + wave * 1024), 16, 0, 0);
    __builtin_amdgcn_global_load_lds((const unsigned*)((const char*)vb + gvo), (LAS unsigned*)(buf + 8192 + wave * 1024), 16, 0, 0);
}
__device__ __forceinline__ void scores_d(f32x16 (&p)[2], const bf16x8 (&qf)[4], const LAS unsigned char* buf, int lane) {
    const int r = lane & 31, h = lane >> 5;
#pragma unroll
    for (int kt = 0; kt < 2; ++kt) { f32x16 x;
#pragma unroll
        for (int i = 0; i < 16; ++i) x[i] = 0.f;
        const int row = 32 * kt + r; const LAS unsigned char* kr = buf + row * 128; const int sw = (row >> 1) & 7;
#pragma unroll
        for (int s = 0; s < 4; ++s) { const bf16x8 kf = *(const LAS bf16x8*)(kr + (((2 * s + h) ^ sw) * 16)); x = __builtin_amdgcn_mfma_f32_32x32x16_bf16(kf, qf[s], x, 0, 0, 0); }
        p[kt] = x; }
}
template <bool ELEM, class MaskF> __device__ __forceinline__ void fused_d(State<64>& st, f32x16 (&p)[2], const LAS unsigned char* buf, int lane, bool lane_ok, MaskF valid,
                                                                        const bf16x8 (&qf)[4], const LAS unsigned char* nbuf, f32x16 (&pn)[2]) {
    float mx = fmaxf(p[0][0], p[1][0]);
#pragma unroll
    for (int i = 1; i < 16; ++i) mx = fmaxf(mx, fmaxf(p[0][i], p[1][i]));
    mx = fmaxf(mx, __shfl_xor(mx, 32));
    if (__any(mx > st.m)) {
        const float mnew = fmaxf(st.m, mx), alpha = __builtin_amdgcn_exp2f(st.m - mnew);
        st.l *= alpha; st.m = mnew;
#pragma unroll
        for (int dh = 0; dh < 2; ++dh)
#pragma unroll
            for (int i = 0; i < 16; ++i) st.o[dh][i] *= alpha;
    }
    const float sub = lane_ok ? st.m : __builtin_huge_valf();
    asm volatile("" : "+v"(lane));
    const int r = lane & 31, h = lane >> 5, blk = (lane >> 4) & 1, q4 = (lane & 15) >> 2, pp = lane & 3;
    const int ksw = (r >> 1) & 7;
    const LAS unsigned char* kl = nbuf + r * 128;
    const int vsw = 4 * ((q4 >> 1) & 1);
    const LAS unsigned char* vl = buf + 8192 + (4 * h + q4) * 128 + 8 * (pp & 1);
    const int vc0 = ((2 * blk + (pp >> 1)) ^ vsw) * 16, vc1 = ((4 + 2 * blk + (pp >> 1)) ^ vsw) * 16;
#pragma unroll
    for (int i = 0; i < 16; ++i) { pn[0][i] = 0.f; pn[1][i] = 0.f; }
    float ls = 0.f;
#pragma unroll
    for (int c = 0; c < 4; ++c) {
        const int kt = c >> 1, s2 = c & 1;
        s16x4 l0, h0, l1, h1;
        { const unsigned a0 = (unsigned)(size_t)(vl + (32 * kt + 16 * s2) * 128 + vc0), a1 = (unsigned)(size_t)(vl + (32 * kt + 16 * s2) * 128 + vc1);
          asm volatile("ds_read_b64_tr_b16 %0, %4\n\tds_read_b64_tr_b16 %1, %4 offset:1024\n\tds_read_b64_tr_b16 %2, %5\n\tds_read_b64_tr_b16 %3, %5 offset:1024"
                       : "=&v"(l0), "=&v"(h0), "=&v"(l1), "=&v"(h1) : "v"(a0), "v"(a1) : "memory"); }
#pragma unroll
        for (int ss = 0; ss < 2; ++ss) { const int sk = 2 * s2 + ss; const bf16x8 kf = *(const LAS bf16x8*)(kl + kt * 4096 + (((2 * sk + h) ^ ksw) * 16));
            pn[kt] = __builtin_amdgcn_mfma_f32_32x32x16_bf16(kf, qf[sk], pn[kt], 0, 0, 0); }
#pragma unroll
        for (int j = 0; j < 8; ++j) { const int i = 8 * s2 + j; float e = __builtin_amdgcn_exp2f(p[kt][i] - sub);
            if (ELEM) { const int koff = 32 * kt + (i & 3) + 8 * (i >> 2); e = valid(koff) ? e : 0.f; }
            p[kt][i] = e; ls += e; }
        const bf16x8 pb = pack8(p[kt], 8 * s2);
        asm volatile("s_waitcnt lgkmcnt(0)" ::: "memory"); __builtin_amdgcn_sched_barrier(0);
        st.o[0] = __builtin_amdgcn_mfma_f32_32x32x16_bf16(__builtin_shufflevector(l0, h0, 0, 1, 2, 3, 4, 5, 6, 7), pb, st.o[0], 0, 0, 0);
        st.o[1] = __builtin_amdgcn_mfma_f32_32x32x16_bf16(__builtin_shufflevector(l1, h1, 0, 1, 2, 3, 4, 5, 6, 7), pb, st.o[1], 0, 0, 0);
        __builtin_amdgcn_sched_barrier(0);
    }
    st.l += ls;
}
template <int XTRA, class SrcF, class FinF, class XtraF> __device__ __forceinline__ void kv_pipeline_dma(LAS unsigned char* lds, int nt, int wave, int lane, const bf16x8 (&qf)[4], SrcF src, FinF fin, XtraF xtra) {
    const bf16_t *kb, *vb; size_t kp, vp;
    asm volatile("s_waitcnt vmcnt(0) lgkmcnt(0)" ::: "memory"); __builtin_amdgcn_s_barrier();
    if (nt <= 0) return;
#pragma unroll
    for (int i = 0; i < 3; ++i) if (i < nt) { src(i, kb, kp, vb, vp); dma_tile(lds + i * DBUF, kb, kp, vb, vp, wave, lane); xtra(i, i); }
    if (nt >= 3) { if (XTRA) asm volatile("s_waitcnt vmcnt(3)" ::: "memory"); else asm volatile("s_waitcnt vmcnt(2)" ::: "memory"); }
    else asm volatile("s_waitcnt vmcnt(0)" ::: "memory");
    __builtin_amdgcn_s_barrier();
    f32x16 pc[2], pn[2];
    scores_d(pc, qf, lds, lane);
    for (int t = 0; t < nt; ++t) {
        if (t + 3 < nt) { src(t + 3, kb, kp, vb, vp); dma_tile(lds + ((t + 3) & 3) * DBUF, kb, kp, vb, vp, wave, lane); xtra(t + 3, (t + 3) & 3); }
        const int bn = (t + 1 < nt) ? ((t + 1) & 3) : (t & 3);
        fin(t, pc, lds + (t & 3) * DBUF, lds + bn * DBUF, pn, t & 3);
        if (t + 3 < nt) { if (XTRA) asm volatile("s_waitcnt vmcnt(3) lgkmcnt(0)" ::: "memory"); else asm volatile("s_waitcnt vmcnt(2) lgkmcnt(0)" ::: "memory"); }
        else asm volatile("s_waitcnt vmcnt(0) lgkmcnt(0)" ::: "memory");
        __builtin_amdgcn_s_barrier();
#pragma unroll
        for (int k = 0; k < 2; ++k) pc[k] = pn[k];
    }
}
struct NoXtra { __device__ __forceinline__ void operator()(int, int) const {} };

template <int MODE, bool HS, class MaskF> __device__ __forceinline__ void fused_np(f32x16 (&o)[2], float& l, const f32x16 (&p)[2], const LAS unsigned char* buf, int lane, bool lane_ok, float shift, MaskF valid, unsigned wlo, unsigned whi,
                                                                        const bf16x8 (&qf)[4], const LAS unsigned char* nbuf, f32x16 (&pn)[2]) {
    asm volatile("" : "+v"(lane));
    const int r = lane & 31, h = lane >> 5, blk = (lane >> 4) & 1, q4 = (lane & 15) >> 2, pp = lane & 3;
    const int ksw = (r >> 1) & 7;
    const LAS unsigned char* kl = nbuf + r * 128;
    const int vsw = 4 * ((q4 >> 1) & 1);
    const LAS unsigned char* vl = buf + 8192 + (4 * h + q4) * 128 + 8 * (pp & 1);
    const unsigned vb0 = (unsigned)(size_t)vl + ((2 * blk + (pp >> 1)) ^ vsw) * 16, vb1 = (unsigned)(size_t)vl + ((4 + 2 * blk + (pp >> 1)) ^ vsw) * 16;
    const unsigned lmask = lane_ok ? 0xffffffffu : 0u;
    float ls = 0.f;
#pragma unroll
    for (int c = 0; c < 4; ++c) {
        const int kt = c >> 1, s2 = c & 1;
        s16x4 l0, h0, l1, h1;
        asm volatile("ds_read_b64_tr_b16 %0, %4 offset:%c6\n\tds_read_b64_tr_b16 %1, %4 offset:%c7\n\tds_read_b64_tr_b16 %2, %5 offset:%c6\n\tds_read_b64_tr_b16 %3, %5 offset:%c7"
                     : "=&v"(l0), "=&v"(h0), "=&v"(l1), "=&v"(h1) : "v"(vb0), "v"(vb1), "i"((32 * (c >> 1) + 16 * (c & 1)) * 128), "i"((32 * (c >> 1) + 16 * (c & 1)) * 128 + 1024) : "memory");
#pragma unroll
        for (int ss = 0; ss < 2; ++ss) { const int sk = 2 * s2 + ss; const bf16x8 kf = *(const LAS bf16x8*)(kl + kt * 4096 + (((2 * sk + h) ^ ksw) * 16));
            if (sk == 0) { f32x16 z;
#pragma unroll
                for (int i = 0; i < 16; ++i) z[i] = 0.f;
                pn[kt] = __builtin_amdgcn_mfma_f32_32x32x16_bf16(kf, qf[sk], z, 0, 0, 0); }
            else pn[kt] = __builtin_amdgcn_mfma_f32_32x32x16_bf16(kf, qf[sk], pn[kt], 0, 0, 0); }
        float e[8];
#pragma unroll
        for (int j = 0; j < 8; ++j) { const int i = 8 * s2 + j; const int koff = 32 * kt + (i & 3) + 8 * (i >> 2); float x = __builtin_amdgcn_exp2f(HS ? p[kt][i] - shift : p[kt][i]);
            if (MODE == 1) x = valid(koff) ? x : 0.f;
            if (MODE == 2) { int tb; asm("v_bfe_i32 %0, %1, %2, 1" : "=v"(tb) : "v"(kt ? whi : wlo), "n"(koff & 31)); x = __builtin_bit_cast(float, __builtin_bit_cast(unsigned, x) & (unsigned)tb); }
            e[j] = x; }
        u32x4 pw; pw.x = pk2(e[0], e[1]) & lmask; pw.y = pk2(e[2], e[3]) & lmask; pw.z = pk2(e[4], e[5]) & lmask; pw.w = pk2(e[6], e[7]) & lmask;
#pragma unroll
        for (int j = 0; j < 8; ++j) ls += lane_ok ? e[j] : 0.f;
        const bf16x8 pb = __builtin_bit_cast(bf16x8, pw);
        asm volatile("s_waitcnt lgkmcnt(0)" ::: "memory"); __builtin_amdgcn_sched_barrier(0);
        o[0] = __builtin_amdgcn_mfma_f32_32x32x16_bf16(__builtin_shufflevector(l0, h0, 0, 1, 2, 3, 4, 5, 6, 7), pb, o[0], 0, 0, 0);
        o[1] = __builtin_amdgcn_mfma_f32_32x32x16_bf16(__builtin_shufflevector(l1, h1, 0, 1, 2, 3, 4, 5, 6, 7), pb, o[1], 0, 0, 0);
        __builtin_amdgcn_sched_barrier(0);
    }
    l += ls;
}
struct LpOff { unsigned k0, k1, v0, v1, gk, gv; };
__device__ __forceinline__ LpOff lp_offsets(int lane, int wave = 0, unsigned pitch_bytes = 0) {
    const int r = lane & 31, h = lane >> 5, blk = (lane >> 4) & 1, q4 = (lane & 15) >> 2, pp = lane & 3;
    const int ksw = (r >> 1) & 7, vsw = 4 * ((q4 >> 1) & 1);
    const unsigned vl = 8192 + (4 * h + q4) * 128 + 8 * (pp & 1);
    LpOff o; o.k0 = r * 128 + ((h ^ ksw) * 16); o.k1 = r * 128 + (((2 + h) ^ ksw) * 16);
    o.v0 = vl + ((2 * blk + (pp >> 1)) ^ vsw) * 16; o.v1 = vl + ((4 + 2 * blk + (pp >> 1)) ^ vsw) * 16;
    { const int row = 8 * wave + (lane >> 3), cp = lane & 7;
      o.gk = (unsigned)row * pitch_bytes + ((cp ^ ((row >> 1) & 7)) * 16); o.gv = (unsigned)row * pitch_bytes + ((cp ^ (4 * ((row >> 1) & 1))) * 16); }
    asm volatile("" : "+v"(o.k0), "+v"(o.k1), "+v"(o.v0), "+v"(o.v1), "+v"(o.gk), "+v"(o.gv));
    return o;
}
template <int MODE, bool HS, class MaskF> __device__ __forceinline__ void fused_lp(f32x16 (&o)[2], float& l, const f32x16 (&p)[2], const LAS unsigned char* buf, int lane, bool lane_ok, float shift, MaskF valid, unsigned wlo, unsigned whi,
                                                                        const bf16x8 (&qf)[4], const LAS unsigned char* nbuf, f32x16 (&pn)[2], const LpOff& lo) {
    const unsigned nb = (unsigned)(size_t)nbuf, cb = (unsigned)(size_t)buf;
    const unsigned kA0 = nb + lo.k0, kA1 = nb + lo.k1, kB0 = kA0 ^ 64u, kB1 = kA1 ^ 64u;
    const unsigned vb0 = cb + lo.v0, vb1 = cb + lo.v1;
    const unsigned lmask = lane_ok ? 0xffffffffu : 0u;
    bf16x8 kf[2][2]; s16x4 vf[3][4]; bf16x8 pbp = {0, 0, 0, 0, 0, 0, 0, 0};
#define FE_ISSUE(c_, KS_, VS_) do { constexpr int kt_ = (c_) >> 1, s2_ = (c_) & 1; \
        asm volatile("ds_read_b128 %0, %6 offset:%c10\n\tds_read_b128 %1, %7 offset:%c10\n\tds_read_b64_tr_b16 %2, %8 offset:%c11\n\tds_read_b64_tr_b16 %3, %8 offset:%c12\n\tds_read_b64_tr_b16 %4, %9 offset:%c11\n\tds_read_b64_tr_b16 %5, %9 offset:%c12" \
                     : "=&v"(kf[KS_][0]), "=&v"(kf[KS_][1]), "=&v"(vf[VS_][0]), "=&v"(vf[VS_][1]), "=&v"(vf[VS_][2]), "=&v"(vf[VS_][3]) \
                     : "v"(s2_ ? kB0 : kA0), "v"(s2_ ? kB1 : kA1), "v"(vb0), "v"(vb1), "i"(kt_ * 4096), "i"((32 * kt_ + 16 * s2_) * 128), "i"((32 * kt_ + 16 * s2_) * 128 + 1024) : "memory"); } while (0)
    FE_ISSUE(0, 0, 0);
    float ls = 0.f;
#pragma unroll
    for (int c = 0; c < 4; ++c) {
        const int kt = c >> 1, s2 = c & 1, KS = c & 1, VS = c % 3, VP = (c + 2) % 3;
        asm volatile("s_waitcnt lgkmcnt(0)" ::: "memory"); __builtin_amdgcn_sched_barrier(0);
        if (c < 3) { if (c == 0) FE_ISSUE(1, 1, 1); else if (c == 1) FE_ISSUE(2, 0, 2); else FE_ISSUE(3, 1, 0); }
        if (s2 == 0) { f32x16 z;
#pragma unroll
            for (int i = 0; i < 16; ++i) z[i] = 0.f;
            pn[kt] = __builtin_amdgcn_mfma_f32_32x32x16_bf16(kf[KS][0], qf[0], z, 0, 0, 0); pn[kt] = __builtin_amdgcn_mfma_f32_32x32x16_bf16(kf[KS][1], qf[1], pn[kt], 0, 0, 0); }
        else { pn[kt] = __builtin_amdgcn_mfma_f32_32x32x16_bf16(kf[KS][0], qf[2], pn[kt], 0, 0, 0); pn[kt] = __builtin_amdgcn_mfma_f32_32x32x16_bf16(kf[KS][1], qf[3], pn[kt], 0, 0, 0); }
        if (c > 0) {
            o[0] = __builtin_amdgcn_mfma_f32_32x32x16_bf16(__builtin_shufflevector(vf[VP][0], vf[VP][1], 0, 1, 2, 3, 4, 5, 6, 7), pbp, o[0], 0, 0, 0);
            o[1] = __builtin_amdgcn_mfma_f32_32x32x16_bf16(__builtin_shufflevector(vf[VP][2], vf[VP][3], 0, 1, 2, 3, 4, 5, 6, 7), pbp, o[1], 0, 0, 0); }
        float e[8];
#pragma unroll
        for (int j = 0; j < 8; ++j) { const int i = 8 * s2 + j; const int koff = 32 * kt + (i & 3) + 8 * (i >> 2); float x = __builtin_amdgcn_exp2f(HS ? p[kt][i] - shift : p[kt][i]);
            if (MODE == 1) x = valid(koff) ? x : 0.f;
            if (MODE == 2) { int tb; asm("v_bfe_i32 %0, %1, %2, 1" : "=v"(tb) : "v"(kt ? whi : wlo), "n"(koff & 31)); x = __builtin_bit_cast(float, __builtin_bit_cast(unsigned, x) & (unsigned)tb); }
            e[j] = x; }
        u32x4 pw; pw.x = pk2(e[0], e[1]) & lmask; pw.y = pk2(e[2], e[3]) & lmask; pw.z = pk2(e[4], e[5]) & lmask; pw.w = pk2(e[6], e[7]) & lmask;
#pragma unroll
        for (int j = 0; j < 8; ++j) ls += lane_ok ? e[j] : 0.f;
#pragma unroll
        for (int g = 0; g < 4; ++g) { __builtin_amdgcn_sched_group_barrier(0x008, 1, 0); __builtin_amdgcn_sched_group_barrier(0x002, 9, 0); }
        __builtin_amdgcn_sched_barrier(0);
        pbp = __builtin_bit_cast(bf16x8, pw);
    }
    o[0] = __builtin_amdgcn_mfma_f32_32x32x16_bf16(__builtin_shufflevector(vf[0][0], vf[0][1], 0, 1, 2, 3, 4, 5, 6, 7), pbp, o[0], 0, 0, 0);
    o[1] = __builtin_amdgcn_mfma_f32_32x32x16_bf16(__builtin_shufflevector(vf[0][2], vf[0][3], 0, 1, 2, 3, 4, 5, 6, 7), pbp, o[1], 0, 0, 0);
#undef FE_ISSUE
    l += ls;
}
template <int MODE, bool HS, bool LP, class MaskF> __device__ __forceinline__ void fused_e(f32x16 (&o)[2], float& l, const f32x16 (&p)[2], const LAS unsigned char* buf, int lane, bool lane_ok, float shift, MaskF valid, unsigned wlo, unsigned whi,
                                                                        const bf16x8 (&qf)[4], const LAS unsigned char* nbuf, f32x16 (&pn)[2], const LpOff& lo = LpOff{}) {
    if constexpr (LP) fused_lp<MODE, HS>(o, l, p, buf, lane, lane_ok, shift, valid, wlo, whi, qf, nbuf, pn, lo); else fused_np<MODE, HS>(o, l, p, buf, lane, lane_ok, shift, valid, wlo, whi, qf, nbuf, pn);
}
template <int XTRA, class SrcF, class FinF, class XtraF> __device__ __forceinline__ void kv_pipeline_dma2(LAS unsigned char* lds, int nt, int wave, int lane, const bf16x8 (&qf)[4], SrcF src, FinF fin, XtraF xtra) {
    const bf16_t *kb, *vb; size_t kp, vp;
    asm volatile("s_waitcnt vmcnt(0) lgkmcnt(0)" ::: "memory"); __builtin_amdgcn_s_barrier();
    if (nt <= 0) return;
#pragma unroll
    for (int i = 0; i < 3; ++i) if (i < nt) { src(i, kb, kp, vb, vp); dma_tile(lds + i * DBUF, kb, kp, vb, vp, wave, lane); xtra(i, i); }
    if (nt >= 3) { if (XTRA) asm volatile("s_waitcnt vmcnt(3)" ::: "memory"); else asm volatile("s_waitcnt vmcnt(2)" ::: "memory"); }
    else asm volatile("s_waitcnt vmcnt(0)" ::: "memory");
    __builtin_amdgcn_s_barrier();
    f32x16 pa[2], pb[2];
    scores_d(pa, qf, lds, lane);
#define KVD2_STEP(PC, PN) do { \
        if (t + 3 < nt) { src(t + 3, kb, kp, vb, vp); dma_tile(lds + ((t + 3) & 3) * DBUF, kb, kp, vb, vp, wave, lane); xtra(t + 3, (t + 3) & 3); } \
        const int bn_ = (t + 1 < nt) ? ((t + 1) & 3) : (t & 3); \
        fin(t, PC, lds + (t & 3) * DBUF, lds + bn_ * DBUF, PN, t & 3); \
        if (t + 3 < nt) { if (XTRA) asm volatile("s_waitcnt vmcnt(3) lgkmcnt(0)" ::: "memory"); else asm volatile("s_waitcnt vmcnt(2) lgkmcnt(0)" ::: "memory"); } \
        else asm volatile("s_waitcnt vmcnt(0) lgkmcnt(0)" ::: "memory"); \
        __builtin_amdgcn_s_barrier(); ++t; } while (0)
    int t = 0;
    while (t < nt) { KVD2_STEP(pa, pb); if (t >= nt) break; KVD2_STEP(pb, pa); }
#undef KVD2_STEP
}
__device__ __forceinline__ float gain_max64(const float* g) { float m = 0.f; for (int i = 0; i < 64; ++i) m = fmaxf(m, fabsf(g[i])); return m; }
__device__ __forceinline__ float softmax_shift(float gq, float gk) { const float B = 8.0f * LOG2E * gq * gk * 1.02f; return B > 60.f ? B - 60.f : 0.f; }

template <int MODE, bool HS, class MaskF> __device__ __forceinline__ void half_v(u32x4 (&pw)[4], float& l, const f32x16 (&p)[2], bool lane_ok, float shift, MaskF valid, unsigned wlo, unsigned whi) {
    const unsigned lmask = lane_ok ? 0xffffffffu : 0u; float ls = 0.f;
#pragma unroll
    for (int c = 0; c < 4; ++c) { const int kt = c >> 1, s2 = c & 1; float e[8];
#pragma unroll
        for (int j = 0; j < 8; ++j) { const int i = 8 * s2 + j; const int koff = 32 * kt + (i & 3) + 8 * (i >> 2); float x = __builtin_amdgcn_exp2f(HS ? p[kt][i] - shift : p[kt][i]);
            if (MODE == 1) x = valid(koff) ? x : 0.f;
            if (MODE == 2) { int tb; asm("v_bfe_i32 %0, %1, %2, 1" : "=v"(tb) : "v"(kt ? whi : wlo), "n"(koff & 31)); x = __builtin_bit_cast(float, __builtin_bit_cast(unsigned, x) & (unsigned)tb); }
            e[j] = x; ls += x; }
        pw[c].x = pk2(e[0], e[1]) & lmask; pw[c].y = pk2(e[2], e[3]) & lmask; pw[c].z = pk2(e[4], e[5]) & lmask; pw[c].w = pk2(e[6], e[7]) & lmask; }
    l += lane_ok ? ls : 0.f;
}
__device__ __forceinline__ void half_m(f32x16 (&o)[2], const u32x4 (&pw)[4], const LAS unsigned char* buf, const LAS unsigned char* nbuf, const bf16x8 (&qf)[4], f32x16 (&pn)[2], bool do_scores, int lane) {
    asm volatile("" : "+v"(lane));
    const int r = lane & 31, h = lane >> 5, blk = (lane >> 4) & 1, q4 = (lane & 15) >> 2, pp = lane & 3;
    const int ksw = (r >> 1) & 7;
    const unsigned kl = (unsigned)(size_t)(nbuf + r * 128);
    const unsigned kx0 = ((h ^ ksw) * 16), kx1 = (((2 + h) ^ ksw) * 16);
    const unsigned kA0 = kl + kx0, kA1 = kl + kx1, kB0 = kl + (kx0 ^ 64u), kB1 = kl + (kx1 ^ 64u);
    const int vsw = 4 * ((q4 >> 1) & 1);
    const unsigned vl = (unsigned)(size_t)(buf + 8192 + (4 * h + q4) * 128 + 8 * (pp & 1));
    const unsigned vb0 = vl + ((2 * blk + (pp >> 1)) ^ vsw) * 16, vb1 = vl + ((4 + 2 * blk + (pp >> 1)) ^ vsw) * 16;
    bf16x8 kf[8]; s16x4 vf[16];
    if (do_scores) {
        asm volatile("ds_read_b128 %0, %8\n\tds_read_b128 %1, %9\n\tds_read_b128 %2, %10\n\tds_read_b128 %3, %11\n\tds_read_b128 %4, %8 offset:4096\n\tds_read_b128 %5, %9 offset:4096\n\tds_read_b128 %6, %10 offset:4096\n\tds_read_b128 %7, %11 offset:4096"
                     : "=&v"(kf[0]), "=&v"(kf[1]), "=&v"(kf[2]), "=&v"(kf[3]), "=&v"(kf[4]), "=&v"(kf[5]), "=&v"(kf[6]), "=&v"(kf[7]) : "v"(kA0), "v"(kA1), "v"(kB0), "v"(kB1) : "memory");
    }
#define HM_V(c_) asm volatile("ds_read_b64_tr_b16 %0, %4 offset:%c6\n\tds_read_b64_tr_b16 %1, %4 offset:%c7\n\tds_read_b64_tr_b16 %2, %5 offset:%c6\n\tds_read_b64_tr_b16 %3, %5 offset:%c7" \
                     : "=&v"(vf[4 * (c_)]), "=&v"(vf[4 * (c_) + 1]), "=&v"(vf[4 * (c_) + 2]), "=&v"(vf[4 * (c_) + 3]) : "v"(vb0), "v"(vb1), "i"((32 * ((c_) >> 1) + 16 * ((c_) & 1)) * 128), "i"((32 * ((c_) >> 1) + 16 * ((c_) & 1)) * 128 + 1024) : "memory")
    asm volatile("s_waitcnt lgkmcnt(0)" ::: "memory"); __builtin_amdgcn_sched_barrier(0);
    HM_V(0); HM_V(1); HM_V(2); HM_V(3);
#undef HM_V
    if (do_scores) {
#pragma unroll
        for (int kt = 0; kt < 2; ++kt) { f32x16 z;
#pragma unroll
            for (int i = 0; i < 16; ++i) z[i] = 0.f;
            z = __builtin_amdgcn_mfma_f32_32x32x16_bf16(kf[4 * kt + 0], qf[0], z, 0, 0, 0);
            z = __builtin_amdgcn_mfma_f32_32x32x16_bf16(kf[4 * kt + 1], qf[1], z, 0, 0, 0);
            z = __builtin_amdgcn_mfma_f32_32x32x16_bf16(kf[4 * kt + 2], qf[2], z, 0, 0, 0);
            z = __builtin_amdgcn_mfma_f32_32x32x16_bf16(kf[4 * kt + 3], qf[3], z, 0, 0, 0);
            pn[kt] = z; }
    }
    asm volatile("s_waitcnt lgkmcnt(0)" ::: "memory"); __builtin_amdgcn_sched_barrier(0);
#pragma unroll
    for (int c = 0; c < 4; ++c) { const bf16x8 pb = __builtin_bit_cast(bf16x8, pw[c]);
        o[0] = __builtin_amdgcn_mfma_f32_32x32x16_bf16(__builtin_shufflevector(vf[4 * c], vf[4 * c + 1], 0, 1, 2, 3, 4, 5, 6, 7), pb, o[0], 0, 0, 0);
        o[1] = __builtin_amdgcn_mfma_f32_32x32x16_bf16(__builtin_shufflevector(vf[4 * c + 2], vf[4 * c + 3], 0, 1, 2, 3, 4, 5, 6, 7), pb, o[1], 0, 0, 0); }
}
template <int XTRA, class SrcF, class VF, class XtraF> __device__ __forceinline__ void kv_pipeline_ab(LAS unsigned char* lds, int nt, int wave, int lane, const bf16x8 (&qf)[4], f32x16 (&o)[2], SrcF src, VF vhalf, XtraF xtra) {
    const bf16_t *kb, *vb; size_t kp, vp;
    asm volatile("s_waitcnt vmcnt(0) lgkmcnt(0)" ::: "memory"); __builtin_amdgcn_s_barrier();
    if (nt <= 0) return;
#pragma unroll
    for (int i = 0; i < 3; ++i) if (i < nt) { src(i, kb, kp, vb, vp); dma_tile(lds + i * DBUF, kb, kp, vb, vp, wave, lane); xtra(i, i); }
    if (nt >= 3) { if (XTRA) asm volatile("s_waitcnt vmcnt(3)" ::: "memory"); else asm volatile("s_waitcnt vmcnt(2)" ::: "memory"); }
    else asm volatile("s_waitcnt vmcnt(0)" ::: "memory");
    __builtin_amdgcn_s_barrier();
    f32x16 pc[2]; scores_d(pc, qf, lds, lane);
    asm volatile("s_waitcnt lgkmcnt(0)" ::: "memory");
    const bool grpB = (wave & 4) != 0;
    if (grpB) __builtin_amdgcn_s_barrier();
    u32x4 pw[4];
    for (int t = 0; t < nt; ++t) {
        vhalf(t, pc, pw, t & 3);
        asm volatile("s_waitcnt lgkmcnt(0)" ::: "memory"); __builtin_amdgcn_s_barrier();
        if (t + 3 < nt) { src(t + 3, kb, kp, vb, vp); dma_tile(lds + ((t + 3) & 3) * DBUF, kb, kp, vb, vp, wave, lane); xtra(t + 3, (t + 3) & 3); }
        half_m(o, pw, lds + (t & 3) * DBUF, lds + ((t + 1) & 3) * DBUF, qf, pc, t + 1 < nt, lane);
        if (t + 3 < nt) { if (XTRA) asm volatile("s_waitcnt vmcnt(3) lgkmcnt(0)" ::: "memory"); else asm volatile("s_waitcnt vmcnt(2) lgkmcnt(0)" ::: "memory"); }
        else asm volatile("s_waitcnt vmcnt(0) lgkmcnt(0)" ::: "memory");
        __builtin_amdgcn_s_barrier();
    }
    if (!grpB) __builtin_amdgcn_s_barrier();
}

template <int XTRA, class SrcF, class FinF, class XtraF> __device__ __forceinline__ void kv_pipeline_dma8(LAS unsigned char* lds, int nt, int wave, int lane, const bf16x8 (&qf)[4], const LpOff& lo, SrcF src, FinF fin, XtraF xtra) {
    const bf16_t *kb, *vb; size_t kp, vp;
    asm volatile("s_waitcnt vmcnt(0) lgkmcnt(0)" ::: "memory"); __builtin_amdgcn_s_barrier();
    if (nt <= 0) return;
#define KV8_WAIT(n_) do { const int na_ = (n_); \
        if (XTRA) { if (na_ >= 3) asm volatile("s_waitcnt vmcnt(9) lgkmcnt(0)" ::: "memory"); else if (na_ == 2) asm volatile("s_waitcnt vmcnt(6) lgkmcnt(0)" ::: "memory"); else if (na_ == 1) asm volatile("s_waitcnt vmcnt(3) lgkmcnt(0)" ::: "memory"); else asm volatile("s_waitcnt vmcnt(0) lgkmcnt(0)" ::: "memory"); } \
        else { if (na_ >= 3) asm volatile("s_waitcnt vmcnt(6) lgkmcnt(0)" ::: "memory"); else if (na_ == 2) asm volatile("s_waitcnt vmcnt(4) lgkmcnt(0)" ::: "memory"); else if (na_ == 1) asm volatile("s_waitcnt vmcnt(2) lgkmcnt(0)" ::: "memory"); else asm volatile("s_waitcnt vmcnt(0) lgkmcnt(0)" ::: "memory"); } } while (0)
#pragma unroll
    for (int i = 0; i < 6; ++i) if (i < nt) { src(i, kb, kp, vb, vp); dma_tile_o(lds + i * DBUF, kb, vb, lo.gk, lo.gv, wave); xtra(i, i); }
    { const int iss = nt < 6 ? nt : 6; KV8_WAIT(iss > 3 ? iss - 3 : 0); }
    __builtin_amdgcn_s_barrier();
    f32x16 pa[2], pb[2];
    scores_d(pa, qf, lds, lane);
    int t = 0;
    while (true) {
        if (t + 6 < nt) { src(t + 6, kb, kp, vb, vp); dma_tile_o(lds + ((t + 6) & 7) * DBUF, kb, vb, lo.gk, lo.gv, wave); xtra(t + 6, (t + 6) & 7); }
        { const int bn_ = (t + 1 < nt) ? ((t + 1) & 7) : (t & 7); fin(t, pa, lds + (t & 7) * DBUF, lds + bn_ * DBUF, pb, t & 7); }
        if (t + 1 >= nt) break;
        if (t + 7 < nt) { src(t + 7, kb, kp, vb, vp); dma_tile_o(lds + ((t + 7) & 7) * DBUF, kb, vb, lo.gk, lo.gv, wave); xtra(t + 7, (t + 7) & 7); }
        { const int bn_ = (t + 2 < nt) ? ((t + 2) & 7) : ((t + 1) & 7); fin(t + 1, pb, lds + ((t + 1) & 7) * DBUF, lds + bn_ * DBUF, pa, (t + 1) & 7); }
        { const int rem = nt - (t + 5); KV8_WAIT(rem < 0 ? 0 : (rem > 3 ? 3 : rem)); }
        __builtin_amdgcn_s_barrier();
        t += 2; if (t >= nt) break;
    }
    asm volatile("s_waitcnt vmcnt(0) lgkmcnt(0)" ::: "memory"); __builtin_amdgcn_s_barrier();
#undef KV8_WAIT
}
template <int HD> __device__ __forceinline__ void store_o(const f32x16 (&o)[HD / 32], float f, bf16_t* orow, int lane) {
    const int h = lane >> 5;
#pragma unroll
    for (int dh = 0; dh < HD / 32; ++dh)
#pragma unroll
        for (int g = 0; g < 4; ++g) { u32x2 w; w.x = pk2(o[dh][4 * g] * f, o[dh][4 * g + 1] * f); w.y = pk2(o[dh][4 * g + 2] * f, o[dh][4 * g + 3] * f);
            *(u32x2*)(orow + 32 * dh + 8 * g + 4 * h) = w; }
}

template <int HD> __device__ __forceinline__ void store_o_t(const f32x16 (&o)[HD / 32], float f, bf16_t* base, size_t ld, LAS unsigned char* scr, int lane) {
    constexpr int PITCH = HD * 2 + 16;
    asm volatile("" : "+v"(lane));
    const int r = lane & 31, h = lane >> 5;
#pragma unroll
    for (int dh = 0; dh < HD / 32; ++dh)
#pragma unroll
        for (int g = 0; g < 4; ++g) { u32x2 w; w.x = pk2(o[dh][4 * g] * f, o[dh][4 * g + 1] * f); w.y = pk2(o[dh][4 * g + 2] * f, o[dh][4 * g + 3] * f);
            *(LAS u32x2*)(scr + r * PITCH + (32 * dh + 8 * g + 4 * h) * 2) = w; }
    asm volatile("s_waitcnt lgkmcnt(0)" ::: "memory");
    constexpr int CPR = HD / 8;
#pragma unroll
    for (int i = 0; i < (32 * CPR) / 64; ++i) { const int idx = lane + 64 * i, row = idx / CPR, c = idx % CPR;
        const u32x4 v = *(const LAS u32x4*)(scr + row * PITCH + c * 16);
        *(u32x4*)(base + (size_t)row * ld + c * 8) = v; }
}
}


__device__ __forceinline__ float row_rstd(const float* rsq, int row) {
    const f32x4* pr = (const f32x4*)(rsq + (size_t)row * 16); const f32x4 a = pr[0], b = pr[1], c = pr[2], d = pr[3];
    const float ss = (((a[0] + a[1]) + (a[2] + a[3])) + ((b[0] + b[1]) + (b[2] + b[3]))) + (((c[0] + c[1]) + (c[2] + c[3])) + ((d[0] + d[1]) + (d[2] + d[3])));
    return __builtin_amdgcn_rsqf(ss * (1.0f / 1024.0f) + RMS_EPS);
}
__device__ __forceinline__ void unpack8(const u32x4 w, float (&f)[8]) {
#pragma unroll
    for (int j = 0; j < 4; ++j) { f[2 * j] = __builtin_bit_cast(float, w[j] << 16); f[2 * j + 1] = __builtin_bit_cast(float, w[j] & 0xffff0000u); } }
__device__ __forceinline__ u32x4 pack8f(const float (&f)[8]) { u32x4 o; o.x = pk2(f[0], f[1]); o.y = pk2(f[2], f[3]); o.z = pk2(f[4], f[5]); o.w = pk2(f[6], f[7]); return o; }
__device__ __forceinline__ void head_norm64(float (&f)[8], const float* gain, float extra, int lane) {
    float ss = 0.f;
#pragma unroll
    for (int j = 0; j < 8; ++j) ss += f[j] * f[j];
    ss += __shfl_xor(ss, 1); ss += __shfl_xor(ss, 2); ss += __shfl_xor(ss, 4);
    const float rn = __builtin_amdgcn_rsqf(ss * (1.0f / 64.0f) + RMS_EPS) * extra; const float* gn = gain + (lane & 7) * 8;
#pragma unroll
    for (int j = 0; j < 8; ++j) f[j] = f[j] * rn * gn[j];
}
__device__ __forceinline__ void head_rope64(float (&f)[8], const float* cs, int lane) {
    float oth[8];
#pragma unroll
    for (int j = 0; j < 8; ++j) oth[j] = __shfl_xor(f[j], 1);
    const int li = lane & 7;
    if (li < 2) {
#pragma unroll
        for (int j = 0; j < 8; ++j) { const float c = cs[j], sn = cs[8 + j]; f[j] = (li == 0) ? f[j] * c - oth[j] * sn : f[j] * c + oth[j] * sn; }
    }
}

__device__ __forceinline__ int wave_sum_i(int x) {
    x += __builtin_amdgcn_update_dpp(0, x, 0x111, 0xf, 0xf, true);
    x += __builtin_amdgcn_update_dpp(0, x, 0x112, 0xf, 0xf, true);
    x += __builtin_amdgcn_update_dpp(0, x, 0x114, 0xf, 0xf, true);
    x += __builtin_amdgcn_update_dpp(0, x, 0x118, 0xf, 0xf, true);
    x += __builtin_amdgcn_update_dpp(0, x, 0x142, 0xa, 0xf, true);
    x += __builtin_amdgcn_update_dpp(0, x, 0x143, 0xc, 0xf, true);
    return __builtin_amdgcn_readlane(x, 63);
}

__device__ __forceinline__ int cnt_ge(unsigned u, unsigned cand, int c) {
    int r; asm("v_cmp_ge_u32 vcc, %1, %2\n\tv_addc_co_u32 %0, vcc, 0, %3, vcc" : "=v"(r) : "v"(u), "v"(cand), "v"(c) : "vcc"); return r; }

__device__ __forceinline__ int cnt_ge16(const unsigned* u, unsigned cand, int c) {
    asm("v_cmp_ge_u32 vcc, %1, %17\n\tv_addc_co_u32 %0, vcc, 0, %0, vcc\n\tv_cmp_ge_u32 vcc, %2, %17\n\tv_addc_co_u32 %0, vcc, 0, %0, vcc\n\t"
        "v_cmp_ge_u32 vcc, %3, %17\n\tv_addc_co_u32 %0, vcc, 0, %0, vcc\n\tv_cmp_ge_u32 vcc, %4, %17\n\tv_addc_co_u32 %0, vcc, 0, %0, vcc\n\t"
        "v_cmp_ge_u32 vcc, %5, %17\n\tv_addc_co_u32 %0, vcc, 0, %0, vcc\n\tv_cmp_ge_u32 vcc, %6, %17\n\tv_addc_co_u32 %0, vcc, 0, %0, vcc\n\t"
        "v_cmp_ge_u32 vcc, %7, %17\n\tv_addc_co_u32 %0, vcc, 0, %0, vcc\n\tv_cmp_ge_u32 vcc, %8, %17\n\tv_addc_co_u32 %0, vcc, 0, %0, vcc\n\t"
        "v_cmp_ge_u32 vcc, %9, %17\n\tv_addc_co_u32 %0, vcc, 0, %0, vcc\n\tv_cmp_ge_u32 vcc, %10, %17\n\tv_addc_co_u32 %0, vcc, 0, %0, vcc\n\t"
        "v_cmp_ge_u32 vcc, %11, %17\n\tv_addc_co_u32 %0, vcc, 0, %0, vcc\n\tv_cmp_ge_u32 vcc, %12, %17\n\tv_addc_co_u32 %0, vcc, 0, %0, vcc\n\t"
        "v_cmp_ge_u32 vcc, %13, %17\n\tv_addc_co_u32 %0, vcc, 0, %0, vcc\n\tv_cmp_ge_u32 vcc, %14, %17\n\tv_addc_co_u32 %0, vcc, 0, %0, vcc\n\t"
        "v_cmp_ge_u32 vcc, %15, %17\n\tv_addc_co_u32 %0, vcc, 0, %0, vcc\n\tv_cmp_ge_u32 vcc, %16, %17\n\tv_addc_co_u32 %0, vcc, 0, %0, vcc"
        : "+v"(c) : "v"(u[0]), "v"(u[1]), "v"(u[2]), "v"(u[3]), "v"(u[4]), "v"(u[5]), "v"(u[6]), "v"(u[7]), "v"(u[8]), "v"(u[9]), "v"(u[10]), "v"(u[11]), "v"(u[12]), "v"(u[13]), "v"(u[14]), "v"(u[15]), "v"(cand) : "vcc");
    return c;
}
struct Args { const void* in[32]; float* out; unsigned char* ws; int ph_lo, ph_hi, li, pad; };

template <class CMap>
__device__ __forceinline__ void transpose_item(const float* W, int K, int N, bf16_t* WT, const float* gain, LAS float* scr, int kb, int nb, int lane, CMap cmap) {
    const int k0 = 64 * kb, n0 = 32 * nb, n4 = (lane & 7) * 4; const int c = cmap(n0 + n4);
    f32x4 v[8]; float gk[8];
#pragma unroll
    for (int i = 0; i < 8; ++i) { const int kk = (lane >> 3) + 8 * i; v[i] = (f32x4){0.f, 0.f, 0.f, 0.f}; gk[i] = 1.f;
        if (c >= 0) { v[i] = *(const f32x4*)(W + (size_t)(k0 + kk) * N + c); if (gain) gk[i] = gain[k0 + kk]; } }
#pragma unroll
    for (int i = 0; i < 8; ++i) { const int kk = (lane >> 3) + 8 * i; *(LAS f32x4*)(scr + kk * 36 + n4) = v[i] * gk[i]; }
    asm volatile("s_waitcnt lgkmcnt(0)" ::: "memory");
    const int ch = lane & 7;
#pragma unroll
    for (int j = 0; j < 4; ++j) { const int n = (lane >> 3) + 8 * j; const LAS float* s = scr + (8 * ch) * 36 + n;
        u32x4 o; o.x = pk2(s[0 * 36], s[1 * 36]); o.y = pk2(s[2 * 36], s[3 * 36]); o.z = pk2(s[4 * 36], s[5 * 36]); o.w = pk2(s[6 * 36], s[7 * 36]);
        *(u32x4*)(WT + (size_t)(n0 + n) * K + k0 + 8 * ch) = o; }
    asm volatile("s_waitcnt lgkmcnt(0)" ::: "memory");
}

struct CMapId { int n; __device__ __forceinline__ int operator()(int p) const { return p < n ? p : -1; } };
struct CMapProj0 { __device__ __forceinline__ int operator()(int p) const { const int o = p & 255, c = 64 * (4 * (p >> 8) + ((o >> 5) & 3)) + 8 * (2 * ((o >> 3) & 3) + (o >> 7)) + (o & 7);
    if (c < 936) return c; if (c < 960) return -1; return (c - 24 < AB_W) ? c - 24 : -1; } };
struct CMapProj1 { __device__ __forceinline__ int operator()(int p) const { const int o = p & 255, c = 64 * (4 * (p >> 8) + ((o >> 5) & 3)) + 8 * (2 * ((o >> 3) & 3) + (o >> 7)) + (o & 7); return c < C_W ? c : -1; } };
struct CMapFfn { __device__ __forceinline__ int operator()(int p) const { const int t = p >> 8, r = p & 255; return r < 128 ? t * 128 + r : DFF + t * 128 + (r - 128); } };

#ifndef PIPE_MEM
#define PIPE_MEM false
#endif
#ifndef PIPE_DSA
#define PIPE_DSA true
#endif
#ifndef PIPE_MOBA
#define PIPE_MOBA false
#endif
#ifndef PIPE_SEL
#define PIPE_SEL true
#endif
#ifndef PIPE_WIN
#define PIPE_WIN true
#endif
#ifndef LP_L0
#define LP_L0 true
#endif
#ifndef LP_NSA
#define LP_NSA false
#endif
#ifndef AB_L0
#define AB_L0 0
#endif
#ifndef PROBE_MASK
#define PROBE_MASK 0u
#endif
#define REPS(k) (((PROBE_MASK >> (k)) & 1u) ? 2 : 1)
#define RUN(k) (lo <= (k) && (k) < hi)
#define SEAM(k) do { if ((k) + 1 < hi) xcd_barrier(bar); } while (0)
#define INF_(k) ((const float*)args.in[k])
#define x_in INF_(0)
#define mem_in INF_(1)
#define positions ((const int*)args.in[2])
#define norm_mix INF_(3)
#define norm_mem INF_(4)
#define norm_mem_src INF_(5)
#define norm_ffn INF_(6)
#define ab_w_in INF_(7)
#define ab_w_out INF_(8)
#define nsa_w_in INF_(13)
#define nsa_w_out INF_(14)
#define mem_w_q INF_(25)
#define mem_w_kv INF_(26)
#define mem_w_o INF_(27)
#define ffn_w_in INF_(30)
#define ffn_w_out INF_(31)
#define out (args.out)
#define WSB(off) ((bf16_t*)(args.ws + (off)))
#define W_AB WSB(WS_WAB)
#define W_C WSB(WS_WC)
#define W_ABO WSB(WS_WABO)
#define W_CO WSB(WS_WCO)
#define W_MQ WSB(WS_WMQ)
#define W_KV WSB(WS_WKV)
#define W_MO WSB(WS_WMO)
#define W_FI WSB(WS_WFI)
#define W_FO WSB(WS_WFO)
#define XB WSB(WS_XB)
#define RSQ ((float*)(args.ws + WS_RSQ))
#define HID WSB(WS_R1)
#define MEMB WSB(WS_MEMB)
#define KVRAW WSB(WS_KVRAW)
#define MRS ((float*)(args.ws + WS_MRS))
#define MQB WSB(WS_MQ)
#define OMEM WSB(WS_OMEM)
#define mem_q_norm INF_(28)
#define RAW WSB(WS_R1)
#define OATT WSB(WS_OATT)
#define ROPE64 ((float*)(args.ws + WS_ROPE64))
#define ROPE32 ((float*)(args.ws + WS_ROPE32))
#define W1T WSB(WS_W1T)
#define POSW1 ((float*)(args.ws + WS_POSW1))
#define KCMP WSB(WS_KCMP)
#define VCMP WSB(WS_VCMP)
#define GT ((float*)(args.ws + WS_GT))
#define SCR ((float*)(args.ws + WS_SC))
#define BMK ((unsigned long long*)(args.ws + WS_BM))
#define KMEAN ((float*)(args.ws + WS_KM))
#define IWB ((float*)(args.ws + WS_ISG))
#define dsa_q_norm INF_(9)
#define dsa_k_norm INF_(10)
#define moba_q_norm INF_(11)
#define moba_k_norm INF_(12)
#define nsa_q_norm INF_(15)
#define nsa_kcmp_norm INF_(16)
#define nsa_ksel_norm INF_(17)
#define nsa_kwin_norm INF_(18)
#define nsa_cmp_pos_k INF_(19)
#define nsa_cmp_pos_v INF_(20)
#define nsa_cmp_w1_k INF_(21)
#define nsa_cmp_w2_k INF_(22)
#define nsa_cmp_w1_v INF_(23)
#define nsa_cmp_w2_v INF_(24)
#define mem_k_norm INF_(29)
template <int L> __device__ __forceinline__ void layer_phases(const Args& args, LAS unsigned char* lds, const XcdBarrier& bar, const int lo, const int hi, const int wave) {
    const int G = gridDim.x, bid = blockIdx.x;
    constexpr int pb = 1 + 10 * L;
        if (RUN(pb + 0)) for (int rep_ = 0; rep_ < REPS(pb + 0); ++rep_) {
            int lane = (int)__builtin_amdgcn_mbcnt_hi(~0u, __builtin_amdgcn_mbcnt_lo(~0u, 0u)); asm volatile("" : "+v"(lane)); const int tid = wave * 64 + lane;
            if (L == 0) {
                pg8::Gemm g{MEMB, W_KV, MMEM, 2048, DM}; pg8::StaticOrder S; S.init(MMEM, 2048, G, bid);
                pg8::EpiPlain E{KVRAW, 2048};
                pg8::gemm_phase<pg8::EpiPlain, pg8::StaticOrder, true, true>(lds, g, S, E, wave);
            }
            if (L == 0) {
                pg8::Gemm g{XB, W_AB, MTOK, AB_WP, DM}; pg8::StaticOrder S; S.init(MTOK, AB_WP, G, bid);
                pg8::EpiProj<0> E{RAW, AB_WP, RSQ, ROPE64, ROPE32, dsa_q_norm, dsa_k_norm, moba_q_norm, moba_k_norm, IWB};
                pg8::gemm_phase<pg8::EpiProj<0>, pg8::StaticOrder, true, true>(lds, g, S, E, wave);
            }
            if (L == 1) {
                pg8::Gemm g{XB, W_C, MTOK, C_WP, DM}; pg8::StaticOrder S; S.init(MTOK, C_WP, G, bid);
                pg8::EpiProj<1> E{RAW, C_WP, RSQ, ROPE64, ROPE32, nsa_q_norm, nsa_ksel_norm, nsa_kwin_norm, nullptr, GT};
                pg8::gemm_phase<pg8::EpiProj<1>, pg8::StaticOrder, true, true>(lds, g, S, E, wave);
            }
            SEAM(pb + 0);
        }
        if (RUN(pb + 1)) for (int rep_ = 0; rep_ < REPS(pb + 1); ++rep_) {
            int lane = (int)__builtin_amdgcn_mbcnt_hi(~0u, __builtin_amdgcn_mbcnt_lo(~0u, 0u)); asm volatile("" : "+v"(lane)); const int tid = wave * 64 + lane;
            if (L == 1) {
                LAS float* PART = (LAS float*)lds;
                LAS float* HB = (LAS float*)(lds + 65536);
                LAS float* W2S = (LAS float*)(lds + 65536 + 8448);
                for (int u = bid; u < BATCH * 4 * 2 * 8; u += G) {
                    const int ch = u & 7, kv = (u >> 3) & 1, g = (u >> 4) & 3, b = u >> 6;
                    const int r = lane & 31, h = lane >> 5, n0 = ch * 32;
                    const bf16_t* xb0 = RAW + (size_t)(b * SEQ + 16 * (n0 + r)) * C_WP + (kv ? 1280 : 1024) + g * 64 + 8 * h;
                    const bf16_t* wt = W1T + (size_t)kv * 64 * 2048 + 8 * h;
                    f32x16 acc[2];
#pragma unroll
                    for (int i = 0; i < 16; ++i) { acc[0][i] = 0.f; acc[1][i] = 0.f; }
                    const bool rowok = (n0 + r) < 255;
                    float rsl[4];
#pragma unroll
                    for (int li = 0; li < 4; ++li) rsl[li] = rowok ? row_rstd(RSQ, b * SEQ + 16 * (n0 + r) + wave * 4 + li) : 0.f;
#pragma unroll
                    for (int li = 0; li < 4; ++li) { const int l = wave * 4 + li;
#pragma unroll
                        for (int s2 = 0; s2 < 4; ++s2) {
                            bf16x8 a = {0, 0, 0, 0, 0, 0, 0, 0};
                            if (rowok) { float f[8]; unpack8(*(const u32x4*)(xb0 + (size_t)l * C_WP + 16 * s2), f);
#pragma unroll
                                for (int j = 0; j < 8; ++j) f[j] *= rsl[li];
                                a = __builtin_bit_cast(bf16x8, pack8f(f)); }
                            const bf16x8 b0 = *(const bf16x8*)(wt + (size_t)r * 2048 + l * 64 + 16 * s2), b1 = *(const bf16x8*)(wt + (size_t)(32 + r) * 2048 + l * 64 + 16 * s2);
                            acc[0] = __builtin_amdgcn_mfma_f32_32x32x16_bf16(a, b0, acc[0], 0, 0, 0); acc[1] = __builtin_amdgcn_mfma_f32_32x32x16_bf16(a, b1, acc[1], 0, 0, 0); } }
                    __syncthreads();
#pragma unroll
                    for (int nh = 0; nh < 2; ++nh)
#pragma unroll
                        for (int i = 0; i < 16; ++i) PART[wave * 2048 + ((i & 3) + 8 * (i >> 2) + 4 * h) * 64 + nh * 32 + r] = acc[nh][i];
                    { const float* w2 = kv ? nsa_cmp_w2_v : nsa_cmp_w2_k; const f32x4 wa = *(const f32x4*)(w2 + tid * 4), wb = *(const f32x4*)(w2 + 2048 + tid * 4);
                      *(LAS f32x4*)(W2S + tid * 4) = wa; *(LAS f32x4*)(W2S + 2048 + tid * 4) = wb; }
                    __syncthreads();
                    const float pw1 = POSW1[kv * 64 + (tid & 63)];
                    for (int i = tid; i < 2048; i += 512) { float a = pw1;
#pragma unroll
                        for (int w = 0; w < 8; ++w) a += PART[w * 2048 + i];
                        HB[(i >> 6) * 65 + (i & 63)] = a / (1.0f + __expf(-a)); }
                    __syncthreads();
                    { const int n = tid >> 4, c4 = (tid & 15) * 4; float o[4] = {0.f, 0.f, 0.f, 0.f};
                        for (int c = 0; c < 64; ++c) { const float hv = HB[n * 65 + c]; const f32x4 w = *(const LAS f32x4*)(W2S + c * 64 + c4); o[0] += hv * w[0]; o[1] += hv * w[1]; o[2] += hv * w[2]; o[3] += hv * w[3]; }
                        if (kv == 0) { float ss = (o[0] * o[0] + o[1] * o[1]) + (o[2] * o[2] + o[3] * o[3]);
                            ss += __shfl_xor(ss, 1); ss += __shfl_xor(ss, 2); ss += __shfl_xor(ss, 4); ss += __shfl_xor(ss, 8);
                            const float rn = __builtin_amdgcn_rsqf(ss * (1.0f / 64.0f) + RMS_EPS);
#pragma unroll
                            for (int j = 0; j < 4; ++j) o[j] = o[j] * rn * nsa_kcmp_norm[c4 + j]; }
                        if (n0 + n >= 255) { o[0] = o[1] = o[2] = o[3] = 0.f; }
                        u32x2 w; w.x = pk2(o[0], o[1]); w.y = pk2(o[2], o[3]);
                        *(u32x2*)((kv ? VCMP : KCMP) + ((size_t)(b * 4 + g) * 256 + n0 + n) * 64 + c4) = w; }
                    __syncthreads();
                }
            }
            if (L == 1) SEAM(pb + 1);
        }
        if (RUN(pb + 2)) for (int rep_ = 0; rep_ < REPS(pb + 2); ++rep_) {
            int lane = (int)__builtin_amdgcn_mbcnt_hi(~0u, __builtin_amdgcn_mbcnt_lo(~0u, 0u)); asm volatile("" : "+v"(lane)); const int tid = wave * 64 + lane;
            if (L == 0 && rep_ == 0) {
                const int gw = bid * NWAVES + wave, NGW = G * NWAVES;
                for (int m = gw; m < MMEM; m += NGW) {
                    const float rs = MRS[m]; bf16_t* row = KVRAW + (size_t)m * 2048;
#pragma unroll
                    for (int st = 0; st < 4; ++st) {
                        u32x4 w = *(const u32x4*)(row + st * 512 + lane * 8); float f[8];
#pragma unroll
                        for (int j = 0; j < 4; ++j) { f[2 * j] = __builtin_bit_cast(float, w[j] << 16) * rs; f[2 * j + 1] = __builtin_bit_cast(float, w[j] & 0xffff0000u) * rs; }
                        if ((st & 1) == 0) {
                            float ss = 0.f;
#pragma unroll
                            for (int j = 0; j < 8; ++j) ss += f[j] * f[j];
                            ss += __shfl_xor(ss, 1); ss += __shfl_xor(ss, 2); ss += __shfl_xor(ss, 4); ss += __shfl_xor(ss, 8);
                            const float rn = __builtin_amdgcn_rsqf(ss * (1.0f / 128.0f) + RMS_EPS);
                            const float* gn = mem_k_norm + (st >> 1) * 128 + (lane & 15) * 8;
#pragma unroll
                            for (int j = 0; j < 8; ++j) f[j] = f[j] * rn * gn[j];
                        }
                        u32x4 o; o.x = pk2(f[0], f[1]); o.y = pk2(f[2], f[3]); o.z = pk2(f[4], f[5]); o.w = pk2(f[6], f[7]);
                        *(u32x4*)(row + st * 512 + lane * 8) = o;
                    }
                }
            }
            if (L == 0) {
                { const int gw = bid * NWAVES + wave, NGW = G * NWAVES;
                  for (int u = gw; u < BATCH * 8 * 16; u += NGW) { const int n = u & 15, hm = (u >> 4) & 7, b = u >> 7;
                      const bf16_t* kb = RAW + (size_t)(b * SEQ + 256 * n + (lane >> 3)) * AB_WP + 1472 + hm * 64 + (lane & 7) * 8; float a[8] = {0.f, 0.f, 0.f, 0.f, 0.f, 0.f, 0.f, 0.f};
                      for (int i0 = 0; i0 < 32; i0 += 8) { u32x4 rw[8];
#pragma unroll
                          for (int i = 0; i < 8; ++i) rw[i] = *(const u32x4*)(kb + (size_t)(8 * (i0 + i)) * AB_WP);
#pragma unroll
                          for (int i = 0; i < 8; ++i) { float f[8]; unpack8(rw[i], f);
#pragma unroll
                              for (int j = 0; j < 8; ++j) a[j] += f[j]; } }
#pragma unroll
                      for (int j = 0; j < 8; ++j) { a[j] += __shfl_xor(a[j], 8); a[j] += __shfl_xor(a[j], 16); a[j] += __shfl_xor(a[j], 32); }
                      if (lane < 8) { float* o = KMEAN + (size_t)u * 64 + lane * 8;
#pragma unroll
                          for (int j = 0; j < 8; ++j) o[j] = a[j] * (1.0f / 256.0f); } } }
                LAS float* SCL = (LAS float*)lds;
#if defined(PROBE_IDX) && PROBE_IDX == 2
                if (rep_ == 0)
#endif
                for (int ui = bid; ui < BATCH * 256; ui += G) {
                    const int rr = ui >> 8, pos = ui & 255; const int qi = 32 * rr + ((rr & 1) ? 31 - (pos >> 3) : (pos >> 3)), b = pos & 7;
                    const int t0 = qi * 16, tmax = t0 + 15, nchunk = (tmax >> 10) + 1, nreg = (tmax >> 6) + 1;
                    const int ql = lane & 15, kq = lane >> 4;
                    const size_t qrow = (size_t)b * SEQ + t0 + ql;
                    typedef float f32x4v __attribute__((ext_vector_type(4)));
                    bf16x8 qf[8];
#pragma unroll
                    for (int hi = 0; hi < 8; ++hi) qf[hi] = *(const bf16x8*)(RAW + qrow * AB_WP + 640 + hi * 32 + 8 * kq);
                    const f32x4 iw0 = *(const f32x4*)(IWB + qrow * 8), iw1 = *(const f32x4*)(IWB + qrow * 8 + 4);
                    unsigned uu[2][64];
#pragma unroll
                    for (int rg = 0; rg < 64; ++rg) { uu[0][rg] = 0u; uu[1][rg] = 0u; }
#pragma unroll
                    for (int c = 0; c < 4; ++c) if (c < nchunk) {
                        const int ntile = ((tmax - 1024 * c) >> 4) + 1 < 64 ? ((tmax - 1024 * c) >> 4) + 1 : 64;
                        __syncthreads();
                        const bf16_t* kfp = RAW + (size_t)(b * SEQ + 1024 * c + ql) * AB_WP + 896 + 8 * kq;
                        bf16x8 kfn = *(const bf16x8*)(kfp + (size_t)(16 * (wave < ntile ? wave : 0)) * AB_WP);
                        for (int tile = wave; tile < ntile; tile += 8) {
                            const bf16x8 kf = kfn; { const int tn = tile + 8 < ntile ? tile + 8 : tile; kfn = *(const bf16x8*)(kfp + (size_t)(16 * tn) * AB_WP); }
                            f32x4v sc = {0.f, 0.f, 0.f, 0.f};
#pragma unroll
                            for (int hi = 0; hi < 8; ++hi) { f32x4v x = {0.f, 0.f, 0.f, 0.f}; x = __builtin_amdgcn_mfma_f32_16x16x32_bf16(kf, qf[hi], x, 0, 0, 0);
                                const float sf = hi < 4 ? iw0[hi & 3] : iw1[hi & 3];
#pragma unroll
                                for (int i = 0; i < 4; ++i) sc[i] += sf * fmaxf(x[i], 0.f); }
                            *(LAS f32x4v*)(SCL + ql * 1028 + 16 * tile + 4 * kq) = sc;
                        }
                        __syncthreads();
#pragma unroll
                        for (int qq = 0; qq < 2; ++qq) { const int t = t0 + 2 * wave + qq;
#pragma unroll
                            for (int rl = 0; rl < 16; ++rl) { const int key = 1024 * c + 64 * rl + lane; const unsigned bits = __builtin_bit_cast(unsigned, SCL[(2 * wave + qq) * 1028 + 64 * rl + lane]);
                                const unsigned mono = bits ^ ((bits >> 31) ? 0xffffffffu : 0x80000000u); uu[qq][16 * c + rl] = (key <= t) ? mono : 0u; } }
                    }
#if defined(PROBE_IDX) && PROBE_IDX == 1
                    if (rep_) { if (uu[0][3] == 12345u && uu[1][40] == 777u) BMK[0] = 1ull; continue; }
#endif
                    int lb = lane; asm volatile("" : "+v"(lb));
                    unsigned long long word[2] = {0ull, 0ull};
                    unsigned T[2] = {0u, 0u}; bool done[2], exact[2] = {false, false};
                    done[0] = (t0 + 2 * wave) < 256; done[1] = (t0 + 2 * wave + 1) < 256;
                    for (int bit = 31; bit >= 0 && !(done[0] && done[1]); --bit) {
                        const unsigned c0 = T[0] | (1u << bit), c1 = T[1] | (1u << bit); int n0 = 0, n1 = 0;
#pragma unroll
                        for (int ch = 0; ch < 4; ++ch) if (16 * ch < nreg) {
#pragma unroll
                            for (int dummy_ = 0; dummy_ < 1; ++dummy_) { n0 = cnt_ge16(&uu[0][16 * ch], c0, n0); n1 = cnt_ge16(&uu[1][16 * ch], c1, n1); } }
                        const int s0 = wave_sum_i(n0), s1 = wave_sum_i(n1);
                        if (!done[0]) { if (s0 >= 256) T[0] = c0; if (s0 == 256) { done[0] = true; exact[0] = true; } }
                        if (!done[1]) { if (s1 >= 256) T[1] = c1; if (s1 == 256) { done[1] = true; exact[1] = true; } }
                    }
#pragma unroll
                    for (int qq = 0; qq < 2; ++qq) { const int t = t0 + 2 * wave + qq; unsigned long long myword = 0ull;
                        if (t < 256) {
#pragma unroll
                            for (int rg = 0; rg < 4; ++rg) { const unsigned long long w = __ballot(64 * rg + lb <= t); if (lb == rg) myword = w; }
                        } else if (exact[qq]) {
#pragma unroll
                            for (int rg = 0; rg < 64; ++rg) { const unsigned long long w = __ballot(uu[qq][rg] >= T[qq]); if (lb == rg) myword = w; __builtin_amdgcn_sched_barrier(0); }
                        } else {
                            int cg = 0;
#pragma unroll
                            for (int rg = 0; rg < 64; ++rg) cg = cnt_ge(uu[qq][rg], T[qq] + 1u, cg);
                            int need = 256 - wave_sum_i(cg);
#pragma unroll
                            for (int rg = 0; rg < 64; ++rg) {
                                unsigned long long w = __ballot(uu[qq][rg] > T[qq]), eq = __ballot(uu[qq][rg] == T[qq]); const int ne = __builtin_popcountll(eq);
                                if (ne <= need) { w |= eq; need -= ne; } else { while (need > 0) { const unsigned long long low = eq & (0ull - eq); w |= low; eq ^= low; --need; } }
                                if (lb == rg) myword = w; __builtin_amdgcn_sched_barrier(0); }
                        }
                        BMK[((size_t)(b * 128 + (t >> 5)) * 64 + lb) * 32 + (t & 31)] = myword;
                    }
                }
            }
            if (L == 0) SEAM(pb + 2);
        }
        if (RUN(pb + 3)) for (int rep_ = 0; rep_ < REPS(pb + 3); ++rep_) {
            int lane = (int)__builtin_amdgcn_mbcnt_hi(~0u, __builtin_amdgcn_mbcnt_lo(~0u, 0u)); asm volatile("" : "+v"(lane)); const int tid = wave * 64 + lane;
            if (L == 0) {
                const float shiftA = att::softmax_shift(att::gain_max64(dsa_q_norm), att::gain_max64(dsa_k_norm)), shiftB = att::softmax_shift(att::gain_max64(moba_q_norm), att::gain_max64(moba_k_norm));
                for (int ui = bid; ui < BATCH * 128; ui += G) {
                    const int rr = ui >> 8, pos = ui & 255; const int qt = 32 * rr + ((rr & 1) ? 31 - (pos >> 3) : (pos >> 3)), b = pos & 7;
                    const int r = lane & 31, h = lane >> 5; const size_t row = (size_t)b * SEQ + qt * 32 + r;
                    bf16x8 qf[4];
                    { const bf16_t* qrow = RAW + row * AB_WP + wave * 64 + 8 * h;
#pragma unroll
                      for (int s2 = 0; s2 < 4; ++s2) qf[s2] = *(const bf16x8*)(qrow + 16 * s2); }
                    f32x16 oo[2]; float ll = 0.f;
#pragma unroll
                    for (int i = 0; i < 16; ++i) { oo[0][i] = 0.f; oo[1][i] = 0.f; }
                    const bf16_t* kbase = RAW + (size_t)b * SEQ * AB_WP + 512; const unsigned long long* bm = BMK + (size_t)(b * 128 + qt) * 64 * 32;
                    const att::LpOff lpo = att::lp_offsets(lane, wave, AB_WP * 2);
                    LAS unsigned char* MSL = lds + 8 * att::DBUF;
{ auto go_ = [&](auto hs_) { constexpr bool HS = decltype(hs_)::value;
#if AB_L0
                    att::kv_pipeline_ab<1>(lds, (qt >> 1) + 1, wave, lane, qf, oo,
                        [&](int tt, const bf16_t*& kb, size_t& kp, const bf16_t*& vb, size_t& vp) { kb = kbase + (size_t)(64 * tt) * AB_WP; kp = AB_WP; vb = kb + 64; vp = AB_WP; },
                        [&](int tt, const f32x16 (&p)[2], u32x4 (&pw)[4], int slot) {
                            const unsigned long long w = *(const LAS unsigned long long*)(MSL + (slot * 8 + wave) * 256 + r * 8) >> (4 * h);
                            att::half_v<2, HS>(pw, ll, p, true, shiftA, [](int) { return true; }, (unsigned)w, (unsigned)(w >> 32)); },
                        [&](int tt, int slot) { __builtin_amdgcn_global_load_lds((const unsigned*)(bm + (size_t)tt * 32) + lane, (LAS unsigned*)(MSL + (slot * 8 + wave) * 256), 4, 0, 0); });
#else
                    att::kv_pipeline_dma8<0>(lds, (qt >> 1) + 1, wave, lane, qf, lpo,
                        [&](int tt, const bf16_t*& kb, size_t& kp, const bf16_t*& vb, size_t& vp) { kb = kbase + (size_t)(64 * tt) * AB_WP; kp = AB_WP; vb = kb + 64; vp = AB_WP; },
                        [&](int tt, f32x16 (&p)[2], const LAS unsigned char* buf, const LAS unsigned char* nbuf, f32x16 (&pn)[2], int slot) {
                            const unsigned long long w = *(const LAS unsigned long long*)(MSL + slot * 256 + r * 8) >> (4 * h);
#if defined(PROBE_SKEL) && PROBE_SKEL == 2
                            if (rep_ == 0)
#endif
                            att::fused_e<2, HS, LP_L0>(oo, ll, p, buf, lane, true, shiftA, [](int) { return true; }, (unsigned)w, (unsigned)(w >> 32), qf, nbuf, pn, lpo); },
                        [&](int tt, int slot) { if ((tt & 7) == wave) __builtin_amdgcn_global_load_lds((const unsigned*)(bm + (size_t)tt * 32) + lane, (LAS unsigned*)(MSL + slot * 256), 4, 0, 0); });
#endif
 }; if (shiftA == 0.f) go_(std::false_type{}); else go_(std::true_type{}); }
                    const float lt = ll + __shfl_xor(ll, 32);
#if defined(PROBE_SKEL) && PROBE_SKEL == 2
                    if (rep_ == 0)
#endif
                    att::store_o_t<64>(oo, lt > 0.f ? 1.0f / lt : 0.f, OATT + ((size_t)b * SEQ + qt * 32) * 1024 + wave * 64, 1024, lds + wave * 4608, lane);
                }
                LAS unsigned* UNI = (LAS unsigned*)(lds + 8 * att::DBUF); LAS int* TL = (LAS int*)(lds + 8 * att::DBUF + 16); LAS float* KMS = (LAS float*)(lds + 8 * att::DBUF + 256);
#if defined(PROBE_SKEL)
                if (rep_ == 0)
#endif
                for (int ui = bid; ui < BATCH * 8 * 16; ui += G) {
                    const int rr = ui >> 8, pos = ui & 255; const int xk = pos >> 3, cmb = rr * 16 + (pos & 7) * 2 + (xk >> 4);
                    const int own = (rr & 1) ? 15 - (xk & 15) : (xk & 15), b = cmb >> 3, hm = cmb & 7;
                    const int r = lane & 31, h = lane >> 5; const int tl = wave * 32 + r; const size_t row = (size_t)b * SEQ + own * 256 + tl;
                    bf16x8 qf[4];
                    { const bf16_t* qrow = RAW + row * AB_WP + 960 + hm * 64 + 8 * h;
#pragma unroll
                      for (int s2 = 0; s2 < 4; ++s2) qf[s2] = *(const bf16x8*)(qrow + 16 * s2); }
                    if (tid == 0) UNI[0] = 0u;
                    { const f32x2 kmv = *(const f32x2*)(KMEAN + (size_t)(b * 8 + hm) * 1024 + tid * 2); *(LAS f32x2*)(KMS + tid * 2) = kmv; }
                    __syncthreads();
                    unsigned msk = 0u;
                    { float b0 = att::NEG_INF, b1 = att::NEG_INF, b2 = att::NEG_INF; int i0 = -1, i1 = -1, i2 = -1;
                      float qv[32];
#pragma unroll
                      for (int s2 = 0; s2 < 4; ++s2) { float f[8]; unpack8(__builtin_bit_cast(u32x4, qf[s2]), f);
#pragma unroll
                          for (int j = 0; j < 8; ++j) qv[8 * s2 + j] = f[j]; }
                      for (int n = 0; n < own; ++n) { const LAS float* km = KMS + n * 64 + 8 * h; float a = 0.f;
#pragma unroll
                          for (int s2 = 0; s2 < 4; ++s2) { const f32x4 k0 = *(const LAS f32x4*)(km + 16 * s2), k1 = *(const LAS f32x4*)(km + 16 * s2 + 4);
                              a += qv[8 * s2] * k0[0] + qv[8 * s2 + 1] * k0[1] + qv[8 * s2 + 2] * k0[2] + qv[8 * s2 + 3] * k0[3] + qv[8 * s2 + 4] * k1[0] + qv[8 * s2 + 5] * k1[1] + qv[8 * s2 + 6] * k1[2] + qv[8 * s2 + 7] * k1[3]; }
                          a += __shfl_xor(a, 32);
                          if (a > b0) { b2 = b1; i2 = i1; b1 = b0; i1 = i0; b0 = a; i0 = n; } else if (a > b1) { b2 = b1; i2 = i1; b1 = a; i1 = n; } else if (a > b2) { b2 = a; i2 = n; } }
                      if (i0 >= 0) msk |= 1u << i0; if (i1 >= 0) msk |= 1u << i1; if (i2 >= 0) msk |= 1u << i2; }
                    { unsigned um = msk;
#pragma unroll
                      for (int o = 1; o < 64; o <<= 1) um |= __shfl_xor(um, o);
                      if (lane == 0) __hip_atomic_fetch_or(UNI, um, __ATOMIC_RELAXED, __HIP_MEMORY_SCOPE_WORKGROUP); }
                    __syncthreads();
                    const unsigned U = (unsigned)__builtin_amdgcn_readfirstlane((int)UNI[0]);
                    const int npast = __builtin_popcount(U);
                    if (wave == 0 && lane < 16 && ((U >> lane) & 1u)) TL[__builtin_amdgcn_mbcnt_lo(U, 0u)] = lane;
                    f32x16 oo[2]; float ll = 0.f;
#pragma unroll
                    for (int i = 0; i < 16; ++i) { oo[0][i] = 0.f; oo[1][i] = 0.f; }
                    const bf16_t* kbase = RAW + (size_t)b * SEQ * AB_WP + 1472 + hm * 64;
                    const att::LpOff lpo = att::lp_offsets(lane, wave, AB_WP * 2);
                    __syncthreads();
{ auto go_ = [&](auto hs_) { constexpr bool HS = decltype(hs_)::value;
#if AB_L0
                    att::kv_pipeline_ab<0>(lds, 4 * npast + 4, wave, lane, qf, oo,
                        [&](int tt, const bf16_t*& kb, size_t& kp, const bf16_t*& vb, size_t& vp) {
                            const int blk = (tt < 4 * npast) ? __builtin_amdgcn_readfirstlane(TL[tt >> 2]) : own, sub = (tt < 4 * npast) ? (tt & 3) : tt - 4 * npast;
                            kb = kbase + (size_t)(256 * blk + 64 * sub) * AB_WP; kp = AB_WP; vb = kb + 512; vp = AB_WP; },
                        [&](int tt, const f32x16 (&p)[2], u32x4 (&pw)[4], int) {
                            if (tt < 4 * npast) { const int blk = __builtin_amdgcn_readfirstlane(TL[tt >> 2]); const bool sel = (msk >> blk) & 1u;
                                att::half_v<0, HS>(pw, ll, p, sel, shiftB, [](int) { return true; }, 0u, 0u); }
                            else { const int sub = tt - 4 * npast; const int lim = tl - 64 * sub - 4 * h;
                                att::half_v<1, HS>(pw, ll, p, true, shiftB, [&](int koff) { return koff <= lim; }, 0u, 0u); } },
                        att::NoXtra());
#else
                    att::kv_pipeline_dma8<0>(lds, 4 * npast + 4, wave, lane, qf, lpo,
                        [&](int tt, const bf16_t*& kb, size_t& kp, const bf16_t*& vb, size_t& vp) {
                            const int blk = (tt < 4 * npast) ? __builtin_amdgcn_readfirstlane(TL[tt >> 2]) : own, sub = (tt < 4 * npast) ? (tt & 3) : tt - 4 * npast;
                            kb = kbase + (size_t)(256 * blk + 64 * sub) * AB_WP; kp = AB_WP; vb = kb + 512; vp = AB_WP; },
                        [&](int tt, f32x16 (&p)[2], const LAS unsigned char* buf, const LAS unsigned char* nbuf, f32x16 (&pn)[2], int) {
                            if (tt < 4 * npast) { const int blk = __builtin_amdgcn_readfirstlane(TL[tt >> 2]); const bool sel = (msk >> blk) & 1u;
                                att::fused_e<0, HS, LP_L0>(oo, ll, p, buf, lane, sel, shiftB, [](int) { return true; }, 0u, 0u, qf, nbuf, pn, lpo); }
                            else { const int sub = tt - 4 * npast; const int lim = tl - 64 * sub - 4 * h;
                                att::fused_e<1, HS, LP_L0>(oo, ll, p, buf, lane, true, shiftB, [&](int koff) { return koff <= lim; }, 0u, 0u, qf, nbuf, pn, lpo); } },
                        att::NoXtra());
#endif
 }; if (shiftB == 0.f) go_(std::false_type{}); else go_(std::true_type{}); }
                    const float lt = ll + __shfl_xor(ll, 32);
                    att::store_o_t<64>(oo, lt > 0.f ? 1.0f / lt : 0.f, OATT + ((size_t)b * SEQ + own * 256 + wave * 32) * 1024 + 512 + hm * 64, 1024, lds + wave * 4608, lane);
                    __syncthreads();
                }
            }
            if (L == 1) {
                const float shiftS = att::softmax_shift(att::gain_max64(nsa_q_norm), att::gain_max64(nsa_ksel_norm)), shiftW = att::softmax_shift(att::gain_max64(nsa_q_norm), att::gain_max64(nsa_kwin_norm));
                LAS unsigned* IMP = (LAS unsigned*)(lds + 86016);
                LAS unsigned long long* SELM = (LAS unsigned long long*)(lds + 4 * att::DBUF); LAS int* TL = (LAS int*)(lds + 4 * att::DBUF + 528);
                for (int ui = bid; ui < BATCH * 4 * 64; ui += G) {
                    const int rr = ui >> 8, pos = ui & 255;
                    const int pr = (pos & 7) * 4 + (rr >> 1), xk = pos >> 3, qt = (rr & 1) ? 63 - xk : xk, b = pr >> 2, g = pr & 3;
                    const int r = lane & 31, h = lane >> 5, j = wave & 3, qs = wave >> 2, hd = g * 4 + j;
                    const int t = qt * 64 + qs * 32 + r, ql = qs * 32 + r; const size_t row = (size_t)b * SEQ + t;
                    bf16x8 qf[4];
                    { const bf16_t* qrow = RAW + row * C_WP + hd * 64 + 8 * h;
#pragma unroll
                      for (int s2 = 0; s2 < 4; ++s2) qf[s2] = *(const bf16x8*)(qrow + 16 * s2); }
                    for (int i = tid; i < ((qt >> 4) + 1) * 64 * 64 / 4; i += 512) ((LAS u32x4*)IMP)[i] = (u32x4){0u, 0u, 0u, 0u};
                    f32x16 oacc[2];
                    const float* gt = GT + row * 48 + hd * 3; const float g0 = gt[0];
                    const int nvalid = t >= 31 ? ((t - 31) >> 4) + 1 : 0;
                    const int ntc = (qt >> 4) + 1;
                    { const bf16_t* kcb = KCMP + (size_t)(b * 4 + g) * 256 * 64; const bf16_t* vcb = VCMP + (size_t)(b * 4 + g) * 256 * 64;
                      for (int idx = tid; idx < 64 * 8 * ntc; idx += 512) { const int rw = idx >> 3, c = idx & 7;
                          *(LAS u32x4*)(lds + rw * 144 + c * 16) = *(const u32x4*)(kcb + rw * 64 + c * 8);
                          *(LAS u32x4*)(lds + 36864 + rw * 192 + c * 16) = *(const u32x4*)(vcb + rw * 64 + c * 8); } }
                    __syncthreads();
                    float mc = att::NEG_INF, lc = 0.f;
#pragma unroll 1
                    for (int tt = 0; tt < ntc; ++tt) {
                        f32x16 p[2]; att::tile_scores<64>(p, qf, lds + tt * 9216, lane); const int lim = nvalid - 64 * tt - 4 * h; float mx = att::NEG_INF;
#pragma unroll
                        for (int kt = 0; kt < 2; ++kt)
#pragma unroll
                            for (int i = 0; i < 16; ++i) { const int koff = 32 * kt + (i & 3) + 8 * (i >> 2); const float v = (koff < lim) ? p[kt][i] : att::NEG_INF; p[kt][i] = v; mx = fmaxf(mx, v); }
                        mx = fmaxf(mx, __shfl_xor(mx, 32));
                        const float mnew = fmaxf(mc, mx), muse = (mnew == att::NEG_INF) ? 0.f : mnew; float ls = 0.f;
#pragma unroll
                        for (int kt = 0; kt < 2; ++kt)
#pragma unroll
                            for (int i = 0; i < 16; ++i) ls += __builtin_amdgcn_exp2f(p[kt][i] - muse);
                        lc = lc * __builtin_amdgcn_exp2f(mc - muse) + ls; mc = mnew; }
                    lc += __shfl_xor(lc, 32);
                    const float invl = lc > 0.f ? 1.0f / lc : 0.f, mcu = (mc == att::NEG_INF) ? 0.f : mc;
#pragma unroll
                    for (int i = 0; i < 16; ++i) { oacc[0][i] = 0.f; oacc[1][i] = 0.f; }
#pragma unroll 1
                    for (int tt = 0; tt < ntc; ++tt) {
                        f32x16 p[2]; att::tile_scores<64>(p, qf, lds + tt * 9216, lane); const int lim = nvalid - 64 * tt - 4 * h;
#pragma unroll
                        for (int kt = 0; kt < 2; ++kt)
#pragma unroll
                            for (int i = 0; i < 16; ++i) { const int koff = 32 * kt + (i & 3) + 8 * (i >> 2); const float pv = (koff < lim) ? __builtin_amdgcn_exp2f(p[kt][i] - mcu) * invl : 0.f; p[kt][i] = pv;
                                __hip_atomic_fetch_add(IMP + (64 * tt + koff + 4 * h) * 64 + ql, (unsigned)(pv * 134217728.0f + 0.5f), __ATOMIC_RELAXED, __HIP_MEMORY_SCOPE_WORKGROUP);
                                if ((i & 3) == 3) __builtin_amdgcn_sched_barrier(0); }
                        __builtin_amdgcn_sched_barrier(0);
                        att::tile_pv<64>(oacc, p, lds + 36864 + tt * 12288 - 9216, lane); }
#pragma unroll
                    for (int i = 0; i < 16; ++i) { oacc[0][i] *= g0; oacc[1][i] *= g0; }
                    LAS float* STASH = (LAS float*)IMP + wave * 2048 + lane;
                    __syncthreads();
                    {
                        int l2 = lane; asm volatile("" : "+v"(l2));
                        const int qq = l2 >> 3, seg = l2 & 7, q = wave * 8 + qq, cur = qt;
                        unsigned key[8];
#pragma unroll
                        for (int k = 0; k < 8; ++k) { const int sb = 8 * seg + k; unsigned v = 0u;
#pragma unroll
                            for (int dn = -1; dn <= 3; ++dn) { const int n = 4 * sb + dn; if (n >= 0 && n < 255) v += IMP[n * 64 + q]; }
                            const bool forced = (sb == 0) || (sb == cur) || (sb == cur - 1);
                            key[k] = (sb <= cur) ? ((forced ? 0xffffff80u : ((v >> 7) << 7)) | (unsigned)(64 - sb)) : 0u; __builtin_amdgcn_sched_barrier(0); }
                        unsigned T = 0u;
                        for (int bit = 31; bit >= 0; --bit) { const unsigned cand = T | (1u << bit); int c = 0;
#pragma unroll
                            for (int k = 0; k < 8; ++k) c += (key[k] >= cand) ? 1 : 0;
                            c += __builtin_amdgcn_update_dpp(0, c, 0xB1, 0xf, 0xf, false);
                            c += __builtin_amdgcn_update_dpp(0, c, 0x4E, 0xf, 0xf, false);
                            c += __builtin_amdgcn_update_dpp(0, c, 0x141, 0xf, 0xf, false);
                            if (c >= 16) T = cand; }
                        unsigned byte = 0u;
#pragma unroll
                        for (int k = 0; k < 8; ++k) byte |= (key[k] != 0u && key[k] >= T) ? (1u << k) : 0u;
                        ((LAS unsigned char*)SELM)[q * 8 + seg] = (unsigned char)byte;
                    }
                    __syncthreads();
#pragma unroll
                    for (int i = 0; i < 16; ++i) { STASH[i * 64] = oacc[0][i]; STASH[(16 + i) * 64] = oacc[1][i]; }
                    { float own[8], oth[8]; const float* cs = ROPE64 + row * 16; u32x4 w = __builtin_bit_cast(u32x4, qf[0]); unpack8(w, own);
#pragma unroll
                      for (int jj = 0; jj < 8; ++jj) oth[jj] = __shfl_xor(own[jj], 32);
#pragma unroll
                      for (int jj = 0; jj < 8; ++jj) own[jj] = h ? own[jj] * cs[jj] + oth[jj] * cs[8 + jj] : own[jj] * cs[jj] - oth[jj] * cs[8 + jj];
                      qf[0] = __builtin_bit_cast(bf16x8, pack8f(own)); }
                    {
                        const unsigned long long mymask = SELM[ql]; const unsigned long long un0 = SELM[lane];
                        unsigned ul = (unsigned)un0, uh = (unsigned)(un0 >> 32);
#pragma unroll
                        for (int o = 1; o < 64; o <<= 1) { ul |= __shfl_xor(ul, o); uh |= __shfl_xor(uh, o); }
                        const unsigned ulo = (unsigned)__builtin_amdgcn_readfirstlane((int)ul), uhi = (unsigned)__builtin_amdgcn_readfirstlane((int)uh);
                        const unsigned long long U = ((unsigned long long)uhi << 32) | ulo;
                        if (wave == 0 && ((U >> lane) & 1ull)) TL[__builtin_amdgcn_mbcnt_hi(uhi, __builtin_amdgcn_mbcnt_lo(ulo, 0u))] = lane;
                        f32x16 oo[2]; float ll = 0.f;
#pragma unroll
                        for (int i = 0; i < 16; ++i) { oo[0][i] = 0.f; oo[1][i] = 0.f; }
                        const bf16_t* kbase = RAW + (size_t)b * SEQ * C_WP + 1536 + g * 64;
                        __syncthreads();
{ auto go_ = [&](auto hs_) { constexpr bool HS = decltype(hs_)::value;
                        att::kv_pipeline_dma2<0>(lds, __builtin_popcountll(U), wave, lane, qf,
                            [&](int tt, const bf16_t*& kb, size_t& kp, const bf16_t*& vb, size_t& vp) { const int sblk = __builtin_amdgcn_readfirstlane(TL[tt]); kb = kbase + (size_t)(64 * sblk) * C_WP; kp = C_WP; vb = kb + 256; vp = C_WP; },
                            [&](int tt, f32x16 (&p)[2], const LAS unsigned char* buf, const LAS unsigned char* nbuf, f32x16 (&pn)[2], int) { const int sblk = __builtin_amdgcn_readfirstlane(TL[tt]);
                                const bool sel = (mymask >> sblk) & 1ull; const int lim = t - 64 * sblk - 4 * h;
                                if (sblk == qt) att::fused_e<1, HS, LP_NSA>(oo, ll, p, buf, lane, sel, shiftS, [&](int koff) { return koff <= lim; }, 0u, 0u, qf, nbuf, pn);
                                else att::fused_e<0, HS, LP_NSA>(oo, ll, p, buf, lane, sel, shiftS, [](int) { return true; }, 0u, 0u, qf, nbuf, pn); },
                            att::NoXtra());
 }; if (shiftS == 0.f) go_(std::false_type{}); else go_(std::true_type{}); }
                        const float lt = ll + __shfl_xor(ll, 32); const float f = lt > 0.f ? GT[row * 48 + hd * 3 + 1] / lt : 0.f;
#pragma unroll
                        for (int i = 0; i < 16; ++i) { STASH[i * 64] += oo[0][i] * f; STASH[(16 + i) * 64] += oo[1][i] * f; }
                    }
                    {
                        const int tw0 = qt >= 8 ? qt - 8 : 0, ntw = qt - tw0 + 1;
                        f32x16 oo[2]; float ll = 0.f;
#pragma unroll
                        for (int i = 0; i < 16; ++i) { oo[0][i] = 0.f; oo[1][i] = 0.f; }
                        const bf16_t* kbase = RAW + (size_t)b * SEQ * C_WP + 2048 + g * 64;
{ auto go_ = [&](auto hs_) { constexpr bool HS = decltype(hs_)::value;
                        att::kv_pipeline_dma2<0>(lds, ntw, wave, lane, qf,
                            [&](int tt, const bf16_t*& kb, size_t& kp, const bf16_t*& vb, size_t& vp) { kb = kbase + (size_t)(64 * (tw0 + tt)) * C_WP; kp = C_WP; vb = kb + 256; vp = C_WP; },
                            [&](int tt, f32x16 (&p)[2], const LAS unsigned char* buf, const LAS unsigned char* nbuf, f32x16 (&pn)[2], int) { const int tw = tw0 + tt; const int d0 = t - 64 * tw - 4 * h;
                                if (tw == qt || (qt >= 8 && tw == qt - 8)) att::fused_e<1, HS, LP_NSA>(oo, ll, p, buf, lane, true, shiftW, [&](int koff) { const int dist = d0 - koff; return dist >= 0 && dist < 512; }, 0u, 0u, qf, nbuf, pn);
                                else att::fused_e<0, HS, LP_NSA>(oo, ll, p, buf, lane, true, shiftW, [](int) { return true; }, 0u, 0u, qf, nbuf, pn); },
                            att::NoXtra());
 }; if (shiftW == 0.f) go_(std::false_type{}); else go_(std::true_type{}); }
                        const float lt = ll + __shfl_xor(ll, 32); const float f = lt > 0.f ? GT[row * 48 + hd * 3 + 2] / lt : 0.f;
#pragma unroll
                        for (int i = 0; i < 16; ++i) { oo[0][i] = STASH[i * 64] + oo[0][i] * f; oo[1][i] = STASH[(16 + i) * 64] + oo[1][i] * f; }
#if defined(PROBE_NSA)
                        if (rep_ == 0)
#endif
                        att::store_o_t<64>(oo, 1.0f, OATT + ((size_t)b * SEQ + qt * 64 + qs * 32) * 1024 + hd * 64, 1024, lds + wave * 4608, lane);
                    }
                    __syncthreads();
                }
            }
            SEAM(pb + 3);
        }
        if (RUN(pb + 4)) for (int rep_ = 0; rep_ < REPS(pb + 4); ++rep_) {
            int lane = (int)__builtin_amdgcn_mbcnt_hi(~0u, __builtin_amdgcn_mbcnt_lo(~0u, 0u)); asm volatile("" : "+v"(lane)); const int tid = wave * 64 + lane;
            if (L == 0) {
                pg8::Gemm g{OATT, W_ABO, MTOK, DM, DM}; pg8::StaticOrder S; S.init(MTOK, DM, G, bid);
                pg8::EpiResid<false> E{out, XB, RSQ};
                pg8::gemm_phase<pg8::EpiResid<false>, pg8::StaticOrder, true, true>(lds, g, S, E, wave);
            }
            if (L == 1) {
                pg8::Gemm g{OATT, W_CO, MTOK, DM, DM}; pg8::StaticOrder S; S.init(MTOK, DM, G, bid);
                pg8::EpiResid<false> E{out, XB, RSQ};
                pg8::gemm_phase<pg8::EpiResid<false>, pg8::StaticOrder, true, true>(lds, g, S, E, wave);
            }
            SEAM(pb + 4);
        }
        if (RUN(pb + 5)) for (int rep_ = 0; rep_ < REPS(pb + 5); ++rep_) {
            int lane = (int)__builtin_amdgcn_mbcnt_hi(~0u, __builtin_amdgcn_mbcnt_lo(~0u, 0u)); asm volatile("" : "+v"(lane)); const int tid = wave * 64 + lane;
            pg8::Gemm g{XB, W_MQ + (size_t)L * 512 * DM, MTOK, 512, DM}; pg8::StaticOrder S; S.init(MTOK, 512, G, bid);
            pg8::EpiPlain E{MQB, 512};
            pg8::gemm_phase<pg8::EpiPlain, pg8::StaticOrder, true, true>(lds, g, S, E, wave);
            SEAM(pb + 5);
        }
        if (RUN(pb + 6)) for (int rep_ = 0; rep_ < REPS(pb + 6); ++rep_) {
            int lane = (int)__builtin_amdgcn_mbcnt_hi(~0u, __builtin_amdgcn_mbcnt_lo(~0u, 0u)); asm volatile("" : "+v"(lane)); const int tid = wave * 64 + lane;
            const float shiftM = [&] { float gq = 0.f, gk = 0.f; for (int i = 0; i < 128; ++i) { gq = fmaxf(gq, fabsf(mem_q_norm[L * 128 + i])); gk = fmaxf(gk, fabsf(mem_k_norm[L * 128 + i])); }
                                       const float B = 11.3137085f * LOG2E * gq * gk * 1.02f; return B > 60.f ? B - 60.f : 0.f; }();
            const int upb = (512 % G == 0) ? 512 / G : 0; int cur_pair = -1;
            for (int k = 0; ; ++k) {
                const int u = upb ? bid * upb + k : bid + k * G; if ((upb && k >= upb) || u >= BATCH * 4 * 16) break;
                const int b = u >> 6, hh = (u >> 4) & 3, qb = u & 15;
                const int r = lane & 31, h = lane >> 5;
                const int row = b * SEQ + qb * 256 + wave * 32 + r;
                if ((u >> 4) != cur_pair) { cur_pair = u >> 4;
                    __syncthreads();
                    const bf16_t* kbase = KVRAW + (size_t)(b * NMEM) * 2048 + L * 1024 + hh * 128;
#pragma unroll
                    for (int i = 0; i < 8; ++i) { const int idx = tid + 512 * i, rw = idx >> 4, c = idx & 15;
                        *(LAS u32x4*)(lds + rw * 272 + c * 16) = *(const u32x4*)(kbase + (size_t)rw * 2048 + c * 8);
                        *(LAS u32x4*)(lds + 69632 + rw * 320 + c * 16) = *(const u32x4*)(kbase + (size_t)rw * 2048 + 512 + c * 8); }
                    __syncthreads(); }
                const float rs = row_rstd(RSQ, row);
                bf16x8 qf[8]; float ssq = 0.f;
                const bf16_t* qrow = MQB + (size_t)row * 512 + hh * 128 + 8 * h;
#pragma unroll
                for (int s2 = 0; s2 < 8; ++s2) { qf[s2] = *(const bf16x8*)(qrow + 16 * s2);
#pragma unroll
                    for (int j = 0; j < 8; ++j) { const float f = bf2f((unsigned short)qf[s2][j]) * rs; ssq += f * f; } }
                ssq += __shfl_xor(ssq, 32);
                const float qs = rs * __builtin_amdgcn_rsqf(ssq * (1.0f / 128.0f) + RMS_EPS) * (0.08838834764831845f * LOG2E);
#pragma unroll
                for (int s2 = 0; s2 < 8; ++s2) { const float* gn = mem_q_norm + L * 128 + 16 * s2 + 8 * h; const f32x4 ga = *(const f32x4*)gn, gb = *(const f32x4*)(gn + 4); u32x4 w;
#pragma unroll
                    for (int j = 0; j < 4; ++j) { const float g0_ = j < 2 ? ga[2 * j] : gb[2 * j - 4], g1_ = j < 2 ? ga[2 * j + 1] : gb[2 * j - 3];
                        w[j] = pk2(bf2f((unsigned short)qf[s2][2 * j]) * qs * g0_, bf2f((unsigned short)qf[s2][2 * j + 1]) * qs * g1_); }
                    qf[s2] = __builtin_bit_cast(bf16x8, w); }
                f32x16 oo[4]; float ll = 0.f;
#pragma unroll
                for (int d = 0; d < 4; ++d)
#pragma unroll
                    for (int i = 0; i < 16; ++i) oo[d][i] = 0.f;
#pragma unroll 1
                for (int tt = 0; tt < 4; ++tt) {
                    f32x16 p[2]; att::tile_scores<128>(p, qf, lds + tt * 64 * 272, lane);
                    float ls = 0.f;
#pragma unroll
                    for (int kt = 0; kt < 2; ++kt)
#pragma unroll
                        for (int i = 0; i < 16; ++i) { const float e = __builtin_amdgcn_exp2f(p[kt][i] - shiftM); p[kt][i] = e; ls += e; }
                    ll += ls;
                    att::tile_pv<128>(oo, p, lds + 69632 + tt * 64 * 320 - att::Geo<128>::KB, lane); }
                const float lt = ll + __shfl_xor(ll, 32);
                att::store_o<128>(oo, 1.0f / lt, OMEM + (size_t)row * 512 + hh * 128, lane);
            }
            SEAM(pb + 6);
        }
        if (RUN(pb + 7)) for (int rep_ = 0; rep_ < REPS(pb + 7); ++rep_) {
            int lane = (int)__builtin_amdgcn_mbcnt_hi(~0u, __builtin_amdgcn_mbcnt_lo(~0u, 0u)); asm volatile("" : "+v"(lane)); const int tid = wave * 64 + lane;
            pg8::Gemm g{OMEM, W_MO + (size_t)L * DM * 512, MTOK, DM, 512}; pg8::StaticOrder S; S.init(MTOK, DM, G, bid);
            pg8::EpiResid<false> E{out, XB, RSQ};
            pg8::gemm_phase<pg8::EpiResid<false>, pg8::StaticOrder, true, true>(lds, g, S, E, wave);
            SEAM(pb + 7);
        }
        if (RUN(pb + 8)) for (int rep_ = 0; rep_ < REPS(pb + 8); ++rep_) {
            int lane = (int)__builtin_amdgcn_mbcnt_hi(~0u, __builtin_amdgcn_mbcnt_lo(~0u, 0u)); asm volatile("" : "+v"(lane)); const int tid = wave * 64 + lane;
            pg8::Gemm g{XB, W_FI + (size_t)L * 5632 * DM, MTOK, 5632, DM}; pg8::StaticOrder S; S.init(MTOK, 5632, G, bid);
            pg8::EpiSwiGLU E{RSQ, HID};
            pg8::gemm_phase<pg8::EpiSwiGLU, pg8::StaticOrder, true, true>(lds, g, S, E, wave);
#ifdef PROBE_DUP_FFN
            if (L == 0) { __syncthreads(); pg8::gemm_phase<pg8::EpiSwiGLU, pg8::StaticOrder, true, true>(lds, g, S, E, wave); }
#endif
            SEAM(pb + 8);
        }
        if (RUN(pb + 9)) for (int rep_ = 0; rep_ < REPS(pb + 9); ++rep_) {
            int lane = (int)__builtin_amdgcn_mbcnt_hi(~0u, __builtin_amdgcn_mbcnt_lo(~0u, 0u)); asm volatile("" : "+v"(lane)); const int tid = wave * 64 + lane;
            pg8::Gemm g{HID, W_FO + (size_t)L * DM * DFF, MTOK, DM, DFF}; pg8::StaticOrder S; S.init(MTOK, DM, G, bid);
            if (L == 0) { pg8::EpiResid<false> E{out, XB, RSQ}; pg8::gemm_phase<pg8::EpiResid<false>, pg8::StaticOrder, true, true>(lds, g, S, E, wave); }
            else { pg8::EpiResid<true> E{out, XB, RSQ}; pg8::gemm_phase<pg8::EpiResid<true>, pg8::StaticOrder, true, true>(lds, g, S, E, wave); }
            SEAM(pb + 9);
        }
}

__global__ void __launch_bounds__(NWAVES * 64, 2) fwd_kernel(Args args) {
    extern __shared__ __attribute__((aligned(16))) unsigned char lds_raw[];
    LAS unsigned char* lds = (LAS unsigned char*)(unsigned)__builtin_amdgcn_readfirstlane((int)(unsigned)(size_t)(LAS unsigned char*)lds_raw);
    volatile LAS unsigned* MISC = (volatile LAS unsigned*)(lds + LDS_MISC);
    const int tid = threadIdx.x, lane = tid & 63, wave = __builtin_amdgcn_readfirstlane(tid >> 6);
    const int G = gridDim.x, bid = blockIdx.x;
    unsigned* ctl = (unsigned*)(args.ws + WS_CTL);
    for (int u = tid; u < (LDS_BYTES - LDS_MISC) / 4; u += NWAVES * 64) ((LAS unsigned*)(lds + LDS_MISC))[u] = 0u;
    __syncthreads();
    XcdBarrier bar = xcd_barrier_post(ctl + CW_BAR + args.li * XCD_BAR_WORDS, MISC + 8);
    const int lo = args.ph_lo, hi = args.ph_hi;

    if (RUN(0)) for (int rep_ = 0; rep_ < REPS(0); ++rep_) {
        LAS float* scr = (LAS float*)(lds + wave * 16384);
        const int gw = bid * NWAVES + wave, NGW = G * NWAVES;
        constexpr int I_AB = 16 * (AB_WP / 32), I_C = 16 * (C_WP / 32), I_O = 16 * 32, I_MQ = 16 * 16, I_KV = 16 * 32, I_MO = 8 * 32, I_FI = 16 * (5632 / 32), I_FO = (DFF / 64) * 32;
        constexpr int NITEMS = I_AB + I_C + 2 * I_O + 2 * I_MQ + 2 * I_KV + 2 * I_MO + 2 * I_FI + 2 * I_FO;
        for (int it = gw; it < NITEMS; it += NGW) {
            int r = it;
            if (r < I_AB) { const int nbn = AB_WP / 32; transpose_item(ab_w_in, DM, AB_W, W_AB, norm_mix, scr, r / nbn, r % nbn, lane, CMapProj0{}); continue; } r -= I_AB;
            if (r < I_C) { const int nbn = C_WP / 32; transpose_item(nsa_w_in, DM, C_W, W_C, norm_mix + DM, scr, r / nbn, r % nbn, lane, CMapProj1{}); continue; } r -= I_C;
            if (r < I_O) { transpose_item(ab_w_out, DM, DM, W_ABO, nullptr, scr, r / 32, r % 32, lane, CMapId{DM}); continue; } r -= I_O;
            if (r < I_O) { transpose_item(nsa_w_out, DM, DM, W_CO, nullptr, scr, r / 32, r % 32, lane, CMapId{DM}); continue; } r -= I_O;
            if (r < 2 * I_MQ) { const int L = r / I_MQ; r %= I_MQ; transpose_item(mem_w_q + (size_t)L * DM * 512, DM, 512, W_MQ + (size_t)L * 512 * DM, norm_mem + L * DM, scr, r / 16, r % 16, lane, CMapId{512}); continue; } r -= 2 * I_MQ;
            if (r < 2 * I_KV) { const int L = r / I_KV; r %= I_KV; transpose_item(mem_w_kv + (size_t)L * DM * 1024, DM, 1024, W_KV + (size_t)L * 1024 * DM, norm_mem_src + L * DM, scr, r / 32, r % 32, lane, CMapId{1024}); continue; } r -= 2 * I_KV;
            if (r < 2 * I_MO) { const int L = r / I_MO; r %= I_MO; transpose_item(mem_w_o + (size_t)L * 512 * DM, 512, DM, W_MO + (size_t)L * DM * 512, nullptr, scr, r / 32, r % 32, lane, CMapId{DM}); continue; } r -= 2 * I_MO;
            if (r < 2 * I_FI) { const int L = r / I_FI; r %= I_FI; const int nbn = 5632 / 32; transpose_item(ffn_w_in + (size_t)L * DM * 5632, DM, 5632, W_FI + (size_t)L * 5632 * DM, norm_ffn + L * DM, scr, r / nbn, r % nbn, lane, CMapFfn{}); continue; } r -= 2 * I_FI;
            { const int L = r / I_FO; r %= I_FO; transpose_item(ffn_w_out + (size_t)L * DFF * DM, DFF, DM, W_FO + (size_t)L * DM * DFF, nullptr, scr, r / 32, r % 32, lane, CMapId{DM}); }
        }
        for (int m = gw; m < MTOK; m += 4 * NGW) {
            int mr[4]; f32x4 v[4][4]; float sq[4];
#pragma unroll
            for (int q = 0; q < 4; ++q) { mr[q] = m + q * NGW < MTOK ? m + q * NGW : m; const f32x4* xr = (const f32x4*)(x_in + (size_t)mr[q] * DM) + lane;
#pragma unroll
                for (int j = 0; j < 4; ++j) v[q][j] = xr[64 * j]; }
#pragma unroll
            for (int q = 0; q < 4; ++q) { float a = 0.f;
#pragma unroll
                for (int j = 0; j < 4; ++j) a += (v[q][j][0] * v[q][j][0] + v[q][j][1] * v[q][j][1]) + (v[q][j][2] * v[q][j][2] + v[q][j][3] * v[q][j][3]);
                sq[q] = a; }
#pragma unroll
            for (int o = 1; o < 64; o <<= 1) {
#pragma unroll
                for (int q = 0; q < 4; ++q) sq[q] += __shfl_xor(sq[q], o); }
#pragma unroll
            for (int q = 0; q < 4; ++q) { u32x2* xbr = (u32x2*)(XB + (size_t)mr[q] * DM) + lane;
#pragma unroll
                for (int j = 0; j < 4; ++j) { u32x2 w; w.x = pk2(v[q][j][0], v[q][j][1]); w.y = pk2(v[q][j][2], v[q][j][3]); xbr[64 * j] = w; }
                if (lane < 16) RSQ[(size_t)mr[q] * 16 + lane] = (lane == 0) ? sq[q] : 0.f; }
        }
        for (int i = bid * 512 + tid; i < MTOK * 12; i += G * 512) {
            const int m = i / 12, k = i % 12;
            const float f64t[8] = {1.0f, 0.19392274474868576f, 0.03760603093086393f, 0.007292664737217109f, 0.001414213562373095f, 0.0002742481756762073f, 5.318295896944988e-05f, 1.031338537721246e-05f};
            float fr;
            if (k < 8) fr = f64t[k]; else { const int q = k - 8; fr = (q == 0) ? 1.0f : (q == 1) ? 0.03760603093086393f : (q == 2) ? 0.001414213562373095f : 5.318295896944988e-05f; }
            const float ang = (float)positions[m] * fr;
            const double rev = (double)ang * 0.15915494309189535; const float frac = (float)(rev - __builtin_rint(rev));
            const float c = __builtin_amdgcn_cosf(frac), sn = __builtin_amdgcn_sinf(frac);
            if (k < 8) { ROPE64[(size_t)m * 16 + k] = c; ROPE64[(size_t)m * 16 + 8 + k] = sn; } else { ROPE32[(size_t)m * 8 + (k - 8)] = c; ROPE32[(size_t)m * 8 + 4 + (k - 8)] = sn; }
        }
        for (int it = gw; it < 128; it += NGW) { const int kv = it >> 6, r = it & 63;
            transpose_item(kv ? nsa_cmp_w1_v : nsa_cmp_w1_k, 2048, 64, W1T + (size_t)kv * 64 * 2048, nullptr, scr, r >> 1, r & 1, lane, CMapId{64}); }
        for (int it = (NGW - 1 - gw); it < 128; it += NGW) { const int kv = it >> 6, c = it & 63; const float* pe = kv ? nsa_cmp_pos_v : nsa_cmp_pos_k; const float* w1 = kv ? nsa_cmp_w1_v : nsa_cmp_w1_k;
            float a = 0.f;
            for (int k0 = 0; k0 < 2048; k0 += 512) { float pv[8], wv[8];
#pragma unroll
                for (int j = 0; j < 8; ++j) { const int k = k0 + 64 * j + lane; pv[j] = pe[k]; wv[j] = w1[(size_t)k * 64 + c]; }
#pragma unroll
                for (int j = 0; j < 8; ++j) a += pv[j] * wv[j]; }
            a = wave_sum(a); if (lane == 0) POSW1[kv * 64 + c] = a; }
        for (int m = gw; m < MMEM; m += NGW) {
            const f32x4* xr = (const f32x4*)(mem_in + (size_t)m * DM) + lane; f32x4 v[4]; float s = 0.f;
#pragma unroll
            for (int j = 0; j < 4; ++j) { v[j] = xr[64 * j]; s += (v[j][0] * v[j][0] + v[j][1] * v[j][1]) + (v[j][2] * v[j][2] + v[j][3] * v[j][3]); }
            s = wave_sum(s);
            u32x2* xbr = (u32x2*)(MEMB + (size_t)m * DM) + lane;
#pragma unroll
            for (int j = 0; j < 4; ++j) { u32x2 w; w.x = pk2(v[j][0], v[j][1]); w.y = pk2(v[j][2], v[j][3]); xbr[64 * j] = w; }
            if (lane == 0) MRS[m] = __builtin_amdgcn_rsqf(s * (1.0f / 1024.0f) + RMS_EPS);
        }
        SEAM(0);
    }

    layer_phases<0>(args, lds, bar, lo, hi, wave);
    layer_phases<1>(args, lds, bar, lo, hi, wave);
#undef RUN
#undef SEAM
}
#undef INF_
#undef x_in
#undef mem_in
#undef positions
#undef norm_mix
#undef norm_mem
#undef norm_mem_src
#undef norm_ffn
#undef ab_w_in
#undef ab_w_out
#undef nsa_w_in
#undef nsa_w_out
#undef mem_w_q
#undef mem_w_kv
#undef mem_w_o
#undef ffn_w_in
#undef ffn_w_out
#undef out
#undef WSB
#undef W_AB
#undef W_C
#undef W_ABO
#undef W_CO
#undef W_MQ
#undef W_KV
#undef W_MO
#undef W_FI
#undef W_FO
#undef XB
#undef RSQ
#undef HID
#undef MEMB
#undef KVRAW
#undef MRS
#undef MQB
#undef OMEM
#undef mem_q_norm
#undef RAW
#undef OATT
#undef ROPE64
#undef ROPE32
#undef W1T
#undef POSW1
#undef KCMP
#undef VCMP
#undef GT
#undef nsa_q_norm
#undef SCR
#undef BMK
#undef KMEAN
#undef IWB
#undef dsa_q_norm
#undef dsa_k_norm
#undef moba_q_norm
#undef moba_k_norm
#undef nsa_kcmp_norm
#undef nsa_ksel_norm
#undef nsa_kwin_norm
#undef nsa_cmp_pos_k
#undef nsa_cmp_pos_v
#undef nsa_cmp_w1_k
#undef nsa_cmp_w2_k
#undef nsa_cmp_w1_v
#undef nsa_cmp_w2_v
#undef mem_k_norm

extern "C" void kernel_launch(void* const* d_in, const int* in_sizes, int n_in, void* d_out, int out_size, void* d_ws, size_t ws_size, hipStream_t stream) {
    static int grid = 0;
    if (grid == 0) {
        if (n_in != 32 || out_size != MTOK * DM || ws_size < WS_END) { fprintf(stderr, "kernel_launch: unexpected shapes (n_in %d out %d ws %zu)\n", n_in, out_size, ws_size); grid = -1; return; }
        int dev = 0, cus = 0, per_cu = 0;
        if (hipGetDevice(&dev) != hipSuccess || hipDeviceGetAttribute(&cus, hipDeviceAttributeMultiprocessorCount, dev) != hipSuccess) { grid = -1; return; }
        if (hipFuncSetAttribute((const void*)fwd_kernel, hipFuncAttributeMaxDynamicSharedMemorySize, LDS_BYTES) != hipSuccess) { fprintf(stderr, "kernel_launch: hipFuncSetAttribute failed\n"); grid = -1; return; }
        if (hipOccupancyMaxActiveBlocksPerMultiprocessor(&per_cu, (const void*)fwd_kernel, NWAVES * 64, LDS_BYTES) != hipSuccess || per_cu < 1) fprintf(stderr, "kernel_launch: occupancy query says %d\n", per_cu);
        (void)hipGetLastError();
        grid = cus;
    }
    if (grid < 0) return;
    if (hipMemsetAsync((char*)d_ws + WS_CTL, 0, CTL_ZERO_BYTES, stream) != hipSuccess) return;
    Args a{};
    for (int i = 0; i < 32; ++i) a.in[i] = d_in[i];
    a.out = (float*)d_out; a.ws = (unsigned char*)d_ws; a.pad = 0;
    const int NPH = 21;
#if 0
    for (int p = 0; p < NPH; ++p) { a.ph_lo = p; a.ph_hi = p + 1; a.li = 0; hipLaunchKernelGGL(fwd_kernel, dim3(grid), dim3(NWAVES * 64), LDS_BYTES, stream, a); }
#else
    a.ph_lo = 0; a.ph_hi = NPH; a.li = 0; hipLaunchKernelGGL(fwd_kernel, dim3(grid), dim3(NWAVES * 64), LDS_BYTES, stream, a);
#endif
}
```

```cpp
#include <hip/hip_runtime.h>
#include <cstdio>
#include <cstdint>
#include <type_traits>

#define LAS __attribute__((address_space(3)))
#define GAS __attribute__((address_space(1)))
typedef unsigned short bf16_t;
typedef short bf16x8 __attribute__((ext_vector_type(8)));
typedef short s16x4 __attribute__((ext_vector_type(4)));
typedef float f32x4 __attribute__((ext_vector_type(4)));
typedef float f32x2 __attribute__((ext_vector_type(2)));
typedef float f32x16 __attribute__((ext_vector_type(16)));
typedef unsigned u32x4 __attribute__((ext_vector_type(4)));
typedef unsigned u32x2 __attribute__((ext_vector_type(2)));
typedef __bf16 bf16x2_t __attribute__((ext_vector_type(2)));

constexpr int BATCH = 8, SEQ = 4096, DM = 1024, MTOK = BATCH * SEQ;
constexpr int NMEM = 256, MMEM = BATCH * NMEM;
constexpr int DFF = 2816;
constexpr int AB_W = 2472, AB_WP = 2560;
constexpr int C_W = 2608, C_WP = 2816;
constexpr float RMS_EPS = 1e-6f;
constexpr float LOG2E = 1.4426950408889634f;

namespace pg8 {
constexpr int BM = 256, BK = 64, HALF = 128, HTB = HALF * BK * 2, STAGE_BYTES = 8 * HTB, NXCD = 8, WGM = 4;
__host__ __device__ __forceinline__ int lds_byte(int r, int c) { const int st = (r >> 4) * 2 + (c >> 5), rr = r & 15, cc = c & 31, ob = rr * 64 + cc * 2; return st * 1024 + (ob ^ (((ob >> 9) & 1) << 5)); }
__host__ __device__ __forceinline__ void stage_rc(int b, int& R, int& C) { const int st = b / 1024, sb = b % 1024, swz = sb ^ (((sb >> 9) & 1) << 5); R = (st >> 1) * 16 + swz / 64; C = (st & 1) * 32 + (swz % 64) / 2; }
__host__ __device__ __forceinline__ int perm32(int rho) { const int n = rho >> 4, i = rho & 15; return 8 * (i >> 2) + 4 * n + (i & 3); }
struct Unit { int pm, pn; };
struct Gemm { const bf16_t* A; const bf16_t* Bt; int M, N, K; };
struct StaticOrder {
    int nM, nN, nwg, G, c;
    __host__ __device__ void init(int M, int N, int G_, int c_) { nM = M / BM; nN = N / BM; nwg = nM * nN; G = G_; c = c_; }
    __host__ __device__ bool next(int i, Unit& u) const {
        const long L = (long)i * G + c; if (L >= nwg) return false;
        int wgid = (int)L; { const int q = nwg / NXCD, r = nwg % NXCD, xcd = wgid % NXCD, off = wgid / NXCD; wgid = (xcd < r ? xcd * (q + 1) : r * (q + 1) + (xcd - r) * q) + off; }
        const int nig = WGM * nN, gid = wgid / nig, fm = gid * WGM, gsz = (nM - fm) < WGM ? (nM - fm) : WGM;
        u.pm = fm + ((wgid % nig) % gsz); u.pn = (wgid % nig) / gsz; return true;
    }
    __device__ __forceinline__ void a_ready(const Unit&) const {}
    __device__ __forceinline__ void done(const Unit&) const {}
};
__device__ __forceinline__ unsigned cvt_pk_bf16(float lo, float hi) { unsigned r; asm volatile("v_cvt_pk_bf16_f32 %0, %1, %2" : "=v"(r) : "v"(lo), "v"(hi)); return r; }

struct EpiPlain {
    static constexpr bool PERM = true, AFTER_DRAIN = false;
    bf16_t* O; int ldc;
    __device__ __forceinline__ void operator()(const f32x4 (&acc)[2][2][4][2], const Unit& u, int wr, int wc, int fr, int fq) const {
        const int row0 = u.pm * BM + wr * 64 + fr, col0 = u.pn * BM + wc * 32 + 8 * fq;
#pragma unroll
        for (int ai = 0; ai < 2; ++ai)
#pragma unroll
            for (int m = 0; m < 4; ++m) { bf16_t* rowp = O + (size_t)(row0 + ai * HALF + m * 16) * ldc + col0;
#pragma unroll
                for (int bj = 0; bj < 2; ++bj) { const f32x4 v0 = acc[ai][bj][m][0], v1 = acc[ai][bj][m][1];
                    u32x4 w; w.x = cvt_pk_bf16(v0[0], v0[1]); w.y = cvt_pk_bf16(v0[2], v0[3]); w.z = cvt_pk_bf16(v1[0], v1[1]); w.w = cvt_pk_bf16(v1[2], v1[3]);
                    *(u32x4*)(rowp + bj * HALF) = w; } }
    }
};
template <bool FINAL> struct EpiResid {
    static constexpr bool PERM = true, AFTER_DRAIN = false;
    float* out; bf16_t* xb; float* rsq;
    __device__ __forceinline__ void operator()(const f32x4 (&acc)[2][2][4][2], const Unit& u, int wr, int wc, int fr, int fq) const {
        const int col0 = u.pn * BM + wc * 32 + 8 * fq;
#pragma unroll
        for (int ai = 0; ai < 2; ++ai) {
            u32x4 rb[4][2];
#pragma unroll
            for (int m = 0; m < 4; ++m)
#pragma unroll
                for (int bj = 0; bj < 2; ++bj) rb[m][bj] = *(const u32x4*)(xb + (size_t)(u.pm * BM + ai * HALF + wr * 64 + m * 16 + fr) * 1024 + col0 + bj * HALF);
#pragma unroll
            for (int m = 0; m < 4; ++m) { const int row = u.pm * BM + ai * HALF + wr * 64 + m * 16 + fr; const size_t off = (size_t)row * 1024 + col0; float ss = 0.f;
#pragma unroll
                for (int bj = 0; bj < 2; ++bj) { const size_t o = off + bj * HALF; const u32x4 r4 = rb[m][bj]; float v[8];
#pragma unroll
                    for (int k = 0; k < 4; ++k) { v[2 * k] = acc[ai][bj][m][k >> 1][(2 * k) & 3] + __builtin_bit_cast(float, r4[k] << 16); v[2 * k + 1] = acc[ai][bj][m][k >> 1][(2 * k + 1) & 3] + __builtin_bit_cast(float, r4[k] & 0xffff0000u); }
                    if (FINAL) { *(f32x4*)(out + o) = (f32x4){v[0], v[1], v[2], v[3]}; *(f32x4*)(out + o + 4) = (f32x4){v[4], v[5], v[6], v[7]}; }
                    else { u32x4 w; w.x = cvt_pk_bf16(v[0], v[1]); w.y = cvt_pk_bf16(v[2], v[3]); w.z = cvt_pk_bf16(v[4], v[5]); w.w = cvt_pk_bf16(v[6], v[7]); *(u32x4*)(xb + o) = w;
#pragma unroll
                        for (int k = 0; k < 4; ++k) { const float r0 = __builtin_bit_cast(float, w[k] << 16), r1 = __builtin_bit_cast(float, w[k] & 0xffff0000u); ss += r0 * r0 + r1 * r1; } } }
                if (!FINAL) { ss += __shfl_xor(ss, 16); ss += __shfl_xor(ss, 32);
                    if (fq == 0) rsq[(size_t)row * 16 + u.pn * 4 + wc] = ss; } }
            asm volatile("" ::: "memory");
        }
    }
};
struct EpiSwiGLU {
    static constexpr bool PERM = true, AFTER_DRAIN = false;
    const float* rsq; bf16_t* hid;
    __device__ __forceinline__ void operator()(const f32x4 (&acc)[2][2][4][2], const Unit& u, int wr, int wc, int fr, int fq) const {
        const int col0 = u.pn * 128 + wc * 32 + 8 * fq;
        f32x4 pr[2][4];
#pragma unroll
        for (int ai = 0; ai < 2; ++ai)
#pragma unroll
            for (int m = 0; m < 4; ++m) pr[ai][m] = *(const f32x4*)(rsq + (size_t)(u.pm * BM + ai * HALF + wr * 64 + m * 16 + fr) * 16 + 4 * fq);
#pragma unroll
        for (int ai = 0; ai < 2; ++ai)
#pragma unroll
            for (int m = 0; m < 4; ++m) { const int row = u.pm * BM + ai * HALF + wr * 64 + m * 16 + fr;
                float ss = (pr[ai][m][0] + pr[ai][m][1]) + (pr[ai][m][2] + pr[ai][m][3]);
                ss += __shfl_xor(ss, 16); ss += __shfl_xor(ss, 32);
                const float c = __builtin_amdgcn_rsqf(ss * (1.0f / 1024.0f) + RMS_EPS);
                float h[8];
#pragma unroll
                for (int n = 0; n < 2; ++n)
#pragma unroll
                    for (int e = 0; e < 4; ++e) { const float g = acc[ai][0][m][n][e] * c, uu = acc[ai][1][m][n][e] * c;
                        const float sg = g * __builtin_amdgcn_rcpf(1.0f + __builtin_amdgcn_exp2f(-g * LOG2E)); h[n * 4 + e] = sg * uu; }
                u32x4 w; w.x = cvt_pk_bf16(h[0], h[1]); w.y = cvt_pk_bf16(h[2], h[3]); w.z = cvt_pk_bf16(h[4], h[5]); w.w = cvt_pk_bf16(h[6], h[7]);
                *(u32x4*)(hid + (size_t)row * DFF + col0) = w; }
    }
};

struct ProjUnit { int kind; const float* gain; float scale; bool rope; };
template <int L> struct EpiProj {
    static constexpr bool PERM = true, AFTER_DRAIN = false;
    bf16_t* O; int ldc; const float* rsq; const float* rope64; const float* rope32; const float* g0; const float* g1; const float* g2; const float* g3; float* aux;
    __device__ __forceinline__ ProjUnit classify(int unit) const {
        constexpr float C2 = 0.125f * LOG2E;
        if (L == 0) {
            if (unit < 8) return {1, g0, C2, true}; if (unit == 8) return {1, g1, 1.f, true}; if (unit == 9) return {2, nullptr, 1.f, false};
            if (unit < 14) return {4, nullptr, 1.f, false}; if (unit == 14) return {5, nullptr, 1.f, false};
            if (unit < 23) return {1, g2, C2, true}; if (unit < 31) return {1, g3, 1.f, true}; if (unit < 39) return {2, nullptr, 1.f, false}; return {0, nullptr, 1.f, false};
        } else {
            if (unit < 16) return {1, g0, C2, false}; if (unit < 24) return {3, nullptr, 1.f, false};
            if (unit < 28) return {1, g1, 1.f, true}; if (unit < 32) return {2, nullptr, 1.f, false}; if (unit < 36) return {1, g2, 1.f, true}; if (unit < 40) return {2, nullptr, 1.f, false};
            if (unit == 40) return {6, nullptr, 1.f, false}; return {0, nullptr, 1.f, false};
        }
    }
    __device__ __forceinline__ void operator()(const f32x4 (&acc)[2][2][4][2], const Unit& u, int wr, int wc, int fr, int fq) const {
        const int unit = 4 * u.pn + wc; const ProjUnit pu = classify(unit);
        if (pu.kind == 0) return;
        float gl[2][8];
        if (pu.kind == 1) {
#pragma unroll
            for (int bj = 0; bj < 2; ++bj) { const f32x4 a = *(const f32x4*)(pu.gain + 8 * (2 * fq + bj)), b = *(const f32x4*)(pu.gain + 8 * (2 * fq + bj) + 4);
#pragma unroll
                for (int x = 0; x < 4; ++x) { gl[bj][x] = a[x] * pu.scale; gl[bj][4 + x] = b[x] * pu.scale; } }
        }
        float rsv[2][4];
        if (pu.kind != 3) { f32x4 pr[2][4];
#pragma unroll
            for (int ai = 0; ai < 2; ++ai)
#pragma unroll
                for (int m = 0; m < 4; ++m) pr[ai][m] = *(const f32x4*)(rsq + (size_t)(u.pm * BM + ai * HALF + wr * 64 + m * 16 + fr) * 16 + 4 * fq);
#pragma unroll
            for (int ai = 0; ai < 2; ++ai)
#pragma unroll
                for (int m = 0; m < 4; ++m) { float ss = (pr[ai][m][0] + pr[ai][m][1]) + (pr[ai][m][2] + pr[ai][m][3]); ss += __shfl_xor(ss, 16); ss += __shfl_xor(ss, 32);
                    rsv[ai][m] = __builtin_amdgcn_rsqf(ss * (1.0f / 1024.0f) + RMS_EPS); } }
        else {
#pragma unroll
            for (int ai = 0; ai < 2; ++ai)
#pragma unroll
                for (int m = 0; m < 4; ++m) rsv[ai][m] = 1.f; }
#pragma unroll
        for (int ai = 0; ai < 2; ++ai)
#pragma unroll
            for (int m = 0; m < 4; ++m) { const int row = u.pm * BM + ai * HALF + wr * 64 + m * 16 + fr;
                const float rs = rsv[ai][m];
                float v[2][8];
#pragma unroll
                for (int bj = 0; bj < 2; ++bj)
#pragma unroll
                    for (int e = 0; e < 8; ++e) v[bj][e] = acc[ai][bj][m][e >> 2][e & 3] * rs;
                if (pu.kind == 1) {
                    float ss = 0.f;
#pragma unroll
                    for (int bj = 0; bj < 2; ++bj)
#pragma unroll
                        for (int e = 0; e < 8; ++e) ss += v[bj][e] * v[bj][e];
                    ss += __shfl_xor(ss, 16); ss += __shfl_xor(ss, 32);
                    const float rn = __builtin_amdgcn_rsqf(ss * (1.0f / 64.0f) + RMS_EPS);
#pragma unroll
                    for (int bj = 0; bj < 2; ++bj)
#pragma unroll
                        for (int e = 0; e < 8; ++e) v[bj][e] = v[bj][e] * rn * gl[bj][e];
                    if (pu.rope && fq == 0) {
                        const float* cs = rope64 + (size_t)row * 16; const f32x4 c0 = *(const f32x4*)cs, c1 = *(const f32x4*)(cs + 4), s0 = *(const f32x4*)(cs + 8), s1 = *(const f32x4*)(cs + 12);
#pragma unroll
                        for (int e = 0; e < 8; ++e) { const float c = e < 4 ? c0[e & 3] : c1[e & 3], sn = e < 4 ? s0[e & 3] : s1[e & 3]; const float x1 = v[0][e], x2 = v[1][e];
                            v[0][e] = x1 * c - x2 * sn; v[1][e] = x2 * c + x1 * sn; }
                    }
                }
                if (pu.kind == 4 || pu.kind == 5) {
                    if (fq == 0 || (fq == 2 && pu.kind == 4)) { const float* cs = rope32 + (size_t)row * 8; const f32x4 c = *(const f32x4*)cs, sn = *(const f32x4*)(cs + 4);
#pragma unroll
                        for (int x = 0; x < 4; ++x) { const float a = v[0][x], b = v[0][4 + x]; v[0][x] = a * c[x] - b * sn[x]; v[0][4 + x] = b * c[x] + a * sn[x]; } }
                    if (pu.kind == 5 && fq == 2) { *(f32x4*)(aux + (size_t)row * 8) = (f32x4){v[0][0], v[0][1], v[0][2], v[0][3]}; *(f32x4*)(aux + (size_t)row * 8 + 4) = (f32x4){v[0][4], v[0][5], v[0][6], v[0][7]}; }
                }
                if (pu.kind == 6) {
#pragma unroll
                    for (int bj = 0; bj < 2; ++bj) if (2 * fq + bj < 6) {
#pragma unroll
                        for (int e = 0; e < 8; ++e) v[bj][e] = __builtin_amdgcn_rcpf(1.0f + __builtin_amdgcn_exp2f(-v[bj][e] * LOG2E));
                        float* ap = aux + (size_t)row * 48 + 8 * (2 * fq + bj);
                        *(f32x4*)ap = (f32x4){v[bj][0], v[bj][1], v[bj][2], v[bj][3]}; *(f32x4*)(ap + 4) = (f32x4){v[bj][4], v[bj][5], v[bj][6], v[bj][7]}; }
                } else {
                    bf16_t* orow = O + (size_t)row * ldc + 64 * unit + 16 * fq;
                    u32x4 w0, w1;
                    w0.x = cvt_pk_bf16(v[0][0], v[0][1]); w0.y = cvt_pk_bf16(v[0][2], v[0][3]); w0.z = cvt_pk_bf16(v[0][4], v[0][5]); w0.w = cvt_pk_bf16(v[0][6], v[0][7]);
                    w1.x = cvt_pk_bf16(v[1][0], v[1][1]); w1.y = cvt_pk_bf16(v[1][2], v[1][3]); w1.z = cvt_pk_bf16(v[1][4], v[1][5]); w1.w = cvt_pk_bf16(v[1][6], v[1][7]);
                    *(u32x4*)orow = w0; *(u32x4*)(orow + 8) = w1;
                }
                if (m & 1) asm volatile("" ::: "memory"); }
    }
};

template <class Epi, class Sched, bool ALIGN_EPI = false, bool SP2 = false>
__device__ __forceinline__ void gemm_phase(LAS unsigned char* lds, const Gemm g, const Sched& S, const Epi& E, const int wave_id) {
    int tid = wave_id * 64 + (int)__builtin_amdgcn_mbcnt_hi(~0u, __builtin_amdgcn_mbcnt_lo(~0u, 0u)); asm volatile("" : "+v"(tid));
    const int wid = wave_id, lane = tid & 63, wr = wid >> 2, wc = wid & 3, fr = lane & 15, fq = lane >> 4;
    const int K = g.K, nt = K / BK;
    unsigned voffA[2], voffB[2];
#pragma unroll
    for (int i = 0; i < 2; ++i) { int R, C; stage_rc(tid * 16 + i * 8192, R, C); const int Rb = Epi::PERM ? ((R & ~31) + perm32(R & 31)) : R;
        voffA[i] = (unsigned)(R * K + C) * 2u; voffB[i] = (unsigned)(Rb * K + C) * 2u; }
    const size_t kstep = (size_t)(BK * 2);
    const size_t hstep = (size_t)HALF * K * 2;
    const size_t tstep = 2 * hstep;
    const unsigned ldsw = (unsigned)wid * 1024u;
    const int aoff = lds_byte(wr * 64 + fr, fq * 8), boff = lds_byte(wc * 32 + fr, fq * 8);
#define PG8_SA(b, h) (((b) * 2 + (h)) * HTB)
#define PG8_SB(b, h) ((4 + (b) * 2 + (h)) * HTB)
#define PG8_STAGE(bufoff, gbase, voff) do { _Pragma("unroll") for (int _i = 0; _i < 2; ++_i) \
        __builtin_amdgcn_global_load_lds((const unsigned*)((const char*)(gbase) + (voff)[_i]), (LAS unsigned*)(lds + (bufoff) + ldsw + _i * 8192), 16, 0, 0); } while (0)
#define PG8_LDA(dst, b, h) do { _Pragma("unroll") for (int m = 0; m < 4; ++m) _Pragma("unroll") for (int k = 0; k < 2; ++k) dst[m][k] = *(const LAS bf16x8*)(lds + PG8_SA(b, h) + aoff + m * 2048 + k * 1024); } while (0)
#define PG8_LDB(dst, b, h) do { _Pragma("unroll") for (int n = 0; n < 2; ++n) _Pragma("unroll") for (int k = 0; k < 2; ++k) dst[n][k] = *(const LAS bf16x8*)(lds + PG8_SB(b, h) + boff + n * 2048 + k * 1024); } while (0)
#define PG8_MMA(ai, bj, At, Bt) do { __builtin_amdgcn_s_setprio(1); _Pragma("unroll") for (int m = 0; m < 4; ++m) _Pragma("unroll") for (int n = 0; n < 2; ++n) _Pragma("unroll") for (int k = 0; k < 2; ++k) \
        acc[ai][bj][m][n] = __builtin_amdgcn_mfma_f32_16x16x32_bf16(Bt[n][k], At[m][k], acc[ai][bj][m][n], 0, 0, 0); __builtin_amdgcn_s_setprio(0); } while (0)
#define PG8_WAIT_V(n) asm volatile("s_waitcnt vmcnt(" #n ")" ::: "memory")
#define PG8_WAIT_L(n) asm volatile("s_waitcnt lgkmcnt(" #n ")" ::: "memory")
#define PG8_BAR __builtin_amdgcn_s_barrier()
#define PG8_SCHED __builtin_amdgcn_sched_barrier(0)
    Unit cur, nxt; int ui = 0;
    if (!S.next(0, cur)) return;
    f32x4 acc[2][2][4][2];
#pragma unroll
    for (int a = 0; a < 2; ++a)
#pragma unroll
        for (int b = 0; b < 2; ++b)
#pragma unroll
            for (int m = 0; m < 4; ++m)
#pragma unroll
                for (int n = 0; n < 2; ++n) acc[a][b][m][n] = (f32x4){0.f, 0.f, 0.f, 0.f};
    bf16x8 At[4][2], B0[2][2], B1[2][2];
    const char* cA = (const char*)g.A + (size_t)cur.pm * tstep; const char* cB = (const char*)g.Bt + (size_t)cur.pn * tstep;
    S.a_ready(cur);
    if constexpr (SP2) {
        PG8_STAGE(PG8_SB(0, 0), cB, voffB); PG8_STAGE(PG8_SB(0, 1), cB + hstep, voffB); PG8_STAGE(PG8_SA(0, 0), cA, voffA); PG8_STAGE(PG8_SA(0, 1), cA + hstep, voffA);
        if (wr == 1) PG8_BAR;
        PG8_WAIT_V(2); PG8_BAR;
        PG8_STAGE(PG8_SB(1, 0), cB + kstep, voffB); PG8_STAGE(PG8_SA(1, 0), cA + kstep, voffA); PG8_STAGE(PG8_SB(1, 1), cB + hstep + kstep, voffB);
        PG8_WAIT_V(6); PG8_BAR;
    } else {
        PG8_STAGE(PG8_SB(0, 0), cB, voffB); PG8_STAGE(PG8_SA(0, 0), cA, voffA); PG8_STAGE(PG8_SB(0, 1), cB + hstep, voffB); PG8_STAGE(PG8_SA(0, 1), cA + hstep, voffA);
        if (wr == 1) PG8_BAR;
        PG8_WAIT_V(4); PG8_BAR;
        PG8_STAGE(PG8_SB(1, 0), cB + kstep, voffB); PG8_STAGE(PG8_SA(1, 0), cA + kstep, voffA); PG8_STAGE(PG8_SB(1, 1), cB + hstep + kstep, voffB);
        PG8_WAIT_V(6); PG8_BAR;
    }
    for (;;) {
        const bool has_next = S.next(ui + 1, nxt);
        const char* nA = has_next ? (const char*)g.A + (size_t)nxt.pm * tstep : cA; const char* nB = has_next ? (const char*)g.Bt + (size_t)nxt.pn * tstep : cB;
        for (int t = 0; t < nt; t += 2) {
            const bool last = (t == nt - 2);
            const char* a1 = cA + (size_t)(t + 1) * kstep;
            const char* a2 = last ? nA : cA + (size_t)(t + 2) * kstep; const char* b2 = last ? nB : cB + (size_t)(t + 2) * kstep;
            const char* a3 = a2 + kstep; const char* b3 = b2 + kstep;
            if (last && has_next) S.a_ready(nxt);
            if constexpr (SP2) {
            PG8_LDB(B0, 0, 0); PG8_LDB(B1, 0, 1); PG8_SCHED; PG8_LDA(At, 0, 0); PG8_STAGE(PG8_SA(1, 1), a1 + hstep, voffA);
            PG8_WAIT_V(8); PG8_WAIT_L(0); PG8_BAR; PG8_MMA(0, 0, At, B0); PG8_MMA(0, 1, At, B1); PG8_BAR; PG8_SCHED;
            PG8_LDA(At, 0, 1); PG8_STAGE(PG8_SB(0, 0), b2, voffB); PG8_STAGE(PG8_SB(0, 1), b2 + hstep, voffB); PG8_STAGE(PG8_SA(0, 0), a2, voffA);
            PG8_WAIT_V(8); PG8_WAIT_L(0); PG8_BAR; PG8_MMA(1, 0, At, B0); PG8_MMA(1, 1, At, B1); PG8_BAR; PG8_SCHED;
            PG8_LDB(B0, 1, 0); PG8_LDB(B1, 1, 1); PG8_SCHED; PG8_LDA(At, 1, 0); PG8_STAGE(PG8_SA(0, 1), a2 + hstep, voffA);
            PG8_WAIT_V(8); PG8_WAIT_L(0); PG8_BAR; PG8_MMA(0, 0, At, B0); PG8_MMA(0, 1, At, B1); PG8_BAR; PG8_SCHED;
            PG8_LDA(At, 1, 1); PG8_STAGE(PG8_SB(1, 0), b3, voffB); PG8_STAGE(PG8_SB(1, 1), b3 + hstep, voffB); PG8_STAGE(PG8_SA(1, 0), a3, voffA);
            PG8_WAIT_V(8); PG8_WAIT_L(0); PG8_BAR; PG8_MMA(1, 0, At, B0); PG8_MMA(1, 1, At, B1); PG8_BAR; PG8_SCHED;
            } else {
            PG8_LDB(B0, 0, 0); PG8_SCHED; PG8_LDA(At, 0, 0); PG8_STAGE(PG8_SA(1, 1), a1 + hstep, voffA);
            PG8_WAIT_L(8); PG8_BAR; PG8_WAIT_L(0); PG8_MMA(0, 0, At, B0); PG8_BAR; PG8_SCHED;
            PG8_LDB(B1, 0, 1); PG8_STAGE(PG8_SB(0, 0), b2, voffB);
            PG8_BAR; PG8_WAIT_L(0); PG8_MMA(0, 1, At, B1); PG8_BAR;
            PG8_LDA(At, 0, 1); PG8_STAGE(PG8_SA(0, 0), a2, voffA);
            PG8_BAR; PG8_WAIT_L(0); PG8_MMA(1, 0, At, B0); PG8_BAR; PG8_SCHED;
            PG8_STAGE(PG8_SB(0, 1), b2 + hstep, voffB);
            PG8_WAIT_V(6); PG8_BAR; PG8_MMA(1, 1, At, B1); PG8_BAR;
            PG8_LDB(B0, 1, 0); PG8_SCHED; PG8_LDA(At, 1, 0); PG8_STAGE(PG8_SA(0, 1), a2 + hstep, voffA);
            PG8_WAIT_L(8); PG8_BAR; PG8_WAIT_L(0); PG8_MMA(0, 0, At, B0); PG8_BAR; PG8_SCHED;
            PG8_LDB(B1, 1, 1); PG8_STAGE(PG8_SB(1, 0), b3, voffB);
            PG8_BAR; PG8_WAIT_L(0); PG8_MMA(0, 1, At, B1); PG8_BAR;
            PG8_LDA(At, 1, 1); PG8_STAGE(PG8_SA(1, 0), a3, voffA);
            PG8_BAR; PG8_WAIT_L(0); PG8_MMA(1, 0, At, B0); PG8_BAR; PG8_SCHED;
            PG8_STAGE(PG8_SB(1, 1), b3 + hstep, voffB);
            PG8_WAIT_V(6); PG8_BAR; PG8_MMA(1, 1, At, B1); PG8_BAR;
            }
        }
        if constexpr (ALIGN_EPI) { if (wr == 0) PG8_BAR; }
        if constexpr (!Epi::AFTER_DRAIN) { E(acc, cur, wr, wc, fr, fq); S.done(cur); }
        if (!has_next) break;
#pragma unroll
        for (int a = 0; a < 2; ++a)
#pragma unroll
            for (int b = 0; b < 2; ++b)
#pragma unroll
                for (int m = 0; m < 4; ++m)
#pragma unroll
                    for (int n = 0; n < 2; ++n) acc[a][b][m][n] = (f32x4){0.f, 0.f, 0.f, 0.f};
        cur = nxt; cA = nA; cB = nB; ++ui;
        if constexpr (ALIGN_EPI) { if (wr == 1) PG8_BAR; }
    }
    PG8_WAIT_V(0);
    if constexpr (!ALIGN_EPI) { if (wr == 0) PG8_BAR; }
    PG8_BAR;
#undef PG8_SA
#undef PG8_SB
#undef PG8_STAGE
#undef PG8_LDA
#undef PG8_LDB
#undef PG8_MMA
#undef PG8_WAIT_V
#undef PG8_WAIT_L
#undef PG8_BAR
#undef PG8_SCHED
}
}

#define XB_TMO      128
#define XB_XCNT(j)  (256  + 64 * (j))
#define XB_XSUB(j)  (1280 + 64 * (j))
#define XB_XGEN(j)  (2304 + 64 * (j))
#define XB_TOP      3328
#define XB_TOPGEN   3392
#define XCD_BAR_WORDS 3456
#define XB_SPIN_CAP (1u << 18)
__device__ __forceinline__ unsigned xb_ld(unsigned* p)              { return __hip_atomic_load(p, __ATOMIC_RELAXED, __HIP_MEMORY_SCOPE_AGENT); }
__device__ __forceinline__ unsigned xb_add(unsigned* p, unsigned v) { return __hip_atomic_fetch_add(p, v, __ATOMIC_RELAXED, __HIP_MEMORY_SCOPE_AGENT); }
__device__ __forceinline__ unsigned xb_xcc_id() { return (unsigned)__builtin_amdgcn_s_getreg((3 << 11) | 20) & 0xFu; }
#define XB_SPIN(cond, bar) do { unsigned _sp = 0; while (cond) { __builtin_amdgcn_s_sleep(1); \
    if ((++_sp & 255u) == 0u) { if (xb_ld(&(bar)[XB_TMO])) break; if (_sp > XB_SPIN_CAP) { atomicAdd(&(bar)[XB_TMO], 1u); break; } } } } while (0)
struct XcdBarrier { unsigned* bar; unsigned x; volatile LAS unsigned* st; };
__device__ __forceinline__ XcdBarrier xcd_barrier_post(unsigned* bar, volatile LAS unsigned* st) {
    XcdBarrier b; b.bar = bar; b.x = xb_xcc_id(); b.st = st;
    if (threadIdx.x == 0) (void)xb_add(&bar[XB_XCNT(b.x)], 1u);
    return b;
}
__device__ __forceinline__ void xcd_barrier_complete(unsigned* bar, unsigned x, unsigned& nloc, unsigned& nx) {
    const unsigned G = gridDim.x * gridDim.y * gridDim.z;
    unsigned sum, cnt, mine, sp = 0u;
    for (;;) {
        sum = 0u; cnt = 0u; mine = 0u;
#pragma unroll
        for (unsigned j = 0; j < 16; ++j) { const unsigned c = xb_ld(&bar[XB_XCNT(j)]); sum += c; cnt += (c > 0u) ? 1u : 0u; mine = (j == x) ? c : mine; }
        if (sum == G) break;
        __builtin_amdgcn_s_sleep(1);
        if ((++sp & 255u) == 0u) { if (xb_ld(&bar[XB_TMO])) break; if (sp > XB_SPIN_CAP) { atomicAdd(&bar[XB_TMO], 1u); break; } }
    }
    nloc = mine > 0u ? mine : 1u; nx = cnt > 0u ? cnt : 1u;
}
__device__ __forceinline__ void xcd_barrier(const XcdBarrier& b) {
    asm volatile("s_waitcnt vmcnt(0)" ::: "memory");
    __syncthreads();
    if (threadIdx.x == 0) {
        unsigned* bar = b.bar;
        __builtin_amdgcn_s_waitcnt(0);
        unsigned nloc = b.st[0], nx = b.st[1];
        if (nloc == 0u) { xcd_barrier_complete(bar, b.x, nloc, nx); b.st[0] = nloc; b.st[1] = nx; }
        const unsigned old = xb_add(&bar[XB_XSUB(b.x)], 1u);
        const unsigned gen = old / nloc;
        if (old + 1u == (gen + 1u) * nloc) {
            __builtin_amdgcn_fence(__ATOMIC_RELEASE, "agent");
            asm volatile("s_waitcnt vmcnt(0)" ::: "memory");
            const unsigned og = xb_add(&bar[XB_TOP], 1u);
            const unsigned tg = og / nx;
            if (og + 1u == (tg + 1u) * nx) xb_add(&bar[XB_TOPGEN], 1u);
            else XB_SPIN(xb_ld(&bar[XB_TOPGEN]) == tg, bar);
            __builtin_amdgcn_fence(__ATOMIC_ACQUIRE, "agent");
            xb_add(&bar[XB_XGEN(b.x)], 1u);
            asm volatile("s_waitcnt vmcnt(0)" ::: "memory");
        } else {
            XB_SPIN(xb_ld(&bar[XB_XGEN(b.x)]) == gen, bar);
            __builtin_amdgcn_fence(__ATOMIC_ACQUIRE, "agent");
            asm volatile("s_waitcnt vmcnt(0)" ::: "memory");
        }
    }
    __syncthreads();
}

constexpr size_t MiB = 1u << 20;
constexpr size_t WS_CTL = 0, CTL_ZERO_BYTES = 1 * MiB;
constexpr int CW_BAR = 4096;
constexpr size_t WS_WAB = 1 * MiB;
constexpr size_t WS_WC = WS_WAB + (size_t)AB_WP * DM * 2;
constexpr size_t WS_WABO = WS_WC + (size_t)C_WP * DM * 2;
constexpr size_t WS_WCO = WS_WABO + (size_t)DM * DM * 2;
constexpr size_t WS_WMQ = WS_WCO + (size_t)DM * DM * 2;
constexpr size_t WS_WKV = WS_WMQ + (size_t)2 * 512 * DM * 2;
constexpr size_t WS_WMO = WS_WKV + (size_t)2048 * DM * 2;
constexpr size_t WS_WFI = WS_WMO + (size_t)2 * DM * 512 * 2;
constexpr size_t WS_WFO = WS_WFI + (size_t)2 * 5632 * DM * 2;
constexpr size_t WS_WEND = WS_WFO + (size_t)2 * DM * DFF * 2;
constexpr size_t WS_MISC = 64 * MiB;
static_assert(WS_WEND <= WS_MISC, "weights fit");
constexpr size_t WS_ROPE64 = WS_MISC;
constexpr size_t WS_ROPE32 = WS_ROPE64 + (size_t)MTOK * 16 * 4;
constexpr size_t WS_RSQ = WS_ROPE32 + (size_t)MTOK * 8 * 4;
constexpr size_t WS_MRS = WS_RSQ + (size_t)MTOK * 16 * 4;
constexpr size_t WS_MEMB = WS_MRS + 8192;
constexpr size_t WS_KVRAW = WS_MEMB + (size_t)MMEM * DM * 2;
constexpr size_t WS_W1T = WS_KVRAW + (size_t)MMEM * 2048 * 2;
constexpr size_t WS_POSW1 = WS_W1T + (size_t)2 * 64 * 2048 * 2;
constexpr size_t WS_KCMP = WS_POSW1 + 512;
constexpr size_t WS_VCMP = WS_KCMP + (size_t)BATCH * 4 * 256 * 64 * 2;
constexpr size_t WS_MISCEND = WS_VCMP + (size_t)BATCH * 4 * 256 * 64 * 2;
constexpr size_t WS_XB = 96 * MiB;
static_assert(WS_MISCEND <= WS_XB, "misc fits");
constexpr size_t WS_R1 = 160 * MiB;
constexpr size_t WS_OATT = 336 * MiB;
constexpr size_t WS_R3 = 400 * MiB;
constexpr size_t WS_GT = WS_R3;
constexpr size_t WS_MQ = WS_R3;
constexpr size_t WS_OMEM = WS_R3 + (size_t)MTOK * 512 * 2;
constexpr size_t WS_SC = WS_OATT;
constexpr size_t WS_BM = 464 * MiB;
constexpr size_t WS_KM = 480 * MiB;
constexpr size_t WS_ISG = 481 * MiB;
constexpr size_t WS_END = 512 * MiB;
static_assert(WS_R1 + (size_t)MTOK * C_WP * 2 <= WS_OATT, "R1 fits");

constexpr int LDS_BYTES = 155648;
constexpr int LDS_MISC = 151552;
constexpr int NWAVES = 8;

__device__ __forceinline__ unsigned f2bf(float f) { unsigned u = __builtin_bit_cast(unsigned, f); return (u + 0x7fffu + ((u >> 16) & 1u)) >> 16; }
__device__ __forceinline__ unsigned pk2(float lo, float hi) { f32x2 v = {lo, hi}; bf16x2_t b = __builtin_convertvector(v, bf16x2_t); return __builtin_bit_cast(unsigned, b); }
__device__ __forceinline__ float bf2f(unsigned short b) { return __builtin_bit_cast(float, (unsigned)b << 16); }
__device__ __forceinline__ float wave_sum(float v) {
#pragma unroll
    for (int o = 1; o < 64; o <<= 1) v += __shfl_xor(v, o);
    return v;
}


namespace att {
constexpr float NEG_INF = -__builtin_huge_valf();
template <int HD> struct Geo { static constexpr int PK = HD * 2 + 16, PV = (HD == 64 ? 192 : 320), KB = 64 * PK, VB = 64 * PV, BUF = KB + VB; };
template <int HD> struct State { f32x16 o[HD / 32]; float m, l;
    __device__ __forceinline__ void init() {
#pragma unroll
        for (int d = 0; d < HD / 32; ++d)
#pragma unroll
            for (int i = 0; i < 16; ++i) o[d][i] = 0.f;
        m = NEG_INF; l = 0.f; } };
template <int HD> struct TileRegs { u32x4 k[HD / 64], v[HD / 64]; };
template <int HD> __device__ __forceinline__ void load_tile(TileRegs<HD>& tr, const bf16_t* kb, size_t kp, const bf16_t* vb, size_t vp, int tid) {
#pragma unroll
    for (int i = 0; i < HD / 64; ++i) { const int idx = tid + 512 * i, row = idx / (HD / 8), c = idx % (HD / 8);
        tr.k[i] = *(const u32x4*)(kb + (size_t)row * kp + c * 8); tr.v[i] = *(const u32x4*)(vb + (size_t)row * vp + c * 8); }
}
template <int HD> __device__ __forceinline__ void store_tile(const TileRegs<HD>& tr, LAS unsigned char* buf, int tid) {
#pragma unroll
    for (int i = 0; i < HD / 64; ++i) { const int idx = tid + 512 * i, row = idx / (HD / 8), c = idx % (HD / 8);
        *(LAS u32x4*)(buf + row * Geo<HD>::PK + c * 16) = tr.k[i]; *(LAS u32x4*)(buf + Geo<HD>::KB + row * Geo<HD>::PV + c * 16) = tr.v[i]; }
}
__device__ __forceinline__ s16x4 tr_read(const LAS unsigned char* p) { typedef short v4i16_t __attribute__((ext_vector_type(4)));
    return __builtin_bit_cast(s16x4, __builtin_amdgcn_ds_read_tr16_b64_v4i16((LAS v4i16_t*)p)); }
__device__ __forceinline__ bf16x8 pack8(const f32x16& x, int s8) {
    u32x4 w; w.x = pk2(x[s8], x[s8 + 1]); w.y = pk2(x[s8 + 2], x[s8 + 3]); w.z = pk2(x[s8 + 4], x[s8 + 5]); w.w = pk2(x[s8 + 6], x[s8 + 7]); return __builtin_bit_cast(bf16x8, w); }
template <int HD> __device__ __forceinline__ void tile_scores(f32x16 (&p)[2], const bf16x8 (&qf)[HD / 16], const LAS unsigned char* buf, int lane) {
    const int r = lane & 31, h = lane >> 5;
#pragma unroll
    for (int kt = 0; kt < 2; ++kt) { f32x16 x;
#pragma unroll
        for (int i = 0; i < 16; ++i) x[i] = 0.f;
#pragma unroll
        for (int s = 0; s < HD / 16; ++s) { const bf16x8 kf = *(const LAS bf16x8*)(buf + (32 * kt + r) * Geo<HD>::PK + 32 * s + 16 * h); x = __builtin_amdgcn_mfma_f32_32x32x16_bf16(kf, qf[s], x, 0, 0, 0); }
        p[kt] = x; }
}
template <int HD> __device__ __forceinline__ void tile_pv(f32x16 (&o)[HD / 32], const f32x16 (&p)[2], const LAS unsigned char* buf, int lane) {
    const int h = lane >> 5, blk = (lane >> 4) & 1, q = (lane & 15) >> 2, pp = lane & 3;
    const LAS unsigned char* vb = buf + Geo<HD>::KB + (4 * h + q) * Geo<HD>::PV + 32 * blk + 8 * pp;
#pragma unroll
    for (int kt = 0; kt < 2; ++kt)
#pragma unroll
        for (int s = 0; s < 2; ++s) { const bf16x8 pb = pack8(p[kt], 8 * s);
#pragma unroll
            for (int dh = 0; dh < HD / 32; ++dh) { const LAS unsigned char* a = vb + (32 * kt + 16 * s) * Geo<HD>::PV + 64 * dh;
                const s16x4 lo = tr_read(a), hi = tr_read(a + 8 * Geo<HD>::PV);
                const bf16x8 vf = __builtin_shufflevector(lo, hi, 0, 1, 2, 3, 4, 5, 6, 7);
                o[dh] = __builtin_amdgcn_mfma_f32_32x32x16_bf16(vf, pb, o[dh], 0, 0, 0); } }
}
template <int HD, class MaskF> __device__ __forceinline__ void tile_step(State<HD>& st, const bf16x8 (&qf)[HD / 16], const LAS unsigned char* buf, int lane, MaskF valid) {
    f32x16 p[2]; tile_scores<HD>(p, qf, buf, lane);
    float mx = NEG_INF;
#pragma unroll
    for (int kt = 0; kt < 2; ++kt)
#pragma unroll
        for (int i = 0; i < 16; ++i) { const int koff = 32 * kt + (i & 3) + 8 * (i >> 2); const float v = valid(koff) ? p[kt][i] : NEG_INF; p[kt][i] = v; mx = fmaxf(mx, v); }
    mx = fmaxf(mx, __shfl_xor(mx, 32));
    const float mnew = fmaxf(st.m, mx), muse = (mnew == NEG_INF) ? 0.f : mnew;
    const float alpha = __builtin_amdgcn_exp2f(st.m - muse);
    float ls = 0.f;
#pragma unroll
    for (int kt = 0; kt < 2; ++kt)
#pragma unroll
        for (int i = 0; i < 16; ++i) { const float e = __builtin_amdgcn_exp2f(p[kt][i] - muse); p[kt][i] = e; ls += e; }
    st.l = st.l * alpha + ls; st.m = mnew;
#pragma unroll
    for (int dh = 0; dh < HD / 32; ++dh)
#pragma unroll
        for (int i = 0; i < 16; ++i) st.o[dh][i] *= alpha;
    tile_pv<HD>(st.o, p, buf, lane);
}
template <int HD, class SrcF, class CompF> __device__ __forceinline__ void kv_pipeline(LAS unsigned char* lds, int nt, int tid, SrcF src, CompF comp) {
    TileRegs<HD> tr; const bf16_t *kb, *vb; size_t kp, vp;
    __syncthreads();
    if (nt <= 0) return;
    src(0, kb, kp, vb, vp); load_tile<HD>(tr, kb, kp, vb, vp, tid); store_tile<HD>(tr, lds, tid);
    __syncthreads();
    for (int t = 0; t < nt; ++t) {
        if (t + 1 < nt) { src(t + 1, kb, kp, vb, vp); load_tile<HD>(tr, kb, kp, vb, vp, tid); }
        comp(t, lds + (t & 1) * Geo<HD>::BUF);
        if (t + 1 < nt) store_tile<HD>(tr, lds + ((t + 1) & 1) * Geo<HD>::BUF, tid);
        __syncthreads();
    }
}

template <int HD, bool PIPE, class SrcF, class ActF, class FinF> __device__ __forceinline__ void kv_pipeline3(LAS unsigned char* lds, int nt, int tid, int lane, const bf16x8 (&qf)[HD / 16], SrcF src, ActF act, FinF fin) {
    TileRegs<HD> tr; const bf16_t *kb, *vb; size_t kp, vp;
    __syncthreads();
    if (nt <= 0) return;
    src(0, kb, kp, vb, vp); load_tile<HD>(tr, kb, kp, vb, vp, tid); store_tile<HD>(tr, lds, tid);
    if (nt > 1) { src(1, kb, kp, vb, vp); load_tile<HD>(tr, kb, kp, vb, vp, tid); store_tile<HD>(tr, lds + Geo<HD>::BUF, tid); }
    __syncthreads();
    f32x16 pc[2], pn[2];
    if constexpr (PIPE) { if (act(0)) tile_scores<HD>(pc, qf, lds, lane); }
    int b0 = 0, b1 = 1, b2 = 2;
    for (int t = 0; t < nt; ++t) {
        if (t + 2 < nt) { src(t + 2, kb, kp, vb, vp); load_tile<HD>(tr, kb, kp, vb, vp, tid); }
        if constexpr (PIPE) {
            const bool an = (t + 1 < nt) && act(t + 1);
            if (an) tile_scores<HD>(pn, qf, lds + b1 * Geo<HD>::BUF, lane);
            if (act(t)) fin(t, pc, lds + b0 * Geo<HD>::BUF);
        } else {
            if (act(t)) { tile_scores<HD>(pc, qf, lds + b0 * Geo<HD>::BUF, lane); fin(t, pc, lds + b0 * Geo<HD>::BUF); }
        }
        if (t + 2 < nt) store_tile<HD>(tr, lds + b2 * Geo<HD>::BUF, tid);
        __syncthreads();
        if constexpr (PIPE) {
#pragma unroll
            for (int k = 0; k < 2; ++k) pc[k] = pn[k]; }
        const int tb = b0; b0 = b1; b1 = b2; b2 = tb;
    }
}
template <int HD, class MaskF> __device__ __forceinline__ void tile_finish(State<HD>& st, f32x16 (&p)[2], const LAS unsigned char* buf, int lane, bool lane_ok, bool elem, MaskF valid) {
    float mx = fmaxf(p[0][0], p[1][0]);
#pragma unroll
    for (int i = 1; i < 16; ++i) mx = fmaxf(mx, fmaxf(p[0][i], p[1][i]));
    mx = fmaxf(mx, __shfl_xor(mx, 32));
    if (__any(mx > st.m)) {
        const float mnew = fmaxf(st.m, mx), alpha = __builtin_amdgcn_exp2f(st.m - mnew);
        st.l *= alpha; st.m = mnew;
#pragma unroll
        for (int dh = 0; dh < HD / 32; ++dh)
#pragma unroll
            for (int i = 0; i < 16; ++i) st.o[dh][i] *= alpha;
    }
    const float sub = lane_ok ? st.m : __builtin_huge_valf();
#pragma unroll
    for (int kt = 0; kt < 2; ++kt)
#pragma unroll
        for (int i = 0; i < 16; ++i) p[kt][i] = __builtin_amdgcn_exp2f(p[kt][i] - sub);
    if (elem) {
#pragma unroll
        for (int kt = 0; kt < 2; ++kt)
#pragma unroll
            for (int i = 0; i < 16; ++i) { const int koff = 32 * kt + (i & 3) + 8 * (i >> 2); p[kt][i] = valid(koff) ? p[kt][i] : 0.f; }
    }
    float ls = 0.f;
#pragma unroll
    for (int i = 0; i < 16; ++i) ls += p[0][i] + p[1][i];
    st.l += ls;
    tile_pv<HD>(st.o, p, buf, lane);
}

template <int HD, bool ELEM, class MaskF> __device__ __forceinline__ void tile_fused(State<HD>& st, f32x16 (&p)[2], const LAS unsigned char* buf, int lane, bool lane_ok, MaskF valid,
                                                                                 const bf16x8 (&qf)[HD / 16], const LAS unsigned char* nbuf, f32x16 (&pn)[2]) {
    float mx = fmaxf(p[0][0], p[1][0]);
#pragma unroll
    for (int i = 1; i < 16; ++i) mx = fmaxf(mx, fmaxf(p[0][i], p[1][i]));
    mx = fmaxf(mx, __shfl_xor(mx, 32));
    if (__any(mx > st.m)) {
        const float mnew = fmaxf(st.m, mx), alpha = __builtin_amdgcn_exp2f(st.m - mnew);
        st.l *= alpha; st.m = mnew;
#pragma unroll
        for (int dh = 0; dh < HD / 32; ++dh)
#pragma unroll
            for (int i = 0; i < 16; ++i) st.o[dh][i] *= alpha;
    }
    const float sub = lane_ok ? st.m : __builtin_huge_valf();
    asm volatile("" : "+v"(lane));
    const int r = lane & 31, h = lane >> 5, blk = (lane >> 4) & 1, q4 = (lane & 15) >> 2, pp = lane & 3;
    const LAS unsigned char* kl = nbuf + r * Geo<HD>::PK + 16 * h;
    const LAS unsigned char* vl = buf + Geo<HD>::KB + (4 * h + q4) * Geo<HD>::PV + 32 * blk + 8 * pp;
#pragma unroll
    for (int i = 0; i < 16; ++i) { pn[0][i] = 0.f; pn[1][i] = 0.f; }
    float ls = 0.f;
#pragma unroll
    for (int c = 0; c < 4; ++c) {
        const int kt = c >> 1, s2 = c & 1;
#pragma unroll
        for (int ss = 0; ss < HD / 32; ++ss) { const int sk = (HD / 32) * s2 + ss; const bf16x8 kf = *(const LAS bf16x8*)(kl + (32 * kt) * Geo<HD>::PK + 32 * sk);
            pn[kt] = __builtin_amdgcn_mfma_f32_32x32x16_bf16(kf, qf[sk], pn[kt], 0, 0, 0); }
#pragma unroll
        for (int j = 0; j < 8; ++j) { const int i = 8 * s2 + j; float e = __builtin_amdgcn_exp2f(p[kt][i] - sub);
            if (ELEM) { const int koff = 32 * kt + (i & 3) + 8 * (i >> 2); e = valid(koff) ? e : 0.f; }
            p[kt][i] = e; ls += e; }
        const bf16x8 pb = pack8(p[kt], 8 * s2);
#pragma unroll
        for (int dh = 0; dh < HD / 32; ++dh) { const LAS unsigned char* a = vl + (32 * kt + 16 * s2) * Geo<HD>::PV + 64 * dh;
            const s16x4 lo = tr_read(a), hi = tr_read(a + 8 * Geo<HD>::PV);
            const bf16x8 vf = __builtin_shufflevector(lo, hi, 0, 1, 2, 3, 4, 5, 6, 7);
            st.o[dh] = __builtin_amdgcn_mfma_f32_32x32x16_bf16(vf, pb, st.o[dh], 0, 0, 0); }
        __builtin_amdgcn_sched_barrier(0);
    }
    st.l += ls;
}
struct NoPre { __device__ __forceinline__ void operator()(int) const {} };
template <int HD, class SrcF, class FinF, class PreF = NoPre> __device__ __forceinline__ void kv_pipeline4(LAS unsigned char* lds, int nt, int tid, int lane, const bf16x8 (&qf)[HD / 16], SrcF src, FinF fin, PreF pre = PreF()) {
    TileRegs<HD> tr; const bf16_t *kb, *vb; size_t kp, vp;
    __syncthreads();
    if (nt <= 0) return;
    src(0, kb, kp, vb, vp); load_tile<HD>(tr, kb, kp, vb, vp, tid); store_tile<HD>(tr, lds, tid);
    if (nt > 1) { src(1, kb, kp, vb, vp); load_tile<HD>(tr, kb, kp, vb, vp, tid); store_tile<HD>(tr, lds + Geo<HD>::BUF, tid); }
    __syncthreads();
    f32x16 pc[2], pn[2];
    tile_scores<HD>(pc, qf, lds, lane);
    int b0 = 0, b1 = 1, b2 = 2;
    for (int t = 0; t < nt; ++t) {
        pre(t + 1);
        if (t + 2 < nt) { src(t + 2, kb, kp, vb, vp); load_tile<HD>(tr, kb, kp, vb, vp, tid); }
        const int bn = (t + 1 < nt) ? b1 : b0;
        fin(t, pc, lds + b0 * Geo<HD>::BUF, lds + bn * Geo<HD>::BUF, pn);
        if (t + 2 < nt) store_tile<HD>(tr, lds + b2 * Geo<HD>::BUF, tid);
        __syncthreads();
#pragma unroll
        for (int k = 0; k < 2; ++k) pc[k] = pn[k];
        const int tb = b0; b0 = b1; b1 = b2; b2 = tb;
    }
}

constexpr int DBUF = 16384;
__device__ __forceinline__ void dma_tile(LAS unsigned char* buf, const bf16_t* kb, size_t kp, const bf16_t* vb, size_t vp, int wave, int lane) {
    const int row = 8 * wave + (lane >> 3), cp = lane & 7;
    const bf16_t* gk = kb + (size_t)row * kp + ((cp ^ ((row >> 1) & 7)) * 8);
    const bf16_t* gv = vb + (size_t)row * vp + ((cp ^ (4 * ((row >> 1) & 1))) * 8);
    __builtin_amdgcn_global_load_lds((const unsigned*)gk, (LAS unsigned*)(buf + wave * 1024), 16, 0, 0);
    __builtin_amdgcn_global_load_lds((const unsigned*)gv, (LAS unsigned*)(buf + 8192 + wave * 1024), 16, 0, 0);
}
__device__ __forceinline__ void dma_tile_o(LAS unsigned char* buf, const bf16_t* kb, const bf16_t* vb, unsigned gko, unsigned gvo, int wave) {
    __builtin_amdgcn_global_load_lds((const unsigned*)((const char*)kb + gko), (LAS unsigned*)(buf + wave * 1024), 16, 0, 0);
    __builtin_amdgcn_global_load_lds((const unsigned*)((const char*)vb + gvo), (LAS unsigned*)(buf + 8192 + wave * 1024), 16, 0, 0);
}
__device__ __forceinline__ void scores_d(f32x16 (&p)[2], const bf16x8 (&qf)[4], const LAS unsigned char* buf, int lane) {
    const int r = lane & 31, h = lane >> 5;
#pragma unroll
    for (int kt = 0; kt < 2; ++kt) { f32x16 x;
#pragma unroll
        for (int i = 0; i < 16; ++i) x[i] = 0.f;
        const int row = 32 * kt + r; const LAS unsigned char* kr = buf + row * 128; const int sw = (row >> 1) & 7;
#pragma unroll
        for (int s = 0; s < 4; ++s) { const bf16x8 kf = *(const LAS bf16x8*)(kr + (((2 * s + h) ^ sw) * 16)); x = __builtin_amdgcn_mfma_f32_32x32x16_bf16(kf, qf[s], x, 0, 0, 0); }
        p[kt] = x; }
}
template <bool ELEM, class MaskF> __device__ __forceinline__ void fused_d(State<64>& st, f32x16 (&p)[2], const LAS unsigned char* buf, int lane, bool lane_ok, MaskF valid,
                                                                        const bf16x8 (&qf)[4], const LAS unsigned char* nbuf, f32x16 (&pn)[2]) {
    float mx = fmaxf(p[0][0], p[1][0]);
#pragma unroll
    for (int i = 1; i < 16; ++i) mx = fmaxf(mx, fmaxf(p[0][i], p[1][i]));
    mx = fmaxf(mx, __shfl_xor(mx, 32));
    if (__any(mx > st.m)) {
        const float mnew = fmaxf(st.m, mx), alpha = __builtin_amdgcn_exp2f(st.m - mnew);
        st.l *= alpha; st.m = mnew;
#pragma unroll
        for (int dh = 0; dh < 2; ++dh)
#pragma unroll
            for (int i = 0; i < 16; ++i) st.o[dh][i] *= alpha;
    }
    const float sub = lane_ok ? st.m : __builtin_huge_valf();
    asm volatile("" : "+v"(lane));
    const int r = lane & 31, h = lane >> 5, blk = (lane >> 4) & 1, q4 = (lane & 15) >> 2, pp = lane & 3;
    const int ksw = (r >> 1) & 7;
    const LAS unsigned char* kl = nbuf + r * 128;
    const int vsw = 4 * ((q4 >> 1) & 1);
    const LAS unsigned char* vl = buf + 8192 + (4 * h + q4) * 128 + 8 * (pp & 1);
    const int vc0 = ((2 * blk + (pp >> 1)) ^ vsw) * 16, vc1 = ((4 + 2 * blk + (pp >> 1)) ^ vsw) * 16;
#pragma unroll
    for (int i = 0; i < 16; ++i) { pn[0][i] = 0.f; pn[1][i] = 0.f; }
    float ls = 0.f;
#pragma unroll
    for (int c = 0; c < 4; ++c) {
        const int kt = c >> 1, s2 = c & 1;
        s16x4 l0, h0, l1, h1;
        { const unsigned a0 = (unsigned)(size_t)(vl + (32 * kt + 16 * s2) * 128 + vc0), a1 = (unsigned)(size_t)(vl + (32 * kt + 16 * s2) * 128 + vc1);
          asm volatile("ds_read_b64_tr_b16 %0, %4\n\tds_read_b64_tr_b16 %1, %4 offset:1024\n\tds_read_b64_tr_b16 %2, %5\n\tds_read_b64_tr_b16 %3, %5 offset:1024"
                       : "=&v"(l0), "=&v"(h0), "=&v"(l1), "=&v"(h1) : "v"(a0), "v"(a1) : "memory"); }
#pragma unroll
        for (int ss = 0; ss < 2; ++ss) { const int sk = 2 * s2 + ss; const bf16x8 kf = *(const LAS bf16x8*)(kl + kt * 4096 + (((2 * sk + h) ^ ksw) * 16));
            pn[kt] = __builtin_amdgcn_mfma_f32_32x32x16_bf16(kf, qf[sk], pn[kt], 0, 0, 0); }
#pragma unroll
        for (int j = 0; j < 8; ++j) { const int i = 8 * s2 + j; float e = __builtin_amdgcn_exp2f(p[kt][i] - sub);
            if (ELEM) { const int koff = 32 * kt + (i & 3) + 8 * (i >> 2); e = valid(koff) ? e : 0.f; }
            p[kt][i] = e; ls += e; }
        const bf16x8 pb = pack8(p[kt], 8 * s2);
        asm volatile("s_waitcnt lgkmcnt(0)" ::: "memory"); __builtin_amdgcn_sched_barrier(0);
        st.o[0] = __builtin_amdgcn_mfma_f32_32x32x16_bf16(__builtin_shufflevector(l0, h0, 0, 1, 2, 3, 4, 5, 6, 7), pb, st.o[0], 0, 0, 0);
        st.o[1] = __builtin_amdgcn_mfma_f32_32x32x16_bf16(__builtin_shufflevector(l1, h1, 0, 1, 2, 3, 4, 5, 6, 7), pb, st.o[1], 0, 0, 0);
        __builtin_amdgcn_sched_barrier(0);
    }
    st.l += ls;
}
template <int XTRA, class SrcF, class FinF, class XtraF> __device__ __forceinline__ void kv_pipeline_dma(LAS unsigned char* lds, int nt, int wave, int lane, const bf16x8 (&qf)[4], SrcF src, FinF fin, XtraF xtra) {
    const bf16_t *kb, *vb; size_t kp, vp;
    asm volatile("s_waitcnt vmcnt(0) lgkmcnt(0)" ::: "memory"); __builtin_amdgcn_s_barrier();
    if (nt <= 0) return;
#pragma unroll
    for (int i = 0; i < 3; ++i) if (i < nt) { src(i, kb, kp, vb, vp); dma_tile(lds + i * DBUF, kb, kp, vb, vp, wave, lane); xtra(i, i); }
    if (nt >= 3) { if (XTRA) asm volatile("s_waitcnt vmcnt(3)" ::: "memory"); else asm volatile("s_waitcnt vmcnt(2)" ::: "memory"); }
    else asm volatile("s_waitcnt vmcnt(0)" ::: "memory");
    __builtin_amdgcn_s_barrier();
    f32x16 pc[2], pn[2];
    scores_d(pc, qf, lds, lane);
    for (int t = 0; t < nt; ++t) {
        if (t + 3 < nt) { src(t + 3, kb, kp, vb, vp); dma_tile(lds + ((t + 3) & 3) * DBUF, kb, kp, vb, vp, wave, lane); xtra(t + 3, (t + 3) & 3); }
        const int bn = (t + 1 < nt) ? ((t + 1) & 3) : (t & 3);
        fin(t, pc, lds + (t & 3) * DBUF, lds + bn * DBUF, pn, t & 3);
        if (t + 3 < nt) { if (XTRA) asm volatile("s_waitcnt vmcnt(3) lgkmcnt(0)" ::: "memory"); else asm volatile("s_waitcnt vmcnt(2) lgkmcnt(0)" ::: "memory"); }
        else asm volatile("s_waitcnt vmcnt(0) lgkmcnt(0)" ::: "memory");
        __builtin_amdgcn_s_barrier();
#pragma unroll
        for (int k = 0; k < 2; ++k) pc[k] = pn[k];
    }
}
struct NoXtra { __device__ __forceinline__ void operator()(int, int) const {} };

struct LpOff { unsigned k0, k1, v0, v1, gk, gv; };
__device__ __forceinline__ LpOff lp_offsets(int lane, int wave = 0, unsigned pitch_bytes = 0) {
    const int r = lane & 31, h = lane >> 5, blk = (lane >> 4) & 1, q4 = (lane & 15) >> 2, pp = lane & 3;
    const int ksw = (r >> 1) & 7, vsw = 4 * ((q4 >> 1) & 1);
    const unsigned vl = 8192 + (4 * h + q4) * 128 + 8 * (pp & 1);
    LpOff o; o.k0 = r * 128 + ((h ^ ksw) * 16); o.k1 = r * 128 + (((2 + h) ^ ksw) * 16);
    o.v0 = vl + ((2 * blk + (pp >> 1)) ^ vsw) * 16; o.v1 = vl + ((4 + 2 * blk + (pp >> 1)) ^ vsw) * 16;
    { const int row = 8 * wave + (lane >> 3), cp = lane & 7;
      o.gk = (unsigned)row * pitch_bytes + ((cp ^ ((row >> 1) & 7)) * 16); o.gv = (unsigned)row * pitch_bytes + ((cp ^ (4 * ((row >> 1) & 1))) * 16); }
    asm volatile("" : "+v"(o.k0), "+v"(o.k1), "+v"(o.v0), "+v"(o.v1), "+v"(o.gk), "+v"(o.gv));
    return o;
}
template <int MODE, bool HS, class MaskF> __device__ __forceinline__ void fused_np(f32x16 (&o)[2], float& l, const f32x16 (&p)[2], const LAS unsigned char* buf, int lane, bool lane_ok, float shift, MaskF valid, unsigned wlo, unsigned whi,
                                                                        const bf16x8 (&qf)[4], const LAS unsigned char* nbuf, f32x16 (&pn)[2], const LpOff& lo) {
    const unsigned nb = (unsigned)(size_t)nbuf, cb = (unsigned)(size_t)buf;
    const unsigned kA0 = nb + lo.k0, kA1 = nb + lo.k1, kB0 = kA0 ^ 64u, kB1 = kA1 ^ 64u;
    const unsigned vb0 = cb + lo.v0, vb1 = cb + lo.v1;
    const unsigned lmask = lane_ok ? 0xffffffffu : 0u;
    float ls = 0.f;
#pragma unroll
    for (int c = 0; c < 4; ++c) {
        const int kt = c >> 1, s2 = c & 1;
        s16x4 l0, h0, l1, h1;
        asm volatile("ds_read_b64_tr_b16 %0, %4 offset:%c6\n\tds_read_b64_tr_b16 %1, %4 offset:%c7\n\tds_read_b64_tr_b16 %2, %5 offset:%c6\n\tds_read_b64_tr_b16 %3, %5 offset:%c7"
                     : "=&v"(l0), "=&v"(h0), "=&v"(l1), "=&v"(h1) : "v"(vb0), "v"(vb1), "i"((32 * (c >> 1) + 16 * (c & 1)) * 128), "i"((32 * (c >> 1) + 16 * (c & 1)) * 128 + 1024) : "memory");
#pragma unroll
        for (int ss = 0; ss < 2; ++ss) { const int sk = 2 * s2 + ss; const bf16x8 kf = *(const LAS bf16x8*)(size_t)((sk == 0 ? kA0 : sk == 1 ? kA1 : sk == 2 ? kB0 : kB1) + kt * 4096);
            if (sk == 0) { f32x16 z;
#pragma unroll
                for (int i = 0; i < 16; ++i) z[i] = 0.f;
                pn[kt] = __builtin_amdgcn_mfma_f32_32x32x16_bf16(kf, qf[sk], z, 0, 0, 0); }
            else pn[kt] = __builtin_amdgcn_mfma_f32_32x32x16_bf16(kf, qf[sk], pn[kt], 0, 0, 0); }
        float e[8];
#pragma unroll
        for (int j = 0; j < 8; ++j) { const int i = 8 * s2 + j; const int koff = 32 * kt + (i & 3) + 8 * (i >> 2); float x = __builtin_amdgcn_exp2f(HS ? p[kt][i] - shift : p[kt][i]);
            if (MODE == 1) x = valid(koff) ? x : 0.f;
            if (MODE == 2) { int tb; asm("v_bfe_i32 %0, %1, %2, 1" : "=v"(tb) : "v"(kt ? whi : wlo), "n"(koff & 31)); x = __builtin_bit_cast(float, __builtin_bit_cast(unsigned, x) & (unsigned)tb); }
            e[j] = x; }
        u32x4 pw; pw.x = pk2(e[0], e[1]) & lmask; pw.y = pk2(e[2], e[3]) & lmask; pw.z = pk2(e[4], e[5]) & lmask; pw.w = pk2(e[6], e[7]) & lmask;
#pragma unroll
        for (int j = 0; j < 8; ++j) ls += lane_ok ? e[j] : 0.f;
        const bf16x8 pb = __builtin_bit_cast(bf16x8, pw);
        asm volatile("s_waitcnt lgkmcnt(0)" ::: "memory"); __builtin_amdgcn_sched_barrier(0);
        o[0] = __builtin_amdgcn_mfma_f32_32x32x16_bf16(__builtin_shufflevector(l0, h0, 0, 1, 2, 3, 4, 5, 6, 7), pb, o[0], 0, 0, 0);
        o[1] = __builtin_amdgcn_mfma_f32_32x32x16_bf16(__builtin_shufflevector(l1, h1, 0, 1, 2, 3, 4, 5, 6, 7), pb, o[1], 0, 0, 0);
        __builtin_amdgcn_sched_barrier(0);
    }
    l += ls;
}
template <int MODE, bool HS, class MaskF> __device__ __forceinline__ void fused_lp(f32x16 (&o)[2], float& l, const f32x16 (&p)[2], const LAS unsigned char* buf, int lane, bool lane_ok, float shift, MaskF valid, unsigned wlo, unsigned whi,
                                                                        const bf16x8 (&qf)[4], const LAS unsigned char* nbuf, f32x16 (&pn)[2], const LpOff& lo) {
    const unsigned nb = (unsigned)(size_t)nbuf, cb = (unsigned)(size_t)buf;
    const unsigned kA0 = nb + lo.k0, kA1 = nb + lo.k1, kB0 = kA0 ^ 64u, kB1 = kA1 ^ 64u;
    const unsigned vb0 = cb + lo.v0, vb1 = cb + lo.v1;
    const unsigned lmask = lane_ok ? 0xffffffffu : 0u;
    bf16x8 kf[2][2]; s16x4 vf[3][4]; bf16x8 pbp = {0, 0, 0, 0, 0, 0, 0, 0};
#define FE_ISSUE(c_, KS_, VS_) do { constexpr int kt_ = (c_) >> 1, s2_ = (c_) & 1; \
        asm volatile("ds_read_b128 %0, %6 offset:%c10\n\tds_read_b128 %1, %7 offset:%c10\n\tds_read_b64_tr_b16 %2, %8 offset:%c11\n\tds_read_b64_tr_b16 %3, %8 offset:%c12\n\tds_read_b64_tr_b16 %4, %9 offset:%c11\n\tds_read_b64_tr_b16 %5, %9 offset:%c12" \
                     : "=&v"(kf[KS_][0]), "=&v"(kf[KS_][1]), "=&v"(vf[VS_][0]), "=&v"(vf[VS_][1]), "=&v"(vf[VS_][2]), "=&v"(vf[VS_][3]) \
                     : "v"(s2_ ? kB0 : kA0), "v"(s2_ ? kB1 : kA1), "v"(vb0), "v"(vb1), "i"(kt_ * 4096), "i"((32 * kt_ + 16 * s2_) * 128), "i"((32 * kt_ + 16 * s2_) * 128 + 1024) : "memory"); } while (0)
    FE_ISSUE(0, 0, 0);
    float ls = 0.f;
#pragma unroll
    for (int c = 0; c < 4; ++c) {
        const int kt = c >> 1, s2 = c & 1, KS = c & 1, VS = c % 3, VP = (c + 2) % 3;
        asm volatile("s_waitcnt lgkmcnt(0)" ::: "memory"); __builtin_amdgcn_sched_barrier(0);
        if (c < 3) { if (c == 0) FE_ISSUE(1, 1, 1); else if (c == 1) FE_ISSUE(2, 0, 2); else FE_ISSUE(3, 1, 0); }
        if (s2 == 0) { f32x16 z;
#pragma unroll
            for (int i = 0; i < 16; ++i) z[i] = 0.f;
            pn[kt] = __builtin_amdgcn_mfma_f32_32x32x16_bf16(kf[KS][0], qf[0], z, 0, 0, 0); pn[kt] = __builtin_amdgcn_mfma_f32_32x32x16_bf16(kf[KS][1], qf[1], pn[kt], 0, 0, 0); }
        else { pn[kt] = __builtin_amdgcn_mfma_f32_32x32x16_bf16(kf[KS][0], qf[2], pn[kt], 0, 0, 0); pn[kt] = __builtin_amdgcn_mfma_f32_32x32x16_bf16(kf[KS][1], qf[3], pn[kt], 0, 0, 0); }
        if (c > 0) {
            o[0] = __builtin_amdgcn_mfma_f32_32x32x16_bf16(__builtin_shufflevector(vf[VP][0], vf[VP][1], 0, 1, 2, 3, 4, 5, 6, 7), pbp, o[0], 0, 0, 0);
            o[1] = __builtin_amdgcn_mfma_f32_32x32x16_bf16(__builtin_shufflevector(vf[VP][2], vf[VP][3], 0, 1, 2, 3, 4, 5, 6, 7), pbp, o[1], 0, 0, 0); }
        float e[8];
#pragma unroll
        for (int j = 0; j < 8; ++j) { const int i = 8 * s2 + j; const int koff = 32 * kt + (i & 3) + 8 * (i >> 2); float x = __builtin_amdgcn_exp2f(HS ? p[kt][i] - shift : p[kt][i]);
            if (MODE == 1) x = valid(koff) ? x : 0.f;
            if (MODE == 2) { int tb; asm("v_bfe_i32 %0, %1, %2, 1" : "=v"(tb) : "v"(kt ? whi : wlo), "n"(koff & 31)); x = __builtin_bit_cast(float, __builtin_bit_cast(unsigned, x) & (unsigned)tb); }
            e[j] = x; }
        u32x4 pw; pw.x = pk2(e[0], e[1]) & lmask; pw.y = pk2(e[2], e[3]) & lmask; pw.z = pk2(e[4], e[5]) & lmask; pw.w = pk2(e[6], e[7]) & lmask;
#pragma unroll
        for (int j = 0; j < 8; ++j) ls += lane_ok ? e[j] : 0.f;
#pragma unroll
        for (int g = 0; g < 4; ++g) { __builtin_amdgcn_sched_group_barrier(0x008, 1, 0); __builtin_amdgcn_sched_group_barrier(0x002, 9, 0); }
        __builtin_amdgcn_sched_barrier(0);
        pbp = __builtin_bit_cast(bf16x8, pw);
    }
    o[0] = __builtin_amdgcn_mfma_f32_32x32x16_bf16(__builtin_shufflevector(vf[0][0], vf[0][1], 0, 1, 2, 3, 4, 5, 6, 7), pbp, o[0], 0, 0, 0);
    o[1] = __builtin_amdgcn_mfma_f32_32x32x16_bf16(__builtin_shufflevector(vf[0][2], vf[0][3], 0, 1, 2, 3, 4, 5, 6, 7), pbp, o[1], 0, 0, 0);
#undef FE_ISSUE
    l += ls;
}
template <int MODE, bool HS, bool LP, class MaskF> __device__ __forceinline__ void fused_e(f32x16 (&o)[2], float& l, const f32x16 (&p)[2], const LAS unsigned char* buf, int lane, bool lane_ok, float shift, MaskF valid, unsigned wlo, unsigned whi,
                                                                        const bf16x8 (&qf)[4], const LAS unsigned char* nbuf, f32x16 (&pn)[2], const LpOff& lo = LpOff{}) {
    if constexpr (LP) fused_lp<MODE, HS>(o, l, p, buf, lane, lane_ok, shift, valid, wlo, whi, qf, nbuf, pn, lo); else fused_np<MODE, HS>(o, l, p, buf, lane, lane_ok, shift, valid, wlo, whi, qf, nbuf, pn, lo);
}
template <int XTRA, class SrcF, class FinF, class XtraF> __device__ __forceinline__ void kv_pipeline_dma2(LAS unsigned char* lds, int nt, int wave, int lane, const bf16x8 (&qf)[4], const LpOff& lo, SrcF src, FinF fin, XtraF xtra) {
    const bf16_t *kb, *vb; size_t kp, vp;
    asm volatile("s_waitcnt vmcnt(0) lgkmcnt(0)" ::: "memory"); __builtin_amdgcn_s_barrier();
    if (nt <= 0) return;
#pragma unroll
    for (int i = 0; i < 3; ++i) if (i < nt) { src(i, kb, kp, vb, vp); dma_tile_o(lds + i * DBUF, kb, vb, lo.gk, lo.gv, wave); xtra(i, i); }
    if (nt >= 3) { if (XTRA) asm volatile("s_waitcnt vmcnt(3)" ::: "memory"); else asm volatile("s_waitcnt vmcnt(2)" ::: "memory"); }
    else asm volatile("s_waitcnt vmcnt(0)" ::: "memory");
    __builtin_amdgcn_s_barrier();
    f32x16 pa[2], pb[2];
    scores_d(pa, qf, lds, lane);
#define KVD2_STEP(PC, PN) do { \
        if (t + 3 < nt) { src(t + 3, kb, kp, vb, vp); dma_tile_o(lds + ((t + 3) & 3) * DBUF, kb, vb, lo.gk, lo.gv, wave); xtra(t + 3, (t + 3) & 3); } \
        const int bn_ = (t + 1 < nt) ? ((t + 1) & 3) : (t & 3); \
        fin(t, PC, lds + (t & 3) * DBUF, lds + bn_ * DBUF, PN, t & 3); \
        if (t + 3 < nt) { if (XTRA) asm volatile("s_waitcnt vmcnt(3) lgkmcnt(0)" ::: "memory"); else asm volatile("s_waitcnt vmcnt(2) lgkmcnt(0)" ::: "memory"); } \
        else asm volatile("s_waitcnt vmcnt(0) lgkmcnt(0)" ::: "memory"); \
        __builtin_amdgcn_s_barrier(); ++t; } while (0)
    int t = 0;
    while (t < nt) { KVD2_STEP(pa, pb); if (t >= nt) break; KVD2_STEP(pb, pa); }
#undef KVD2_STEP
}
__device__ __forceinline__ float gain_max64(const float* g) { float m = 0.f; for (int i = 0; i < 64; ++i) m = fmaxf(m, fabsf(g[i])); return m; }
__device__ __forceinline__ float softmax_shift(float gq, float gk) { const float B = 8.0f * LOG2E * gq * gk * 1.02f; return B > 60.f ? B - 60.f : 0.f; }

template <int MODE, bool HS, class MaskF> __device__ __forceinline__ void half_v(u32x4 (&pw)[4], float& l, const f32x16 (&p)[2], bool lane_ok, float shift, MaskF valid, unsigned wlo, unsigned whi) {
    const unsigned lmask = lane_ok ? 0xffffffffu : 0u; float ls = 0.f;
#pragma unroll
    for (int c = 0; c < 4; ++c) { const int kt = c >> 1, s2 = c & 1; float e[8];
#pragma unroll
        for (int j = 0; j < 8; ++j) { const int i = 8 * s2 + j; const int koff = 32 * kt + (i & 3) + 8 * (i >> 2); float x = __builtin_amdgcn_exp2f(HS ? p[kt][i] - shift : p[kt][i]);
            if (MODE == 1) x = valid(koff) ? x : 0.f;
            if (MODE == 2) { int tb; asm("v_bfe_i32 %0, %1, %2, 1" : "=v"(tb) : "v"(kt ? whi : wlo), "n"(koff & 31)); x = __builtin_bit_cast(float, __builtin_bit_cast(unsigned, x) & (unsigned)tb); }
            e[j] = x; ls += x; }
        pw[c].x = pk2(e[0], e[1]) & lmask; pw[c].y = pk2(e[2], e[3]) & lmask; pw[c].z = pk2(e[4], e[5]) & lmask; pw[c].w = pk2(e[6], e[7]) & lmask; }
    l += lane_ok ? ls : 0.f;
}
__device__ __forceinline__ void half_m(f32x16 (&o)[2], const u32x4 (&pw)[4], const LAS unsigned char* buf, const LAS unsigned char* nbuf, const bf16x8 (&qf)[4], f32x16 (&pn)[2], bool do_scores, int lane) {
    asm volatile("" : "+v"(lane));
    const int r = lane & 31, h = lane >> 5, blk = (lane >> 4) & 1, q4 = (lane & 15) >> 2, pp = lane & 3;
    const int ksw = (r >> 1) & 7;
    const unsigned kl = (unsigned)(size_t)(nbuf + r * 128);
    const unsigned kx0 = ((h ^ ksw) * 16), kx1 = (((2 + h) ^ ksw) * 16);
    const unsigned kA0 = kl + kx0, kA1 = kl + kx1, kB0 = kl + (kx0 ^ 64u), kB1 = kl + (kx1 ^ 64u);
    const int vsw = 4 * ((q4 >> 1) & 1);
    const unsigned vl = (unsigned)(size_t)(buf + 8192 + (4 * h + q4) * 128 + 8 * (pp & 1));
    const unsigned vb0 = vl + ((2 * blk + (pp >> 1)) ^ vsw) * 16, vb1 = vl + ((4 + 2 * blk + (pp >> 1)) ^ vsw) * 16;
    bf16x8 kf[8]; s16x4 vf[16];
    if (do_scores) {
        asm volatile("ds_read_b128 %0, %8\n\tds_read_b128 %1, %9\n\tds_read_b128 %2, %10\n\tds_read_b128 %3, %11\n\tds_read_b128 %4, %8 offset:4096\n\tds_read_b128 %5, %9 offset:4096\n\tds_read_b128 %6, %10 offset:4096\n\tds_read_b128 %7, %11 offset:4096"
                     : "=&v"(kf[0]), "=&v"(kf[1]), "=&v"(kf[2]), "=&v"(kf[3]), "=&v"(kf[4]), "=&v"(kf[5]), "=&v"(kf[6]), "=&v"(kf[7]) : "v"(kA0), "v"(kA1), "v"(kB0), "v"(kB1) : "memory");
    }
#define HM_V(c_) asm volatile("ds_read_b64_tr_b16 %0, %4 offset:%c6\n\tds_read_b64_tr_b16 %1, %4 offset:%c7\n\tds_read_b64_tr_b16 %2, %5 offset:%c6\n\tds_read_b64_tr_b16 %3, %5 offset:%c7" \
                     : "=&v"(vf[4 * (c_)]), "=&v"(vf[4 * (c_) + 1]), "=&v"(vf[4 * (c_) + 2]), "=&v"(vf[4 * (c_) + 3]) : "v"(vb0), "v"(vb1), "i"((32 * ((c_) >> 1) + 16 * ((c_) & 1)) * 128), "i"((32 * ((c_) >> 1) + 16 * ((c_) & 1)) * 128 + 1024) : "memory")
    asm volatile("s_waitcnt lgkmcnt(0)" ::: "memory"); __builtin_amdgcn_sched_barrier(0);
    HM_V(0); HM_V(1); HM_V(2); HM_V(3);
#undef HM_V
    if (do_scores) {
#pragma unroll
        for (int kt = 0; kt < 2; ++kt) { f32x16 z;
#pragma unroll
            for (int i = 0; i < 16; ++i) z[i] = 0.f;
            z = __builtin_amdgcn_mfma_f32_32x32x16_bf16(kf[4 * kt + 0], qf[0], z, 0, 0, 0);
            z = __builtin_amdgcn_mfma_f32_32x32x16_bf16(kf[4 * kt + 1], qf[1], z, 0, 0, 0);
            z = __builtin_amdgcn_mfma_f32_32x32x16_bf16(kf[4 * kt + 2], qf[2], z, 0, 0, 0);
            z = __builtin_amdgcn_mfma_f32_32x32x16_bf16(kf[4 * kt + 3], qf[3], z, 0, 0, 0);
            pn[kt] = z; }
    }
    asm volatile("s_waitcnt lgkmcnt(0)" ::: "memory"); __builtin_amdgcn_sched_barrier(0);
#pragma unroll
    for (int c = 0; c < 4; ++c) { const bf16x8 pb = __builtin_bit_cast(bf16x8, pw[c]);
        o[0] = __builtin_amdgcn_mfma_f32_32x32x16_bf16(__builtin_shufflevector(vf[4 * c], vf[4 * c + 1], 0, 1, 2, 3, 4, 5, 6, 7), pb, o[0], 0, 0, 0);
        o[1] = __builtin_amdgcn_mfma_f32_32x32x16_bf16(__builtin_shufflevector(vf[4 * c + 2], vf[4 * c + 3], 0, 1, 2, 3, 4, 5, 6, 7), pb, o[1], 0, 0, 0); }
}
template <int XTRA, class SrcF, class VF, class XtraF> __device__ __forceinline__ void kv_pipeline_ab(LAS unsigned char* lds, int nt, int wave, int lane, const bf16x8 (&qf)[4], f32x16 (&o)[2], SrcF src, VF vhalf, XtraF xtra) {
    const bf16_t *kb, *vb; size_t kp, vp;
    asm volatile("s_waitcnt vmcnt(0) lgkmcnt(0)" ::: "memory"); __builtin_amdgcn_s_barrier();
    if (nt <= 0) return;
#pragma unroll
    for (int i = 0; i < 3; ++i) if (i < nt) { src(i, kb, kp, vb, vp); dma_tile(lds + i * DBUF, kb, kp, vb, vp, wave, lane); xtra(i, i); }
    if (nt >= 3) { if (XTRA) asm volatile("s_waitcnt vmcnt(3)" ::: "memory"); else asm volatile("s_waitcnt vmcnt(2)" ::: "memory"); }
    else asm volatile("s_waitcnt vmcnt(0)" ::: "memory");
    __builtin_amdgcn_s_barrier();
    f32x16 pc[2]; scores_d(pc, qf, lds, lane);
    asm volatile("s_waitcnt lgkmcnt(0)" ::: "memory");
    const bool grpB = (wave & 4) != 0;
    if (grpB) __builtin_amdgcn_s_barrier();
    u32x4 pw[4];
    for (int t = 0; t < nt; ++t) {
        vhalf(t, pc, pw, t & 3);
        asm volatile("s_waitcnt lgkmcnt(0)" ::: "memory"); __builtin_amdgcn_s_barrier();
        if (t + 3 < nt) { src(t + 3, kb, kp, vb, vp); dma_tile(lds + ((t + 3) & 3) * DBUF, kb, kp, vb, vp, wave, lane); xtra(t + 3, (t + 3) & 3); }
        half_m(o, pw, lds + (t & 3) * DBUF, lds + ((t + 1) & 3) * DBUF, qf, pc, t + 1 < nt, lane);
        if (t + 3 < nt) { if (XTRA) asm volatile("s_waitcnt vmcnt(3) lgkmcnt(0)" ::: "memory"); else asm volatile("s_waitcnt vmcnt(2) lgkmcnt(0)" ::: "memory"); }
        else asm volatile("s_waitcnt vmcnt(0) lgkmcnt(0)" ::: "memory");
        __builtin_amdgcn_s_barrier();
    }
    if (!grpB) __builtin_amdgcn_s_barrier();
}

template <int XTRA, class SrcF, class FinF, class XtraF> __device__ __forceinline__ void kv_pipeline_dma8(LAS unsigned char* lds, int nt, int wave, int lane, const bf16x8 (&qf)[4], const LpOff& lo, SrcF src, FinF fin, XtraF xtra) {
    const bf16_t *kb, *vb; size_t kp, vp;
    asm volatile("s_waitcnt vmcnt(0) lgkmcnt(0)" ::: "memory"); __builtin_amdgcn_s_barrier();
    if (nt <= 0) return;
#define KV8_WAIT(n_) do { const int na_ = (n_); \
        if (XTRA) { if (na_ >= 3) asm volatile("s_waitcnt vmcnt(9) lgkmcnt(0)" ::: "memory"); else if (na_ == 2) asm volatile("s_waitcnt vmcnt(6) lgkmcnt(0)" ::: "memory"); else if (na_ == 1) asm volatile("s_waitcnt vmcnt(3) lgkmcnt(0)" ::: "memory"); else asm volatile("s_waitcnt vmcnt(0) lgkmcnt(0)" ::: "memory"); } \
        else { if (na_ >= 3) asm volatile("s_waitcnt vmcnt(6) lgkmcnt(0)" ::: "memory"); else if (na_ == 2) asm volatile("s_waitcnt vmcnt(4) lgkmcnt(0)" ::: "memory"); else if (na_ == 1) asm volatile("s_waitcnt vmcnt(2) lgkmcnt(0)" ::: "memory"); else asm volatile("s_waitcnt vmcnt(0) lgkmcnt(0)" ::: "memory"); } } while (0)
#pragma unroll
    for (int i = 0; i < 6; ++i) if (i < nt) { src(i, kb, kp, vb, vp); dma_tile_o(lds + i * DBUF, kb, vb, lo.gk, lo.gv, wave); xtra(i, i); }
    { const int iss = nt < 6 ? nt : 6; KV8_WAIT(iss > 3 ? iss - 3 : 0); }
    __builtin_amdgcn_s_barrier();
    f32x16 pa[2], pb[2];
    scores_d(pa, qf, lds, lane);
    int t = 0;
    while (true) {
        if (t + 6 < nt) { src(t + 6, kb, kp, vb, vp); dma_tile_o(lds + ((t + 6) & 7) * DBUF, kb, vb, lo.gk, lo.gv, wave); xtra(t + 6, (t + 6) & 7); }
        { const int bn_ = (t + 1 < nt) ? ((t + 1) & 7) : (t & 7); fin(t, pa, lds + (t & 7) * DBUF, lds + bn_ * DBUF, pb, t & 7); }
        if (t + 1 >= nt) break;
        if (t + 7 < nt) { src(t + 7, kb, kp, vb, vp); dma_tile_o(lds + ((t + 7) & 7) * DBUF, kb, vb, lo.gk, lo.gv, wave); xtra(t + 7, (t + 7) & 7); }
        { const int bn_ = (t + 2 < nt) ? ((t + 2) & 7) : ((t + 1) & 7); fin(t + 1, pb, lds + ((t + 1) & 7) * DBUF, lds + bn_ * DBUF, pa, (t + 1) & 7); }
        { const int rem = nt - (t + 5); KV8_WAIT(rem < 0 ? 0 : (rem > 3 ? 3 : rem)); }
        __builtin_amdgcn_s_barrier();
        t += 2; if (t >= nt) break;
    }
    asm volatile("s_waitcnt vmcnt(0) lgkmcnt(0)" ::: "memory"); __builtin_amdgcn_s_barrier();
#undef KV8_WAIT
}
template <int HD> __device__ __forceinline__ void store_o(const f32x16 (&o)[HD / 32], float f, bf16_t* orow, int lane) {
    const int h = lane >> 5;
#pragma unroll
    for (int dh = 0; dh < HD / 32; ++dh)
#pragma unroll
        for (int g = 0; g < 4; ++g) { u32x2 w; w.x = pk2(o[dh][4 * g] * f, o[dh][4 * g + 1] * f); w.y = pk2(o[dh][4 * g + 2] * f, o[dh][4 * g + 3] * f);
            *(u32x2*)(orow + 32 * dh + 8 * g + 4 * h) = w; }
}

template <int HD> __device__ __forceinline__ void store_o_t(const f32x16 (&o)[HD / 32], float f, bf16_t* base, size_t ld, LAS unsigned char* scr, int lane) {
    constexpr int PITCH = HD * 2 + 16;
    asm volatile("" : "+v"(lane));
    const int r = lane & 31, h = lane >> 5;
#pragma unroll
    for (int dh = 0; dh < HD / 32; ++dh)
#pragma unroll
        for (int g = 0; g < 4; ++g) { u32x2 w; w.x = pk2(o[dh][4 * g] * f, o[dh][4 * g + 1] * f); w.y = pk2(o[dh][4 * g + 2] * f, o[dh][4 * g + 3] * f);
            *(LAS u32x2*)(scr + r * PITCH + (32 * dh + 8 * g + 4 * h) * 2) = w; }
    asm volatile("s_waitcnt lgkmcnt(0)" ::: "memory");
    constexpr int CPR = HD / 8;
#pragma unroll
    for (int i = 0; i < (32 * CPR) / 64; ++i) { const int idx = lane + 64 * i, row = idx / CPR, c = idx % CPR;
        const u32x4 v = *(const LAS u32x4*)(scr + row * PITCH + c * 16);
        *(u32x4*)(base + (size_t)row * ld + c * 8) = v; }
}
}


__device__ __forceinline__ float row_rstd(const float* rsq, int row) {
    const f32x4* pr = (const f32x4*)(rsq + (size_t)row * 16); const f32x4 a = pr[0], b = pr[1], c = pr[2], d = pr[3];
    const float ss = (((a[0] + a[1]) + (a[2] + a[3])) + ((b[0] + b[1]) + (b[2] + b[3]))) + (((c[0] + c[1]) + (c[2] + c[3])) + ((d[0] + d[1]) + (d[2] + d[3])));
    return __builtin_amdgcn_rsqf(ss * (1.0f / 1024.0f) + RMS_EPS);
}
__device__ __forceinline__ void unpack8(const u32x4 w, float (&f)[8]) {
#pragma unroll
    for (int j = 0; j < 4; ++j) { f[2 * j] = __builtin_bit_cast(float, w[j] << 16); f[2 * j + 1] = __builtin_bit_cast(float, w[j] & 0xffff0000u); } }
__device__ __forceinline__ u32x4 pack8f(const float (&f)[8]) { u32x4 o; o.x = pk2(f[0], f[1]); o.y = pk2(f[2], f[3]); o.z = pk2(f[4], f[5]); o.w = pk2(f[6], f[7]); return o; }
__device__ __forceinline__ void head_norm64(float (&f)[8], const float* gain, float extra, int lane) {
    float ss = 0.f;
#pragma unroll
    for (int j = 0; j < 8; ++j) ss += f[j] * f[j];
    ss += __shfl_xor(ss, 1); ss += __shfl_xor(ss, 2); ss += __shfl_xor(ss, 4);
    const float rn = __builtin_amdgcn_rsqf(ss * (1.0f / 64.0f) + RMS_EPS) * extra; const float* gn = gain + (lane & 7) * 8;
#pragma unroll
    for (int j = 0; j < 8; ++j) f[j] = f[j] * rn * gn[j];
}
__device__ __forceinline__ void head_rope64(float (&f)[8], const float* cs, int lane) {
    float oth[8];
#pragma unroll
    for (int j = 0; j < 8; ++j) oth[j] = __shfl_xor(f[j], 1);
    const int li = lane & 7;
    if (li < 2) {
#pragma unroll
        for (int j = 0; j < 8; ++j) { const float c = cs[j], sn = cs[8 + j]; f[j] = (li == 0) ? f[j] * c - oth[j] * sn : f[j] * c + oth[j] * sn; }
    }
}

__device__ __forceinline__ int wave_sum_i(int x) {
    x += __builtin_amdgcn_update_dpp(0, x, 0x111, 0xf, 0xf, true);
    x += __builtin_amdgcn_update_dpp(0, x, 0x112, 0xf, 0xf, true);
    x += __builtin_amdgcn_update_dpp(0, x, 0x114, 0xf, 0xf, true);
    x += __builtin_amdgcn_update_dpp(0, x, 0x118, 0xf, 0xf, true);
    x += __builtin_amdgcn_update_dpp(0, x, 0x142, 0xa, 0xf, true);
    x += __builtin_amdgcn_update_dpp(0, x, 0x143, 0xc, 0xf, true);
    return __builtin_amdgcn_readlane(x, 63);
}

__device__ __forceinline__ int cnt_ge(unsigned u, unsigned cand, int c) {
    int r; asm("v_cmp_ge_u32 vcc, %1, %2\n\tv_addc_co_u32 %0, vcc, 0, %3, vcc" : "=v"(r) : "v"(u), "v"(cand), "v"(c) : "vcc"); return r; }

__device__ __forceinline__ int cnt_ge16(const unsigned* u, unsigned cand, int c) {
    asm("v_cmp_ge_u32 vcc, %1, %17\n\tv_addc_co_u32 %0, vcc, 0, %0, vcc\n\tv_cmp_ge_u32 vcc, %2, %17\n\tv_addc_co_u32 %0, vcc, 0, %0, vcc\n\t"
        "v_cmp_ge_u32 vcc, %3, %17\n\tv_addc_co_u32 %0, vcc, 0, %0, vcc\n\tv_cmp_ge_u32 vcc, %4, %17\n\tv_addc_co_u32 %0, vcc, 0, %0, vcc\n\t"
        "v_cmp_ge_u32 vcc, %5, %17\n\tv_addc_co_u32 %0, vcc, 0, %0, vcc\n\tv_cmp_ge_u32 vcc, %6, %17\n\tv_addc_co_u32 %0, vcc, 0, %0, vcc\n\t"
        "v_cmp_ge_u32 vcc, %7, %17\n\tv_addc_co_u32 %0, vcc, 0, %0, vcc\n\tv_cmp_ge_u32 vcc, %8, %17\n\tv_addc_co_u32 %0, vcc, 0, %0, vcc\n\t"
        "v_cmp_ge_u32 vcc, %9, %17\n\tv_addc_co_u32 %0, vcc, 0, %0, vcc\n\tv_cmp_ge_u32 vcc, %10, %17\n\tv_addc_co_u32 %0, vcc, 0, %0, vcc\n\t"
        "v_cmp_ge_u32 vcc, %11, %17\n\tv_addc_co_u32 %0, vcc, 0, %0, vcc\n\tv_cmp_ge_u32 vcc, %12, %17\n\tv_addc_co_u32 %0, vcc, 0, %0, vcc\n\t"
        "v_cmp_ge_u32 vcc, %13, %17\n\tv_addc_co_u32 %0, vcc, 0, %0, vcc\n\tv_cmp_ge_u32 vcc, %14, %17\n\tv_addc_co_u32 %0, vcc, 0, %0, vcc\n\t"
        "v_cmp_ge_u32 vcc, %15, %17\n\tv_addc_co_u32 %0, vcc, 0, %0, vcc\n\tv_cmp_ge_u32 vcc, %16, %17\n\tv_addc_co_u32 %0, vcc, 0, %0, vcc"
        : "+v"(c) : "v"(u[0]), "v"(u[1]), "v"(u[2]), "v"(u[3]), "v"(u[4]), "v"(u[5]), "v"(u[6]), "v"(u[7]), "v"(u[8]), "v"(u[9]), "v"(u[10]), "v"(u[11]), "v"(u[12]), "v"(u[13]), "v"(u[14]), "v"(u[15]), "v"(cand) : "vcc");
    return c;
}
struct Args { const void* in[32]; float* out; unsigned char* ws; int ph_lo, ph_hi, li, pad; };

template <class CMap>
__device__ __forceinline__ void transpose_item(const float* W, int K, int N, bf16_t* WT, const float* gain, LAS float* scr, int kb, int nb, int lane, CMap cmap) {
    const int k0 = 64 * kb, n0 = 32 * nb, n4 = (lane & 7) * 4; const int c = cmap(n0 + n4);
    f32x4 v[8]; float gk[8];
#pragma unroll
    for (int i = 0; i < 8; ++i) { const int kk = (lane >> 3) + 8 * i; v[i] = (f32x4){0.f, 0.f, 0.f, 0.f}; gk[i] = 1.f;
        if (c >= 0) { v[i] = *(const f32x4*)(W + (size_t)(k0 + kk) * N + c); if (gain) gk[i] = gain[k0 + kk]; } }
#pragma unroll
    for (int i = 0; i < 8; ++i) { const int kk = (lane >> 3) + 8 * i; *(LAS f32x4*)(scr + kk * 36 + n4) = v[i] * gk[i]; }
    asm volatile("s_waitcnt lgkmcnt(0)" ::: "memory");
    const int ch = lane & 7;
#pragma unroll
    for (int j = 0; j < 4; ++j) { const int n = (lane >> 3) + 8 * j; const LAS float* s = scr + (8 * ch) * 36 + n;
        u32x4 o; o.x = pk2(s[0 * 36], s[1 * 36]); o.y = pk2(s[2 * 36], s[3 * 36]); o.z = pk2(s[4 * 36], s[5 * 36]); o.w = pk2(s[6 * 36], s[7 * 36]);
        *(u32x4*)(WT + (size_t)(n0 + n) * K + k0 + 8 * ch) = o; }
    asm volatile("s_waitcnt lgkmcnt(0)" ::: "memory");
}

struct CMapId { int n; __device__ __forceinline__ int operator()(int p) const { return p < n ? p : -1; } };
struct CMapProj0 { __device__ __forceinline__ int operator()(int p) const { const int o = p & 255, c = 64 * (4 * (p >> 8) + ((o >> 5) & 3)) + 8 * (2 * ((o >> 3) & 3) + (o >> 7)) + (o & 7);
    if (c < 936) return c; if (c < 960) return -1; return (c - 24 < AB_W) ? c - 24 : -1; } };
struct CMapProj1 { __device__ __forceinline__ int operator()(int p) const { const int o = p & 255, c = 64 * (4 * (p >> 8) + ((o >> 5) & 3)) + 8 * (2 * ((o >> 3) & 3) + (o >> 7)) + (o & 7); return c < C_W ? c : -1; } };
struct CMapFfn { __device__ __forceinline__ int operator()(int p) const { const int t = p >> 8, r = p & 255; return r < 128 ? t * 128 + r : DFF + t * 128 + (r - 128); } };

#ifndef PIPE_MEM
#define PIPE_MEM false
#endif
#ifndef PIPE_DSA
#define PIPE_DSA true
#endif
#ifndef PIPE_MOBA
#define PIPE_MOBA false
#endif
#ifndef PIPE_SEL
#define PIPE_SEL true
#endif
#ifndef PIPE_WIN
#define PIPE_WIN true
#endif
#ifndef LP_L0
#define LP_L0 true
#endif
#ifndef LP_NSA
#define LP_NSA false
#endif
#ifndef AB_L0
#define AB_L0 0
#endif
#ifndef PROBE_MASK
#define PROBE_MASK 0u
#endif
#define REPS(k) (((PROBE_MASK >> (k)) & 1u) ? 2 : 1)
#define RUN(k) (lo <= (k) && (k) < hi)
#define SEAM(k) do { if ((k) + 1 < hi) xcd_barrier(bar); } while (0)
#define INF_(k) ((const float*)args.in[k])
#define x_in INF_(0)
#define mem_in INF_(1)
#define positions ((const int*)args.in[2])
#define norm_mix INF_(3)
#define norm_mem INF_(4)
#define norm_mem_src INF_(5)
#define norm_ffn INF_(6)
#define ab_w_in INF_(7)
#define ab_w_out INF_(8)
#define nsa_w_in INF_(13)
#define nsa_w_out INF_(14)
#define mem_w_q INF_(25)
#define mem_w_kv INF_(26)
#define mem_w_o INF_(27)
#define ffn_w_in INF_(30)
#define ffn_w_out INF_(31)
#define out (args.out)
#define WSB(off) ((bf16_t*)(args.ws + (off)))
#define W_AB WSB(WS_WAB)
#define W_C WSB(WS_WC)
#define W_ABO WSB(WS_WABO)
#define W_CO WSB(WS_WCO)
#define W_MQ WSB(WS_WMQ)
#define W_KV WSB(WS_WKV)
#define W_MO WSB(WS_WMO)
#define W_FI WSB(WS_WFI)
#define W_FO WSB(WS_WFO)
#define XB WSB(WS_XB)
#define RSQ ((float*)(args.ws + WS_RSQ))
#define HID WSB(WS_R1)
#define MEMB WSB(WS_MEMB)
#define KVRAW WSB(WS_KVRAW)
#define MRS ((float*)(args.ws + WS_MRS))
#define MQB WSB(WS_MQ)
#define OMEM WSB(WS_OMEM)
#define mem_q_norm INF_(28)
#define RAW WSB(WS_R1)
#define OATT WSB(WS_OATT)
#define ROPE64 ((float*)(args.ws + WS_ROPE64))
#define ROPE32 ((float*)(args.ws + WS_ROPE32))
#define W1T WSB(WS_W1T)
#define POSW1 ((float*)(args.ws + WS_POSW1))
#define KCMP WSB(WS_KCMP)
#define VCMP WSB(WS_VCMP)
#define GT ((float*)(args.ws + WS_GT))
#define SCR ((float*)(args.ws + WS_SC))
#define BMK ((unsigned long long*)(args.ws + WS_BM))
#define KMEAN ((float*)(args.ws + WS_KM))
#define IWB ((float*)(args.ws + WS_ISG))
#define dsa_q_norm INF_(9)
#define dsa_k_norm INF_(10)
#define moba_q_norm INF_(11)
#define moba_k_norm INF_(12)
#define nsa_q_norm INF_(15)
#define nsa_kcmp_norm INF_(16)
#define nsa_ksel_norm INF_(17)
#define nsa_kwin_norm INF_(18)
#define nsa_cmp_pos_k INF_(19)
#define nsa_cmp_pos_v INF_(20)
#define nsa_cmp_w1_k INF_(21)
#define nsa_cmp_w2_k INF_(22)
#define nsa_cmp_w1_v INF_(23)
#define nsa_cmp_w2_v INF_(24)
#define mem_k_norm INF_(29)
template <int L> __device__ __forceinline__ void layer_phases(const Args& args, LAS unsigned char* lds, const XcdBarrier& bar, const int lo, const int hi, const int wave) {
    const int G = gridDim.x, bid = blockIdx.x;
    constexpr int pb = 1 + 10 * L;
        if (RUN(pb + 0)) for (int rep_ = 0; rep_ < REPS(pb + 0); ++rep_) {
            int lane = (int)__builtin_amdgcn_mbcnt_hi(~0u, __builtin_amdgcn_mbcnt_lo(~0u, 0u)); asm volatile("" : "+v"(lane)); const int tid = wave * 64 + lane;
            if (L == 0) {
                pg8::Gemm g{MEMB, W_KV, MMEM, 2048, DM}; pg8::StaticOrder S; S.init(MMEM, 2048, G, bid);
                pg8::EpiPlain E{KVRAW, 2048};
                pg8::gemm_phase<pg8::EpiPlain, pg8::StaticOrder, true, true>(lds, g, S, E, wave);
            }
            if (L == 0) {
                pg8::Gemm g{XB, W_AB, MTOK, AB_WP, DM}; pg8::StaticOrder S; S.init(MTOK, AB_WP, G, bid);
                pg8::EpiProj<0> E{RAW, AB_WP, RSQ, ROPE64, ROPE32, dsa_q_norm, dsa_k_norm, moba_q_norm, moba_k_norm, IWB};
                pg8::gemm_phase<pg8::EpiProj<0>, pg8::StaticOrder, true, true>(lds, g, S, E, wave);
            }
            if (L == 1) {
                pg8::Gemm g{XB, W_C, MTOK, C_WP, DM}; pg8::StaticOrder S; S.init(MTOK, C_WP, G, bid);
                pg8::EpiProj<1> E{RAW, C_WP, RSQ, ROPE64, ROPE32, nsa_q_norm, nsa_ksel_norm, nsa_kwin_norm, nullptr, GT};
                pg8::gemm_phase<pg8::EpiProj<1>, pg8::StaticOrder, true, true>(lds, g, S, E, wave);
            }
            SEAM(pb + 0);
        }
        if (RUN(pb + 1)) for (int rep_ = 0; rep_ < REPS(pb + 1); ++rep_) {
            int lane = (int)__builtin_amdgcn_mbcnt_hi(~0u, __builtin_amdgcn_mbcnt_lo(~0u, 0u)); asm volatile("" : "+v"(lane)); const int tid = wave * 64 + lane;
            if (L == 1) {
                LAS float* PART = (LAS float*)lds;
                LAS float* HB = (LAS float*)(lds + 65536);
                LAS float* W2S = (LAS float*)(lds + 65536 + 8448);
                for (int u = bid; u < BATCH * 4 * 2 * 8; u += G) {
                    const int ch = u & 7, kv = (u >> 3) & 1, g = (u >> 4) & 3, b = u >> 6;
                    const int r = lane & 31, h = lane >> 5, n0 = ch * 32;
                    const bf16_t* xb0 = RAW + (size_t)(b * SEQ + 16 * (n0 + r)) * C_WP + (kv ? 1280 : 1024) + g * 64 + 8 * h;
                    const bf16_t* wt = W1T + (size_t)kv * 64 * 2048 + 8 * h;
                    f32x16 acc[2];
#pragma unroll
                    for (int i = 0; i < 16; ++i) { acc[0][i] = 0.f; acc[1][i] = 0.f; }
                    const bool rowok = (n0 + r) < 255;
                    float rsl[4];
#pragma unroll
                    for (int li = 0; li < 4; ++li) rsl[li] = rowok ? row_rstd(RSQ, b * SEQ + 16 * (n0 + r) + wave * 4 + li) : 0.f;
#pragma unroll
                    for (int li = 0; li < 4; ++li) { const int l = wave * 4 + li;
#pragma unroll
                        for (int s2 = 0; s2 < 4; ++s2) {
                            bf16x8 a = {0, 0, 0, 0, 0, 0, 0, 0};
                            if (rowok) { float f[8]; unpack8(*(const u32x4*)(xb0 + (size_t)l * C_WP + 16 * s2), f);
#pragma unroll
                                for (int j = 0; j < 8; ++j) f[j] *= rsl[li];
                                a = __builtin_bit_cast(bf16x8, pack8f(f)); }
                            const bf16x8 b0 = *(const bf16x8*)(wt + (size_t)r * 2048 + l * 64 + 16 * s2), b1 = *(const bf16x8*)(wt + (size_t)(32 + r) * 2048 + l * 64 + 16 * s2);
                            acc[0] = __builtin_amdgcn_mfma_f32_32x32x16_bf16(a, b0, acc[0], 0, 0, 0); acc[1] = __builtin_amdgcn_mfma_f32_32x32x16_bf16(a, b1, acc[1], 0, 0, 0); } }
                    __syncthreads();
#pragma unroll
                    for (int nh = 0; nh < 2; ++nh)
#pragma unroll
                        for (int i = 0; i < 16; ++i) PART[wave * 2048 + ((i & 3) + 8 * (i >> 2) + 4 * h) * 64 + nh * 32 + r] = acc[nh][i];
                    { const float* w2 = kv ? nsa_cmp_w2_v : nsa_cmp_w2_k; const f32x4 wa = *(const f32x4*)(w2 + tid * 4), wb = *(const f32x4*)(w2 + 2048 + tid * 4);
                      *(LAS f32x4*)(W2S + tid * 4) = wa; *(LAS f32x4*)(W2S + 2048 + tid * 4) = wb; }
                    __syncthreads();
                    const float pw1 = POSW1[kv * 64 + (tid & 63)];
                    for (int i = tid; i < 2048; i += 512) { float a = pw1;
#pragma unroll
                        for (int w = 0; w < 8; ++w) a += PART[w * 2048 + i];
                        HB[(i >> 6) * 65 + (i & 63)] = a / (1.0f + __expf(-a)); }
                    __syncthreads();
                    { const int n = tid >> 4, c4 = (tid & 15) * 4; float o[4] = {0.f, 0.f, 0.f, 0.f};
                        for (int c = 0; c < 64; ++c) { const float hv = HB[n * 65 + c]; const f32x4 w = *(const LAS f32x4*)(W2S + c * 64 + c4); o[0] += hv * w[0]; o[1] += hv * w[1]; o[2] += hv * w[2]; o[3] += hv * w[3]; }
                        if (kv == 0) { float ss = (o[0] * o[0] + o[1] * o[1]) + (o[2] * o[2] + o[3] * o[3]);
                            ss += __shfl_xor(ss, 1); ss += __shfl_xor(ss, 2); ss += __shfl_xor(ss, 4); ss += __shfl_xor(ss, 8);
                            const float rn = __builtin_amdgcn_rsqf(ss * (1.0f / 64.0f) + RMS_EPS);
#pragma unroll
                            for (int j = 0; j < 4; ++j) o[j] = o[j] * rn * nsa_kcmp_norm[c4 + j]; }
                        if (n0 + n >= 255) { o[0] = o[1] = o[2] = o[3] = 0.f; }
                        u32x2 w; w.x = pk2(o[0], o[1]); w.y = pk2(o[2], o[3]);
                        *(u32x2*)((kv ? VCMP : KCMP) + ((size_t)(b * 4 + g) * 256 + n0 + n) * 64 + c4) = w; }
                    __syncthreads();
                }
            }
            if (L == 1) SEAM(pb + 1);
        }
        if (RUN(pb + 2)) for (int rep_ = 0; rep_ < REPS(pb + 2); ++rep_) {
            int lane = (int)__builtin_amdgcn_mbcnt_hi(~0u, __builtin_amdgcn_mbcnt_lo(~0u, 0u)); asm volatile("" : "+v"(lane)); const int tid = wave * 64 + lane;
            if (L == 0 && rep_ == 0) {
                const int gw = bid * NWAVES + wave, NGW = G * NWAVES;
                for (int m = gw; m < MMEM; m += NGW) {
                    const float rs = MRS[m]; bf16_t* row = KVRAW + (size_t)m * 2048;
#pragma unroll
                    for (int st = 0; st < 4; ++st) {
                        u32x4 w = *(const u32x4*)(row + st * 512 + lane * 8); float f[8];
#pragma unroll
                        for (int j = 0; j < 4; ++j) { f[2 * j] = __builtin_bit_cast(float, w[j] << 16) * rs; f[2 * j + 1] = __builtin_bit_cast(float, w[j] & 0xffff0000u) * rs; }
                        if ((st & 1) == 0) {
                            float ss = 0.f;
#pragma unroll
                            for (int j = 0; j < 8; ++j) ss += f[j] * f[j];
                            ss += __shfl_xor(ss, 1); ss += __shfl_xor(ss, 2); ss += __shfl_xor(ss, 4); ss += __shfl_xor(ss, 8);
                            const float rn = __builtin_amdgcn_rsqf(ss * (1.0f / 128.0f) + RMS_EPS);
                            const float* gn = mem_k_norm + (st >> 1) * 128 + (lane & 15) * 8;
#pragma unroll
                            for (int j = 0; j < 8; ++j) f[j] = f[j] * rn * gn[j];
                        }
                        u32x4 o; o.x = pk2(f[0], f[1]); o.y = pk2(f[2], f[3]); o.z = pk2(f[4], f[5]); o.w = pk2(f[6], f[7]);
                        *(u32x4*)(row + st * 512 + lane * 8) = o;
                    }
                }
            }
            if (L == 0) {
                { const int gw = bid * NWAVES + wave, NGW = G * NWAVES;
                  for (int u = gw; u < BATCH * 8 * 16; u += NGW) { const int n = u & 15, hm = (u >> 4) & 7, b = u >> 7;
                      const bf16_t* kb = RAW + (size_t)(b * SEQ + 256 * n + (lane >> 3)) * AB_WP + 1472 + hm * 64 + (lane & 7) * 8; float a[8] = {0.f, 0.f, 0.f, 0.f, 0.f, 0.f, 0.f, 0.f};
                      for (int i0 = 0; i0 < 32; i0 += 8) { u32x4 rw[8];
#pragma unroll
                          for (int i = 0; i < 8; ++i) rw[i] = *(const u32x4*)(kb + (size_t)(8 * (i0 + i)) * AB_WP);
#pragma unroll
                          for (int i = 0; i < 8; ++i) { float f[8]; unpack8(rw[i], f);
#pragma unroll
                              for (int j = 0; j < 8; ++j) a[j] += f[j]; } }
#pragma unroll
                      for (int j = 0; j < 8; ++j) { a[j] += __shfl_xor(a[j], 8); a[j] += __shfl_xor(a[j], 16); a[j] += __shfl_xor(a[j], 32); }
                      if (lane < 8) { float* o = KMEAN + (size_t)u * 64 + lane * 8;
#pragma unroll
                          for (int j = 0; j < 8; ++j) o[j] = a[j] * (1.0f / 256.0f); } } }
                LAS float* SCL = (LAS float*)lds;
#if defined(PROBE_IDX) && PROBE_IDX == 2
                if (rep_ == 0)
#endif
                for (int ui = bid; ui < BATCH * 256; ui += G) {
                    const int rr = ui >> 8, pos = ui & 255; const int qi = 32 * rr + ((rr & 1) ? 31 - (pos >> 3) : (pos >> 3)), b = pos & 7;
                    const int t0 = qi * 16, tmax = t0 + 15, nchunk = (tmax >> 10) + 1, nreg = (tmax >> 6) + 1;
                    const int ql = lane & 15, kq = lane >> 4;
                    const size_t qrow = (size_t)b * SEQ + t0 + ql;
                    typedef float f32x4v __attribute__((ext_vector_type(4)));
                    bf16x8 qf[8];
#pragma unroll
                    for (int hi = 0; hi < 8; ++hi) qf[hi] = *(const bf16x8*)(RAW + qrow * AB_WP + 640 + hi * 32 + 8 * kq);
                    const f32x4 iw0 = *(const f32x4*)(IWB + qrow * 8), iw1 = *(const f32x4*)(IWB + qrow * 8 + 4);
                    unsigned uu[2][64];
#pragma unroll
                    for (int rg = 0; rg < 64; ++rg) { uu[0][rg] = 0u; uu[1][rg] = 0u; }
#pragma unroll
                    for (int c = 0; c < 4; ++c) if (c < nchunk) {
                        const int ntile = ((tmax - 1024 * c) >> 4) + 1 < 64 ? ((tmax - 1024 * c) >> 4) + 1 : 64;
                        __syncthreads();
                        const bf16_t* kfp = RAW + (size_t)(b * SEQ + 1024 * c + ql) * AB_WP + 896 + 8 * kq;
                        bf16x8 kfn = *(const bf16x8*)(kfp + (size_t)(16 * (wave < ntile ? wave : 0)) * AB_WP);
                        for (int tile = wave; tile < ntile; tile += 8) {
                            const bf16x8 kf = kfn; { const int tn = tile + 8 < ntile ? tile + 8 : tile; kfn = *(const bf16x8*)(kfp + (size_t)(16 * tn) * AB_WP); }
                            f32x4v sc = {0.f, 0.f, 0.f, 0.f};
#pragma unroll
                            for (int hi = 0; hi < 8; ++hi) { f32x4v x = {0.f, 0.f, 0.f, 0.f}; x = __builtin_amdgcn_mfma_f32_16x16x32_bf16(kf, qf[hi], x, 0, 0, 0);
                                const float sf = hi < 4 ? iw0[hi & 3] : iw1[hi & 3];
#pragma unroll
                                for (int i = 0; i < 4; ++i) sc[i] += sf * fmaxf(x[i], 0.f); }
                            *(LAS f32x4v*)(SCL + ql * 1028 + 16 * tile + 4 * kq) = sc;
                        }
                        __syncthreads();
#pragma unroll
                        for (int qq = 0; qq < 2; ++qq) { const int t = t0 + 2 * wave + qq;
#pragma unroll
                            for (int rl = 0; rl < 16; ++rl) { const int key = 1024 * c + 64 * rl + lane; const unsigned bits = __builtin_bit_cast(unsigned, SCL[(2 * wave + qq) * 1028 + 64 * rl + lane]);
                                const unsigned mono = bits ^ ((bits >> 31) ? 0xffffffffu : 0x80000000u); uu[qq][16 * c + rl] = (key <= t) ? mono : 0u; } }
                    }
#if defined(PROBE_IDX) && PROBE_IDX == 1
                    if (rep_) { if (uu[0][3] == 12345u && uu[1][40] == 777u) BMK[0] = 1ull; continue; }
#endif
                    int lb = lane; asm volatile("" : "+v"(lb));
                    unsigned long long word[2] = {0ull, 0ull};
                    unsigned T[2] = {0u, 0u}; bool done[2], exact[2] = {false, false};
                    done[0] = (t0 + 2 * wave) < 256; done[1] = (t0 + 2 * wave + 1) < 256;
                    for (int bit = 31; bit >= 0 && !(done[0] && done[1]); --bit) {
                        const unsigned c0 = T[0] | (1u << bit), c1 = T[1] | (1u << bit); int n0 = 0, n1 = 0;
#pragma unroll
                        for (int ch = 0; ch < 4; ++ch) if (16 * ch < nreg) {
#pragma unroll
                            for (int dummy_ = 0; dummy_ < 1; ++dummy_) { n0 = cnt_ge16(&uu[0][16 * ch], c0, n0); n1 = cnt_ge16(&uu[1][16 * ch], c1, n1); } }
                        const int s0 = wave_sum_i(n0), s1 = wave_sum_i(n1);
                        if (!done[0]) { if (s0 >= 256) T[0] = c0; if (s0 == 256) { done[0] = true; exact[0] = true; } }
                        if (!done[1]) { if (s1 >= 256) T[1] = c1; if (s1 == 256) { done[1] = true; exact[1] = true; } }
                    }
#pragma unroll
                    for (int qq = 0; qq < 2; ++qq) { const int t = t0 + 2 * wave + qq; unsigned long long myword = 0ull;
                        if (t < 256) {
#pragma unroll
                            for (int rg = 0; rg < 4; ++rg) { const unsigned long long w = __ballot(64 * rg + lb <= t); if (lb == rg) myword = w; }
                        } else if (exact[qq]) {
#pragma unroll
                            for (int rg = 0; rg < 64; ++rg) { const unsigned long long w = __ballot(uu[qq][rg] >= T[qq]); if (lb == rg) myword = w; __builtin_amdgcn_sched_barrier(0); }
                        } else {
                            int cg = 0;
#pragma unroll
                            for (int rg = 0; rg < 64; ++rg) cg = cnt_ge(uu[qq][rg], T[qq] + 1u, cg);
                            int need = 256 - wave_sum_i(cg);
#pragma unroll
                            for (int rg = 0; rg < 64; ++rg) {
                                unsigned long long w = __ballot(uu[qq][rg] > T[qq]), eq = __ballot(uu[qq][rg] == T[qq]); const int ne = __builtin_popcountll(eq);
                                if (ne <= need) { w |= eq; need -= ne; } else { while (need > 0) { const unsigned long long low = eq & (0ull - eq); w |= low; eq ^= low; --need; } }
                                if (lb == rg) myword = w; __builtin_amdgcn_sched_barrier(0); }
                        }
                        BMK[((size_t)(b * 128 + (t >> 5)) * 64 + lb) * 32 + (t & 31)] = myword;
                    }
                }
            }
            if (L == 0) SEAM(pb + 2);
        }
        if (RUN(pb + 3)) for (int rep_ = 0; rep_ < REPS(pb + 3); ++rep_) {
            int lane = (int)__builtin_amdgcn_mbcnt_hi(~0u, __builtin_amdgcn_mbcnt_lo(~0u, 0u)); asm volatile("" : "+v"(lane)); const int tid = wave * 64 + lane;
            if (L == 0) {
                const float shiftA = att::softmax_shift(att::gain_max64(dsa_q_norm), att::gain_max64(dsa_k_norm)), shiftB = att::softmax_shift(att::gain_max64(moba_q_norm), att::gain_max64(moba_k_norm));
                for (int ui = bid; ui < BATCH * 128; ui += G) {
                    const int rr = ui >> 8, pos = ui & 255; const int qt = 32 * rr + ((rr & 1) ? 31 - (pos >> 3) : (pos >> 3)), b = pos & 7;
                    const int r = lane & 31, h = lane >> 5; const size_t row = (size_t)b * SEQ + qt * 32 + r;
                    bf16x8 qf[4];
                    { const bf16_t* qrow = RAW + row * AB_WP + wave * 64 + 8 * h;
#pragma unroll
                      for (int s2 = 0; s2 < 4; ++s2) qf[s2] = *(const bf16x8*)(qrow + 16 * s2); }
                    f32x16 oo[2]; float ll = 0.f;
#pragma unroll
                    for (int i = 0; i < 16; ++i) { oo[0][i] = 0.f; oo[1][i] = 0.f; }
                    const bf16_t* kbase = RAW + (size_t)b * SEQ * AB_WP + 512; const unsigned long long* bm = BMK + (size_t)(b * 128 + qt) * 64 * 32;
                    const att::LpOff lpo = att::lp_offsets(lane, wave, AB_WP * 2);
                    LAS unsigned char* MSL = lds + 8 * att::DBUF;
{ auto go_ = [&](auto hs_) { constexpr bool HS = decltype(hs_)::value;
#if AB_L0
                    att::kv_pipeline_ab<1>(lds, (qt >> 1) + 1, wave, lane, qf, oo,
                        [&](int tt, const bf16_t*& kb, size_t& kp, const bf16_t*& vb, size_t& vp) { kb = kbase + (size_t)(64 * tt) * AB_WP; kp = AB_WP; vb = kb + 64; vp = AB_WP; },
                        [&](int tt, const f32x16 (&p)[2], u32x4 (&pw)[4], int slot) {
                            const unsigned long long w = *(const LAS unsigned long long*)(MSL + (slot * 8 + wave) * 256 + r * 8) >> (4 * h);
                            att::half_v<2, HS>(pw, ll, p, true, shiftA, [](int) { return true; }, (unsigned)w, (unsigned)(w >> 32)); },
                        [&](int tt, int slot) { __builtin_amdgcn_global_load_lds((const unsigned*)(bm + (size_t)tt * 32) + lane, (LAS unsigned*)(MSL + (slot * 8 + wave) * 256), 4, 0, 0); });
#else
                    att::kv_pipeline_dma8<0>(lds, (qt >> 1) + 1, wave, lane, qf, lpo,
                        [&](int tt, const bf16_t*& kb, size_t& kp, const bf16_t*& vb, size_t& vp) { kb = kbase + (size_t)(64 * tt) * AB_WP; kp = AB_WP; vb = kb + 64; vp = AB_WP; },
                        [&](int tt, f32x16 (&p)[2], const LAS unsigned char* buf, const LAS unsigned char* nbuf, f32x16 (&pn)[2], int slot) {
                            const unsigned long long w = *(const LAS unsigned long long*)(MSL + slot * 256 + r * 8) >> (4 * h);
#if defined(PROBE_SKEL) && PROBE_SKEL == 2
                            if (rep_ == 0)
#endif
                            att::fused_e<2, HS, LP_L0>(oo, ll, p, buf, lane, true, shiftA, [](int) { return true; }, (unsigned)w, (unsigned)(w >> 32), qf, nbuf, pn, lpo); },
                        [&](int tt, int slot) { if ((tt & 7) == wave) __builtin_amdgcn_global_load_lds((const unsigned*)(bm + (size_t)tt * 32) + lane, (LAS unsigned*)(MSL + slot * 256), 4, 0, 0); });
#endif
 }; if (shiftA == 0.f) go_(std::false_type{}); else go_(std::true_type{}); }
                    const float lt = ll + __shfl_xor(ll, 32);
#if defined(PROBE_SKEL) && PROBE_SKEL == 2
                    if (rep_ == 0)
#endif
                    att::store_o_t<64>(oo, lt > 0.f ? 1.0f / lt : 0.f, OATT + ((size_t)b * SEQ + qt * 32) * 1024 + wave * 64, 1024, lds + wave * 4608, lane);
                }
                LAS unsigned* UNI = (LAS unsigned*)(lds + 8 * att::DBUF); LAS int* TL = (LAS int*)(lds + 8 * att::DBUF + 16); LAS float* KMS = (LAS float*)(lds + 8 * att::DBUF + 256);
#if defined(PROBE_SKEL)
                if (rep_ == 0)
#endif
                for (int ui = bid; ui < BATCH * 8 * 16; ui += G) {
                    const int rr = ui >> 8, pos = ui & 255; const int xk = pos >> 3, cmb = rr * 16 + (pos & 7) * 2 + (xk >> 4);
                    const int own = (rr & 1) ? 15 - (xk & 15) : (xk & 15), b = cmb >> 3, hm = cmb & 7;
                    const int r = lane & 31, h = lane >> 5; const int tl = wave * 32 + r; const size_t row = (size_t)b * SEQ + own * 256 + tl;
                    bf16x8 qf[4];
                    { const bf16_t* qrow = RAW + row * AB_WP + 960 + hm * 64 + 8 * h;
#pragma unroll
                      for (int s2 = 0; s2 < 4; ++s2) qf[s2] = *(const bf16x8*)(qrow + 16 * s2); }
                    if (tid == 0) UNI[0] = 0u;
                    { const f32x2 kmv = *(const f32x2*)(KMEAN + (size_t)(b * 8 + hm) * 1024 + tid * 2); *(LAS f32x2*)(KMS + tid * 2) = kmv; }
                    __syncthreads();
                    unsigned msk = 0u;
                    { float b0 = att::NEG_INF, b1 = att::NEG_INF, b2 = att::NEG_INF; int i0 = -1, i1 = -1, i2 = -1;
                      float qv[32];
#pragma unroll
                      for (int s2 = 0; s2 < 4; ++s2) { float f[8]; unpack8(__builtin_bit_cast(u32x4, qf[s2]), f);
#pragma unroll
                          for (int j = 0; j < 8; ++j) qv[8 * s2 + j] = f[j]; }
                      for (int n = 0; n < own; ++n) { const LAS float* km = KMS + n * 64 + 8 * h; float a = 0.f;
#pragma unroll
                          for (int s2 = 0; s2 < 4; ++s2) { const f32x4 k0 = *(const LAS f32x4*)(km + 16 * s2), k1 = *(const LAS f32x4*)(km + 16 * s2 + 4);
                              a += qv[8 * s2] * k0[0] + qv[8 * s2 + 1] * k0[1] + qv[8 * s2 + 2] * k0[2] + qv[8 * s2 + 3] * k0[3] + qv[8 * s2 + 4] * k1[0] + qv[8 * s2 + 5] * k1[1] + qv[8 * s2 + 6] * k1[2] + qv[8 * s2 + 7] * k1[3]; }
                          a += __shfl_xor(a, 32);
                          if (a > b0) { b2 = b1; i2 = i1; b1 = b0; i1 = i0; b0 = a; i0 = n; } else if (a > b1) { b2 = b1; i2 = i1; b1 = a; i1 = n; } else if (a > b2) { b2 = a; i2 = n; } }
                      if (i0 >= 0) msk |= 1u << i0; if (i1 >= 0) msk |= 1u << i1; if (i2 >= 0) msk |= 1u << i2; }
                    { unsigned um = msk;
#pragma unroll
                      for (int o = 1; o < 64; o <<= 1) um |= __shfl_xor(um, o);
                      if (lane == 0) __hip_atomic_fetch_or(UNI, um, __ATOMIC_RELAXED, __HIP_MEMORY_SCOPE_WORKGROUP); }
                    __syncthreads();
                    const unsigned U = (unsigned)__builtin_amdgcn_readfirstlane((int)UNI[0]);
                    const int npast = __builtin_popcount(U);
                    if (wave == 0 && lane < 16 && ((U >> lane) & 1u)) TL[__builtin_amdgcn_mbcnt_lo(U, 0u)] = lane;
                    f32x16 oo[2]; float ll = 0.f;
#pragma unroll
                    for (int i = 0; i < 16; ++i) { oo[0][i] = 0.f; oo[1][i] = 0.f; }
                    const bf16_t* kbase = RAW + (size_t)b * SEQ * AB_WP + 1472 + hm * 64;
                    const att::LpOff lpo = att::lp_offsets(lane, wave, AB_WP * 2);
                    __syncthreads();
{ auto go_ = [&](auto hs_) { constexpr bool HS = decltype(hs_)::value;
#if AB_L0
                    att::kv_pipeline_ab<0>(lds, 4 * npast + 4, wave, lane, qf, oo,
                        [&](int tt, const bf16_t*& kb, size_t& kp, const bf16_t*& vb, size_t& vp) {
                            const int blk = (tt < 4 * npast) ? __builtin_amdgcn_readfirstlane(TL[tt >> 2]) : own, sub = (tt < 4 * npast) ? (tt & 3) : tt - 4 * npast;
                            kb = kbase + (size_t)(256 * blk + 64 * sub) * AB_WP; kp = AB_WP; vb = kb + 512; vp = AB_WP; },
                        [&](int tt, const f32x16 (&p)[2], u32x4 (&pw)[4], int) {
                            if (tt < 4 * npast) { const int blk = __builtin_amdgcn_readfirstlane(TL[tt >> 2]); const bool sel = (msk >> blk) & 1u;
                                att::half_v<0, HS>(pw, ll, p, sel, shiftB, [](int) { return true; }, 0u, 0u); }
                            else { const int sub = tt - 4 * npast; const int lim = tl - 64 * sub - 4 * h;
                                att::half_v<1, HS>(pw, ll, p, true, shiftB, [&](int koff) { return koff <= lim; }, 0u, 0u); } },
                        att::NoXtra());
#else
                    att::kv_pipeline_dma8<0>(lds, 4 * npast + 4, wave, lane, qf, lpo,
                        [&](int tt, const bf16_t*& kb, size_t& kp, const bf16_t*& vb, size_t& vp) {
                            const int blk = (tt < 4 * npast) ? __builtin_amdgcn_readfirstlane(TL[tt >> 2]) : own, sub = (tt < 4 * npast) ? (tt & 3) : tt - 4 * npast;
                            kb = kbase + (size_t)(256 * blk + 64 * sub) * AB_WP; kp = AB_WP; vb = kb + 512; vp = AB_WP; },
                        [&](int tt, f32x16 (&p)[2], const LAS unsigned char* buf, const LAS unsigned char* nbuf, f32x16 (&pn)[2], int) {
                            if (tt < 4 * npast) { const int blk = __builtin_amdgcn_readfirstlane(TL[tt >> 2]); const bool sel = (msk >> blk) & 1u;
                                att::fused_e<0, HS, LP_L0>(oo, ll, p, buf, lane, sel, shiftB, [](int) { return true; }, 0u, 0u, qf, nbuf, pn, lpo); }
                            else { const int sub = tt - 4 * npast; const int lim = tl - 64 * sub - 4 * h;
                                att::fused_e<1, HS, LP_L0>(oo, ll, p, buf, lane, true, shiftB, [&](int koff) { return koff <= lim; }, 0u, 0u, qf, nbuf, pn, lpo); } },
                        att::NoXtra());
#endif
 }; if (shiftB == 0.f) go_(std::false_type{}); else go_(std::true_type{}); }
                    const float lt = ll + __shfl_xor(ll, 32);
                    att::store_o_t<64>(oo, lt > 0.f ? 1.0f / lt : 0.f, OATT + ((size_t)b * SEQ + own * 256 + wave * 32) * 1024 + 512 + hm * 64, 1024, lds + wave * 4608, lane);
                    __syncthreads();
                }
            }
            if (L == 1) {
                const float shiftS = att::softmax_shift(att::gain_max64(nsa_q_norm), att::gain_max64(nsa_ksel_norm)), shiftW = att::softmax_shift(att::gain_max64(nsa_q_norm), att::gain_max64(nsa_kwin_norm));
                LAS unsigned* IMP = (LAS unsigned*)(lds + 86016);
                LAS unsigned long long* SELM = (LAS unsigned long long*)(lds + 4 * att::DBUF); LAS int* TL = (LAS int*)(lds + 4 * att::DBUF + 528);
                for (int ui = bid; ui < BATCH * 4 * 64; ui += G) {
                    const int rr = ui >> 8, pos = ui & 255;
                    const int pr = (pos & 7) * 4 + (rr >> 1), xk = pos >> 3, qt = (rr & 1) ? 63 - xk : xk, b = pr >> 2, g = pr & 3;
                    const int r = lane & 31, h = lane >> 5, j = wave & 3, qs = wave >> 2, hd = g * 4 + j;
                    const int t = qt * 64 + qs * 32 + r, ql = qs * 32 + r; const size_t row = (size_t)b * SEQ + t;
                    bf16x8 qf[4];
                    { const bf16_t* qrow = RAW + row * C_WP + hd * 64 + 8 * h;
#pragma unroll
                      for (int s2 = 0; s2 < 4; ++s2) qf[s2] = *(const bf16x8*)(qrow + 16 * s2); }
                    for (int i = tid; i < ((qt >> 4) + 1) * 64 * 64 / 4; i += 512) ((LAS u32x4*)IMP)[i] = (u32x4){0u, 0u, 0u, 0u};
                    f32x16 oacc[2];
                    const float* gt = GT + row * 48 + hd * 3; const float g0 = gt[0];
                    const int nvalid = t >= 31 ? ((t - 31) >> 4) + 1 : 0;
                    const int ntc = (qt >> 4) + 1;
                    { const bf16_t* kcb = KCMP + (size_t)(b * 4 + g) * 256 * 64; const bf16_t* vcb = VCMP + (size_t)(b * 4 + g) * 256 * 64;
                      for (int idx = tid; idx < 64 * 8 * ntc; idx += 512) { const int rw = idx >> 3, c = idx & 7;
                          *(LAS u32x4*)(lds + rw * 144 + c * 16) = *(const u32x4*)(kcb + rw * 64 + c * 8);
                          *(LAS u32x4*)(lds + 36864 + rw * 192 + c * 16) = *(const u32x4*)(vcb + rw * 64 + c * 8); } }
                    __syncthreads();
                    float mc = att::NEG_INF, lc = 0.f;
#pragma unroll 1
                    for (int tt = 0; tt < ntc; ++tt) {
                        f32x16 p[2]; att::tile_scores<64>(p, qf, lds + tt * 9216, lane); const int lim = nvalid - 64 * tt - 4 * h; float mx = att::NEG_INF;
#pragma unroll
                        for (int kt = 0; kt < 2; ++kt)
#pragma unroll
                            for (int i = 0; i < 16; ++i) { const int koff = 32 * kt + (i & 3) + 8 * (i >> 2); const float v = (koff < lim) ? p[kt][i] : att::NEG_INF; p[kt][i] = v; mx = fmaxf(mx, v); }
                        mx = fmaxf(mx, __shfl_xor(mx, 32));
                        const float mnew = fmaxf(mc, mx), muse = (mnew == att::NEG_INF) ? 0.f : mnew; float ls = 0.f;
#pragma unroll
                        for (int kt = 0; kt < 2; ++kt)
#pragma unroll
                            for (int i = 0; i < 16; ++i) ls += __builtin_amdgcn_exp2f(p[kt][i] - muse);
                        lc = lc * __builtin_amdgcn_exp2f(mc - muse) + ls; mc = mnew; }
                    lc += __shfl_xor(lc, 32);
                    const float invl = lc > 0.f ? 1.0f / lc : 0.f, mcu = (mc == att::NEG_INF) ? 0.f : mc;
#pragma unroll
                    for (int i = 0; i < 16; ++i) { oacc[0][i] = 0.f; oacc[1][i] = 0.f; }
#pragma unroll 1
                    for (int tt = 0; tt < ntc; ++tt) {
                        f32x16 p[2]; att::tile_scores<64>(p, qf, lds + tt * 9216, lane); const int lim = nvalid - 64 * tt - 4 * h;
#pragma unroll
                        for (int kt = 0; kt < 2; ++kt)
#pragma unroll
                            for (int i = 0; i < 16; ++i) { const int koff = 32 * kt + (i & 3) + 8 * (i >> 2); const float pv = (koff < lim) ? __builtin_amdgcn_exp2f(p[kt][i] - mcu) * invl : 0.f; p[kt][i] = pv;
                                __hip_atomic_fetch_add(IMP + (64 * tt + koff + 4 * h) * 64 + ql, (unsigned)(pv * 134217728.0f + 0.5f), __ATOMIC_RELAXED, __HIP_MEMORY_SCOPE_WORKGROUP);
                                if ((i & 3) == 3) __builtin_amdgcn_sched_barrier(0); }
                        __builtin_amdgcn_sched_barrier(0);
                        att::tile_pv<64>(oacc, p, lds + 36864 + tt * 12288 - 9216, lane); }
#pragma unroll
                    for (int i = 0; i < 16; ++i) { oacc[0][i] *= g0; oacc[1][i] *= g0; }
                    LAS float* STASH = (LAS float*)IMP + wave * 2048 + lane;
                    __syncthreads();
                    {
                        int l2 = lane; asm volatile("" : "+v"(l2));
                        const int qq = l2 >> 3, seg = l2 & 7, q = wave * 8 + qq, cur = qt;
                        unsigned key[8];
#pragma unroll
                        for (int k = 0; k < 8; ++k) { const int sb = 8 * seg + k; unsigned v = 0u;
#pragma unroll
                            for (int dn = -1; dn <= 3; ++dn) { const int n = 4 * sb + dn; if (n >= 0 && n < 255) v += IMP[n * 64 + q]; }
                            const bool forced = (sb == 0) || (sb == cur) || (sb == cur - 1);
                            key[k] = (sb <= cur) ? ((forced ? 0xffffff80u : ((v >> 7) << 7)) | (unsigned)(64 - sb)) : 0u; __builtin_amdgcn_sched_barrier(0); }
                        unsigned T = 0u;
                        for (int bit = 31; bit >= 0; --bit) { const unsigned cand = T | (1u << bit); int c = 0;
#pragma unroll
                            for (int k = 0; k < 8; ++k) c += (key[k] >= cand) ? 1 : 0;
                            c += __builtin_amdgcn_update_dpp(0, c, 0xB1, 0xf, 0xf, false);
                            c += __builtin_amdgcn_update_dpp(0, c, 0x4E, 0xf, 0xf, false);
                            c += __builtin_amdgcn_update_dpp(0, c, 0x141, 0xf, 0xf, false);
                            if (c >= 16) T = cand; }
                        unsigned byte = 0u;
#pragma unroll
                        for (int k = 0; k < 8; ++k) byte |= (key[k] != 0u && key[k] >= T) ? (1u << k) : 0u;
                        ((LAS unsigned char*)SELM)[q * 8 + seg] = (unsigned char)byte;
                    }
                    __syncthreads();
#pragma unroll
                    for (int i = 0; i < 16; ++i) { STASH[i * 64] = oacc[0][i]; STASH[(16 + i) * 64] = oacc[1][i]; }
                    { float own[8], oth[8]; const float* cs = ROPE64 + row * 16; u32x4 w = __builtin_bit_cast(u32x4, qf[0]); unpack8(w, own);
#pragma unroll
                      for (int jj = 0; jj < 8; ++jj) oth[jj] = __shfl_xor(own[jj], 32);
#pragma unroll
                      for (int jj = 0; jj < 8; ++jj) own[jj] = h ? own[jj] * cs[jj] + oth[jj] * cs[8 + jj] : own[jj] * cs[jj] - oth[jj] * cs[8 + jj];
                      qf[0] = __builtin_bit_cast(bf16x8, pack8f(own)); }
                    const att::LpOff lpo = att::lp_offsets(lane, wave, C_WP * 2);
                    {
                        const unsigned long long mymask = SELM[ql]; const unsigned long long un0 = SELM[lane];
                        unsigned ul = (unsigned)un0, uh = (unsigned)(un0 >> 32);
#pragma unroll
                        for (int o = 1; o < 64; o <<= 1) { ul |= __shfl_xor(ul, o); uh |= __shfl_xor(uh, o); }
                        const unsigned ulo = (unsigned)__builtin_amdgcn_readfirstlane((int)ul), uhi = (unsigned)__builtin_amdgcn_readfirstlane((int)uh);
                        const unsigned long long U = ((unsigned long long)uhi << 32) | ulo;
                        if (wave == 0 && ((U >> lane) & 1ull)) TL[__builtin_amdgcn_mbcnt_hi(uhi, __builtin_amdgcn_mbcnt_lo(ulo, 0u))] = lane;
                        f32x16 oo[2]; float ll = 0.f;
#pragma unroll
                        for (int i = 0; i < 16; ++i) { oo[0][i] = 0.f; oo[1][i] = 0.f; }
                        const bf16_t* kbase = RAW + (size_t)b * SEQ * C_WP + 1536 + g * 64;
                        __syncthreads();
{ auto go_ = [&](auto hs_) { constexpr bool HS = decltype(hs_)::value;
                        att::kv_pipeline_dma2<0>(lds, __builtin_popcountll(U), wave, lane, qf, lpo,
                            [&](int tt, const bf16_t*& kb, size_t& kp, const bf16_t*& vb, size_t& vp) { const int sblk = __builtin_amdgcn_readfirstlane(TL[tt]); kb = kbase + (size_t)(64 * sblk) * C_WP; kp = C_WP; vb = kb + 256; vp = C_WP; },
                            [&](int tt, f32x16 (&p)[2], const LAS unsigned char* buf, const LAS unsigned char* nbuf, f32x16 (&pn)[2], int) { const int sblk = __builtin_amdgcn_readfirstlane(TL[tt]);
                                const bool sel = (mymask >> sblk) & 1ull; const int lim = t - 64 * sblk - 4 * h;
                                if (sblk == qt) att::fused_e<1, HS, LP_NSA>(oo, ll, p, buf, lane, sel, shiftS, [&](int koff) { return koff <= lim; }, 0u, 0u, qf, nbuf, pn, lpo);
                                else att::fused_e<0, HS, LP_NSA>(oo, ll, p, buf, lane, sel, shiftS, [](int) { return true; }, 0u, 0u, qf, nbuf, pn, lpo); },
                            att::NoXtra());
 }; if (shiftS == 0.f) go_(std::false_type{}); else go_(std::true_type{}); }
                        const float lt = ll + __shfl_xor(ll, 32); const float f = lt > 0.f ? GT[row * 48 + hd * 3 + 1] / lt : 0.f;
#pragma unroll
                        for (int i = 0; i < 16; ++i) { STASH[i * 64] += oo[0][i] * f; STASH[(16 + i) * 64] += oo[1][i] * f; }
                    }
                    {
                        const int tw0 = qt >= 8 ? qt - 8 : 0, ntw = qt - tw0 + 1;
                        f32x16 oo[2]; float ll = 0.f;
#pragma unroll
                        for (int i = 0; i < 16; ++i) { oo[0][i] = 0.f; oo[1][i] = 0.f; }
                        const bf16_t* kbase = RAW + (size_t)b * SEQ * C_WP + 2048 + g * 64;
{ auto go_ = [&](auto hs_) { constexpr bool HS = decltype(hs_)::value;
                        att::kv_pipeline_dma2<0>(lds, ntw, wave, lane, qf, lpo,
                            [&](int tt, const bf16_t*& kb, size_t& kp, const bf16_t*& vb, size_t& vp) { kb = kbase + (size_t)(64 * (tw0 + tt)) * C_WP; kp = C_WP; vb = kb + 256; vp = C_WP; },
                            [&](int tt, f32x16 (&p)[2], const LAS unsigned char* buf, const LAS unsigned char* nbuf, f32x16 (&pn)[2], int) { const int tw = tw0 + tt; const int d0 = t - 64 * tw - 4 * h;
                                if (tw == qt || (qt >= 8 && tw == qt - 8)) att::fused_e<1, HS, LP_NSA>(oo, ll, p, buf, lane, true, shiftW, [&](int koff) { const int dist = d0 - koff; return dist >= 0 && dist < 512; }, 0u, 0u, qf, nbuf, pn, lpo);
                                else att::fused_e<0, HS, LP_NSA>(oo, ll, p, buf, lane, true, shiftW, [](int) { return true; }, 0u, 0u, qf, nbuf, pn, lpo); },
                            att::NoXtra());
 }; if (shiftW == 0.f) go_(std::false_type{}); else go_(std::true_type{}); }
                        const float lt = ll + __shfl_xor(ll, 32); const float f = lt > 0.f ? GT[row * 48 + hd * 3 + 2] / lt : 0.f;
#pragma unroll
                        for (int i = 0; i < 16; ++i) { oo[0][i] = STASH[i * 64] + oo[0][i] * f; oo[1][i] = STASH[(16 + i) * 64] + oo[1][i] * f; }
#if defined(PROBE_NSA)
                        if (rep_ == 0)
#endif
                        att::store_o_t<64>(oo, 1.0f, OATT + ((size_t)b * SEQ + qt * 64 + qs * 32) * 1024 + hd * 64, 1024, lds + wave * 4608, lane);
                    }
                    __syncthreads();
                }
            }
            SEAM(pb + 3);
        }
        if (RUN(pb + 4)) for (int rep_ = 0; rep_ < REPS(pb + 4); ++rep_) {
            int lane = (int)__builtin_amdgcn_mbcnt_hi(~0u, __builtin_amdgcn_mbcnt_lo(~0u, 0u)); asm volatile("" : "+v"(lane)); const int tid = wave * 64 + lane;
            if (L == 0) {
                pg8::Gemm g{OATT, W_ABO, MTOK, DM, DM}; pg8::StaticOrder S; S.init(MTOK, DM, G, bid);
                pg8::EpiResid<false> E{out, XB, RSQ};
                pg8::gemm_phase<pg8::EpiResid<false>, pg8::StaticOrder, true, true>(lds, g, S, E, wave);
            }
            if (L == 1) {
                pg8::Gemm g{OATT, W_CO, MTOK, DM, DM}; pg8::StaticOrder S; S.init(MTOK, DM, G, bid);
                pg8::EpiResid<false> E{out, XB, RSQ};
                pg8::gemm_phase<pg8::EpiResid<false>, pg8::StaticOrder, true, true>(lds, g, S, E, wave);
            }
            SEAM(pb + 4);
        }
        if (RUN(pb + 5)) for (int rep_ = 0; rep_ < REPS(pb + 5); ++rep_) {
            int lane = (int)__builtin_amdgcn_mbcnt_hi(~0u, __builtin_amdgcn_mbcnt_lo(~0u, 0u)); asm volatile("" : "+v"(lane)); const int tid = wave * 64 + lane;
            pg8::Gemm g{XB, W_MQ + (size_t)L * 512 * DM, MTOK, 512, DM}; pg8::StaticOrder S; S.init(MTOK, 512, G, bid);
            pg8::EpiPlain E{MQB, 512};
            pg8::gemm_phase<pg8::EpiPlain, pg8::StaticOrder, true, true>(lds, g, S, E, wave);
            SEAM(pb + 5);
        }
        if (RUN(pb + 6)) for (int rep_ = 0; rep_ < REPS(pb + 6); ++rep_) {
            int lane = (int)__builtin_amdgcn_mbcnt_hi(~0u, __builtin_amdgcn_mbcnt_lo(~0u, 0u)); asm volatile("" : "+v"(lane)); const int tid = wave * 64 + lane;
            const float shiftM = [&] { float gq = 0.f, gk = 0.f; for (int i = 0; i < 128; ++i) { gq = fmaxf(gq, fabsf(mem_q_norm[L * 128 + i])); gk = fmaxf(gk, fabsf(mem_k_norm[L * 128 + i])); }
                                       const float B = 11.3137085f * LOG2E * gq * gk * 1.02f; return B > 60.f ? B - 60.f : 0.f; }();
            const int upb = (512 % G == 0) ? 512 / G : 0; int cur_pair = -1;
            for (int k = 0; ; ++k) {
                const int u = upb ? bid * upb + k : bid + k * G; if ((upb && k >= upb) || u >= BATCH * 4 * 16) break;
                const int b = u >> 6, hh = (u >> 4) & 3, qb = u & 15;
                const int r = lane & 31, h = lane >> 5;
                const int row = b * SEQ + qb * 256 + wave * 32 + r;
                if ((u >> 4) != cur_pair) { cur_pair = u >> 4;
                    __syncthreads();
                    const bf16_t* kbase = KVRAW + (size_t)(b * NMEM) * 2048 + L * 1024 + hh * 128;
#pragma unroll
                    for (int i = 0; i < 8; ++i) { const int idx = tid + 512 * i, rw = idx >> 4, c = idx & 15;
                        *(LAS u32x4*)(lds + rw * 272 + c * 16) = *(const u32x4*)(kbase + (size_t)rw * 2048 + c * 8);
                        *(LAS u32x4*)(lds + 69632 + rw * 320 + c * 16) = *(const u32x4*)(kbase + (size_t)rw * 2048 + 512 + c * 8); }
                    __syncthreads(); }
                const float rs = row_rstd(RSQ, row);
                bf16x8 qf[8]; float ssq = 0.f;
                const bf16_t* qrow = MQB + (size_t)row * 512 + hh * 128 + 8 * h;
#pragma unroll
                for (int s2 = 0; s2 < 8; ++s2) { qf[s2] = *(const bf16x8*)(qrow + 16 * s2);
#pragma unroll
                    for (int j = 0; j < 8; ++j) { const float f = bf2f((unsigned short)qf[s2][j]) * rs; ssq += f * f; } }
                ssq += __shfl_xor(ssq, 32);
                const float qs = rs * __builtin_amdgcn_rsqf(ssq * (1.0f / 128.0f) + RMS_EPS) * (0.08838834764831845f * LOG2E);
#pragma unroll
                for (int s2 = 0; s2 < 8; ++s2) { const float* gn = mem_q_norm + L * 128 + 16 * s2 + 8 * h; const f32x4 ga = *(const f32x4*)gn, gb = *(const f32x4*)(gn + 4); u32x4 w;
#pragma unroll
                    for (int j = 0; j < 4; ++j) { const float g0_ = j < 2 ? ga[2 * j] : gb[2 * j - 4], g1_ = j < 2 ? ga[2 * j + 1] : gb[2 * j - 3];
                        w[j] = pk2(bf2f((unsigned short)qf[s2][2 * j]) * qs * g0_, bf2f((unsigned short)qf[s2][2 * j + 1]) * qs * g1_); }
                    qf[s2] = __builtin_bit_cast(bf16x8, w); }
                f32x16 oo[4]; float ll = 0.f;
#pragma unroll
                for (int d = 0; d < 4; ++d)
#pragma unroll
                    for (int i = 0; i < 16; ++i) oo[d][i] = 0.f;
#pragma unroll 1
                for (int tt = 0; tt < 4; ++tt) {
                    f32x16 p[2]; att::tile_scores<128>(p, qf, lds + tt * 64 * 272, lane);
                    float ls = 0.f;
#pragma unroll
                    for (int kt = 0; kt < 2; ++kt)
#pragma unroll
                        for (int i = 0; i < 16; ++i) { const float e = __builtin_amdgcn_exp2f(p[kt][i] - shiftM); p[kt][i] = e; ls += e; }
                    ll += ls;
                    att::tile_pv<128>(oo, p, lds + 69632 + tt * 64 * 320 - att::Geo<128>::KB, lane); }
                const float lt = ll + __shfl_xor(ll, 32);
                att::store_o<128>(oo, 1.0f / lt, OMEM + (size_t)row * 512 + hh * 128, lane);
            }
            SEAM(pb + 6);
        }
        if (RUN(pb + 7)) for (int rep_ = 0; rep_ < REPS(pb + 7); ++rep_) {
            int lane = (int)__builtin_amdgcn_mbcnt_hi(~0u, __builtin_amdgcn_mbcnt_lo(~0u, 0u)); asm volatile("" : "+v"(lane)); const int tid = wave * 64 + lane;
            pg8::Gemm g{OMEM, W_MO + (size_t)L * DM * 512, MTOK, DM, 512}; pg8::StaticOrder S; S.init(MTOK, DM, G, bid);
            pg8::EpiResid<false> E{out, XB, RSQ};
            pg8::gemm_phase<pg8::EpiResid<false>, pg8::StaticOrder, true, true>(lds, g, S, E, wave);
            SEAM(pb + 7);
        }
        if (RUN(pb + 8)) for (int rep_ = 0; rep_ < REPS(pb + 8); ++rep_) {
            int lane = (int)__builtin_amdgcn_mbcnt_hi(~0u, __builtin_amdgcn_mbcnt_lo(~0u, 0u)); asm volatile("" : "+v"(lane)); const int tid = wave * 64 + lane;
            pg8::Gemm g{XB, W_FI + (size_t)L * 5632 * DM, MTOK, 5632, DM}; pg8::StaticOrder S; S.init(MTOK, 5632, G, bid);
            pg8::EpiSwiGLU E{RSQ, HID};
            pg8::gemm_phase<pg8::EpiSwiGLU, pg8::StaticOrder, true, true>(lds, g, S, E, wave);
#ifdef PROBE_DUP_FFN
            if (L == 0) { __syncthreads(); pg8::gemm_phase<pg8::EpiSwiGLU, pg8::StaticOrder, true, true>(lds, g, S, E, wave); }
#endif
            SEAM(pb + 8);
        }
        if (RUN(pb + 9)) for (int rep_ = 0; rep_ < REPS(pb + 9); ++rep_) {
            int lane = (int)__builtin_amdgcn_mbcnt_hi(~0u, __builtin_amdgcn_mbcnt_lo(~0u, 0u)); asm volatile("" : "+v"(lane)); const int tid = wave * 64 + lane;
            pg8::Gemm g{HID, W_FO + (size_t)L * DM * DFF, MTOK, DM, DFF}; pg8::StaticOrder S; S.init(MTOK, DM, G, bid);
            if (L == 0) { pg8::EpiResid<false> E{out, XB, RSQ}; pg8::gemm_phase<pg8::EpiResid<false>, pg8::StaticOrder, true, true>(lds, g, S, E, wave); }
            else { pg8::EpiResid<true> E{out, XB, RSQ}; pg8::gemm_phase<pg8::EpiResid<true>, pg8::StaticOrder, true, true>(lds, g, S, E, wave); }
            SEAM(pb + 9);
        }
}

__global__ void __launch_bounds__(NWAVES * 64, 2) fwd_kernel(Args args) {
    extern __shared__ __attribute__((aligned(16))) unsigned char lds_raw[];
    LAS unsigned char* lds = (LAS unsigned char*)(unsigned)__builtin_amdgcn_readfirstlane((int)(unsigned)(size_t)(LAS unsigned char*)lds_raw);
    volatile LAS unsigned* MISC = (volatile LAS unsigned*)(lds + LDS_MISC);
    const int tid = threadIdx.x, lane = tid & 63, wave = __builtin_amdgcn_readfirstlane(tid >> 6);
    const int G = gridDim.x, bid = blockIdx.x;
    unsigned* ctl = (unsigned*)(args.ws + WS_CTL);
    for (int u = tid; u < (LDS_BYTES - LDS_MISC) / 4; u += NWAVES * 64) ((LAS unsigned*)(lds + LDS_MISC))[u] = 0u;
    __syncthreads();
    XcdBarrier bar = xcd_barrier_post(ctl + CW_BAR + args.li * XCD_BAR_WORDS, MISC + 8);
    const int lo = args.ph_lo, hi = args.ph_hi;

    if (RUN(0)) for (int rep_ = 0; rep_ < REPS(0); ++rep_) {
        LAS float* scr = (LAS float*)(lds + wave * 16384);
        const int gw = bid * NWAVES + wave, NGW = G * NWAVES;
        constexpr int I_AB = 16 * (AB_WP / 32), I_C = 16 * (C_WP / 32), I_O = 16 * 32, I_MQ = 16 * 16, I_KV = 16 * 32, I_MO = 8 * 32, I_FI = 16 * (5632 / 32), I_FO = (DFF / 64) * 32;
        constexpr int NITEMS = I_AB + I_C + 2 * I_O + 2 * I_MQ + 2 * I_KV + 2 * I_MO + 2 * I_FI + 2 * I_FO;
        for (int it = gw; it < NITEMS; it += NGW) {
            int r = it;
            if (r < I_AB) { const int nbn = AB_WP / 32; transpose_item(ab_w_in, DM, AB_W, W_AB, norm_mix, scr, r / nbn, r % nbn, lane, CMapProj0{}); continue; } r -= I_AB;
            if (r < I_C) { const int nbn = C_WP / 32; transpose_item(nsa_w_in, DM, C_W, W_C, norm_mix + DM, scr, r / nbn, r % nbn, lane, CMapProj1{}); continue; } r -= I_C;
            if (r < I_O) { transpose_item(ab_w_out, DM, DM, W_ABO, nullptr, scr, r / 32, r % 32, lane, CMapId{DM}); continue; } r -= I_O;
            if (r < I_O) { transpose_item(nsa_w_out, DM, DM, W_CO, nullptr, scr, r / 32, r % 32, lane, CMapId{DM}); continue; } r -= I_O;
            if (r < 2 * I_MQ) { const int L = r / I_MQ; r %= I_MQ; transpose_item(mem_w_q + (size_t)L * DM * 512, DM, 512, W_MQ + (size_t)L * 512 * DM, norm_mem + L * DM, scr, r / 16, r % 16, lane, CMapId{512}); continue; } r -= 2 * I_MQ;
            if (r < 2 * I_KV) { const int L = r / I_KV; r %= I_KV; transpose_item(mem_w_kv + (size_t)L * DM * 1024, DM, 1024, W_KV + (size_t)L * 1024 * DM, norm_mem_src + L * DM, scr, r / 32, r % 32, lane, CMapId{1024}); continue; } r -= 2 * I_KV;
            if (r < 2 * I_MO) { const int L = r / I_MO; r %= I_MO; transpose_item(mem_w_o + (size_t)L * 512 * DM, 512, DM, W_MO + (size_t)L * DM * 512, nullptr, scr, r / 32, r % 32, lane, CMapId{DM}); continue; } r -= 2 * I_MO;
            if (r < 2 * I_FI) { const int L = r / I_FI; r %= I_FI; const int nbn = 5632 / 32; transpose_item(ffn_w_in + (size_t)L * DM * 5632, DM, 5632, W_FI + (size_t)L * 5632 * DM, norm_ffn + L * DM, scr, r / nbn, r % nbn, lane, CMapFfn{}); continue; } r -= 2 * I_FI;
            { const int L = r / I_FO; r %= I_FO; transpose_item(ffn_w_out + (size_t)L * DFF * DM, DFF, DM, W_FO + (size_t)L * DM * DFF, nullptr, scr, r / 32, r % 32, lane, CMapId{DM}); }
        }
        for (int m = gw; m < MTOK; m += 4 * NGW) {
            int mr[4]; f32x4 v[4][4]; float sq[4];
#pragma unroll
            for (int q = 0; q < 4; ++q) { mr[q] = m + q * NGW < MTOK ? m + q * NGW : m; const f32x4* xr = (const f32x4*)(x_in + (size_t)mr[q] * DM) + lane;
#pragma unroll
                for (int j = 0; j < 4; ++j) v[q][j] = xr[64 * j]; }
#pragma unroll
            for (int q = 0; q < 4; ++q) { float a = 0.f;
#pragma unroll
                for (int j = 0; j < 4; ++j) a += (v[q][j][0] * v[q][j][0] + v[q][j][1] * v[q][j][1]) + (v[q][j][2] * v[q][j][2] + v[q][j][3] * v[q][j][3]);
                sq[q] = a; }
#pragma unroll
            for (int o = 1; o < 64; o <<= 1) {
#pragma unroll
                for (int q = 0; q < 4; ++q) sq[q] += __shfl_xor(sq[q], o); }
#pragma unroll
            for (int q = 0; q < 4; ++q) { u32x2* xbr = (u32x2*)(XB + (size_t)mr[q] * DM) + lane;
#pragma unroll
                for (int j = 0; j < 4; ++j) { u32x2 w; w.x = pk2(v[q][j][0], v[q][j][1]); w.y = pk2(v[q][j][2], v[q][j][3]); xbr[64 * j] = w; }
                if (lane < 16) RSQ[(size_t)mr[q] * 16 + lane] = (lane == 0) ? sq[q] : 0.f; }
        }
        for (int i = bid * 512 + tid; i < MTOK * 12; i += G * 512) {
            const int m = i / 12, k = i % 12;
            const float f64t[8] = {1.0f, 0.19392274474868576f, 0.03760603093086393f, 0.007292664737217109f, 0.001414213562373095f, 0.0002742481756762073f, 5.318295896944988e-05f, 1.031338537721246e-05f};
            float fr;
            if (k < 8) fr = f64t[k]; else { const int q = k - 8; fr = (q == 0) ? 1.0f : (q == 1) ? 0.03760603093086393f : (q == 2) ? 0.001414213562373095f : 5.318295896944988e-05f; }
            const float ang = (float)positions[m] * fr;
            const double rev = (double)ang * 0.15915494309189535; const float frac = (float)(rev - __builtin_rint(rev));
            const float c = __builtin_amdgcn_cosf(frac), sn = __builtin_amdgcn_sinf(frac);
            if (k < 8) { ROPE64[(size_t)m * 16 + k] = c; ROPE64[(size_t)m * 16 + 8 + k] = sn; } else { ROPE32[(size_t)m * 8 + (k - 8)] = c; ROPE32[(size_t)m * 8 + 4 + (k - 8)] = sn; }
        }
        for (int it = gw; it < 128; it += NGW) { const int kv = it >> 6, r = it & 63;
            transpose_item(kv ? nsa_cmp_w1_v : nsa_cmp_w1_k, 2048, 64, W1T + (size_t)kv * 64 * 2048, nullptr, scr, r >> 1, r & 1, lane, CMapId{64}); }
        for (int it = (NGW - 1 - gw); it < 128; it += NGW) { const int kv = it >> 6, c = it & 63; const float* pe = kv ? nsa_cmp_pos_v : nsa_cmp_pos_k; const float* w1 = kv ? nsa_cmp_w1_v : nsa_cmp_w1_k;
            float a = 0.f;
            for (int k0 = 0; k0 < 2048; k0 += 512) { float pv[8], wv[8];
#pragma unroll
                for (int j = 0; j < 8; ++j) { const int k = k0 + 64 * j + lane; pv[j] = pe[k]; wv[j] = w1[(size_t)k * 64 + c]; }
#pragma unroll
                for (int j = 0; j < 8; ++j) a += pv[j] * wv[j]; }
            a = wave_sum(a); if (lane == 0) POSW1[kv * 64 + c] = a; }
        for (int m = gw; m < MMEM; m += NGW) {
            const f32x4* xr = (const f32x4*)(mem_in + (size_t)m * DM) + lane; f32x4 v[4]; float s = 0.f;
#pragma unroll
            for (int j = 0; j < 4; ++j) { v[j] = xr[64 * j]; s += (v[j][0] * v[j][0] + v[j][1] * v[j][1]) + (v[j][2] * v[j][2] + v[j][3] * v[j][3]); }
            s = wave_sum(s);
            u32x2* xbr = (u32x2*)(MEMB + (size_t)m * DM) + lane;
#pragma unroll
            for (int j = 0; j < 4; ++j) { u32x2 w; w.x = pk2(v[j][0], v[j][1]); w.y = pk2(v[j][2], v[j][3]); xbr[64 * j] = w; }
            if (lane == 0) MRS[m] = __builtin_amdgcn_rsqf(s * (1.0f / 1024.0f) + RMS_EPS);
        }
        SEAM(0);
    }

    layer_phases<0>(args, lds, bar, lo, hi, wave);
    layer_phases<1>(args, lds, bar, lo, hi, wave);
#undef RUN
#undef SEAM
}
#undef INF_
#undef x_in
#undef mem_in
#undef positions
#undef norm_mix
#undef norm_mem
#undef norm_mem_src
#undef norm_ffn
#undef ab_w_in
#undef ab_w_out
#undef nsa_w_in
#undef nsa_w_out
#undef mem_w_q
#undef mem_w_kv
#undef mem_w_o
#undef ffn_w_in
#undef ffn_w_out
#undef out
#undef WSB
#undef W_AB
#undef W_C
#undef W_ABO
#undef W_CO
#undef W_MQ
#undef W_KV
#undef W_MO
#undef W_FI
#undef W_FO
#undef XB
#undef RSQ
#undef HID
#undef MEMB
#undef KVRAW
#undef MRS
#undef MQB
#undef OMEM
#undef mem_q_norm
#undef RAW
#undef OATT
#undef ROPE64
#undef ROPE32
#undef W1T
#undef POSW1
#undef KCMP
#undef VCMP
#undef GT
#undef nsa_q_norm
#undef SCR
#undef BMK
#undef KMEAN
#undef IWB
#undef dsa_q_norm
#undef dsa_k_norm
#undef moba_q_norm
#undef moba_k_norm
#undef nsa_kcmp_norm
#undef nsa_ksel_norm
#undef nsa_kwin_norm
#undef nsa_cmp_pos_k
#undef nsa_cmp_pos_v
#undef nsa_cmp_w1_k
#undef nsa_cmp_w2_k
#undef nsa_cmp_w1_v
#undef nsa_cmp_w2_v
#undef mem_k_norm

extern "C" void kernel_launch(void* const* d_in, const int* in_sizes, int n_in, void* d_out, int out_size, void* d_ws, size_t ws_size, hipStream_t stream) {
    static int grid = 0;
    if (grid == 0) {
        if (n_in != 32 || out_size != MTOK * DM || ws_size < WS_END) { fprintf(stderr, "kernel_launch: unexpected shapes (n_in %d out %d ws %zu)\n", n_in, out_size, ws_size); grid = -1; return; }
        int dev = 0, cus = 0, per_cu = 0;
        if (hipGetDevice(&dev) != hipSuccess || hipDeviceGetAttribute(&cus, hipDeviceAttributeMultiprocessorCount, dev) != hipSuccess) { grid = -1; return; }
        if (hipFuncSetAttribute((const void*)fwd_kernel, hipFuncAttributeMaxDynamicSharedMemorySize, LDS_BYTES) != hipSuccess) { fprintf(stderr, "kernel_launch: hipFuncSetAttribute failed\n"); grid = -1; return; }
        if (hipOccupancyMaxActiveBlocksPerMultiprocessor(&per_cu, (const void*)fwd_kernel, NWAVES * 64, LDS_BYTES) != hipSuccess || per_cu < 1) fprintf(stderr, "kernel_launch: occupancy query says %d\n", per_cu);
        (void)hipGetLastError();
        grid = cus;
    }
    if (grid < 0) return;
    if (hipMemsetAsync((char*)d_ws + WS_CTL, 0, CTL_ZERO_BYTES, stream) != hipSuccess) return;
    Args a{};
    for (int i = 0; i < 32; ++i) a.in[i] = d_in[i];
    a.out = (float*)d_out; a.ws = (unsigned char*)d_ws; a.pad = 0;
    const int NPH = 21;
#if 0
    for (int p = 0; p < NPH; ++p) { a.ph_lo = p; a.ph_hi = p + 1; a.li = 0; hipLaunchKernelGGL(fwd_kernel, dim3(grid), dim3(NWAVES * 64), LDS_BYTES, stream, a); }
#else
    a.ph_lo = 0; a.ph_hi = NPH; a.li = 0; hipLaunchKernelGGL(fwd_kernel, dim3(grid), dim3(NWAVES * 64), LDS_BYTES, stream, a);
#endif
}
```

```cpp
#include <hip/hip_runtime.h>
#include <cstdio>
#include <cstdint>
#include <type_traits>

#define LAS __attribute__((address_space(3)))
#define GAS __attribute__((address_space(1)))
typedef unsigned short bf16_t;
typedef short bf16x8 __attribute__((ext_vector_type(8)));
typedef short s16x4 __attribute__((ext_vector_type(4)));
typedef float f32x4 __attribute__((ext_vector_type(4)));
typedef float f32x2 __attribute__((ext_vector_type(2)));
typedef float f32x16 __attribute__((ext_vector_type(16)));
typedef unsigned u32x4 __attribute__((ext_vector_type(4)));
typedef unsigned u32x2 __attribute__((ext_vector_type(2)));
typedef __bf16 bf16x2_t __attribute__((ext_vector_type(2)));

constexpr int BATCH = 8, SEQ = 4096, DM = 1024, MTOK = BATCH * SEQ;
constexpr int NMEM = 256, MMEM = BATCH * NMEM;
constexpr int DFF = 2816;
constexpr int AB_W = 2472, AB_WP = 2560;
constexpr int C_W = 2608, C_WP = 2816;
constexpr float RMS_EPS = 1e-6f;
constexpr float LOG2E = 1.4426950408889634f;

namespace pg8 {
constexpr int BM = 256, BK = 64, HALF = 128, HTB = HALF * BK * 2, STAGE_BYTES = 8 * HTB, NXCD = 8, WGM = 4;
__host__ __device__ __forceinline__ int lds_byte(int r, int c) { const int st = (r >> 4) * 2 + (c >> 5), rr = r & 15, cc = c & 31, ob = rr * 64 + cc * 2; return st * 1024 + (ob ^ (((ob >> 9) & 1) << 5)); }
__host__ __device__ __forceinline__ void stage_rc(int b, int& R, int& C) { const int st = b / 1024, sb = b % 1024, swz = sb ^ (((sb >> 9) & 1) << 5); R = (st >> 1) * 16 + swz / 64; C = (st & 1) * 32 + (swz % 64) / 2; }
__host__ __device__ __forceinline__ int perm32(int rho) { const int n = rho >> 4, i = rho & 15; return 8 * (i >> 2) + 4 * n + (i & 3); }
struct Unit { int pm, pn; };
struct Gemm { const bf16_t* A; const bf16_t* Bt; int M, N, K; };
struct StaticOrder {
    int nM, nN, nwg, G, c;
    __host__ __device__ void init(int M, int N, int G_, int c_) { nM = M / BM; nN = N / BM; nwg = nM * nN; G = G_; c = c_; }
    __host__ __device__ bool next(int i, Unit& u) const {
        const long L = (long)i * G + c; if (L >= nwg) return false;
        int wgid = (int)L; { const int q = nwg / NXCD, r = nwg % NXCD, xcd = wgid % NXCD, off = wgid / NXCD; wgid = (xcd < r ? xcd * (q + 1) : r * (q + 1) + (xcd - r) * q) + off; }
        const int nig = WGM * nN, gid = wgid / nig, fm = gid * WGM, gsz = (nM - fm) < WGM ? (nM - fm) : WGM;
        u.pm = fm + ((wgid % nig) % gsz); u.pn = (wgid % nig) / gsz; return true;
    }
    __device__ __forceinline__ void a_ready(const Unit&) const {}
    __device__ __forceinline__ void done(const Unit&) const {}
};
__device__ __forceinline__ unsigned cvt_pk_bf16(float lo, float hi) { unsigned r; asm volatile("v_cvt_pk_bf16_f32 %0, %1, %2" : "=v"(r) : "v"(lo), "v"(hi)); return r; }

struct EpiPlain {
    static constexpr bool PERM = true, AFTER_DRAIN = false, STAGE = false;
    bf16_t* O; int ldc;
    __device__ __forceinline__ void operator()(const f32x4 (&acc)[2][2][4][2], const Unit& u, int wr, int wc, int fr, int fq) const {
        const int row0 = u.pm * BM + wr * 64 + fr, col0 = u.pn * BM + wc * 32 + 8 * fq;
#pragma unroll
        for (int ai = 0; ai < 2; ++ai)
#pragma unroll
            for (int m = 0; m < 4; ++m) { bf16_t* rowp = O + (size_t)(row0 + ai * HALF + m * 16) * ldc + col0;
#pragma unroll
                for (int bj = 0; bj < 2; ++bj) { const f32x4 v0 = acc[ai][bj][m][0], v1 = acc[ai][bj][m][1];
                    u32x4 w; w.x = cvt_pk_bf16(v0[0], v0[1]); w.y = cvt_pk_bf16(v0[2], v0[3]); w.z = cvt_pk_bf16(v1[0], v1[1]); w.w = cvt_pk_bf16(v1[2], v1[3]);
                    *(u32x4*)(rowp + bj * HALF) = w; } }
    }
};
template <bool FINAL> struct EpiResid {
    static constexpr bool PERM = true, AFTER_DRAIN = false, STAGE = false;
    float* out; bf16_t* xb; float* rsq;
    __device__ __forceinline__ void operator()(const f32x4 (&acc)[2][2][4][2], const Unit& u, int wr, int wc, int fr, int fq) const {
        const int col0 = u.pn * BM + wc * 32 + 8 * fq;
#pragma unroll
        for (int ai = 0; ai < 2; ++ai) {
            u32x4 rb[4][2];
#pragma unroll
            for (int m = 0; m < 4; ++m)
#pragma unroll
                for (int bj = 0; bj < 2; ++bj) rb[m][bj] = *(const u32x4*)(xb + (size_t)(u.pm * BM + ai * HALF + wr * 64 + m * 16 + fr) * 1024 + col0 + bj * HALF);
#pragma unroll
            for (int m = 0; m < 4; ++m) { const int row = u.pm * BM + ai * HALF + wr * 64 + m * 16 + fr; const size_t off = (size_t)row * 1024 + col0; float ss = 0.f;
#pragma unroll
                for (int bj = 0; bj < 2; ++bj) { const size_t o = off + bj * HALF; const u32x4 r4 = rb[m][bj]; float v[8];
#pragma unroll
                    for (int k = 0; k < 4; ++k) { v[2 * k] = acc[ai][bj][m][k >> 1][(2 * k) & 3] + __builtin_bit_cast(float, r4[k] << 16); v[2 * k + 1] = acc[ai][bj][m][k >> 1][(2 * k + 1) & 3] + __builtin_bit_cast(float, r4[k] & 0xffff0000u); }
                    if (FINAL) { *(f32x4*)(out + o) = (f32x4){v[0], v[1], v[2], v[3]}; *(f32x4*)(out + o + 4) = (f32x4){v[4], v[5], v[6], v[7]}; }
                    else { u32x4 w; w.x = cvt_pk_bf16(v[0], v[1]); w.y = cvt_pk_bf16(v[2], v[3]); w.z = cvt_pk_bf16(v[4], v[5]); w.w = cvt_pk_bf16(v[6], v[7]); *(u32x4*)(xb + o) = w;
#pragma unroll
                        for (int k = 0; k < 4; ++k) { const float r0 = __builtin_bit_cast(float, w[k] << 16), r1 = __builtin_bit_cast(float, w[k] & 0xffff0000u); ss += r0 * r0 + r1 * r1; } } }
                if (!FINAL) { ss += __shfl_xor(ss, 16); ss += __shfl_xor(ss, 32);
                    if (fq == 0) rsq[(size_t)row * 16 + u.pn * 4 + wc] = ss; } }
            asm volatile("" ::: "memory");
        }
    }
};
struct EpiSwiGLU {
    static constexpr bool PERM = true, AFTER_DRAIN = false, STAGE = false;
    const float* rsq; bf16_t* hid;
    __device__ __forceinline__ void operator()(const f32x4 (&acc)[2][2][4][2], const Unit& u, int wr, int wc, int fr, int fq) const {
        const int col0 = u.pn * 128 + wc * 32 + 8 * fq;
        f32x4 pr[2][4];
#pragma unroll
        for (int ai = 0; ai < 2; ++ai)
#pragma unroll
            for (int m = 0; m < 4; ++m) pr[ai][m] = *(const f32x4*)(rsq + (size_t)(u.pm * BM + ai * HALF + wr * 64 + m * 16 + fr) * 16 + 4 * fq);
#pragma unroll
        for (int ai = 0; ai < 2; ++ai)
#pragma unroll
            for (int m = 0; m < 4; ++m) { const int row = u.pm * BM + ai * HALF + wr * 64 + m * 16 + fr;
                float ss = (pr[ai][m][0] + pr[ai][m][1]) + (pr[ai][m][2] + pr[ai][m][3]);
                ss += __shfl_xor(ss, 16); ss += __shfl_xor(ss, 32);
                const float c = __builtin_amdgcn_rsqf(ss * (1.0f / 1024.0f) + RMS_EPS);
                float h[8];
#pragma unroll
                for (int n = 0; n < 2; ++n)
#pragma unroll
                    for (int e = 0; e < 4; ++e) { const float g = acc[ai][0][m][n][e] * c, uu = acc[ai][1][m][n][e] * c;
                        const float sg = g * __builtin_amdgcn_rcpf(1.0f + __builtin_amdgcn_exp2f(-g * LOG2E)); h[n * 4 + e] = sg * uu; }
                u32x4 w; w.x = cvt_pk_bf16(h[0], h[1]); w.y = cvt_pk_bf16(h[2], h[3]); w.z = cvt_pk_bf16(h[4], h[5]); w.w = cvt_pk_bf16(h[6], h[7]);
                *(u32x4*)(hid + (size_t)row * DFF + col0) = w; }
    }
};

struct ProjUnit { int kind; const float* gain; float scale; bool rope; };
template <int L> struct EpiProj {
    static constexpr bool PERM = true, AFTER_DRAIN = false, STAGE = true;
    bf16_t* O; int ldc; const float* rsq; const float* rope64; const float* rope32; const float* g0; const float* g1; const float* g2; const float* g3; float* aux; LAS unsigned char* ldsb;
    static constexpr int ROPE_STG = STAGE_BYTES;
    __device__ __forceinline__ void stage(const Unit& u, int wid, int lane) const {
        int ln = (int)__builtin_amdgcn_mbcnt_hi(~0u, __builtin_amdgcn_mbcnt_lo(~0u, 0u)); asm volatile("" : "+v"(ln));
        const float* src = rope64 + ((size_t)u.pm * BM + 32 * wid) * 16 + ln * 4;
        __builtin_amdgcn_global_load_lds((const unsigned*)src, (LAS unsigned*)(ldsb + ROPE_STG + wid * 2048), 16, 0, 0);
        __builtin_amdgcn_global_load_lds((const unsigned*)(src + 256), (LAS unsigned*)(ldsb + ROPE_STG + wid * 2048 + 1024), 16, 0, 0);
    }
    __device__ __forceinline__ ProjUnit classify(int unit) const {
        constexpr float C2 = 0.125f * LOG2E;
        if (L == 0) {
            if (unit < 8) return {1, g0, C2, true}; if (unit == 8) return {1, g1, 1.f, true}; if (unit == 9) return {2, nullptr, 1.f, false};
            if (unit < 14) return {4, nullptr, 1.f, false}; if (unit == 14) return {5, nullptr, 1.f, false};
            if (unit < 23) return {1, g2, C2, true}; if (unit < 31) return {1, g3, 1.f, true}; if (unit < 39) return {2, nullptr, 1.f, false}; return {0, nullptr, 1.f, false};
        } else {
            if (unit < 16) return {1, g0, C2, false}; if (unit < 24) return {3, nullptr, 1.f, false};
            if (unit < 28) return {1, g1, 1.f, true}; if (unit < 32) return {2, nullptr, 1.f, false}; if (unit < 36) return {1, g2, 1.f, true}; if (unit < 40) return {2, nullptr, 1.f, false};
            if (unit == 40) return {6, nullptr, 1.f, false}; return {0, nullptr, 1.f, false};
        }
    }
    __device__ __forceinline__ void operator()(const f32x4 (&acc)[2][2][4][2], const Unit& u, int wr, int wc, int fr, int fq) const {
        const int unit = 4 * u.pn + wc; const ProjUnit pu = classify(unit);
        if (pu.kind == 0) return;
        const unsigned ropeb = (unsigned)(size_t)(ldsb + ROPE_STG) + (unsigned)(wr * 64 + fr) * 64u;
        float gl[2][8];
        if (pu.kind == 1) {
#pragma unroll
            for (int bj = 0; bj < 2; ++bj) { const f32x4 a = *(const f32x4*)(pu.gain + 8 * (2 * fq + bj)), b = *(const f32x4*)(pu.gain + 8 * (2 * fq + bj) + 4);
#pragma unroll
                for (int x = 0; x < 4; ++x) { gl[bj][x] = a[x] * pu.scale; gl[bj][4 + x] = b[x] * pu.scale; } }
        }
        float rsv[2][4];
        if (pu.kind != 3) { f32x4 pr[2][4];
#pragma unroll
            for (int ai = 0; ai < 2; ++ai)
#pragma unroll
                for (int m = 0; m < 4; ++m) pr[ai][m] = *(const f32x4*)(rsq + (size_t)(u.pm * BM + ai * HALF + wr * 64 + m * 16 + fr) * 16 + 4 * fq);
#pragma unroll
            for (int ai = 0; ai < 2; ++ai)
#pragma unroll
                for (int m = 0; m < 4; ++m) { float ss = (pr[ai][m][0] + pr[ai][m][1]) + (pr[ai][m][2] + pr[ai][m][3]); ss += __shfl_xor(ss, 16); ss += __shfl_xor(ss, 32);
                    rsv[ai][m] = __builtin_amdgcn_rsqf(ss * (1.0f / 1024.0f) + RMS_EPS); } }
        else {
#pragma unroll
            for (int ai = 0; ai < 2; ++ai)
#pragma unroll
                for (int m = 0; m < 4; ++m) rsv[ai][m] = 1.f; }
#pragma unroll
        for (int ai = 0; ai < 2; ++ai)
#pragma unroll
            for (int m = 0; m < 4; ++m) { const int row = u.pm * BM + ai * HALF + wr * 64 + m * 16 + fr;
                const float rs = rsv[ai][m];
                float v[2][8];
#pragma unroll
                for (int bj = 0; bj < 2; ++bj)
#pragma unroll
                    for (int e = 0; e < 8; ++e) v[bj][e] = acc[ai][bj][m][e >> 2][e & 3] * rs;
                if (pu.kind == 1) {
                    float ss = 0.f;
#pragma unroll
                    for (int bj = 0; bj < 2; ++bj)
#pragma unroll
                        for (int e = 0; e < 8; ++e) ss += v[bj][e] * v[bj][e];
                    ss += __shfl_xor(ss, 16); ss += __shfl_xor(ss, 32);
                    const float rn = __builtin_amdgcn_rsqf(ss * (1.0f / 64.0f) + RMS_EPS);
#pragma unroll
                    for (int bj = 0; bj < 2; ++bj)
#pragma unroll
                        for (int e = 0; e < 8; ++e) v[bj][e] = v[bj][e] * rn * gl[bj][e];
                    if (pu.rope && fq == 0) {
                        const LAS float* cs = (const LAS float*)(size_t)(ropeb + (ai * HALF + m * 16) * 64); const f32x4 c0 = *(const LAS f32x4*)cs, c1 = *(const LAS f32x4*)(cs + 4), s0 = *(const LAS f32x4*)(cs + 8), s1 = *(const LAS f32x4*)(cs + 12);
#pragma unroll
                        for (int e = 0; e < 8; ++e) { const float c = e < 4 ? c0[e & 3] : c1[e & 3], sn = e < 4 ? s0[e & 3] : s1[e & 3]; const float x1 = v[0][e], x2 = v[1][e];
                            v[0][e] = x1 * c - x2 * sn; v[1][e] = x2 * c + x1 * sn; }
                    }
                }
                if (pu.kind == 4 || pu.kind == 5) {
                    if (fq == 0 || (fq == 2 && pu.kind == 4)) { const LAS float* cs = (const LAS float*)(size_t)(ropeb + (ai * HALF + m * 16) * 64);
                        const f32x4 ca = *(const LAS f32x4*)cs, cb = *(const LAS f32x4*)(cs + 4), sa = *(const LAS f32x4*)(cs + 8), sb = *(const LAS f32x4*)(cs + 12);
                        const f32x4 c = {ca[0], ca[2], cb[0], cb[2]}, sn = {sa[0], sa[2], sb[0], sb[2]};
#pragma unroll
                        for (int x = 0; x < 4; ++x) { const float a = v[0][x], b = v[0][4 + x]; v[0][x] = a * c[x] - b * sn[x]; v[0][4 + x] = b * c[x] + a * sn[x]; } }
                    if (pu.kind == 5 && fq == 2) { *(f32x4*)(aux + (size_t)row * 8) = (f32x4){v[0][0], v[0][1], v[0][2], v[0][3]}; *(f32x4*)(aux + (size_t)row * 8 + 4) = (f32x4){v[0][4], v[0][5], v[0][6], v[0][7]}; }
                }
                if (pu.kind == 6) {
#pragma unroll
                    for (int bj = 0; bj < 2; ++bj) if (2 * fq + bj < 6) {
#pragma unroll
                        for (int e = 0; e < 8; ++e) v[bj][e] = __builtin_amdgcn_rcpf(1.0f + __builtin_amdgcn_exp2f(-v[bj][e] * LOG2E));
                        float* ap = aux + (size_t)row * 48 + 8 * (2 * fq + bj);
                        *(f32x4*)ap = (f32x4){v[bj][0], v[bj][1], v[bj][2], v[bj][3]}; *(f32x4*)(ap + 4) = (f32x4){v[bj][4], v[bj][5], v[bj][6], v[bj][7]}; }
                } else {
                    bf16_t* orow = O + (size_t)row * ldc + 64 * unit + 16 * fq;
                    u32x4 w0, w1;
                    w0.x = cvt_pk_bf16(v[0][0], v[0][1]); w0.y = cvt_pk_bf16(v[0][2], v[0][3]); w0.z = cvt_pk_bf16(v[0][4], v[0][5]); w0.w = cvt_pk_bf16(v[0][6], v[0][7]);
                    w1.x = cvt_pk_bf16(v[1][0], v[1][1]); w1.y = cvt_pk_bf16(v[1][2], v[1][3]); w1.z = cvt_pk_bf16(v[1][4], v[1][5]); w1.w = cvt_pk_bf16(v[1][6], v[1][7]);
                    *(u32x4*)orow = w0; *(u32x4*)(orow + 8) = w1;
                }
                if (m & 1) asm volatile("" ::: "memory"); }
    }
};

template <class Epi, class Sched, bool ALIGN_EPI = false, bool SP2 = false>
__device__ __forceinline__ void gemm_phase(LAS unsigned char* lds, const Gemm g, const Sched& S, const Epi& E, const int wave_id) {
    int tid = wave_id * 64 + (int)__builtin_amdgcn_mbcnt_hi(~0u, __builtin_amdgcn_mbcnt_lo(~0u, 0u)); asm volatile("" : "+v"(tid));
    const int wid = wave_id, lane = tid & 63, wr = wid >> 2, wc = wid & 3, fr = lane & 15, fq = lane >> 4;
    const int K = g.K, nt = K / BK;
    unsigned voffA[2], voffB[2];
#pragma unroll
    for (int i = 0; i < 2; ++i) { int R, C; stage_rc(tid * 16 + i * 8192, R, C); const int Rb = Epi::PERM ? ((R & ~31) + perm32(R & 31)) : R;
        voffA[i] = (unsigned)(R * K + C) * 2u; voffB[i] = (unsigned)(Rb * K + C) * 2u; }
    const size_t kstep = (size_t)(BK * 2);
    const size_t hstep = (size_t)HALF * K * 2;
    const size_t tstep = 2 * hstep;
    const unsigned ldsw = (unsigned)wid * 1024u;
    const int aoff = lds_byte(wr * 64 + fr, fq * 8), boff = lds_byte(wc * 32 + fr, fq * 8);
#define PG8_SA(b, h) (((b) * 2 + (h)) * HTB)
#define PG8_SB(b, h) ((4 + (b) * 2 + (h)) * HTB)
#define PG8_STAGE(bufoff, gbase, voff) do { _Pragma("unroll") for (int _i = 0; _i < 2; ++_i) \
        __builtin_amdgcn_global_load_lds((const unsigned*)((const char*)(gbase) + (voff)[_i]), (LAS unsigned*)(lds + (bufoff) + ldsw + _i * 8192), 16, 0, 0); } while (0)
#define PG8_LDA(dst, b, h) do { _Pragma("unroll") for (int m = 0; m < 4; ++m) _Pragma("unroll") for (int k = 0; k < 2; ++k) dst[m][k] = *(const LAS bf16x8*)(lds + PG8_SA(b, h) + aoff + m * 2048 + k * 1024); } while (0)
#define PG8_LDB(dst, b, h) do { _Pragma("unroll") for (int n = 0; n < 2; ++n) _Pragma("unroll") for (int k = 0; k < 2; ++k) dst[n][k] = *(const LAS bf16x8*)(lds + PG8_SB(b, h) + boff + n * 2048 + k * 1024); } while (0)
#define PG8_MMA(ai, bj, At, Bt) do { __builtin_amdgcn_s_setprio(1); _Pragma("unroll") for (int m = 0; m < 4; ++m) _Pragma("unroll") for (int n = 0; n < 2; ++n) _Pragma("unroll") for (int k = 0; k < 2; ++k) \
        acc[ai][bj][m][n] = __builtin_amdgcn_mfma_f32_16x16x32_bf16(Bt[n][k], At[m][k], acc[ai][bj][m][n], 0, 0, 0); __builtin_amdgcn_s_setprio(0); } while (0)
#define PG8_WAIT_V(n) asm volatile("s_waitcnt vmcnt(" #n ")" ::: "memory")
#define PG8_WAIT_L(n) asm volatile("s_waitcnt lgkmcnt(" #n ")" ::: "memory")
#define PG8_BAR __builtin_amdgcn_s_barrier()
#define PG8_SCHED __builtin_amdgcn_sched_barrier(0)
    Unit cur, nxt; int ui = 0;
    if (!S.next(0, cur)) return;
    f32x4 acc[2][2][4][2];
#pragma unroll
    for (int a = 0; a < 2; ++a)
#pragma unroll
        for (int b = 0; b < 2; ++b)
#pragma unroll
            for (int m = 0; m < 4; ++m)
#pragma unroll
                for (int n = 0; n < 2; ++n) acc[a][b][m][n] = (f32x4){0.f, 0.f, 0.f, 0.f};
    bf16x8 At[4][2], B0[2][2], B1[2][2];
    const char* cA = (const char*)g.A + (size_t)cur.pm * tstep; const char* cB = (const char*)g.Bt + (size_t)cur.pn * tstep;
    S.a_ready(cur);
    if constexpr (Epi::STAGE) E.stage(cur, wid, 0);
    if constexpr (SP2) {
        PG8_STAGE(PG8_SB(0, 0), cB, voffB); PG8_STAGE(PG8_SB(0, 1), cB + hstep, voffB); PG8_STAGE(PG8_SA(0, 0), cA, voffA); PG8_STAGE(PG8_SA(0, 1), cA + hstep, voffA);
        if (wr == 1) PG8_BAR;
        PG8_WAIT_V(2); PG8_BAR;
        PG8_STAGE(PG8_SB(1, 0), cB + kstep, voffB); PG8_STAGE(PG8_SA(1, 0), cA + kstep, voffA); PG8_STAGE(PG8_SB(1, 1), cB + hstep + kstep, voffB);
        PG8_WAIT_V(6); PG8_BAR;
    } else {
        PG8_STAGE(PG8_SB(0, 0), cB, voffB); PG8_STAGE(PG8_SA(0, 0), cA, voffA); PG8_STAGE(PG8_SB(0, 1), cB + hstep, voffB); PG8_STAGE(PG8_SA(0, 1), cA + hstep, voffA);
        if (wr == 1) PG8_BAR;
        PG8_WAIT_V(4); PG8_BAR;
        PG8_STAGE(PG8_SB(1, 0), cB + kstep, voffB); PG8_STAGE(PG8_SA(1, 0), cA + kstep, voffA); PG8_STAGE(PG8_SB(1, 1), cB + hstep + kstep, voffB);
        PG8_WAIT_V(6); PG8_BAR;
    }
    for (;;) {
        const bool has_next = S.next(ui + 1, nxt);
        const char* nA = has_next ? (const char*)g.A + (size_t)nxt.pm * tstep : cA; const char* nB = has_next ? (const char*)g.Bt + (size_t)nxt.pn * tstep : cB;
        for (int t = 0; t < nt; t += 2) {
            const bool last = (t == nt - 2);
            const char* a1 = cA + (size_t)(t + 1) * kstep;
            const char* a2 = last ? nA : cA + (size_t)(t + 2) * kstep; const char* b2 = last ? nB : cB + (size_t)(t + 2) * kstep;
            const char* a3 = a2 + kstep; const char* b3 = b2 + kstep;
            if (last && has_next) S.a_ready(nxt);
            if constexpr (SP2) {
            PG8_LDB(B0, 0, 0); PG8_LDB(B1, 0, 1); PG8_SCHED; PG8_LDA(At, 0, 0); PG8_STAGE(PG8_SA(1, 1), a1 + hstep, voffA);
            PG8_WAIT_V(8); PG8_WAIT_L(0); PG8_BAR; PG8_MMA(0, 0, At, B0); PG8_MMA(0, 1, At, B1); PG8_BAR; PG8_SCHED;
            PG8_LDA(At, 0, 1); PG8_STAGE(PG8_SB(0, 0), b2, voffB); PG8_STAGE(PG8_SB(0, 1), b2 + hstep, voffB); PG8_STAGE(PG8_SA(0, 0), a2, voffA);
            PG8_WAIT_V(8); PG8_WAIT_L(0); PG8_BAR; PG8_MMA(1, 0, At, B0); PG8_MMA(1, 1, At, B1); PG8_BAR; PG8_SCHED;
            PG8_LDB(B0, 1, 0); PG8_LDB(B1, 1, 1); PG8_SCHED; PG8_LDA(At, 1, 0); PG8_STAGE(PG8_SA(0, 1), a2 + hstep, voffA);
            PG8_WAIT_V(8); PG8_WAIT_L(0); PG8_BAR; PG8_MMA(0, 0, At, B0); PG8_MMA(0, 1, At, B1); PG8_BAR; PG8_SCHED;
            PG8_LDA(At, 1, 1); PG8_STAGE(PG8_SB(1, 0), b3, voffB); PG8_STAGE(PG8_SB(1, 1), b3 + hstep, voffB); PG8_STAGE(PG8_SA(1, 0), a3, voffA);
            PG8_WAIT_V(8); PG8_WAIT_L(0); PG8_BAR; PG8_MMA(1, 0, At, B0); PG8_MMA(1, 1, At, B1); PG8_BAR; PG8_SCHED;
            } else {
            PG8_LDB(B0, 0, 0); PG8_SCHED; PG8_LDA(At, 0, 0); PG8_STAGE(PG8_SA(1, 1), a1 + hstep, voffA);
            PG8_WAIT_L(8); PG8_BAR; PG8_WAIT_L(0); PG8_MMA(0, 0, At, B0); PG8_BAR; PG8_SCHED;
            PG8_LDB(B1, 0, 1); PG8_STAGE(PG8_SB(0, 0), b2, voffB);
            PG8_BAR; PG8_WAIT_L(0); PG8_MMA(0, 1, At, B1); PG8_BAR;
            PG8_LDA(At, 0, 1); PG8_STAGE(PG8_SA(0, 0), a2, voffA);
            PG8_BAR; PG8_WAIT_L(0); PG8_MMA(1, 0, At, B0); PG8_BAR; PG8_SCHED;
            PG8_STAGE(PG8_SB(0, 1), b2 + hstep, voffB);
            PG8_WAIT_V(6); PG8_BAR; PG8_MMA(1, 1, At, B1); PG8_BAR;
            PG8_LDB(B0, 1, 0); PG8_SCHED; PG8_LDA(At, 1, 0); PG8_STAGE(PG8_SA(0, 1), a2 + hstep, voffA);
            PG8_WAIT_L(8); PG8_BAR; PG8_WAIT_L(0); PG8_MMA(0, 0, At, B0); PG8_BAR; PG8_SCHED;
            PG8_LDB(B1, 1, 1); PG8_STAGE(PG8_SB(1, 0), b3, voffB);
            PG8_BAR; PG8_WAIT_L(0); PG8_MMA(0, 1, At, B1); PG8_BAR;
            PG8_LDA(At, 1, 1); PG8_STAGE(PG8_SA(1, 0), a3, voffA);
            PG8_BAR; PG8_WAIT_L(0); PG8_MMA(1, 0, At, B0); PG8_BAR; PG8_SCHED;
            PG8_STAGE(PG8_SB(1, 1), b3 + hstep, voffB);
            PG8_WAIT_V(6); PG8_BAR; PG8_MMA(1, 1, At, B1); PG8_BAR;
            }
        }
        if constexpr (ALIGN_EPI) { if (wr == 0) PG8_BAR; }
        if constexpr (!Epi::AFTER_DRAIN) { int l2 = (int)__builtin_amdgcn_mbcnt_hi(~0u, __builtin_amdgcn_mbcnt_lo(~0u, 0u)); asm volatile("" : "+v"(l2));
            E(acc, cur, wr, wc, l2 & 15, l2 >> 4); S.done(cur); }
        if (!has_next) break;
#pragma unroll
        for (int a = 0; a < 2; ++a)
#pragma unroll
            for (int b = 0; b < 2; ++b)
#pragma unroll
                for (int m = 0; m < 4; ++m)
#pragma unroll
                    for (int n = 0; n < 2; ++n) acc[a][b][m][n] = (f32x4){0.f, 0.f, 0.f, 0.f};
        cur = nxt; cA = nA; cB = nB; ++ui;
        if constexpr (Epi::STAGE) { PG8_BAR; E.stage(cur, wid, 0); }
        if constexpr (ALIGN_EPI) { if (wr == 1) PG8_BAR; }
    }
    PG8_WAIT_V(0);
    if constexpr (!ALIGN_EPI) { if (wr == 0) PG8_BAR; }
    PG8_BAR;
#undef PG8_SA
#undef PG8_SB
#undef PG8_STAGE
#undef PG8_LDA
#undef PG8_LDB
#undef PG8_MMA
#undef PG8_WAIT_V
#undef PG8_WAIT_L
#undef PG8_BAR
#undef PG8_SCHED
}
}

#define XB_TMO      128
#define XB_XCNT(j)  (256  + 64 * (j))
#define XB_XSUB(j)  (1280 + 64 * (j))
#define XB_XGEN(j)  (2304 + 64 * (j))
#define XB_TOP      3328
#define XB_TOPGEN   3392
#define XCD_BAR_WORDS 3456
#define XB_SPIN_CAP (1u << 18)
__device__ __forceinline__ unsigned xb_ld(unsigned* p)              { return __hip_atomic_load(p, __ATOMIC_RELAXED, __HIP_MEMORY_SCOPE_AGENT); }
__device__ __forceinline__ unsigned xb_add(unsigned* p, unsigned v) { return __hip_atomic_fetch_add(p, v, __ATOMIC_RELAXED, __HIP_MEMORY_SCOPE_AGENT); }
__device__ __forceinline__ unsigned xb_xcc_id() { return (unsigned)__builtin_amdgcn_s_getreg((3 << 11) | 20) & 0xFu; }
#define XB_SPIN(cond, bar) do { unsigned _sp = 0; while (cond) { __builtin_amdgcn_s_sleep(1); \
    if ((++_sp & 255u) == 0u) { if (xb_ld(&(bar)[XB_TMO])) break; if (_sp > XB_SPIN_CAP) { atomicAdd(&(bar)[XB_TMO], 1u); break; } } } } while (0)
struct XcdBarrier { unsigned* bar; unsigned x; volatile LAS unsigned* st; };
__device__ __forceinline__ XcdBarrier xcd_barrier_post(unsigned* bar, volatile LAS unsigned* st) {
    XcdBarrier b; b.bar = bar; b.x = xb_xcc_id(); b.st = st;
    if (threadIdx.x == 0) (void)xb_add(&bar[XB_XCNT(b.x)], 1u);
    return b;
}
__device__ __forceinline__ void xcd_barrier_complete(unsigned* bar, unsigned x, unsigned& nloc, unsigned& nx) {
    const unsigned G = gridDim.x * gridDim.y * gridDim.z;
    unsigned sum, cnt, mine, sp = 0u;
    for (;;) {
        sum = 0u; cnt = 0u; mine = 0u;
#pragma unroll
        for (unsigned j = 0; j < 16; ++j) { const unsigned c = xb_ld(&bar[XB_XCNT(j)]); sum += c; cnt += (c > 0u) ? 1u : 0u; mine = (j == x) ? c : mine; }
        if (sum == G) break;
        __builtin_amdgcn_s_sleep(1);
        if ((++sp & 255u) == 0u) { if (xb_ld(&bar[XB_TMO])) break; if (sp > XB_SPIN_CAP) { atomicAdd(&bar[XB_TMO], 1u); break; } }
    }
    nloc = mine > 0u ? mine : 1u; nx = cnt > 0u ? cnt : 1u;
}
__device__ __forceinline__ void xcd_barrier(const XcdBarrier& b) {
    asm volatile("s_waitcnt vmcnt(0)" ::: "memory");
    __syncthreads();
    if (threadIdx.x == 0) {
        unsigned* bar = b.bar;
        __builtin_amdgcn_s_waitcnt(0);
        unsigned nloc = b.st[0], nx = b.st[1];
        if (nloc == 0u) { xcd_barrier_complete(bar, b.x, nloc, nx); b.st[0] = nloc; b.st[1] = nx; }
        const unsigned old = xb_add(&bar[XB_XSUB(b.x)], 1u);
        const unsigned gen = old / nloc;
        if (old + 1u == (gen + 1u) * nloc) {
            __builtin_amdgcn_fence(__ATOMIC_RELEASE, "agent");
            asm volatile("s_waitcnt vmcnt(0)" ::: "memory");
            const unsigned og = xb_add(&bar[XB_TOP], 1u);
            const unsigned tg = og / nx;
            if (og + 1u == (tg + 1u) * nx) xb_add(&bar[XB_TOPGEN], 1u);
            else XB_SPIN(xb_ld(&bar[XB_TOPGEN]) == tg, bar);
            __builtin_amdgcn_fence(__ATOMIC_ACQUIRE, "agent");
            xb_add(&bar[XB_XGEN(b.x)], 1u);
            asm volatile("s_waitcnt vmcnt(0)" ::: "memory");
        } else {
            XB_SPIN(xb_ld(&bar[XB_XGEN(b.x)]) == gen, bar);
            __builtin_amdgcn_fence(__ATOMIC_ACQUIRE, "agent");
            asm volatile("s_waitcnt vmcnt(0)" ::: "memory");
        }
    }
    __syncthreads();
}

constexpr size_t MiB = 1u << 20;
constexpr size_t WS_CTL = 0, CTL_ZERO_BYTES = 1 * MiB;
constexpr int CW_BAR = 4096;
constexpr size_t WS_WAB = 1 * MiB;
constexpr size_t WS_WC = WS_WAB + (size_t)AB_WP * DM * 2;
constexpr size_t WS_WABO = WS_WC + (size_t)C_WP * DM * 2;
constexpr size_t WS_WCO = WS_WABO + (size_t)DM * DM * 2;
constexpr size_t WS_WMQ = WS_WCO + (size_t)DM * DM * 2;
constexpr size_t WS_WKV = WS_WMQ + (size_t)2 * 512 * DM * 2;
constexpr size_t WS_WMO = WS_WKV + (size_t)2048 * DM * 2;
constexpr size_t WS_WFI = WS_WMO + (size_t)2 * DM * 512 * 2;
constexpr size_t WS_WFO = WS_WFI + (size_t)2 * 5632 * DM * 2;
constexpr size_t WS_WEND = WS_WFO + (size_t)2 * DM * DFF * 2;
constexpr size_t WS_MISC = 64 * MiB;
static_assert(WS_WEND <= WS_MISC, "weights fit");
constexpr size_t WS_ROPE64 = WS_MISC;
constexpr size_t WS_ROPE32 = WS_ROPE64 + (size_t)MTOK * 16 * 4;
constexpr size_t WS_RSQ = WS_ROPE32 + (size_t)MTOK * 8 * 4;
constexpr size_t WS_MRS = WS_RSQ + (size_t)MTOK * 16 * 4;
constexpr size_t WS_MEMB = WS_MRS + 8192;
constexpr size_t WS_KVRAW = WS_MEMB + (size_t)MMEM * DM * 2;
constexpr size_t WS_W1T = WS_KVRAW + (size_t)MMEM * 2048 * 2;
constexpr size_t WS_POSW1 = WS_W1T + (size_t)2 * 64 * 2048 * 2;
constexpr size_t WS_KCMP = WS_POSW1 + 512;
constexpr size_t WS_VCMP = WS_KCMP + (size_t)BATCH * 4 * 256 * 64 * 2;
constexpr size_t WS_MISCEND = WS_VCMP + (size_t)BATCH * 4 * 256 * 64 * 2;
constexpr size_t WS_XB = 96 * MiB;
static_assert(WS_MISCEND <= WS_XB, "misc fits");
constexpr size_t WS_R1 = 160 * MiB;
constexpr size_t WS_OATT = 336 * MiB;
constexpr size_t WS_R3 = 400 * MiB;
constexpr size_t WS_GT = WS_R3;
constexpr size_t WS_MQ = WS_R3;
constexpr size_t WS_OMEM = WS_R3 + (size_t)MTOK * 512 * 2;
constexpr size_t WS_SC = WS_OATT;
constexpr size_t WS_BM = 464 * MiB;
constexpr size_t WS_KM = 480 * MiB;
constexpr size_t WS_ISG = 481 * MiB;
constexpr size_t WS_END = 512 * MiB;
static_assert(WS_R1 + (size_t)MTOK * C_WP * 2 <= WS_OATT, "R1 fits");

constexpr int LDS_BYTES = 155648;
constexpr int LDS_MISC = 151552;
constexpr int NWAVES = 8;

__device__ __forceinline__ unsigned f2bf(float f) { unsigned u = __builtin_bit_cast(unsigned, f); return (u + 0x7fffu + ((u >> 16) & 1u)) >> 16; }
__device__ __forceinline__ unsigned pk2(float lo, float hi) { f32x2 v = {lo, hi}; bf16x2_t b = __builtin_convertvector(v, bf16x2_t); return __builtin_bit_cast(unsigned, b); }
__device__ __forceinline__ float bf2f(unsigned short b) { return __builtin_bit_cast(float, (unsigned)b << 16); }
__device__ __forceinline__ float wave_sum(float v) {
#pragma unroll
    for (int o = 1; o < 64; o <<= 1) v += __shfl_xor(v, o);
    return v;
}


namespace att {
constexpr float NEG_INF = -__builtin_huge_valf();
template <int HD> struct Geo { static constexpr int PK = HD * 2 + 16, PV = (HD == 64 ? 192 : 320), KB = 64 * PK, VB = 64 * PV, BUF = KB + VB; };
template <int HD> struct State { f32x16 o[HD / 32]; float m, l;
    __device__ __forceinline__ void init() {
#pragma unroll
        for (int d = 0; d < HD / 32; ++d)
#pragma unroll
            for (int i = 0; i < 16; ++i) o[d][i] = 0.f;
        m = NEG_INF; l = 0.f; } };
template <int HD> struct TileRegs { u32x4 k[HD / 64], v[HD / 64]; };
template <int HD> __device__ __forceinline__ void load_tile(TileRegs<HD>& tr, const bf16_t* kb, size_t kp, const bf16_t* vb, size_t vp, int tid) {
#pragma unroll
    for (int i = 0; i < HD / 64; ++i) { const int idx = tid + 512 * i, row = idx / (HD / 8), c = idx % (HD / 8);
        tr.k[i] = *(const u32x4*)(kb + (size_t)row * kp + c * 8); tr.v[i] = *(const u32x4*)(vb + (size_t)row * vp + c * 8); }
}
template <int HD> __device__ __forceinline__ void store_tile(const TileRegs<HD>& tr, LAS unsigned char* buf, int tid) {
#pragma unroll
    for (int i = 0; i < HD / 64; ++i) { const int idx = tid + 512 * i, row = idx / (HD / 8), c = idx % (HD / 8);
        *(LAS u32x4*)(buf + row * Geo<HD>::PK + c * 16) = tr.k[i]; *(LAS u32x4*)(buf + Geo<HD>::KB + row * Geo<HD>::PV + c * 16) = tr.v[i]; }
}
__device__ __forceinline__ s16x4 tr_read(const LAS unsigned char* p) { typedef short v4i16_t __attribute__((ext_vector_type(4)));
    return __builtin_bit_cast(s16x4, __builtin_amdgcn_ds_read_tr16_b64_v4i16((LAS v4i16_t*)p)); }
__device__ __forceinline__ bf16x8 pack8(const f32x16& x, int s8) {
    u32x4 w; w.x = pk2(x[s8], x[s8 + 1]); w.y = pk2(x[s8 + 2], x[s8 + 3]); w.z = pk2(x[s8 + 4], x[s8 + 5]); w.w = pk2(x[s8 + 6], x[s8 + 7]); return __builtin_bit_cast(bf16x8, w); }
template <int HD> __device__ __forceinline__ void tile_scores(f32x16 (&p)[2], const bf16x8 (&qf)[HD / 16], const LAS unsigned char* buf, int lane) {
    const int r = lane & 31, h = lane >> 5;
#pragma unroll
    for (int kt = 0; kt < 2; ++kt) { f32x16 x;
#pragma unroll
        for (int i = 0; i < 16; ++i) x[i] = 0.f;
#pragma unroll
        for (int s = 0; s < HD / 16; ++s) { const bf16x8 kf = *(const LAS bf16x8*)(buf + (32 * kt + r) * Geo<HD>::PK + 32 * s + 16 * h); x = __builtin_amdgcn_mfma_f32_32x32x16_bf16(kf, qf[s], x, 0, 0, 0); }
        p[kt] = x; }
}
template <int HD> __device__ __forceinline__ void tile_pv(f32x16 (&o)[HD / 32], const f32x16 (&p)[2], const LAS unsigned char* buf, int lane) {
    const int h = lane >> 5, blk = (lane >> 4) & 1, q = (lane & 15) >> 2, pp = lane & 3;
    const LAS unsigned char* vb = buf + Geo<HD>::KB + (4 * h + q) * Geo<HD>::PV + 32 * blk + 8 * pp;
#pragma unroll
    for (int kt = 0; kt < 2; ++kt)
#pragma unroll
        for (int s = 0; s < 2; ++s) { const bf16x8 pb = pack8(p[kt], 8 * s);
#pragma unroll
            for (int dh = 0; dh < HD / 32; ++dh) { const LAS unsigned char* a = vb + (32 * kt + 16 * s) * Geo<HD>::PV + 64 * dh;
                const s16x4 lo = tr_read(a), hi = tr_read(a + 8 * Geo<HD>::PV);
                const bf16x8 vf = __builtin_shufflevector(lo, hi, 0, 1, 2, 3, 4, 5, 6, 7);
                o[dh] = __builtin_amdgcn_mfma_f32_32x32x16_bf16(vf, pb, o[dh], 0, 0, 0); } }
}
template <int HD, class MaskF> __device__ __forceinline__ void tile_step(State<HD>& st, const bf16x8 (&qf)[HD / 16], const LAS unsigned char* buf, int lane, MaskF valid) {
    f32x16 p[2]; tile_scores<HD>(p, qf, buf, lane);
    float mx = NEG_INF;
#pragma unroll
    for (int kt = 0; kt < 2; ++kt)
#pragma unroll
        for (int i = 0; i < 16; ++i) { const int koff = 32 * kt + (i & 3) + 8 * (i >> 2); const float v = valid(koff) ? p[kt][i] : NEG_INF; p[kt][i] = v; mx = fmaxf(mx, v); }
    mx = fmaxf(mx, __shfl_xor(mx, 32));
    const float mnew = fmaxf(st.m, mx), muse = (mnew == NEG_INF) ? 0.f : mnew;
    const float alpha = __builtin_amdgcn_exp2f(st.m - muse);
    float ls = 0.f;
#pragma unroll
    for (int kt = 0; kt < 2; ++kt)
#pragma unroll
        for (int i = 0; i < 16; ++i) { const float e = __builtin_amdgcn_exp2f(p[kt][i] - muse); p[kt][i] = e; ls += e; }
    st.l = st.l * alpha + ls; st.m = mnew;
#pragma unroll
    for (int dh = 0; dh < HD / 32; ++dh)
#pragma unroll
        for (int i = 0; i < 16; ++i) st.o[dh][i] *= alpha;
    tile_pv<HD>(st.o, p, buf, lane);
}
template <int HD, class SrcF, class CompF> __device__ __forceinline__ void kv_pipeline(LAS unsigned char* lds, int nt, int tid, SrcF src, CompF comp) {
    TileRegs<HD> tr; const bf16_t *kb, *vb; size_t kp, vp;
    __syncthreads();
    if (nt <= 0) return;
    src(0, kb, kp, vb, vp); load_tile<HD>(tr, kb, kp, vb, vp, tid); store_tile<HD>(tr, lds, tid);
    __syncthreads();
    for (int t = 0; t < nt; ++t) {
        if (t + 1 < nt) { src(t + 1, kb, kp, vb, vp); load_tile<HD>(tr, kb, kp, vb, vp, tid); }
        comp(t, lds + (t & 1) * Geo<HD>::BUF);
        if (t + 1 < nt) store_tile<HD>(tr, lds + ((t + 1) & 1) * Geo<HD>::BUF, tid);
        __syncthreads();
    }
}

template <int HD, bool PIPE, class SrcF, class ActF, class FinF> __device__ __forceinline__ void kv_pipeline3(LAS unsigned char* lds, int nt, int tid, int lane, const bf16x8 (&qf)[HD / 16], SrcF src, ActF act, FinF fin) {
    TileRegs<HD> tr; const bf16_t *kb, *vb; size_t kp, vp;
    __syncthreads();
    if (nt <= 0) return;
    src(0, kb, kp, vb, vp); load_tile<HD>(tr, kb, kp, vb, vp, tid); store_tile<HD>(tr, lds, tid);
    if (nt > 1) { src(1, kb, kp, vb, vp); load_tile<HD>(tr, kb, kp, vb, vp, tid); store_tile<HD>(tr, lds + Geo<HD>::BUF, tid); }
    __syncthreads();
    f32x16 pc[2], pn[2];
    if constexpr (PIPE) { if (act(0)) tile_scores<HD>(pc, qf, lds, lane); }
    int b0 = 0, b1 = 1, b2 = 2;
    for (int t = 0; t < nt; ++t) {
        if (t + 2 < nt) { src(t + 2, kb, kp, vb, vp); load_tile<HD>(tr, kb, kp, vb, vp, tid); }
        if constexpr (PIPE) {
            const bool an = (t + 1 < nt) && act(t + 1);
            if (an) tile_scores<HD>(pn, qf, lds + b1 * Geo<HD>::BUF, lane);
            if (act(t)) fin(t, pc, lds + b0 * Geo<HD>::BUF);
        } else {
            if (act(t)) { tile_scores<HD>(pc, qf, lds + b0 * Geo<HD>::BUF, lane); fin(t, pc, lds + b0 * Geo<HD>::BUF); }
        }
        if (t + 2 < nt) store_tile<HD>(tr, lds + b2 * Geo<HD>::BUF, tid);
        __syncthreads();
        if constexpr (PIPE) {
#pragma unroll
            for (int k = 0; k < 2; ++k) pc[k] = pn[k]; }
        const int tb = b0; b0 = b1; b1 = b2; b2 = tb;
    }
}
template <int HD, class MaskF> __device__ __forceinline__ void tile_finish(State<HD>& st, f32x16 (&p)[2], const LAS unsigned char* buf, int lane, bool lane_ok, bool elem, MaskF valid) {
    float mx = fmaxf(p[0][0], p[1][0]);
#pragma unroll
    for (int i = 1; i < 16; ++i) mx = fmaxf(mx, fmaxf(p[0][i], p[1][i]));
    mx = fmaxf(mx, __shfl_xor(mx, 32));
    if (__any(mx > st.m)) {
        const float mnew = fmaxf(st.m, mx), alpha = __builtin_amdgcn_exp2f(st.m - mnew);
        st.l *= alpha; st.m = mnew;
#pragma unroll
        for (int dh = 0; dh < HD / 32; ++dh)
#pragma unroll
            for (int i = 0; i < 16; ++i) st.o[dh][i] *= alpha;
    }
    const float sub = lane_ok ? st.m : __builtin_huge_valf();
#pragma unroll
    for (int kt = 0; kt < 2; ++kt)
#pragma unroll
        for (int i = 0; i < 16; ++i) p[kt][i] = __builtin_amdgcn_exp2f(p[kt][i] - sub);
    if (elem) {
#pragma unroll
        for (int kt = 0; kt < 2; ++kt)
#pragma unroll
            for (int i = 0; i < 16; ++i) { const int koff = 32 * kt + (i & 3) + 8 * (i >> 2); p[kt][i] = valid(koff) ? p[kt][i] : 0.f; }
    }
    float ls = 0.f;
#pragma unroll
    for (int i = 0; i < 16; ++i) ls += p[0][i] + p[1][i];
    st.l += ls;
    tile_pv<HD>(st.o, p, buf, lane);
}

template <int HD, bool ELEM, class MaskF> __device__ __forceinline__ void tile_fused(State<HD>& st, f32x16 (&p)[2], const LAS unsigned char* buf, int lane, bool lane_ok, MaskF valid,
                                                                                 const bf16x8 (&qf)[HD / 16], const LAS unsigned char* nbuf, f32x16 (&pn)[2]) {
    float mx = fmaxf(p[0][0], p[1][0]);
#pragma unroll
    for (int i = 1; i < 16; ++i) mx = fmaxf(mx, fmaxf(p[0][i], p[1][i]));
    mx = fmaxf(mx, __shfl_xor(mx, 32));
    if (__any(mx > st.m)) {
        const float mnew = fmaxf(st.m, mx), alpha = __builtin_amdgcn_exp2f(st.m - mnew);
        st.l *= alpha; st.m = mnew;
#pragma unroll
        for (int dh = 0; dh < HD / 32; ++dh)
#pragma unroll
            for (int i = 0; i < 16; ++i) st.o[dh][i] *= alpha;
    }
    const float sub = lane_ok ? st.m : __builtin_huge_valf();
    asm volatile("" : "+v"(lane));
    const int r = lane & 31, h = lane >> 5, blk = (lane >> 4) & 1, q4 = (lane & 15) >> 2, pp = lane & 3;
    const LAS unsigned char* kl = nbuf + r * Geo<HD>::PK + 16 * h;
    const LAS unsigned char* vl = buf + Geo<HD>::KB + (4 * h + q4) * Geo<HD>::PV + 32 * blk + 8 * pp;
#pragma unroll
    for (int i = 0; i < 16; ++i) { pn[0][i] = 0.f; pn[1][i] = 0.f; }
    float ls = 0.f;
#pragma unroll
    for (int c = 0; c < 4; ++c) {
        const int kt = c >> 1, s2 = c & 1;
#pragma unroll
        for (int ss = 0; ss < HD / 32; ++ss) { const int sk = (HD / 32) * s2 + ss; const bf16x8 kf = *(const LAS bf16x8*)(kl + (32 * kt) * Geo<HD>::PK + 32 * sk);
            pn[kt] = __builtin_amdgcn_mfma_f32_32x32x16_bf16(kf, qf[sk], pn[kt], 0, 0, 0); }
#pragma unroll
        for (int j = 0; j < 8; ++j) { const int i = 8 * s2 + j; float e = __builtin_amdgcn_exp2f(p[kt][i] - sub);
            if (ELEM) { const int koff = 32 * kt + (i & 3) + 8 * (i >> 2); e = valid(koff) ? e : 0.f; }
            p[kt][i] = e; ls += e; }
        const bf16x8 pb = pack8(p[kt], 8 * s2);
#pragma unroll
        for (int dh = 0; dh < HD / 32; ++dh) { const LAS unsigned char* a = vl + (32 * kt + 16 * s2) * Geo<HD>::PV + 64 * dh;
            const s16x4 lo = tr_read(a), hi = tr_read(a + 8 * Geo<HD>::PV);
            const bf16x8 vf = __builtin_shufflevector(lo, hi, 0, 1, 2, 3, 4, 5, 6, 7);
            st.o[dh] = __builtin_amdgcn_mfma_f32_32x32x16_bf16(vf, pb, st.o[dh], 0, 0, 0); }
        __builtin_amdgcn_sched_barrier(0);
    }
    st.l += ls;
}
struct NoPre { __device__ __forceinline__ void operator()(int) const {} };
template <int HD, class SrcF, class FinF, class PreF = NoPre> __device__ __forceinline__ void kv_pipeline4(LAS unsigned char* lds, int nt, int tid, int lane, const bf16x8 (&qf)[HD / 16], SrcF src, FinF fin, PreF pre = PreF()) {
    TileRegs<HD> tr; const bf16_t *kb, *vb; size_t kp, vp;
    __syncthreads();
    if (nt <= 0) return;
    src(0, kb, kp, vb, vp); load_tile<HD>(tr, kb, kp, vb, vp, tid); store_tile<HD>(tr, lds, tid);
    if (nt > 1) { src(1, kb, kp, vb, vp); load_tile<HD>(tr, kb, kp, vb, vp, tid); store_tile<HD>(tr, lds + Geo<HD>::BUF, tid); }
    __syncthreads();
    f32x16 pc[2], pn[2];
    tile_scores<HD>(pc, qf, lds, lane);
    int b0 = 0, b1 = 1, b2 = 2;
    for (int t = 0; t < nt; ++t) {
        pre(t + 1);
        if (t + 2 < nt) { src(t + 2, kb, kp, vb, vp); load_tile<HD>(tr, kb, kp, vb, vp, tid); }
        const int bn = (t + 1 < nt) ? b1 : b0;
        fin(t, pc, lds + b0 * Geo<HD>::BUF, lds + bn * Geo<HD>::BUF, pn);
        if (t + 2 < nt) store_tile<HD>(tr, lds + b2 * Geo<HD>::BUF, tid);
        __syncthreads();
#pragma unroll
        for (int k = 0; k < 2; ++k) pc[k] = pn[k];
        const int tb = b0; b0 = b1; b1 = b2; b2 = tb;
    }
}

constexpr int DBUF = 16384;
__device__ __forceinline__ void dma_tile(LAS unsigned char* buf, const bf16_t* kb, size_t kp, const bf16_t* vb, size_t vp, int wave, int lane) {
    const int row = 8 * wave + (lane >> 3), cp = lane & 7;
    const bf16_t* gk = kb + (size_t)row * kp + ((cp ^ ((row >> 1) & 7)) * 8);
    const bf16_t* gv = vb + (size_t)row * vp + ((cp ^ (4 * ((row >> 1) & 1))) * 8);
    __builtin_amdgcn_global_load_lds((const unsigned*)gk, (LAS unsigned*)(buf + wave * 1024), 16, 0, 0);
    __builtin_amdgcn_global_load_lds((const unsigned*)gv, (LAS unsigned*)(buf + 8192 + wave * 1024), 16, 0, 0);
}
__device__ __forceinline__ void dma_tile_o(LAS unsigned char* buf, const bf16_t* kb, const bf16_t* vb, unsigned gko, unsigned gvo, int wave) {
    __builtin_amdgcn_global_load_lds((const unsigned*)((const char*)kb + gko), (LAS unsigned*)(buf + wave * 1024), 16, 0, 0);
    __builtin_amdgcn_global_load_lds((const unsigned*)((const char*)vb + gvo), (LAS unsigned*)(buf + 8192 + wave * 1024), 16, 0, 0);
}
__device__ __forceinline__ void scores_d(f32x16 (&p)[2], const bf16x8 (&qf)[4], const LAS unsigned char* buf, int lane) {
    const int r = lane & 31, h = lane >> 5;
#pragma unroll
    for (int kt = 0; kt < 2; ++kt) { f32x16 x;
#pragma unroll
        for (int i = 0; i < 16; ++i) x[i] = 0.f;
        const int row = 32 * kt + r; const LAS unsigned char* kr = buf + row * 128; const int sw = (row >> 1) & 7;
#pragma unroll
        for (int s = 0; s < 4; ++s) { const bf16x8 kf = *(const LAS bf16x8*)(kr + (((2 * s + h) ^ sw) * 16)); x = __builtin_amdgcn_mfma_f32_32x32x16_bf16(kf, qf[s], x, 0, 0, 0); }
        p[kt] = x; }
}
template <bool ELEM, class MaskF> __device__ __forceinline__ void fused_d(State<64>& st, f32x16 (&p)[2], const LAS unsigned char* buf, int lane, bool lane_ok, MaskF valid,
                                                                        const bf16x8 (&qf)[4], const LAS unsigned char* nbuf, f32x16 (&pn)[2]) {
    float mx = fmaxf(p[0][0], p[1][0]);
#pragma unroll
    for (int i = 1; i < 16; ++i) mx = fmaxf(mx, fmaxf(p[0][i], p[1][i]));
    mx = fmaxf(mx, __shfl_xor(mx, 32));
    if (__any(mx > st.m)) {
        const float mnew = fmaxf(st.m, mx), alpha = __builtin_amdgcn_exp2f(st.m - mnew);
        st.l *= alpha; st.m = mnew;
#pragma unroll
        for (int dh = 0; dh < 2; ++dh)
#pragma unroll
            for (int i = 0; i < 16; ++i) st.o[dh][i] *= alpha;
    }
    const float sub = lane_ok ? st.m : __builtin_huge_valf();
    asm volatile("" : "+v"(lane));
    const int r = lane & 31, h = lane >> 5, blk = (lane >> 4) & 1, q4 = (lane & 15) >> 2, pp = lane & 3;
    const int ksw = (r >> 1) & 7;
    const LAS unsigned char* kl = nbuf + r * 128;
    const int vsw = 4 * ((q4 >> 1) & 1);
    const LAS unsigned char* vl = buf + 8192 + (4 * h + q4) * 128 + 8 * (pp & 1);
    const int vc0 = ((2 * blk + (pp >> 1)) ^ vsw) * 16, vc1 = ((4 + 2 * blk + (pp >> 1)) ^ vsw) * 16;
#pragma unroll
    for (int i = 0; i < 16; ++i) { pn[0][i] = 0.f; pn[1][i] = 0.f; }
    float ls = 0.f;
#pragma unroll
    for (int c = 0; c < 4; ++c) {
        const int kt = c >> 1, s2 = c & 1;
        s16x4 l0, h0, l1, h1;
        { const unsigned a0 = (unsigned)(size_t)(vl + (32 * kt + 16 * s2) * 128 + vc0), a1 = (unsigned)(size_t)(vl + (32 * kt + 16 * s2) * 128 + vc1);
          asm volatile("ds_read_b64_tr_b16 %0, %4\n\tds_read_b64_tr_b16 %1, %4 offset:1024\n\tds_read_b64_tr_b16 %2, %5\n\tds_read_b64_tr_b16 %3, %5 offset:1024"
                       : "=&v"(l0), "=&v"(h0), "=&v"(l1), "=&v"(h1) : "v"(a0), "v"(a1) : "memory"); }
#pragma unroll
        for (int ss = 0; ss < 2; ++ss) { const int sk = 2 * s2 + ss; const bf16x8 kf = *(const LAS bf16x8*)(kl + kt * 4096 + (((2 * sk + h) ^ ksw) * 16));
            pn[kt] = __builtin_amdgcn_mfma_f32_32x32x16_bf16(kf, qf[sk], pn[kt], 0, 0, 0); }
#pragma unroll
        for (int j = 0; j < 8; ++j) { const int i = 8 * s2 + j; float e = __builtin_amdgcn_exp2f(p[kt][i] - sub);
            if (ELEM) { const int koff = 32 * kt + (i & 3) + 8 * (i >> 2); e = valid(koff) ? e : 0.f; }
            p[kt][i] = e; ls += e; }
        const bf16x8 pb = pack8(p[kt], 8 * s2);
        asm volatile("s_waitcnt lgkmcnt(0)" ::: "memory"); __builtin_amdgcn_sched_barrier(0);
        st.o[0] = __builtin_amdgcn_mfma_f32_32x32x16_bf16(__builtin_shufflevector(l0, h0, 0, 1, 2, 3, 4, 5, 6, 7), pb, st.o[0], 0, 0, 0);
        st.o[1] = __builtin_amdgcn_mfma_f32_32x32x16_bf16(__builtin_shufflevector(l1, h1, 0, 1, 2, 3, 4, 5, 6, 7), pb, st.o[1], 0, 0, 0);
        __builtin_amdgcn_sched_barrier(0);
    }
    st.l += ls;
}
template <int XTRA, class SrcF, class FinF, class XtraF> __device__ __forceinline__ void kv_pipeline_dma(LAS unsigned char* lds, int nt, int wave, int lane, const bf16x8 (&qf)[4], SrcF src, FinF fin, XtraF xtra) {
    const bf16_t *kb, *vb; size_t kp, vp;
    asm volatile("s_waitcnt vmcnt(0) lgkmcnt(0)" ::: "memory"); __builtin_amdgcn_s_barrier();
    if (nt <= 0) return;
#pragma unroll
    for (int i = 0; i < 3; ++i) if (i < nt) { src(i, kb, kp, vb, vp); dma_tile(lds + i * DBUF, kb, kp, vb, vp, wave, lane); xtra(i, i); }
    if (nt >= 3) { if (XTRA) asm volatile("s_waitcnt vmcnt(3)" ::: "memory"); else asm volatile("s_waitcnt vmcnt(2)" ::: "memory"); }
    else asm volatile("s_waitcnt vmcnt(0)" ::: "memory");
    __builtin_amdgcn_s_barrier();
    f32x16 pc[2], pn[2];
    scores_d(pc, qf, lds, lane);
    for (int t = 0; t < nt; ++t) {
        if (t + 3 < nt) { src(t + 3, kb, kp, vb, vp); dma_tile(lds + ((t + 3) & 3) * DBUF, kb, kp, vb, vp, wave, lane); xtra(t + 3, (t + 3) & 3); }
        const int bn = (t + 1 < nt) ? ((t + 1) & 3) : (t & 3);
        fin(t, pc, lds + (t & 3) * DBUF, lds + bn * DBUF, pn, t & 3);
        if (t + 3 < nt) { if (XTRA) asm volatile("s_waitcnt vmcnt(3) lgkmcnt(0)" ::: "memory"); else asm volatile("s_waitcnt vmcnt(2) lgkmcnt(0)" ::: "memory"); }
        else asm volatile("s_waitcnt vmcnt(0) lgkmcnt(0)" ::: "memory");
        __builtin_amdgcn_s_barrier();
#pragma unroll
        for (int k = 0; k < 2; ++k) pc[k] = pn[k];
    }
}
struct NoXtra { __device__ __forceinline__ void operator()(int, int) const {} };

struct LpOff { unsigned k0, k1, v0, v1, gk, gv; };
__device__ __forceinline__ LpOff lp_offsets(int lane, int wave = 0, unsigned pitch_bytes = 0) {
    const int r = lane & 31, h = lane >> 5, blk = (lane >> 4) & 1, q4 = (lane & 15) >> 2, pp = lane & 3;
    const int ksw = (r >> 1) & 7, vsw = 4 * ((q4 >> 1) & 1);
    const unsigned vl = 8192 + (4 * h + q4) * 128 + 8 * (pp & 1);
    LpOff o; o.k0 = r * 128 + ((h ^ ksw) * 16); o.k1 = r * 128 + (((2 + h) ^ ksw) * 16);
    o.v0 = vl + ((2 * blk + (pp >> 1)) ^ vsw) * 16; o.v1 = vl + ((4 + 2 * blk + (pp >> 1)) ^ vsw) * 16;
    { const int row = 8 * wave + (lane >> 3), cp = lane & 7;
      o.gk = (unsigned)row * pitch_bytes + ((cp ^ ((row >> 1) & 7)) * 16); o.gv = (unsigned)row * pitch_bytes + ((cp ^ (4 * ((row >> 1) & 1))) * 16); }
    asm volatile("" : "+v"(o.k0), "+v"(o.k1), "+v"(o.v0), "+v"(o.v1), "+v"(o.gk), "+v"(o.gv));
    return o;
}
template <int MODE, bool HS, class MaskF> __device__ __forceinline__ void fused_np(f32x16 (&o)[2], float& l, const f32x16 (&p)[2], const LAS unsigned char* buf, int lane, bool lane_ok, float shift, MaskF valid, unsigned wlo, unsigned whi,
                                                                        const bf16x8 (&qf)[4], const LAS unsigned char* nbuf, f32x16 (&pn)[2], const LpOff& lo) {
    const unsigned nb = (unsigned)(size_t)nbuf, cb = (unsigned)(size_t)buf;
    const unsigned kA0 = nb + lo.k0, kA1 = nb + lo.k1, kB0 = kA0 ^ 64u, kB1 = kA1 ^ 64u;
    const unsigned vb0 = cb + lo.v0, vb1 = cb + lo.v1;
    const unsigned lmask = lane_ok ? 0xffffffffu : 0u;
    float ls = 0.f;
#pragma unroll
    for (int c = 0; c < 4; ++c) {
        const int kt = c >> 1, s2 = c & 1;
        s16x4 l0, h0, l1, h1;
        asm volatile("ds_read_b64_tr_b16 %0, %4 offset:%c6\n\tds_read_b64_tr_b16 %1, %4 offset:%c7\n\tds_read_b64_tr_b16 %2, %5 offset:%c6\n\tds_read_b64_tr_b16 %3, %5 offset:%c7"
                     : "=&v"(l0), "=&v"(h0), "=&v"(l1), "=&v"(h1) : "v"(vb0), "v"(vb1), "i"((32 * (c >> 1) + 16 * (c & 1)) * 128), "i"((32 * (c >> 1) + 16 * (c & 1)) * 128 + 1024) : "memory");
#pragma unroll
        for (int ss = 0; ss < 2; ++ss) { const int sk = 2 * s2 + ss; const bf16x8 kf = *(const LAS bf16x8*)(size_t)((sk == 0 ? kA0 : sk == 1 ? kA1 : sk == 2 ? kB0 : kB1) + kt * 4096);
            if (sk == 0) { f32x16 z;
#pragma unroll
                for (int i = 0; i < 16; ++i) z[i] = 0.f;
                pn[kt] = __builtin_amdgcn_mfma_f32_32x32x16_bf16(kf, qf[sk], z, 0, 0, 0); }
            else pn[kt] = __builtin_amdgcn_mfma_f32_32x32x16_bf16(kf, qf[sk], pn[kt], 0, 0, 0); }
        float e[8];
#pragma unroll
        for (int j = 0; j < 8; ++j) { const int i = 8 * s2 + j; const int koff = 32 * kt + (i & 3) + 8 * (i >> 2); float x = __builtin_amdgcn_exp2f(HS ? p[kt][i] - shift : p[kt][i]);
            if (MODE == 1) x = valid(koff) ? x : 0.f;
            if (MODE == 2) { int tb; asm("v_bfe_i32 %0, %1, %2, 1" : "=v"(tb) : "v"(kt ? whi : wlo), "n"(koff & 31)); x = __builtin_bit_cast(float, __builtin_bit_cast(unsigned, x) & (unsigned)tb); }
            e[j] = x; }
        u32x4 pw; pw.x = pk2(e[0], e[1]) & lmask; pw.y = pk2(e[2], e[3]) & lmask; pw.z = pk2(e[4], e[5]) & lmask; pw.w = pk2(e[6], e[7]) & lmask;
#pragma unroll
        for (int j = 0; j < 8; ++j) ls += lane_ok ? e[j] : 0.f;
        const bf16x8 pb = __builtin_bit_cast(bf16x8, pw);
        asm volatile("s_waitcnt lgkmcnt(0)" ::: "memory"); __builtin_amdgcn_sched_barrier(0);
        o[0] = __builtin_amdgcn_mfma_f32_32x32x16_bf16(__builtin_shufflevector(l0, h0, 0, 1, 2, 3, 4, 5, 6, 7), pb, o[0], 0, 0, 0);
        o[1] = __builtin_amdgcn_mfma_f32_32x32x16_bf16(__builtin_shufflevector(l1, h1, 0, 1, 2, 3, 4, 5, 6, 7), pb, o[1], 0, 0, 0);
        __builtin_amdgcn_sched_barrier(0);
    }
    l += ls;
}
template <int MODE, bool HS, class MaskF> __device__ __forceinline__ void fused_lp(f32x16 (&o)[2], float& l, const f32x16 (&p)[2], const LAS unsigned char* buf, int lane, bool lane_ok, float shift, MaskF valid, unsigned wlo, unsigned whi,
                                                                        const bf16x8 (&qf)[4], const LAS unsigned char* nbuf, f32x16 (&pn)[2], const LpOff& lo) {
    const unsigned nb = (unsigned)(size_t)nbuf, cb = (unsigned)(size_t)buf;
    const unsigned kA0 = nb + lo.k0, kA1 = nb + lo.k1, kB0 = kA0 ^ 64u, kB1 = kA1 ^ 64u;
    const unsigned vb0 = cb + lo.v0, vb1 = cb + lo.v1;
    const unsigned lmask = lane_ok ? 0xffffffffu : 0u;
    bf16x8 kf[2][2]; s16x4 vf[3][4]; bf16x8 pbp = {0, 0, 0, 0, 0, 0, 0, 0};
#define FE_ISSUE(c_, KS_, VS_) do { constexpr int kt_ = (c_) >> 1, s2_ = (c_) & 1; \
        asm volatile("ds_read_b128 %0, %6 offset:%c10\n\tds_read_b128 %1, %7 offset:%c10\n\tds_read_b64_tr_b16 %2, %8 offset:%c11\n\tds_read_b64_tr_b16 %3, %8 offset:%c12\n\tds_read_b64_tr_b16 %4, %9 offset:%c11\n\tds_read_b64_tr_b16 %5, %9 offset:%c12" \
                     : "=&v"(kf[KS_][0]), "=&v"(kf[KS_][1]), "=&v"(vf[VS_][0]), "=&v"(vf[VS_][1]), "=&v"(vf[VS_][2]), "=&v"(vf[VS_][3]) \
                     : "v"(s2_ ? kB0 : kA0), "v"(s2_ ? kB1 : kA1), "v"(vb0), "v"(vb1), "i"(kt_ * 4096), "i"((32 * kt_ + 16 * s2_) * 128), "i"((32 * kt_ + 16 * s2_) * 128 + 1024) : "memory"); } while (0)
    FE_ISSUE(0, 0, 0);
    float ls = 0.f;
#pragma unroll
    for (int c = 0; c < 4; ++c) {
        const int kt = c >> 1, s2 = c & 1, KS = c & 1, VS = c % 3, VP = (c + 2) % 3;
        asm volatile("s_waitcnt lgkmcnt(0)" ::: "memory"); __builtin_amdgcn_sched_barrier(0);
        if (c < 3) { if (c == 0) FE_ISSUE(1, 1, 1); else if (c == 1) FE_ISSUE(2, 0, 2); else FE_ISSUE(3, 1, 0); }
        if (s2 == 0) { f32x16 z;
#pragma unroll
            for (int i = 0; i < 16; ++i) z[i] = 0.f;
            pn[kt] = __builtin_amdgcn_mfma_f32_32x32x16_bf16(kf[KS][0], qf[0], z, 0, 0, 0); pn[kt] = __builtin_amdgcn_mfma_f32_32x32x16_bf16(kf[KS][1], qf[1], pn[kt], 0, 0, 0); }
        else { pn[kt] = __builtin_amdgcn_mfma_f32_32x32x16_bf16(kf[KS][0], qf[2], pn[kt], 0, 0, 0); pn[kt] = __builtin_amdgcn_mfma_f32_32x32x16_bf16(kf[KS][1], qf[3], pn[kt], 0, 0, 0); }
        if (c > 0) {
            o[0] = __builtin_amdgcn_mfma_f32_32x32x16_bf16(__builtin_shufflevector(vf[VP][0], vf[VP][1], 0, 1, 2, 3, 4, 5, 6, 7), pbp, o[0], 0, 0, 0);
            o[1] = __builtin_amdgcn_mfma_f32_32x32x16_bf16(__builtin_shufflevector(vf[VP][2], vf[VP][3], 0, 1, 2, 3, 4, 5, 6, 7), pbp, o[1], 0, 0, 0); }
        float e[8];
#pragma unroll
        for (int j = 0; j < 8; ++j) { const int i = 8 * s2 + j; const int koff = 32 * kt + (i & 3) + 8 * (i >> 2); float x = __builtin_amdgcn_exp2f(HS ? p[kt][i] - shift : p[kt][i]);
            if (MODE == 1) x = valid(koff) ? x : 0.f;
            if (MODE == 2) { int tb; asm("v_bfe_i32 %0, %1, %2, 1" : "=v"(tb) : "v"(kt ? whi : wlo), "n"(koff & 31)); x = __builtin_bit_cast(float, __builtin_bit_cast(unsigned, x) & (unsigned)tb); }
            e[j] = x; }
        u32x4 pw; pw.x = pk2(e[0], e[1]) & lmask; pw.y = pk2(e[2], e[3]) & lmask; pw.z = pk2(e[4], e[5]) & lmask; pw.w = pk2(e[6], e[7]) & lmask;
#pragma unroll
        for (int j = 0; j < 8; ++j) ls += lane_ok ? e[j] : 0.f;
#pragma unroll
        for (int g = 0; g < 4; ++g) { __builtin_amdgcn_sched_group_barrier(0x008, 1, 0); __builtin_amdgcn_sched_group_barrier(0x002, 9, 0); }
        __builtin_amdgcn_sched_barrier(0);
        pbp = __builtin_bit_cast(bf16x8, pw);
    }
    o[0] = __builtin_amdgcn_mfma_f32_32x32x16_bf16(__builtin_shufflevector(vf[0][0], vf[0][1], 0, 1, 2, 3, 4, 5, 6, 7), pbp, o[0], 0, 0, 0);
    o[1] = __builtin_amdgcn_mfma_f32_32x32x16_bf16(__builtin_shufflevector(vf[0][2], vf[0][3], 0, 1, 2, 3, 4, 5, 6, 7), pbp, o[1], 0, 0, 0);
#undef FE_ISSUE
    l += ls;
}
template <int MODE, bool HS, bool LP, class MaskF> __device__ __forceinline__ void fused_e(f32x16 (&o)[2], float& l, const f32x16 (&p)[2], const LAS unsigned char* buf, int lane, bool lane_ok, float shift, MaskF valid, unsigned wlo, unsigned whi,
                                                                        const bf16x8 (&qf)[4], const LAS unsigned char* nbuf, f32x16 (&pn)[2], const LpOff& lo = LpOff{}) {
    if constexpr (LP) fused_lp<MODE, HS>(o, l, p, buf, lane, lane_ok, shift, valid, wlo, whi, qf, nbuf, pn, lo); else fused_np<MODE, HS>(o, l, p, buf, lane, lane_ok, shift, valid, wlo, whi, qf, nbuf, pn, lo);
}
template <int XTRA, class SrcF, class FinF, class XtraF> __device__ __forceinline__ void kv_pipeline_dma2(LAS unsigned char* lds, int nt, int wave, int lane, const bf16x8 (&qf)[4], const LpOff& lo, SrcF src, FinF fin, XtraF xtra) {
    const bf16_t *kb, *vb; size_t kp, vp;
    asm volatile("s_waitcnt vmcnt(0) lgkmcnt(0)" ::: "memory"); __builtin_amdgcn_s_barrier();
    if (nt <= 0) return;
#pragma unroll
    for (int i = 0; i < 3; ++i) if (i < nt) { src(i, kb, kp, vb, vp); dma_tile_o(lds + i * DBUF, kb, vb, lo.gk, lo.gv, wave); xtra(i, i); }
    if (nt >= 3) { if (XTRA) asm volatile("s_waitcnt vmcnt(3)" ::: "memory"); else asm volatile("s_waitcnt vmcnt(2)" ::: "memory"); }
    else asm volatile("s_waitcnt vmcnt(0)" ::: "memory");
    __builtin_amdgcn_s_barrier();
    f32x16 pa[2], pb[2];
    scores_d(pa, qf, lds, lane);
#define KVD2_STEP(PC, PN) do { \
        if (t + 3 < nt) { src(t + 3, kb, kp, vb, vp); dma_tile_o(lds + ((t + 3) & 3) * DBUF, kb, vb, lo.gk, lo.gv, wave); xtra(t + 3, (t + 3) & 3); } \
        const int bn_ = (t + 1 < nt) ? ((t + 1) & 3) : (t & 3); \
        fin(t, PC, lds + (t & 3) * DBUF, lds + bn_ * DBUF, PN, t & 3); \
        if (t + 3 < nt) { if (XTRA) asm volatile("s_waitcnt vmcnt(3) lgkmcnt(0)" ::: "memory"); else asm volatile("s_waitcnt vmcnt(2) lgkmcnt(0)" ::: "memory"); } \
        else asm volatile("s_waitcnt vmcnt(0) lgkmcnt(0)" ::: "memory"); \
        __builtin_amdgcn_s_barrier(); ++t; } while (0)
    int t = 0;
    while (t < nt) { KVD2_STEP(pa, pb); if (t >= nt) break; KVD2_STEP(pb, pa); }
#undef KVD2_STEP
}
__device__ __forceinline__ float gain_max64(const float* g) { float m = 0.f; for (int i = 0; i < 64; ++i) m = fmaxf(m, fabsf(g[i])); return m; }
__device__ __forceinline__ float softmax_shift(float gq, float gk) { const float B = 8.0f * LOG2E * gq * gk * 1.02f; return B > 60.f ? B - 60.f : 0.f; }

template <int MODE, bool HS, class MaskF> __device__ __forceinline__ void half_v(u32x4 (&pw)[4], float& l, const f32x16 (&p)[2], bool lane_ok, float shift, MaskF valid, unsigned wlo, unsigned whi) {
    const unsigned lmask = lane_ok ? 0xffffffffu : 0u; float ls = 0.f;
#pragma unroll
    for (int c = 0; c < 4; ++c) { const int kt = c >> 1, s2 = c & 1; float e[8];
#pragma unroll
        for (int j = 0; j < 8; ++j) { const int i = 8 * s2 + j; const int koff = 32 * kt + (i & 3) + 8 * (i >> 2); float x = __builtin_amdgcn_exp2f(HS ? p[kt][i] - shift : p[kt][i]);
            if (MODE == 1) x = valid(koff) ? x : 0.f;
            if (MODE == 2) { int tb; asm("v_bfe_i32 %0, %1, %2, 1" : "=v"(tb) : "v"(kt ? whi : wlo), "n"(koff & 31)); x = __builtin_bit_cast(float, __builtin_bit_cast(unsigned, x) & (unsigned)tb); }
            e[j] = x; ls += x; }
        pw[c].x = pk2(e[0], e[1]) & lmask; pw[c].y = pk2(e[2], e[3]) & lmask; pw[c].z = pk2(e[4], e[5]) & lmask; pw[c].w = pk2(e[6], e[7]) & lmask; }
    l += lane_ok ? ls : 0.f;
}
__device__ __forceinline__ void half_m(f32x16 (&o)[2], const u32x4 (&pw)[4], const LAS unsigned char* buf, const LAS unsigned char* nbuf, const bf16x8 (&qf)[4], f32x16 (&pn)[2], bool do_scores, int lane) {
    asm volatile("" : "+v"(lane));
    const int r = lane & 31, h = lane >> 5, blk = (lane >> 4) & 1, q4 = (lane & 15) >> 2, pp = lane & 3;
    const int ksw = (r >> 1) & 7;
    const unsigned kl = (unsigned)(size_t)(nbuf + r * 128);
    const unsigned kx0 = ((h ^ ksw) * 16), kx1 = (((2 + h) ^ ksw) * 16);
    const unsigned kA0 = kl + kx0, kA1 = kl + kx1, kB0 = kl + (kx0 ^ 64u), kB1 = kl + (kx1 ^ 64u);
    const int vsw = 4 * ((q4 >> 1) & 1);
    const unsigned vl = (unsigned)(size_t)(buf + 8192 + (4 * h + q4) * 128 + 8 * (pp & 1));
    const unsigned vb0 = vl + ((2 * blk + (pp >> 1)) ^ vsw) * 16, vb1 = vl + ((4 + 2 * blk + (pp >> 1)) ^ vsw) * 16;
    bf16x8 kf[8]; s16x4 vf[16];
    if (do_scores) {
        asm volatile("ds_read_b128 %0, %8\n\tds_read_b128 %1, %9\n\tds_read_b128 %2, %10\n\tds_read_b128 %3, %11\n\tds_read_b128 %4, %8 offset:4096\n\tds_read_b128 %5, %9 offset:4096\n\tds_read_b128 %6, %10 offset:4096\n\tds_read_b128 %7, %11 offset:4096"
                     : "=&v"(kf[0]), "=&v"(kf[1]), "=&v"(kf[2]), "=&v"(kf[3]), "=&v"(kf[4]), "=&v"(kf[5]), "=&v"(kf[6]), "=&v"(kf[7]) : "v"(kA0), "v"(kA1), "v"(kB0), "v"(kB1) : "memory");
    }
#define HM_V(c_) asm volatile("ds_read_b64_tr_b16 %0, %4 offset:%c6\n\tds_read_b64_tr_b16 %1, %4 offset:%c7\n\tds_read_b64_tr_b16 %2, %5 offset:%c6\n\tds_read_b64_tr_b16 %3, %5 offset:%c7" \
                     : "=&v"(vf[4 * (c_)]), "=&v"(vf[4 * (c_) + 1]), "=&v"(vf[4 * (c_) + 2]), "=&v"(vf[4 * (c_) + 3]) : "v"(vb0), "v"(vb1), "i"((32 * ((c_) >> 1) + 16 * ((c_) & 1)) * 128), "i"((32 * ((c_) >> 1) + 16 * ((c_) & 1)) * 128 + 1024) : "memory")
    asm volatile("s_waitcnt lgkmcnt(0)" ::: "memory"); __builtin_amdgcn_sched_barrier(0);
    HM_V(0); HM_V(1); HM_V(2); HM_V(3);
#undef HM_V
    if (do_scores) {
#pragma unroll
        for (int kt = 0; kt < 2; ++kt) { f32x16 z;
#pragma unroll
            for (int i = 0; i < 16; ++i) z[i] = 0.f;
            z = __builtin_amdgcn_mfma_f32_32x32x16_bf16(kf[4 * kt + 0], qf[0], z, 0, 0, 0);
            z = __builtin_amdgcn_mfma_f32_32x32x16_bf16(kf[4 * kt + 1], qf[1], z, 0, 0, 0);
            z = __builtin_amdgcn_mfma_f32_32x32x16_bf16(kf[4 * kt + 2], qf[2], z, 0, 0, 0);
            z = __builtin_amdgcn_mfma_f32_32x32x16_bf16(kf[4 * kt + 3], qf[3], z, 0, 0, 0);
            pn[kt] = z; }
    }
    asm volatile("s_waitcnt lgkmcnt(0)" ::: "memory"); __builtin_amdgcn_sched_barrier(0);
#pragma unroll
    for (int c = 0; c < 4; ++c) { const bf16x8 pb = __builtin_bit_cast(bf16x8, pw[c]);
        o[0] = __builtin_amdgcn_mfma_f32_32x32x16_bf16(__builtin_shufflevector(vf[4 * c], vf[4 * c + 1], 0, 1, 2, 3, 4, 5, 6, 7), pb, o[0], 0, 0, 0);
        o[1] = __builtin_amdgcn_mfma_f32_32x32x16_bf16(__builtin_shufflevector(vf[4 * c + 2], vf[4 * c + 3], 0, 1, 2, 3, 4, 5, 6, 7), pb, o[1], 0, 0, 0); }
}
template <int XTRA, class SrcF, class VF, class XtraF> __device__ __forceinline__ void kv_pipeline_ab(LAS unsigned char* lds, int nt, int wave, int lane, const bf16x8 (&qf)[4], f32x16 (&o)[2], SrcF src, VF vhalf, XtraF xtra) {
    const bf16_t *kb, *vb; size_t kp, vp;
    asm volatile("s_waitcnt vmcnt(0) lgkmcnt(0)" ::: "memory"); __builtin_amdgcn_s_barrier();
    if (nt <= 0) return;
#pragma unroll
    for (int i = 0; i < 3; ++i) if (i < nt) { src(i, kb, kp, vb, vp); dma_tile(lds + i * DBUF, kb, kp, vb, vp, wave, lane); xtra(i, i); }
    if (nt >= 3) { if (XTRA) asm volatile("s_waitcnt vmcnt(3)" ::: "memory"); else asm volatile("s_waitcnt vmcnt(2)" ::: "memory"); }
    else asm volatile("s_waitcnt vmcnt(0)" ::: "memory");
    __builtin_amdgcn_s_barrier();
    f32x16 pc[2]; scores_d(pc, qf, lds, lane);
    asm volatile("s_waitcnt lgkmcnt(0)" ::: "memory");
    const bool grpB = (wave & 4) != 0;
    if (grpB) __builtin_amdgcn_s_barrier();
    u32x4 pw[4];
    for (int t = 0; t < nt; ++t) {
        vhalf(t, pc, pw, t & 3);
        asm volatile("s_waitcnt lgkmcnt(0)" ::: "memory"); __builtin_amdgcn_s_barrier();
        if (t + 3 < nt) { src(t + 3, kb, kp, vb, vp); dma_tile(lds + ((t + 3) & 3) * DBUF, kb, kp, vb, vp, wave, lane); xtra(t + 3, (t + 3) & 3); }
        half_m(o, pw, lds + (t & 3) * DBUF, lds + ((t + 1) & 3) * DBUF, qf, pc, t + 1 < nt, lane);
        if (t + 3 < nt) { if (XTRA) asm volatile("s_waitcnt vmcnt(3) lgkmcnt(0)" ::: "memory"); else asm volatile("s_waitcnt vmcnt(2) lgkmcnt(0)" ::: "memory"); }
        else asm volatile("s_waitcnt vmcnt(0) lgkmcnt(0)" ::: "memory");
        __builtin_amdgcn_s_barrier();
    }
    if (!grpB) __builtin_amdgcn_s_barrier();
}

template <int XTRA, class SrcF, class FinF, class XtraF> __device__ __forceinline__ void kv_pipeline_dma8(LAS unsigned char* lds, int nt, int wave, int lane, const bf16x8 (&qf)[4], const LpOff& lo, SrcF src, FinF fin, XtraF xtra) {
    const bf16_t *kb, *vb; size_t kp, vp;
    asm volatile("s_waitcnt vmcnt(0) lgkmcnt(0)" ::: "memory"); __builtin_amdgcn_s_barrier();
    if (nt <= 0) return;
#define KV8_WAIT(n_) do { const int na_ = (n_); \
        if (XTRA) { if (na_ >= 3) asm volatile("s_waitcnt vmcnt(9) lgkmcnt(0)" ::: "memory"); else if (na_ == 2) asm volatile("s_waitcnt vmcnt(6) lgkmcnt(0)" ::: "memory"); else if (na_ == 1) asm volatile("s_waitcnt vmcnt(3) lgkmcnt(0)" ::: "memory"); else asm volatile("s_waitcnt vmcnt(0) lgkmcnt(0)" ::: "memory"); } \
        else { if (na_ >= 3) asm volatile("s_waitcnt vmcnt(6) lgkmcnt(0)" ::: "memory"); else if (na_ == 2) asm volatile("s_waitcnt vmcnt(4) lgkmcnt(0)" ::: "memory"); else if (na_ == 1) asm volatile("s_waitcnt vmcnt(2) lgkmcnt(0)" ::: "memory"); else asm volatile("s_waitcnt vmcnt(0) lgkmcnt(0)" ::: "memory"); } } while (0)
#pragma unroll
    for (int i = 0; i < 6; ++i) if (i < nt) { src(i, kb, kp, vb, vp); dma_tile_o(lds + i * DBUF, kb, vb, lo.gk, lo.gv, wave); xtra(i, i); }
    { const int iss = nt < 6 ? nt : 6; KV8_WAIT(iss > 3 ? iss - 3 : 0); }
    __builtin_amdgcn_s_barrier();
    f32x16 pa[2], pb[2];
    scores_d(pa, qf, lds, lane);
    int t = 0;
    while (true) {
        if (t + 6 < nt) { src(t + 6, kb, kp, vb, vp); dma_tile_o(lds + ((t + 6) & 7) * DBUF, kb, vb, lo.gk, lo.gv, wave); xtra(t + 6, (t + 6) & 7); }
        { const int bn_ = (t + 1 < nt) ? ((t + 1) & 7) : (t & 7); fin(t, pa, lds + (t & 7) * DBUF, lds + bn_ * DBUF, pb, t & 7); }
        if (t + 1 >= nt) break;
        if (t + 7 < nt) { src(t + 7, kb, kp, vb, vp); dma_tile_o(lds + ((t + 7) & 7) * DBUF, kb, vb, lo.gk, lo.gv, wave); xtra(t + 7, (t + 7) & 7); }
        { const int bn_ = (t + 2 < nt) ? ((t + 2) & 7) : ((t + 1) & 7); fin(t + 1, pb, lds + ((t + 1) & 7) * DBUF, lds + bn_ * DBUF, pa, (t + 1) & 7); }
        { const int rem = nt - (t + 5); KV8_WAIT(rem < 0 ? 0 : (rem > 3 ? 3 : rem)); }
        __builtin_amdgcn_s_barrier();
        t += 2; if (t >= nt) break;
    }
    asm volatile("s_waitcnt vmcnt(0) lgkmcnt(0)" ::: "memory"); __builtin_amdgcn_s_barrier();
#undef KV8_WAIT
}
template <int HD> __device__ __forceinline__ void store_o(const f32x16 (&o)[HD / 32], float f, bf16_t* orow, int lane) {
    const int h = lane >> 5;
#pragma unroll
    for (int dh = 0; dh < HD / 32; ++dh)
#pragma unroll
        for (int g = 0; g < 4; ++g) { u32x2 w; w.x = pk2(o[dh][4 * g] * f, o[dh][4 * g + 1] * f); w.y = pk2(o[dh][4 * g + 2] * f, o[dh][4 * g + 3] * f);
            *(u32x2*)(orow + 32 * dh + 8 * g + 4 * h) = w; }
}

template <int HD> __device__ __forceinline__ void store_o_t(const f32x16 (&o)[HD / 32], float f, bf16_t* base, size_t ld, LAS unsigned char* scr, int lane) {
    constexpr int PITCH = HD * 2 + 16;
    asm volatile("" : "+v"(lane));
    const int r = lane & 31, h = lane >> 5;
#pragma unroll
    for (int dh = 0; dh < HD / 32; ++dh)
#pragma unroll
        for (int g = 0; g < 4; ++g) { u32x2 w; w.x = pk2(o[dh][4 * g] * f, o[dh][4 * g + 1] * f); w.y = pk2(o[dh][4 * g + 2] * f, o[dh][4 * g + 3] * f);
            *(LAS u32x2*)(scr + r * PITCH + (32 * dh + 8 * g + 4 * h) * 2) = w; }
    asm volatile("s_waitcnt lgkmcnt(0)" ::: "memory");
    constexpr int CPR = HD / 8;
#pragma unroll
    for (int i = 0; i < (32 * CPR) / 64; ++i) { const int idx = lane + 64 * i, row = idx / CPR, c = idx % CPR;
        const u32x4 v = *(const LAS u32x4*)(scr + row * PITCH + c * 16);
        *(u32x4*)(base + (size_t)row * ld + c * 8) = v; }
}
}


__device__ __forceinline__ float row_rstd(const float* rsq, int row) {
    const f32x4* pr = (const f32x4*)(rsq + (size_t)row * 16); const f32x4 a = pr[0], b = pr[1], c = pr[2], d = pr[3];
    const float ss = (((a[0] + a[1]) + (a[2] + a[3])) + ((b[0] + b[1]) + (b[2] + b[3]))) + (((c[0] + c[1]) + (c[2] + c[3])) + ((d[0] + d[1]) + (d[2] + d[3])));
    return __builtin_amdgcn_rsqf(ss * (1.0f / 1024.0f) + RMS_EPS);
}
__device__ __forceinline__ void unpack8(const u32x4 w, float (&f)[8]) {
#pragma unroll
    for (int j = 0; j < 4; ++j) { f[2 * j] = __builtin_bit_cast(float, w[j] << 16); f[2 * j + 1] = __builtin_bit_cast(float, w[j] & 0xffff0000u); } }
__device__ __forceinline__ u32x4 pack8f(const float (&f)[8]) { u32x4 o; o.x = pk2(f[0], f[1]); o.y = pk2(f[2], f[3]); o.z = pk2(f[4], f[5]); o.w = pk2(f[6], f[7]); return o; }
__device__ __forceinline__ void head_norm64(float (&f)[8], const float* gain, float extra, int lane) {
    float ss = 0.f;
#pragma unroll
    for (int j = 0; j < 8; ++j) ss += f[j] * f[j];
    ss += __shfl_xor(ss, 1); ss += __shfl_xor(ss, 2); ss += __shfl_xor(ss, 4);
    const float rn = __builtin_amdgcn_rsqf(ss * (1.0f / 64.0f) + RMS_EPS) * extra; const float* gn = gain + (lane & 7) * 8;
#pragma unroll
    for (int j = 0; j < 8; ++j) f[j] = f[j] * rn * gn[j];
}
__device__ __forceinline__ void head_rope64(float (&f)[8], const float* cs, int lane) {
    float oth[8];
#pragma unroll
    for (int j = 0; j < 8; ++j) oth[j] = __shfl_xor(f[j], 1);
    const int li = lane & 7;
    if (li < 2) {
#pragma unroll
        for (int j = 0; j < 8; ++j) { const float c = cs[j], sn = cs[8 + j]; f[j] = (li == 0) ? f[j] * c - oth[j] * sn : f[j] * c + oth[j] * sn; }
    }
}

__device__ __forceinline__ int wave_sum_i(int x) {
    x += __builtin_amdgcn_update_dpp(0, x, 0x111, 0xf, 0xf, true);
    x += __builtin_amdgcn_update_dpp(0, x, 0x112, 0xf, 0xf, true);
    x += __builtin_amdgcn_update_dpp(0, x, 0x114, 0xf, 0xf, true);
    x += __builtin_amdgcn_update_dpp(0, x, 0x118, 0xf, 0xf, true);
    x += __builtin_amdgcn_update_dpp(0, x, 0x142, 0xa, 0xf, true);
    x += __builtin_amdgcn_update_dpp(0, x, 0x143, 0xc, 0xf, true);
    return __builtin_amdgcn_readlane(x, 63);
}

__device__ __forceinline__ int cnt_ge(unsigned u, unsigned cand, int c) {
    int r; asm("v_cmp_ge_u32 vcc, %1, %2\n\tv_addc_co_u32 %0, vcc, 0, %3, vcc" : "=v"(r) : "v"(u), "v"(cand), "v"(c) : "vcc"); return r; }

__device__ __forceinline__ int cnt_ge16(const unsigned* u, unsigned cand, int c) {
    asm("v_cmp_ge_u32 vcc, %1, %17\n\tv_addc_co_u32 %0, vcc, 0, %0, vcc\n\tv_cmp_ge_u32 vcc, %2, %17\n\tv_addc_co_u32 %0, vcc, 0, %0, vcc\n\t"
        "v_cmp_ge_u32 vcc, %3, %17\n\tv_addc_co_u32 %0, vcc, 0, %0, vcc\n\tv_cmp_ge_u32 vcc, %4, %17\n\tv_addc_co_u32 %0, vcc, 0, %0, vcc\n\t"
        "v_cmp_ge_u32 vcc, %5, %17\n\tv_addc_co_u32 %0, vcc, 0, %0, vcc\n\tv_cmp_ge_u32 vcc, %6, %17\n\tv_addc_co_u32 %0, vcc, 0, %0, vcc\n\t"
        "v_cmp_ge_u32 vcc, %7, %17\n\tv_addc_co_u32 %0, vcc, 0, %0, vcc\n\tv_cmp_ge_u32 vcc, %8, %17\n\tv_addc_co_u32 %0, vcc, 0, %0, vcc\n\t"
        "v_cmp_ge_u32 vcc, %9, %17\n\tv_addc_co_u32 %0, vcc, 0, %0, vcc\n\tv_cmp_ge_u32 vcc, %10, %17\n\tv_addc_co_u32 %0, vcc, 0, %0, vcc\n\t"
        "v_cmp_ge_u32 vcc, %11, %17\n\tv_addc_co_u32 %0, vcc, 0, %0, vcc\n\tv_cmp_ge_u32 vcc, %12, %17\n\tv_addc_co_u32 %0, vcc, 0, %0, vcc\n\t"
        "v_cmp_ge_u32 vcc, %13, %17\n\tv_addc_co_u32 %0, vcc, 0, %0, vcc\n\tv_cmp_ge_u32 vcc, %14, %17\n\tv_addc_co_u32 %0, vcc, 0, %0, vcc\n\t"
        "v_cmp_ge_u32 vcc, %15, %17\n\tv_addc_co_u32 %0, vcc, 0, %0, vcc\n\tv_cmp_ge_u32 vcc, %16, %17\n\tv_addc_co_u32 %0, vcc, 0, %0, vcc"
        : "+v"(c) : "v"(u[0]), "v"(u[1]), "v"(u[2]), "v"(u[3]), "v"(u[4]), "v"(u[5]), "v"(u[6]), "v"(u[7]), "v"(u[8]), "v"(u[9]), "v"(u[10]), "v"(u[11]), "v"(u[12]), "v"(u[13]), "v"(u[14]), "v"(u[15]), "v"(cand) : "vcc");
    return c;
}
struct Args { const void* in[32]; float* out; unsigned char* ws; int ph_lo, ph_hi, li, pad; };

template <class CMap>
__device__ __forceinline__ void transpose_item(const float* W, int K, int N, bf16_t* WT, const float* gain, LAS float* scr, int kb, int nb, int lane, CMap cmap) {
    const int k0 = 64 * kb, n0 = 32 * nb, n4 = (lane & 7) * 4; const int c = cmap(n0 + n4);
    f32x4 v[8]; float gk[8];
#pragma unroll
    for (int i = 0; i < 8; ++i) { const int kk = (lane >> 3) + 8 * i; v[i] = (f32x4){0.f, 0.f, 0.f, 0.f}; gk[i] = 1.f;
        if (c >= 0) { v[i] = *(const f32x4*)(W + (size_t)(k0 + kk) * N + c); if (gain) gk[i] = gain[k0 + kk]; } }
#pragma unroll
    for (int i = 0; i < 8; ++i) { const int kk = (lane >> 3) + 8 * i; *(LAS f32x4*)(scr + kk * 36 + n4) = v[i] * gk[i]; }
    asm volatile("s_waitcnt lgkmcnt(0)" ::: "memory");
    const int ch = lane & 7;
#pragma unroll
    for (int j = 0; j < 4; ++j) { const int n = (lane >> 3) + 8 * j; const LAS float* s = scr + (8 * ch) * 36 + n;
        u32x4 o; o.x = pk2(s[0 * 36], s[1 * 36]); o.y = pk2(s[2 * 36], s[3 * 36]); o.z = pk2(s[4 * 36], s[5 * 36]); o.w = pk2(s[6 * 36], s[7 * 36]);
        *(u32x4*)(WT + (size_t)(n0 + n) * K + k0 + 8 * ch) = o; }
    asm volatile("s_waitcnt lgkmcnt(0)" ::: "memory");
}

struct CMapId { int n; __device__ __forceinline__ int operator()(int p) const { return p < n ? p : -1; } };
struct CMapProj0 { __device__ __forceinline__ int operator()(int p) const { const int o = p & 255, c = 64 * (4 * (p >> 8) + ((o >> 5) & 3)) + 8 * (2 * ((o >> 3) & 3) + (o >> 7)) + (o & 7);
    if (c < 936) return c; if (c < 960) return -1; return (c - 24 < AB_W) ? c - 24 : -1; } };
struct CMapProj1 { __device__ __forceinline__ int operator()(int p) const { const int o = p & 255, c = 64 * (4 * (p >> 8) + ((o >> 5) & 3)) + 8 * (2 * ((o >> 3) & 3) + (o >> 7)) + (o & 7); return c < C_W ? c : -1; } };
struct CMapFfn { __device__ __forceinline__ int operator()(int p) const { const int t = p >> 8, r = p & 255; return r < 128 ? t * 128 + r : DFF + t * 128 + (r - 128); } };

#ifndef PIPE_MEM
#define PIPE_MEM false
#endif
#ifndef PIPE_DSA
#define PIPE_DSA true
#endif
#ifndef PIPE_MOBA
#define PIPE_MOBA false
#endif
#ifndef PIPE_SEL
#define PIPE_SEL true
#endif
#ifndef PIPE_WIN
#define PIPE_WIN true
#endif
#ifndef LP_L0
#define LP_L0 true
#endif
#ifndef LP_NSA
#define LP_NSA false
#endif
#ifndef AB_L0
#define AB_L0 0
#endif
#ifndef PROBE_MASK
#define PROBE_MASK 0u
#endif
#define REPS(k) (((PROBE_MASK >> (k)) & 1u) ? 2 : 1)
#define RUN(k) (lo <= (k) && (k) < hi)
#define SEAM(k) do { if ((k) + 1 < hi) xcd_barrier(bar); } while (0)
#define INF_(k) ((const float*)args.in[k])
#define x_in INF_(0)
#define mem_in INF_(1)
#define positions ((const int*)args.in[2])
#define norm_mix INF_(3)
#define norm_mem INF_(4)
#define norm_mem_src INF_(5)
#define norm_ffn INF_(6)
#define ab_w_in INF_(7)
#define ab_w_out INF_(8)
#define nsa_w_in INF_(13)
#define nsa_w_out INF_(14)
#define mem_w_q INF_(25)
#define mem_w_kv INF_(26)
#define mem_w_o INF_(27)
#define ffn_w_in INF_(30)
#define ffn_w_out INF_(31)
#define out (args.out)
#define WSB(off) ((bf16_t*)(args.ws + (off)))
#define W_AB WSB(WS_WAB)
#define W_C WSB(WS_WC)
#define W_ABO WSB(WS_WABO)
#define W_CO WSB(WS_WCO)
#define W_MQ WSB(WS_WMQ)
#define W_KV WSB(WS_WKV)
#define W_MO WSB(WS_WMO)
#define W_FI WSB(WS_WFI)
#define W_FO WSB(WS_WFO)
#define XB WSB(WS_XB)
#define RSQ ((float*)(args.ws + WS_RSQ))
#define HID WSB(WS_R1)
#define MEMB WSB(WS_MEMB)
#define KVRAW WSB(WS_KVRAW)
#define MRS ((float*)(args.ws + WS_MRS))
#define MQB WSB(WS_MQ)
#define OMEM WSB(WS_OMEM)
#define mem_q_norm INF_(28)
#define RAW WSB(WS_R1)
#define OATT WSB(WS_OATT)
#define ROPE64 ((float*)(args.ws + WS_ROPE64))
#define ROPE32 ((float*)(args.ws + WS_ROPE32))
#define W1T WSB(WS_W1T)
#define POSW1 ((float*)(args.ws + WS_POSW1))
#define KCMP WSB(WS_KCMP)
#define VCMP WSB(WS_VCMP)
#define GT ((float*)(args.ws + WS_GT))
#define SCR ((float*)(args.ws + WS_SC))
#define BMK ((unsigned long long*)(args.ws + WS_BM))
#define KMEAN ((float*)(args.ws + WS_KM))
#define IWB ((float*)(args.ws + WS_ISG))
#define dsa_q_norm INF_(9)
#define dsa_k_norm INF_(10)
#define moba_q_norm INF_(11)
#define moba_k_norm INF_(12)
#define nsa_q_norm INF_(15)
#define nsa_kcmp_norm INF_(16)
#define nsa_ksel_norm INF_(17)
#define nsa_kwin_norm INF_(18)
#define nsa_cmp_pos_k INF_(19)
#define nsa_cmp_pos_v INF_(20)
#define nsa_cmp_w1_k INF_(21)
#define nsa_cmp_w2_k INF_(22)
#define nsa_cmp_w1_v INF_(23)
#define nsa_cmp_w2_v INF_(24)
#define mem_k_norm INF_(29)
template <int L> __device__ __forceinline__ void layer_phases(const Args& args, LAS unsigned char* lds, const XcdBarrier& bar, const int lo, const int hi, const int wave) {
    const int G = gridDim.x, bid = blockIdx.x;
    constexpr int pb = 1 + 10 * L;
        if (RUN(pb + 0)) for (int rep_ = 0; rep_ < REPS(pb + 0); ++rep_) {
            int lane = (int)__builtin_amdgcn_mbcnt_hi(~0u, __builtin_amdgcn_mbcnt_lo(~0u, 0u)); asm volatile("" : "+v"(lane)); const int tid = wave * 64 + lane;
            if (L == 0) {
                pg8::Gemm g{MEMB, W_KV, MMEM, 2048, DM}; pg8::StaticOrder S; S.init(MMEM, 2048, G, bid);
                pg8::EpiPlain E{KVRAW, 2048};
                pg8::gemm_phase<pg8::EpiPlain, pg8::StaticOrder, true, true>(lds, g, S, E, wave);
            }
            if (L == 0) {
                pg8::Gemm g{XB, W_AB, MTOK, AB_WP, DM}; pg8::StaticOrder S; S.init(MTOK, AB_WP, G, bid);
                pg8::EpiProj<0> E{RAW, AB_WP, RSQ, ROPE64, ROPE32, dsa_q_norm, dsa_k_norm, moba_q_norm, moba_k_norm, IWB, lds};
                pg8::gemm_phase<pg8::EpiProj<0>, pg8::StaticOrder, true, true>(lds, g, S, E, wave);
            }
            if (L == 1) {
                pg8::Gemm g{XB, W_C, MTOK, C_WP, DM}; pg8::StaticOrder S; S.init(MTOK, C_WP, G, bid);
                pg8::EpiProj<1> E{RAW, C_WP, RSQ, ROPE64, ROPE32, nsa_q_norm, nsa_ksel_norm, nsa_kwin_norm, nullptr, GT, lds};
                pg8::gemm_phase<pg8::EpiProj<1>, pg8::StaticOrder, true, true>(lds, g, S, E, wave);
            }
            SEAM(pb + 0);
        }
        if (RUN(pb + 1)) for (int rep_ = 0; rep_ < REPS(pb + 1); ++rep_) {
            int lane = (int)__builtin_amdgcn_mbcnt_hi(~0u, __builtin_amdgcn_mbcnt_lo(~0u, 0u)); asm volatile("" : "+v"(lane)); const int tid = wave * 64 + lane;
            if (L == 1) {
                LAS float* PART = (LAS float*)lds;
                LAS float* HB = (LAS float*)(lds + 65536);
                LAS float* W2S = (LAS float*)(lds + 65536 + 8448);
                for (int u = bid; u < BATCH * 4 * 2 * 8; u += G) {
                    const int ch = u & 7, kv = (u >> 3) & 1, g = (u >> 4) & 3, b = u >> 6;
                    const int r = lane & 31, h = lane >> 5, n0 = ch * 32;
                    const bf16_t* xb0 = RAW + (size_t)(b * SEQ + 16 * (n0 + r)) * C_WP + (kv ? 1280 : 1024) + g * 64 + 8 * h;
                    const bf16_t* wt = W1T + (size_t)kv * 64 * 2048 + 8 * h;
                    f32x16 acc[2];
#pragma unroll
                    for (int i = 0; i < 16; ++i) { acc[0][i] = 0.f; acc[1][i] = 0.f; }
                    const bool rowok = (n0 + r) < 255;
                    float rsl[4];
#pragma unroll
                    for (int li = 0; li < 4; ++li) rsl[li] = rowok ? row_rstd(RSQ, b * SEQ + 16 * (n0 + r) + wave * 4 + li) : 0.f;
#pragma unroll
                    for (int li = 0; li < 4; ++li) { const int l = wave * 4 + li;
#pragma unroll
                        for (int s2 = 0; s2 < 4; ++s2) {
                            bf16x8 a = {0, 0, 0, 0, 0, 0, 0, 0};
                            if (rowok) { float f[8]; unpack8(*(const u32x4*)(xb0 + (size_t)l * C_WP + 16 * s2), f);
#pragma unroll
                                for (int j = 0; j < 8; ++j) f[j] *= rsl[li];
                                a = __builtin_bit_cast(bf16x8, pack8f(f)); }
                            const bf16x8 b0 = *(const bf16x8*)(wt + (size_t)r * 2048 + l * 64 + 16 * s2), b1 = *(const bf16x8*)(wt + (size_t)(32 + r) * 2048 + l * 64 + 16 * s2);
                            acc[0] = __builtin_amdgcn_mfma_f32_32x32x16_bf16(a, b0, acc[0], 0, 0, 0); acc[1] = __builtin_amdgcn_mfma_f32_32x32x16_bf16(a, b1, acc[1], 0, 0, 0); } }
                    __syncthreads();
#pragma unroll
                    for (int nh = 0; nh < 2; ++nh)
#pragma unroll
                        for (int i = 0; i < 16; ++i) PART[wave * 2048 + ((i & 3) + 8 * (i >> 2) + 4 * h) * 64 + nh * 32 + r] = acc[nh][i];
                    { const float* w2 = kv ? nsa_cmp_w2_v : nsa_cmp_w2_k; const f32x4 wa = *(const f32x4*)(w2 + tid * 4), wb = *(const f32x4*)(w2 + 2048 + tid * 4);
                      *(LAS f32x4*)(W2S + tid * 4) = wa; *(LAS f32x4*)(W2S + 2048 + tid * 4) = wb; }
                    __syncthreads();
                    const float pw1 = POSW1[kv * 64 + (tid & 63)];
                    for (int i = tid; i < 2048; i += 512) { float a = pw1;
#pragma unroll
                        for (int w = 0; w < 8; ++w) a += PART[w * 2048 + i];
                        HB[(i >> 6) * 65 + (i & 63)] = a / (1.0f + __expf(-a)); }
                    __syncthreads();
                    { const int n = tid >> 4, c4 = (tid & 15) * 4; float o[4] = {0.f, 0.f, 0.f, 0.f};
                        for (int c = 0; c < 64; ++c) { const float hv = HB[n * 65 + c]; const f32x4 w = *(const LAS f32x4*)(W2S + c * 64 + c4); o[0] += hv * w[0]; o[1] += hv * w[1]; o[2] += hv * w[2]; o[3] += hv * w[3]; }
                        if (kv == 0) { float ss = (o[0] * o[0] + o[1] * o[1]) + (o[2] * o[2] + o[3] * o[3]);
                            ss += __shfl_xor(ss, 1); ss += __shfl_xor(ss, 2); ss += __shfl_xor(ss, 4); ss += __shfl_xor(ss, 8);
                            const float rn = __builtin_amdgcn_rsqf(ss * (1.0f / 64.0f) + RMS_EPS);
#pragma unroll
                            for (int j = 0; j < 4; ++j) o[j] = o[j] * rn * nsa_kcmp_norm[c4 + j]; }
                        if (n0 + n >= 255) { o[0] = o[1] = o[2] = o[3] = 0.f; }
                        u32x2 w; w.x = pk2(o[0], o[1]); w.y = pk2(o[2], o[3]);
                        *(u32x2*)((kv ? VCMP : KCMP) + ((size_t)(b * 4 + g) * 256 + n0 + n) * 64 + c4) = w; }
                    __syncthreads();
                }
            }
            if (L == 1) SEAM(pb + 1);
        }
        if (RUN(pb + 2)) for (int rep_ = 0; rep_ < REPS(pb + 2); ++rep_) {
            int lane = (int)__builtin_amdgcn_mbcnt_hi(~0u, __builtin_amdgcn_mbcnt_lo(~0u, 0u)); asm volatile("" : "+v"(lane)); const int tid = wave * 64 + lane;
            if (L == 0 && rep_ == 0) {
                const int gw = bid * NWAVES + wave, NGW = G * NWAVES;
                for (int m = gw; m < MMEM; m += NGW) {
                    const float rs = MRS[m]; bf16_t* row = KVRAW + (size_t)m * 2048;
#pragma unroll
                    for (int st = 0; st < 4; ++st) {
                        u32x4 w = *(const u32x4*)(row + st * 512 + lane * 8); float f[8];
#pragma unroll
                        for (int j = 0; j < 4; ++j) { f[2 * j] = __builtin_bit_cast(float, w[j] << 16) * rs; f[2 * j + 1] = __builtin_bit_cast(float, w[j] & 0xffff0000u) * rs; }
                        if ((st & 1) == 0) {
                            float ss = 0.f;
#pragma unroll
                            for (int j = 0; j < 8; ++j) ss += f[j] * f[j];
                            ss += __shfl_xor(ss, 1); ss += __shfl_xor(ss, 2); ss += __shfl_xor(ss, 4); ss += __shfl_xor(ss, 8);
                            const float rn = __builtin_amdgcn_rsqf(ss * (1.0f / 128.0f) + RMS_EPS);
                            const float* gn = mem_k_norm + (st >> 1) * 128 + (lane & 15) * 8;
#pragma unroll
                            for (int j = 0; j < 8; ++j) f[j] = f[j] * rn * gn[j];
                        }
                        u32x4 o; o.x = pk2(f[0], f[1]); o.y = pk2(f[2], f[3]); o.z = pk2(f[4], f[5]); o.w = pk2(f[6], f[7]);
                        *(u32x4*)(row + st * 512 + lane * 8) = o;
                    }
                }
            }
            if (L == 0) {
                { const int gw = bid * NWAVES + wave, NGW = G * NWAVES;
                  for (int u = gw; u < BATCH * 8 * 16; u += NGW) { const int n = u & 15, hm = (u >> 4) & 7, b = u >> 7;
                      const bf16_t* kb = RAW + (size_t)(b * SEQ + 256 * n + (lane >> 3)) * AB_WP + 1472 + hm * 64 + (lane & 7) * 8; float a[8] = {0.f, 0.f, 0.f, 0.f, 0.f, 0.f, 0.f, 0.f};
                      for (int i0 = 0; i0 < 32; i0 += 8) { u32x4 rw[8];
#pragma unroll
                          for (int i = 0; i < 8; ++i) rw[i] = *(const u32x4*)(kb + (size_t)(8 * (i0 + i)) * AB_WP);
#pragma unroll
                          for (int i = 0; i < 8; ++i) { float f[8]; unpack8(rw[i], f);
#pragma unroll
                              for (int j = 0; j < 8; ++j) a[j] += f[j]; } }
#pragma unroll
                      for (int j = 0; j < 8; ++j) { a[j] += __shfl_xor(a[j], 8); a[j] += __shfl_xor(a[j], 16); a[j] += __shfl_xor(a[j], 32); }
                      if (lane < 8) { float* o = KMEAN + (size_t)u * 64 + lane * 8;
#pragma unroll
                          for (int j = 0; j < 8; ++j) o[j] = a[j] * (1.0f / 256.0f); } } }
                LAS float* SCL = (LAS float*)lds;
#if defined(PROBE_IDX) && PROBE_IDX == 2
                if (rep_ == 0)
#endif
                for (int ui = bid; ui < BATCH * 256; ui += G) {
                    const int rr = ui >> 8, pos = ui & 255; const int qi = 32 * rr + ((rr & 1) ? 31 - (pos >> 3) : (pos >> 3)), b = pos & 7;
                    const int t0 = qi * 16, tmax = t0 + 15, nchunk = (tmax >> 10) + 1, nreg = (tmax >> 6) + 1;
                    const int ql = lane & 15, kq = lane >> 4;
                    const size_t qrow = (size_t)b * SEQ + t0 + ql;
                    typedef float f32x4v __attribute__((ext_vector_type(4)));
                    bf16x8 qf[8];
#pragma unroll
                    for (int hi = 0; hi < 8; ++hi) qf[hi] = *(const bf16x8*)(RAW + qrow * AB_WP + 640 + hi * 32 + 8 * kq);
                    const f32x4 iw0 = *(const f32x4*)(IWB + qrow * 8), iw1 = *(const f32x4*)(IWB + qrow * 8 + 4);
                    unsigned uu[2][64];
#pragma unroll
                    for (int rg = 0; rg < 64; ++rg) { uu[0][rg] = 0u; uu[1][rg] = 0u; }
#pragma unroll
                    for (int c = 0; c < 4; ++c) if (c < nchunk) {
                        const int ntile = ((tmax - 1024 * c) >> 4) + 1 < 64 ? ((tmax - 1024 * c) >> 4) + 1 : 64;
                        __syncthreads();
                        const bf16_t* kfp = RAW + (size_t)(b * SEQ + 1024 * c + ql) * AB_WP + 896 + 8 * kq;
                        bf16x8 kfn = *(const bf16x8*)(kfp + (size_t)(16 * (wave < ntile ? wave : 0)) * AB_WP);
                        for (int tile = wave; tile < ntile; tile += 8) {
                            const bf16x8 kf = kfn; { const int tn = tile + 8 < ntile ? tile + 8 : tile; kfn = *(const bf16x8*)(kfp + (size_t)(16 * tn) * AB_WP); }
                            f32x4v sc = {0.f, 0.f, 0.f, 0.f};
#pragma unroll
                            for (int hi = 0; hi < 8; ++hi) { f32x4v x = {0.f, 0.f, 0.f, 0.f}; x = __builtin_amdgcn_mfma_f32_16x16x32_bf16(kf, qf[hi], x, 0, 0, 0);
                                const float sf = hi < 4 ? iw0[hi & 3] : iw1[hi & 3];
#pragma unroll
                                for (int i = 0; i < 4; ++i) sc[i] += sf * fmaxf(x[i], 0.f); }
                            *(LAS f32x4v*)(SCL + ql * 1028 + 16 * tile + 4 * kq) = sc;
                        }
                        __syncthreads();
#pragma unroll
                        for (int qq = 0; qq < 2; ++qq) { const int t = t0 + 2 * wave + qq;
#pragma unroll
                            for (int rl = 0; rl < 16; ++rl) { const int key = 1024 * c + 64 * rl + lane; const unsigned bits = __builtin_bit_cast(unsigned, SCL[(2 * wave + qq) * 1028 + 64 * rl + lane]);
                                const unsigned mono = bits ^ ((bits >> 31) ? 0xffffffffu : 0x80000000u); uu[qq][16 * c + rl] = (key <= t) ? mono : 0u; } }
                    }
#if defined(PROBE_IDX) && PROBE_IDX == 1
                    if (rep_) { if (uu[0][3] == 12345u && uu[1][40] == 777u) BMK[0] = 1ull; continue; }
#endif
                    int lb = lane; asm volatile("" : "+v"(lb));
                    unsigned long long word[2] = {0ull, 0ull};
                    unsigned T[2] = {0u, 0u}; bool done[2], exact[2] = {false, false};
                    done[0] = (t0 + 2 * wave) < 256; done[1] = (t0 + 2 * wave + 1) < 256;
                    for (int bit = 31; bit >= 0 && !(done[0] && done[1]); --bit) {
                        const unsigned c0 = T[0] | (1u << bit), c1 = T[1] | (1u << bit); int n0 = 0, n1 = 0;
#pragma unroll
                        for (int ch = 0; ch < 4; ++ch) if (16 * ch < nreg) {
#pragma unroll
                            for (int dummy_ = 0; dummy_ < 1; ++dummy_) { n0 = cnt_ge16(&uu[0][16 * ch], c0, n0); n1 = cnt_ge16(&uu[1][16 * ch], c1, n1); } }
                        const int s0 = wave_sum_i(n0), s1 = wave_sum_i(n1);
                        if (!done[0]) { if (s0 >= 256) T[0] = c0; if (s0 == 256) { done[0] = true; exact[0] = true; } }
                        if (!done[1]) { if (s1 >= 256) T[1] = c1; if (s1 == 256) { done[1] = true; exact[1] = true; } }
                    }
#pragma unroll
                    for (int qq = 0; qq < 2; ++qq) { const int t = t0 + 2 * wave + qq; unsigned long long myword = 0ull;
                        if (t < 256) {
#pragma unroll
                            for (int rg = 0; rg < 4; ++rg) { const unsigned long long w = __ballot(64 * rg + lb <= t); if (lb == rg) myword = w; }
                        } else if (exact[qq]) {
#pragma unroll
                            for (int rg = 0; rg < 64; ++rg) { const unsigned long long w = __ballot(uu[qq][rg] >= T[qq]); if (lb == rg) myword = w; __builtin_amdgcn_sched_barrier(0); }
                        } else {
                            int cg = 0;
#pragma unroll
                            for (int rg = 0; rg < 64; ++rg) cg = cnt_ge(uu[qq][rg], T[qq] + 1u, cg);
                            int need = 256 - wave_sum_i(cg);
#pragma unroll
                            for (int rg = 0; rg < 64; ++rg) {
                                unsigned long long w = __ballot(uu[qq][rg] > T[qq]), eq = __ballot(uu[qq][rg] == T[qq]); const int ne = __builtin_popcountll(eq);
                                if (ne <= need) { w |= eq; need -= ne; } else { while (need > 0) { const unsigned long long low = eq & (0ull - eq); w |= low; eq ^= low; --need; } }
                                if (lb == rg) myword = w; __builtin_amdgcn_sched_barrier(0); }
                        }
                        BMK[((size_t)(b * 128 + (t >> 5)) * 64 + lb) * 32 + (t & 31)] = myword;
                    }
                }
            }
            if (L == 0) SEAM(pb + 2);
        }
        if (RUN(pb + 3)) for (int rep_ = 0; rep_ < REPS(pb + 3); ++rep_) {
            int lane = (int)__builtin_amdgcn_mbcnt_hi(~0u, __builtin_amdgcn_mbcnt_lo(~0u, 0u)); asm volatile("" : "+v"(lane)); const int tid = wave * 64 + lane;
            if (L == 0) {
                const float shiftA = att::softmax_shift(att::gain_max64(dsa_q_norm), att::gain_max64(dsa_k_norm)), shiftB = att::softmax_shift(att::gain_max64(moba_q_norm), att::gain_max64(moba_k_norm));
                for (int ui = bid; ui < BATCH * 128; ui += G) {
                    const int rr = ui >> 8, pos = ui & 255; const int qt = 32 * rr + ((rr & 1) ? 31 - (pos >> 3) : (pos >> 3)), b = pos & 7;
                    const int r = lane & 31, h = lane >> 5; const size_t row = (size_t)b * SEQ + qt * 32 + r;
                    bf16x8 qf[4];
                    { const bf16_t* qrow = RAW + row * AB_WP + wave * 64 + 8 * h;
#pragma unroll
                      for (int s2 = 0; s2 < 4; ++s2) qf[s2] = *(const bf16x8*)(qrow + 16 * s2); }
                    f32x16 oo[2]; float ll = 0.f;
#pragma unroll
                    for (int i = 0; i < 16; ++i) { oo[0][i] = 0.f; oo[1][i] = 0.f; }
                    const bf16_t* kbase = RAW + (size_t)b * SEQ * AB_WP + 512; const unsigned long long* bm = BMK + (size_t)(b * 128 + qt) * 64 * 32;
                    const att::LpOff lpo = att::lp_offsets(lane, wave, AB_WP * 2);
                    LAS unsigned char* MSL = lds + 8 * att::DBUF;
{ auto go_ = [&](auto hs_) { constexpr bool HS = decltype(hs_)::value;
#if AB_L0
                    att::kv_pipeline_ab<1>(lds, (qt >> 1) + 1, wave, lane, qf, oo,
                        [&](int tt, const bf16_t*& kb, size_t& kp, const bf16_t*& vb, size_t& vp) { kb = kbase + (size_t)(64 * tt) * AB_WP; kp = AB_WP; vb = kb + 64; vp = AB_WP; },
                        [&](int tt, const f32x16 (&p)[2], u32x4 (&pw)[4], int slot) {
                            const unsigned long long w = *(const LAS unsigned long long*)(MSL + (slot * 8 + wave) * 256 + r * 8) >> (4 * h);
                            att::half_v<2, HS>(pw, ll, p, true, shiftA, [](int) { return true; }, (unsigned)w, (unsigned)(w >> 32)); },
                        [&](int tt, int slot) { __builtin_amdgcn_global_load_lds((const unsigned*)(bm + (size_t)tt * 32) + lane, (LAS unsigned*)(MSL + (slot * 8 + wave) * 256), 4, 0, 0); });
#else
                    att::kv_pipeline_dma8<0>(lds, (qt >> 1) + 1, wave, lane, qf, lpo,
                        [&](int tt, const bf16_t*& kb, size_t& kp, const bf16_t*& vb, size_t& vp) { kb = kbase + (size_t)(64 * tt) * AB_WP; kp = AB_WP; vb = kb + 64; vp = AB_WP; },
                        [&](int tt, f32x16 (&p)[2], const LAS unsigned char* buf, const LAS unsigned char* nbuf, f32x16 (&pn)[2], int slot) {
                            const unsigned long long w = *(const LAS unsigned long long*)(MSL + slot * 256 + r * 8) >> (4 * h);
#if defined(PROBE_SKEL) && PROBE_SKEL == 2
                            if (rep_ == 0)
#endif
                            att::fused_e<2, HS, LP_L0>(oo, ll, p, buf, lane, true, shiftA, [](int) { return true; }, (unsigned)w, (unsigned)(w >> 32), qf, nbuf, pn, lpo); },
                        [&](int tt, int slot) { if ((tt & 7) == wave) __builtin_amdgcn_global_load_lds((const unsigned*)(bm + (size_t)tt * 32) + lane, (LAS unsigned*)(MSL + slot * 256), 4, 0, 0); });
#endif
 }; if (shiftA == 0.f) go_(std::false_type{}); else go_(std::true_type{}); }
                    const float lt = ll + __shfl_xor(ll, 32);
#if defined(PROBE_SKEL) && PROBE_SKEL == 2
                    if (rep_ == 0)
#endif
                    att::store_o_t<64>(oo, lt > 0.f ? 1.0f / lt : 0.f, OATT + ((size_t)b * SEQ + qt * 32) * 1024 + wave * 64, 1024, lds + wave * 4608, lane);
                }
                LAS unsigned* UNI = (LAS unsigned*)(lds + 8 * att::DBUF); LAS int* TL = (LAS int*)(lds + 8 * att::DBUF + 16); LAS float* KMS = (LAS float*)(lds + 8 * att::DBUF + 256);
#if defined(PROBE_SKEL)
                if (rep_ == 0)
#endif
                for (int ui = bid; ui < BATCH * 8 * 16; ui += G) {
                    const int rr = ui >> 8, pos = ui & 255; const int xk = pos >> 3, cmb = rr * 16 + (pos & 7) * 2 + (xk >> 4);
                    const int own = (rr & 1) ? 15 - (xk & 15) : (xk & 15), b = cmb >> 3, hm = cmb & 7;
                    const int r = lane & 31, h = lane >> 5; const int tl = wave * 32 + r; const size_t row = (size_t)b * SEQ + own * 256 + tl;
                    bf16x8 qf[4];
                    { const bf16_t* qrow = RAW + row * AB_WP + 960 + hm * 64 + 8 * h;
#pragma unroll
                      for (int s2 = 0; s2 < 4; ++s2) qf[s2] = *(const bf16x8*)(qrow + 16 * s2); }
                    if (tid == 0) UNI[0] = 0u;
                    { const f32x2 kmv = *(const f32x2*)(KMEAN + (size_t)(b * 8 + hm) * 1024 + tid * 2); *(LAS f32x2*)(KMS + tid * 2) = kmv; }
                    __syncthreads();
                    unsigned msk = 0u;
                    { float b0 = att::NEG_INF, b1 = att::NEG_INF, b2 = att::NEG_INF; int i0 = -1, i1 = -1, i2 = -1;
                      float qv[32];
#pragma unroll
                      for (int s2 = 0; s2 < 4; ++s2) { float f[8]; unpack8(__builtin_bit_cast(u32x4, qf[s2]), f);
#pragma unroll
                          for (int j = 0; j < 8; ++j) qv[8 * s2 + j] = f[j]; }
                      for (int n = 0; n < own; ++n) { const LAS float* km = KMS + n * 64 + 8 * h; float a = 0.f;
#pragma unroll
                          for (int s2 = 0; s2 < 4; ++s2) { const f32x4 k0 = *(const LAS f32x4*)(km + 16 * s2), k1 = *(const LAS f32x4*)(km + 16 * s2 + 4);
                              a += qv[8 * s2] * k0[0] + qv[8 * s2 + 1] * k0[1] + qv[8 * s2 + 2] * k0[2] + qv[8 * s2 + 3] * k0[3] + qv[8 * s2 + 4] * k1[0] + qv[8 * s2 + 5] * k1[1] + qv[8 * s2 + 6] * k1[2] + qv[8 * s2 + 7] * k1[3]; }
                          a += __shfl_xor(a, 32);
                          if (a > b0) { b2 = b1; i2 = i1; b1 = b0; i1 = i0; b0 = a; i0 = n; } else if (a > b1) { b2 = b1; i2 = i1; b1 = a; i1 = n; } else if (a > b2) { b2 = a; i2 = n; } }
                      if (i0 >= 0) msk |= 1u << i0; if (i1 >= 0) msk |= 1u << i1; if (i2 >= 0) msk |= 1u << i2; }
                    { unsigned um = msk;
#pragma unroll
                      for (int o = 1; o < 64; o <<= 1) um |= __shfl_xor(um, o);
                      if (lane == 0) __hip_atomic_fetch_or(UNI, um, __ATOMIC_RELAXED, __HIP_MEMORY_SCOPE_WORKGROUP); }
                    __syncthreads();
                    const unsigned U = (unsigned)__builtin_amdgcn_readfirstlane((int)UNI[0]);
                    const int npast = __builtin_popcount(U);
                    if (wave == 0 && lane < 16 && ((U >> lane) & 1u)) TL[__builtin_amdgcn_mbcnt_lo(U, 0u)] = lane;
                    f32x16 oo[2]; float ll = 0.f;
#pragma unroll
                    for (int i = 0; i < 16; ++i) { oo[0][i] = 0.f; oo[1][i] = 0.f; }
                    const bf16_t* kbase = RAW + (size_t)b * SEQ * AB_WP + 1472 + hm * 64;
                    const att::LpOff lpo = att::lp_offsets(lane, wave, AB_WP * 2);
                    __syncthreads();
{ auto go_ = [&](auto hs_) { constexpr bool HS = decltype(hs_)::value;
#if AB_L0
                    att::kv_pipeline_ab<0>(lds, 4 * npast + 4, wave, lane, qf, oo,
                        [&](int tt, const bf16_t*& kb, size_t& kp, const bf16_t*& vb, size_t& vp) {
                            const int blk = (tt < 4 * npast) ? __builtin_amdgcn_readfirstlane(TL[tt >> 2]) : own, sub = (tt < 4 * npast) ? (tt & 3) : tt - 4 * npast;
                            kb = kbase + (size_t)(256 * blk + 64 * sub) * AB_WP; kp = AB_WP; vb = kb + 512; vp = AB_WP; },
                        [&](int tt, const f32x16 (&p)[2], u32x4 (&pw)[4], int) {
                            if (tt < 4 * npast) { const int blk = __builtin_amdgcn_readfirstlane(TL[tt >> 2]); const bool sel = (msk >> blk) & 1u;
                                att::half_v<0, HS>(pw, ll, p, sel, shiftB, [](int) { return true; }, 0u, 0u); }
                            else { const int sub = tt - 4 * npast; const int lim = tl - 64 * sub - 4 * h;
                                att::half_v<1, HS>(pw, ll, p, true, shiftB, [&](int koff) { return koff <= lim; }, 0u, 0u); } },
                        att::NoXtra());
#else
                    att::kv_pipeline_dma8<0>(lds, 4 * npast + 4, wave, lane, qf, lpo,
                        [&](int tt, const bf16_t*& kb, size_t& kp, const bf16_t*& vb, size_t& vp) {
                            const int blk = (tt < 4 * npast) ? __builtin_amdgcn_readfirstlane(TL[tt >> 2]) : own, sub = (tt < 4 * npast) ? (tt & 3) : tt - 4 * npast;
                            kb = kbase + (size_t)(256 * blk + 64 * sub) * AB_WP; kp = AB_WP; vb = kb + 512; vp = AB_WP; },
                        [&](int tt, f32x16 (&p)[2], const LAS unsigned char* buf, const LAS unsigned char* nbuf, f32x16 (&pn)[2], int) {
                            if (tt < 4 * npast) { const int blk = __builtin_amdgcn_readfirstlane(TL[tt >> 2]); const bool sel = (msk >> blk) & 1u;
                                att::fused_e<0, HS, LP_L0>(oo, ll, p, buf, lane, sel, shiftB, [](int) { return true; }, 0u, 0u, qf, nbuf, pn, lpo); }
                            else { const int sub = tt - 4 * npast; const int lim = tl - 64 * sub - 4 * h;
                                att::fused_e<1, HS, LP_L0>(oo, ll, p, buf, lane, true, shiftB, [&](int koff) { return koff <= lim; }, 0u, 0u, qf, nbuf, pn, lpo); } },
                        att::NoXtra());
#endif
 }; if (shiftB == 0.f) go_(std::false_type{}); else go_(std::true_type{}); }
                    const float lt = ll + __shfl_xor(ll, 32);
                    att::store_o_t<64>(oo, lt > 0.f ? 1.0f / lt : 0.f, OATT + ((size_t)b * SEQ + own * 256 + wave * 32) * 1024 + 512 + hm * 64, 1024, lds + wave * 4608, lane);
                    __syncthreads();
                }
            }
            if (L == 1) {
                const float shiftS = att::softmax_shift(att::gain_max64(nsa_q_norm), att::gain_max64(nsa_ksel_norm)), shiftW = att::softmax_shift(att::gain_max64(nsa_q_norm), att::gain_max64(nsa_kwin_norm));
                LAS unsigned* IMP = (LAS unsigned*)(lds + 86016);
                LAS unsigned long long* SELM = (LAS unsigned long long*)(lds + 4 * att::DBUF); LAS int* TL = (LAS int*)(lds + 4 * att::DBUF + 528);
                for (int ui = bid; ui < BATCH * 4 * 64; ui += G) {
                    const int rr = ui >> 8, pos = ui & 255;
                    const int pr = (pos & 7) * 4 + (rr >> 1), xk = pos >> 3, qt = (rr & 1) ? 63 - xk : xk, b = pr >> 2, g = pr & 3;
                    const int r = lane & 31, h = lane >> 5, j = wave & 3, qs = wave >> 2, hd = g * 4 + j;
                    const int t = qt * 64 + qs * 32 + r, ql = qs * 32 + r; const size_t row = (size_t)b * SEQ + t;
                    bf16x8 qf[4];
                    { const bf16_t* qrow = RAW + row * C_WP + hd * 64 + 8 * h;
#pragma unroll
                      for (int s2 = 0; s2 < 4; ++s2) qf[s2] = *(const bf16x8*)(qrow + 16 * s2); }
                    for (int i = tid; i < ((qt >> 4) + 1) * 64 * 64 / 4; i += 512) ((LAS u32x4*)IMP)[i] = (u32x4){0u, 0u, 0u, 0u};
                    f32x16 oacc[2];
                    const float* gt = GT + row * 48 + hd * 3; const float g0 = gt[0];
                    const int nvalid = t >= 31 ? ((t - 31) >> 4) + 1 : 0;
                    const int ntc = (qt >> 4) + 1;
                    { const bf16_t* kcb = KCMP + (size_t)(b * 4 + g) * 256 * 64; const bf16_t* vcb = VCMP + (size_t)(b * 4 + g) * 256 * 64;
                      for (int idx = tid; idx < 64 * 8 * ntc; idx += 512) { const int rw = idx >> 3, c = idx & 7;
                          *(LAS u32x4*)(lds + rw * 144 + c * 16) = *(const u32x4*)(kcb + rw * 64 + c * 8);
                          *(LAS u32x4*)(lds + 36864 + rw * 192 + c * 16) = *(const u32x4*)(vcb + rw * 64 + c * 8); } }
                    __syncthreads();
                    float mc = att::NEG_INF, lc = 0.f;
#pragma unroll 1
                    for (int tt = 0; tt < ntc; ++tt) {
                        f32x16 p[2]; att::tile_scores<64>(p, qf, lds + tt * 9216, lane); const int lim = nvalid - 64 * tt - 4 * h; float mx = att::NEG_INF;
#pragma unroll
                        for (int kt = 0; kt < 2; ++kt)
#pragma unroll
                            for (int i = 0; i < 16; ++i) { const int koff = 32 * kt + (i & 3) + 8 * (i >> 2); const float v = (koff < lim) ? p[kt][i] : att::NEG_INF; p[kt][i] = v; mx = fmaxf(mx, v); }
                        mx = fmaxf(mx, __shfl_xor(mx, 32));
                        const float mnew = fmaxf(mc, mx), muse = (mnew == att::NEG_INF) ? 0.f : mnew; float ls = 0.f;
#pragma unroll
                        for (int kt = 0; kt < 2; ++kt)
#pragma unroll
                            for (int i = 0; i < 16; ++i) ls += __builtin_amdgcn_exp2f(p[kt][i] - muse);
                        lc = lc * __builtin_amdgcn_exp2f(mc - muse) + ls; mc = mnew; }
                    lc += __shfl_xor(lc, 32);
                    const float invl = lc > 0.f ? 1.0f / lc : 0.f, mcu = (mc == att::NEG_INF) ? 0.f : mc;
#pragma unroll
                    for (int i = 0; i < 16; ++i) { oacc[0][i] = 0.f; oacc[1][i] = 0.f; }
#pragma unroll 1
                    for (int tt = 0; tt < ntc; ++tt) {
                        f32x16 p[2]; att::tile_scores<64>(p, qf, lds + tt * 9216, lane); const int lim = nvalid - 64 * tt - 4 * h;
#pragma unroll
                        for (int kt = 0; kt < 2; ++kt)
#pragma unroll
                            for (int i = 0; i < 16; ++i) { const int koff = 32 * kt + (i & 3) + 8 * (i >> 2); const float pv = (koff < lim) ? __builtin_amdgcn_exp2f(p[kt][i] - mcu) * invl : 0.f; p[kt][i] = pv;
                                __hip_atomic_fetch_add(IMP + (64 * tt + koff + 4 * h) * 64 + ql, (unsigned)(pv * 134217728.0f + 0.5f), __ATOMIC_RELAXED, __HIP_MEMORY_SCOPE_WORKGROUP);
                                if ((i & 3) == 3) __builtin_amdgcn_sched_barrier(0); }
                        __builtin_amdgcn_sched_barrier(0);
                        att::tile_pv<64>(oacc, p, lds + 36864 + tt * 12288 - 9216, lane); }
#pragma unroll
                    for (int i = 0; i < 16; ++i) { oacc[0][i] *= g0; oacc[1][i] *= g0; }
                    LAS float* STASH = (LAS float*)IMP + wave * 2048 + lane;
                    __syncthreads();
                    {
                        int l2 = lane; asm volatile("" : "+v"(l2));
                        const int qq = l2 >> 3, seg = l2 & 7, q = wave * 8 + qq, cur = qt;
                        unsigned key[8];
#pragma unroll
                        for (int k = 0; k < 8; ++k) { const int sb = 8 * seg + k; unsigned v = 0u;
#pragma unroll
                            for (int dn = -1; dn <= 3; ++dn) { const int n = 4 * sb + dn; if (n >= 0 && n < 255) v += IMP[n * 64 + q]; }
                            const bool forced = (sb == 0) || (sb == cur) || (sb == cur - 1);
                            key[k] = (sb <= cur) ? ((forced ? 0xffffff80u : ((v >> 7) << 7)) | (unsigned)(64 - sb)) : 0u; __builtin_amdgcn_sched_barrier(0); }
                        unsigned T = 0u;
                        for (int bit = 31; bit >= 0; --bit) { const unsigned cand = T | (1u << bit); int c = 0;
#pragma unroll
                            for (int k = 0; k < 8; ++k) c += (key[k] >= cand) ? 1 : 0;
                            c += __builtin_amdgcn_update_dpp(0, c, 0xB1, 0xf, 0xf, false);
                            c += __builtin_amdgcn_update_dpp(0, c, 0x4E, 0xf, 0xf, false);
                            c += __builtin_amdgcn_update_dpp(0, c, 0x141, 0xf, 0xf, false);
                            if (c >= 16) T = cand; }
                        unsigned byte = 0u;
#pragma unroll
                        for (int k = 0; k < 8; ++k) byte |= (key[k] != 0u && key[k] >= T) ? (1u << k) : 0u;
                        ((LAS unsigned char*)SELM)[q * 8 + seg] = (unsigned char)byte;
                    }
                    __syncthreads();
#pragma unroll
                    for (int i = 0; i < 16; ++i) { STASH[i * 64] = oacc[0][i]; STASH[(16 + i) * 64] = oacc[1][i]; }
                    { float own[8], oth[8]; const float* cs = ROPE64 + row * 16; u32x4 w = __builtin_bit_cast(u32x4, qf[0]); unpack8(w, own);
#pragma unroll
                      for (int jj = 0; jj < 8; ++jj) oth[jj] = __shfl_xor(own[jj], 32);
#pragma unroll
                      for (int jj = 0; jj < 8; ++jj) own[jj] = h ? own[jj] * cs[jj] + oth[jj] * cs[8 + jj] : own[jj] * cs[jj] - oth[jj] * cs[8 + jj];
                      qf[0] = __builtin_bit_cast(bf16x8, pack8f(own)); }
                    const att::LpOff lpo = att::lp_offsets(lane, wave, C_WP * 2);
                    {
                        const unsigned long long mymask = SELM[ql]; const unsigned long long un0 = SELM[lane];
                        unsigned ul = (unsigned)un0, uh = (unsigned)(un0 >> 32);
#pragma unroll
                        for (int o = 1; o < 64; o <<= 1) { ul |= __shfl_xor(ul, o); uh |= __shfl_xor(uh, o); }
                        const unsigned ulo = (unsigned)__builtin_amdgcn_readfirstlane((int)ul), uhi = (unsigned)__builtin_amdgcn_readfirstlane((int)uh);
                        const unsigned long long U = ((unsigned long long)uhi << 32) | ulo;
                        if (wave == 0 && ((U >> lane) & 1ull)) TL[__builtin_amdgcn_mbcnt_hi(uhi, __builtin_amdgcn_mbcnt_lo(ulo, 0u))] = lane;
                        f32x16 oo[2]; float ll = 0.f;
#pragma unroll
                        for (int i = 0; i < 16; ++i) { oo[0][i] = 0.f; oo[1][i] = 0.f; }
                        const bf16_t* kbase = RAW + (size_t)b * SEQ * C_WP + 1536 + g * 64;
                        __syncthreads();
{ auto go_ = [&](auto hs_) { constexpr bool HS = decltype(hs_)::value;
                        att::kv_pipeline_dma2<0>(lds, __builtin_popcountll(U), wave, lane, qf, lpo,
                            [&](int tt, const bf16_t*& kb, size_t& kp, const bf16_t*& vb, size_t& vp) { const int sblk = __builtin_amdgcn_readfirstlane(TL[tt]); kb = kbase + (size_t)(64 * sblk) * C_WP; kp = C_WP; vb = kb + 256; vp = C_WP; },
                            [&](int tt, f32x16 (&p)[2], const LAS unsigned char* buf, const LAS unsigned char* nbuf, f32x16 (&pn)[2], int) { const int sblk = __builtin_amdgcn_readfirstlane(TL[tt]);
                                const bool sel = (mymask >> sblk) & 1ull; const int lim = t - 64 * sblk - 4 * h;
                                if (sblk == qt) att::fused_e<1, HS, LP_NSA>(oo, ll, p, buf, lane, sel, shiftS, [&](int koff) { return koff <= lim; }, 0u, 0u, qf, nbuf, pn, lpo);
                                else att::fused_e<0, HS, LP_NSA>(oo, ll, p, buf, lane, sel, shiftS, [](int) { return true; }, 0u, 0u, qf, nbuf, pn, lpo); },
                            att::NoXtra());
 }; if (shiftS == 0.f) go_(std::false_type{}); else go_(std::true_type{}); }
                        const float lt = ll + __shfl_xor(ll, 32); const float f = lt > 0.f ? GT[row * 48 + hd * 3 + 1] / lt : 0.f;
#pragma unroll
                        for (int i = 0; i < 16; ++i) { STASH[i * 64] += oo[0][i] * f; STASH[(16 + i) * 64] += oo[1][i] * f; }
                    }
                    {
                        const int tw0 = qt >= 8 ? qt - 8 : 0, ntw = qt - tw0 + 1;
                        f32x16 oo[2]; float ll = 0.f;
#pragma unroll
                        for (int i = 0; i < 16; ++i) { oo[0][i] = 0.f; oo[1][i] = 0.f; }
                        const bf16_t* kbase = RAW + (size_t)b * SEQ * C_WP + 2048 + g * 64;
{ auto go_ = [&](auto hs_) { constexpr bool HS = decltype(hs_)::value;
                        att::kv_pipeline_dma2<0>(lds, ntw, wave, lane, qf, lpo,
                            [&](int tt, const bf16_t*& kb, size_t& kp, const bf16_t*& vb, size_t& vp) { kb = kbase + (size_t)(64 * (tw0 + tt)) * C_WP; kp = C_WP; vb = kb + 256; vp = C_WP; },
                            [&](int tt, f32x16 (&p)[2], const LAS unsigned char* buf, const LAS unsigned char* nbuf, f32x16 (&pn)[2], int) { const int tw = tw0 + tt; const int d0 = t - 64 * tw - 4 * h;
                                if (tw == qt || (qt >= 8 && tw == qt - 8)) att::fused_e<1, HS, LP_NSA>(oo, ll, p, buf, lane, true, shiftW, [&](int koff) { const int dist = d0 - koff; return dist >= 0 && dist < 512; }, 0u, 0u, qf, nbuf, pn, lpo);
                                else att::fused_e<0, HS, LP_NSA>(oo, ll, p, buf, lane, true, shiftW, [](int) { return true; }, 0u, 0u, qf, nbuf, pn, lpo); },
                            att::NoXtra());
 }; if (shiftW == 0.f) go_(std::false_type{}); else go_(std::true_type{}); }
                        const float lt = ll + __shfl_xor(ll, 32); const float f = lt > 0.f ? GT[row * 48 + hd * 3 + 2] / lt : 0.f;
#pragma unroll
                        for (int i = 0; i < 16; ++i) { oo[0][i] = STASH[i * 64] + oo[0][i] * f; oo[1][i] = STASH[(16 + i) * 64] + oo[1][i] * f; }
#if defined(PROBE_NSA)
                        if (rep_ == 0)
#endif
                        att::store_o_t<64>(oo, 1.0f, OATT + ((size_t)b * SEQ + qt * 64 + qs * 32) * 1024 + hd * 64, 1024, lds + wave * 4608, lane);
                    }
                    __syncthreads();
                }
            }
            SEAM(pb + 3);
        }
        if (RUN(pb + 4)) for (int rep_ = 0; rep_ < REPS(pb + 4); ++rep_) {
            int lane = (int)__builtin_amdgcn_mbcnt_hi(~0u, __builtin_amdgcn_mbcnt_lo(~0u, 0u)); asm volatile("" : "+v"(lane)); const int tid = wave * 64 + lane;
            if (L == 0) {
                pg8::Gemm g{OATT, W_ABO, MTOK, DM, DM}; pg8::StaticOrder S; S.init(MTOK, DM, G, bid);
                pg8::EpiResid<false> E{out, XB, RSQ};
                pg8::gemm_phase<pg8::EpiResid<false>, pg8::StaticOrder, true, true>(lds, g, S, E, wave);
            }
            if (L == 1) {
                pg8::Gemm g{OATT, W_CO, MTOK, DM, DM}; pg8::StaticOrder S; S.init(MTOK, DM, G, bid);
                pg8::EpiResid<false> E{out, XB, RSQ};
                pg8::gemm_phase<pg8::EpiResid<false>, pg8::StaticOrder, true, true>(lds, g, S, E, wave);
            }
            SEAM(pb + 4);
        }
        if (RUN(pb + 5)) for (int rep_ = 0; rep_ < REPS(pb + 5); ++rep_) {
            int lane = (int)__builtin_amdgcn_mbcnt_hi(~0u, __builtin_amdgcn_mbcnt_lo(~0u, 0u)); asm volatile("" : "+v"(lane)); const int tid = wave * 64 + lane;
            pg8::Gemm g{XB, W_MQ + (size_t)L * 512 * DM, MTOK, 512, DM}; pg8::StaticOrder S; S.init(MTOK, 512, G, bid);
            pg8::EpiPlain E{MQB, 512};
            pg8::gemm_phase<pg8::EpiPlain, pg8::StaticOrder, true, true>(lds, g, S, E, wave);
            SEAM(pb + 5);
        }
        if (RUN(pb + 6)) for (int rep_ = 0; rep_ < REPS(pb + 6); ++rep_) {
            int lane = (int)__builtin_amdgcn_mbcnt_hi(~0u, __builtin_amdgcn_mbcnt_lo(~0u, 0u)); asm volatile("" : "+v"(lane)); const int tid = wave * 64 + lane;
            const float shiftM = [&] { float gq = 0.f, gk = 0.f; for (int i = 0; i < 128; ++i) { gq = fmaxf(gq, fabsf(mem_q_norm[L * 128 + i])); gk = fmaxf(gk, fabsf(mem_k_norm[L * 128 + i])); }
                                       const float B = 11.3137085f * LOG2E * gq * gk * 1.02f; return B > 60.f ? B - 60.f : 0.f; }();
            const int upb = (512 % G == 0) ? 512 / G : 0; int cur_pair = -1;
            for (int k = 0; ; ++k) {
                const int u = upb ? bid * upb + k : bid + k * G; if ((upb && k >= upb) || u >= BATCH * 4 * 16) break;
                const int b = u >> 6, hh = (u >> 4) & 3, qb = u & 15;
                const int r = lane & 31, h = lane >> 5;
                const int row = b * SEQ + qb * 256 + wave * 32 + r;
                if ((u >> 4) != cur_pair) { cur_pair = u >> 4;
                    __syncthreads();
                    const bf16_t* kbase = KVRAW + (size_t)(b * NMEM) * 2048 + L * 1024 + hh * 128;
#pragma unroll
                    for (int i = 0; i < 8; ++i) { const int idx = tid + 512 * i, rw = idx >> 4, c = idx & 15;
                        *(LAS u32x4*)(lds + rw * 272 + c * 16) = *(const u32x4*)(kbase + (size_t)rw * 2048 + c * 8);
                        *(LAS u32x4*)(lds + 69632 + rw * 320 + c * 16) = *(const u32x4*)(kbase + (size_t)rw * 2048 + 512 + c * 8); }
                    __syncthreads(); }
                const float rs = row_rstd(RSQ, row);
                bf16x8 qf[8]; float ssq = 0.f;
                const bf16_t* qrow = MQB + (size_t)row * 512 + hh * 128 + 8 * h;
#pragma unroll
                for (int s2 = 0; s2 < 8; ++s2) { qf[s2] = *(const bf16x8*)(qrow + 16 * s2);
#pragma unroll
                    for (int j = 0; j < 8; ++j) { const float f = bf2f((unsigned short)qf[s2][j]) * rs; ssq += f * f; } }
                ssq += __shfl_xor(ssq, 32);
                const float qs = rs * __builtin_amdgcn_rsqf(ssq * (1.0f / 128.0f) + RMS_EPS) * (0.08838834764831845f * LOG2E);
#pragma unroll
                for (int s2 = 0; s2 < 8; ++s2) { const float* gn = mem_q_norm + L * 128 + 16 * s2 + 8 * h; const f32x4 ga = *(const f32x4*)gn, gb = *(const f32x4*)(gn + 4); u32x4 w;
#pragma unroll
                    for (int j = 0; j < 4; ++j) { const float g0_ = j < 2 ? ga[2 * j] : gb[2 * j - 4], g1_ = j < 2 ? ga[2 * j + 1] : gb[2 * j - 3];
                        w[j] = pk2(bf2f((unsigned short)qf[s2][2 * j]) * qs * g0_, bf2f((unsigned short)qf[s2][2 * j + 1]) * qs * g1_); }
                    qf[s2] = __builtin_bit_cast(bf16x8, w); }
                f32x16 oo[4]; float ll = 0.f;
#pragma unroll
                for (int d = 0; d < 4; ++d)
#pragma unroll
                    for (int i = 0; i < 16; ++i) oo[d][i] = 0.f;
#pragma unroll 1
                for (int tt = 0; tt < 4; ++tt) {
                    f32x16 p[2]; att::tile_scores<128>(p, qf, lds + tt * 64 * 272, lane);
                    float ls = 0.f;
#pragma unroll
                    for (int kt = 0; kt < 2; ++kt)
#pragma unroll
                        for (int i = 0; i < 16; ++i) { const float e = __builtin_amdgcn_exp2f(p[kt][i] - shiftM); p[kt][i] = e; ls += e; }
                    ll += ls;
                    att::tile_pv<128>(oo, p, lds + 69632 + tt * 64 * 320 - att::Geo<128>::KB, lane); }
                const float lt = ll + __shfl_xor(ll, 32);
                att::store_o<128>(oo, 1.0f / lt, OMEM + (size_t)row * 512 + hh * 128, lane);
            }
            SEAM(pb + 6);
        }
        if (RUN(pb + 7)) for (int rep_ = 0; rep_ < REPS(pb + 7); ++rep_) {
            int lane = (int)__builtin_amdgcn_mbcnt_hi(~0u, __builtin_amdgcn_mbcnt_lo(~0u, 0u)); asm volatile("" : "+v"(lane)); const int tid = wave * 64 + lane;
            pg8::Gemm g{OMEM, W_MO + (size_t)L * DM * 512, MTOK, DM, 512}; pg8::StaticOrder S; S.init(MTOK, DM, G, bid);
            pg8::EpiResid<false> E{out, XB, RSQ};
            pg8::gemm_phase<pg8::EpiResid<false>, pg8::StaticOrder, true, true>(lds, g, S, E, wave);
            SEAM(pb + 7);
        }
        if (RUN(pb + 8)) for (int rep_ = 0; rep_ < REPS(pb + 8); ++rep_) {
            int lane = (int)__builtin_amdgcn_mbcnt_hi(~0u, __builtin_amdgcn_mbcnt_lo(~0u, 0u)); asm volatile("" : "+v"(lane)); const int tid = wave * 64 + lane;
            pg8::Gemm g{XB, W_FI + (size_t)L * 5632 * DM, MTOK, 5632, DM}; pg8::StaticOrder S; S.init(MTOK, 5632, G, bid);
            pg8::EpiSwiGLU E{RSQ, HID};
            pg8::gemm_phase<pg8::EpiSwiGLU, pg8::StaticOrder, true, true>(lds, g, S, E, wave);
#ifdef PROBE_DUP_FFN
            if (L == 0) { __syncthreads(); pg8::gemm_phase<pg8::EpiSwiGLU, pg8::StaticOrder, true, true>(lds, g, S, E, wave); }
#endif
            SEAM(pb + 8);
        }
        if (RUN(pb + 9)) for (int rep_ = 0; rep_ < REPS(pb + 9); ++rep_) {
            int lane = (int)__builtin_amdgcn_mbcnt_hi(~0u, __builtin_amdgcn_mbcnt_lo(~0u, 0u)); asm volatile("" : "+v"(lane)); const int tid = wave * 64 + lane;
            pg8::Gemm g{HID, W_FO + (size_t)L * DM * DFF, MTOK, DM, DFF}; pg8::StaticOrder S; S.init(MTOK, DM, G, bid);
            if (L == 0) { pg8::EpiResid<false> E{out, XB, RSQ}; pg8::gemm_phase<pg8::EpiResid<false>, pg8::StaticOrder, true, true>(lds, g, S, E, wave); }
            else { pg8::EpiResid<true> E{out, XB, RSQ}; pg8::gemm_phase<pg8::EpiResid<true>, pg8::StaticOrder, true, true>(lds, g, S, E, wave); }
            SEAM(pb + 9);
        }
}

__global__ void __launch_bounds__(NWAVES * 64, 2) fwd_kernel(Args args) {
    extern __shared__ __attribute__((aligned(16))) unsigned char lds_raw[];
    LAS unsigned char* lds = (LAS unsigned char*)(unsigned)__builtin_amdgcn_readfirstlane((int)(unsigned)(size_t)(LAS unsigned char*)lds_raw);
    volatile LAS unsigned* MISC = (volatile LAS unsigned*)(lds + LDS_MISC);
    const int tid = threadIdx.x, lane = tid & 63, wave = __builtin_amdgcn_readfirstlane(tid >> 6);
    const int G = gridDim.x, bid = blockIdx.x;
    unsigned* ctl = (unsigned*)(args.ws + WS_CTL);
    for (int u = tid; u < (LDS_BYTES - LDS_MISC) / 4; u += NWAVES * 64) ((LAS unsigned*)(lds + LDS_MISC))[u] = 0u;
    __syncthreads();
    XcdBarrier bar = xcd_barrier_post(ctl + CW_BAR + args.li * XCD_BAR_WORDS, MISC + 8);
    const int lo = args.ph_lo, hi = args.ph_hi;

    if (RUN(0)) for (int rep_ = 0; rep_ < REPS(0); ++rep_) {
        LAS float* scr = (LAS float*)(lds + wave * 16384);
        const int gw = bid * NWAVES + wave, NGW = G * NWAVES;
        constexpr int I_AB = 16 * (AB_WP / 32), I_C = 16 * (C_WP / 32), I_O = 16 * 32, I_MQ = 16 * 16, I_KV = 16 * 32, I_MO = 8 * 32, I_FI = 16 * (5632 / 32), I_FO = (DFF / 64) * 32;
        constexpr int NITEMS = I_AB + I_C + 2 * I_O + 2 * I_MQ + 2 * I_KV + 2 * I_MO + 2 * I_FI + 2 * I_FO;
        for (int it = gw; it < NITEMS; it += NGW) {
            int r = it;
            if (r < I_AB) { const int nbn = AB_WP / 32; transpose_item(ab_w_in, DM, AB_W, W_AB, norm_mix, scr, r / nbn, r % nbn, lane, CMapProj0{}); continue; } r -= I_AB;
            if (r < I_C) { const int nbn = C_WP / 32; transpose_item(nsa_w_in, DM, C_W, W_C, norm_mix + DM, scr, r / nbn, r % nbn, lane, CMapProj1{}); continue; } r -= I_C;
            if (r < I_O) { transpose_item(ab_w_out, DM, DM, W_ABO, nullptr, scr, r / 32, r % 32, lane, CMapId{DM}); continue; } r -= I_O;
            if (r < I_O) { transpose_item(nsa_w_out, DM, DM, W_CO, nullptr, scr, r / 32, r % 32, lane, CMapId{DM}); continue; } r -= I_O;
            if (r < 2 * I_MQ) { const int L = r / I_MQ; r %= I_MQ; transpose_item(mem_w_q + (size_t)L * DM * 512, DM, 512, W_MQ + (size_t)L * 512 * DM, norm_mem + L * DM, scr, r / 16, r % 16, lane, CMapId{512}); continue; } r -= 2 * I_MQ;
            if (r < 2 * I_KV) { const int L = r / I_KV; r %= I_KV; transpose_item(mem_w_kv + (size_t)L * DM * 1024, DM, 1024, W_KV + (size_t)L * 1024 * DM, norm_mem_src + L * DM, scr, r / 32, r % 32, lane, CMapId{1024}); continue; } r -= 2 * I_KV;
            if (r < 2 * I_MO) { const int L = r / I_MO; r %= I_MO; transpose_item(mem_w_o + (size_t)L * 512 * DM, 512, DM, W_MO + (size_t)L * DM * 512, nullptr, scr, r / 32, r % 32, lane, CMapId{DM}); continue; } r -= 2 * I_MO;
            if (r < 2 * I_FI) { const int L = r / I_FI; r %= I_FI; const int nbn = 5632 / 32; transpose_item(ffn_w_in + (size_t)L * DM * 5632, DM, 5632, W_FI + (size_t)L * 5632 * DM, norm_ffn + L * DM, scr, r / nbn, r % nbn, lane, CMapFfn{}); continue; } r -= 2 * I_FI;
            { const int L = r / I_FO; r %= I_FO; transpose_item(ffn_w_out + (size_t)L * DFF * DM, DFF, DM, W_FO + (size_t)L * DM * DFF, nullptr, scr, r / 32, r % 32, lane, CMapId{DM}); }
        }
        for (int m = gw; m < MTOK; m += 4 * NGW) {
            int mr[4]; f32x4 v[4][4]; float sq[4];
#pragma unroll
            for (int q = 0; q < 4; ++q) { mr[q] = m + q * NGW < MTOK ? m + q * NGW : m; const f32x4* xr = (const f32x4*)(x_in + (size_t)mr[q] * DM) + lane;
#pragma unroll
                for (int j = 0; j < 4; ++j) v[q][j] = xr[64 * j]; }
#pragma unroll
            for (int q = 0; q < 4; ++q) { float a = 0.f;
#pragma unroll
                for (int j = 0; j < 4; ++j) a += (v[q][j][0] * v[q][j][0] + v[q][j][1] * v[q][j][1]) + (v[q][j][2] * v[q][j][2] + v[q][j][3] * v[q][j][3]);
                sq[q] = a; }
#pragma unroll
            for (int o = 1; o < 64; o <<= 1) {
#pragma unroll
                for (int q = 0; q < 4; ++q) sq[q] += __shfl_xor(sq[q], o); }
#pragma unroll
            for (int q = 0; q < 4; ++q) { u32x2* xbr = (u32x2*)(XB + (size_t)mr[q] * DM) + lane;
#pragma unroll
                for (int j = 0; j < 4; ++j) { u32x2 w; w.x = pk2(v[q][j][0], v[q][j][1]); w.y = pk2(v[q][j][2], v[q][j][3]); xbr[64 * j] = w; }
                if (lane < 16) RSQ[(size_t)mr[q] * 16 + lane] = (lane == 0) ? sq[q] : 0.f; }
        }
        for (int i = bid * 512 + tid; i < MTOK * 12; i += G * 512) {
            const int m = i / 12, k = i % 12;
            const float f64t[8] = {1.0f, 0.19392274474868576f, 0.03760603093086393f, 0.007292664737217109f, 0.001414213562373095f, 0.0002742481756762073f, 5.318295896944988e-05f, 1.031338537721246e-05f};
            float fr;
            if (k < 8) fr = f64t[k]; else { const int q = k - 8; fr = (q == 0) ? 1.0f : (q == 1) ? 0.03760603093086393f : (q == 2) ? 0.001414213562373095f : 5.318295896944988e-05f; }
            const float ang = (float)positions[m] * fr;
            const double rev = (double)ang * 0.15915494309189535; const float frac = (float)(rev - __builtin_rint(rev));
            const float c = __builtin_amdgcn_cosf(frac), sn = __builtin_amdgcn_sinf(frac);
            if (k < 8) { ROPE64[(size_t)m * 16 + k] = c; ROPE64[(size_t)m * 16 + 8 + k] = sn; } else { ROPE32[(size_t)m * 8 + (k - 8)] = c; ROPE32[(size_t)m * 8 + 4 + (k - 8)] = sn; }
        }
        for (int it = gw; it < 128; it += NGW) { const int kv = it >> 6, r = it & 63;
            transpose_item(kv ? nsa_cmp_w1_v : nsa_cmp_w1_k, 2048, 64, W1T + (size_t)kv * 64 * 2048, nullptr, scr, r >> 1, r & 1, lane, CMapId{64}); }
        for (int it = (NGW - 1 - gw); it < 128; it += NGW) { const int kv = it >> 6, c = it & 63; const float* pe = kv ? nsa_cmp_pos_v : nsa_cmp_pos_k; const float* w1 = kv ? nsa_cmp_w1_v : nsa_cmp_w1_k;
            float a = 0.f;
            for (int k0 = 0; k0 < 2048; k0 += 512) { float pv[8], wv[8];
#pragma unroll
                for (int j = 0; j < 8; ++j) { const int k = k0 + 64 * j + lane; pv[j] = pe[k]; wv[j] = w1[(size_t)k * 64 + c]; }
#pragma unroll
                for (int j = 0; j < 8; ++j) a += pv[j] * wv[j]; }
            a = wave_sum(a); if (lane == 0) POSW1[kv * 64 + c] = a; }
        for (int m = gw; m < MMEM; m += NGW) {
            const f32x4* xr = (const f32x4*)(mem_in + (size_t)m * DM) + lane; f32x4 v[4]; float s = 0.f;
#pragma unroll
            for (int j = 0; j < 4; ++j) { v[j] = xr[64 * j]; s += (v[j][0] * v[j][0] + v[j][1] * v[j][1]) + (v[j][2] * v[j][2] + v[j][3] * v[j][3]); }
            s = wave_sum(s);
            u32x2* xbr = (u32x2*)(MEMB + (size_t)m * DM) + lane;
#pragma unroll
            for (int j = 0; j < 4; ++j) { u32x2 w; w.x = pk2(v[j][0], v[j][1]); w.y = pk2(v[j][2], v[j][3]); xbr[64 * j] = w; }
            if (lane == 0) MRS[m] = __builtin_amdgcn_rsqf(s * (1.0f / 1024.0f) + RMS_EPS);
        }
        SEAM(0);
    }

    layer_phases<0>(args, lds, bar, lo, hi, wave);
    layer_phases<1>(args, lds, bar, lo, hi, wave);
#undef RUN
#undef SEAM
}
#undef INF_
#undef x_in
#undef mem_in
#undef positions
#undef norm_mix
#undef norm_mem
#undef norm_mem_src
#undef norm_ffn
#undef ab_w_in
#undef ab_w_out
#undef nsa_w_in
#undef nsa_w_out
#undef mem_w_q
#undef mem_w_kv
#undef mem_w_o
#undef ffn_w_in
#undef ffn_w_out
#undef out
#undef WSB
#undef W_AB
#undef W_C
#undef W_ABO
#undef W_CO
#undef W_MQ
#undef W_KV
#undef W_MO
#undef W_FI
#undef W_FO
#undef XB
#undef RSQ
#undef HID
#undef MEMB
#undef KVRAW
#undef MRS
#undef MQB
#undef OMEM
#undef mem_q_norm
#undef RAW
#undef OATT
#undef ROPE64
#undef ROPE32
#undef W1T
#undef POSW1
#undef KCMP
#undef VCMP
#undef GT
#undef nsa_q_norm
#undef SCR
#undef BMK
#undef KMEAN
#undef IWB
#undef dsa_q_norm
#undef dsa_k_norm
#undef moba_q_norm
#undef moba_k_norm
#undef nsa_kcmp_norm
#undef nsa_ksel_norm
#undef nsa_kwin_norm
#undef nsa_cmp_pos_k
#undef nsa_cmp_pos_v
#undef nsa_cmp_w1_k
#undef nsa_cmp_w2_k
#undef nsa_cmp_w1_v
#undef nsa_cmp_w2_v
#undef mem_k_norm

extern "C" void kernel_launch(void* const* d_in, const int* in_sizes, int n_in, void* d_out, int out_size, void* d_ws, size_t ws_size, hipStream_t stream) {
    static int grid = 0;
    if (grid == 0) {
        if (n_in != 32 || out_size != MTOK * DM || ws_size < WS_END) { fprintf(stderr, "kernel_launch: unexpected shapes (n_in %d out %d ws %zu)\n", n_in, out_size, ws_size); grid = -1; return; }
        int dev = 0, cus = 0, per_cu = 0;
        if (hipGetDevice(&dev) != hipSuccess || hipDeviceGetAttribute(&cus, hipDeviceAttributeMultiprocessorCount, dev) != hipSuccess) { grid = -1; return; }
        if (hipFuncSetAttribute((const void*)fwd_kernel, hipFuncAttributeMaxDynamicSharedMemorySize, LDS_BYTES) != hipSuccess) { fprintf(stderr, "kernel_launch: hipFuncSetAttribute failed\n"); grid = -1; return; }
        if (hipOccupancyMaxActiveBlocksPerMultiprocessor(&per_cu, (const void*)fwd_kernel, NWAVES * 64, LDS_BYTES) != hipSuccess || per_cu < 1) fprintf(stderr, "kernel_launch: occupancy query says %d\n", per_cu);
        (void)hipGetLastError();
        grid = cus;
    }
    if (grid < 0) return;
    if (hipMemsetAsync((char*)d_ws + WS_CTL, 0, CTL_ZERO_BYTES, stream) != hipSuccess) return;
    Args a{};
    for (int i = 0; i < 32; ++i) a.in[i] = d_in[i];
    a.out = (float*)d_out; a.ws = (unsigned char*)d_ws; a.pad = 0;
    const int NPH = 21;
#if 0
    for (int p = 0; p < NPH; ++p) { a.ph_lo = p; a.ph_hi = p + 1; a.li = 0; hipLaunchKernelGGL(fwd_kernel, dim3(grid), dim3(NWAVES * 64), LDS_BYTES, stream, a); }
#else
    a.ph_lo = 0; a.ph_hi = NPH; a.li = 0; hipLaunchKernelGGL(fwd_kernel, dim3(grid), dim3(NWAVES * 64), LDS_BYTES, stream, a);
#endif
}
```

```cpp
#include <hip/hip_runtime.h>
#include <cstdio>
#include <cstdint>
#include <type_traits>

#define LAS __attribute__((address_space(3)))
#define GAS __attribute__((address_space(1)))
typedef unsigned short bf16_t;
typedef short bf16x8 __attribute__((ext_vector_type(8)));
typedef short s16x4 __attribute__((ext_vector_type(4)));
typedef float f32x4 __attribute__((ext_vector_type(4)));
typedef float f32x2 __attribute__((ext_vector_type(2)));
typedef float f32x16 __attribute__((ext_vector_type(16)));
typedef unsigned u32x4 __attribute__((ext_vector_type(4)));
typedef unsigned u32x2 __attribute__((ext_vector_type(2)));
typedef __bf16 bf16x2_t __attribute__((ext_vector_type(2)));

constexpr int BATCH = 8, SEQ = 4096, DM = 1024, MTOK = BATCH * SEQ;
constexpr int NMEM = 256, MMEM = BATCH * NMEM;
constexpr int DFF = 2816;
constexpr int AB_W = 2472, AB_WP = 2560;
constexpr int C_W = 2608, C_WP = 2816;
constexpr float RMS_EPS = 1e-6f;
constexpr float LOG2E = 1.4426950408889634f;

namespace pg8 {
constexpr int BM = 256, BK = 64, HALF = 128, HTB = HALF * BK * 2, STAGE_BYTES = 8 * HTB, NXCD = 8, WGM = 4;
__host__ __device__ __forceinline__ int lds_byte(int r, int c) { const int st = (r >> 4) * 2 + (c >> 5), rr = r & 15, cc = c & 31, ob = rr * 64 + cc * 2; return st * 1024 + (ob ^ (((ob >> 9) & 1) << 5)); }
__host__ __device__ __forceinline__ void stage_rc(int b, int& R, int& C) { const int st = b / 1024, sb = b % 1024, swz = sb ^ (((sb >> 9) & 1) << 5); R = (st >> 1) * 16 + swz / 64; C = (st & 1) * 32 + (swz % 64) / 2; }
__host__ __device__ __forceinline__ int perm32(int rho) { const int n = rho >> 4, i = rho & 15; return 8 * (i >> 2) + 4 * n + (i & 3); }
struct Unit { int pm, pn; };
struct Gemm { const bf16_t* A; const bf16_t* Bt; int M, N, K; };
struct StaticOrder {
    int nM, nN, nwg, G, c;
    __host__ __device__ void init(int M, int N, int G_, int c_) { nM = M / BM; nN = N / BM; nwg = nM * nN; G = G_; c = c_; }
    __host__ __device__ bool next(int i, Unit& u) const {
        const long L = (long)i * G + c; if (L >= nwg) return false;
        int wgid = (int)L; { const int q = nwg / NXCD, r = nwg % NXCD, xcd = wgid % NXCD, off = wgid / NXCD; wgid = (xcd < r ? xcd * (q + 1) : r * (q + 1) + (xcd - r) * q) + off; }
        const int nig = WGM * nN, gid = wgid / nig, fm = gid * WGM, gsz = (nM - fm) < WGM ? (nM - fm) : WGM;
        u.pm = fm + ((wgid % nig) % gsz); u.pn = (wgid % nig) / gsz; return true;
    }
    __device__ __forceinline__ void a_ready(const Unit&) const {}
    __device__ __forceinline__ void done(const Unit&) const {}
};
__device__ __forceinline__ unsigned cvt_pk_bf16(float lo, float hi) { unsigned r; asm volatile("v_cvt_pk_bf16_f32 %0, %1, %2" : "=v"(r) : "v"(lo), "v"(hi)); return r; }

struct EpiPlain {
    static constexpr bool PERM = true, AFTER_DRAIN = false, STAGE = false;
    bf16_t* O; int ldc;
    __device__ __forceinline__ void operator()(const f32x4 (&acc)[2][2][4][2], const Unit& u, int wr, int wc, int fr, int fq) const {
        const int row0 = u.pm * BM + wr * 64 + fr, col0 = u.pn * BM + wc * 32 + 8 * fq;
#pragma unroll
        for (int ai = 0; ai < 2; ++ai)
#pragma unroll
            for (int m = 0; m < 4; ++m) { bf16_t* rowp = O + (size_t)(row0 + ai * HALF + m * 16) * ldc + col0;
#pragma unroll
                for (int bj = 0; bj < 2; ++bj) { const f32x4 v0 = acc[ai][bj][m][0], v1 = acc[ai][bj][m][1];
                    u32x4 w; w.x = cvt_pk_bf16(v0[0], v0[1]); w.y = cvt_pk_bf16(v0[2], v0[3]); w.z = cvt_pk_bf16(v1[0], v1[1]); w.w = cvt_pk_bf16(v1[2], v1[3]);
                    *(u32x4*)(rowp + bj * HALF) = w; } }
    }
};
template <bool FINAL> struct EpiResid {
    static constexpr bool PERM = true, AFTER_DRAIN = false, STAGE = false;
    float* out; bf16_t* xb; float* rsq;
    __device__ __forceinline__ void operator()(const f32x4 (&acc)[2][2][4][2], const Unit& u, int wr, int wc, int fr, int fq) const {
        const int col0 = u.pn * BM + wc * 32 + 8 * fq;
#pragma unroll
        for (int ai = 0; ai < 2; ++ai) {
            u32x4 rb[4][2];
#pragma unroll
            for (int m = 0; m < 4; ++m)
#pragma unroll
                for (int bj = 0; bj < 2; ++bj) rb[m][bj] = *(const u32x4*)(xb + (size_t)(u.pm * BM + ai * HALF + wr * 64 + m * 16 + fr) * 1024 + col0 + bj * HALF);
#pragma unroll
            for (int m = 0; m < 4; ++m) { const int row = u.pm * BM + ai * HALF + wr * 64 + m * 16 + fr; const size_t off = (size_t)row * 1024 + col0; float ss = 0.f;
#pragma unroll
                for (int bj = 0; bj < 2; ++bj) { const size_t o = off + bj * HALF; const u32x4 r4 = rb[m][bj]; float v[8];
#pragma unroll
                    for (int k = 0; k < 4; ++k) { v[2 * k] = acc[ai][bj][m][k >> 1][(2 * k) & 3] + __builtin_bit_cast(float, r4[k] << 16); v[2 * k + 1] = acc[ai][bj][m][k >> 1][(2 * k + 1) & 3] + __builtin_bit_cast(float, r4[k] & 0xffff0000u); }
                    if (FINAL) { *(f32x4*)(out + o) = (f32x4){v[0], v[1], v[2], v[3]}; *(f32x4*)(out + o + 4) = (f32x4){v[4], v[5], v[6], v[7]}; }
                    else { u32x4 w; w.x = cvt_pk_bf16(v[0], v[1]); w.y = cvt_pk_bf16(v[2], v[3]); w.z = cvt_pk_bf16(v[4], v[5]); w.w = cvt_pk_bf16(v[6], v[7]); *(u32x4*)(xb + o) = w;
#pragma unroll
                        for (int k = 0; k < 4; ++k) { const float r0 = __builtin_bit_cast(float, w[k] << 16), r1 = __builtin_bit_cast(float, w[k] & 0xffff0000u); ss += r0 * r0 + r1 * r1; } } }
                if (!FINAL) { ss += __shfl_xor(ss, 16); ss += __shfl_xor(ss, 32);
                    if (fq == 0) rsq[(size_t)row * 16 + u.pn * 4 + wc] = ss; } }
            asm volatile("" ::: "memory");
        }
    }
};
struct EpiSwiGLU {
    static constexpr bool PERM = true, AFTER_DRAIN = false, STAGE = false;
    const float* rsq; bf16_t* hid;
    __device__ __forceinline__ void operator()(const f32x4 (&acc)[2][2][4][2], const Unit& u, int wr, int wc, int fr, int fq) const {
        const int col0 = u.pn * 128 + wc * 32 + 8 * fq;
        f32x4 pr[2][4];
#pragma unroll
        for (int ai = 0; ai < 2; ++ai)
#pragma unroll
            for (int m = 0; m < 4; ++m) pr[ai][m] = *(const f32x4*)(rsq + (size_t)(u.pm * BM + ai * HALF + wr * 64 + m * 16 + fr) * 16 + 4 * fq);
#pragma unroll
        for (int ai = 0; ai < 2; ++ai)
#pragma unroll
            for (int m = 0; m < 4; ++m) { const int row = u.pm * BM + ai * HALF + wr * 64 + m * 16 + fr;
                float ss = (pr[ai][m][0] + pr[ai][m][1]) + (pr[ai][m][2] + pr[ai][m][3]);
                ss += __shfl_xor(ss, 16); ss += __shfl_xor(ss, 32);
                const float c = __builtin_amdgcn_rsqf(ss * (1.0f / 1024.0f) + RMS_EPS);
                float h[8];
#pragma unroll
                for (int n = 0; n < 2; ++n)
#pragma unroll
                    for (int e = 0; e < 4; ++e) { const float g = acc[ai][0][m][n][e] * c, uu = acc[ai][1][m][n][e] * c;
                        const float sg = g * __builtin_amdgcn_rcpf(1.0f + __builtin_amdgcn_exp2f(-g * LOG2E)); h[n * 4 + e] = sg * uu; }
                u32x4 w; w.x = cvt_pk_bf16(h[0], h[1]); w.y = cvt_pk_bf16(h[2], h[3]); w.z = cvt_pk_bf16(h[4], h[5]); w.w = cvt_pk_bf16(h[6], h[7]);
                *(u32x4*)(hid + (size_t)row * DFF + col0) = w; }
    }
};

struct ProjUnit { int kind; const float* gain; float scale; bool rope; };
template <int L> struct EpiProj {
    static constexpr bool PERM = true, AFTER_DRAIN = false, STAGE = true;
    bf16_t* O; int ldc; const float* rsq; const float* rope64; const float* rope32; const float* g0; const float* g1; const float* g2; const float* g3; float* aux; LAS unsigned char* ldsb;
    static constexpr int ROPE_STG = STAGE_BYTES;
    __device__ __forceinline__ void stage(const Unit& u, int wid, int lane) const {
        int ln = (int)__builtin_amdgcn_mbcnt_hi(~0u, __builtin_amdgcn_mbcnt_lo(~0u, 0u)); asm volatile("" : "+v"(ln));
        const float* src = rope64 + ((size_t)u.pm * BM + 32 * wid) * 16 + ln * 4;
        __builtin_amdgcn_global_load_lds((const unsigned*)src, (LAS unsigned*)(ldsb + ROPE_STG + wid * 2048), 16, 0, 0);
        __builtin_amdgcn_global_load_lds((const unsigned*)(src + 256), (LAS unsigned*)(ldsb + ROPE_STG + wid * 2048 + 1024), 16, 0, 0);
    }
    __device__ __forceinline__ ProjUnit classify(int unit) const {
        constexpr float C2 = 0.125f * LOG2E;
        if (L == 0) {
            if (unit < 8) return {1, g0, C2, true}; if (unit == 8) return {1, g1, 1.f, true}; if (unit == 9) return {2, nullptr, 1.f, false};
            if (unit < 14) return {4, nullptr, 1.f, false}; if (unit == 14) return {5, nullptr, 1.f, false};
            if (unit < 23) return {1, g2, C2, true}; if (unit < 31) return {1, g3, 1.f, true}; if (unit < 39) return {2, nullptr, 1.f, false}; return {0, nullptr, 1.f, false};
        } else {
            if (unit < 16) return {1, g0, C2, false}; if (unit < 24) return {3, nullptr, 1.f, false};
            if (unit < 28) return {1, g1, 1.f, true}; if (unit < 32) return {2, nullptr, 1.f, false}; if (unit < 36) return {1, g2, 1.f, true}; if (unit < 40) return {2, nullptr, 1.f, false};
            if (unit == 40) return {6, nullptr, 1.f, false}; return {0, nullptr, 1.f, false};
        }
    }
    __device__ __forceinline__ void operator()(const f32x4 (&acc)[2][2][4][2], const Unit& u, int wr, int wc, int fr, int fq) const {
        const int unit = 4 * u.pn + wc; const ProjUnit pu = classify(unit);
        if (pu.kind == 0) return;
        const unsigned ropeb = (unsigned)(size_t)(ldsb + ROPE_STG) + (unsigned)(wr * 64 + fr) * 64u;
        float gl[2][8];
        if (pu.kind == 1) {
#pragma unroll
            for (int bj = 0; bj < 2; ++bj) { const f32x4 a = *(const f32x4*)(pu.gain + 8 * (2 * fq + bj)), b = *(const f32x4*)(pu.gain + 8 * (2 * fq + bj) + 4);
#pragma unroll
                for (int x = 0; x < 4; ++x) { gl[bj][x] = a[x] * pu.scale; gl[bj][4 + x] = b[x] * pu.scale; } }
        }
        float rsv[2][4];
        if (pu.kind != 3) { f32x4 pr[2][4];
#pragma unroll
            for (int ai = 0; ai < 2; ++ai)
#pragma unroll
                for (int m = 0; m < 4; ++m) pr[ai][m] = *(const f32x4*)(rsq + (size_t)(u.pm * BM + ai * HALF + wr * 64 + m * 16 + fr) * 16 + 4 * fq);
#pragma unroll
            for (int ai = 0; ai < 2; ++ai)
#pragma unroll
                for (int m = 0; m < 4; ++m) { float ss = (pr[ai][m][0] + pr[ai][m][1]) + (pr[ai][m][2] + pr[ai][m][3]); ss += __shfl_xor(ss, 16); ss += __shfl_xor(ss, 32);
                    rsv[ai][m] = __builtin_amdgcn_rsqf(ss * (1.0f / 1024.0f) + RMS_EPS); } }
        else {
#pragma unroll
            for (int ai = 0; ai < 2; ++ai)
#pragma unroll
                for (int m = 0; m < 4; ++m) rsv[ai][m] = 1.f; }
#pragma unroll
        for (int ai = 0; ai < 2; ++ai)
#pragma unroll
            for (int m = 0; m < 4; ++m) { const int row = u.pm * BM + ai * HALF + wr * 64 + m * 16 + fr;
                const float rs = rsv[ai][m];
                float v[2][8];
#pragma unroll
                for (int bj = 0; bj < 2; ++bj)
#pragma unroll
                    for (int e = 0; e < 8; ++e) v[bj][e] = acc[ai][bj][m][e >> 2][e & 3] * rs;
                if (pu.kind == 1) {
                    float ss = 0.f;
#pragma unroll
                    for (int bj = 0; bj < 2; ++bj)
#pragma unroll
                        for (int e = 0; e < 8; ++e) ss += v[bj][e] * v[bj][e];
                    ss += __shfl_xor(ss, 16); ss += __shfl_xor(ss, 32);
                    const float rn = __builtin_amdgcn_rsqf(ss * (1.0f / 64.0f) + RMS_EPS);
#pragma unroll
                    for (int bj = 0; bj < 2; ++bj)
#pragma unroll
                        for (int e = 0; e < 8; ++e) v[bj][e] = v[bj][e] * rn * gl[bj][e];
                    if (pu.rope && fq == 0) {
                        const LAS float* cs = (const LAS float*)(size_t)(ropeb + (ai * HALF + m * 16) * 64); const f32x4 c0 = *(const LAS f32x4*)cs, c1 = *(const LAS f32x4*)(cs + 4), s0 = *(const LAS f32x4*)(cs + 8), s1 = *(const LAS f32x4*)(cs + 12);
#pragma unroll
                        for (int e = 0; e < 8; ++e) { const float c = e < 4 ? c0[e & 3] : c1[e & 3], sn = e < 4 ? s0[e & 3] : s1[e & 3]; const float x1 = v[0][e], x2 = v[1][e];
                            v[0][e] = x1 * c - x2 * sn; v[1][e] = x2 * c + x1 * sn; }
                    }
                }
                if (pu.kind == 4 || pu.kind == 5) {
                    if (fq == 0 || (fq == 2 && pu.kind == 4)) { const LAS float* cs = (const LAS float*)(size_t)(ropeb + (ai * HALF + m * 16) * 64);
                        const f32x4 ca = *(const LAS f32x4*)cs, cb = *(const LAS f32x4*)(cs + 4), sa = *(const LAS f32x4*)(cs + 8), sb = *(const LAS f32x4*)(cs + 12);
                        const f32x4 c = {ca[0], ca[2], cb[0], cb[2]}, sn = {sa[0], sa[2], sb[0], sb[2]};
#pragma unroll
                        for (int x = 0; x < 4; ++x) { const float a = v[0][x], b = v[0][4 + x]; v[0][x] = a * c[x] - b * sn[x]; v[0][4 + x] = b * c[x] + a * sn[x]; } }
                    if (pu.kind == 5 && fq == 2) { *(f32x4*)(aux + (size_t)row * 8) = (f32x4){v[0][0], v[0][1], v[0][2], v[0][3]}; *(f32x4*)(aux + (size_t)row * 8 + 4) = (f32x4){v[0][4], v[0][5], v[0][6], v[0][7]}; }
                }
                if (pu.kind == 6) {
#pragma unroll
                    for (int bj = 0; bj < 2; ++bj) if (2 * fq + bj < 6) {
#pragma unroll
                        for (int e = 0; e < 8; ++e) v[bj][e] = __builtin_amdgcn_rcpf(1.0f + __builtin_amdgcn_exp2f(-v[bj][e] * LOG2E));
                        float* ap = aux + (size_t)row * 48 + 8 * (2 * fq + bj);
                        *(f32x4*)ap = (f32x4){v[bj][0], v[bj][1], v[bj][2], v[bj][3]}; *(f32x4*)(ap + 4) = (f32x4){v[bj][4], v[bj][5], v[bj][6], v[bj][7]}; }
                } else {
                    bf16_t* orow = O + (size_t)row * ldc + 64 * unit + 16 * fq;
                    u32x4 w0, w1;
                    w0.x = cvt_pk_bf16(v[0][0], v[0][1]); w0.y = cvt_pk_bf16(v[0][2], v[0][3]); w0.z = cvt_pk_bf16(v[0][4], v[0][5]); w0.w = cvt_pk_bf16(v[0][6], v[0][7]);
                    w1.x = cvt_pk_bf16(v[1][0], v[1][1]); w1.y = cvt_pk_bf16(v[1][2], v[1][3]); w1.z = cvt_pk_bf16(v[1][4], v[1][5]); w1.w = cvt_pk_bf16(v[1][6], v[1][7]);
                    *(u32x4*)orow = w0; *(u32x4*)(orow + 8) = w1;
                }
                if (m & 1) asm volatile("" ::: "memory"); }
    }
};

template <class Epi, class Sched, bool ALIGN_EPI = false, bool SP2 = false>
__device__ __forceinline__ void gemm_phase(LAS unsigned char* lds, const Gemm g, const Sched& S, const Epi& E, const int wave_id) {
    int tid = wave_id * 64 + (int)__builtin_amdgcn_mbcnt_hi(~0u, __builtin_amdgcn_mbcnt_lo(~0u, 0u)); asm volatile("" : "+v"(tid));
    const int wid = wave_id, lane = tid & 63, wr = wid >> 2, wc = wid & 3, fr = lane & 15, fq = lane >> 4;
    const int K = g.K, nt = K / BK;
    unsigned voffA[2], voffB[2];
#pragma unroll
    for (int i = 0; i < 2; ++i) { int R, C; stage_rc(tid * 16 + i * 8192, R, C); const int Rb = Epi::PERM ? ((R & ~31) + perm32(R & 31)) : R;
        voffA[i] = (unsigned)(R * K + C) * 2u; voffB[i] = (unsigned)(Rb * K + C) * 2u; }
    const size_t kstep = (size_t)(BK * 2);
    const size_t hstep = (size_t)HALF * K * 2;
    const size_t tstep = 2 * hstep;
    const unsigned ldsw = (unsigned)wid * 1024u;
    const int aoff = lds_byte(wr * 64 + fr, fq * 8), boff = lds_byte(wc * 32 + fr, fq * 8);
#define PG8_SA(b, h) (((b) * 2 + (h)) * HTB)
#define PG8_SB(b, h) ((4 + (b) * 2 + (h)) * HTB)
#define PG8_STAGE(bufoff, gbase, voff) do { _Pragma("unroll") for (int _i = 0; _i < 2; ++_i) \
        __builtin_amdgcn_global_load_lds((const unsigned*)((const char*)(gbase) + (voff)[_i]), (LAS unsigned*)(lds + (bufoff) + ldsw + _i * 8192), 16, 0, 0); } while (0)
#define PG8_LDA(dst, b, h) do { _Pragma("unroll") for (int m = 0; m < 4; ++m) _Pragma("unroll") for (int k = 0; k < 2; ++k) dst[m][k] = *(const LAS bf16x8*)(lds + PG8_SA(b, h) + aoff + m * 2048 + k * 1024); } while (0)
#define PG8_LDB(dst, b, h) do { _Pragma("unroll") for (int n = 0; n < 2; ++n) _Pragma("unroll") for (int k = 0; k < 2; ++k) dst[n][k] = *(const LAS bf16x8*)(lds + PG8_SB(b, h) + boff + n * 2048 + k * 1024); } while (0)
#define PG8_MMA(ai, bj, At, Bt) do { __builtin_amdgcn_s_setprio(1); _Pragma("unroll") for (int m = 0; m < 4; ++m) _Pragma("unroll") for (int n = 0; n < 2; ++n) _Pragma("unroll") for (int k = 0; k < 2; ++k) \
        acc[ai][bj][m][n] = __builtin_amdgcn_mfma_f32_16x16x32_bf16(Bt[n][k], At[m][k], acc[ai][bj][m][n], 0, 0, 0); __builtin_amdgcn_s_setprio(0); } while (0)
#define PG8_WAIT_V(n) asm volatile("s_waitcnt vmcnt(" #n ")" ::: "memory")
#define PG8_WAIT_L(n) asm volatile("s_waitcnt lgkmcnt(" #n ")" ::: "memory")
#define PG8_BAR __builtin_amdgcn_s_barrier()
#define PG8_SCHED __builtin_amdgcn_sched_barrier(0)
    Unit cur, nxt; int ui = 0;
    if (!S.next(0, cur)) return;
    f32x4 acc[2][2][4][2];
#pragma unroll
    for (int a = 0; a < 2; ++a)
#pragma unroll
        for (int b = 0; b < 2; ++b)
#pragma unroll
            for (int m = 0; m < 4; ++m)
#pragma unroll
                for (int n = 0; n < 2; ++n) acc[a][b][m][n] = (f32x4){0.f, 0.f, 0.f, 0.f};
    bf16x8 At[4][2], B0[2][2], B1[2][2];
    const char* cA = (const char*)g.A + (size_t)cur.pm * tstep; const char* cB = (const char*)g.Bt + (size_t)cur.pn * tstep;
    S.a_ready(cur);
    if constexpr (Epi::STAGE) E.stage(cur, wid, 0);
    if constexpr (SP2) {
        PG8_STAGE(PG8_SB(0, 0), cB, voffB); PG8_STAGE(PG8_SB(0, 1), cB + hstep, voffB); PG8_STAGE(PG8_SA(0, 0), cA, voffA); PG8_STAGE(PG8_SA(0, 1), cA + hstep, voffA);
        if (wr == 1) PG8_BAR;
        PG8_WAIT_V(2); PG8_BAR;
        PG8_STAGE(PG8_SB(1, 0), cB + kstep, voffB); PG8_STAGE(PG8_SA(1, 0), cA + kstep, voffA); PG8_STAGE(PG8_SB(1, 1), cB + hstep + kstep, voffB);
        PG8_WAIT_V(6); PG8_BAR;
    } else {
        PG8_STAGE(PG8_SB(0, 0), cB, voffB); PG8_STAGE(PG8_SA(0, 0), cA, voffA); PG8_STAGE(PG8_SB(0, 1), cB + hstep, voffB); PG8_STAGE(PG8_SA(0, 1), cA + hstep, voffA);
        if (wr == 1) PG8_BAR;
        PG8_WAIT_V(4); PG8_BAR;
        PG8_STAGE(PG8_SB(1, 0), cB + kstep, voffB); PG8_STAGE(PG8_SA(1, 0), cA + kstep, voffA); PG8_STAGE(PG8_SB(1, 1), cB + hstep + kstep, voffB);
        PG8_WAIT_V(6); PG8_BAR;
    }
    for (;;) {
        const bool has_next = S.next(ui + 1, nxt);
        const char* nA = has_next ? (const char*)g.A + (size_t)nxt.pm * tstep : cA; const char* nB = has_next ? (const char*)g.Bt + (size_t)nxt.pn * tstep : cB;
        for (int t = 0; t < nt; t += 2) {
            const bool last = (t == nt - 2);
            const char* a1 = cA + (size_t)(t + 1) * kstep;
            const char* a2 = last ? nA : cA + (size_t)(t + 2) * kstep; const char* b2 = last ? nB : cB + (size_t)(t + 2) * kstep;
            const char* a3 = a2 + kstep; const char* b3 = b2 + kstep;
            if (last && has_next) S.a_ready(nxt);
            if constexpr (SP2) {
            PG8_LDB(B0, 0, 0); PG8_LDB(B1, 0, 1); PG8_SCHED; PG8_LDA(At, 0, 0); PG8_STAGE(PG8_SA(1, 1), a1 + hstep, voffA);
            PG8_WAIT_V(8); PG8_WAIT_L(0); PG8_BAR; PG8_MMA(0, 0, At, B0); PG8_MMA(0, 1, At, B1); PG8_BAR; PG8_SCHED;
            PG8_LDA(At, 0, 1); PG8_STAGE(PG8_SB(0, 0), b2, voffB); PG8_STAGE(PG8_SB(0, 1), b2 + hstep, voffB); PG8_STAGE(PG8_SA(0, 0), a2, voffA);
            PG8_WAIT_V(8); PG8_WAIT_L(0); PG8_BAR; PG8_MMA(1, 0, At, B0); PG8_MMA(1, 1, At, B1); PG8_BAR; PG8_SCHED;
            PG8_LDB(B0, 1, 0); PG8_LDB(B1, 1, 1); PG8_SCHED; PG8_LDA(At, 1, 0); PG8_STAGE(PG8_SA(0, 1), a2 + hstep, voffA);
            PG8_WAIT_V(8); PG8_WAIT_L(0); PG8_BAR; PG8_MMA(0, 0, At, B0); PG8_MMA(0, 1, At, B1); PG8_BAR; PG8_SCHED;
            PG8_LDA(At, 1, 1); PG8_STAGE(PG8_SB(1, 0), b3, voffB); PG8_STAGE(PG8_SB(1, 1), b3 + hstep, voffB); PG8_STAGE(PG8_SA(1, 0), a3, voffA);
            PG8_WAIT_V(8); PG8_WAIT_L(0); PG8_BAR; PG8_MMA(1, 0, At, B0); PG8_MMA(1, 1, At, B1); PG8_BAR; PG8_SCHED;
            } else {
            PG8_LDB(B0, 0, 0); PG8_SCHED; PG8_LDA(At, 0, 0); PG8_STAGE(PG8_SA(1, 1), a1 + hstep, voffA);
            PG8_WAIT_L(8); PG8_BAR; PG8_WAIT_L(0); PG8_MMA(0, 0, At, B0); PG8_BAR; PG8_SCHED;
            PG8_LDB(B1, 0, 1); PG8_STAGE(PG8_SB(0, 0), b2, voffB);
            PG8_BAR; PG8_WAIT_L(0); PG8_MMA(0, 1, At, B1); PG8_BAR;
            PG8_LDA(At, 0, 1); PG8_STAGE(PG8_SA(0, 0), a2, voffA);
            PG8_BAR; PG8_WAIT_L(0); PG8_MMA(1, 0, At, B0); PG8_BAR; PG8_SCHED;
            PG8_STAGE(PG8_SB(0, 1), b2 + hstep, voffB);
            PG8_WAIT_V(6); PG8_BAR; PG8_MMA(1, 1, At, B1); PG8_BAR;
            PG8_LDB(B0, 1, 0); PG8_SCHED; PG8_LDA(At, 1, 0); PG8_STAGE(PG8_SA(0, 1), a2 + hstep, voffA);
            PG8_WAIT_L(8); PG8_BAR; PG8_WAIT_L(0); PG8_MMA(0, 0, At, B0); PG8_BAR; PG8_SCHED;
            PG8_LDB(B1, 1, 1); PG8_STAGE(PG8_SB(1, 0), b3, voffB);
            PG8_BAR; PG8_WAIT_L(0); PG8_MMA(0, 1, At, B1); PG8_BAR;
            PG8_LDA(At, 1, 1); PG8_STAGE(PG8_SA(1, 0), a3, voffA);
            PG8_BAR; PG8_WAIT_L(0); PG8_MMA(1, 0, At, B0); PG8_BAR; PG8_SCHED;
            PG8_STAGE(PG8_SB(1, 1), b3 + hstep, voffB);
            PG8_WAIT_V(6); PG8_BAR; PG8_MMA(1, 1, At, B1); PG8_BAR;
            }
        }
        if constexpr (ALIGN_EPI) { if (wr == 0) PG8_BAR; }
        if constexpr (!Epi::AFTER_DRAIN) { int l2 = (int)__builtin_amdgcn_mbcnt_hi(~0u, __builtin_amdgcn_mbcnt_lo(~0u, 0u)); asm volatile("" : "+v"(l2));
            E(acc, cur, wr, wc, l2 & 15, l2 >> 4); S.done(cur); }
        if (!has_next) break;
#pragma unroll
        for (int a = 0; a < 2; ++a)
#pragma unroll
            for (int b = 0; b < 2; ++b)
#pragma unroll
                for (int m = 0; m < 4; ++m)
#pragma unroll
                    for (int n = 0; n < 2; ++n) acc[a][b][m][n] = (f32x4){0.f, 0.f, 0.f, 0.f};
        cur = nxt; cA = nA; cB = nB; ++ui;
        if constexpr (Epi::STAGE) { PG8_BAR; E.stage(cur, wid, 0); }
        if constexpr (ALIGN_EPI) { if (wr == 1) PG8_BAR; }
    }
    PG8_WAIT_V(0);
    if constexpr (!ALIGN_EPI) { if (wr == 0) PG8_BAR; }
    PG8_BAR;
#undef PG8_SA
#undef PG8_SB
#undef PG8_STAGE
#undef PG8_LDA
#undef PG8_LDB
#undef PG8_MMA
#undef PG8_WAIT_V
#undef PG8_WAIT_L
#undef PG8_BAR
#undef PG8_SCHED
}
}

#define XB_TMO      128
#define XB_XCNT(j)  (256  + 64 * (j))
#define XB_XSUB(j)  (1280 + 64 * (j))
#define XB_XGEN(j)  (2304 + 64 * (j))
#define XB_TOP      3328
#define XB_TOPGEN   3392
#define XCD_BAR_WORDS 3456
#define XB_SPIN_CAP (1u << 18)
__device__ __forceinline__ unsigned xb_ld(unsigned* p)              { return __hip_atomic_load(p, __ATOMIC_RELAXED, __HIP_MEMORY_SCOPE_AGENT); }
__device__ __forceinline__ unsigned xb_add(unsigned* p, unsigned v) { return __hip_atomic_fetch_add(p, v, __ATOMIC_RELAXED, __HIP_MEMORY_SCOPE_AGENT); }
__device__ __forceinline__ unsigned xb_xcc_id() { return (unsigned)__builtin_amdgcn_s_getreg((3 << 11) | 20) & 0xFu; }
#define XB_SPIN(cond, bar) do { unsigned _sp = 0; while (cond) { __builtin_amdgcn_s_sleep(1); \
    if ((++_sp & 255u) == 0u) { if (xb_ld(&(bar)[XB_TMO])) break; if (_sp > XB_SPIN_CAP) { atomicAdd(&(bar)[XB_TMO], 1u); break; } } } } while (0)
struct XcdBarrier { unsigned* bar; unsigned x; volatile LAS unsigned* st; };
__device__ __forceinline__ XcdBarrier xcd_barrier_post(unsigned* bar, volatile LAS unsigned* st) {
    XcdBarrier b; b.bar = bar; b.x = xb_xcc_id(); b.st = st;
    if (threadIdx.x == 0) (void)xb_add(&bar[XB_XCNT(b.x)], 1u);
    return b;
}
__device__ __forceinline__ void xcd_barrier_complete(unsigned* bar, unsigned x, unsigned& nloc, unsigned& nx) {
    const unsigned G = gridDim.x * gridDim.y * gridDim.z;
    unsigned sum, cnt, mine, sp = 0u;
    for (;;) {
        sum = 0u; cnt = 0u; mine = 0u;
#pragma unroll
        for (unsigned j = 0; j < 16; ++j) { const unsigned c = xb_ld(&bar[XB_XCNT(j)]); sum += c; cnt += (c > 0u) ? 1u : 0u; mine = (j == x) ? c : mine; }
        if (sum == G) break;
        __builtin_amdgcn_s_sleep(1);
        if ((++sp & 255u) == 0u) { if (xb_ld(&bar[XB_TMO])) break; if (sp > XB_SPIN_CAP) { atomicAdd(&bar[XB_TMO], 1u); break; } }
    }
    nloc = mine > 0u ? mine : 1u; nx = cnt > 0u ? cnt : 1u;
}
__device__ __forceinline__ void xcd_barrier(const XcdBarrier& b) {
    asm volatile("s_waitcnt vmcnt(0)" ::: "memory");
    __syncthreads();
    if (threadIdx.x == 0) {
        unsigned* bar = b.bar;
        __builtin_amdgcn_s_waitcnt(0);
        unsigned nloc = b.st[0], nx = b.st[1]; const unsigned g = b.st[2];
        if (nloc == 0u) { xcd_barrier_complete(bar, b.x, nloc, nx); b.st[0] = nloc; b.st[1] = nx; }
        const unsigned old = xb_add(&bar[XB_XSUB(b.x)], 1u);
        if (old + 1u == (g + 1u) * nloc) {
            __builtin_amdgcn_fence(__ATOMIC_RELEASE, "agent");
            asm volatile("s_waitcnt vmcnt(0)" ::: "memory");
            const unsigned og = xb_add(&bar[XB_TOP], 1u);
            if (og + 1u == (g + 1u) * nx) xb_add(&bar[XB_TOPGEN], 1u);
        }
        XB_SPIN(xb_ld(&bar[XB_TOPGEN]) == g, bar);
        __builtin_amdgcn_fence(__ATOMIC_ACQUIRE, "agent");
        asm volatile("s_waitcnt vmcnt(0)" ::: "memory");
        b.st[2] = g + 1u;
    }
    __syncthreads();
}

constexpr size_t MiB = 1u << 20;
constexpr size_t WS_CTL = 0, CTL_ZERO_BYTES = 1 * MiB;
constexpr int CW_BAR = 4096;
constexpr size_t WS_WAB = 1 * MiB;
constexpr size_t WS_WC = WS_WAB + (size_t)AB_WP * DM * 2;
constexpr size_t WS_WABO = WS_WC + (size_t)C_WP * DM * 2;
constexpr size_t WS_WCO = WS_WABO + (size_t)DM * DM * 2;
constexpr size_t WS_WMQ = WS_WCO + (size_t)DM * DM * 2;
constexpr size_t WS_WKV = WS_WMQ + (size_t)2 * 512 * DM * 2;
constexpr size_t WS_WMO = WS_WKV + (size_t)2048 * DM * 2;
constexpr size_t WS_WFI = WS_WMO + (size_t)2 * DM * 512 * 2;
constexpr size_t WS_WFO = WS_WFI + (size_t)2 * 5632 * DM * 2;
constexpr size_t WS_WEND = WS_WFO + (size_t)2 * DM * DFF * 2;
constexpr size_t WS_MISC = 64 * MiB;
static_assert(WS_WEND <= WS_MISC, "weights fit");
constexpr size_t WS_ROPE64 = WS_MISC;
constexpr size_t WS_ROPE32 = WS_ROPE64 + (size_t)MTOK * 16 * 4;
constexpr size_t WS_RSQ = WS_ROPE32 + (size_t)MTOK * 8 * 4;
constexpr size_t WS_MRS = WS_RSQ + (size_t)MTOK * 16 * 4;
constexpr size_t WS_MEMB = WS_MRS + 8192;
constexpr size_t WS_KVRAW = WS_MEMB + (size_t)MMEM * DM * 2;
constexpr size_t WS_W1T = WS_KVRAW + (size_t)MMEM * 2048 * 2;
constexpr size_t WS_POSW1 = WS_W1T + (size_t)2 * 64 * 2048 * 2;
constexpr size_t WS_KCMP = WS_POSW1 + 512;
constexpr size_t WS_VCMP = WS_KCMP + (size_t)BATCH * 4 * 256 * 64 * 2;
constexpr size_t WS_MISCEND = WS_VCMP + (size_t)BATCH * 4 * 256 * 64 * 2;
constexpr size_t WS_XB = 96 * MiB;
static_assert(WS_MISCEND <= WS_XB, "misc fits");
constexpr size_t WS_R1 = 160 * MiB;
constexpr size_t WS_OATT = 336 * MiB;
constexpr size_t WS_R3 = 400 * MiB;
constexpr size_t WS_GT = WS_R3;
constexpr size_t WS_MQ = WS_R3;
constexpr size_t WS_OMEM = WS_R3 + (size_t)MTOK * 512 * 2;
constexpr size_t WS_SC = WS_OATT;
constexpr size_t WS_BM = 464 * MiB;
constexpr size_t WS_KM = 480 * MiB;
constexpr size_t WS_ISG = 481 * MiB;
constexpr size_t WS_END = 512 * MiB;
static_assert(WS_R1 + (size_t)MTOK * C_WP * 2 <= WS_OATT, "R1 fits");

constexpr int LDS_BYTES = 155648;
constexpr int LDS_MISC = 151552;
constexpr int NWAVES = 8;

__device__ __forceinline__ unsigned f2bf(float f) { unsigned u = __builtin_bit_cast(unsigned, f); return (u + 0x7fffu + ((u >> 16) & 1u)) >> 16; }
__device__ __forceinline__ unsigned pk2(float lo, float hi) { f32x2 v = {lo, hi}; bf16x2_t b = __builtin_convertvector(v, bf16x2_t); return __builtin_bit_cast(unsigned, b); }
__device__ __forceinline__ float bf2f(unsigned short b) { return __builtin_bit_cast(float, (unsigned)b << 16); }
__device__ __forceinline__ float wave_sum(float v) {
#pragma unroll
    for (int o = 1; o < 64; o <<= 1) v += __shfl_xor(v, o);
    return v;
}


namespace att {
constexpr float NEG_INF = -__builtin_huge_valf();
template <int HD> struct Geo { static constexpr int PK = HD * 2 + 16, PV = (HD == 64 ? 192 : 320), KB = 64 * PK, VB = 64 * PV, BUF = KB + VB; };
template <int HD> struct State { f32x16 o[HD / 32]; float m, l;
    __device__ __forceinline__ void init() {
#pragma unroll
        for (int d = 0; d < HD / 32; ++d)
#pragma unroll
            for (int i = 0; i < 16; ++i) o[d][i] = 0.f;
        m = NEG_INF; l = 0.f; } };
template <int HD> struct TileRegs { u32x4 k[HD / 64], v[HD / 64]; };
template <int HD> __device__ __forceinline__ void load_tile(TileRegs<HD>& tr, const bf16_t* kb, size_t kp, const bf16_t* vb, size_t vp, int tid) {
#pragma unroll
    for (int i = 0; i < HD / 64; ++i) { const int idx = tid + 512 * i, row = idx / (HD / 8), c = idx % (HD / 8);
        tr.k[i] = *(const u32x4*)(kb + (size_t)row * kp + c * 8); tr.v[i] = *(const u32x4*)(vb + (size_t)row * vp + c * 8); }
}
template <int HD> __device__ __forceinline__ void store_tile(const TileRegs<HD>& tr, LAS unsigned char* buf, int tid) {
#pragma unroll
    for (int i = 0; i < HD / 64; ++i) { const int idx = tid + 512 * i, row = idx / (HD / 8), c = idx % (HD / 8);
        *(LAS u32x4*)(buf + row * Geo<HD>::PK + c * 16) = tr.k[i]; *(LAS u32x4*)(buf + Geo<HD>::KB + row * Geo<HD>::PV + c * 16) = tr.v[i]; }
}
__device__ __forceinline__ s16x4 tr_read(const LAS unsigned char* p) { typedef short v4i16_t __attribute__((ext_vector_type(4)));
    return __builtin_bit_cast(s16x4, __builtin_amdgcn_ds_read_tr16_b64_v4i16((LAS v4i16_t*)p)); }
__device__ __forceinline__ bf16x8 pack8(const f32x16& x, int s8) {
    u32x4 w; w.x = pk2(x[s8], x[s8 + 1]); w.y = pk2(x[s8 + 2], x[s8 + 3]); w.z = pk2(x[s8 + 4], x[s8 + 5]); w.w = pk2(x[s8 + 6], x[s8 + 7]); return __builtin_bit_cast(bf16x8, w); }
template <int HD> __device__ __forceinline__ void tile_scores(f32x16 (&p)[2], const bf16x8 (&qf)[HD / 16], const LAS unsigned char* buf, int lane) {
    const int r = lane & 31, h = lane >> 5;
#pragma unroll
    for (int kt = 0; kt < 2; ++kt) { f32x16 x;
#pragma unroll
        for (int i = 0; i < 16; ++i) x[i] = 0.f;
#pragma unroll
        for (int s = 0; s < HD / 16; ++s) { const bf16x8 kf = *(const LAS bf16x8*)(buf + (32 * kt + r) * Geo<HD>::PK + 32 * s + 16 * h); x = __builtin_amdgcn_mfma_f32_32x32x16_bf16(kf, qf[s], x, 0, 0, 0); }
        p[kt] = x; }
}
template <int HD> __device__ __forceinline__ void tile_pv(f32x16 (&o)[HD / 32], const f32x16 (&p)[2], const LAS unsigned char* buf, int lane) {
    const int h = lane >> 5, blk = (lane >> 4) & 1, q = (lane & 15) >> 2, pp = lane & 3;
    const LAS unsigned char* vb = buf + Geo<HD>::KB + (4 * h + q) * Geo<HD>::PV + 32 * blk + 8 * pp;
#pragma unroll
    for (int kt = 0; kt < 2; ++kt)
#pragma unroll
        for (int s = 0; s < 2; ++s) { const bf16x8 pb = pack8(p[kt], 8 * s);
#pragma unroll
            for (int dh = 0; dh < HD / 32; ++dh) { const LAS unsigned char* a = vb + (32 * kt + 16 * s) * Geo<HD>::PV + 64 * dh;
                const s16x4 lo = tr_read(a), hi = tr_read(a + 8 * Geo<HD>::PV);
                const bf16x8 vf = __builtin_shufflevector(lo, hi, 0, 1, 2, 3, 4, 5, 6, 7);
                o[dh] = __builtin_amdgcn_mfma_f32_32x32x16_bf16(vf, pb, o[dh], 0, 0, 0); } }
}
template <int HD, class MaskF> __device__ __forceinline__ void tile_step(State<HD>& st, const bf16x8 (&qf)[HD / 16], const LAS unsigned char* buf, int lane, MaskF valid) {
    f32x16 p[2]; tile_scores<HD>(p, qf, buf, lane);
    float mx = NEG_INF;
#pragma unroll
    for (int kt = 0; kt < 2; ++kt)
#pragma unroll
        for (int i = 0; i < 16; ++i) { const int koff = 32 * kt + (i & 3) + 8 * (i >> 2); const float v = valid(koff) ? p[kt][i] : NEG_INF; p[kt][i] = v; mx = fmaxf(mx, v); }
    mx = fmaxf(mx, __shfl_xor(mx, 32));
    const float mnew = fmaxf(st.m, mx), muse = (mnew == NEG_INF) ? 0.f : mnew;
    const float alpha = __builtin_amdgcn_exp2f(st.m - muse);
    float ls = 0.f;
#pragma unroll
    for (int kt = 0; kt < 2; ++kt)
#pragma unroll
        for (int i = 0; i < 16; ++i) { const float e = __builtin_amdgcn_exp2f(p[kt][i] - muse); p[kt][i] = e; ls += e; }
    st.l = st.l * alpha + ls; st.m = mnew;
#pragma unroll
    for (int dh = 0; dh < HD / 32; ++dh)
#pragma unroll
        for (int i = 0; i < 16; ++i) st.o[dh][i] *= alpha;
    tile_pv<HD>(st.o, p, buf, lane);
}
template <int HD, class SrcF, class CompF> __device__ __forceinline__ void kv_pipeline(LAS unsigned char* lds, int nt, int tid, SrcF src, CompF comp) {
    TileRegs<HD> tr; const bf16_t *kb, *vb; size_t kp, vp;
    __syncthreads();
    if (nt <= 0) return;
    src(0, kb, kp, vb, vp); load_tile<HD>(tr, kb, kp, vb, vp, tid); store_tile<HD>(tr, lds, tid);
    __syncthreads();
    for (int t = 0; t < nt; ++t) {
        if (t + 1 < nt) { src(t + 1, kb, kp, vb, vp); load_tile<HD>(tr, kb, kp, vb, vp, tid); }
        comp(t, lds + (t & 1) * Geo<HD>::BUF);
        if (t + 1 < nt) store_tile<HD>(tr, lds + ((t + 1) & 1) * Geo<HD>::BUF, tid);
        __syncthreads();
    }
}

template <int HD, bool PIPE, class SrcF, class ActF, class FinF> __device__ __forceinline__ void kv_pipeline3(LAS unsigned char* lds, int nt, int tid, int lane, const bf16x8 (&qf)[HD / 16], SrcF src, ActF act, FinF fin) {
    TileRegs<HD> tr; const bf16_t *kb, *vb; size_t kp, vp;
    __syncthreads();
    if (nt <= 0) return;
    src(0, kb, kp, vb, vp); load_tile<HD>(tr, kb, kp, vb, vp, tid); store_tile<HD>(tr, lds, tid);
    if (nt > 1) { src(1, kb, kp, vb, vp); load_tile<HD>(tr, kb, kp, vb, vp, tid); store_tile<HD>(tr, lds + Geo<HD>::BUF, tid); }
    __syncthreads();
    f32x16 pc[2], pn[2];
    if constexpr (PIPE) { if (act(0)) tile_scores<HD>(pc, qf, lds, lane); }
    int b0 = 0, b1 = 1, b2 = 2;
    for (int t = 0; t < nt; ++t) {
        if (t + 2 < nt) { src(t + 2, kb, kp, vb, vp); load_tile<HD>(tr, kb, kp, vb, vp, tid); }
        if constexpr (PIPE) {
            const bool an = (t + 1 < nt) && act(t + 1);
            if (an) tile_scores<HD>(pn, qf, lds + b1 * Geo<HD>::BUF, lane);
            if (act(t)) fin(t, pc, lds + b0 * Geo<HD>::BUF);
        } else {
            if (act(t)) { tile_scores<HD>(pc, qf, lds + b0 * Geo<HD>::BUF, lane); fin(t, pc, lds + b0 * Geo<HD>::BUF); }
        }
        if (t + 2 < nt) store_tile<HD>(tr, lds + b2 * Geo<HD>::BUF, tid);
        __syncthreads();
        if constexpr (PIPE) {
#pragma unroll
            for (int k = 0; k < 2; ++k) pc[k] = pn[k]; }
        const int tb = b0; b0 = b1; b1 = b2; b2 = tb;
    }
}
template <int HD, class MaskF> __device__ __forceinline__ void tile_finish(State<HD>& st, f32x16 (&p)[2], const LAS unsigned char* buf, int lane, bool lane_ok, bool elem, MaskF valid) {
    float mx = fmaxf(p[0][0], p[1][0]);
#pragma unroll
    for (int i = 1; i < 16; ++i) mx = fmaxf(mx, fmaxf(p[0][i], p[1][i]));
    mx = fmaxf(mx, __shfl_xor(mx, 32));
    if (__any(mx > st.m)) {
        const float mnew = fmaxf(st.m, mx), alpha = __builtin_amdgcn_exp2f(st.m - mnew);
        st.l *= alpha; st.m = mnew;
#pragma unroll
        for (int dh = 0; dh < HD / 32; ++dh)
#pragma unroll
            for (int i = 0; i < 16; ++i) st.o[dh][i] *= alpha;
    }
    const float sub = lane_ok ? st.m : __builtin_huge_valf();
#pragma unroll
    for (int kt = 0; kt < 2; ++kt)
#pragma unroll
        for (int i = 0; i < 16; ++i) p[kt][i] = __builtin_amdgcn_exp2f(p[kt][i] - sub);
    if (elem) {
#pragma unroll
        for (int kt = 0; kt < 2; ++kt)
#pragma unroll
            for (int i = 0; i < 16; ++i) { const int koff = 32 * kt + (i & 3) + 8 * (i >> 2); p[kt][i] = valid(koff) ? p[kt][i] : 0.f; }
    }
    float ls = 0.f;
#pragma unroll
    for (int i = 0; i < 16; ++i) ls += p[0][i] + p[1][i];
    st.l += ls;
    tile_pv<HD>(st.o, p, buf, lane);
}

template <int HD, bool ELEM, class MaskF> __device__ __forceinline__ void tile_fused(State<HD>& st, f32x16 (&p)[2], const LAS unsigned char* buf, int lane, bool lane_ok, MaskF valid,
                                                                                 const bf16x8 (&qf)[HD / 16], const LAS unsigned char* nbuf, f32x16 (&pn)[2]) {
    float mx = fmaxf(p[0][0], p[1][0]);
#pragma unroll
    for (int i = 1; i < 16; ++i) mx = fmaxf(mx, fmaxf(p[0][i], p[1][i]));
    mx = fmaxf(mx, __shfl_xor(mx, 32));
    if (__any(mx > st.m)) {
        const float mnew = fmaxf(st.m, mx), alpha = __builtin_amdgcn_exp2f(st.m - mnew);
        st.l *= alpha; st.m = mnew;
#pragma unroll
        for (int dh = 0; dh < HD / 32; ++dh)
#pragma unroll
            for (int i = 0; i < 16; ++i) st.o[dh][i] *= alpha;
    }
    const float sub = lane_ok ? st.m : __builtin_huge_valf();
    asm volatile("" : "+v"(lane));
    const int r = lane & 31, h = lane >> 5, blk = (lane >> 4) & 1, q4 = (lane & 15) >> 2, pp = lane & 3;
    const LAS unsigned char* kl = nbuf + r * Geo<HD>::PK + 16 * h;
    const LAS unsigned char* vl = buf + Geo<HD>::KB + (4 * h + q4) * Geo<HD>::PV + 32 * blk + 8 * pp;
#pragma unroll
    for (int i = 0; i < 16; ++i) { pn[0][i] = 0.f; pn[1][i] = 0.f; }
    float ls = 0.f;
#pragma unroll
    for (int c = 0; c < 4; ++c) {
        const int kt = c >> 1, s2 = c & 1;
#pragma unroll
        for (int ss = 0; ss < HD / 32; ++ss) { const int sk = (HD / 32) * s2 + ss; const bf16x8 kf = *(const LAS bf16x8*)(kl + (32 * kt) * Geo<HD>::PK + 32 * sk);
            pn[kt] = __builtin_amdgcn_mfma_f32_32x32x16_bf16(kf, qf[sk], pn[kt], 0, 0, 0); }
#pragma unroll
        for (int j = 0; j < 8; ++j) { const int i = 8 * s2 + j; float e = __builtin_amdgcn_exp2f(p[kt][i] - sub);
            if (ELEM) { const int koff = 32 * kt + (i & 3) + 8 * (i >> 2); e = valid(koff) ? e : 0.f; }
            p[kt][i] = e; ls += e; }
        const bf16x8 pb = pack8(p[kt], 8 * s2);
#pragma unroll
        for (int dh = 0; dh < HD / 32; ++dh) { const LAS unsigned char* a = vl + (32 * kt + 16 * s2) * Geo<HD>::PV + 64 * dh;
            const s16x4 lo = tr_read(a), hi = tr_read(a + 8 * Geo<HD>::PV);
            const bf16x8 vf = __builtin_shufflevector(lo, hi, 0, 1, 2, 3, 4, 5, 6, 7);
            st.o[dh] = __builtin_amdgcn_mfma_f32_32x32x16_bf16(vf, pb, st.o[dh], 0, 0, 0); }
        __builtin_amdgcn_sched_barrier(0);
    }
    st.l += ls;
}
struct NoPre { __device__ __forceinline__ void operator()(int) const {} };
template <int HD, class SrcF, class FinF, class PreF = NoPre> __device__ __forceinline__ void kv_pipeline4(LAS unsigned char* lds, int nt, int tid, int lane, const bf16x8 (&qf)[HD / 16], SrcF src, FinF fin, PreF pre = PreF()) {
    TileRegs<HD> tr; const bf16_t *kb, *vb; size_t kp, vp;
    __syncthreads();
    if (nt <= 0) return;
    src(0, kb, kp, vb, vp); load_tile<HD>(tr, kb, kp, vb, vp, tid); store_tile<HD>(tr, lds, tid);
    if (nt > 1) { src(1, kb, kp, vb, vp); load_tile<HD>(tr, kb, kp, vb, vp, tid); store_tile<HD>(tr, lds + Geo<HD>::BUF, tid); }
    __syncthreads();
    f32x16 pc[2], pn[2];
    tile_scores<HD>(pc, qf, lds, lane);
    int b0 = 0, b1 = 1, b2 = 2;
    for (int t = 0; t < nt; ++t) {
        pre(t + 1);
        if (t + 2 < nt) { src(t + 2, kb, kp, vb, vp); load_tile<HD>(tr, kb, kp, vb, vp, tid); }
        const int bn = (t + 1 < nt) ? b1 : b0;
        fin(t, pc, lds + b0 * Geo<HD>::BUF, lds + bn * Geo<HD>::BUF, pn);
        if (t + 2 < nt) store_tile<HD>(tr, lds + b2 * Geo<HD>::BUF, tid);
        __syncthreads();
#pragma unroll
        for (int k = 0; k < 2; ++k) pc[k] = pn[k];
        const int tb = b0; b0 = b1; b1 = b2; b2 = tb;
    }
}

constexpr int DBUF = 16384;
__device__ __forceinline__ void dma_tile(LAS unsigned char* buf, const bf16_t* kb, size_t kp, const bf16_t* vb, size_t vp, int wave, int lane) {
    const int row = 8 * wave + (lane >> 3), cp = lane & 7;
    const bf16_t* gk = kb + (size_t)row * kp + ((cp ^ ((row >> 1) & 7)) * 8);
    const bf16_t* gv = vb + (size_t)row * vp + ((cp ^ (4 * ((row >> 1) & 1))) * 8);
    __builtin_amdgcn_global_load_lds((const unsigned*)gk, (LAS unsigned*)(buf + wave * 1024), 16, 0, 0);
    __builtin_amdgcn_global_load_lds((const unsigned*)gv, (LAS unsigned*)(buf + 8192 + wave * 1024), 16, 0, 0);
}
__device__ __forceinline__ void dma_tile_o(LAS unsigned char* buf, const bf16_t* kb, const bf16_t* vb, unsigned gko, unsigned gvo, int wave) {
    __builtin_amdgcn_global_load_lds((const unsigned*)((const char*)kb + gko), (LAS unsigned*)(buf + wave * 1024), 16, 0, 0);
    __builtin_amdgcn_global_load_lds((const unsigned*)((const char*)vb + gvo), (LAS unsigned*)(buf + 8192 + wave * 1024), 16, 0, 0);
}
__device__ __forceinline__ void scores_d(f32x16 (&p)[2], const bf16x8 (&qf)[4], const LAS unsigned char* buf, int lane) {
    const int r = lane & 31, h = lane >> 5;
#pragma unroll
    for (int kt = 0; kt < 2; ++kt) { f32x16 x;
#pragma unroll
        for (int i = 0; i < 16; ++i) x[i] = 0.f;
        const int row = 32 * kt + r; const LAS unsigned char* kr = buf + row * 128; const int sw = (row >> 1) & 7;
#pragma unroll
        for (int s = 0; s < 4; ++s) { const bf16x8 kf = *(const LAS bf16x8*)(kr + (((2 * s + h) ^ sw) * 16)); x = __builtin_amdgcn_mfma_f32_32x32x16_bf16(kf, qf[s], x, 0, 0, 0); }
        p[kt] = x; }
}
template <bool ELEM, class MaskF> __device__ __forceinline__ void fused_d(State<64>& st, f32x16 (&p)[2], const LAS unsigned char* buf, int lane, bool lane_ok, MaskF valid,
                                                                        const bf16x8 (&qf)[4], const LAS unsigned char* nbuf, f32x16 (&pn)[2]) {
    float mx = fmaxf(p[0][0], p[1][0]);
#pragma unroll
    for (int i = 1; i < 16; ++i) mx = fmaxf(mx, fmaxf(p[0][i], p[1][i]));
    mx = fmaxf(mx, __shfl_xor(mx, 32));
    if (__any(mx > st.m)) {
        const float mnew = fmaxf(st.m, mx), alpha = __builtin_amdgcn_exp2f(st.m - mnew);
        st.l *= alpha; st.m = mnew;
#pragma unroll
        for (int dh = 0; dh < 2; ++dh)
#pragma unroll
            for (int i = 0; i < 16; ++i) st.o[dh][i] *= alpha;
    }
    const float sub = lane_ok ? st.m : __builtin_huge_valf();
    asm volatile("" : "+v"(lane));
    const int r = lane & 31, h = lane >> 5, blk = (lane >> 4) & 1, q4 = (lane & 15) >> 2, pp = lane & 3;
    const int ksw = (r >> 1) & 7;
    const LAS unsigned char* kl = nbuf + r * 128;
    const int vsw = 4 * ((q4 >> 1) & 1);
    const LAS unsigned char* vl = buf + 8192 + (4 * h + q4) * 128 + 8 * (pp & 1);
    const int vc0 = ((2 * blk + (pp >> 1)) ^ vsw) * 16, vc1 = ((4 + 2 * blk + (pp >> 1)) ^ vsw) * 16;
#pragma unroll
    for (int i = 0; i < 16; ++i) { pn[0][i] = 0.f; pn[1][i] = 0.f; }
    float ls = 0.f;
#pragma unroll
    for (int c = 0; c < 4; ++c) {
        const int kt = c >> 1, s2 = c & 1;
        s16x4 l0, h0, l1, h1;
        { const unsigned a0 = (unsigned)(size_t)(vl + (32 * kt + 16 * s2) * 128 + vc0), a1 = (unsigned)(size_t)(vl + (32 * kt + 16 * s2) * 128 + vc1);
          asm volatile("ds_read_b64_tr_b16 %0, %4\n\tds_read_b64_tr_b16 %1, %4 offset:1024\n\tds_read_b64_tr_b16 %2, %5\n\tds_read_b64_tr_b16 %3, %5 offset:1024"
                       : "=&v"(l0), "=&v"(h0), "=&v"(l1), "=&v"(h1) : "v"(a0), "v"(a1) : "memory"); }
#pragma unroll
        for (int ss = 0; ss < 2; ++ss) { const int sk = 2 * s2 + ss; const bf16x8 kf = *(const LAS bf16x8*)(kl + kt * 4096 + (((2 * sk + h) ^ ksw) * 16));
            pn[kt] = __builtin_amdgcn_mfma_f32_32x32x16_bf16(kf, qf[sk], pn[kt], 0, 0, 0); }
#pragma unroll
        for (int j = 0; j < 8; ++j) { const int i = 8 * s2 + j; float e = __builtin_amdgcn_exp2f(p[kt][i] - sub);
            if (ELEM) { const int koff = 32 * kt + (i & 3) + 8 * (i >> 2); e = valid(koff) ? e : 0.f; }
            p[kt][i] = e; ls += e; }
        const bf16x8 pb = pack8(p[kt], 8 * s2);
        asm volatile("s_waitcnt lgkmcnt(0)" ::: "memory"); __builtin_amdgcn_sched_barrier(0);
        st.o[0] = __builtin_amdgcn_mfma_f32_32x32x16_bf16(__builtin_shufflevector(l0, h0, 0, 1, 2, 3, 4, 5, 6, 7), pb, st.o[0], 0, 0, 0);
        st.o[1] = __builtin_amdgcn_mfma_f32_32x32x16_bf16(__builtin_shufflevector(l1, h1, 0, 1, 2, 3, 4, 5, 6, 7), pb, st.o[1], 0, 0, 0);
        __builtin_amdgcn_sched_barrier(0);
    }
    st.l += ls;
}
template <int XTRA, class SrcF, class FinF, class XtraF> __device__ __forceinline__ void kv_pipeline_dma(LAS unsigned char* lds, int nt, int wave, int lane, const bf16x8 (&qf)[4], SrcF src, FinF fin, XtraF xtra) {
    const bf16_t *kb, *vb; size_t kp, vp;
    asm volatile("s_waitcnt vmcnt(0) lgkmcnt(0)" ::: "memory"); __builtin_amdgcn_s_barrier();
    if (nt <= 0) return;
#pragma unroll
    for (int i = 0; i < 3; ++i) if (i < nt) { src(i, kb, kp, vb, vp); dma_tile(lds + i * DBUF, kb, kp, vb, vp, wave, lane); xtra(i, i); }
    if (nt >= 3) { if (XTRA) asm volatile("s_waitcnt vmcnt(3)" ::: "memory"); else asm volatile("s_waitcnt vmcnt(2)" ::: "memory"); }
    else asm volatile("s_waitcnt vmcnt(0)" ::: "memory");
    __builtin_amdgcn_s_barrier();
    f32x16 pc[2], pn[2];
    scores_d(pc, qf, lds, lane);
    for (int t = 0; t < nt; ++t) {
        if (t + 3 < nt) { src(t + 3, kb, kp, vb, vp); dma_tile(lds + ((t + 3) & 3) * DBUF, kb, kp, vb, vp, wave, lane); xtra(t + 3, (t + 3) & 3); }
        const int bn = (t + 1 < nt) ? ((t + 1) & 3) : (t & 3);
        fin(t, pc, lds + (t & 3) * DBUF, lds + bn * DBUF, pn, t & 3);
        if (t + 3 < nt) { if (XTRA) asm volatile("s_waitcnt vmcnt(3) lgkmcnt(0)" ::: "memory"); else asm volatile("s_waitcnt vmcnt(2) lgkmcnt(0)" ::: "memory"); }
        else asm volatile("s_waitcnt vmcnt(0) lgkmcnt(0)" ::: "memory");
        __builtin_amdgcn_s_barrier();
#pragma unroll
        for (int k = 0; k < 2; ++k) pc[k] = pn[k];
    }
}
struct NoXtra { __device__ __forceinline__ void operator()(int, int) const {} };

struct LpOff { unsigned k0, k1, v0, v1, gk, gv; };
__device__ __forceinline__ LpOff lp_offsets(int lane, int wave = 0, unsigned pitch_bytes = 0) {
    const int r = lane & 31, h = lane >> 5, blk = (lane >> 4) & 1, q4 = (lane & 15) >> 2, pp = lane & 3;
    const int ksw = (r >> 1) & 7, vsw = 4 * ((q4 >> 1) & 1);
    const unsigned vl = 8192 + (4 * h + q4) * 128 + 8 * (pp & 1);
    LpOff o; o.k0 = r * 128 + ((h ^ ksw) * 16); o.k1 = r * 128 + (((2 + h) ^ ksw) * 16);
    o.v0 = vl + ((2 * blk + (pp >> 1)) ^ vsw) * 16; o.v1 = vl + ((4 + 2 * blk + (pp >> 1)) ^ vsw) * 16;
    { const int row = 8 * wave + (lane >> 3), cp = lane & 7;
      o.gk = (unsigned)row * pitch_bytes + ((cp ^ ((row >> 1) & 7)) * 16); o.gv = (unsigned)row * pitch_bytes + ((cp ^ (4 * ((row >> 1) & 1))) * 16); }
    asm volatile("" : "+v"(o.k0), "+v"(o.k1), "+v"(o.v0), "+v"(o.v1), "+v"(o.gk), "+v"(o.gv));
    return o;
}
template <int MODE, bool HS, class MaskF> __device__ __forceinline__ void fused_np(f32x16 (&o)[2], float& l, const f32x16 (&p)[2], const LAS unsigned char* buf, int lane, bool lane_ok, float shift, MaskF valid, unsigned wlo, unsigned whi,
                                                                        const bf16x8 (&qf)[4], const LAS unsigned char* nbuf, f32x16 (&pn)[2], const LpOff& lo) {
    const unsigned nb = (unsigned)(size_t)nbuf, cb = (unsigned)(size_t)buf;
    const unsigned kA0 = nb + lo.k0, kA1 = nb + lo.k1, kB0 = kA0 ^ 64u, kB1 = kA1 ^ 64u;
    const unsigned vb0 = cb + lo.v0, vb1 = cb + lo.v1;
    const unsigned lmask = lane_ok ? 0xffffffffu : 0u;
    float ls = 0.f;
#pragma unroll
    for (int c = 0; c < 4; ++c) {
        const int kt = c >> 1, s2 = c & 1;
        s16x4 l0, h0, l1, h1;
        asm volatile("ds_read_b64_tr_b16 %0, %4 offset:%c6\n\tds_read_b64_tr_b16 %1, %4 offset:%c7\n\tds_read_b64_tr_b16 %2, %5 offset:%c6\n\tds_read_b64_tr_b16 %3, %5 offset:%c7"
                     : "=&v"(l0), "=&v"(h0), "=&v"(l1), "=&v"(h1) : "v"(vb0), "v"(vb1), "i"((32 * (c >> 1) + 16 * (c & 1)) * 128), "i"((32 * (c >> 1) + 16 * (c & 1)) * 128 + 1024) : "memory");
#pragma unroll
        for (int ss = 0; ss < 2; ++ss) { const int sk = 2 * s2 + ss; const bf16x8 kf = *(const LAS bf16x8*)(size_t)((sk == 0 ? kA0 : sk == 1 ? kA1 : sk == 2 ? kB0 : kB1) + kt * 4096);
            if (sk == 0) { f32x16 z;
#pragma unroll
                for (int i = 0; i < 16; ++i) z[i] = 0.f;
                pn[kt] = __builtin_amdgcn_mfma_f32_32x32x16_bf16(kf, qf[sk], z, 0, 0, 0); }
            else pn[kt] = __builtin_amdgcn_mfma_f32_32x32x16_bf16(kf, qf[sk], pn[kt], 0, 0, 0); }
        float e[8];
#pragma unroll
        for (int j = 0; j < 8; ++j) { const int i = 8 * s2 + j; const int koff = 32 * kt + (i & 3) + 8 * (i >> 2); float x = __builtin_amdgcn_exp2f(HS ? p[kt][i] - shift : p[kt][i]);
            if (MODE == 1) x = valid(koff) ? x : 0.f;
            if (MODE == 2) { int tb; asm("v_bfe_i32 %0, %1, %2, 1" : "=v"(tb) : "v"(kt ? whi : wlo), "n"(koff & 31)); x = __builtin_bit_cast(float, __builtin_bit_cast(unsigned, x) & (unsigned)tb); }
            e[j] = x; }
        u32x4 pw; pw.x = pk2(e[0], e[1]) & lmask; pw.y = pk2(e[2], e[3]) & lmask; pw.z = pk2(e[4], e[5]) & lmask; pw.w = pk2(e[6], e[7]) & lmask;
#pragma unroll
        for (int j = 0; j < 8; ++j) ls += lane_ok ? e[j] : 0.f;
        const bf16x8 pb = __builtin_bit_cast(bf16x8, pw);
        asm volatile("s_waitcnt lgkmcnt(0)" ::: "memory"); __builtin_amdgcn_sched_barrier(0);
        o[0] = __builtin_amdgcn_mfma_f32_32x32x16_bf16(__builtin_shufflevector(l0, h0, 0, 1, 2, 3, 4, 5, 6, 7), pb, o[0], 0, 0, 0);
        o[1] = __builtin_amdgcn_mfma_f32_32x32x16_bf16(__builtin_shufflevector(l1, h1, 0, 1, 2, 3, 4, 5, 6, 7), pb, o[1], 0, 0, 0);
        __builtin_amdgcn_sched_barrier(0);
    }
    l += ls;
}
template <int MODE, bool HS, class MaskF> __device__ __forceinline__ void fused_lp(f32x16 (&o)[2], float& l, const f32x16 (&p)[2], const LAS unsigned char* buf, int lane, bool lane_ok, float shift, MaskF valid, unsigned wlo, unsigned whi,
                                                                        const bf16x8 (&qf)[4], const LAS unsigned char* nbuf, f32x16 (&pn)[2], const LpOff& lo) {
    const unsigned nb = (unsigned)(size_t)nbuf, cb = (unsigned)(size_t)buf;
    const unsigned kA0 = nb + lo.k0, kA1 = nb + lo.k1, kB0 = kA0 ^ 64u, kB1 = kA1 ^ 64u;
    const unsigned vb0 = cb + lo.v0, vb1 = cb + lo.v1;
    const unsigned lmask = lane_ok ? 0xffffffffu : 0u;
    bf16x8 kf[2][2]; s16x4 vf[3][4]; bf16x8 pbp = {0, 0, 0, 0, 0, 0, 0, 0};
#define FE_ISSUE(c_, KS_, VS_) do { constexpr int kt_ = (c_) >> 1, s2_ = (c_) & 1; \
        asm volatile("ds_read_b128 %0, %6 offset:%c10\n\tds_read_b128 %1, %7 offset:%c10\n\tds_read_b64_tr_b16 %2, %8 offset:%c11\n\tds_read_b64_tr_b16 %3, %8 offset:%c12\n\tds_read_b64_tr_b16 %4, %9 offset:%c11\n\tds_read_b64_tr_b16 %5, %9 offset:%c12" \
                     : "=&v"(kf[KS_][0]), "=&v"(kf[KS_][1]), "=&v"(vf[VS_][0]), "=&v"(vf[VS_][1]), "=&v"(vf[VS_][2]), "=&v"(vf[VS_][3]) \
                     : "v"(s2_ ? kB0 : kA0), "v"(s2_ ? kB1 : kA1), "v"(vb0), "v"(vb1), "i"(kt_ * 4096), "i"((32 * kt_ + 16 * s2_) * 128), "i"((32 * kt_ + 16 * s2_) * 128 + 1024) : "memory"); } while (0)
    FE_ISSUE(0, 0, 0);
    float ls = 0.f;
#pragma unroll
    for (int c = 0; c < 4; ++c) {
        const int kt = c >> 1, s2 = c & 1, KS = c & 1, VS = c % 3, VP = (c + 2) % 3;
        asm volatile("s_waitcnt lgkmcnt(0)" ::: "memory"); __builtin_amdgcn_sched_barrier(0);
        if (c < 3) { if (c == 0) FE_ISSUE(1, 1, 1); else if (c == 1) FE_ISSUE(2, 0, 2); else FE_ISSUE(3, 1, 0); }
        if (s2 == 0) { f32x16 z;
#pragma unroll
            for (int i = 0; i < 16; ++i) z[i] = 0.f;
            pn[kt] = __builtin_amdgcn_mfma_f32_32x32x16_bf16(kf[KS][0], qf[0], z, 0, 0, 0); pn[kt] = __builtin_amdgcn_mfma_f32_32x32x16_bf16(kf[KS][1], qf[1], pn[kt], 0, 0, 0); }
        else { pn[kt] = __builtin_amdgcn_mfma_f32_32x32x16_bf16(kf[KS][0], qf[2], pn[kt], 0, 0, 0); pn[kt] = __builtin_amdgcn_mfma_f32_32x32x16_bf16(kf[KS][1], qf[3], pn[kt], 0, 0, 0); }
        if (c > 0) {
            o[0] = __builtin_amdgcn_mfma_f32_32x32x16_bf16(__builtin_shufflevector(vf[VP][0], vf[VP][1], 0, 1, 2, 3, 4, 5, 6, 7), pbp, o[0], 0, 0, 0);
            o[1] = __builtin_amdgcn_mfma_f32_32x32x16_bf16(__builtin_shufflevector(vf[VP][2], vf[VP][3], 0, 1, 2, 3, 4, 5, 6, 7), pbp, o[1], 0, 0, 0); }
        float e[8];
#pragma unroll
        for (int j = 0; j < 8; ++j) { const int i = 8 * s2 + j; const int koff = 32 * kt + (i & 3) + 8 * (i >> 2); float x = __builtin_amdgcn_exp2f(HS ? p[kt][i] - shift : p[kt][i]);
            if (MODE == 1) x = valid(koff) ? x : 0.f;
            if (MODE == 2) { int tb; asm("v_bfe_i32 %0, %1, %2, 1" : "=v"(tb) : "v"(kt ? whi : wlo), "n"(koff & 31)); x = __builtin_bit_cast(float, __builtin_bit_cast(unsigned, x) & (unsigned)tb); }
            e[j] = x; }
        u32x4 pw; pw.x = pk2(e[0], e[1]) & lmask; pw.y = pk2(e[2], e[3]) & lmask; pw.z = pk2(e[4], e[5]) & lmask; pw.w = pk2(e[6], e[7]) & lmask;
#pragma unroll
        for (int j = 0; j < 8; ++j) ls += lane_ok ? e[j] : 0.f;
#pragma unroll
        for (int g = 0; g < 4; ++g) { __builtin_amdgcn_sched_group_barrier(0x008, 1, 0); __builtin_amdgcn_sched_group_barrier(0x002, 9, 0); }
        __builtin_amdgcn_sched_barrier(0);
        pbp = __builtin_bit_cast(bf16x8, pw);
    }
    o[0] = __builtin_amdgcn_mfma_f32_32x32x16_bf16(__builtin_shufflevector(vf[0][0], vf[0][1], 0, 1, 2, 3, 4, 5, 6, 7), pbp, o[0], 0, 0, 0);
    o[1] = __builtin_amdgcn_mfma_f32_32x32x16_bf16(__builtin_shufflevector(vf[0][2], vf[0][3], 0, 1, 2, 3, 4, 5, 6, 7), pbp, o[1], 0, 0, 0);
#undef FE_ISSUE
    l += ls;
}
template <int MODE, bool HS, bool LP, class MaskF> __device__ __forceinline__ void fused_e(f32x16 (&o)[2], float& l, const f32x16 (&p)[2], const LAS unsigned char* buf, int lane, bool lane_ok, float shift, MaskF valid, unsigned wlo, unsigned whi,
                                                                        const bf16x8 (&qf)[4], const LAS unsigned char* nbuf, f32x16 (&pn)[2], const LpOff& lo = LpOff{}) {
    if constexpr (LP) fused_lp<MODE, HS>(o, l, p, buf, lane, lane_ok, shift, valid, wlo, whi, qf, nbuf, pn, lo); else fused_np<MODE, HS>(o, l, p, buf, lane, lane_ok, shift, valid, wlo, whi, qf, nbuf, pn, lo);
}
template <int XTRA, class SrcF, class FinF, class XtraF> __device__ __forceinline__ void kv_pipeline_dma2(LAS unsigned char* lds, int nt, int wave, int lane, const bf16x8 (&qf)[4], const LpOff& lo, SrcF src, FinF fin, XtraF xtra) {
    const bf16_t *kb, *vb; size_t kp, vp;
    asm volatile("s_waitcnt vmcnt(0) lgkmcnt(0)" ::: "memory"); __builtin_amdgcn_s_barrier();
    if (nt <= 0) return;
#pragma unroll
    for (int i = 0; i < 3; ++i) if (i < nt) { src(i, kb, kp, vb, vp); dma_tile_o(lds + i * DBUF, kb, vb, lo.gk, lo.gv, wave); xtra(i, i); }
    if (nt >= 3) { if (XTRA) asm volatile("s_waitcnt vmcnt(3)" ::: "memory"); else asm volatile("s_waitcnt vmcnt(2)" ::: "memory"); }
    else asm volatile("s_waitcnt vmcnt(0)" ::: "memory");
    __builtin_amdgcn_s_barrier();
    f32x16 pa[2], pb[2];
    scores_d(pa, qf, lds, lane);
#define KVD2_STEP(PC, PN) do { \
        if (t + 3 < nt) { src(t + 3, kb, kp, vb, vp); dma_tile_o(lds + ((t + 3) & 3) * DBUF, kb, vb, lo.gk, lo.gv, wave); xtra(t + 3, (t + 3) & 3); } \
        const int bn_ = (t + 1 < nt) ? ((t + 1) & 3) : (t & 3); \
        fin(t, PC, lds + (t & 3) * DBUF, lds + bn_ * DBUF, PN, t & 3); \
        if (t + 3 < nt) { if (XTRA) asm volatile("s_waitcnt vmcnt(3) lgkmcnt(0)" ::: "memory"); else asm volatile("s_waitcnt vmcnt(2) lgkmcnt(0)" ::: "memory"); } \
        else asm volatile("s_waitcnt vmcnt(0) lgkmcnt(0)" ::: "memory"); \
        __builtin_amdgcn_s_barrier(); ++t; } while (0)
    int t = 0;
    while (t < nt) { KVD2_STEP(pa, pb); if (t >= nt) break; KVD2_STEP(pb, pa); }
#undef KVD2_STEP
}
__device__ __forceinline__ float gain_max64(const float* g) { float m = 0.f; for (int i = 0; i < 64; ++i) m = fmaxf(m, fabsf(g[i])); return m; }
__device__ __forceinline__ float softmax_shift(float gq, float gk) { const float B = 8.0f * LOG2E * gq * gk * 1.02f; return B > 60.f ? B - 60.f : 0.f; }

template <int MODE, bool HS, class MaskF> __device__ __forceinline__ void half_v(u32x4 (&pw)[4], float& l, const f32x16 (&p)[2], bool lane_ok, float shift, MaskF valid, unsigned wlo, unsigned whi) {
    const unsigned lmask = lane_ok ? 0xffffffffu : 0u; float ls = 0.f;
#pragma unroll
    for (int c = 0; c < 4; ++c) { const int kt = c >> 1, s2 = c & 1; float e[8];
#pragma unroll
        for (int j = 0; j < 8; ++j) { const int i = 8 * s2 + j; const int koff = 32 * kt + (i & 3) + 8 * (i >> 2); float x = __builtin_amdgcn_exp2f(HS ? p[kt][i] - shift : p[kt][i]);
            if (MODE == 1) x = valid(koff) ? x : 0.f;
            if (MODE == 2) { int tb; asm("v_bfe_i32 %0, %1, %2, 1" : "=v"(tb) : "v"(kt ? whi : wlo), "n"(koff & 31)); x = __builtin_bit_cast(float, __builtin_bit_cast(unsigned, x) & (unsigned)tb); }
            e[j] = x; ls += x; }
        pw[c].x = pk2(e[0], e[1]) & lmask; pw[c].y = pk2(e[2], e[3]) & lmask; pw[c].z = pk2(e[4], e[5]) & lmask; pw[c].w = pk2(e[6], e[7]) & lmask; }
    l += lane_ok ? ls : 0.f;
}
__device__ __forceinline__ void half_m(f32x16 (&o)[2], const u32x4 (&pw)[4], const LAS unsigned char* buf, const LAS unsigned char* nbuf, const bf16x8 (&qf)[4], f32x16 (&pn)[2], bool do_scores, int lane) {
    asm volatile("" : "+v"(lane));
    const int r = lane & 31, h = lane >> 5, blk = (lane >> 4) & 1, q4 = (lane & 15) >> 2, pp = lane & 3;
    const int ksw = (r >> 1) & 7;
    const unsigned kl = (unsigned)(size_t)(nbuf + r * 128);
    const unsigned kx0 = ((h ^ ksw) * 16), kx1 = (((2 + h) ^ ksw) * 16);
    const unsigned kA0 = kl + kx0, kA1 = kl + kx1, kB0 = kl + (kx0 ^ 64u), kB1 = kl + (kx1 ^ 64u);
    const int vsw = 4 * ((q4 >> 1) & 1);
    const unsigned vl = (unsigned)(size_t)(buf + 8192 + (4 * h + q4) * 128 + 8 * (pp & 1));
    const unsigned vb0 = vl + ((2 * blk + (pp >> 1)) ^ vsw) * 16, vb1 = vl + ((4 + 2 * blk + (pp >> 1)) ^ vsw) * 16;
    bf16x8 kf[8]; s16x4 vf[16];
    if (do_scores) {
        asm volatile("ds_read_b128 %0, %8\n\tds_read_b128 %1, %9\n\tds_read_b128 %2, %10\n\tds_read_b128 %3, %11\n\tds_read_b128 %4, %8 offset:4096\n\tds_read_b128 %5, %9 offset:4096\n\tds_read_b128 %6, %10 offset:4096\n\tds_read_b128 %7, %11 offset:4096"
                     : "=&v"(kf[0]), "=&v"(kf[1]), "=&v"(kf[2]), "=&v"(kf[3]), "=&v"(kf[4]), "=&v"(kf[5]), "=&v"(kf[6]), "=&v"(kf[7]) : "v"(kA0), "v"(kA1), "v"(kB0), "v"(kB1) : "memory");
    }
#define HM_V(c_) asm volatile("ds_read_b64_tr_b16 %0, %4 offset:%c6\n\tds_read_b64_tr_b16 %1, %4 offset:%c7\n\tds_read_b64_tr_b16 %2, %5 offset:%c6\n\tds_read_b64_tr_b16 %3, %5 offset:%c7" \
                     : "=&v"(vf[4 * (c_)]), "=&v"(vf[4 * (c_) + 1]), "=&v"(vf[4 * (c_) + 2]), "=&v"(vf[4 * (c_) + 3]) : "v"(vb0), "v"(vb1), "i"((32 * ((c_) >> 1) + 16 * ((c_) & 1)) * 128), "i"((32 * ((c_) >> 1) + 16 * ((c_) & 1)) * 128 + 1024) : "memory")
    asm volatile("s_waitcnt lgkmcnt(0)" ::: "memory"); __builtin_amdgcn_sched_barrier(0);
    HM_V(0); HM_V(1); HM_V(2); HM_V(3);
#undef HM_V
    if (do_scores) {
#pragma unroll
        for (int kt = 0; kt < 2; ++kt) { f32x16 z;
#pragma unroll
            for (int i = 0; i < 16; ++i) z[i] = 0.f;
            z = __builtin_amdgcn_mfma_f32_32x32x16_bf16(kf[4 * kt + 0], qf[0], z, 0, 0, 0);
            z = __builtin_amdgcn_mfma_f32_32x32x16_bf16(kf[4 * kt + 1], qf[1], z, 0, 0, 0);
            z = __builtin_amdgcn_mfma_f32_32x32x16_bf16(kf[4 * kt + 2], qf[2], z, 0, 0, 0);
            z = __builtin_amdgcn_mfma_f32_32x32x16_bf16(kf[4 * kt + 3], qf[3], z, 0, 0, 0);
            pn[kt] = z; }
    }
    asm volatile("s_waitcnt lgkmcnt(0)" ::: "memory"); __builtin_amdgcn_sched_barrier(0);
#pragma unroll
    for (int c = 0; c < 4; ++c) { const bf16x8 pb = __builtin_bit_cast(bf16x8, pw[c]);
        o[0] = __builtin_amdgcn_mfma_f32_32x32x16_bf16(__builtin_shufflevector(vf[4 * c], vf[4 * c + 1], 0, 1, 2, 3, 4, 5, 6, 7), pb, o[0], 0, 0, 0);
        o[1] = __builtin_amdgcn_mfma_f32_32x32x16_bf16(__builtin_shufflevector(vf[4 * c + 2], vf[4 * c + 3], 0, 1, 2, 3, 4, 5, 6, 7), pb, o[1], 0, 0, 0); }
}
template <int XTRA, class SrcF, class VF, class XtraF> __device__ __forceinline__ void kv_pipeline_ab(LAS unsigned char* lds, int nt, int wave, int lane, const bf16x8 (&qf)[4], f32x16 (&o)[2], SrcF src, VF vhalf, XtraF xtra) {
    const bf16_t *kb, *vb; size_t kp, vp;
    asm volatile("s_waitcnt vmcnt(0) lgkmcnt(0)" ::: "memory"); __builtin_amdgcn_s_barrier();
    if (nt <= 0) return;
#pragma unroll
    for (int i = 0; i < 3; ++i) if (i < nt) { src(i, kb, kp, vb, vp); dma_tile(lds + i * DBUF, kb, kp, vb, vp, wave, lane); xtra(i, i); }
    if (nt >= 3) { if (XTRA) asm volatile("s_waitcnt vmcnt(3)" ::: "memory"); else asm volatile("s_waitcnt vmcnt(2)" ::: "memory"); }
    else asm volatile("s_waitcnt vmcnt(0)" ::: "memory");
    __builtin_amdgcn_s_barrier();
    f32x16 pc[2]; scores_d(pc, qf, lds, lane);
    asm volatile("s_waitcnt lgkmcnt(0)" ::: "memory");
    const bool grpB = (wave & 4) != 0;
    if (grpB) __builtin_amdgcn_s_barrier();
    u32x4 pw[4];
    for (int t = 0; t < nt; ++t) {
        vhalf(t, pc, pw, t & 3);
        asm volatile("s_waitcnt lgkmcnt(0)" ::: "memory"); __builtin_amdgcn_s_barrier();
        if (t + 3 < nt) { src(t + 3, kb, kp, vb, vp); dma_tile(lds + ((t + 3) & 3) * DBUF, kb, kp, vb, vp, wave, lane); xtra(t + 3, (t + 3) & 3); }
        half_m(o, pw, lds + (t & 3) * DBUF, lds + ((t + 1) & 3) * DBUF, qf, pc, t + 1 < nt, lane);
        if (t + 3 < nt) { if (XTRA) asm volatile("s_waitcnt vmcnt(3) lgkmcnt(0)" ::: "memory"); else asm volatile("s_waitcnt vmcnt(2) lgkmcnt(0)" ::: "memory"); }
        else asm volatile("s_waitcnt vmcnt(0) lgkmcnt(0)" ::: "memory");
        __builtin_amdgcn_s_barrier();
    }
    if (!grpB) __builtin_amdgcn_s_barrier();
}

template <int XTRA, class SrcF, class FinF, class XtraF> __device__ __forceinline__ void kv_pipeline_dma8(LAS unsigned char* lds, int nt, int wave, int lane, const bf16x8 (&qf)[4], const LpOff& lo, SrcF src, FinF fin, XtraF xtra) {
    const bf16_t *kb, *vb; size_t kp, vp;
    asm volatile("s_waitcnt vmcnt(0) lgkmcnt(0)" ::: "memory"); __builtin_amdgcn_s_barrier();
    if (nt <= 0) return;
#define KV8_WAIT(n_) do { const int na_ = (n_); \
        if (XTRA) { if (na_ >= 3) asm volatile("s_waitcnt vmcnt(9) lgkmcnt(0)" ::: "memory"); else if (na_ == 2) asm volatile("s_waitcnt vmcnt(6) lgkmcnt(0)" ::: "memory"); else if (na_ == 1) asm volatile("s_waitcnt vmcnt(3) lgkmcnt(0)" ::: "memory"); else asm volatile("s_waitcnt vmcnt(0) lgkmcnt(0)" ::: "memory"); } \
        else { if (na_ >= 3) asm volatile("s_waitcnt vmcnt(6) lgkmcnt(0)" ::: "memory"); else if (na_ == 2) asm volatile("s_waitcnt vmcnt(4) lgkmcnt(0)" ::: "memory"); else if (na_ == 1) asm volatile("s_waitcnt vmcnt(2) lgkmcnt(0)" ::: "memory"); else asm volatile("s_waitcnt vmcnt(0) lgkmcnt(0)" ::: "memory"); } } while (0)
#pragma unroll
    for (int i = 0; i < 6; ++i) if (i < nt) { src(i, kb, kp, vb, vp); dma_tile_o(lds + i * DBUF, kb, vb, lo.gk, lo.gv, wave); xtra(i, i); }
    { const int iss = nt < 6 ? nt : 6; KV8_WAIT(iss > 3 ? iss - 3 : 0); }
    __builtin_amdgcn_s_barrier();
    f32x16 pa[2], pb[2];
    scores_d(pa, qf, lds, lane);
    int t = 0;
    while (true) {
        if (t + 6 < nt) { src(t + 6, kb, kp, vb, vp); dma_tile_o(lds + ((t + 6) & 7) * DBUF, kb, vb, lo.gk, lo.gv, wave); xtra(t + 6, (t + 6) & 7); }
        { const int bn_ = (t + 1 < nt) ? ((t + 1) & 7) : (t & 7); fin(t, pa, lds + (t & 7) * DBUF, lds + bn_ * DBUF, pb, t & 7); }
        if (t + 1 >= nt) break;
        if (t + 7 < nt) { src(t + 7, kb, kp, vb, vp); dma_tile_o(lds + ((t + 7) & 7) * DBUF, kb, vb, lo.gk, lo.gv, wave); xtra(t + 7, (t + 7) & 7); }
        { const int bn_ = (t + 2 < nt) ? ((t + 2) & 7) : ((t + 1) & 7); fin(t + 1, pb, lds + ((t + 1) & 7) * DBUF, lds + bn_ * DBUF, pa, (t + 1) & 7); }
        { const int rem = nt - (t + 5); KV8_WAIT(rem < 0 ? 0 : (rem > 3 ? 3 : rem)); }
        __builtin_amdgcn_s_barrier();
        t += 2; if (t >= nt) break;
    }
    asm volatile("s_waitcnt vmcnt(0) lgkmcnt(0)" ::: "memory"); __builtin_amdgcn_s_barrier();
#undef KV8_WAIT
}
template <int HD> __device__ __forceinline__ void store_o(const f32x16 (&o)[HD / 32], float f, bf16_t* orow, int lane) {
    const int h = lane >> 5;
#pragma unroll
    for (int dh = 0; dh < HD / 32; ++dh)
#pragma unroll
        for (int g = 0; g < 4; ++g) { u32x2 w; w.x = pk2(o[dh][4 * g] * f, o[dh][4 * g + 1] * f); w.y = pk2(o[dh][4 * g + 2] * f, o[dh][4 * g + 3] * f);
            *(u32x2*)(orow + 32 * dh + 8 * g + 4 * h) = w; }
}

template <int HD> __device__ __forceinline__ void store_o_t(const f32x16 (&o)[HD / 32], float f, bf16_t* base, size_t ld, LAS unsigned char* scr, int lane) {
    constexpr int PITCH = HD * 2 + 16;
    asm volatile("" : "+v"(lane));
    const int r = lane & 31, h = lane >> 5;
#pragma unroll
    for (int dh = 0; dh < HD / 32; ++dh)
#pragma unroll
        for (int g = 0; g < 4; ++g) { u32x2 w; w.x = pk2(o[dh][4 * g] * f, o[dh][4 * g + 1] * f); w.y = pk2(o[dh][4 * g + 2] * f, o[dh][4 * g + 3] * f);
            *(LAS u32x2*)(scr + r * PITCH + (32 * dh + 8 * g + 4 * h) * 2) = w; }
    asm volatile("s_waitcnt lgkmcnt(0)" ::: "memory");
    constexpr int CPR = HD / 8;
#pragma unroll
    for (int i = 0; i < (32 * CPR) / 64; ++i) { const int idx = lane + 64 * i, row = idx / CPR, c = idx % CPR;
        const u32x4 v = *(const LAS u32x4*)(scr + row * PITCH + c * 16);
        *(u32x4*)(base + (size_t)row * ld + c * 8) = v; }
}
}


__device__ __forceinline__ float row_rstd(const float* rsq, int row) {
    const f32x4* pr = (const f32x4*)(rsq + (size_t)row * 16); const f32x4 a = pr[0], b = pr[1], c = pr[2], d = pr[3];
    const float ss = (((a[0] + a[1]) + (a[2] + a[3])) + ((b[0] + b[1]) + (b[2] + b[3]))) + (((c[0] + c[1]) + (c[2] + c[3])) + ((d[0] + d[1]) + (d[2] + d[3])));
    return __builtin_amdgcn_rsqf(ss * (1.0f / 1024.0f) + RMS_EPS);
}
__device__ __forceinline__ void unpack8(const u32x4 w, float (&f)[8]) {
#pragma unroll
    for (int j = 0; j < 4; ++j) { f[2 * j] = __builtin_bit_cast(float, w[j] << 16); f[2 * j + 1] = __builtin_bit_cast(float, w[j] & 0xffff0000u); } }
__device__ __forceinline__ u32x4 pack8f(const float (&f)[8]) { u32x4 o; o.x = pk2(f[0], f[1]); o.y = pk2(f[2], f[3]); o.z = pk2(f[4], f[5]); o.w = pk2(f[6], f[7]); return o; }
__device__ __forceinline__ void head_norm64(float (&f)[8], const float* gain, float extra, int lane) {
    float ss = 0.f;
#pragma unroll
    for (int j = 0; j < 8; ++j) ss += f[j] * f[j];
    ss += __shfl_xor(ss, 1); ss += __shfl_xor(ss, 2); ss += __shfl_xor(ss, 4);
    const float rn = __builtin_amdgcn_rsqf(ss * (1.0f / 64.0f) + RMS_EPS) * extra; const float* gn = gain + (lane & 7) * 8;
#pragma unroll
    for (int j = 0; j < 8; ++j) f[j] = f[j] * rn * gn[j];
}
__device__ __forceinline__ void head_rope64(float (&f)[8], const float* cs, int lane) {
    float oth[8];
#pragma unroll
    for (int j = 0; j < 8; ++j) oth[j] = __shfl_xor(f[j], 1);
    const int li = lane & 7;
    if (li < 2) {
#pragma unroll
        for (int j = 0; j < 8; ++j) { const float c = cs[j], sn = cs[8 + j]; f[j] = (li == 0) ? f[j] * c - oth[j] * sn : f[j] * c + oth[j] * sn; }
    }
}

__device__ __forceinline__ int wave_sum_i(int x) {
    x += __builtin_amdgcn_update_dpp(0, x, 0x111, 0xf, 0xf, true);
    x += __builtin_amdgcn_update_dpp(0, x, 0x112, 0xf, 0xf, true);
    x += __builtin_amdgcn_update_dpp(0, x, 0x114, 0xf, 0xf, true);
    x += __builtin_amdgcn_update_dpp(0, x, 0x118, 0xf, 0xf, true);
    x += __builtin_amdgcn_update_dpp(0, x, 0x142, 0xa, 0xf, true);
    x += __builtin_amdgcn_update_dpp(0, x, 0x143, 0xc, 0xf, true);
    return __builtin_amdgcn_readlane(x, 63);
}

__device__ __forceinline__ int cnt_ge(unsigned u, unsigned cand, int c) {
    int r; asm("v_cmp_ge_u32 vcc, %1, %2\n\tv_addc_co_u32 %0, vcc, 0, %3, vcc" : "=v"(r) : "v"(u), "v"(cand), "v"(c) : "vcc"); return r; }

__device__ __forceinline__ int cnt_ge16(const unsigned* u, unsigned cand, int c) {
    asm("v_cmp_ge_u32 vcc, %1, %17\n\tv_addc_co_u32 %0, vcc, 0, %0, vcc\n\tv_cmp_ge_u32 vcc, %2, %17\n\tv_addc_co_u32 %0, vcc, 0, %0, vcc\n\t"
        "v_cmp_ge_u32 vcc, %3, %17\n\tv_addc_co_u32 %0, vcc, 0, %0, vcc\n\tv_cmp_ge_u32 vcc, %4, %17\n\tv_addc_co_u32 %0, vcc, 0, %0, vcc\n\t"
        "v_cmp_ge_u32 vcc, %5, %17\n\tv_addc_co_u32 %0, vcc, 0, %0, vcc\n\tv_cmp_ge_u32 vcc, %6, %17\n\tv_addc_co_u32 %0, vcc, 0, %0, vcc\n\t"
        "v_cmp_ge_u32 vcc, %7, %17\n\tv_addc_co_u32 %0, vcc, 0, %0, vcc\n\tv_cmp_ge_u32 vcc, %8, %17\n\tv_addc_co_u32 %0, vcc, 0, %0, vcc\n\t"
        "v_cmp_ge_u32 vcc, %9, %17\n\tv_addc_co_u32 %0, vcc, 0, %0, vcc\n\tv_cmp_ge_u32 vcc, %10, %17\n\tv_addc_co_u32 %0, vcc, 0, %0, vcc\n\t"
        "v_cmp_ge_u32 vcc, %11, %17\n\tv_addc_co_u32 %0, vcc, 0, %0, vcc\n\tv_cmp_ge_u32 vcc, %12, %17\n\tv_addc_co_u32 %0, vcc, 0, %0, vcc\n\t"
        "v_cmp_ge_u32 vcc, %13, %17\n\tv_addc_co_u32 %0, vcc, 0, %0, vcc\n\tv_cmp_ge_u32 vcc, %14, %17\n\tv_addc_co_u32 %0, vcc, 0, %0, vcc\n\t"
        "v_cmp_ge_u32 vcc, %15, %17\n\tv_addc_co_u32 %0, vcc, 0, %0, vcc\n\tv_cmp_ge_u32 vcc, %16, %17\n\tv_addc_co_u32 %0, vcc, 0, %0, vcc"
        : "+v"(c) : "v"(u[0]), "v"(u[1]), "v"(u[2]), "v"(u[3]), "v"(u[4]), "v"(u[5]), "v"(u[6]), "v"(u[7]), "v"(u[8]), "v"(u[9]), "v"(u[10]), "v"(u[11]), "v"(u[12]), "v"(u[13]), "v"(u[14]), "v"(u[15]), "v"(cand) : "vcc");
    return c;
}
struct Args { const void* in[32]; float* out; unsigned char* ws; int ph_lo, ph_hi, li, pad; };

template <class CMap>
__device__ __forceinline__ void transpose_item(const float* W, int K, int N, bf16_t* WT, const float* gain, LAS float* scr, int kb, int nb, int lane, CMap cmap) {
    const int k0 = 64 * kb, n0 = 32 * nb, n4 = (lane & 7) * 4; const int c = cmap(n0 + n4);
    f32x4 v[8]; float gk[8];
#pragma unroll
    for (int i = 0; i < 8; ++i) { const int kk = (lane >> 3) + 8 * i; v[i] = (f32x4){0.f, 0.f, 0.f, 0.f}; gk[i] = 1.f;
        if (c >= 0) { v[i] = *(const f32x4*)(W + (size_t)(k0 + kk) * N + c); if (gain) gk[i] = gain[k0 + kk]; } }
#pragma unroll
    for (int i = 0; i < 8; ++i) { const int kk = (lane >> 3) + 8 * i; *(LAS f32x4*)(scr + kk * 36 + n4) = v[i] * gk[i]; }
    asm volatile("s_waitcnt lgkmcnt(0)" ::: "memory");
    const int ch = lane & 7;
#pragma unroll
    for (int j = 0; j < 4; ++j) { const int n = (lane >> 3) + 8 * j; const LAS float* s = scr + (8 * ch) * 36 + n;
        u32x4 o; o.x = pk2(s[0 * 36], s[1 * 36]); o.y = pk2(s[2 * 36], s[3 * 36]); o.z = pk2(s[4 * 36], s[5 * 36]); o.w = pk2(s[6 * 36], s[7 * 36]);
        *(u32x4*)(WT + (size_t)(n0 + n) * K + k0 + 8 * ch) = o; }
    asm volatile("s_waitcnt lgkmcnt(0)" ::: "memory");
}

struct CMapId { int n; __device__ __forceinline__ int operator()(int p) const { return p < n ? p : -1; } };
struct CMapProj0 { __device__ __forceinline__ int operator()(int p) const { const int o = p & 255, c = 64 * (4 * (p >> 8) + ((o >> 5) & 3)) + 8 * (2 * ((o >> 3) & 3) + (o >> 7)) + (o & 7);
    if (c < 936) return c; if (c < 960) return -1; return (c - 24 < AB_W) ? c - 24 : -1; } };
struct CMapProj1 { __device__ __forceinline__ int operator()(int p) const { const int o = p & 255, c = 64 * (4 * (p >> 8) + ((o >> 5) & 3)) + 8 * (2 * ((o >> 3) & 3) + (o >> 7)) + (o & 7); return c < C_W ? c : -1; } };
struct CMapFfn { __device__ __forceinline__ int operator()(int p) const { const int t = p >> 8, r = p & 255; return r < 128 ? t * 128 + r : DFF + t * 128 + (r - 128); } };

#ifndef PIPE_MEM
#define PIPE_MEM false
#endif
#ifndef PIPE_DSA
#define PIPE_DSA true
#endif
#ifndef PIPE_MOBA
#define PIPE_MOBA false
#endif
#ifndef PIPE_SEL
#define PIPE_SEL true
#endif
#ifndef PIPE_WIN
#define PIPE_WIN true
#endif
#ifndef LP_L0
#define LP_L0 true
#endif
#ifndef LP_NSA
#define LP_NSA false
#endif
#ifndef AB_L0
#define AB_L0 0
#endif
#ifndef PROBE_MASK
#define PROBE_MASK 0u
#endif
#define REPS(k) (((PROBE_MASK >> (k)) & 1u) ? 2 : 1)
#define RUN(k) (lo <= (k) && (k) < hi)
#define SEAM(k) do { if ((k) + 1 < hi) xcd_barrier(bar); } while (0)
#define INF_(k) ((const float*)args.in[k])
#define x_in INF_(0)
#define mem_in INF_(1)
#define positions ((const int*)args.in[2])
#define norm_mix INF_(3)
#define norm_mem INF_(4)
#define norm_mem_src INF_(5)
#define norm_ffn INF_(6)
#define ab_w_in INF_(7)
#define ab_w_out INF_(8)
#define nsa_w_in INF_(13)
#define nsa_w_out INF_(14)
#define mem_w_q INF_(25)
#define mem_w_kv INF_(26)
#define mem_w_o INF_(27)
#define ffn_w_in INF_(30)
#define ffn_w_out INF_(31)
#define out (args.out)
#define WSB(off) ((bf16_t*)(args.ws + (off)))
#define W_AB WSB(WS_WAB)
#define W_C WSB(WS_WC)
#define W_ABO WSB(WS_WABO)
#define W_CO WSB(WS_WCO)
#define W_MQ WSB(WS_WMQ)
#define W_KV WSB(WS_WKV)
#define W_MO WSB(WS_WMO)
#define W_FI WSB(WS_WFI)
#define W_FO WSB(WS_WFO)
#define XB WSB(WS_XB)
#define RSQ ((float*)(args.ws + WS_RSQ))
#define HID WSB(WS_R1)
#define MEMB WSB(WS_MEMB)
#define KVRAW WSB(WS_KVRAW)
#define MRS ((float*)(args.ws + WS_MRS))
#define MQB WSB(WS_MQ)
#define OMEM WSB(WS_OMEM)
#define mem_q_norm INF_(28)
#define RAW WSB(WS_R1)
#define OATT WSB(WS_OATT)
#define ROPE64 ((float*)(args.ws + WS_ROPE64))
#define ROPE32 ((float*)(args.ws + WS_ROPE32))
#define W1T WSB(WS_W1T)
#define POSW1 ((float*)(args.ws + WS_POSW1))
#define KCMP WSB(WS_KCMP)
#define VCMP WSB(WS_VCMP)
#define GT ((float*)(args.ws + WS_GT))
#define SCR ((float*)(args.ws + WS_SC))
#define BMK ((unsigned long long*)(args.ws + WS_BM))
#define KMEAN ((float*)(args.ws + WS_KM))
#define IWB ((float*)(args.ws + WS_ISG))
#define dsa_q_norm INF_(9)
#define dsa_k_norm INF_(10)
#define moba_q_norm INF_(11)
#define moba_k_norm INF_(12)
#define nsa_q_norm INF_(15)
#define nsa_kcmp_norm INF_(16)
#define nsa_ksel_norm INF_(17)
#define nsa_kwin_norm INF_(18)
#define nsa_cmp_pos_k INF_(19)
#define nsa_cmp_pos_v INF_(20)
#define nsa_cmp_w1_k INF_(21)
#define nsa_cmp_w2_k INF_(22)
#define nsa_cmp_w1_v INF_(23)
#define nsa_cmp_w2_v INF_(24)
#define mem_k_norm INF_(29)
template <int L> __device__ __forceinline__ void layer_phases(const Args& args, LAS unsigned char* lds, const XcdBarrier& bar, const int lo, const int hi, const int wave) {
    const int G = gridDim.x, bid = blockIdx.x;
    constexpr int pb = 1 + 10 * L;
        if (RUN(pb + 0)) for (int rep_ = 0; rep_ < REPS(pb + 0); ++rep_) {
            int lane = (int)__builtin_amdgcn_mbcnt_hi(~0u, __builtin_amdgcn_mbcnt_lo(~0u, 0u)); asm volatile("" : "+v"(lane)); const int tid = wave * 64 + lane;
            if (L == 0) {
                pg8::Gemm g{MEMB, W_KV, MMEM, 2048, DM}; pg8::StaticOrder S; S.init(MMEM, 2048, G, bid);
                pg8::EpiPlain E{KVRAW, 2048};
                pg8::gemm_phase<pg8::EpiPlain, pg8::StaticOrder, true, true>(lds, g, S, E, wave);
            }
            if (L == 0) {
                pg8::Gemm g{XB, W_AB, MTOK, AB_WP, DM}; pg8::StaticOrder S; S.init(MTOK, AB_WP, G, bid);
                pg8::EpiProj<0> E{RAW, AB_WP, RSQ, ROPE64, ROPE32, dsa_q_norm, dsa_k_norm, moba_q_norm, moba_k_norm, IWB, lds};
                pg8::gemm_phase<pg8::EpiProj<0>, pg8::StaticOrder, true, true>(lds, g, S, E, wave);
            }
            if (L == 1) {
                pg8::Gemm g{XB, W_C, MTOK, C_WP, DM}; pg8::StaticOrder S; S.init(MTOK, C_WP, G, bid);
                pg8::EpiProj<1> E{RAW, C_WP, RSQ, ROPE64, ROPE32, nsa_q_norm, nsa_ksel_norm, nsa_kwin_norm, nullptr, GT, lds};
                pg8::gemm_phase<pg8::EpiProj<1>, pg8::StaticOrder, true, true>(lds, g, S, E, wave);
            }
            SEAM(pb + 0);
        }
        if (RUN(pb + 1)) for (int rep_ = 0; rep_ < REPS(pb + 1); ++rep_) {
            int lane = (int)__builtin_amdgcn_mbcnt_hi(~0u, __builtin_amdgcn_mbcnt_lo(~0u, 0u)); asm volatile("" : "+v"(lane)); const int tid = wave * 64 + lane;
            if (L == 1) {
                LAS float* PART = (LAS float*)lds;
                LAS float* HB = (LAS float*)(lds + 65536);
                LAS float* W2S = (LAS float*)(lds + 65536 + 8448);
                for (int u = bid; u < BATCH * 4 * 2 * 8; u += G) {
                    const int ch = u & 7, kv = (u >> 3) & 1, g = (u >> 4) & 3, b = u >> 6;
                    const int r = lane & 31, h = lane >> 5, n0 = ch * 32;
                    const bf16_t* xb0 = RAW + (size_t)(b * SEQ + 16 * (n0 + r)) * C_WP + (kv ? 1280 : 1024) + g * 64 + 8 * h;
                    const bf16_t* wt = W1T + (size_t)kv * 64 * 2048 + 8 * h;
                    f32x16 acc[2];
#pragma unroll
                    for (int i = 0; i < 16; ++i) { acc[0][i] = 0.f; acc[1][i] = 0.f; }
                    const bool rowok = (n0 + r) < 255;
                    float rsl[4];
#pragma unroll
                    for (int li = 0; li < 4; ++li) rsl[li] = rowok ? row_rstd(RSQ, b * SEQ + 16 * (n0 + r) + wave * 4 + li) : 0.f;
#pragma unroll
                    for (int li = 0; li < 4; ++li) { const int l = wave * 4 + li;
#pragma unroll
                        for (int s2 = 0; s2 < 4; ++s2) {
                            bf16x8 a = {0, 0, 0, 0, 0, 0, 0, 0};
                            if (rowok) { float f[8]; unpack8(*(const u32x4*)(xb0 + (size_t)l * C_WP + 16 * s2), f);
#pragma unroll
                                for (int j = 0; j < 8; ++j) f[j] *= rsl[li];
                                a = __builtin_bit_cast(bf16x8, pack8f(f)); }
                            const bf16x8 b0 = *(const bf16x8*)(wt + (size_t)r * 2048 + l * 64 + 16 * s2), b1 = *(const bf16x8*)(wt + (size_t)(32 + r) * 2048 + l * 64 + 16 * s2);
                            acc[0] = __builtin_amdgcn_mfma_f32_32x32x16_bf16(a, b0, acc[0], 0, 0, 0); acc[1] = __builtin_amdgcn_mfma_f32_32x32x16_bf16(a, b1, acc[1], 0, 0, 0); } }
                    __syncthreads();
#pragma unroll
                    for (int nh = 0; nh < 2; ++nh)
#pragma unroll
                        for (int i = 0; i < 16; ++i) PART[wave * 2048 + ((i & 3) + 8 * (i >> 2) + 4 * h) * 64 + nh * 32 + r] = acc[nh][i];
                    { const float* w2 = kv ? nsa_cmp_w2_v : nsa_cmp_w2_k; const f32x4 wa = *(const f32x4*)(w2 + tid * 4), wb = *(const f32x4*)(w2 + 2048 + tid * 4);
                      *(LAS f32x4*)(W2S + tid * 4) = wa; *(LAS f32x4*)(W2S + 2048 + tid * 4) = wb; }
                    __syncthreads();
                    const float pw1 = POSW1[kv * 64 + (tid & 63)];
                    for (int i = tid; i < 2048; i += 512) { float a = pw1;
#pragma unroll
                        for (int w = 0; w < 8; ++w) a += PART[w * 2048 + i];
                        HB[(i >> 6) * 65 + (i & 63)] = a / (1.0f + __expf(-a)); }
                    __syncthreads();
                    { const int n = tid >> 4, c4 = (tid & 15) * 4; float o[4] = {0.f, 0.f, 0.f, 0.f};
                        for (int c = 0; c < 64; ++c) { const float hv = HB[n * 65 + c]; const f32x4 w = *(const LAS f32x4*)(W2S + c * 64 + c4); o[0] += hv * w[0]; o[1] += hv * w[1]; o[2] += hv * w[2]; o[3] += hv * w[3]; }
                        if (kv == 0) { float ss = (o[0] * o[0] + o[1] * o[1]) + (o[2] * o[2] + o[3] * o[3]);
                            ss += __shfl_xor(ss, 1); ss += __shfl_xor(ss, 2); ss += __shfl_xor(ss, 4); ss += __shfl_xor(ss, 8);
                            const float rn = __builtin_amdgcn_rsqf(ss * (1.0f / 64.0f) + RMS_EPS);
#pragma unroll
                            for (int j = 0; j < 4; ++j) o[j] = o[j] * rn * nsa_kcmp_norm[c4 + j]; }
                        if (n0 + n >= 255) { o[0] = o[1] = o[2] = o[3] = 0.f; }
                        u32x2 w; w.x = pk2(o[0], o[1]); w.y = pk2(o[2], o[3]);
                        *(u32x2*)((kv ? VCMP : KCMP) + ((size_t)(b * 4 + g) * 256 + n0 + n) * 64 + c4) = w; }
                    __syncthreads();
                }
            }
            if (L == 1) SEAM(pb + 1);
        }
        if (RUN(pb + 2)) for (int rep_ = 0; rep_ < REPS(pb + 2); ++rep_) {
            int lane = (int)__builtin_amdgcn_mbcnt_hi(~0u, __builtin_amdgcn_mbcnt_lo(~0u, 0u)); asm volatile("" : "+v"(lane)); const int tid = wave * 64 + lane;
            if (L == 0 && rep_ == 0) {
                const int gw = bid * NWAVES + wave, NGW = G * NWAVES;
                for (int m = gw; m < MMEM; m += NGW) {
                    const float rs = MRS[m]; bf16_t* row = KVRAW + (size_t)m * 2048;
#pragma unroll
                    for (int st = 0; st < 4; ++st) {
                        u32x4 w = *(const u32x4*)(row + st * 512 + lane * 8); float f[8];
#pragma unroll
                        for (int j = 0; j < 4; ++j) { f[2 * j] = __builtin_bit_cast(float, w[j] << 16) * rs; f[2 * j + 1] = __builtin_bit_cast(float, w[j] & 0xffff0000u) * rs; }
                        if ((st & 1) == 0) {
                            float ss = 0.f;
#pragma unroll
                            for (int j = 0; j < 8; ++j) ss += f[j] * f[j];
                            ss += __shfl_xor(ss, 1); ss += __shfl_xor(ss, 2); ss += __shfl_xor(ss, 4); ss += __shfl_xor(ss, 8);
                            const float rn = __builtin_amdgcn_rsqf(ss * (1.0f / 128.0f) + RMS_EPS);
                            const float* gn = mem_k_norm + (st >> 1) * 128 + (lane & 15) * 8;
#pragma unroll
                            for (int j = 0; j < 8; ++j) f[j] = f[j] * rn * gn[j];
                        }
                        u32x4 o; o.x = pk2(f[0], f[1]); o.y = pk2(f[2], f[3]); o.z = pk2(f[4], f[5]); o.w = pk2(f[6], f[7]);
                        *(u32x4*)(row + st * 512 + lane * 8) = o;
                    }
                }
            }
            if (L == 0) {
                { const int gw = bid * NWAVES + wave, NGW = G * NWAVES;
                  for (int u = gw; u < BATCH * 8 * 16; u += NGW) { const int n = u & 15, hm = (u >> 4) & 7, b = u >> 7;
                      const bf16_t* kb = RAW + (size_t)(b * SEQ + 256 * n + (lane >> 3)) * AB_WP + 1472 + hm * 64 + (lane & 7) * 8; float a[8] = {0.f, 0.f, 0.f, 0.f, 0.f, 0.f, 0.f, 0.f};
                      for (int i0 = 0; i0 < 32; i0 += 8) { u32x4 rw[8];
#pragma unroll
                          for (int i = 0; i < 8; ++i) rw[i] = *(const u32x4*)(kb + (size_t)(8 * (i0 + i)) * AB_WP);
#pragma unroll
                          for (int i = 0; i < 8; ++i) { float f[8]; unpack8(rw[i], f);
#pragma unroll
                              for (int j = 0; j < 8; ++j) a[j] += f[j]; } }
#pragma unroll
                      for (int j = 0; j < 8; ++j) { a[j] += __shfl_xor(a[j], 8); a[j] += __shfl_xor(a[j], 16); a[j] += __shfl_xor(a[j], 32); }
                      if (lane < 8) { float* o = KMEAN + (size_t)u * 64 + lane * 8;
#pragma unroll
                          for (int j = 0; j < 8; ++j) o[j] = a[j] * (1.0f / 256.0f); } } }
                LAS float* SCL = (LAS float*)lds;
#if defined(PROBE_IDX) && PROBE_IDX == 2
                if (rep_ == 0)
#endif
                for (int ui = bid; ui < BATCH * 256; ui += G) {
                    const int rr = ui >> 8, pos = ui & 255; const int qi = 32 * rr + ((rr & 1) ? 31 - (pos >> 3) : (pos >> 3)), b = pos & 7;
                    const int t0 = qi * 16, tmax = t0 + 15, nchunk = (tmax >> 10) + 1, nreg = (tmax >> 6) + 1;
                    const int ql = lane & 15, kq = lane >> 4;
                    const size_t qrow = (size_t)b * SEQ + t0 + ql;
                    typedef float f32x4v __attribute__((ext_vector_type(4)));
                    bf16x8 qf[8];
#pragma unroll
                    for (int hi = 0; hi < 8; ++hi) qf[hi] = *(const bf16x8*)(RAW + qrow * AB_WP + 640 + hi * 32 + 8 * kq);
                    const f32x4 iw0 = *(const f32x4*)(IWB + qrow * 8), iw1 = *(const f32x4*)(IWB + qrow * 8 + 4);
                    unsigned uu[2][64];
#pragma unroll
                    for (int rg = 0; rg < 64; ++rg) { uu[0][rg] = 0u; uu[1][rg] = 0u; }
#pragma unroll
                    for (int c = 0; c < 4; ++c) if (c < nchunk) {
                        const int ntile = ((tmax - 1024 * c) >> 4) + 1 < 64 ? ((tmax - 1024 * c) >> 4) + 1 : 64;
                        __syncthreads();
                        const bf16_t* kfp = RAW + (size_t)(b * SEQ + 1024 * c + ql) * AB_WP + 896 + 8 * kq;
                        bf16x8 kfn = *(const bf16x8*)(kfp + (size_t)(16 * (wave < ntile ? wave : 0)) * AB_WP);
                        for (int tile = wave; tile < ntile; tile += 8) {
                            const bf16x8 kf = kfn; { const int tn = tile + 8 < ntile ? tile + 8 : tile; kfn = *(const bf16x8*)(kfp + (size_t)(16 * tn) * AB_WP); }
                            f32x4v sc = {0.f, 0.f, 0.f, 0.f};
#pragma unroll
                            for (int hi = 0; hi < 8; ++hi) { f32x4v x = {0.f, 0.f, 0.f, 0.f}; x = __builtin_amdgcn_mfma_f32_16x16x32_bf16(kf, qf[hi], x, 0, 0, 0);
                                const float sf = hi < 4 ? iw0[hi & 3] : iw1[hi & 3];
#pragma unroll
                                for (int i = 0; i < 4; ++i) sc[i] += sf * fmaxf(x[i], 0.f); }
                            *(LAS f32x4v*)(SCL + ql * 1028 + 16 * tile + 4 * kq) = sc;
                        }
                        __syncthreads();
#pragma unroll
                        for (int qq = 0; qq < 2; ++qq) { const int t = t0 + 2 * wave + qq;
#pragma unroll
                            for (int rl = 0; rl < 16; ++rl) { const int key = 1024 * c + 64 * rl + lane; const unsigned bits = __builtin_bit_cast(unsigned, SCL[(2 * wave + qq) * 1028 + 64 * rl + lane]);
                                const unsigned mono = bits ^ ((bits >> 31) ? 0xffffffffu : 0x80000000u); uu[qq][16 * c + rl] = (key <= t) ? mono : 0u; } }
                    }
#if defined(PROBE_IDX) && PROBE_IDX == 1
                    if (rep_) { if (uu[0][3] == 12345u && uu[1][40] == 777u) BMK[0] = 1ull; continue; }
#endif
                    int lb = lane; asm volatile("" : "+v"(lb));
                    unsigned long long word[2] = {0ull, 0ull};
                    unsigned T[2] = {0u, 0u}; bool done[2], exact[2] = {false, false};
                    done[0] = (t0 + 2 * wave) < 256; done[1] = (t0 + 2 * wave + 1) < 256;
                    for (int bit = 31; bit >= 0 && !(done[0] && done[1]); --bit) {
                        const unsigned c0 = T[0] | (1u << bit), c1 = T[1] | (1u << bit); int n0 = 0, n1 = 0;
#pragma unroll
                        for (int ch = 0; ch < 4; ++ch) if (16 * ch < nreg) {
#pragma unroll
                            for (int dummy_ = 0; dummy_ < 1; ++dummy_) { n0 = cnt_ge16(&uu[0][16 * ch], c0, n0); n1 = cnt_ge16(&uu[1][16 * ch], c1, n1); } }
                        const int s0 = wave_sum_i(n0), s1 = wave_sum_i(n1);
                        if (!done[0]) { if (s0 >= 256) T[0] = c0; if (s0 == 256) { done[0] = true; exact[0] = true; } }
                        if (!done[1]) { if (s1 >= 256) T[1] = c1; if (s1 == 256) { done[1] = true; exact[1] = true; } }
                    }
#pragma unroll
                    for (int qq = 0; qq < 2; ++qq) { const int t = t0 + 2 * wave + qq; unsigned long long myword = 0ull;
                        if (t < 256) {
#pragma unroll
                            for (int rg = 0; rg < 4; ++rg) { const unsigned long long w = __ballot(64 * rg + lb <= t); if (lb == rg) myword = w; }
                        } else if (exact[qq]) {
#pragma unroll
                            for (int rg = 0; rg < 64; ++rg) { const unsigned long long w = __ballot(uu[qq][rg] >= T[qq]); if (lb == rg) myword = w; __builtin_amdgcn_sched_barrier(0); }
                        } else {
                            int cg = 0;
#pragma unroll
                            for (int rg = 0; rg < 64; ++rg) cg = cnt_ge(uu[qq][rg], T[qq] + 1u, cg);
                            int need = 256 - wave_sum_i(cg);
#pragma unroll
                            for (int rg = 0; rg < 64; ++rg) {
                                unsigned long long w = __ballot(uu[qq][rg] > T[qq]), eq = __ballot(uu[qq][rg] == T[qq]); const int ne = __builtin_popcountll(eq);
                                if (ne <= need) { w |= eq; need -= ne; } else { while (need > 0) { const unsigned long long low = eq & (0ull - eq); w |= low; eq ^= low; --need; } }
                                if (lb == rg) myword = w; __builtin_amdgcn_sched_barrier(0); }
                        }
                        BMK[((size_t)(b * 128 + (t >> 5)) * 64 + lb) * 32 + (t & 31)] = myword;
                    }
                }
            }
            if (L == 0) SEAM(pb + 2);
        }
        if (RUN(pb + 3)) for (int rep_ = 0; rep_ < REPS(pb + 3); ++rep_) {
            int lane = (int)__builtin_amdgcn_mbcnt_hi(~0u, __builtin_amdgcn_mbcnt_lo(~0u, 0u)); asm volatile("" : "+v"(lane)); const int tid = wave * 64 + lane;
            if (L == 0) {
                const float shiftA = att::softmax_shift(att::gain_max64(dsa_q_norm), att::gain_max64(dsa_k_norm)), shiftB = att::softmax_shift(att::gain_max64(moba_q_norm), att::gain_max64(moba_k_norm));
                for (int ui = bid; ui < BATCH * 128; ui += G) {
                    const int rr = ui >> 8, pos = ui & 255; const int qt = 32 * rr + ((rr & 1) ? 31 - (pos >> 3) : (pos >> 3)), b = pos & 7;
                    const int r = lane & 31, h = lane >> 5; const size_t row = (size_t)b * SEQ + qt * 32 + r;
                    bf16x8 qf[4];
                    { const bf16_t* qrow = RAW + row * AB_WP + wave * 64 + 8 * h;
#pragma unroll
                      for (int s2 = 0; s2 < 4; ++s2) qf[s2] = *(const bf16x8*)(qrow + 16 * s2); }
                    f32x16 oo[2]; float ll = 0.f;
#pragma unroll
                    for (int i = 0; i < 16; ++i) { oo[0][i] = 0.f; oo[1][i] = 0.f; }
                    const bf16_t* kbase = RAW + (size_t)b * SEQ * AB_WP + 512; const unsigned long long* bm = BMK + (size_t)(b * 128 + qt) * 64 * 32;
                    const att::LpOff lpo = att::lp_offsets(lane, wave, AB_WP * 2);
                    LAS unsigned char* MSL = lds + 8 * att::DBUF;
{ auto go_ = [&](auto hs_) { constexpr bool HS = decltype(hs_)::value;
#if AB_L0
                    att::kv_pipeline_ab<1>(lds, (qt >> 1) + 1, wave, lane, qf, oo,
                        [&](int tt, const bf16_t*& kb, size_t& kp, const bf16_t*& vb, size_t& vp) { kb = kbase + (size_t)(64 * tt) * AB_WP; kp = AB_WP; vb = kb + 64; vp = AB_WP; },
                        [&](int tt, const f32x16 (&p)[2], u32x4 (&pw)[4], int slot) {
                            const unsigned long long w = *(const LAS unsigned long long*)(MSL + (slot * 8 + wave) * 256 + r * 8) >> (4 * h);
                            att::half_v<2, HS>(pw, ll, p, true, shiftA, [](int) { return true; }, (unsigned)w, (unsigned)(w >> 32)); },
                        [&](int tt, int slot) { __builtin_amdgcn_global_load_lds((const unsigned*)(bm + (size_t)tt * 32) + lane, (LAS unsigned*)(MSL + (slot * 8 + wave) * 256), 4, 0, 0); });
#else
                    att::kv_pipeline_dma8<0>(lds, (qt >> 1) + 1, wave, lane, qf, lpo,
                        [&](int tt, const bf16_t*& kb, size_t& kp, const bf16_t*& vb, size_t& vp) { kb = kbase + (size_t)(64 * tt) * AB_WP; kp = AB_WP; vb = kb + 64; vp = AB_WP; },
                        [&](int tt, f32x16 (&p)[2], const LAS unsigned char* buf, const LAS unsigned char* nbuf, f32x16 (&pn)[2], int slot) {
                            const unsigned long long w = *(const LAS unsigned long long*)(MSL + slot * 256 + r * 8) >> (4 * h);
#if defined(PROBE_SKEL) && PROBE_SKEL == 2
                            if (rep_ == 0)
#endif
                            att::fused_e<2, HS, LP_L0>(oo, ll, p, buf, lane, true, shiftA, [](int) { return true; }, (unsigned)w, (unsigned)(w >> 32), qf, nbuf, pn, lpo); },
                        [&](int tt, int slot) { if ((tt & 7) == wave) __builtin_amdgcn_global_load_lds((const unsigned*)(bm + (size_t)tt * 32) + lane, (LAS unsigned*)(MSL + slot * 256), 4, 0, 0); });
#endif
 }; if (shiftA == 0.f) go_(std::false_type{}); else go_(std::true_type{}); }
                    const float lt = ll + __shfl_xor(ll, 32);
#if defined(PROBE_SKEL) && PROBE_SKEL == 2
                    if (rep_ == 0)
#endif
                    att::store_o_t<64>(oo, lt > 0.f ? 1.0f / lt : 0.f, OATT + ((size_t)b * SEQ + qt * 32) * 1024 + wave * 64, 1024, lds + wave * 4608, lane);
                }
                LAS unsigned* UNI = (LAS unsigned*)(lds + 8 * att::DBUF); LAS int* TL = (LAS int*)(lds + 8 * att::DBUF + 16); LAS float* KMS = (LAS float*)(lds + 8 * att::DBUF + 256);
#if defined(PROBE_SKEL)
                if (rep_ == 0)
#endif
                for (int ui = bid; ui < BATCH * 8 * 16; ui += G) {
                    const int rr = ui >> 8, pos = ui & 255; const int xk = pos >> 3, cmb = rr * 16 + (pos & 7) * 2 + (xk >> 4);
                    const int own = (rr & 1) ? 15 - (xk & 15) : (xk & 15), b = cmb >> 3, hm = cmb & 7;
                    const int r = lane & 31, h = lane >> 5; const int tl = wave * 32 + r; const size_t row = (size_t)b * SEQ + own * 256 + tl;
                    bf16x8 qf[4];
                    { const bf16_t* qrow = RAW + row * AB_WP + 960 + hm * 64 + 8 * h;
#pragma unroll
                      for (int s2 = 0; s2 < 4; ++s2) qf[s2] = *(const bf16x8*)(qrow + 16 * s2); }
                    if (tid == 0) UNI[0] = 0u;
                    { const f32x2 kmv = *(const f32x2*)(KMEAN + (size_t)(b * 8 + hm) * 1024 + tid * 2); *(LAS f32x2*)(KMS + tid * 2) = kmv; }
                    __syncthreads();
                    unsigned msk = 0u;
                    { float b0 = att::NEG_INF, b1 = att::NEG_INF, b2 = att::NEG_INF; int i0 = -1, i1 = -1, i2 = -1;
                      float qv[32];
#pragma unroll
                      for (int s2 = 0; s2 < 4; ++s2) { float f[8]; unpack8(__builtin_bit_cast(u32x4, qf[s2]), f);
#pragma unroll
                          for (int j = 0; j < 8; ++j) qv[8 * s2 + j] = f[j]; }
                      for (int n = 0; n < own; ++n) { const LAS float* km = KMS + n * 64 + 8 * h; float a = 0.f;
#pragma unroll
                          for (int s2 = 0; s2 < 4; ++s2) { const f32x4 k0 = *(const LAS f32x4*)(km + 16 * s2), k1 = *(const LAS f32x4*)(km + 16 * s2 + 4);
                              a += qv[8 * s2] * k0[0] + qv[8 * s2 + 1] * k0[1] + qv[8 * s2 + 2] * k0[2] + qv[8 * s2 + 3] * k0[3] + qv[8 * s2 + 4] * k1[0] + qv[8 * s2 + 5] * k1[1] + qv[8 * s2 + 6] * k1[2] + qv[8 * s2 + 7] * k1[3]; }
                          a += __shfl_xor(a, 32);
                          if (a > b0) { b2 = b1; i2 = i1; b1 = b0; i1 = i0; b0 = a; i0 = n; } else if (a > b1) { b2 = b1; i2 = i1; b1 = a; i1 = n; } else if (a > b2) { b2 = a; i2 = n; } }
                      if (i0 >= 0) msk |= 1u << i0; if (i1 >= 0) msk |= 1u << i1; if (i2 >= 0) msk |= 1u << i2; }
                    { unsigned um = msk;
#pragma unroll
                      for (int o = 1; o < 64; o <<= 1) um |= __shfl_xor(um, o);
                      if (lane == 0) __hip_atomic_fetch_or(UNI, um, __ATOMIC_RELAXED, __HIP_MEMORY_SCOPE_WORKGROUP); }
                    __syncthreads();
                    const unsigned U = (unsigned)__builtin_amdgcn_readfirstlane((int)UNI[0]);
                    const int npast = __builtin_popcount(U);
                    if (wave == 0 && lane < 16 && ((U >> lane) & 1u)) TL[__builtin_amdgcn_mbcnt_lo(U, 0u)] = lane;
                    f32x16 oo[2]; float ll = 0.f;
#pragma unroll
                    for (int i = 0; i < 16; ++i) { oo[0][i] = 0.f; oo[1][i] = 0.f; }
                    const bf16_t* kbase = RAW + (size_t)b * SEQ * AB_WP + 1472 + hm * 64;
                    const att::LpOff lpo = att::lp_offsets(lane, wave, AB_WP * 2);
                    __syncthreads();
{ auto go_ = [&](auto hs_) { constexpr bool HS = decltype(hs_)::value;
#if AB_L0
                    att::kv_pipeline_ab<0>(lds, 4 * npast + 4, wave, lane, qf, oo,
                        [&](int tt, const bf16_t*& kb, size_t& kp, const bf16_t*& vb, size_t& vp) {
                            const int blk = (tt < 4 * npast) ? __builtin_amdgcn_readfirstlane(TL[tt >> 2]) : own, sub = (tt < 4 * npast) ? (tt & 3) : tt - 4 * npast;
                            kb = kbase + (size_t)(256 * blk + 64 * sub) * AB_WP; kp = AB_WP; vb = kb + 512; vp = AB_WP; },
                        [&](int tt, const f32x16 (&p)[2], u32x4 (&pw)[4], int) {
                            if (tt < 4 * npast) { const int blk = __builtin_amdgcn_readfirstlane(TL[tt >> 2]); const bool sel = (msk >> blk) & 1u;
                                att::half_v<0, HS>(pw, ll, p, sel, shiftB, [](int) { return true; }, 0u, 0u); }
                            else { const int sub = tt - 4 * npast; const int lim = tl - 64 * sub - 4 * h;
                                att::half_v<1, HS>(pw, ll, p, true, shiftB, [&](int koff) { return koff <= lim; }, 0u, 0u); } },
                        att::NoXtra());
#else
                    att::kv_pipeline_dma8<0>(lds, 4 * npast + 4, wave, lane, qf, lpo,
                        [&](int tt, const bf16_t*& kb, size_t& kp, const bf16_t*& vb, size_t& vp) {
                            const int blk = (tt < 4 * npast) ? __builtin_amdgcn_readfirstlane(TL[tt >> 2]) : own, sub = (tt < 4 * npast) ? (tt & 3) : tt - 4 * npast;
                            kb = kbase + (size_t)(256 * blk + 64 * sub) * AB_WP; kp = AB_WP; vb = kb + 512; vp = AB_WP; },
                        [&](int tt, f32x16 (&p)[2], const LAS unsigned char* buf, const LAS unsigned char* nbuf, f32x16 (&pn)[2], int) {
                            if (tt < 4 * npast) { const int blk = __builtin_amdgcn_readfirstlane(TL[tt >> 2]); const bool sel = (msk >> blk) & 1u;
                                att::fused_e<0, HS, LP_L0>(oo, ll, p, buf, lane, sel, shiftB, [](int) { return true; }, 0u, 0u, qf, nbuf, pn, lpo); }
                            else { const int sub = tt - 4 * npast; const int lim = tl - 64 * sub - 4 * h;
                                att::fused_e<1, HS, LP_L0>(oo, ll, p, buf, lane, true, shiftB, [&](int koff) { return koff <= lim; }, 0u, 0u, qf, nbuf, pn, lpo); } },
                        att::NoXtra());
#endif
 }; if (shiftB == 0.f) go_(std::false_type{}); else go_(std::true_type{}); }
                    const float lt = ll + __shfl_xor(ll, 32);
                    att::store_o_t<64>(oo, lt > 0.f ? 1.0f / lt : 0.f, OATT + ((size_t)b * SEQ + own * 256 + wave * 32) * 1024 + 512 + hm * 64, 1024, lds + wave * 4608, lane);
                    __syncthreads();
                }
            }
            if (L == 1) {
                const float shiftS = att::softmax_shift(att::gain_max64(nsa_q_norm), att::gain_max64(nsa_ksel_norm)), shiftW = att::softmax_shift(att::gain_max64(nsa_q_norm), att::gain_max64(nsa_kwin_norm));
                LAS unsigned* IMP = (LAS unsigned*)(lds + 86016);
                LAS unsigned long long* SELM = (LAS unsigned long long*)(lds + 4 * att::DBUF); LAS int* TL = (LAS int*)(lds + 4 * att::DBUF + 528);
                for (int ui = bid; ui < BATCH * 4 * 64; ui += G) {
                    const int rr = ui >> 8, pos = ui & 255;
                    const int pr = (pos & 7) * 4 + (rr >> 1), xk = pos >> 3, qt = (rr & 1) ? 63 - xk : xk, b = pr >> 2, g = pr & 3;
                    const int r = lane & 31, h = lane >> 5, j = wave & 3, qs = wave >> 2, hd = g * 4 + j;
                    const int t = qt * 64 + qs * 32 + r, ql = qs * 32 + r; const size_t row = (size_t)b * SEQ + t;
                    bf16x8 qf[4];
                    { const bf16_t* qrow = RAW + row * C_WP + hd * 64 + 8 * h;
#pragma unroll
                      for (int s2 = 0; s2 < 4; ++s2) qf[s2] = *(const bf16x8*)(qrow + 16 * s2); }
                    for (int i = tid; i < ((qt >> 4) + 1) * 64 * 64 / 4; i += 512) ((LAS u32x4*)IMP)[i] = (u32x4){0u, 0u, 0u, 0u};
                    f32x16 oacc[2];
                    const float* gt = GT + row * 48 + hd * 3; const float g0 = gt[0];
                    const int nvalid = t >= 31 ? ((t - 31) >> 4) + 1 : 0;
                    const int ntc = (qt >> 4) + 1;
                    { const bf16_t* kcb = KCMP + (size_t)(b * 4 + g) * 256 * 64; const bf16_t* vcb = VCMP + (size_t)(b * 4 + g) * 256 * 64;
                      for (int idx = tid; idx < 64 * 8 * ntc; idx += 512) { const int rw = idx >> 3, c = idx & 7;
                          *(LAS u32x4*)(lds + rw * 144 + c * 16) = *(const u32x4*)(kcb + rw * 64 + c * 8);
                          *(LAS u32x4*)(lds + 36864 + rw * 192 + c * 16) = *(const u32x4*)(vcb + rw * 64 + c * 8); } }
                    __syncthreads();
                    float mc = att::NEG_INF, lc = 0.f;
#pragma unroll 1
                    for (int tt = 0; tt < ntc; ++tt) {
                        f32x16 p[2]; att::tile_scores<64>(p, qf, lds + tt * 9216, lane); const int lim = nvalid - 64 * tt - 4 * h; float mx = att::NEG_INF;
#pragma unroll
                        for (int kt = 0; kt < 2; ++kt)
#pragma unroll
                            for (int i = 0; i < 16; ++i) { const int koff = 32 * kt + (i & 3) + 8 * (i >> 2); const float v = (koff < lim) ? p[kt][i] : att::NEG_INF; p[kt][i] = v; mx = fmaxf(mx, v); }
                        mx = fmaxf(mx, __shfl_xor(mx, 32));
                        const float mnew = fmaxf(mc, mx), muse = (mnew == att::NEG_INF) ? 0.f : mnew; float ls = 0.f;
#pragma unroll
                        for (int kt = 0; kt < 2; ++kt)
#pragma unroll
                            for (int i = 0; i < 16; ++i) ls += __builtin_amdgcn_exp2f(p[kt][i] - muse);
                        lc = lc * __builtin_amdgcn_exp2f(mc - muse) + ls; mc = mnew; }
                    lc += __shfl_xor(lc, 32);
                    const float invl = lc > 0.f ? 1.0f / lc : 0.f, mcu = (mc == att::NEG_INF) ? 0.f : mc;
#pragma unroll
                    for (int i = 0; i < 16; ++i) { oacc[0][i] = 0.f; oacc[1][i] = 0.f; }
#pragma unroll 1
                    for (int tt = 0; tt < ntc; ++tt) {
                        f32x16 p[2]; att::tile_scores<64>(p, qf, lds + tt * 9216, lane); const int lim = nvalid - 64 * tt - 4 * h;
#pragma unroll
                        for (int kt = 0; kt < 2; ++kt)
#pragma unroll
                            for (int i = 0; i < 16; ++i) { const int koff = 32 * kt + (i & 3) + 8 * (i >> 2); const float pv = (koff < lim) ? __builtin_amdgcn_exp2f(p[kt][i] - mcu) * invl : 0.f; p[kt][i] = pv;
                                __hip_atomic_fetch_add(IMP + (64 * tt + koff + 4 * h) * 64 + ql, (unsigned)(pv * 134217728.0f + 0.5f), __ATOMIC_RELAXED, __HIP_MEMORY_SCOPE_WORKGROUP);
                                if ((i & 3) == 3) __builtin_amdgcn_sched_barrier(0); }
                        __builtin_amdgcn_sched_barrier(0);
                        att::tile_pv<64>(oacc, p, lds + 36864 + tt * 12288 - 9216, lane); }
#pragma unroll
                    for (int i = 0; i < 16; ++i) { oacc[0][i] *= g0; oacc[1][i] *= g0; }
                    LAS float* STASH = (LAS float*)IMP + wave * 2048 + lane;
                    __syncthreads();
                    {
                        int l2 = lane; asm volatile("" : "+v"(l2));
                        const int qq = l2 >> 3, seg = l2 & 7, q = wave * 8 + qq, cur = qt;
                        unsigned key[8];
#pragma unroll
                        for (int k = 0; k < 8; ++k) { const int sb = 8 * seg + k; unsigned v = 0u;
#pragma unroll
                            for (int dn = -1; dn <= 3; ++dn) { const int n = 4 * sb + dn; if (n >= 0 && n < 255) v += IMP[n * 64 + q]; }
                            const bool forced = (sb == 0) || (sb == cur) || (sb == cur - 1);
                            key[k] = (sb <= cur) ? ((forced ? 0xffffff80u : ((v >> 7) << 7)) | (unsigned)(64 - sb)) : 0u; __builtin_amdgcn_sched_barrier(0); }
                        unsigned T = 0u;
                        for (int bit = 31; bit >= 0; --bit) { const unsigned cand = T | (1u << bit); int c = 0;
#pragma unroll
                            for (int k = 0; k < 8; ++k) c += (key[k] >= cand) ? 1 : 0;
                            c += __builtin_amdgcn_update_dpp(0, c, 0xB1, 0xf, 0xf, false);
                            c += __builtin_amdgcn_update_dpp(0, c, 0x4E, 0xf, 0xf, false);
                            c += __builtin_amdgcn_update_dpp(0, c, 0x141, 0xf, 0xf, false);
                            if (c >= 16) T = cand; }
                        unsigned byte = 0u;
#pragma unroll
                        for (int k = 0; k < 8; ++k) byte |= (key[k] != 0u && key[k] >= T) ? (1u << k) : 0u;
                        ((LAS unsigned char*)SELM)[q * 8 + seg] = (unsigned char)byte;
                    }
                    __syncthreads();
#pragma unroll
                    for (int i = 0; i < 16; ++i) { STASH[i * 64] = oacc[0][i]; STASH[(16 + i) * 64] = oacc[1][i]; }
                    { float own[8], oth[8]; const float* cs = ROPE64 + row * 16; u32x4 w = __builtin_bit_cast(u32x4, qf[0]); unpack8(w, own);
#pragma unroll
                      for (int jj = 0; jj < 8; ++jj) oth[jj] = __shfl_xor(own[jj], 32);
#pragma unroll
                      for (int jj = 0; jj < 8; ++jj) own[jj] = h ? own[jj] * cs[jj] + oth[jj] * cs[8 + jj] : own[jj] * cs[jj] - oth[jj] * cs[8 + jj];
                      qf[0] = __builtin_bit_cast(bf16x8, pack8f(own)); }
                    const att::LpOff lpo = att::lp_offsets(lane, wave, C_WP * 2);
                    {
                        const unsigned long long mymask = SELM[ql]; const unsigned long long un0 = SELM[lane];
                        unsigned ul = (unsigned)un0, uh = (unsigned)(un0 >> 32);
#pragma unroll
                        for (int o = 1; o < 64; o <<= 1) { ul |= __shfl_xor(ul, o); uh |= __shfl_xor(uh, o); }
                        const unsigned ulo = (unsigned)__builtin_amdgcn_readfirstlane((int)ul), uhi = (unsigned)__builtin_amdgcn_readfirstlane((int)uh);
                        const unsigned long long U = ((unsigned long long)uhi << 32) | ulo;
                        if (wave == 0 && ((U >> lane) & 1ull)) TL[__builtin_amdgcn_mbcnt_hi(uhi, __builtin_amdgcn_mbcnt_lo(ulo, 0u))] = lane;
                        f32x16 oo[2]; float ll = 0.f;
#pragma unroll
                        for (int i = 0; i < 16; ++i) { oo[0][i] = 0.f; oo[1][i] = 0.f; }
                        const bf16_t* kbase = RAW + (size_t)b * SEQ * C_WP + 1536 + g * 64;
                        __syncthreads();
{ auto go_ = [&](auto hs_) { constexpr bool HS = decltype(hs_)::value;
                        att::kv_pipeline_dma2<0>(lds, __builtin_popcountll(U), wave, lane, qf, lpo,
                            [&](int tt, const bf16_t*& kb, size_t& kp, const bf16_t*& vb, size_t& vp) { const int sblk = __builtin_amdgcn_readfirstlane(TL[tt]); kb = kbase + (size_t)(64 * sblk) * C_WP; kp = C_WP; vb = kb + 256; vp = C_WP; },
                            [&](int tt, f32x16 (&p)[2], const LAS unsigned char* buf, const LAS unsigned char* nbuf, f32x16 (&pn)[2], int) { const int sblk = __builtin_amdgcn_readfirstlane(TL[tt]);
                                const bool sel = (mymask >> sblk) & 1ull; const int lim = t - 64 * sblk - 4 * h;
                                if (sblk == qt) att::fused_e<1, HS, LP_NSA>(oo, ll, p, buf, lane, sel, shiftS, [&](int koff) { return koff <= lim; }, 0u, 0u, qf, nbuf, pn, lpo);
                                else att::fused_e<0, HS, LP_NSA>(oo, ll, p, buf, lane, sel, shiftS, [](int) { return true; }, 0u, 0u, qf, nbuf, pn, lpo); },
                            att::NoXtra());
 }; if (shiftS == 0.f) go_(std::false_type{}); else go_(std::true_type{}); }
                        const float lt = ll + __shfl_xor(ll, 32); const float f = lt > 0.f ? GT[row * 48 + hd * 3 + 1] / lt : 0.f;
#pragma unroll
                        for (int i = 0; i < 16; ++i) { STASH[i * 64] += oo[0][i] * f; STASH[(16 + i) * 64] += oo[1][i] * f; }
                    }
                    {
                        const int tw0 = qt >= 8 ? qt - 8 : 0, ntw = qt - tw0 + 1;
                        f32x16 oo[2]; float ll = 0.f;
#pragma unroll
                        for (int i = 0; i < 16; ++i) { oo[0][i] = 0.f; oo[1][i] = 0.f; }
                        const bf16_t* kbase = RAW + (size_t)b * SEQ * C_WP + 2048 + g * 64;
{ auto go_ = [&](auto hs_) { constexpr bool HS = decltype(hs_)::value;
                        att::kv_pipeline_dma2<0>(lds, ntw, wave, lane, qf, lpo,
                            [&](int tt, const bf16_t*& kb, size_t& kp, const bf16_t*& vb, size_t& vp) { kb = kbase + (size_t)(64 * (tw0 + tt)) * C_WP; kp = C_WP; vb = kb + 256; vp = C_WP; },
                            [&](int tt, f32x16 (&p)[2], const LAS unsigned char* buf, const LAS unsigned char* nbuf, f32x16 (&pn)[2], int) { const int tw = tw0 + tt; const int d0 = t - 64 * tw - 4 * h;
                                if (tw == qt || (qt >= 8 && tw == qt - 8)) att::fused_e<1, HS, LP_NSA>(oo, ll, p, buf, lane, true, shiftW, [&](int koff) { const int dist = d0 - koff; return dist >= 0 && dist < 512; }, 0u, 0u, qf, nbuf, pn, lpo);
                                else att::fused_e<0, HS, LP_NSA>(oo, ll, p, buf, lane, true, shiftW, [](int) { return true; }, 0u, 0u, qf, nbuf, pn, lpo); },
                            att::NoXtra());
 }; if (shiftW == 0.f) go_(std::false_type{}); else go_(std::true_type{}); }
                        const float lt = ll + __shfl_xor(ll, 32); const float f = lt > 0.f ? GT[row * 48 + hd * 3 + 2] / lt : 0.f;
#pragma unroll
                        for (int i = 0; i < 16; ++i) { oo[0][i] = STASH[i * 64] + oo[0][i] * f; oo[1][i] = STASH[(16 + i) * 64] + oo[1][i] * f; }
#if defined(PROBE_NSA)
                        if (rep_ == 0)
#endif
                        att::store_o_t<64>(oo, 1.0f, OATT + ((size_t)b * SEQ + qt * 64 + qs * 32) * 1024 + hd * 64, 1024, lds + wave * 4608, lane);
                    }
                    __syncthreads();
                }
            }
            SEAM(pb + 3);
        }
        if (RUN(pb + 4)) for (int rep_ = 0; rep_ < REPS(pb + 4); ++rep_) {
            int lane = (int)__builtin_amdgcn_mbcnt_hi(~0u, __builtin_amdgcn_mbcnt_lo(~0u, 0u)); asm volatile("" : "+v"(lane)); const int tid = wave * 64 + lane;
            if (L == 0) {
                pg8::Gemm g{OATT, W_ABO, MTOK, DM, DM}; pg8::StaticOrder S; S.init(MTOK, DM, G, bid);
                pg8::EpiResid<false> E{out, XB, RSQ};
                pg8::gemm_phase<pg8::EpiResid<false>, pg8::StaticOrder, true, true>(lds, g, S, E, wave);
            }
            if (L == 1) {
                pg8::Gemm g{OATT, W_CO, MTOK, DM, DM}; pg8::StaticOrder S; S.init(MTOK, DM, G, bid);
                pg8::EpiResid<false> E{out, XB, RSQ};
                pg8::gemm_phase<pg8::EpiResid<false>, pg8::StaticOrder, true, true>(lds, g, S, E, wave);
            }
            SEAM(pb + 4);
        }
        if (RUN(pb + 5)) for (int rep_ = 0; rep_ < REPS(pb + 5); ++rep_) {
            int lane = (int)__builtin_amdgcn_mbcnt_hi(~0u, __builtin_amdgcn_mbcnt_lo(~0u, 0u)); asm volatile("" : "+v"(lane)); const int tid = wave * 64 + lane;
            pg8::Gemm g{XB, W_MQ + (size_t)L * 512 * DM, MTOK, 512, DM}; pg8::StaticOrder S; S.init(MTOK, 512, G, bid);
            pg8::EpiPlain E{MQB, 512};
            pg8::gemm_phase<pg8::EpiPlain, pg8::StaticOrder, true, true>(lds, g, S, E, wave);
            SEAM(pb + 5);
        }
        if (RUN(pb + 6)) for (int rep_ = 0; rep_ < REPS(pb + 6); ++rep_) {
            int lane = (int)__builtin_amdgcn_mbcnt_hi(~0u, __builtin_amdgcn_mbcnt_lo(~0u, 0u)); asm volatile("" : "+v"(lane)); const int tid = wave * 64 + lane;
            const float shiftM = [&] { float gq = 0.f, gk = 0.f; for (int i = 0; i < 128; ++i) { gq = fmaxf(gq, fabsf(mem_q_norm[L * 128 + i])); gk = fmaxf(gk, fabsf(mem_k_norm[L * 128 + i])); }
                                       const float B = 11.3137085f * LOG2E * gq * gk * 1.02f; return B > 60.f ? B - 60.f : 0.f; }();
            const int upb = (512 % G == 0) ? 512 / G : 0; int cur_pair = -1;
            for (int k = 0; ; ++k) {
                const int u = upb ? bid * upb + k : bid + k * G; if ((upb && k >= upb) || u >= BATCH * 4 * 16) break;
                const int b = u >> 6, hh = (u >> 4) & 3, qb = u & 15;
                const int r = lane & 31, h = lane >> 5;
                const int row = b * SEQ + qb * 256 + wave * 32 + r;
                if ((u >> 4) != cur_pair) { cur_pair = u >> 4;
                    __syncthreads();
                    const bf16_t* kbase = KVRAW + (size_t)(b * NMEM) * 2048 + L * 1024 + hh * 128;
#pragma unroll
                    for (int i = 0; i < 8; ++i) { const int idx = tid + 512 * i, rw = idx >> 4, c = idx & 15;
                        *(LAS u32x4*)(lds + rw * 272 + c * 16) = *(const u32x4*)(kbase + (size_t)rw * 2048 + c * 8);
                        *(LAS u32x4*)(lds + 69632 + rw * 320 + c * 16) = *(const u32x4*)(kbase + (size_t)rw * 2048 + 512 + c * 8); }
                    __syncthreads(); }
                const float rs = row_rstd(RSQ, row);
                bf16x8 qf[8]; float ssq = 0.f;
                const bf16_t* qrow = MQB + (size_t)row * 512 + hh * 128 + 8 * h;
#pragma unroll
                for (int s2 = 0; s2 < 8; ++s2) { qf[s2] = *(const bf16x8*)(qrow + 16 * s2);
#pragma unroll
                    for (int j = 0; j < 8; ++j) { const float f = bf2f((unsigned short)qf[s2][j]) * rs; ssq += f * f; } }
                ssq += __shfl_xor(ssq, 32);
                const float qs = rs * __builtin_amdgcn_rsqf(ssq * (1.0f / 128.0f) + RMS_EPS) * (0.08838834764831845f * LOG2E);
#pragma unroll
                for (int s2 = 0; s2 < 8; ++s2) { const float* gn = mem_q_norm + L * 128 + 16 * s2 + 8 * h; const f32x4 ga = *(const f32x4*)gn, gb = *(const f32x4*)(gn + 4); u32x4 w;
#pragma unroll
                    for (int j = 0; j < 4; ++j) { const float g0_ = j < 2 ? ga[2 * j] : gb[2 * j - 4], g1_ = j < 2 ? ga[2 * j + 1] : gb[2 * j - 3];
                        w[j] = pk2(bf2f((unsigned short)qf[s2][2 * j]) * qs * g0_, bf2f((unsigned short)qf[s2][2 * j + 1]) * qs * g1_); }
                    qf[s2] = __builtin_bit_cast(bf16x8, w); }
                f32x16 oo[4]; float ll = 0.f;
#pragma unroll
                for (int d = 0; d < 4; ++d)
#pragma unroll
                    for (int i = 0; i < 16; ++i) oo[d][i] = 0.f;
#pragma unroll 1
                for (int tt = 0; tt < 4; ++tt) {
                    f32x16 p[2]; att::tile_scores<128>(p, qf, lds + tt * 64 * 272, lane);
                    float ls = 0.f;
#pragma unroll
                    for (int kt = 0; kt < 2; ++kt)
#pragma unroll
                        for (int i = 0; i < 16; ++i) { const float e = __builtin_amdgcn_exp2f(p[kt][i] - shiftM); p[kt][i] = e; ls += e; }
                    ll += ls;
                    att::tile_pv<128>(oo, p, lds + 69632 + tt * 64 * 320 - att::Geo<128>::KB, lane); }
                const float lt = ll + __shfl_xor(ll, 32);
                att::store_o<128>(oo, 1.0f / lt, OMEM + (size_t)row * 512 + hh * 128, lane);
            }
            SEAM(pb + 6);
        }
        if (RUN(pb + 7)) for (int rep_ = 0; rep_ < REPS(pb + 7); ++rep_) {
            int lane = (int)__builtin_amdgcn_mbcnt_hi(~0u, __builtin_amdgcn_mbcnt_lo(~0u, 0u)); asm volatile("" : "+v"(lane)); const int tid = wave * 64 + lane;
            pg8::Gemm g{OMEM, W_MO + (size_t)L * DM * 512, MTOK, DM, 512}; pg8::StaticOrder S; S.init(MTOK, DM, G, bid);
            pg8::EpiResid<false> E{out, XB, RSQ};
            pg8::gemm_phase<pg8::EpiResid<false>, pg8::StaticOrder, true, true>(lds, g, S, E, wave);
            SEAM(pb + 7);
        }
        if (RUN(pb + 8)) for (int rep_ = 0; rep_ < REPS(pb + 8); ++rep_) {
            int lane = (int)__builtin_amdgcn_mbcnt_hi(~0u, __builtin_amdgcn_mbcnt_lo(~0u, 0u)); asm volatile("" : "+v"(lane)); const int tid = wave * 64 + lane;
            pg8::Gemm g{XB, W_FI + (size_t)L * 5632 * DM, MTOK, 5632, DM}; pg8::StaticOrder S; S.init(MTOK, 5632, G, bid);
            pg8::EpiSwiGLU E{RSQ, HID};
            pg8::gemm_phase<pg8::EpiSwiGLU, pg8::StaticOrder, true, true>(lds, g, S, E, wave);
#ifdef PROBE_DUP_FFN
            if (L == 0) { __syncthreads(); pg8::gemm_phase<pg8::EpiSwiGLU, pg8::StaticOrder, true, true>(lds, g, S, E, wave); }
#endif
            SEAM(pb + 8);
        }
        if (RUN(pb + 9)) for (int rep_ = 0; rep_ < REPS(pb + 9); ++rep_) {
            int lane = (int)__builtin_amdgcn_mbcnt_hi(~0u, __builtin_amdgcn_mbcnt_lo(~0u, 0u)); asm volatile("" : "+v"(lane)); const int tid = wave * 64 + lane;
            pg8::Gemm g{HID, W_FO + (size_t)L * DM * DFF, MTOK, DM, DFF}; pg8::StaticOrder S; S.init(MTOK, DM, G, bid);
            if (L == 0) { pg8::EpiResid<false> E{out, XB, RSQ}; pg8::gemm_phase<pg8::EpiResid<false>, pg8::StaticOrder, true, true>(lds, g, S, E, wave); }
            else { pg8::EpiResid<true> E{out, XB, RSQ}; pg8::gemm_phase<pg8::EpiResid<true>, pg8::StaticOrder, true, true>(lds, g, S, E, wave); }
            SEAM(pb + 9);
        }
}

__global__ void __launch_bounds__(NWAVES * 64, 2) fwd_kernel(Args args) {
    extern __shared__ __attribute__((aligned(16))) unsigned char lds_raw[];
    LAS unsigned char* lds = (LAS unsigned char*)(unsigned)__builtin_amdgcn_readfirstlane((int)(unsigned)(size_t)(LAS unsigned char*)lds_raw);
    volatile LAS unsigned* MISC = (volatile LAS unsigned*)(lds + LDS_MISC);
    const int tid = threadIdx.x, lane = tid & 63, wave = __builtin_amdgcn_readfirstlane(tid >> 6);
    const int G = gridDim.x, bid = blockIdx.x;
    unsigned* ctl = (unsigned*)(args.ws + WS_CTL);
    for (int u = tid; u < (LDS_BYTES - LDS_MISC) / 4; u += NWAVES * 64) ((LAS unsigned*)(lds + LDS_MISC))[u] = 0u;
    __syncthreads();
    XcdBarrier bar = xcd_barrier_post(ctl + CW_BAR + args.li * XCD_BAR_WORDS, MISC + 8);
    const int lo = args.ph_lo, hi = args.ph_hi;

    if (RUN(0)) for (int rep_ = 0; rep_ < REPS(0); ++rep_) {
        LAS float* scr = (LAS float*)(lds + wave * 16384);
        const int gw = bid * NWAVES + wave, NGW = G * NWAVES;
        constexpr int I_AB = 16 * (AB_WP / 32), I_C = 16 * (C_WP / 32), I_O = 16 * 32, I_MQ = 16 * 16, I_KV = 16 * 32, I_MO = 8 * 32, I_FI = 16 * (5632 / 32), I_FO = (DFF / 64) * 32;
        constexpr int NITEMS = I_AB + I_C + 2 * I_O + 2 * I_MQ + 2 * I_KV + 2 * I_MO + 2 * I_FI + 2 * I_FO;
        for (int it = gw; it < NITEMS; it += NGW) {
            int r = it;
            if (r < I_AB) { const int nbn = AB_WP / 32; transpose_item(ab_w_in, DM, AB_W, W_AB, norm_mix, scr, r / nbn, r % nbn, lane, CMapProj0{}); continue; } r -= I_AB;
            if (r < I_C) { const int nbn = C_WP / 32; transpose_item(nsa_w_in, DM, C_W, W_C, norm_mix + DM, scr, r / nbn, r % nbn, lane, CMapProj1{}); continue; } r -= I_C;
            if (r < I_O) { transpose_item(ab_w_out, DM, DM, W_ABO, nullptr, scr, r / 32, r % 32, lane, CMapId{DM}); continue; } r -= I_O;
            if (r < I_O) { transpose_item(nsa_w_out, DM, DM, W_CO, nullptr, scr, r / 32, r % 32, lane, CMapId{DM}); continue; } r -= I_O;
            if (r < 2 * I_MQ) { const int L = r / I_MQ; r %= I_MQ; transpose_item(mem_w_q + (size_t)L * DM * 512, DM, 512, W_MQ + (size_t)L * 512 * DM, norm_mem + L * DM, scr, r / 16, r % 16, lane, CMapId{512}); continue; } r -= 2 * I_MQ;
            if (r < 2 * I_KV) { const int L = r / I_KV; r %= I_KV; transpose_item(mem_w_kv + (size_t)L * DM * 1024, DM, 1024, W_KV + (size_t)L * 1024 * DM, norm_mem_src + L * DM, scr, r / 32, r % 32, lane, CMapId{1024}); continue; } r -= 2 * I_KV;
            if (r < 2 * I_MO) { const int L = r / I_MO; r %= I_MO; transpose_item(mem_w_o + (size_t)L * 512 * DM, 512, DM, W_MO + (size_t)L * DM * 512, nullptr, scr, r / 32, r % 32, lane, CMapId{DM}); continue; } r -= 2 * I_MO;
            if (r < 2 * I_FI) { const int L = r / I_FI; r %= I_FI; const int nbn = 5632 / 32; transpose_item(ffn_w_in + (size_t)L * DM * 5632, DM, 5632, W_FI + (size_t)L * 5632 * DM, norm_ffn + L * DM, scr, r / nbn, r % nbn, lane, CMapFfn{}); continue; } r -= 2 * I_FI;
            { const int L = r / I_FO; r %= I_FO; transpose_item(ffn_w_out + (size_t)L * DFF * DM, DFF, DM, W_FO + (size_t)L * DM * DFF, nullptr, scr, r / 32, r % 32, lane, CMapId{DM}); }
        }
        for (int m = gw; m < MTOK; m += 4 * NGW) {
            int mr[4]; f32x4 v[4][4]; float sq[4];
#pragma unroll
            for (int q = 0; q < 4; ++q) { mr[q] = m + q * NGW < MTOK ? m + q * NGW : m; const f32x4* xr = (const f32x4*)(x_in + (size_t)mr[q] * DM) + lane;
#pragma unroll
                for (int j = 0; j < 4; ++j) v[q][j] = xr[64 * j]; }
#pragma unroll
            for (int q = 0; q < 4; ++q) { float a = 0.f;
#pragma unroll
                for (int j = 0; j < 4; ++j) a += (v[q][j][0] * v[q][j][0] + v[q][j][1] * v[q][j][1]) + (v[q][j][2] * v[q][j][2] + v[q][j][3] * v[q][j][3]);
                sq[q] = a; }
#pragma unroll
            for (int o = 1; o < 64; o <<= 1) {
#pragma unroll
                for (int q = 0; q < 4; ++q) sq[q] += __shfl_xor(sq[q], o); }
#pragma unroll
            for (int q = 0; q < 4; ++q) { u32x2* xbr = (u32x2*)(XB + (size_t)mr[q] * DM) + lane;
#pragma unroll
                for (int j = 0; j < 4; ++j) { u32x2 w; w.x = pk2(v[q][j][0], v[q][j][1]); w.y = pk2(v[q][j][2], v[q][j][3]); xbr[64 * j] = w; }
                if (lane < 16) RSQ[(size_t)mr[q] * 16 + lane] = (lane == 0) ? sq[q] : 0.f; }
        }
        for (int i = bid * 512 + tid; i < MTOK * 12; i += G * 512) {
            const int m = i / 12, k = i % 12;
            const float f64t[8] = {1.0f, 0.19392274474868576f, 0.03760603093086393f, 0.007292664737217109f, 0.001414213562373095f, 0.0002742481756762073f, 5.318295896944988e-05f, 1.031338537721246e-05f};
            float fr;
            if (k < 8) fr = f64t[k]; else { const int q = k - 8; fr = (q == 0) ? 1.0f : (q == 1) ? 0.03760603093086393f : (q == 2) ? 0.001414213562373095f : 5.318295896944988e-05f; }
            const float ang = (float)positions[m] * fr;
            const double rev = (double)ang * 0.15915494309189535; const float frac = (float)(rev - __builtin_rint(rev));
            const float c = __builtin_amdgcn_cosf(frac), sn = __builtin_amdgcn_sinf(frac);
            if (k < 8) { ROPE64[(size_t)m * 16 + k] = c; ROPE64[(size_t)m * 16 + 8 + k] = sn; } else { ROPE32[(size_t)m * 8 + (k - 8)] = c; ROPE32[(size_t)m * 8 + 4 + (k - 8)] = sn; }
        }
        for (int it = gw; it < 128; it += NGW) { const int kv = it >> 6, r = it & 63;
            transpose_item(kv ? nsa_cmp_w1_v : nsa_cmp_w1_k, 2048, 64, W1T + (size_t)kv * 64 * 2048, nullptr, scr, r >> 1, r & 1, lane, CMapId{64}); }
        for (int it = (NGW - 1 - gw); it < 128; it += NGW) { const int kv = it >> 6, c = it & 63; const float* pe = kv ? nsa_cmp_pos_v : nsa_cmp_pos_k; const float* w1 = kv ? nsa_cmp_w1_v : nsa_cmp_w1_k;
            float a = 0.f;
            for (int k0 = 0; k0 < 2048; k0 += 512) { float pv[8], wv[8];
#pragma unroll
                for (int j = 0; j < 8; ++j) { const int k = k0 + 64 * j + lane; pv[j] = pe[k]; wv[j] = w1[(size_t)k * 64 + c]; }
#pragma unroll
                for (int j = 0; j < 8; ++j) a += pv[j] * wv[j]; }
            a = wave_sum(a); if (lane == 0) POSW1[kv * 64 + c] = a; }
        for (int m = gw; m < MMEM; m += NGW) {
            const f32x4* xr = (const f32x4*)(mem_in + (size_t)m * DM) + lane; f32x4 v[4]; float s = 0.f;
#pragma unroll
            for (int j = 0; j < 4; ++j) { v[j] = xr[64 * j]; s += (v[j][0] * v[j][0] + v[j][1] * v[j][1]) + (v[j][2] * v[j][2] + v[j][3] * v[j][3]); }
            s = wave_sum(s);
            u32x2* xbr = (u32x2*)(MEMB + (size_t)m * DM) + lane;
#pragma unroll
            for (int j = 0; j < 4; ++j) { u32x2 w; w.x = pk2(v[j][0], v[j][1]); w.y = pk2(v[j][2], v[j][3]); xbr[64 * j] = w; }
            if (lane == 0) MRS[m] = __builtin_amdgcn_rsqf(s * (1.0f / 1024.0f) + RMS_EPS);
        }
        SEAM(0);
    }

    layer_phases<0>(args, lds, bar, lo, hi, wave);
    layer_phases<1>(args, lds, bar, lo, hi, wave);
#undef RUN
#undef SEAM
}
#undef INF_
#undef x_in
#undef mem_in
#undef positions
#undef norm_mix
#undef norm_mem
#undef norm_mem_src
#undef norm_ffn
#undef ab_w_in
#undef ab_w_out
#undef nsa_w_in
#undef nsa_w_out
#undef mem_w_q
#undef mem_w_kv
#undef mem_w_o
#undef ffn_w_in
#undef ffn_w_out
#undef out
#undef WSB
#undef W_AB
#undef W_C
#undef W_ABO
#undef W_CO
#undef W_MQ
#undef W_KV
#undef W_MO
#undef W_FI
#undef W_FO
#undef XB
#undef RSQ
#undef HID
#undef MEMB
#undef KVRAW
#undef MRS
#undef MQB
#undef OMEM
#undef mem_q_norm
#undef RAW
#undef OATT
#undef ROPE64
#undef ROPE32
#undef W1T
#undef POSW1
#undef KCMP
#undef VCMP
#undef GT
#undef nsa_q_norm
#undef SCR
#undef BMK
#undef KMEAN
#undef IWB
#undef dsa_q_norm
#undef dsa_k_norm
#undef moba_q_norm
#undef moba_k_norm
#undef nsa_kcmp_norm
#undef nsa_ksel_norm
#undef nsa_kwin_norm
#undef nsa_cmp_pos_k
#undef nsa_cmp_pos_v
#undef nsa_cmp_w1_k
#undef nsa_cmp_w2_k
#undef nsa_cmp_w1_v
#undef nsa_cmp_w2_v
#undef mem_k_norm

extern "C" void kernel_launch(void* const* d_in, const int* in_sizes, int n_in, void* d_out, int out_size, void* d_ws, size_t ws_size, hipStream_t stream) {
    static int grid = 0;
    if (grid == 0) {
        if (n_in != 32 || out_size != MTOK * DM || ws_size < WS_END) { fprintf(stderr, "kernel_launch: unexpected shapes (n_in %d out %d ws %zu)\n", n_in, out_size, ws_size); grid = -1; return; }
        int dev = 0, cus = 0, per_cu = 0;
        if (hipGetDevice(&dev) != hipSuccess || hipDeviceGetAttribute(&cus, hipDeviceAttributeMultiprocessorCount, dev) != hipSuccess) { grid = -1; return; }
        if (hipFuncSetAttribute((const void*)fwd_kernel, hipFuncAttributeMaxDynamicSharedMemorySize, LDS_BYTES) != hipSuccess) { fprintf(stderr, "kernel_launch: hipFuncSetAttribute failed\n"); grid = -1; return; }
        if (hipOccupancyMaxActiveBlocksPerMultiprocessor(&per_cu, (const void*)fwd_kernel, NWAVES * 64, LDS_BYTES) != hipSuccess || per_cu < 1) fprintf(stderr, "kernel_launch: occupancy query says %d\n", per_cu);
        (void)hipGetLastError();
        grid = cus;
    }
    if (grid < 0) return;
    if (hipMemsetAsync((char*)d_ws + WS_CTL, 0, CTL_ZERO_BYTES, stream) != hipSuccess) return;
    Args a{};
    for (int i = 0; i < 32; ++i) a.in[i] = d_in[i];
    a.out = (float*)d_out; a.ws = (unsigned char*)d_ws; a.pad = 0;
    const int NPH = 21;
#if 0
    for (int p = 0; p < NPH; ++p) { a.ph_lo = p; a.ph_hi = p + 1; a.li = 0; hipLaunchKernelGGL(fwd_kernel, dim3(grid), dim3(NWAVES * 64), LDS_BYTES, stream, a); }
#else
    a.ph_lo = 0; a.ph_hi = NPH; a.li = 0; hipLaunchKernelGGL(fwd_kernel, dim3(grid), dim3(NWAVES * 64), LDS_BYTES, stream, a);
#endif
}
```

```cpp
#include <hip/hip_runtime.h>
#include <cstdio>
#include <cstdint>
#include <type_traits>

#define LAS __attribute__((address_space(3)))
#define GAS __attribute__((address_space(1)))
typedef unsigned short bf16_t;
typedef short bf16x8 __attribute__((ext_vector_type(8)));
typedef short s16x4 __attribute__((ext_vector_type(4)));
typedef float f32x4 __attribute__((ext_vector_type(4)));
typedef float f32x2 __attribute__((ext_vector_type(2)));
typedef float f32x16 __attribute__((ext_vector_type(16)));
typedef unsigned u32x4 __attribute__((ext_vector_type(4)));
typedef unsigned u32x2 __attribute__((ext_vector_type(2)));
typedef __bf16 bf16x2_t __attribute__((ext_vector_type(2)));

constexpr int BATCH = 8, SEQ = 4096, DM = 1024, MTOK = BATCH * SEQ;
constexpr int NMEM = 256, MMEM = BATCH * NMEM;
constexpr int DFF = 2816;
constexpr int AB_W = 2472, AB_WP = 2560;
constexpr int C_W = 2608, C_WP = 2816;
constexpr float RMS_EPS = 1e-6f;
constexpr float LOG2E = 1.4426950408889634f;

namespace pg8 {
constexpr int BM = 256, BK = 64, HALF = 128, HTB = HALF * BK * 2, STAGE_BYTES = 8 * HTB, NXCD = 8, WGM = 4;
__host__ __device__ __forceinline__ int lds_byte(int r, int c) { const int st = (r >> 4) * 2 + (c >> 5), rr = r & 15, cc = c & 31, ob = rr * 64 + cc * 2; return st * 1024 + (ob ^ (((ob >> 9) & 1) << 5)); }
__host__ __device__ __forceinline__ void stage_rc(int b, int& R, int& C) { const int st = b / 1024, sb = b % 1024, swz = sb ^ (((sb >> 9) & 1) << 5); R = (st >> 1) * 16 + swz / 64; C = (st & 1) * 32 + (swz % 64) / 2; }
__host__ __device__ __forceinline__ int perm32(int rho) { const int n = rho >> 4, i = rho & 15; return 8 * (i >> 2) + 4 * n + (i & 3); }
struct Unit { int pm, pn; };
struct Gemm { const bf16_t* A; const bf16_t* Bt; int M, N, K; };
struct StaticOrder {
    int nM, nN, nwg, G, c;
    __host__ __device__ void init(int M, int N, int G_, int c_) { nM = M / BM; nN = N / BM; nwg = nM * nN; G = G_; c = c_; }
    __host__ __device__ bool next(int i, Unit& u) const {
        const long L = (long)i * G + c; if (L >= nwg) return false;
        int wgid = (int)L; { const int q = nwg / NXCD, r = nwg % NXCD, xcd = wgid % NXCD, off = wgid / NXCD; wgid = (xcd < r ? xcd * (q + 1) : r * (q + 1) + (xcd - r) * q) + off; }
        const int nig = WGM * nN, gid = wgid / nig, fm = gid * WGM, gsz = (nM - fm) < WGM ? (nM - fm) : WGM;
        u.pm = fm + ((wgid % nig) % gsz); u.pn = (wgid % nig) / gsz; return true;
    }
    __device__ __forceinline__ void a_ready(const Unit&) const {}
    __device__ __forceinline__ void done(const Unit&) const {}
};
__device__ __forceinline__ unsigned cvt_pk_bf16(float lo, float hi) { unsigned r; asm volatile("v_cvt_pk_bf16_f32 %0, %1, %2" : "=v"(r) : "v"(lo), "v"(hi)); return r; }

struct EpiPlain {
    static constexpr bool PERM = true, AFTER_DRAIN = false, STAGE = false;
    bf16_t* O; int ldc;
    __device__ __forceinline__ void operator()(const f32x4 (&acc)[2][2][4][2], const Unit& u, int wr, int wc, int fr, int fq) const {
        const int row0 = u.pm * BM + wr * 64 + fr, col0 = u.pn * BM + wc * 32 + 8 * fq;
#pragma unroll
        for (int ai = 0; ai < 2; ++ai)
#pragma unroll
            for (int m = 0; m < 4; ++m) { bf16_t* rowp = O + (size_t)(row0 + ai * HALF + m * 16) * ldc + col0;
#pragma unroll
                for (int bj = 0; bj < 2; ++bj) { const f32x4 v0 = acc[ai][bj][m][0], v1 = acc[ai][bj][m][1];
                    u32x4 w; w.x = cvt_pk_bf16(v0[0], v0[1]); w.y = cvt_pk_bf16(v0[2], v0[3]); w.z = cvt_pk_bf16(v1[0], v1[1]); w.w = cvt_pk_bf16(v1[2], v1[3]);
                    *(u32x4*)(rowp + bj * HALF) = w; } }
    }
};
template <bool FINAL> struct EpiResid {
    static constexpr bool PERM = true, AFTER_DRAIN = false, STAGE = false;
    float* out; bf16_t* xb; float* rsq;
    __device__ __forceinline__ void operator()(const f32x4 (&acc)[2][2][4][2], const Unit& u, int wr, int wc, int fr, int fq) const {
        const int col0 = u.pn * BM + wc * 32 + 8 * fq;
#pragma unroll
        for (int ai = 0; ai < 2; ++ai) {
            u32x4 rb[4][2];
#pragma unroll
            for (int m = 0; m < 4; ++m)
#pragma unroll
                for (int bj = 0; bj < 2; ++bj) rb[m][bj] = *(const u32x4*)(xb + (size_t)(u.pm * BM + ai * HALF + wr * 64 + m * 16 + fr) * 1024 + col0 + bj * HALF);
#pragma unroll
            for (int m = 0; m < 4; ++m) { const int row = u.pm * BM + ai * HALF + wr * 64 + m * 16 + fr; const size_t off = (size_t)row * 1024 + col0; float ss = 0.f;
#pragma unroll
                for (int bj = 0; bj < 2; ++bj) { const size_t o = off + bj * HALF; const u32x4 r4 = rb[m][bj]; float v[8];
#pragma unroll
                    for (int k = 0; k < 4; ++k) { v[2 * k] = acc[ai][bj][m][k >> 1][(2 * k) & 3] + __builtin_bit_cast(float, r4[k] << 16); v[2 * k + 1] = acc[ai][bj][m][k >> 1][(2 * k + 1) & 3] + __builtin_bit_cast(float, r4[k] & 0xffff0000u); }
                    if (FINAL) { *(f32x4*)(out + o) = (f32x4){v[0], v[1], v[2], v[3]}; *(f32x4*)(out + o + 4) = (f32x4){v[4], v[5], v[6], v[7]}; }
                    else { u32x4 w; w.x = cvt_pk_bf16(v[0], v[1]); w.y = cvt_pk_bf16(v[2], v[3]); w.z = cvt_pk_bf16(v[4], v[5]); w.w = cvt_pk_bf16(v[6], v[7]); *(u32x4*)(xb + o) = w;
#pragma unroll
                        for (int k = 0; k < 4; ++k) { const float r0 = __builtin_bit_cast(float, w[k] << 16), r1 = __builtin_bit_cast(float, w[k] & 0xffff0000u); ss += r0 * r0 + r1 * r1; } } }
                if (!FINAL) { ss += __shfl_xor(ss, 16); ss += __shfl_xor(ss, 32);
                    if (fq == 0) rsq[(size_t)row * 16 + u.pn * 4 + wc] = ss; } }
            asm volatile("" ::: "memory");
        }
    }
};
struct EpiSwiGLU {
    static constexpr bool PERM = true, AFTER_DRAIN = false, STAGE = false;
    const float* rsq; bf16_t* hid;
    __device__ __forceinline__ void operator()(const f32x4 (&acc)[2][2][4][2], const Unit& u, int wr, int wc, int fr, int fq) const {
        const int col0 = u.pn * 128 + wc * 32 + 8 * fq;
        f32x4 pr[2][4];
#pragma unroll
        for (int ai = 0; ai < 2; ++ai)
#pragma unroll
            for (int m = 0; m < 4; ++m) pr[ai][m] = *(const f32x4*)(rsq + (size_t)(u.pm * BM + ai * HALF + wr * 64 + m * 16 + fr) * 16 + 4 * fq);
#pragma unroll
        for (int ai = 0; ai < 2; ++ai)
#pragma unroll
            for (int m = 0; m < 4; ++m) { const int row = u.pm * BM + ai * HALF + wr * 64 + m * 16 + fr;
                float ss = (pr[ai][m][0] + pr[ai][m][1]) + (pr[ai][m][2] + pr[ai][m][3]);
                ss += __shfl_xor(ss, 16); ss += __shfl_xor(ss, 32);
                const float c = __builtin_amdgcn_rsqf(ss * (1.0f / 1024.0f) + RMS_EPS);
                float h[8];
#pragma unroll
                for (int n = 0; n < 2; ++n)
#pragma unroll
                    for (int e = 0; e < 4; ++e) { const float g = acc[ai][0][m][n][e] * c, uu = acc[ai][1][m][n][e] * c;
                        const float sg = g * __builtin_amdgcn_rcpf(1.0f + __builtin_amdgcn_exp2f(-g * LOG2E)); h[n * 4 + e] = sg * uu; }
                u32x4 w; w.x = cvt_pk_bf16(h[0], h[1]); w.y = cvt_pk_bf16(h[2], h[3]); w.z = cvt_pk_bf16(h[4], h[5]); w.w = cvt_pk_bf16(h[6], h[7]);
                *(u32x4*)(hid + (size_t)row * DFF + col0) = w; }
    }
};

struct ProjUnit { int kind; const float* gain; float scale; bool rope; };
template <int L> struct EpiProj {
    static constexpr bool PERM = true, AFTER_DRAIN = false, STAGE = true;
    bf16_t* O; int ldc; const float* rsq; const float* rope64; const float* rope32; const float* g0; const float* g1; const float* g2; const float* g3; float* aux; LAS unsigned char* ldsb;
    static constexpr int ROPE_STG = STAGE_BYTES;
    __device__ __forceinline__ void stage(const Unit& u, int wid, int lane) const {
        int ln = (int)__builtin_amdgcn_mbcnt_hi(~0u, __builtin_amdgcn_mbcnt_lo(~0u, 0u)); asm volatile("" : "+v"(ln));
        const float* src = rope64 + ((size_t)u.pm * BM + 32 * wid) * 16 + ln * 4;
        __builtin_amdgcn_global_load_lds((const unsigned*)src, (LAS unsigned*)(ldsb + ROPE_STG + wid * 2048), 16, 0, 0);
        __builtin_amdgcn_global_load_lds((const unsigned*)(src + 256), (LAS unsigned*)(ldsb + ROPE_STG + wid * 2048 + 1024), 16, 0, 0);
    }
    __device__ __forceinline__ ProjUnit classify(int unit) const {
        constexpr float C2 = 0.125f * LOG2E;
        if (L == 0) {
            if (unit < 8) return {1, g0, C2, true}; if (unit == 8) return {1, g1, 1.f, true}; if (unit == 9) return {2, nullptr, 1.f, false};
            if (unit < 14) return {4, nullptr, 1.f, false}; if (unit == 14) return {5, nullptr, 1.f, false};
            if (unit < 23) return {1, g2, C2, true}; if (unit < 31) return {1, g3, 1.f, true}; if (unit < 39) return {2, nullptr, 1.f, false}; return {0, nullptr, 1.f, false};
        } else {
            if (unit < 16) return {1, g0, C2, false}; if (unit < 24) return {3, nullptr, 1.f, false};
            if (unit < 28) return {1, g1, 1.f, true}; if (unit < 32) return {2, nullptr, 1.f, false}; if (unit < 36) return {1, g2, 1.f, true}; if (unit < 40) return {2, nullptr, 1.f, false};
            if (unit == 40) return {6, nullptr, 1.f, false}; return {0, nullptr, 1.f, false};
        }
    }
    __device__ __forceinline__ void operator()(const f32x4 (&acc)[2][2][4][2], const Unit& u, int wr, int wc, int fr, int fq) const {
        const int unit = 4 * u.pn + wc; const ProjUnit pu = classify(unit);
        if (pu.kind == 0) return;
        const unsigned ropeb = (unsigned)(size_t)(ldsb + ROPE_STG) + (unsigned)(wr * 64 + fr) * 64u;
        float gl[2][8];
        if (pu.kind == 1) {
#pragma unroll
            for (int bj = 0; bj < 2; ++bj) { const f32x4 a = *(const f32x4*)(pu.gain + 8 * (2 * fq + bj)), b = *(const f32x4*)(pu.gain + 8 * (2 * fq + bj) + 4);
#pragma unroll
                for (int x = 0; x < 4; ++x) { gl[bj][x] = a[x] * pu.scale; gl[bj][4 + x] = b[x] * pu.scale; } }
        }
        float rsv[2][4];
        if (pu.kind != 3) { f32x4 pr[2][4];
#pragma unroll
            for (int ai = 0; ai < 2; ++ai)
#pragma unroll
                for (int m = 0; m < 4; ++m) pr[ai][m] = *(const f32x4*)(rsq + (size_t)(u.pm * BM + ai * HALF + wr * 64 + m * 16 + fr) * 16 + 4 * fq);
#pragma unroll
            for (int ai = 0; ai < 2; ++ai)
#pragma unroll
                for (int m = 0; m < 4; ++m) { float ss = (pr[ai][m][0] + pr[ai][m][1]) + (pr[ai][m][2] + pr[ai][m][3]); ss += __shfl_xor(ss, 16); ss += __shfl_xor(ss, 32);
                    rsv[ai][m] = __builtin_amdgcn_rsqf(ss * (1.0f / 1024.0f) + RMS_EPS); } }
        else {
#pragma unroll
            for (int ai = 0; ai < 2; ++ai)
#pragma unroll
                for (int m = 0; m < 4; ++m) rsv[ai][m] = 1.f; }
#pragma unroll
        for (int ai = 0; ai < 2; ++ai)
#pragma unroll
            for (int m = 0; m < 4; ++m) { const int row = u.pm * BM + ai * HALF + wr * 64 + m * 16 + fr;
                const float rs = rsv[ai][m];
                float v[2][8];
#pragma unroll
                for (int bj = 0; bj < 2; ++bj)
#pragma unroll
                    for (int e = 0; e < 8; ++e) v[bj][e] = acc[ai][bj][m][e >> 2][e & 3] * rs;
                if (pu.kind == 1) {
                    float ss = 0.f;
#pragma unroll
                    for (int bj = 0; bj < 2; ++bj)
#pragma unroll
                        for (int e = 0; e < 8; ++e) ss += v[bj][e] * v[bj][e];
                    ss += __shfl_xor(ss, 16); ss += __shfl_xor(ss, 32);
                    const float rn = __builtin_amdgcn_rsqf(ss * (1.0f / 64.0f) + RMS_EPS);
#pragma unroll
                    for (int bj = 0; bj < 2; ++bj)
#pragma unroll
                        for (int e = 0; e < 8; ++e) v[bj][e] = v[bj][e] * rn * gl[bj][e];
                    if (pu.rope && fq == 0) {
                        const LAS float* cs = (const LAS float*)(size_t)(ropeb + (ai * HALF + m * 16) * 64); const f32x4 c0 = *(const LAS f32x4*)cs, c1 = *(const LAS f32x4*)(cs + 4), s0 = *(const LAS f32x4*)(cs + 8), s1 = *(const LAS f32x4*)(cs + 12);
#pragma unroll
                        for (int e = 0; e < 8; ++e) { const float c = e < 4 ? c0[e & 3] : c1[e & 3], sn = e < 4 ? s0[e & 3] : s1[e & 3]; const float x1 = v[0][e], x2 = v[1][e];
                            v[0][e] = x1 * c - x2 * sn; v[1][e] = x2 * c + x1 * sn; }
                    }
                }
                if (pu.kind == 4 || pu.kind == 5) {
                    if (fq == 0 || (fq == 2 && pu.kind == 4)) { const LAS float* cs = (const LAS float*)(size_t)(ropeb + (ai * HALF + m * 16) * 64);
                        const f32x4 ca = *(const LAS f32x4*)cs, cb = *(const LAS f32x4*)(cs + 4), sa = *(const LAS f32x4*)(cs + 8), sb = *(const LAS f32x4*)(cs + 12);
                        const f32x4 c = {ca[0], ca[2], cb[0], cb[2]}, sn = {sa[0], sa[2], sb[0], sb[2]};
#pragma unroll
                        for (int x = 0; x < 4; ++x) { const float a = v[0][x], b = v[0][4 + x]; v[0][x] = a * c[x] - b * sn[x]; v[0][4 + x] = b * c[x] + a * sn[x]; } }
                    if (pu.kind == 5 && fq == 2) { *(f32x4*)(aux + (size_t)row * 8) = (f32x4){v[0][0], v[0][1], v[0][2], v[0][3]}; *(f32x4*)(aux + (size_t)row * 8 + 4) = (f32x4){v[0][4], v[0][5], v[0][6], v[0][7]}; }
                }
                if (pu.kind == 6) {
#pragma unroll
                    for (int bj = 0; bj < 2; ++bj) if (2 * fq + bj < 6) {
#pragma unroll
                        for (int e = 0; e < 8; ++e) v[bj][e] = __builtin_amdgcn_rcpf(1.0f + __builtin_amdgcn_exp2f(-v[bj][e] * LOG2E));
                        float* ap = aux + (size_t)row * 48 + 8 * (2 * fq + bj);
                        *(f32x4*)ap = (f32x4){v[bj][0], v[bj][1], v[bj][2], v[bj][3]}; *(f32x4*)(ap + 4) = (f32x4){v[bj][4], v[bj][5], v[bj][6], v[bj][7]}; }
                } else {
                    bf16_t* orow = O + (size_t)row * ldc + 64 * unit + 16 * fq;
                    u32x4 w0, w1;
                    w0.x = cvt_pk_bf16(v[0][0], v[0][1]); w0.y = cvt_pk_bf16(v[0][2], v[0][3]); w0.z = cvt_pk_bf16(v[0][4], v[0][5]); w0.w = cvt_pk_bf16(v[0][6], v[0][7]);
                    w1.x = cvt_pk_bf16(v[1][0], v[1][1]); w1.y = cvt_pk_bf16(v[1][2], v[1][3]); w1.z = cvt_pk_bf16(v[1][4], v[1][5]); w1.w = cvt_pk_bf16(v[1][6], v[1][7]);
                    *(u32x4*)orow = w0; *(u32x4*)(orow + 8) = w1;
                }
                if (m & 1) asm volatile("" ::: "memory"); }
    }
};

template <class Epi, class Sched, bool ALIGN_EPI = false, bool SP2 = false>
__device__ __forceinline__ void gemm_phase(LAS unsigned char* lds, const Gemm g, const Sched& S, const Epi& E, const int wave_id) {
    int tid = wave_id * 64 + (int)__builtin_amdgcn_mbcnt_hi(~0u, __builtin_amdgcn_mbcnt_lo(~0u, 0u)); asm volatile("" : "+v"(tid));
    const int wid = wave_id, lane = tid & 63, wr = wid >> 2, wc = wid & 3, fr = lane & 15, fq = lane >> 4;
    const int K = g.K, nt = K / BK;
    unsigned voffA[2], voffB[2];
#pragma unroll
    for (int i = 0; i < 2; ++i) { int R, C; stage_rc(tid * 16 + i * 8192, R, C); const int Rb = Epi::PERM ? ((R & ~31) + perm32(R & 31)) : R;
        voffA[i] = (unsigned)(R * K + C) * 2u; voffB[i] = (unsigned)(Rb * K + C) * 2u; }
    const size_t kstep = (size_t)(BK * 2);
    const size_t hstep = (size_t)HALF * K * 2;
    const size_t tstep = 2 * hstep;
    const unsigned ldsw = (unsigned)wid * 1024u;
    const int aoff = lds_byte(wr * 64 + fr, fq * 8), boff = lds_byte(wc * 32 + fr, fq * 8);
#define PG8_SA(b, h) (((b) * 2 + (h)) * HTB)
#define PG8_SB(b, h) ((4 + (b) * 2 + (h)) * HTB)
#define PG8_STAGE(bufoff, gbase, voff) do { _Pragma("unroll") for (int _i = 0; _i < 2; ++_i) \
        __builtin_amdgcn_global_load_lds((const unsigned*)((const char*)(gbase) + (voff)[_i]), (LAS unsigned*)(lds + (bufoff) + ldsw + _i * 8192), 16, 0, 0); } while (0)
#define PG8_LDA(dst, b, h) do { _Pragma("unroll") for (int m = 0; m < 4; ++m) _Pragma("unroll") for (int k = 0; k < 2; ++k) dst[m][k] = *(const LAS bf16x8*)(lds + PG8_SA(b, h) + aoff + m * 2048 + k * 1024); } while (0)
#define PG8_LDB(dst, b, h) do { _Pragma("unroll") for (int n = 0; n < 2; ++n) _Pragma("unroll") for (int k = 0; k < 2; ++k) dst[n][k] = *(const LAS bf16x8*)(lds + PG8_SB(b, h) + boff + n * 2048 + k * 1024); } while (0)
#define PG8_MMA(ai, bj, At, Bt) do { __builtin_amdgcn_s_setprio(1); _Pragma("unroll") for (int m = 0; m < 4; ++m) _Pragma("unroll") for (int n = 0; n < 2; ++n) _Pragma("unroll") for (int k = 0; k < 2; ++k) \
        acc[ai][bj][m][n] = __builtin_amdgcn_mfma_f32_16x16x32_bf16(Bt[n][k], At[m][k], acc[ai][bj][m][n], 0, 0, 0); __builtin_amdgcn_s_setprio(0); } while (0)
#define PG8_WAIT_V(n) asm volatile("s_waitcnt vmcnt(" #n ")" ::: "memory")
#define PG8_WAIT_L(n) asm volatile("s_waitcnt lgkmcnt(" #n ")" ::: "memory")
#define PG8_BAR __builtin_amdgcn_s_barrier()
#define PG8_SCHED __builtin_amdgcn_sched_barrier(0)
    Unit cur, nxt; int ui = 0;
    if (!S.next(0, cur)) return;
    f32x4 acc[2][2][4][2];
#pragma unroll
    for (int a = 0; a < 2; ++a)
#pragma unroll
        for (int b = 0; b < 2; ++b)
#pragma unroll
            for (int m = 0; m < 4; ++m)
#pragma unroll
                for (int n = 0; n < 2; ++n) acc[a][b][m][n] = (f32x4){0.f, 0.f, 0.f, 0.f};
    bf16x8 At[4][2], B0[2][2], B1[2][2];
    const char* cA = (const char*)g.A + (size_t)cur.pm * tstep; const char* cB = (const char*)g.Bt + (size_t)cur.pn * tstep;
    S.a_ready(cur);
    if constexpr (Epi::STAGE) E.stage(cur, wid, 0);
    if constexpr (SP2) {
        PG8_STAGE(PG8_SB(0, 0), cB, voffB); PG8_STAGE(PG8_SB(0, 1), cB + hstep, voffB); PG8_STAGE(PG8_SA(0, 0), cA, voffA); PG8_STAGE(PG8_SA(0, 1), cA + hstep, voffA);
        if (wr == 1) PG8_BAR;
        PG8_WAIT_V(2); PG8_BAR;
        PG8_STAGE(PG8_SB(1, 0), cB + kstep, voffB); PG8_STAGE(PG8_SA(1, 0), cA + kstep, voffA); PG8_STAGE(PG8_SB(1, 1), cB + hstep + kstep, voffB);
        PG8_WAIT_V(6); PG8_BAR;
    } else {
        PG8_STAGE(PG8_SB(0, 0), cB, voffB); PG8_STAGE(PG8_SA(0, 0), cA, voffA); PG8_STAGE(PG8_SB(0, 1), cB + hstep, voffB); PG8_STAGE(PG8_SA(0, 1), cA + hstep, voffA);
        if (wr == 1) PG8_BAR;
        PG8_WAIT_V(4); PG8_BAR;
        PG8_STAGE(PG8_SB(1, 0), cB + kstep, voffB); PG8_STAGE(PG8_SA(1, 0), cA + kstep, voffA); PG8_STAGE(PG8_SB(1, 1), cB + hstep + kstep, voffB);
        PG8_WAIT_V(6); PG8_BAR;
    }
    for (;;) {
        const bool has_next = S.next(ui + 1, nxt);
        const char* nA = has_next ? (const char*)g.A + (size_t)nxt.pm * tstep : cA; const char* nB = has_next ? (const char*)g.Bt + (size_t)nxt.pn * tstep : cB;
        for (int t = 0; t < nt; t += 2) {
            const bool last = (t == nt - 2);
            const char* a1 = cA + (size_t)(t + 1) * kstep;
            const char* a2 = last ? nA : cA + (size_t)(t + 2) * kstep; const char* b2 = last ? nB : cB + (size_t)(t + 2) * kstep;
            const char* a3 = a2 + kstep; const char* b3 = b2 + kstep;
            if (last && has_next) S.a_ready(nxt);
            if constexpr (SP2) {
            PG8_LDB(B0, 0, 0); PG8_LDB(B1, 0, 1); PG8_SCHED; PG8_LDA(At, 0, 0); PG8_STAGE(PG8_SA(1, 1), a1 + hstep, voffA);
            PG8_WAIT_V(8); PG8_WAIT_L(0); PG8_BAR; PG8_MMA(0, 0, At, B0); PG8_MMA(0, 1, At, B1); PG8_BAR; PG8_SCHED;
            PG8_LDA(At, 0, 1); PG8_STAGE(PG8_SB(0, 0), b2, voffB); PG8_STAGE(PG8_SB(0, 1), b2 + hstep, voffB); PG8_STAGE(PG8_SA(0, 0), a2, voffA);
            PG8_WAIT_V(8); PG8_WAIT_L(0); PG8_BAR; PG8_MMA(1, 0, At, B0); PG8_MMA(1, 1, At, B1); PG8_BAR; PG8_SCHED;
            PG8_LDB(B0, 1, 0); PG8_LDB(B1, 1, 1); PG8_SCHED; PG8_LDA(At, 1, 0); PG8_STAGE(PG8_SA(0, 1), a2 + hstep, voffA);
            PG8_WAIT_V(8); PG8_WAIT_L(0); PG8_BAR; PG8_MMA(0, 0, At, B0); PG8_MMA(0, 1, At, B1); PG8_BAR; PG8_SCHED;
            PG8_LDA(At, 1, 1); PG8_STAGE(PG8_SB(1, 0), b3, voffB); PG8_STAGE(PG8_SB(1, 1), b3 + hstep, voffB); PG8_STAGE(PG8_SA(1, 0), a3, voffA);
            PG8_WAIT_V(8); PG8_WAIT_L(0); PG8_BAR; PG8_MMA(1, 0, At, B0); PG8_MMA(1, 1, At, B1); PG8_BAR; PG8_SCHED;
            } else {
            PG8_LDB(B0, 0, 0); PG8_SCHED; PG8_LDA(At, 0, 0); PG8_STAGE(PG8_SA(1, 1), a1 + hstep, voffA);
            PG8_WAIT_L(8); PG8_BAR; PG8_WAIT_L(0); PG8_MMA(0, 0, At, B0); PG8_BAR; PG8_SCHED;
            PG8_LDB(B1, 0, 1); PG8_STAGE(PG8_SB(0, 0), b2, voffB);
            PG8_BAR; PG8_WAIT_L(0); PG8_MMA(0, 1, At, B1); PG8_BAR;
            PG8_LDA(At, 0, 1); PG8_STAGE(PG8_SA(0, 0), a2, voffA);
            PG8_BAR; PG8_WAIT_L(0); PG8_MMA(1, 0, At, B0); PG8_BAR; PG8_SCHED;
            PG8_STAGE(PG8_SB(0, 1), b2 + hstep, voffB);
            PG8_WAIT_V(6); PG8_BAR; PG8_MMA(1, 1, At, B1); PG8_BAR;
            PG8_LDB(B0, 1, 0); PG8_SCHED; PG8_LDA(At, 1, 0); PG8_STAGE(PG8_SA(0, 1), a2 + hstep, voffA);
            PG8_WAIT_L(8); PG8_BAR; PG8_WAIT_L(0); PG8_MMA(0, 0, At, B0); PG8_BAR; PG8_SCHED;
            PG8_LDB(B1, 1, 1); PG8_STAGE(PG8_SB(1, 0), b3, voffB);
            PG8_BAR; PG8_WAIT_L(0); PG8_MMA(0, 1, At, B1); PG8_BAR;
            PG8_LDA(At, 1, 1); PG8_STAGE(PG8_SA(1, 0), a3, voffA);
            PG8_BAR; PG8_WAIT_L(0); PG8_MMA(1, 0, At, B0); PG8_BAR; PG8_SCHED;
            PG8_STAGE(PG8_SB(1, 1), b3 + hstep, voffB);
            PG8_WAIT_V(6); PG8_BAR; PG8_MMA(1, 1, At, B1); PG8_BAR;
            }
        }
        if constexpr (ALIGN_EPI) { if (wr == 0) PG8_BAR; }
        if constexpr (!Epi::AFTER_DRAIN) { int l2 = (int)__builtin_amdgcn_mbcnt_hi(~0u, __builtin_amdgcn_mbcnt_lo(~0u, 0u)); asm volatile("" : "+v"(l2));
            E(acc, cur, wr, wc, l2 & 15, l2 >> 4); S.done(cur); }
        if (!has_next) break;
#pragma unroll
        for (int a = 0; a < 2; ++a)
#pragma unroll
            for (int b = 0; b < 2; ++b)
#pragma unroll
                for (int m = 0; m < 4; ++m)
#pragma unroll
                    for (int n = 0; n < 2; ++n) acc[a][b][m][n] = (f32x4){0.f, 0.f, 0.f, 0.f};
        cur = nxt; cA = nA; cB = nB; ++ui;
        if constexpr (Epi::STAGE) { PG8_BAR; E.stage(cur, wid, 0); }
        if constexpr (ALIGN_EPI) { if (wr == 1) PG8_BAR; }
    }
    PG8_WAIT_V(0);
    if constexpr (!ALIGN_EPI) { if (wr == 0) PG8_BAR; }
    PG8_BAR;
#undef PG8_SA
#undef PG8_SB
#undef PG8_STAGE
#undef PG8_LDA
#undef PG8_LDB
#undef PG8_MMA
#undef PG8_WAIT_V
#undef PG8_WAIT_L
#undef PG8_BAR
#undef PG8_SCHED
}
}

#define XB_TMO      128
#define XB_XCNT(j)  (256  + 64 * (j))
#define XB_XSUB(j)  (1280 + 64 * (j))
#define XB_XGEN(j)  (2304 + 64 * (j))
#define XB_TOP      3328
#define XB_TOPGEN   3392
#define XCD_BAR_WORDS 3456
#define XB_SPIN_CAP (1u << 18)
__device__ __forceinline__ unsigned xb_ld(unsigned* p)              { return __hip_atomic_load(p, __ATOMIC_RELAXED, __HIP_MEMORY_SCOPE_AGENT); }
__device__ __forceinline__ unsigned xb_add(unsigned* p, unsigned v) { return __hip_atomic_fetch_add(p, v, __ATOMIC_RELAXED, __HIP_MEMORY_SCOPE_AGENT); }
__device__ __forceinline__ unsigned xb_xcc_id() { return (unsigned)__builtin_amdgcn_s_getreg((3 << 11) | 20) & 0xFu; }
#define XB_SPIN(cond, bar) do { unsigned _sp = 0; while (cond) { __builtin_amdgcn_s_sleep(1); \
    if ((++_sp & 255u) == 0u) { if (xb_ld(&(bar)[XB_TMO])) break; if (_sp > XB_SPIN_CAP) { atomicAdd(&(bar)[XB_TMO], 1u); break; } } } } while (0)
struct XcdBarrier { unsigned* bar; unsigned x; volatile LAS unsigned* st; };
__device__ __forceinline__ XcdBarrier xcd_barrier_post(unsigned* bar, volatile LAS unsigned* st) {
    XcdBarrier b; b.bar = bar; b.x = xb_xcc_id(); b.st = st;
    if (threadIdx.x == 0) (void)xb_add(&bar[XB_XCNT(b.x)], 1u);
    return b;
}
__device__ __forceinline__ void xcd_barrier_complete(unsigned* bar, unsigned x, unsigned& nloc, unsigned& nx) {
    const unsigned G = gridDim.x * gridDim.y * gridDim.z;
    unsigned sum, cnt, mine, sp = 0u;
    for (;;) {
        sum = 0u; cnt = 0u; mine = 0u;
#pragma unroll
        for (unsigned j = 0; j < 16; ++j) { const unsigned c = xb_ld(&bar[XB_XCNT(j)]); sum += c; cnt += (c > 0u) ? 1u : 0u; mine = (j == x) ? c : mine; }
        if (sum == G) break;
        __builtin_amdgcn_s_sleep(1);
        if ((++sp & 255u) == 0u) { if (xb_ld(&bar[XB_TMO])) break; if (sp > XB_SPIN_CAP) { atomicAdd(&bar[XB_TMO], 1u); break; } }
    }
    nloc = mine > 0u ? mine : 1u; nx = cnt > 0u ? cnt : 1u;
}
__device__ __forceinline__ void xcd_barrier(const XcdBarrier& b) {
    asm volatile("s_waitcnt vmcnt(0)" ::: "memory");
    __syncthreads();
    if (threadIdx.x == 0) {
        unsigned* bar = b.bar;
        __builtin_amdgcn_s_waitcnt(0);
        unsigned nloc = b.st[0], nx = b.st[1]; const unsigned g = b.st[2];
        if (nloc == 0u) { xcd_barrier_complete(bar, b.x, nloc, nx); b.st[0] = nloc; b.st[1] = nx; }
        const unsigned old = xb_add(&bar[XB_XSUB(b.x)], 1u);
        if (old + 1u == (g + 1u) * nloc) {
            __builtin_amdgcn_fence(__ATOMIC_RELEASE, "agent");
            asm volatile("s_waitcnt vmcnt(0)" ::: "memory");
            const unsigned og = xb_add(&bar[XB_TOP], 1u);
            if (og + 1u == (g + 1u) * nx) xb_add(&bar[XB_TOPGEN], 1u);
        }
        XB_SPIN(xb_ld(&bar[XB_TOPGEN]) == g, bar);
        __builtin_amdgcn_fence(__ATOMIC_ACQUIRE, "agent");
        asm volatile("s_waitcnt vmcnt(0)" ::: "memory");
        b.st[2] = g + 1u;
    }
    __syncthreads();
}

constexpr size_t MiB = 1u << 20;
constexpr size_t WS_CTL = 0, CTL_ZERO_BYTES = 1 * MiB;
constexpr int CW_BAR = 4096;
constexpr size_t WS_WAB = 1 * MiB;
constexpr size_t WS_WC = WS_WAB + (size_t)AB_WP * DM * 2;
constexpr size_t WS_WABO = WS_WC + (size_t)C_WP * DM * 2;
constexpr size_t WS_WCO = WS_WABO + (size_t)DM * DM * 2;
constexpr size_t WS_WMQ = WS_WCO + (size_t)DM * DM * 2;
constexpr size_t WS_WKV = WS_WMQ + (size_t)2 * 512 * DM * 2;
constexpr size_t WS_WMO = WS_WKV + (size_t)2048 * DM * 2;
constexpr size_t WS_WFI = WS_WMO + (size_t)2 * DM * 512 * 2;
constexpr size_t WS_WFO = WS_WFI + (size_t)2 * 5632 * DM * 2;
constexpr size_t WS_WEND = WS_WFO + (size_t)2 * DM * DFF * 2;
constexpr size_t WS_MISC = 64 * MiB;
static_assert(WS_WEND <= WS_MISC, "weights fit");
constexpr size_t WS_ROPE64 = WS_MISC;
constexpr size_t WS_ROPE32 = WS_ROPE64 + (size_t)MTOK * 16 * 4;
constexpr size_t WS_RSQ = WS_ROPE32 + (size_t)MTOK * 8 * 4;
constexpr size_t WS_MRS = WS_RSQ + (size_t)MTOK * 16 * 4;
constexpr size_t WS_MEMB = WS_MRS + 8192;
constexpr size_t WS_KVRAW = WS_MEMB + (size_t)MMEM * DM * 2;
constexpr size_t WS_W1T = WS_KVRAW + (size_t)MMEM * 2048 * 2;
constexpr size_t WS_POSW1 = WS_W1T + (size_t)2 * 64 * 2048 * 2;
constexpr size_t WS_KCMP = WS_POSW1 + 512;
constexpr size_t WS_VCMP = WS_KCMP + (size_t)BATCH * 4 * 256 * 64 * 2;
constexpr size_t WS_MISCEND = WS_VCMP + (size_t)BATCH * 4 * 256 * 64 * 2;
constexpr size_t WS_XB = 96 * MiB;
static_assert(WS_MISCEND <= WS_XB, "misc fits");
constexpr size_t WS_R1 = 160 * MiB;
constexpr size_t WS_OATT = 336 * MiB;
constexpr size_t WS_R3 = 400 * MiB;
constexpr size_t WS_GT = WS_R3;
constexpr size_t WS_MQ = WS_R3;
constexpr size_t WS_OMEM = WS_R3 + (size_t)MTOK * 512 * 2;
constexpr size_t WS_SC = WS_OATT;
constexpr size_t WS_BM = 464 * MiB;
constexpr size_t WS_KM = 480 * MiB;
constexpr size_t WS_ISG = 481 * MiB;
constexpr size_t WS_END = 512 * MiB;
static_assert(WS_R1 + (size_t)MTOK * C_WP * 2 <= WS_OATT, "R1 fits");

constexpr int LDS_BYTES = 155648;
constexpr int LDS_MISC = 151552;
constexpr int NWAVES = 8;

__device__ __forceinline__ unsigned f2bf(float f) { unsigned u = __builtin_bit_cast(unsigned, f); return (u + 0x7fffu + ((u >> 16) & 1u)) >> 16; }
__device__ __forceinline__ unsigned pk2(float lo, float hi) { f32x2 v = {lo, hi}; bf16x2_t b = __builtin_convertvector(v, bf16x2_t); return __builtin_bit_cast(unsigned, b); }
__device__ __forceinline__ float bf2f(unsigned short b) { return __builtin_bit_cast(float, (unsigned)b << 16); }
__device__ __forceinline__ float wave_sum(float v) {
#pragma unroll
    for (int o = 1; o < 64; o <<= 1) v += __shfl_xor(v, o);
    return v;
}


namespace att {
constexpr float NEG_INF = -__builtin_huge_valf();
template <int HD> struct Geo { static constexpr int PK = HD * 2 + 16, PV = (HD == 64 ? 192 : 320), KB = 64 * PK, VB = 64 * PV, BUF = KB + VB; };
template <int HD> struct State { f32x16 o[HD / 32]; float m, l;
    __device__ __forceinline__ void init() {
#pragma unroll
        for (int d = 0; d < HD / 32; ++d)
#pragma unroll
            for (int i = 0; i < 16; ++i) o[d][i] = 0.f;
        m = NEG_INF; l = 0.f; } };
template <int HD> struct TileRegs { u32x4 k[HD / 64], v[HD / 64]; };
template <int HD> __device__ __forceinline__ void load_tile(TileRegs<HD>& tr, const bf16_t* kb, size_t kp, const bf16_t* vb, size_t vp, int tid) {
#pragma unroll
    for (int i = 0; i < HD / 64; ++i) { const int idx = tid + 512 * i, row = idx / (HD / 8), c = idx % (HD / 8);
        tr.k[i] = *(const u32x4*)(kb + (size_t)row * kp + c * 8); tr.v[i] = *(const u32x4*)(vb + (size_t)row * vp + c * 8); }
}
template <int HD> __device__ __forceinline__ void store_tile(const TileRegs<HD>& tr, LAS unsigned char* buf, int tid) {
#pragma unroll
    for (int i = 0; i < HD / 64; ++i) { const int idx = tid + 512 * i, row = idx / (HD / 8), c = idx % (HD / 8);
        *(LAS u32x4*)(buf + row * Geo<HD>::PK + c * 16) = tr.k[i]; *(LAS u32x4*)(buf + Geo<HD>::KB + row * Geo<HD>::PV + c * 16) = tr.v[i]; }
}
__device__ __forceinline__ s16x4 tr_read(const LAS unsigned char* p) { typedef short v4i16_t __attribute__((ext_vector_type(4)));
    return __builtin_bit_cast(s16x4, __builtin_amdgcn_ds_read_tr16_b64_v4i16((LAS v4i16_t*)p)); }
__device__ __forceinline__ bf16x8 pack8(const f32x16& x, int s8) {
    u32x4 w; w.x = pk2(x[s8], x[s8 + 1]); w.y = pk2(x[s8 + 2], x[s8 + 3]); w.z = pk2(x[s8 + 4], x[s8 + 5]); w.w = pk2(x[s8 + 6], x[s8 + 7]); return __builtin_bit_cast(bf16x8, w); }
template <int HD> __device__ __forceinline__ void tile_scores(f32x16 (&p)[2], const bf16x8 (&qf)[HD / 16], const LAS unsigned char* buf, int lane) {
    const int r = lane & 31, h = lane >> 5;
#pragma unroll
    for (int kt = 0; kt < 2; ++kt) { f32x16 x;
#pragma unroll
        for (int i = 0; i < 16; ++i) x[i] = 0.f;
#pragma unroll
        for (int s = 0; s < HD / 16; ++s) { const bf16x8 kf = *(const LAS bf16x8*)(buf + (32 * kt + r) * Geo<HD>::PK + 32 * s + 16 * h); x = __builtin_amdgcn_mfma_f32_32x32x16_bf16(kf, qf[s], x, 0, 0, 0); }
        p[kt] = x; }
}
template <int HD> __device__ __forceinline__ void tile_pv(f32x16 (&o)[HD / 32], const f32x16 (&p)[2], const LAS unsigned char* buf, int lane) {
    const int h = lane >> 5, blk = (lane >> 4) & 1, q = (lane & 15) >> 2, pp = lane & 3;
    const LAS unsigned char* vb = buf + Geo<HD>::KB + (4 * h + q) * Geo<HD>::PV + 32 * blk + 8 * pp;
#pragma unroll
    for (int kt = 0; kt < 2; ++kt)
#pragma unroll
        for (int s = 0; s < 2; ++s) { const bf16x8 pb = pack8(p[kt], 8 * s);
#pragma unroll
            for (int dh = 0; dh < HD / 32; ++dh) { const LAS unsigned char* a = vb + (32 * kt + 16 * s) * Geo<HD>::PV + 64 * dh;
                const s16x4 lo = tr_read(a), hi = tr_read(a + 8 * Geo<HD>::PV);
                const bf16x8 vf = __builtin_shufflevector(lo, hi, 0, 1, 2, 3, 4, 5, 6, 7);
                o[dh] = __builtin_amdgcn_mfma_f32_32x32x16_bf16(vf, pb, o[dh], 0, 0, 0); } }
}
template <int HD, class MaskF> __device__ __forceinline__ void tile_step(State<HD>& st, const bf16x8 (&qf)[HD / 16], const LAS unsigned char* buf, int lane, MaskF valid) {
    f32x16 p[2]; tile_scores<HD>(p, qf, buf, lane);
    float mx = NEG_INF;
#pragma unroll
    for (int kt = 0; kt < 2; ++kt)
#pragma unroll
        for (int i = 0; i < 16; ++i) { const int koff = 32 * kt + (i & 3) + 8 * (i >> 2); const float v = valid(koff) ? p[kt][i] : NEG_INF; p[kt][i] = v; mx = fmaxf(mx, v); }
    mx = fmaxf(mx, __shfl_xor(mx, 32));
    const float mnew = fmaxf(st.m, mx), muse = (mnew == NEG_INF) ? 0.f : mnew;
    const float alpha = __builtin_amdgcn_exp2f(st.m - muse);
    float ls = 0.f;
#pragma unroll
    for (int kt = 0; kt < 2; ++kt)
#pragma unroll
        for (int i = 0; i < 16; ++i) { const float e = __builtin_amdgcn_exp2f(p[kt][i] - muse); p[kt][i] = e; ls += e; }
    st.l = st.l * alpha + ls; st.m = mnew;
#pragma unroll
    for (int dh = 0; dh < HD / 32; ++dh)
#pragma unroll
        for (int i = 0; i < 16; ++i) st.o[dh][i] *= alpha;
    tile_pv<HD>(st.o, p, buf, lane);
}
template <int HD, class SrcF, class CompF> __device__ __forceinline__ void kv_pipeline(LAS unsigned char* lds, int nt, int tid, SrcF src, CompF comp) {
    TileRegs<HD> tr; const bf16_t *kb, *vb; size_t kp, vp;
    __syncthreads();
    if (nt <= 0) return;
    src(0, kb, kp, vb, vp); load_tile<HD>(tr, kb, kp, vb, vp, tid); store_tile<HD>(tr, lds, tid);
    __syncthreads();
    for (int t = 0; t < nt; ++t) {
        if (t + 1 < nt) { src(t + 1, kb, kp, vb, vp); load_tile<HD>(tr, kb, kp, vb, vp, tid); }
        comp(t, lds + (t & 1) * Geo<HD>::BUF);
        if (t + 1 < nt) store_tile<HD>(tr, lds + ((t + 1) & 1) * Geo<HD>::BUF, tid);
        __syncthreads();
    }
}

template <int HD, bool PIPE, class SrcF, class ActF, class FinF> __device__ __forceinline__ void kv_pipeline3(LAS unsigned char* lds, int nt, int tid, int lane, const bf16x8 (&qf)[HD / 16], SrcF src, ActF act, FinF fin) {
    TileRegs<HD> tr; const bf16_t *kb, *vb; size_t kp, vp;
    __syncthreads();
    if (nt <= 0) return;
    src(0, kb, kp, vb, vp); load_tile<HD>(tr, kb, kp, vb, vp, tid); store_tile<HD>(tr, lds, tid);
    if (nt > 1) { src(1, kb, kp, vb, vp); load_tile<HD>(tr, kb, kp, vb, vp, tid); store_tile<HD>(tr, lds + Geo<HD>::BUF, tid); }
    __syncthreads();
    f32x16 pc[2], pn[2];
    if constexpr (PIPE) { if (act(0)) tile_scores<HD>(pc, qf, lds, lane); }
    int b0 = 0, b1 = 1, b2 = 2;
    for (int t = 0; t < nt; ++t) {
        if (t + 2 < nt) { src(t + 2, kb, kp, vb, vp); load_tile<HD>(tr, kb, kp, vb, vp, tid); }
        if constexpr (PIPE) {
            const bool an = (t + 1 < nt) && act(t + 1);
            if (an) tile_scores<HD>(pn, qf, lds + b1 * Geo<HD>::BUF, lane);
            if (act(t)) fin(t, pc, lds + b0 * Geo<HD>::BUF);
        } else {
            if (act(t)) { tile_scores<HD>(pc, qf, lds + b0 * Geo<HD>::BUF, lane); fin(t, pc, lds + b0 * Geo<HD>::BUF); }
        }
        if (t + 2 < nt) store_tile<HD>(tr, lds + b2 * Geo<HD>::BUF, tid);
        __syncthreads();
        if constexpr (PIPE) {
#pragma unroll
            for (int k = 0; k < 2; ++k) pc[k] = pn[k]; }
        const int tb = b0; b0 = b1; b1 = b2; b2 = tb;
    }
}
template <int HD, class MaskF> __device__ __forceinline__ void tile_finish(State<HD>& st, f32x16 (&p)[2], const LAS unsigned char* buf, int lane, bool lane_ok, bool elem, MaskF valid) {
    float mx = fmaxf(p[0][0], p[1][0]);
#pragma unroll
    for (int i = 1; i < 16; ++i) mx = fmaxf(mx, fmaxf(p[0][i], p[1][i]));
    mx = fmaxf(mx, __shfl_xor(mx, 32));
    if (__any(mx > st.m)) {
        const float mnew = fmaxf(st.m, mx), alpha = __builtin_amdgcn_exp2f(st.m - mnew);
        st.l *= alpha; st.m = mnew;
#pragma unroll
        for (int dh = 0; dh < HD / 32; ++dh)
#pragma unroll
            for (int i = 0; i < 16; ++i) st.o[dh][i] *= alpha;
    }
    const float sub = lane_ok ? st.m : __builtin_huge_valf();
#pragma unroll
    for (int kt = 0; kt < 2; ++kt)
#pragma unroll
        for (int i = 0; i < 16; ++i) p[kt][i] = __builtin_amdgcn_exp2f(p[kt][i] - sub);
    if (elem) {
#pragma unroll
        for (int kt = 0; kt < 2; ++kt)
#pragma unroll
            for (int i = 0; i < 16; ++i) { const int koff = 32 * kt + (i & 3) + 8 * (i >> 2); p[kt][i] = valid(koff) ? p[kt][i] : 0.f; }
    }
    float ls = 0.f;
#pragma unroll
    for (int i = 0; i < 16; ++i) ls += p[0][i] + p[1][i];
    st.l += ls;
    tile_pv<HD>(st.o, p, buf, lane);
}

template <int HD, bool ELEM, class MaskF> __device__ __forceinline__ void tile_fused(State<HD>& st, f32x16 (&p)[2], const LAS unsigned char* buf, int lane, bool lane_ok, MaskF valid,
                                                                                 const bf16x8 (&qf)[HD / 16], const LAS unsigned char* nbuf, f32x16 (&pn)[2]) {
    float mx = fmaxf(p[0][0], p[1][0]);
#pragma unroll
    for (int i = 1; i < 16; ++i) mx = fmaxf(mx, fmaxf(p[0][i], p[1][i]));
    mx = fmaxf(mx, __shfl_xor(mx, 32));
    if (__any(mx > st.m)) {
        const float mnew = fmaxf(st.m, mx), alpha = __builtin_amdgcn_exp2f(st.m - mnew);
        st.l *= alpha; st.m = mnew;
#pragma unroll
        for (int dh = 0; dh < HD / 32; ++dh)
#pragma unroll
            for (int i = 0; i < 16; ++i) st.o[dh][i] *= alpha;
    }
    const float sub = lane_ok ? st.m : __builtin_huge_valf();
    asm volatile("" : "+v"(lane));
    const int r = lane & 31, h = lane >> 5, blk = (lane >> 4) & 1, q4 = (lane & 15) >> 2, pp = lane & 3;
    const LAS unsigned char* kl = nbuf + r * Geo<HD>::PK + 16 * h;
    const LAS unsigned char* vl = buf + Geo<HD>::KB + (4 * h + q4) * Geo<HD>::PV + 32 * blk + 8 * pp;
#pragma unroll
    for (int i = 0; i < 16; ++i) { pn[0][i] = 0.f; pn[1][i] = 0.f; }
    float ls = 0.f;
#pragma unroll
    for (int c = 0; c < 4; ++c) {
        const int kt = c >> 1, s2 = c & 1;
#pragma unroll
        for (int ss = 0; ss < HD / 32; ++ss) { const int sk = (HD / 32) * s2 + ss; const bf16x8 kf = *(const LAS bf16x8*)(kl + (32 * kt) * Geo<HD>::PK + 32 * sk);
            pn[kt] = __builtin_amdgcn_mfma_f32_32x32x16_bf16(kf, qf[sk], pn[kt], 0, 0, 0); }
#pragma unroll
        for (int j = 0; j < 8; ++j) { const int i = 8 * s2 + j; float e = __builtin_amdgcn_exp2f(p[kt][i] - sub);
            if (ELEM) { const int koff = 32 * kt + (i & 3) + 8 * (i >> 2); e = valid(koff) ? e : 0.f; }
            p[kt][i] = e; ls += e; }
        const bf16x8 pb = pack8(p[kt], 8 * s2);
#pragma unroll
        for (int dh = 0; dh < HD / 32; ++dh) { const LAS unsigned char* a = vl + (32 * kt + 16 * s2) * Geo<HD>::PV + 64 * dh;
            const s16x4 lo = tr_read(a), hi = tr_read(a + 8 * Geo<HD>::PV);
            const bf16x8 vf = __builtin_shufflevector(lo, hi, 0, 1, 2, 3, 4, 5, 6, 7);
            st.o[dh] = __builtin_amdgcn_mfma_f32_32x32x16_bf16(vf, pb, st.o[dh], 0, 0, 0); }
        __builtin_amdgcn_sched_barrier(0);
    }
    st.l += ls;
}
struct NoPre { __device__ __forceinline__ void operator()(int) const {} };
template <int HD, class SrcF, class FinF, class PreF = NoPre> __device__ __forceinline__ void kv_pipeline4(LAS unsigned char* lds, int nt, int tid, int lane, const bf16x8 (&qf)[HD / 16], SrcF src, FinF fin, PreF pre = PreF()) {
    TileRegs<HD> tr; const bf16_t *kb, *vb; size_t kp, vp;
    __syncthreads();
    if (nt <= 0) return;
    src(0, kb, kp, vb, vp); load_tile<HD>(tr, kb, kp, vb, vp, tid); store_tile<HD>(tr, lds, tid);
    if (nt > 1) { src(1, kb, kp, vb, vp); load_tile<HD>(tr, kb, kp, vb, vp, tid); store_tile<HD>(tr, lds + Geo<HD>::BUF, tid); }
    __syncthreads();
    f32x16 pc[2], pn[2];
    tile_scores<HD>(pc, qf, lds, lane);
    int b0 = 0, b1 = 1, b2 = 2;
    for (int t = 0; t < nt; ++t) {
        pre(t + 1);
        if (t + 2 < nt) { src(t + 2, kb, kp, vb, vp); load_tile<HD>(tr, kb, kp, vb, vp, tid); }
        const int bn = (t + 1 < nt) ? b1 : b0;
        fin(t, pc, lds + b0 * Geo<HD>::BUF, lds + bn * Geo<HD>::BUF, pn);
        if (t + 2 < nt) store_tile<HD>(tr, lds + b2 * Geo<HD>::BUF, tid);
        __syncthreads();
#pragma unroll
        for (int k = 0; k < 2; ++k) pc[k] = pn[k];
        const int tb = b0; b0 = b1; b1 = b2; b2 = tb;
    }
}

constexpr int DBUF = 16384;
__device__ __forceinline__ void dma_tile(LAS unsigned char* buf, const bf16_t* kb, size_t kp, const bf16_t* vb, size_t vp, int wave, int lane) {
    const int row = 8 * wave + (lane >> 3), cp = lane & 7;
    const bf16_t* gk = kb + (size_t)row * kp + ((cp ^ ((row >> 1) & 7)) * 8);
    const bf16_t* gv = vb + (size_t)row * vp + ((cp ^ (4 * ((row >> 1) & 1))) * 8);
    __builtin_amdgcn_global_load_lds((const unsigned*)gk, (LAS unsigned*)(buf + wave * 1024), 16, 0, 0);
    __builtin_amdgcn_global_load_lds((const unsigned*)gv, (LAS unsigned*)(buf + 8192 + wave * 1024), 16, 0, 0);
}
__device__ __forceinline__ void dma_tile_o(LAS unsigned char* buf, const bf16_t* kb, const bf16_t* vb, unsigned gko, unsigned gvo, int wave) {
    __builtin_amdgcn_global_load_lds((const unsigned*)((const char*)kb + gko), (LAS unsigned*)(buf + wave * 1024), 16, 0, 0);
    __builtin_amdgcn_global_load_lds((const unsigned*)((const char*)vb + gvo), (LAS unsigned*)(buf + 8192 + wave * 1024), 16, 0, 0);
}
__device__ __forceinline__ void scores_d(f32x16 (&p)[2], const bf16x8 (&qf)[4], const LAS unsigned char* buf, int lane) {
    const int r = lane & 31, h = lane >> 5;
#pragma unroll
    for (int kt = 0; kt < 2; ++kt) { f32x16 x;
#pragma unroll
        for (int i = 0; i < 16; ++i) x[i] = 0.f;
        const int row = 32 * kt + r; const LAS unsigned char* kr = buf + row * 128; const int sw = (row >> 1) & 7;
#pragma unroll
        for (int s = 0; s < 4; ++s) { const bf16x8 kf = *(const LAS bf16x8*)(kr + (((2 * s + h) ^ sw) * 16)); x = __builtin_amdgcn_mfma_f32_32x32x16_bf16(kf, qf[s], x, 0, 0, 0); }
        p[kt] = x; }
}
template <bool ELEM, class MaskF> __device__ __forceinline__ void fused_d(State<64>& st, f32x16 (&p)[2], const LAS unsigned char* buf, int lane, bool lane_ok, MaskF valid,
                                                                        const bf16x8 (&qf)[4], const LAS unsigned char* nbuf, f32x16 (&pn)[2]) {
    float mx = fmaxf(p[0][0], p[1][0]);
#pragma unroll
    for (int i = 1; i < 16; ++i) mx = fmaxf(mx, fmaxf(p[0][i], p[1][i]));
    mx = fmaxf(mx, __shfl_xor(mx, 32));
    if (__any(mx > st.m)) {
        const float mnew = fmaxf(st.m, mx), alpha = __builtin_amdgcn_exp2f(st.m - mnew);
        st.l *= alpha; st.m = mnew;
#pragma unroll
        for (int dh = 0; dh < 2; ++dh)
#pragma unroll
            for (int i = 0; i < 16; ++i) st.o[dh][i] *= alpha;
    }
    const float sub = lane_ok ? st.m : __builtin_huge_valf();
    asm volatile("" : "+v"(lane));
    const int r = lane & 31, h = lane >> 5, blk = (lane >> 4) & 1, q4 = (lane & 15) >> 2, pp = lane & 3;
    const int ksw = (r >> 1) & 7;
    const LAS unsigned char* kl = nbuf + r * 128;
    const int vsw = 4 * ((q4 >> 1) & 1);
    const LAS unsigned char* vl = buf + 8192 + (4 * h + q4) * 128 + 8 * (pp & 1);
    const int vc0 = ((2 * blk + (pp >> 1)) ^ vsw) * 16, vc1 = ((4 + 2 * blk + (pp >> 1)) ^ vsw) * 16;
#pragma unroll
    for (int i = 0; i < 16; ++i) { pn[0][i] = 0.f; pn[1][i] = 0.f; }
    float ls = 0.f;
#pragma unroll
    for (int c = 0; c < 4; ++c) {
        const int kt = c >> 1, s2 = c & 1;
        s16x4 l0, h0, l1, h1;
        { const unsigned a0 = (unsigned)(size_t)(vl + (32 * kt + 16 * s2) * 128 + vc0), a1 = (unsigned)(size_t)(vl + (32 * kt + 16 * s2) * 128 + vc1);
          asm volatile("ds_read_b64_tr_b16 %0, %4\n\tds_read_b64_tr_b16 %1, %4 offset:1024\n\tds_read_b64_tr_b16 %2, %5\n\tds_read_b64_tr_b16 %3, %5 offset:1024"
                       : "=&v"(l0), "=&v"(h0), "=&v"(l1), "=&v"(h1) : "v"(a0), "v"(a1) : "memory"); }
#pragma unroll
        for (int ss = 0; ss < 2; ++ss) { const int sk = 2 * s2 + ss; const bf16x8 kf = *(const LAS bf16x8*)(kl + kt * 4096 + (((2 * sk + h) ^ ksw) * 16));
            pn[kt] = __builtin_amdgcn_mfma_f32_32x32x16_bf16(kf, qf[sk], pn[kt], 0, 0, 0); }
#pragma unroll
        for (int j = 0; j < 8; ++j) { const int i = 8 * s2 + j; float e = __builtin_amdgcn_exp2f(p[kt][i] - sub);
            if (ELEM) { const int koff = 32 * kt + (i & 3) + 8 * (i >> 2); e = valid(koff) ? e : 0.f; }
            p[kt][i] = e; ls += e; }
        const bf16x8 pb = pack8(p[kt], 8 * s2);
        asm volatile("s_waitcnt lgkmcnt(0)" ::: "memory"); __builtin_amdgcn_sched_barrier(0);
        st.o[0] = __builtin_amdgcn_mfma_f32_32x32x16_bf16(__builtin_shufflevector(l0, h0, 0, 1, 2, 3, 4, 5, 6, 7), pb, st.o[0], 0, 0, 0);
        st.o[1] = __builtin_amdgcn_mfma_f32_32x32x16_bf16(__builtin_shufflevector(l1, h1, 0, 1, 2, 3, 4, 5, 6, 7), pb, st.o[1], 0, 0, 0);
        __builtin_amdgcn_sched_barrier(0);
    }
    st.l += ls;
}
template <int XTRA, class SrcF, class FinF, class XtraF> __device__ __forceinline__ void kv_pipeline_dma(LAS unsigned char* lds, int nt, int wave, int lane, const bf16x8 (&qf)[4], SrcF src, FinF fin, XtraF xtra) {
    const bf16_t *kb, *vb; size_t kp, vp;
    asm volatile("s_waitcnt vmcnt(0) lgkmcnt(0)" ::: "memory"); __builtin_amdgcn_s_barrier();
    if (nt <= 0) return;
#pragma unroll
    for (int i = 0; i < 3; ++i) if (i < nt) { src(i, kb, kp, vb, vp); dma_tile(lds + i * DBUF, kb, kp, vb, vp, wave, lane); xtra(i, i); }
    if (nt >= 3) { if (XTRA) asm volatile("s_waitcnt vmcnt(3)" ::: "memory"); else asm volatile("s_waitcnt vmcnt(2)" ::: "memory"); }
    else asm volatile("s_waitcnt vmcnt(0)" ::: "memory");
    __builtin_amdgcn_s_barrier();
    f32x16 pc[2], pn[2];
    scores_d(pc, qf, lds, lane);
    for (int t = 0; t < nt; ++t) {
        if (t + 3 < nt) { src(t + 3, kb, kp, vb, vp); dma_tile(lds + ((t + 3) & 3) * DBUF, kb, kp, vb, vp, wave, lane); xtra(t + 3, (t + 3) & 3); }
        const int bn = (t + 1 < nt) ? ((t + 1) & 3) : (t & 3);
        fin(t, pc, lds + (t & 3) * DBUF, lds + bn * DBUF, pn, t & 3);
        if (t + 3 < nt) { if (XTRA) asm volatile("s_waitcnt vmcnt(3) lgkmcnt(0)" ::: "memory"); else asm volatile("s_waitcnt vmcnt(2) lgkmcnt(0)" ::: "memory"); }
        else asm volatile("s_waitcnt vmcnt(0) lgkmcnt(0)" ::: "memory");
        __builtin_amdgcn_s_barrier();
#pragma unroll
        for (int k = 0; k < 2; ++k) pc[k] = pn[k];
    }
}
struct NoXtra { __device__ __forceinline__ void operator()(int, int) const {} };

struct LpOff { unsigned k0, k1, v0, v1, gk, gv; };
__device__ __forceinline__ LpOff lp_offsets(int lane, int wave = 0, unsigned pitch_bytes = 0) {
    const int r = lane & 31, h = lane >> 5, blk = (lane >> 4) & 1, q4 = (lane & 15) >> 2, pp = lane & 3;
    const int ksw = (r >> 1) & 7, vsw = 4 * ((q4 >> 1) & 1);
    const unsigned vl = 8192 + (4 * h + q4) * 128 + 8 * (pp & 1);
    LpOff o; o.k0 = r * 128 + ((h ^ ksw) * 16); o.k1 = r * 128 + (((2 + h) ^ ksw) * 16);
    o.v0 = vl + ((2 * blk + (pp >> 1)) ^ vsw) * 16; o.v1 = vl + ((4 + 2 * blk + (pp >> 1)) ^ vsw) * 16;
    { const int row = 8 * wave + (lane >> 3), cp = lane & 7;
      o.gk = (unsigned)row * pitch_bytes + ((cp ^ ((row >> 1) & 7)) * 16); o.gv = (unsigned)row * pitch_bytes + ((cp ^ (4 * ((row >> 1) & 1))) * 16); }
    asm volatile("" : "+v"(o.k0), "+v"(o.k1), "+v"(o.v0), "+v"(o.v1), "+v"(o.gk), "+v"(o.gv));
    return o;
}
template <int MODE, bool HS, class MaskF> __device__ __forceinline__ void fused_np(f32x16 (&o)[2], float& l, const f32x16 (&p)[2], const LAS unsigned char* buf, int lane, bool lane_ok, float shift, MaskF valid, unsigned wlo, unsigned whi,
                                                                        const bf16x8 (&qf)[4], const LAS unsigned char* nbuf, f32x16 (&pn)[2], const LpOff& lo) {
    const unsigned nb = (unsigned)(size_t)nbuf, cb = (unsigned)(size_t)buf;
    const unsigned kA0 = nb + lo.k0, kA1 = nb + lo.k1, kB0 = kA0 ^ 64u, kB1 = kA1 ^ 64u;
    const unsigned vb0 = cb + lo.v0, vb1 = cb + lo.v1;
    const unsigned lmask = lane_ok ? 0xffffffffu : 0u;
    float ls = 0.f;
#pragma unroll
    for (int c = 0; c < 4; ++c) {
        const int kt = c >> 1, s2 = c & 1;
        s16x4 l0, h0, l1, h1;
        asm volatile("ds_read_b64_tr_b16 %0, %4 offset:%c6\n\tds_read_b64_tr_b16 %1, %4 offset:%c7\n\tds_read_b64_tr_b16 %2, %5 offset:%c6\n\tds_read_b64_tr_b16 %3, %5 offset:%c7"
                     : "=&v"(l0), "=&v"(h0), "=&v"(l1), "=&v"(h1) : "v"(vb0), "v"(vb1), "i"((32 * (c >> 1) + 16 * (c & 1)) * 128), "i"((32 * (c >> 1) + 16 * (c & 1)) * 128 + 1024) : "memory");
#pragma unroll
        for (int ss = 0; ss < 2; ++ss) { const int sk = 2 * s2 + ss; const bf16x8 kf = *(const LAS bf16x8*)(size_t)((sk == 0 ? kA0 : sk == 1 ? kA1 : sk == 2 ? kB0 : kB1) + kt * 4096);
            if (sk == 0) { f32x16 z;
#pragma unroll
                for (int i = 0; i < 16; ++i) z[i] = 0.f;
                pn[kt] = __builtin_amdgcn_mfma_f32_32x32x16_bf16(kf, qf[sk], z, 0, 0, 0); }
            else pn[kt] = __builtin_amdgcn_mfma_f32_32x32x16_bf16(kf, qf[sk], pn[kt], 0, 0, 0); }
        float e[8];
#pragma unroll
        for (int j = 0; j < 8; ++j) { const int i = 8 * s2 + j; const int koff = 32 * kt + (i & 3) + 8 * (i >> 2); float x = __builtin_amdgcn_exp2f(HS ? p[kt][i] - shift : p[kt][i]);
            if (MODE == 1) x = valid(koff) ? x : 0.f;
            if (MODE == 2) { int tb; asm("v_bfe_i32 %0, %1, %2, 1" : "=v"(tb) : "v"(kt ? whi : wlo), "n"(koff & 31)); x = __builtin_bit_cast(float, __builtin_bit_cast(unsigned, x) & (unsigned)tb); }
            e[j] = x; }
        u32x4 pw; pw.x = pk2(e[0], e[1]) & lmask; pw.y = pk2(e[2], e[3]) & lmask; pw.z = pk2(e[4], e[5]) & lmask; pw.w = pk2(e[6], e[7]) & lmask;
#pragma unroll
        for (int j = 0; j < 8; ++j) ls += lane_ok ? e[j] : 0.f;
        const bf16x8 pb = __builtin_bit_cast(bf16x8, pw);
        asm volatile("s_waitcnt lgkmcnt(0)" ::: "memory"); __builtin_amdgcn_sched_barrier(0);
        o[0] = __builtin_amdgcn_mfma_f32_32x32x16_bf16(__builtin_shufflevector(l0, h0, 0, 1, 2, 3, 4, 5, 6, 7), pb, o[0], 0, 0, 0);
        o[1] = __builtin_amdgcn_mfma_f32_32x32x16_bf16(__builtin_shufflevector(l1, h1, 0, 1, 2, 3, 4, 5, 6, 7), pb, o[1], 0, 0, 0);
        __builtin_amdgcn_sched_barrier(0);
    }
    l += ls;
}
template <int MODE, bool HS, class MaskF> __device__ __forceinline__ void fused_lp(f32x16 (&o)[2], float& l, const f32x16 (&p)[2], const LAS unsigned char* buf, int lane, bool lane_ok, float shift, MaskF valid, unsigned wlo, unsigned whi,
                                                                        const bf16x8 (&qf)[4], const LAS unsigned char* nbuf, f32x16 (&pn)[2], const LpOff& lo) {
    const unsigned nb = (unsigned)(size_t)nbuf, cb = (unsigned)(size_t)buf;
    const unsigned kA0 = nb + lo.k0, kA1 = nb + lo.k1, kB0 = kA0 ^ 64u, kB1 = kA1 ^ 64u;
    const unsigned vb0 = cb + lo.v0, vb1 = cb + lo.v1;
    const unsigned lmask = lane_ok ? 0xffffffffu : 0u;
    bf16x8 kf[2][2]; s16x4 vf[3][4]; bf16x8 pbp = {0, 0, 0, 0, 0, 0, 0, 0};
#define FE_ISSUE(c_, KS_, VS_) do { constexpr int kt_ = (c_) >> 1, s2_ = (c_) & 1; \
        asm volatile("ds_read_b128 %0, %6 offset:%c10\n\tds_read_b128 %1, %7 offset:%c10\n\tds_read_b64_tr_b16 %2, %8 offset:%c11\n\tds_read_b64_tr_b16 %3, %8 offset:%c12\n\tds_read_b64_tr_b16 %4, %9 offset:%c11\n\tds_read_b64_tr_b16 %5, %9 offset:%c12" \
                     : "=&v"(kf[KS_][0]), "=&v"(kf[KS_][1]), "=&v"(vf[VS_][0]), "=&v"(vf[VS_][1]), "=&v"(vf[VS_][2]), "=&v"(vf[VS_][3]) \
                     : "v"(s2_ ? kB0 : kA0), "v"(s2_ ? kB1 : kA1), "v"(vb0), "v"(vb1), "i"(kt_ * 4096), "i"((32 * kt_ + 16 * s2_) * 128), "i"((32 * kt_ + 16 * s2_) * 128 + 1024) : "memory"); } while (0)
    FE_ISSUE(0, 0, 0);
    float ls = 0.f;
#pragma unroll
    for (int c = 0; c < 4; ++c) {
        const int kt = c >> 1, s2 = c & 1, KS = c & 1, VS = c % 3, VP = (c + 2) % 3;
        asm volatile("s_waitcnt lgkmcnt(0)" ::: "memory"); __builtin_amdgcn_sched_barrier(0);
        if (c < 3) { if (c == 0) FE_ISSUE(1, 1, 1); else if (c == 1) FE_ISSUE(2, 0, 2); else FE_ISSUE(3, 1, 0); }
        if (s2 == 0) { f32x16 z;
#pragma unroll
            for (int i = 0; i < 16; ++i) z[i] = 0.f;
            pn[kt] = __builtin_amdgcn_mfma_f32_32x32x16_bf16(kf[KS][0], qf[0], z, 0, 0, 0); pn[kt] = __builtin_amdgcn_mfma_f32_32x32x16_bf16(kf[KS][1], qf[1], pn[kt], 0, 0, 0); }
        else { pn[kt] = __builtin_amdgcn_mfma_f32_32x32x16_bf16(kf[KS][0], qf[2], pn[kt], 0, 0, 0); pn[kt] = __builtin_amdgcn_mfma_f32_32x32x16_bf16(kf[KS][1], qf[3], pn[kt], 0, 0, 0); }
        if (c > 0) {
            o[0] = __builtin_amdgcn_mfma_f32_32x32x16_bf16(__builtin_shufflevector(vf[VP][0], vf[VP][1], 0, 1, 2, 3, 4, 5, 6, 7), pbp, o[0], 0, 0, 0);
            o[1] = __builtin_amdgcn_mfma_f32_32x32x16_bf16(__builtin_shufflevector(vf[VP][2], vf[VP][3], 0, 1, 2, 3, 4, 5, 6, 7), pbp, o[1], 0, 0, 0); }
        float e[8];
#pragma unroll
        for (int j = 0; j < 8; ++j) { const int i = 8 * s2 + j; const int koff = 32 * kt + (i & 3) + 8 * (i >> 2); float x = __builtin_amdgcn_exp2f(HS ? p[kt][i] - shift : p[kt][i]);
            if (MODE == 1) x = valid(koff) ? x : 0.f;
            if (MODE == 2) { int tb; asm("v_bfe_i32 %0, %1, %2, 1" : "=v"(tb) : "v"(kt ? whi : wlo), "n"(koff & 31)); x = __builtin_bit_cast(float, __builtin_bit_cast(unsigned, x) & (unsigned)tb); }
            e[j] = x; }
        u32x4 pw; pw.x = pk2(e[0], e[1]) & lmask; pw.y = pk2(e[2], e[3]) & lmask; pw.z = pk2(e[4], e[5]) & lmask; pw.w = pk2(e[6], e[7]) & lmask;
#pragma unroll
        for (int j = 0; j < 8; ++j) ls += lane_ok ? e[j] : 0.f;
#pragma unroll
        for (int g = 0; g < 4; ++g) { __builtin_amdgcn_sched_group_barrier(0x008, 1, 0); __builtin_amdgcn_sched_group_barrier(0x002, 9, 0); }
        __builtin_amdgcn_sched_barrier(0);
        pbp = __builtin_bit_cast(bf16x8, pw);
    }
    o[0] = __builtin_amdgcn_mfma_f32_32x32x16_bf16(__builtin_shufflevector(vf[0][0], vf[0][1], 0, 1, 2, 3, 4, 5, 6, 7), pbp, o[0], 0, 0, 0);
    o[1] = __builtin_amdgcn_mfma_f32_32x32x16_bf16(__builtin_shufflevector(vf[0][2], vf[0][3], 0, 1, 2, 3, 4, 5, 6, 7), pbp, o[1], 0, 0, 0);
#undef FE_ISSUE
    l += ls;
}
template <int MODE, bool HS, bool LP, class MaskF> __device__ __forceinline__ void fused_e(f32x16 (&o)[2], float& l, const f32x16 (&p)[2], const LAS unsigned char* buf, int lane, bool lane_ok, float shift, MaskF valid, unsigned wlo, unsigned whi,
                                                                        const bf16x8 (&qf)[4], const LAS unsigned char* nbuf, f32x16 (&pn)[2], const LpOff& lo = LpOff{}) {
    if constexpr (LP) fused_lp<MODE, HS>(o, l, p, buf, lane, lane_ok, shift, valid, wlo, whi, qf, nbuf, pn, lo); else fused_np<MODE, HS>(o, l, p, buf, lane, lane_ok, shift, valid, wlo, whi, qf, nbuf, pn, lo);
}
template <int XTRA, class SrcF, class FinF, class XtraF> __device__ __forceinline__ void kv_pipeline_dma2(LAS unsigned char* lds, int nt, int wave, int lane, const bf16x8 (&qf)[4], const LpOff& lo, SrcF src, FinF fin, XtraF xtra) {
    const bf16_t *kb, *vb; size_t kp, vp;
    asm volatile("s_waitcnt vmcnt(0) lgkmcnt(0)" ::: "memory"); __builtin_amdgcn_s_barrier();
    if (nt <= 0) return;
#pragma unroll
    for (int i = 0; i < 3; ++i) if (i < nt) { src(i, kb, kp, vb, vp); dma_tile_o(lds + i * DBUF, kb, vb, lo.gk, lo.gv, wave); xtra(i, i); }
    if (nt >= 3) { if (XTRA) asm volatile("s_waitcnt vmcnt(3)" ::: "memory"); else asm volatile("s_waitcnt vmcnt(2)" ::: "memory"); }
    else asm volatile("s_waitcnt vmcnt(0)" ::: "memory");
    __builtin_amdgcn_s_barrier();
    f32x16 pa[2], pb[2];
    scores_d(pa, qf, lds, lane);
#define KVD2_STEP(PC, PN) do { \
        if (t + 3 < nt) { src(t + 3, kb, kp, vb, vp); dma_tile_o(lds + ((t + 3) & 3) * DBUF, kb, vb, lo.gk, lo.gv, wave); xtra(t + 3, (t + 3) & 3); } \
        const int bn_ = (t + 1 < nt) ? ((t + 1) & 3) : (t & 3); \
        fin(t, PC, lds + (t & 3) * DBUF, lds + bn_ * DBUF, PN, t & 3); \
        if (t + 3 < nt) { if (XTRA) asm volatile("s_waitcnt vmcnt(3) lgkmcnt(0)" ::: "memory"); else asm volatile("s_waitcnt vmcnt(2) lgkmcnt(0)" ::: "memory"); } \
        else asm volatile("s_waitcnt vmcnt(0) lgkmcnt(0)" ::: "memory"); \
        __builtin_amdgcn_s_barrier(); ++t; } while (0)
    int t = 0;
    while (t < nt) { KVD2_STEP(pa, pb); if (t >= nt) break; KVD2_STEP(pb, pa); }
#undef KVD2_STEP
}
__device__ __forceinline__ float gain_max64(const float* g) { float m = 0.f; for (int i = 0; i < 64; ++i) m = fmaxf(m, fabsf(g[i])); return m; }
__device__ __forceinline__ float softmax_shift(float gq, float gk) { const float B = 8.0f * LOG2E * gq * gk * 1.02f; return B > 60.f ? B - 60.f : 0.f; }

template <int MODE, bool HS, class MaskF> __device__ __forceinline__ void half_v(u32x4 (&pw)[4], float& l, const f32x16 (&p)[2], bool lane_ok, float shift, MaskF valid, unsigned wlo, unsigned whi) {
    const unsigned lmask = lane_ok ? 0xffffffffu : 0u; float ls = 0.f;
#pragma unroll
    for (int c = 0; c < 4; ++c) { const int kt = c >> 1, s2 = c & 1; float e[8];
#pragma unroll
        for (int j = 0; j < 8; ++j) { const int i = 8 * s2 + j; const int koff = 32 * kt + (i & 3) + 8 * (i >> 2); float x = __builtin_amdgcn_exp2f(HS ? p[kt][i] - shift : p[kt][i]);
            if (MODE == 1) x = valid(koff) ? x : 0.f;
            if (MODE == 2) { int tb; asm("v_bfe_i32 %0, %1, %2, 1" : "=v"(tb) : "v"(kt ? whi : wlo), "n"(koff & 31)); x = __builtin_bit_cast(float, __builtin_bit_cast(unsigned, x) & (unsigned)tb); }
            e[j] = x; ls += x; }
        pw[c].x = pk2(e[0], e[1]) & lmask; pw[c].y = pk2(e[2], e[3]) & lmask; pw[c].z = pk2(e[4], e[5]) & lmask; pw[c].w = pk2(e[6], e[7]) & lmask; }
    l += lane_ok ? ls : 0.f;
}
__device__ __forceinline__ void half_m(f32x16 (&o)[2], const u32x4 (&pw)[4], const LAS unsigned char* buf, const LAS unsigned char* nbuf, const bf16x8 (&qf)[4], f32x16 (&pn)[2], bool do_scores, int lane) {
    asm volatile("" : "+v"(lane));
    const int r = lane & 31, h = lane >> 5, blk = (lane >> 4) & 1, q4 = (lane & 15) >> 2, pp = lane & 3;
    const int ksw = (r >> 1) & 7;
    const unsigned kl = (unsigned)(size_t)(nbuf + r * 128);
    const unsigned kx0 = ((h ^ ksw) * 16), kx1 = (((2 + h) ^ ksw) * 16);
    const unsigned kA0 = kl + kx0, kA1 = kl + kx1, kB0 = kl + (kx0 ^ 64u), kB1 = kl + (kx1 ^ 64u);
    const int vsw = 4 * ((q4 >> 1) & 1);
    const unsigned vl = (unsigned)(size_t)(buf + 8192 + (4 * h + q4) * 128 + 8 * (pp & 1));
    const unsigned vb0 = vl + ((2 * blk + (pp >> 1)) ^ vsw) * 16, vb1 = vl + ((4 + 2 * blk + (pp >> 1)) ^ vsw) * 16;
    bf16x8 kf[8]; s16x4 vf[16];
    if (do_scores) {
        asm volatile("ds_read_b128 %0, %8\n\tds_read_b128 %1, %9\n\tds_read_b128 %2, %10\n\tds_read_b128 %3, %11\n\tds_read_b128 %4, %8 offset:4096\n\tds_read_b128 %5, %9 offset:4096\n\tds_read_b128 %6, %10 offset:4096\n\tds_read_b128 %7, %11 offset:4096"
                     : "=&v"(kf[0]), "=&v"(kf[1]), "=&v"(kf[2]), "=&v"(kf[3]), "=&v"(kf[4]), "=&v"(kf[5]), "=&v"(kf[6]), "=&v"(kf[7]) : "v"(kA0), "v"(kA1), "v"(kB0), "v"(kB1) : "memory");
    }
#define HM_V(c_) asm volatile("ds_read_b64_tr_b16 %0, %4 offset:%c6\n\tds_read_b64_tr_b16 %1, %4 offset:%c7\n\tds_read_b64_tr_b16 %2, %5 offset:%c6\n\tds_read_b64_tr_b16 %3, %5 offset:%c7" \
                     : "=&v"(vf[4 * (c_)]), "=&v"(vf[4 * (c_) + 1]), "=&v"(vf[4 * (c_) + 2]), "=&v"(vf[4 * (c_) + 3]) : "v"(vb0), "v"(vb1), "i"((32 * ((c_) >> 1) + 16 * ((c_) & 1)) * 128), "i"((32 * ((c_) >> 1) + 16 * ((c_) & 1)) * 128 + 1024) : "memory")
    asm volatile("s_waitcnt lgkmcnt(0)" ::: "memory"); __builtin_amdgcn_sched_barrier(0);
    HM_V(0); HM_V(1); HM_V(2); HM_V(3);
#undef HM_V
    if (do_scores) {
#pragma unroll
        for (int kt = 0; kt < 2; ++kt) { f32x16 z;
#pragma unroll
            for (int i = 0; i < 16; ++i) z[i] = 0.f;
            z = __builtin_amdgcn_mfma_f32_32x32x16_bf16(kf[4 * kt + 0], qf[0], z, 0, 0, 0);
            z = __builtin_amdgcn_mfma_f32_32x32x16_bf16(kf[4 * kt + 1], qf[1], z, 0, 0, 0);
            z = __builtin_amdgcn_mfma_f32_32x32x16_bf16(kf[4 * kt + 2], qf[2], z, 0, 0, 0);
            z = __builtin_amdgcn_mfma_f32_32x32x16_bf16(kf[4 * kt + 3], qf[3], z, 0, 0, 0);
            pn[kt] = z; }
    }
    asm volatile("s_waitcnt lgkmcnt(0)" ::: "memory"); __builtin_amdgcn_sched_barrier(0);
#pragma unroll
    for (int c = 0; c < 4; ++c) { const bf16x8 pb = __builtin_bit_cast(bf16x8, pw[c]);
        o[0] = __builtin_amdgcn_mfma_f32_32x32x16_bf16(__builtin_shufflevector(vf[4 * c], vf[4 * c + 1], 0, 1, 2, 3, 4, 5, 6, 7), pb, o[0], 0, 0, 0);
        o[1] = __builtin_amdgcn_mfma_f32_32x32x16_bf16(__builtin_shufflevector(vf[4 * c + 2], vf[4 * c + 3], 0, 1, 2, 3, 4, 5, 6, 7), pb, o[1], 0, 0, 0); }
}
template <int XTRA, class SrcF, class VF, class XtraF> __device__ __forceinline__ void kv_pipeline_ab(LAS unsigned char* lds, int nt, int wave, int lane, const bf16x8 (&qf)[4], f32x16 (&o)[2], SrcF src, VF vhalf, XtraF xtra) {
    const bf16_t *kb, *vb; size_t kp, vp;
    asm volatile("s_waitcnt vmcnt(0) lgkmcnt(0)" ::: "memory"); __builtin_amdgcn_s_barrier();
    if (nt <= 0) return;
#pragma unroll
    for (int i = 0; i < 3; ++i) if (i < nt) { src(i, kb, kp, vb, vp); dma_tile(lds + i * DBUF, kb, kp, vb, vp, wave, lane); xtra(i, i); }
    if (nt >= 3) { if (XTRA) asm volatile("s_waitcnt vmcnt(3)" ::: "memory"); else asm volatile("s_waitcnt vmcnt(2)" ::: "memory"); }
    else asm volatile("s_waitcnt vmcnt(0)" ::: "memory");
    __builtin_amdgcn_s_barrier();
    f32x16 pc[2]; scores_d(pc, qf, lds, lane);
    asm volatile("s_waitcnt lgkmcnt(0)" ::: "memory");
    const bool grpB = (wave & 4) != 0;
    if (grpB) __builtin_amdgcn_s_barrier();
    u32x4 pw[4];
    for (int t = 0; t < nt; ++t) {
        vhalf(t, pc, pw, t & 3);
        asm volatile("s_waitcnt lgkmcnt(0)" ::: "memory"); __builtin_amdgcn_s_barrier();
        if (t + 3 < nt) { src(t + 3, kb, kp, vb, vp); dma_tile(lds + ((t + 3) & 3) * DBUF, kb, kp, vb, vp, wave, lane); xtra(t + 3, (t + 3) & 3); }
        half_m(o, pw, lds + (t & 3) * DBUF, lds + ((t + 1) & 3) * DBUF, qf, pc, t + 1 < nt, lane);
        if (t + 3 < nt) { if (XTRA) asm volatile("s_waitcnt vmcnt(3) lgkmcnt(0)" ::: "memory"); else asm volatile("s_waitcnt vmcnt(2) lgkmcnt(0)" ::: "memory"); }
        else asm volatile("s_waitcnt vmcnt(0) lgkmcnt(0)" ::: "memory");
        __builtin_amdgcn_s_barrier();
    }
    if (!grpB) __builtin_amdgcn_s_barrier();
}

template <int XTRA, class SrcF, class FinF, class XtraF> __device__ __forceinline__ void kv_pipeline_dma8(LAS unsigned char* lds, int nt, int wave, int lane, const bf16x8 (&qf)[4], const LpOff& lo, SrcF src, FinF fin, XtraF xtra) {
    const bf16_t *kb, *vb; size_t kp, vp;
    asm volatile("s_waitcnt vmcnt(0) lgkmcnt(0)" ::: "memory"); __builtin_amdgcn_s_barrier();
    if (nt <= 0) return;
#define KV8_WAIT(n_) do { const int na_ = (n_); \
        if (XTRA) { if (na_ >= 3) asm volatile("s_waitcnt vmcnt(9) lgkmcnt(0)" ::: "memory"); else if (na_ == 2) asm volatile("s_waitcnt vmcnt(6) lgkmcnt(0)" ::: "memory"); else if (na_ == 1) asm volatile("s_waitcnt vmcnt(3) lgkmcnt(0)" ::: "memory"); else asm volatile("s_waitcnt vmcnt(0) lgkmcnt(0)" ::: "memory"); } \
        else { if (na_ >= 3) asm volatile("s_waitcnt vmcnt(6) lgkmcnt(0)" ::: "memory"); else if (na_ == 2) asm volatile("s_waitcnt vmcnt(4) lgkmcnt(0)" ::: "memory"); else if (na_ == 1) asm volatile("s_waitcnt vmcnt(2) lgkmcnt(0)" ::: "memory"); else asm volatile("s_waitcnt vmcnt(0) lgkmcnt(0)" ::: "memory"); } } while (0)
#pragma unroll
    for (int i = 0; i < 6; ++i) if (i < nt) { src(i, kb, kp, vb, vp); dma_tile_o(lds + i * DBUF, kb, vb, lo.gk, lo.gv, wave); xtra(i, i); }
    { const int iss = nt < 6 ? nt : 6; KV8_WAIT(iss > 3 ? iss - 3 : 0); }
    __builtin_amdgcn_s_barrier();
    f32x16 pa[2], pb[2];
    scores_d(pa, qf, lds, lane);
    int t = 0;
    while (true) {
        if (t + 6 < nt) { src(t + 6, kb, kp, vb, vp); dma_tile_o(lds + ((t + 6) & 7) * DBUF, kb, vb, lo.gk, lo.gv, wave); xtra(t + 6, (t + 6) & 7); }
        { const int bn_ = (t + 1 < nt) ? ((t + 1) & 7) : (t & 7); fin(t, pa, lds + (t & 7) * DBUF, lds + bn_ * DBUF, pb, t & 7); }
        if (t + 1 >= nt) break;
        if (t + 7 < nt) { src(t + 7, kb, kp, vb, vp); dma_tile_o(lds + ((t + 7) & 7) * DBUF, kb, vb, lo.gk, lo.gv, wave); xtra(t + 7, (t + 7) & 7); }
        { const int bn_ = (t + 2 < nt) ? ((t + 2) & 7) : ((t + 1) & 7); fin(t + 1, pb, lds + ((t + 1) & 7) * DBUF, lds + bn_ * DBUF, pa, (t + 1) & 7); }
        { const int rem = nt - (t + 5); KV8_WAIT(rem < 0 ? 0 : (rem > 3 ? 3 : rem)); }
        __builtin_amdgcn_s_barrier();
        t += 2; if (t >= nt) break;
    }
    asm volatile("s_waitcnt vmcnt(0) lgkmcnt(0)" ::: "memory"); __builtin_amdgcn_s_barrier();
#undef KV8_WAIT
}
template <int HD> __device__ __forceinline__ void store_o(const f32x16 (&o)[HD / 32], float f, bf16_t* orow, int lane) {
    const int h = lane >> 5;
#pragma unroll
    for (int dh = 0; dh < HD / 32; ++dh)
#pragma unroll
        for (int g = 0; g < 4; ++g) { u32x2 w; w.x = pk2(o[dh][4 * g] * f, o[dh][4 * g + 1] * f); w.y = pk2(o[dh][4 * g + 2] * f, o[dh][4 * g + 3] * f);
            *(u32x2*)(orow + 32 * dh + 8 * g + 4 * h) = w; }
}

template <int HD> __device__ __forceinline__ void store_o_t(const f32x16 (&o)[HD / 32], float f, bf16_t* base, size_t ld, LAS unsigned char* scr, int lane) {
    constexpr int PITCH = HD * 2 + 16;
    asm volatile("" : "+v"(lane));
    const int r = lane & 31, h = lane >> 5;
#pragma unroll
    for (int dh = 0; dh < HD / 32; ++dh)
#pragma unroll
        for (int g = 0; g < 4; ++g) { u32x2 w; w.x = pk2(o[dh][4 * g] * f, o[dh][4 * g + 1] * f); w.y = pk2(o[dh][4 * g + 2] * f, o[dh][4 * g + 3] * f);
            *(LAS u32x2*)(scr + r * PITCH + (32 * dh + 8 * g + 4 * h) * 2) = w; }
    asm volatile("s_waitcnt lgkmcnt(0)" ::: "memory");
    constexpr int CPR = HD / 8;
#pragma unroll
    for (int i = 0; i < (32 * CPR) / 64; ++i) { const int idx = lane + 64 * i, row = idx / CPR, c = idx % CPR;
        const u32x4 v = *(const LAS u32x4*)(scr + row * PITCH + c * 16);
        *(u32x4*)(base + (size_t)row * ld + c * 8) = v; }
}
}


__device__ __forceinline__ float row_rstd(const float* rsq, int row) {
    const f32x4* pr = (const f32x4*)(rsq + (size_t)row * 16); const f32x4 a = pr[0], b = pr[1], c = pr[2], d = pr[3];
    const float ss = (((a[0] + a[1]) + (a[2] + a[3])) + ((b[0] + b[1]) + (b[2] + b[3]))) + (((c[0] + c[1]) + (c[2] + c[3])) + ((d[0] + d[1]) + (d[2] + d[3])));
    return __builtin_amdgcn_rsqf(ss * (1.0f / 1024.0f) + RMS_EPS);
}
__device__ __forceinline__ void unpack8(const u32x4 w, float (&f)[8]) {
#pragma unroll
    for (int j = 0; j < 4; ++j) { f[2 * j] = __builtin_bit_cast(float, w[j] << 16); f[2 * j + 1] = __builtin_bit_cast(float, w[j] & 0xffff0000u); } }
__device__ __forceinline__ u32x4 pack8f(const float (&f)[8]) { u32x4 o; o.x = pk2(f[0], f[1]); o.y = pk2(f[2], f[3]); o.z = pk2(f[4], f[5]); o.w = pk2(f[6], f[7]); return o; }
__device__ __forceinline__ void head_norm64(float (&f)[8], const float* gain, float extra, int lane) {
    float ss = 0.f;
#pragma unroll
    for (int j = 0; j < 8; ++j) ss += f[j] * f[j];
    ss += __shfl_xor(ss, 1); ss += __shfl_xor(ss, 2); ss += __shfl_xor(ss, 4);
    const float rn = __builtin_amdgcn_rsqf(ss * (1.0f / 64.0f) + RMS_EPS) * extra; const float* gn = gain + (lane & 7) * 8;
#pragma unroll
    for (int j = 0; j < 8; ++j) f[j] = f[j] * rn * gn[j];
}
__device__ __forceinline__ void head_rope64(float (&f)[8], const float* cs, int lane) {
    float oth[8];
#pragma unroll
    for (int j = 0; j < 8; ++j) oth[j] = __shfl_xor(f[j], 1);
    const int li = lane & 7;
    if (li < 2) {
#pragma unroll
        for (int j = 0; j < 8; ++j) { const float c = cs[j], sn = cs[8 + j]; f[j] = (li == 0) ? f[j] * c - oth[j] * sn : f[j] * c + oth[j] * sn; }
    }
}

__device__ __forceinline__ int wave_sum_i(int x) {
    x += __builtin_amdgcn_update_dpp(0, x, 0x111, 0xf, 0xf, true);
    x += __builtin_amdgcn_update_dpp(0, x, 0x112, 0xf, 0xf, true);
    x += __builtin_amdgcn_update_dpp(0, x, 0x114, 0xf, 0xf, true);
    x += __builtin_amdgcn_update_dpp(0, x, 0x118, 0xf, 0xf, true);
    x += __builtin_amdgcn_update_dpp(0, x, 0x142, 0xa, 0xf, true);
    x += __builtin_amdgcn_update_dpp(0, x, 0x143, 0xc, 0xf, true);
    return __builtin_amdgcn_readlane(x, 63);
}

__device__ __forceinline__ int cnt_ge(unsigned u, unsigned cand, int c) {
    int r; asm("v_cmp_ge_u32 vcc, %1, %2\n\tv_addc_co_u32 %0, vcc, 0, %3, vcc" : "=v"(r) : "v"(u), "v"(cand), "v"(c) : "vcc"); return r; }

__device__ __forceinline__ int cnt_ge16(const unsigned* u, unsigned cand, int c) {
    asm("v_cmp_ge_u32 vcc, %1, %17\n\tv_addc_co_u32 %0, vcc, 0, %0, vcc\n\tv_cmp_ge_u32 vcc, %2, %17\n\tv_addc_co_u32 %0, vcc, 0, %0, vcc\n\t"
        "v_cmp_ge_u32 vcc, %3, %17\n\tv_addc_co_u32 %0, vcc, 0, %0, vcc\n\tv_cmp_ge_u32 vcc, %4, %17\n\tv_addc_co_u32 %0, vcc, 0, %0, vcc\n\t"
        "v_cmp_ge_u32 vcc, %5, %17\n\tv_addc_co_u32 %0, vcc, 0, %0, vcc\n\tv_cmp_ge_u32 vcc, %6, %17\n\tv_addc_co_u32 %0, vcc, 0, %0, vcc\n\t"
        "v_cmp_ge_u32 vcc, %7, %17\n\tv_addc_co_u32 %0, vcc, 0, %0, vcc\n\tv_cmp_ge_u32 vcc, %8, %17\n\tv_addc_co_u32 %0, vcc, 0, %0, vcc\n\t"
        "v_cmp_ge_u32 vcc, %9, %17\n\tv_addc_co_u32 %0, vcc, 0, %0, vcc\n\tv_cmp_ge_u32 vcc, %10, %17\n\tv_addc_co_u32 %0, vcc, 0, %0, vcc\n\t"
        "v_cmp_ge_u32 vcc, %11, %17\n\tv_addc_co_u32 %0, vcc, 0, %0, vcc\n\tv_cmp_ge_u32 vcc, %12, %17\n\tv_addc_co_u32 %0, vcc, 0, %0, vcc\n\t"
        "v_cmp_ge_u32 vcc, %13, %17\n\tv_addc_co_u32 %0, vcc, 0, %0, vcc\n\tv_cmp_ge_u32 vcc, %14, %17\n\tv_addc_co_u32 %0, vcc, 0, %0, vcc\n\t"
        "v_cmp_ge_u32 vcc, %15, %17\n\tv_addc_co_u32 %0, vcc, 0, %0, vcc\n\tv_cmp_ge_u32 vcc, %16, %17\n\tv_addc_co_u32 %0, vcc, 0, %0, vcc"
        : "+v"(c) : "v"(u[0]), "v"(u[1]), "v"(u[2]), "v"(u[3]), "v"(u[4]), "v"(u[5]), "v"(u[6]), "v"(u[7]), "v"(u[8]), "v"(u[9]), "v"(u[10]), "v"(u[11]), "v"(u[12]), "v"(u[13]), "v"(u[14]), "v"(u[15]), "v"(cand) : "vcc");
    return c;
}
struct Args { const void* in[32]; float* out; unsigned char* ws; int ph_lo, ph_hi, li, pad; };

template <class CMap>
__device__ __forceinline__ void transpose_item(const float* W, int K, int N, bf16_t* WT, const float* gain, LAS float* scr, int kb, int nb, int lane, CMap cmap) {
    const int k0 = 64 * kb, n0 = 32 * nb, n4 = (lane & 7) * 4; const int c = cmap(n0 + n4);
    f32x4 v[8]; float gk[8];
#pragma unroll
    for (int i = 0; i < 8; ++i) { const int kk = (lane >> 3) + 8 * i; v[i] = (f32x4){0.f, 0.f, 0.f, 0.f}; gk[i] = 1.f;
        if (c >= 0) { v[i] = *(const f32x4*)(W + (size_t)(k0 + kk) * N + c); if (gain) gk[i] = gain[k0 + kk]; } }
#pragma unroll
    for (int i = 0; i < 8; ++i) { const int kk = (lane >> 3) + 8 * i; *(LAS f32x4*)(scr + kk * 36 + n4) = v[i] * gk[i]; }
    asm volatile("s_waitcnt lgkmcnt(0)" ::: "memory");
    const int ch = lane & 7;
#pragma unroll
    for (int j = 0; j < 4; ++j) { const int n = (lane >> 3) + 8 * j; const LAS float* s = scr + (8 * ch) * 36 + n;
        u32x4 o; o.x = pk2(s[0 * 36], s[1 * 36]); o.y = pk2(s[2 * 36], s[3 * 36]); o.z = pk2(s[4 * 36], s[5 * 36]); o.w = pk2(s[6 * 36], s[7 * 36]);
        *(u32x4*)(WT + (size_t)(n0 + n) * K + k0 + 8 * ch) = o; }
    asm volatile("s_waitcnt lgkmcnt(0)" ::: "memory");
}

struct CMapId { int n; __device__ __forceinline__ int operator()(int p) const { return p < n ? p : -1; } };
struct CMapProj0 { __device__ __forceinline__ int operator()(int p) const { const int o = p & 255, c = 64 * (4 * (p >> 8) + ((o >> 5) & 3)) + 8 * (2 * ((o >> 3) & 3) + (o >> 7)) + (o & 7);
    if (c < 936) return c; if (c < 960) return -1; return (c - 24 < AB_W) ? c - 24 : -1; } };
struct CMapProj1 { __device__ __forceinline__ int operator()(int p) const { const int o = p & 255, c = 64 * (4 * (p >> 8) + ((o >> 5) & 3)) + 8 * (2 * ((o >> 3) & 3) + (o >> 7)) + (o & 7); return c < C_W ? c : -1; } };
struct CMapFfn { __device__ __forceinline__ int operator()(int p) const { const int t = p >> 8, r = p & 255; return r < 128 ? t * 128 + r : DFF + t * 128 + (r - 128); } };

#ifndef PIPE_MEM
#define PIPE_MEM false
#endif
#ifndef PIPE_DSA
#define PIPE_DSA true
#endif
#ifndef PIPE_MOBA
#define PIPE_MOBA false
#endif
#ifndef PIPE_SEL
#define PIPE_SEL true
#endif
#ifndef PIPE_WIN
#define PIPE_WIN true
#endif
#ifndef LP_L0
#define LP_L0 true
#endif
#ifndef LP_NSA
#define LP_NSA false
#endif
#ifndef AB_L0
#define AB_L0 0
#endif
#ifndef PROBE_MASK
#define PROBE_MASK 0u
#endif
#define REPS(k) (((PROBE_MASK >> (k)) & 1u) ? 2 : 1)
#define RUN(k) (lo <= (k) && (k) < hi)
#define SEAM(k) do { if ((k) + 1 < hi) xcd_barrier(bar); } while (0)
#define INF_(k) ((const float*)args.in[k])
#define x_in INF_(0)
#define mem_in INF_(1)
#define positions ((const int*)args.in[2])
#define norm_mix INF_(3)
#define norm_mem INF_(4)
#define norm_mem_src INF_(5)
#define norm_ffn INF_(6)
#define ab_w_in INF_(7)
#define ab_w_out INF_(8)
#define nsa_w_in INF_(13)
#define nsa_w_out INF_(14)
#define mem_w_q INF_(25)
#define mem_w_kv INF_(26)
#define mem_w_o INF_(27)
#define ffn_w_in INF_(30)
#define ffn_w_out INF_(31)
#define out (args.out)
#define WSB(off) ((bf16_t*)(args.ws + (off)))
#define W_AB WSB(WS_WAB)
#define W_C WSB(WS_WC)
#define W_ABO WSB(WS_WABO)
#define W_CO WSB(WS_WCO)
#define W_MQ WSB(WS_WMQ)
#define W_KV WSB(WS_WKV)
#define W_MO WSB(WS_WMO)
#define W_FI WSB(WS_WFI)
#define W_FO WSB(WS_WFO)
#define XB WSB(WS_XB)
#define RSQ ((float*)(args.ws + WS_RSQ))
#define HID WSB(WS_R1)
#define MEMB WSB(WS_MEMB)
#define KVRAW WSB(WS_KVRAW)
#define MRS ((float*)(args.ws + WS_MRS))
#define MQB WSB(WS_MQ)
#define OMEM WSB(WS_OMEM)
#define mem_q_norm INF_(28)
#define RAW WSB(WS_R1)
#define OATT WSB(WS_OATT)
#define ROPE64 ((float*)(args.ws + WS_ROPE64))
#define ROPE32 ((float*)(args.ws + WS_ROPE32))
#define W1T WSB(WS_W1T)
#define POSW1 ((float*)(args.ws + WS_POSW1))
#define KCMP WSB(WS_KCMP)
#define VCMP WSB(WS_VCMP)
#define GT ((float*)(args.ws + WS_GT))
#define SCR ((float*)(args.ws + WS_SC))
#define BMK ((unsigned long long*)(args.ws + WS_BM))
#define KMEAN ((float*)(args.ws + WS_KM))
#define IWB ((float*)(args.ws + WS_ISG))
#define dsa_q_norm INF_(9)
#define dsa_k_norm INF_(10)
#define moba_q_norm INF_(11)
#define moba_k_norm INF_(12)
#define nsa_q_norm INF_(15)
#define nsa_kcmp_norm INF_(16)
#define nsa_ksel_norm INF_(17)
#define nsa_kwin_norm INF_(18)
#define nsa_cmp_pos_k INF_(19)
#define nsa_cmp_pos_v INF_(20)
#define nsa_cmp_w1_k INF_(21)
#define nsa_cmp_w2_k INF_(22)
#define nsa_cmp_w1_v INF_(23)
#define nsa_cmp_w2_v INF_(24)
#define mem_k_norm INF_(29)
template <int L> __device__ __forceinline__ void layer_phases(const Args& args, LAS unsigned char* lds, const XcdBarrier& bar, const int lo, const int hi, const int wave) {
    const int G = gridDim.x, bid = blockIdx.x;
    constexpr int pb = 1 + 10 * L;
        if (RUN(pb + 0)) for (int rep_ = 0; rep_ < REPS(pb + 0); ++rep_) {
            int lane = (int)__builtin_amdgcn_mbcnt_hi(~0u, __builtin_amdgcn_mbcnt_lo(~0u, 0u)); asm volatile("" : "+v"(lane)); const int tid = wave * 64 + lane;
            if (L == 0) {
                pg8::Gemm g{MEMB, W_KV, MMEM, 2048, DM}; pg8::StaticOrder S; S.init(MMEM, 2048, G, bid);
                pg8::EpiPlain E{KVRAW, 2048};
                pg8::gemm_phase<pg8::EpiPlain, pg8::StaticOrder, true, true>(lds, g, S, E, wave);
            }
            if (L == 0) {
                pg8::Gemm g{XB, W_AB, MTOK, AB_WP, DM}; pg8::StaticOrder S; S.init(MTOK, AB_WP, G, bid);
                pg8::EpiProj<0> E{RAW, AB_WP, RSQ, ROPE64, ROPE32, dsa_q_norm, dsa_k_norm, moba_q_norm, moba_k_norm, IWB, lds};
                pg8::gemm_phase<pg8::EpiProj<0>, pg8::StaticOrder, true, true>(lds, g, S, E, wave);
            }
            if (L == 1) {
                pg8::Gemm g{XB, W_C, MTOK, C_WP, DM}; pg8::StaticOrder S; S.init(MTOK, C_WP, G, bid);
                pg8::EpiProj<1> E{RAW, C_WP, RSQ, ROPE64, ROPE32, nsa_q_norm, nsa_ksel_norm, nsa_kwin_norm, nullptr, GT, lds};
                pg8::gemm_phase<pg8::EpiProj<1>, pg8::StaticOrder, true, true>(lds, g, S, E, wave);
            }
            SEAM(pb + 0);
        }
        if (RUN(pb + 1)) for (int rep_ = 0; rep_ < REPS(pb + 1); ++rep_) {
            int lane = (int)__builtin_amdgcn_mbcnt_hi(~0u, __builtin_amdgcn_mbcnt_lo(~0u, 0u)); asm volatile("" : "+v"(lane)); const int tid = wave * 64 + lane;
            if (L == 1) {
                LAS float* PART = (LAS float*)lds;
                LAS float* HB = (LAS float*)(lds + 65536);
                LAS float* W2S = (LAS float*)(lds + 65536 + 8448);
                for (int u = bid; u < BATCH * 4 * 2 * 8; u += G) {
                    const int ch = u & 7, kv = (u >> 3) & 1, g = (u >> 4) & 3, b = u >> 6;
                    const int r = lane & 31, h = lane >> 5, n0 = ch * 32;
                    const bf16_t* xb0 = RAW + (size_t)(b * SEQ + 16 * (n0 + r)) * C_WP + (kv ? 1280 : 1024) + g * 64 + 8 * h;
                    const bf16_t* wt = W1T + (size_t)kv * 64 * 2048 + 8 * h;
                    f32x16 acc[2];
#pragma unroll
                    for (int i = 0; i < 16; ++i) { acc[0][i] = 0.f; acc[1][i] = 0.f; }
                    const bool rowok = (n0 + r) < 255;
                    float rsl[4];
#pragma unroll
                    for (int li = 0; li < 4; ++li) rsl[li] = rowok ? row_rstd(RSQ, b * SEQ + 16 * (n0 + r) + wave * 4 + li) : 0.f;
#pragma unroll
                    for (int li = 0; li < 4; ++li) { const int l = wave * 4 + li;
#pragma unroll
                        for (int s2 = 0; s2 < 4; ++s2) {
                            bf16x8 a = {0, 0, 0, 0, 0, 0, 0, 0};
                            if (rowok) { float f[8]; unpack8(*(const u32x4*)(xb0 + (size_t)l * C_WP + 16 * s2), f);
#pragma unroll
                                for (int j = 0; j < 8; ++j) f[j] *= rsl[li];
                                a = __builtin_bit_cast(bf16x8, pack8f(f)); }
                            const bf16x8 b0 = *(const bf16x8*)(wt + (size_t)r * 2048 + l * 64 + 16 * s2), b1 = *(const bf16x8*)(wt + (size_t)(32 + r) * 2048 + l * 64 + 16 * s2);
                            acc[0] = __builtin_amdgcn_mfma_f32_32x32x16_bf16(a, b0, acc[0], 0, 0, 0); acc[1] = __builtin_amdgcn_mfma_f32_32x32x16_bf16(a, b1, acc[1], 0, 0, 0); } }
                    __syncthreads();
#pragma unroll
                    for (int nh = 0; nh < 2; ++nh)
#pragma unroll
                        for (int i = 0; i < 16; ++i) PART[wave * 2048 + ((i & 3) + 8 * (i >> 2) + 4 * h) * 64 + nh * 32 + r] = acc[nh][i];
                    { const float* w2 = kv ? nsa_cmp_w2_v : nsa_cmp_w2_k; const f32x4 wa = *(const f32x4*)(w2 + tid * 4), wb = *(const f32x4*)(w2 + 2048 + tid * 4);
                      *(LAS f32x4*)(W2S + tid * 4) = wa; *(LAS f32x4*)(W2S + 2048 + tid * 4) = wb; }
                    __syncthreads();
                    const float pw1 = POSW1[kv * 64 + (tid & 63)];
                    for (int i = tid; i < 2048; i += 512) { float a = pw1;
#pragma unroll
                        for (int w = 0; w < 8; ++w) a += PART[w * 2048 + i];
                        HB[(i >> 6) * 65 + (i & 63)] = a / (1.0f + __expf(-a)); }
                    __syncthreads();
                    { const int n = tid >> 4, c4 = (tid & 15) * 4; float o[4] = {0.f, 0.f, 0.f, 0.f};
                        for (int c = 0; c < 64; ++c) { const float hv = HB[n * 65 + c]; const f32x4 w = *(const LAS f32x4*)(W2S + c * 64 + c4); o[0] += hv * w[0]; o[1] += hv * w[1]; o[2] += hv * w[2]; o[3] += hv * w[3]; }
                        if (kv == 0) { float ss = (o[0] * o[0] + o[1] * o[1]) + (o[2] * o[2] + o[3] * o[3]);
                            ss += __shfl_xor(ss, 1); ss += __shfl_xor(ss, 2); ss += __shfl_xor(ss, 4); ss += __shfl_xor(ss, 8);
                            const float rn = __builtin_amdgcn_rsqf(ss * (1.0f / 64.0f) + RMS_EPS);
#pragma unroll
                            for (int j = 0; j < 4; ++j) o[j] = o[j] * rn * nsa_kcmp_norm[c4 + j]; }
                        if (n0 + n >= 255) { o[0] = o[1] = o[2] = o[3] = 0.f; }
                        u32x2 w; w.x = pk2(o[0], o[1]); w.y = pk2(o[2], o[3]);
                        *(u32x2*)((kv ? VCMP : KCMP) + ((size_t)(b * 4 + g) * 256 + n0 + n) * 64 + c4) = w; }
                    __syncthreads();
                }
            }
            if (L == 1) SEAM(pb + 1);
        }
        if (RUN(pb + 2)) for (int rep_ = 0; rep_ < REPS(pb + 2); ++rep_) {
            int lane = (int)__builtin_amdgcn_mbcnt_hi(~0u, __builtin_amdgcn_mbcnt_lo(~0u, 0u)); asm volatile("" : "+v"(lane)); const int tid = wave * 64 + lane;
            if (L == 0 && rep_ == 0) {
                const int gw = bid * NWAVES + wave, NGW = G * NWAVES;
                for (int m = gw; m < MMEM; m += NGW) {
                    const float rs = MRS[m]; bf16_t* row = KVRAW + (size_t)m * 2048;
#pragma unroll
                    for (int st = 0; st < 4; ++st) {
                        u32x4 w = *(const u32x4*)(row + st * 512 + lane * 8); float f[8];
#pragma unroll
                        for (int j = 0; j < 4; ++j) { f[2 * j] = __builtin_bit_cast(float, w[j] << 16) * rs; f[2 * j + 1] = __builtin_bit_cast(float, w[j] & 0xffff0000u) * rs; }
                        if ((st & 1) == 0) {
                            float ss = 0.f;
#pragma unroll
                            for (int j = 0; j < 8; ++j) ss += f[j] * f[j];
                            ss += __shfl_xor(ss, 1); ss += __shfl_xor(ss, 2); ss += __shfl_xor(ss, 4); ss += __shfl_xor(ss, 8);
                            const float rn = __builtin_amdgcn_rsqf(ss * (1.0f / 128.0f) + RMS_EPS);
                            const float* gn = mem_k_norm + (st >> 1) * 128 + (lane & 15) * 8;
#pragma unroll
                            for (int j = 0; j < 8; ++j) f[j] = f[j] * rn * gn[j];
                        }
                        u32x4 o; o.x = pk2(f[0], f[1]); o.y = pk2(f[2], f[3]); o.z = pk2(f[4], f[5]); o.w = pk2(f[6], f[7]);
                        *(u32x4*)(row + st * 512 + lane * 8) = o;
                    }
                }
            }
            if (L == 0) {
                { const int gw = bid * NWAVES + wave, NGW = G * NWAVES;
                  for (int u = gw; u < BATCH * 8 * 16; u += NGW) { const int n = u & 15, hm = (u >> 4) & 7, b = u >> 7;
                      const bf16_t* kb = RAW + (size_t)(b * SEQ + 256 * n + (lane >> 3)) * AB_WP + 1472 + hm * 64 + (lane & 7) * 8; float a[8] = {0.f, 0.f, 0.f, 0.f, 0.f, 0.f, 0.f, 0.f};
                      for (int i0 = 0; i0 < 32; i0 += 8) { u32x4 rw[8];
#pragma unroll
                          for (int i = 0; i < 8; ++i) rw[i] = *(const u32x4*)(kb + (size_t)(8 * (i0 + i)) * AB_WP);
#pragma unroll
                          for (int i = 0; i < 8; ++i) { float f[8]; unpack8(rw[i], f);
#pragma unroll
                              for (int j = 0; j < 8; ++j) a[j] += f[j]; } }
#pragma unroll
                      for (int j = 0; j < 8; ++j) { a[j] += __shfl_xor(a[j], 8); a[j] += __shfl_xor(a[j], 16); a[j] += __shfl_xor(a[j], 32); }
                      if (lane < 8) { float* o = KMEAN + (size_t)u * 64 + lane * 8;
#pragma unroll
                          for (int j = 0; j < 8; ++j) o[j] = a[j] * (1.0f / 256.0f); } } }
                LAS float* SCL = (LAS float*)lds;
#if defined(PROBE_IDX) && PROBE_IDX == 2
                if (rep_ == 0)
#endif
                for (int ui = bid; ui < BATCH * 256; ui += G) {
                    const int rr = ui >> 8, pos = ui & 255; const int qi = 32 * rr + ((rr & 1) ? 31 - (pos >> 3) : (pos >> 3)), b = pos & 7;
                    const int t0 = qi * 16, tmax = t0 + 15, nchunk = (tmax >> 10) + 1, nreg = (tmax >> 6) + 1;
                    const int ql = lane & 15, kq = lane >> 4;
                    const size_t qrow = (size_t)b * SEQ + t0 + ql;
                    typedef float f32x4v __attribute__((ext_vector_type(4)));
                    bf16x8 qf[8];
#pragma unroll
                    for (int hi = 0; hi < 8; ++hi) qf[hi] = *(const bf16x8*)(RAW + qrow * AB_WP + 640 + hi * 32 + 8 * kq);
                    const f32x4 iw0 = *(const f32x4*)(IWB + qrow * 8), iw1 = *(const f32x4*)(IWB + qrow * 8 + 4);
                    unsigned uu[2][64];
#pragma unroll
                    for (int rg = 0; rg < 64; ++rg) { uu[0][rg] = 0u; uu[1][rg] = 0u; }
#pragma unroll
                    for (int c = 0; c < 4; ++c) if (c < nchunk) {
                        const int ntile = ((tmax - 1024 * c) >> 4) + 1 < 64 ? ((tmax - 1024 * c) >> 4) + 1 : 64;
                        __syncthreads();
                        const bf16_t* kfp = RAW + (size_t)(b * SEQ + 1024 * c + ql) * AB_WP + 896 + 8 * kq;
                        bf16x8 kfn = *(const bf16x8*)(kfp + (size_t)(16 * (wave < ntile ? wave : 0)) * AB_WP);
                        for (int tile = wave; tile < ntile; tile += 8) {
                            const bf16x8 kf = kfn; { const int tn = tile + 8 < ntile ? tile + 8 : tile; kfn = *(const bf16x8*)(kfp + (size_t)(16 * tn) * AB_WP); }
                            f32x4v sc = {0.f, 0.f, 0.f, 0.f};
#pragma unroll
                            for (int hi = 0; hi < 8; ++hi) { f32x4v x = {0.f, 0.f, 0.f, 0.f}; x = __builtin_amdgcn_mfma_f32_16x16x32_bf16(kf, qf[hi], x, 0, 0, 0);
                                const float sf = hi < 4 ? iw0[hi & 3] : iw1[hi & 3];
#pragma unroll
                                for (int i = 0; i < 4; ++i) { const float xv_ = x[i]; const int xb_ = __float_as_int(xv_); sc[i] += sf * __int_as_float(xb_ > 0 ? xb_ : 0); } }
                            *(LAS f32x4v*)(SCL + ql * 1028 + 16 * tile + 4 * kq) = sc;
                        }
                        __syncthreads();
#pragma unroll
                        for (int qq = 0; qq < 2; ++qq) { const int t = t0 + 2 * wave + qq;
#pragma unroll
                            for (int rl = 0; rl < 16; ++rl) { const int key = 1024 * c + 64 * rl + lane; const unsigned bits = __builtin_bit_cast(unsigned, SCL[(2 * wave + qq) * 1028 + 64 * rl + lane]);
                                const unsigned mono = bits ^ ((bits >> 31) ? 0xffffffffu : 0x80000000u); uu[qq][16 * c + rl] = (key <= t) ? mono : 0u; } }
                    }
#if defined(PROBE_IDX) && PROBE_IDX == 1
                    if (rep_) { if (uu[0][3] == 12345u && uu[1][40] == 777u) BMK[0] = 1ull; continue; }
#endif
                    int lb = lane; asm volatile("" : "+v"(lb));
                    unsigned long long word[2] = {0ull, 0ull};
                    unsigned T[2] = {0u, 0u}; bool done[2], exact[2] = {false, false};
                    done[0] = (t0 + 2 * wave) < 256; done[1] = (t0 + 2 * wave + 1) < 256;
                    for (int bit = 31; bit >= 0 && !(done[0] && done[1]); --bit) {
                        const unsigned c0 = T[0] | (1u << bit), c1 = T[1] | (1u << bit); int n0 = 0, n1 = 0;
#pragma unroll
                        for (int ch = 0; ch < 4; ++ch) if (16 * ch < nreg) {
#pragma unroll
                            for (int dummy_ = 0; dummy_ < 1; ++dummy_) { n0 = cnt_ge16(&uu[0][16 * ch], c0, n0); n1 = cnt_ge16(&uu[1][16 * ch], c1, n1); } }
                        const int s0 = wave_sum_i(n0), s1 = wave_sum_i(n1);
                        if (!done[0]) { if (s0 >= 256) T[0] = c0; if (s0 == 256) { done[0] = true; exact[0] = true; } }
                        if (!done[1]) { if (s1 >= 256) T[1] = c1; if (s1 == 256) { done[1] = true; exact[1] = true; } }
                    }
#pragma unroll
                    for (int qq = 0; qq < 2; ++qq) { const int t = t0 + 2 * wave + qq; unsigned long long myword = 0ull;
                        if (t < 256) {
#pragma unroll
                            for (int rg = 0; rg < 4; ++rg) { const unsigned long long w = __ballot(64 * rg + lb <= t); if (lb == rg) myword = w; }
                        } else if (exact[qq]) {
#pragma unroll
                            for (int rg = 0; rg < 64; ++rg) { const unsigned long long w = __ballot(uu[qq][rg] >= T[qq]); if (lb == rg) myword = w; __builtin_amdgcn_sched_barrier(0); }
                        } else {
                            int cg = 0;
#pragma unroll
                            for (int rg = 0; rg < 64; ++rg) cg = cnt_ge(uu[qq][rg], T[qq] + 1u, cg);
                            int need = 256 - wave_sum_i(cg);
#pragma unroll
                            for (int rg = 0; rg < 64; ++rg) {
                                unsigned long long w = __ballot(uu[qq][rg] > T[qq]), eq = __ballot(uu[qq][rg] == T[qq]); const int ne = __builtin_popcountll(eq);
                                if (ne <= need) { w |= eq; need -= ne; } else { while (need > 0) { const unsigned long long low = eq & (0ull - eq); w |= low; eq ^= low; --need; } }
                                if (lb == rg) myword = w; __builtin_amdgcn_sched_barrier(0); }
                        }
                        BMK[((size_t)(b * 128 + (t >> 5)) * 64 + lb) * 32 + (t & 31)] = myword;
                    }
                }
            }
            if (L == 0) SEAM(pb + 2);
        }
        if (RUN(pb + 3)) for (int rep_ = 0; rep_ < REPS(pb + 3); ++rep_) {
            int lane = (int)__builtin_amdgcn_mbcnt_hi(~0u, __builtin_amdgcn_mbcnt_lo(~0u, 0u)); asm volatile("" : "+v"(lane)); const int tid = wave * 64 + lane;
            if (L == 0) {
                const float shiftA = att::softmax_shift(att::gain_max64(dsa_q_norm), att::gain_max64(dsa_k_norm)), shiftB = att::softmax_shift(att::gain_max64(moba_q_norm), att::gain_max64(moba_k_norm));
                for (int ui = bid; ui < BATCH * 128; ui += G) {
                    const int rr = ui >> 8, pos = ui & 255; const int qt = 32 * rr + ((rr & 1) ? 31 - (pos >> 3) : (pos >> 3)), b = pos & 7;
                    const int r = lane & 31, h = lane >> 5; const size_t row = (size_t)b * SEQ + qt * 32 + r;
                    bf16x8 qf[4];
                    { const bf16_t* qrow = RAW + row * AB_WP + wave * 64 + 8 * h;
#pragma unroll
                      for (int s2 = 0; s2 < 4; ++s2) qf[s2] = *(const bf16x8*)(qrow + 16 * s2); }
                    f32x16 oo[2]; float ll = 0.f;
#pragma unroll
                    for (int i = 0; i < 16; ++i) { oo[0][i] = 0.f; oo[1][i] = 0.f; }
                    const bf16_t* kbase = RAW + (size_t)b * SEQ * AB_WP + 512; const unsigned long long* bm = BMK + (size_t)(b * 128 + qt) * 64 * 32;
                    const att::LpOff lpo = att::lp_offsets(lane, wave, AB_WP * 2);
                    LAS unsigned char* MSL = lds + 8 * att::DBUF;
{ auto go_ = [&](auto hs_) { constexpr bool HS = decltype(hs_)::value;
#if AB_L0
                    att::kv_pipeline_ab<1>(lds, (qt >> 1) + 1, wave, lane, qf, oo,
                        [&](int tt, const bf16_t*& kb, size_t& kp, const bf16_t*& vb, size_t& vp) { kb = kbase + (size_t)(64 * tt) * AB_WP; kp = AB_WP; vb = kb + 64; vp = AB_WP; },
                        [&](int tt, const f32x16 (&p)[2], u32x4 (&pw)[4], int slot) {
                            const unsigned long long w = *(const LAS unsigned long long*)(MSL + (slot * 8 + wave) * 256 + r * 8) >> (4 * h);
                            att::half_v<2, HS>(pw, ll, p, true, shiftA, [](int) { return true; }, (unsigned)w, (unsigned)(w >> 32)); },
                        [&](int tt, int slot) { __builtin_amdgcn_global_load_lds((const unsigned*)(bm + (size_t)tt * 32) + lane, (LAS unsigned*)(MSL + (slot * 8 + wave) * 256), 4, 0, 0); });
#else
                    att::kv_pipeline_dma8<0>(lds, (qt >> 1) + 1, wave, lane, qf, lpo,
                        [&](int tt, const bf16_t*& kb, size_t& kp, const bf16_t*& vb, size_t& vp) { kb = kbase + (size_t)(64 * tt) * AB_WP; kp = AB_WP; vb = kb + 64; vp = AB_WP; },
                        [&](int tt, f32x16 (&p)[2], const LAS unsigned char* buf, const LAS unsigned char* nbuf, f32x16 (&pn)[2], int slot) {
                            const unsigned long long w = *(const LAS unsigned long long*)(MSL + slot * 256 + r * 8) >> (4 * h);
#if defined(PROBE_SKEL) && PROBE_SKEL == 2
                            if (rep_ == 0)
#endif
                            att::fused_e<2, HS, LP_L0>(oo, ll, p, buf, lane, true, shiftA, [](int) { return true; }, (unsigned)w, (unsigned)(w >> 32), qf, nbuf, pn, lpo); },
                        [&](int tt, int slot) { if ((tt & 7) == wave) __builtin_amdgcn_global_load_lds((const unsigned*)(bm + (size_t)tt * 32) + lane, (LAS unsigned*)(MSL + slot * 256), 4, 0, 0); });
#endif
 }; if (shiftA == 0.f) go_(std::false_type{}); else go_(std::true_type{}); }
                    const float lt = ll + __shfl_xor(ll, 32);
#if defined(PROBE_SKEL) && PROBE_SKEL == 2
                    if (rep_ == 0)
#endif
                    att::store_o_t<64>(oo, lt > 0.f ? 1.0f / lt : 0.f, OATT + ((size_t)b * SEQ + qt * 32) * 1024 + wave * 64, 1024, lds + wave * 4608, lane);
                }
                LAS unsigned* UNI = (LAS unsigned*)(lds + 8 * att::DBUF); LAS int* TL = (LAS int*)(lds + 8 * att::DBUF + 16); LAS float* KMS = (LAS float*)(lds + 8 * att::DBUF + 256);
#if defined(PROBE_SKEL)
                if (rep_ == 0)
#endif
                for (int ui = bid; ui < BATCH * 8 * 16; ui += G) {
                    const int rr = ui >> 8, pos = ui & 255; const int xk = pos >> 3, cmb = rr * 16 + (pos & 7) * 2 + (xk >> 4);
                    const int own = (rr & 1) ? 15 - (xk & 15) : (xk & 15), b = cmb >> 3, hm = cmb & 7;
                    const int r = lane & 31, h = lane >> 5; const int tl = wave * 32 + r; const size_t row = (size_t)b * SEQ + own * 256 + tl;
                    bf16x8 qf[4];
                    { const bf16_t* qrow = RAW + row * AB_WP + 960 + hm * 64 + 8 * h;
#pragma unroll
                      for (int s2 = 0; s2 < 4; ++s2) qf[s2] = *(const bf16x8*)(qrow + 16 * s2); }
                    if (tid == 0) UNI[0] = 0u;
                    { const f32x2 kmv = *(const f32x2*)(KMEAN + (size_t)(b * 8 + hm) * 1024 + tid * 2); *(LAS f32x2*)(KMS + tid * 2) = kmv; }
                    __syncthreads();
                    unsigned msk = 0u;
                    { float b0 = att::NEG_INF, b1 = att::NEG_INF, b2 = att::NEG_INF; int i0 = -1, i1 = -1, i2 = -1;
                      float qv[32];
#pragma unroll
                      for (int s2 = 0; s2 < 4; ++s2) { float f[8]; unpack8(__builtin_bit_cast(u32x4, qf[s2]), f);
#pragma unroll
                          for (int j = 0; j < 8; ++j) qv[8 * s2 + j] = f[j]; }
                      for (int n = 0; n < own; ++n) { const LAS float* km = KMS + n * 64 + 8 * h; float a = 0.f;
#pragma unroll
                          for (int s2 = 0; s2 < 4; ++s2) { const f32x4 k0 = *(const LAS f32x4*)(km + 16 * s2), k1 = *(const LAS f32x4*)(km + 16 * s2 + 4);
                              a += qv[8 * s2] * k0[0] + qv[8 * s2 + 1] * k0[1] + qv[8 * s2 + 2] * k0[2] + qv[8 * s2 + 3] * k0[3] + qv[8 * s2 + 4] * k1[0] + qv[8 * s2 + 5] * k1[1] + qv[8 * s2 + 6] * k1[2] + qv[8 * s2 + 7] * k1[3]; }
                          a += __shfl_xor(a, 32);
                          if (a > b0) { b2 = b1; i2 = i1; b1 = b0; i1 = i0; b0 = a; i0 = n; } else if (a > b1) { b2 = b1; i2 = i1; b1 = a; i1 = n; } else if (a > b2) { b2 = a; i2 = n; } }
                      if (i0 >= 0) msk |= 1u << i0; if (i1 >= 0) msk |= 1u << i1; if (i2 >= 0) msk |= 1u << i2; }
                    { unsigned um = msk;
#pragma unroll
                      for (int o = 1; o < 64; o <<= 1) um |= __shfl_xor(um, o);
                      if (lane == 0) __hip_atomic_fetch_or(UNI, um, __ATOMIC_RELAXED, __HIP_MEMORY_SCOPE_WORKGROUP); }
                    __syncthreads();
                    const unsigned U = (unsigned)__builtin_amdgcn_readfirstlane((int)UNI[0]);
                    const int npast = __builtin_popcount(U);
                    if (wave == 0 && lane < 16 && ((U >> lane) & 1u)) TL[__builtin_amdgcn_mbcnt_lo(U, 0u)] = lane;
                    f32x16 oo[2]; float ll = 0.f;
#pragma unroll
                    for (int i = 0; i < 16; ++i) { oo[0][i] = 0.f; oo[1][i] = 0.f; }
                    const bf16_t* kbase = RAW + (size_t)b * SEQ * AB_WP + 1472 + hm * 64;
                    const att::LpOff lpo = att::lp_offsets(lane, wave, AB_WP * 2);
                    __syncthreads();
{ auto go_ = [&](auto hs_) { constexpr bool HS = decltype(hs_)::value;
#if AB_L0
                    att::kv_pipeline_ab<0>(lds, 4 * npast + 4, wave, lane, qf, oo,
                        [&](int tt, const bf16_t*& kb, size_t& kp, const bf16_t*& vb, size_t& vp) {
                            const int blk = (tt < 4 * npast) ? __builtin_amdgcn_readfirstlane(TL[tt >> 2]) : own, sub = (tt < 4 * npast) ? (tt & 3) : tt - 4 * npast;
                            kb = kbase + (size_t)(256 * blk + 64 * sub) * AB_WP; kp = AB_WP; vb = kb + 512; vp = AB_WP; },
                        [&](int tt, const f32x16 (&p)[2], u32x4 (&pw)[4], int) {
                            if (tt < 4 * npast) { const int blk = __builtin_amdgcn_readfirstlane(TL[tt >> 2]); const bool sel = (msk >> blk) & 1u;
                                att::half_v<0, HS>(pw, ll, p, sel, shiftB, [](int) { return true; }, 0u, 0u); }
                            else { const int sub = tt - 4 * npast; const int lim = tl - 64 * sub - 4 * h;
                                att::half_v<1, HS>(pw, ll, p, true, shiftB, [&](int koff) { return koff <= lim; }, 0u, 0u); } },
                        att::NoXtra());
#else
                    att::kv_pipeline_dma8<0>(lds, 4 * npast + 4, wave, lane, qf, lpo,
                        [&](int tt, const bf16_t*& kb, size_t& kp, const bf16_t*& vb, size_t& vp) {
                            const int blk = (tt < 4 * npast) ? __builtin_amdgcn_readfirstlane(TL[tt >> 2]) : own, sub = (tt < 4 * npast) ? (tt & 3) : tt - 4 * npast;
                            kb = kbase + (size_t)(256 * blk + 64 * sub) * AB_WP; kp = AB_WP; vb = kb + 512; vp = AB_WP; },
                        [&](int tt, f32x16 (&p)[2], const LAS unsigned char* buf, const LAS unsigned char* nbuf, f32x16 (&pn)[2], int) {
                            if (tt < 4 * npast) { const int blk = __builtin_amdgcn_readfirstlane(TL[tt >> 2]); const bool sel = (msk >> blk) & 1u;
                                att::fused_e<0, HS, LP_L0>(oo, ll, p, buf, lane, sel, shiftB, [](int) { return true; }, 0u, 0u, qf, nbuf, pn, lpo); }
                            else { const int sub = tt - 4 * npast; const int lim = tl - 64 * sub - 4 * h;
                                att::fused_e<1, HS, LP_L0>(oo, ll, p, buf, lane, true, shiftB, [&](int koff) { return koff <= lim; }, 0u, 0u, qf, nbuf, pn, lpo); } },
                        att::NoXtra());
#endif
 }; if (shiftB == 0.f) go_(std::false_type{}); else go_(std::true_type{}); }
                    const float lt = ll + __shfl_xor(ll, 32);
                    att::store_o_t<64>(oo, lt > 0.f ? 1.0f / lt : 0.f, OATT + ((size_t)b * SEQ + own * 256 + wave * 32) * 1024 + 512 + hm * 64, 1024, lds + wave * 4608, lane);
                    __syncthreads();
                }
            }
            if (L == 1) {
                const float shiftS = att::softmax_shift(att::gain_max64(nsa_q_norm), att::gain_max64(nsa_ksel_norm)), shiftW = att::softmax_shift(att::gain_max64(nsa_q_norm), att::gain_max64(nsa_kwin_norm));
                LAS unsigned* IMP = (LAS unsigned*)(lds + 86016);
                LAS unsigned long long* SELM = (LAS unsigned long long*)(lds + 4 * att::DBUF); LAS int* TL = (LAS int*)(lds + 4 * att::DBUF + 528);
                for (int ui = bid; ui < BATCH * 4 * 64; ui += G) {
                    const int rr = ui >> 8, pos = ui & 255;
                    const int pr = (pos & 7) * 4 + (rr >> 1), xk = pos >> 3, qt = (rr & 1) ? 63 - xk : xk, b = pr >> 2, g = pr & 3;
                    const int r = lane & 31, h = lane >> 5, j = wave & 3, qs = wave >> 2, hd = g * 4 + j;
                    const int t = qt * 64 + qs * 32 + r, ql = qs * 32 + r; const size_t row = (size_t)b * SEQ + t;
                    bf16x8 qf[4];
                    { const bf16_t* qrow = RAW + row * C_WP + hd * 64 + 8 * h;
#pragma unroll
                      for (int s2 = 0; s2 < 4; ++s2) qf[s2] = *(const bf16x8*)(qrow + 16 * s2); }
                    for (int i = tid; i < ((qt >> 4) + 1) * 64 * 64 / 4; i += 512) ((LAS u32x4*)IMP)[i] = (u32x4){0u, 0u, 0u, 0u};
                    f32x16 oacc[2];
                    const float* gt = GT + row * 48 + hd * 3; const float g0 = gt[0];
                    const int nvalid = t >= 31 ? ((t - 31) >> 4) + 1 : 0;
                    const int ntc = (qt >> 4) + 1;
                    { const bf16_t* kcb = KCMP + (size_t)(b * 4 + g) * 256 * 64; const bf16_t* vcb = VCMP + (size_t)(b * 4 + g) * 256 * 64;
                      for (int idx = tid; idx < 64 * 8 * ntc; idx += 512) { const int rw = idx >> 3, c = idx & 7;
                          *(LAS u32x4*)(lds + rw * 144 + c * 16) = *(const u32x4*)(kcb + rw * 64 + c * 8);
                          *(LAS u32x4*)(lds + 36864 + rw * 192 + c * 16) = *(const u32x4*)(vcb + rw * 64 + c * 8); } }
                    __syncthreads();
                    float mc = att::NEG_INF, lc = 0.f;
#pragma unroll 1
                    for (int tt = 0; tt < ntc; ++tt) {
                        f32x16 p[2]; att::tile_scores<64>(p, qf, lds + tt * 9216, lane); const int lim = nvalid - 64 * tt - 4 * h; float mx = att::NEG_INF;
#pragma unroll
                        for (int kt = 0; kt < 2; ++kt)
#pragma unroll
                            for (int i = 0; i < 16; ++i) { const int koff = 32 * kt + (i & 3) + 8 * (i >> 2); const float v = (koff < lim) ? p[kt][i] : att::NEG_INF; p[kt][i] = v; mx = fmaxf(mx, v); }
                        mx = fmaxf(mx, __shfl_xor(mx, 32));
                        const float mnew = fmaxf(mc, mx), muse = (mnew == att::NEG_INF) ? 0.f : mnew; float ls = 0.f;
#pragma unroll
                        for (int kt = 0; kt < 2; ++kt)
#pragma unroll
                            for (int i = 0; i < 16; ++i) ls += __builtin_amdgcn_exp2f(p[kt][i] - muse);
                        lc = lc * __builtin_amdgcn_exp2f(mc - muse) + ls; mc = mnew; }
                    lc += __shfl_xor(lc, 32);
                    const float invl = lc > 0.f ? 1.0f / lc : 0.f, mcu = (mc == att::NEG_INF) ? 0.f : mc;
#pragma unroll
                    for (int i = 0; i < 16; ++i) { oacc[0][i] = 0.f; oacc[1][i] = 0.f; }
#pragma unroll 1
                    for (int tt = 0; tt < ntc; ++tt) {
                        f32x16 p[2]; att::tile_scores<64>(p, qf, lds + tt * 9216, lane); const int lim = nvalid - 64 * tt - 4 * h;
#pragma unroll
                        for (int kt = 0; kt < 2; ++kt)
#pragma unroll
                            for (int i = 0; i < 16; ++i) { const int koff = 32 * kt + (i & 3) + 8 * (i >> 2); const float pv = (koff < lim) ? __builtin_amdgcn_exp2f(p[kt][i] - mcu) * invl : 0.f; p[kt][i] = pv;
                                __hip_atomic_fetch_add(IMP + (64 * tt + koff + 4 * h) * 64 + ql, (unsigned)(pv * 134217728.0f + 0.5f), __ATOMIC_RELAXED, __HIP_MEMORY_SCOPE_WORKGROUP);
                                if ((i & 3) == 3) __builtin_amdgcn_sched_barrier(0); }
                        __builtin_amdgcn_sched_barrier(0);
                        att::tile_pv<64>(oacc, p, lds + 36864 + tt * 12288 - 9216, lane); }
#pragma unroll
                    for (int i = 0; i < 16; ++i) { oacc[0][i] *= g0; oacc[1][i] *= g0; }
                    LAS float* STASH = (LAS float*)IMP + wave * 2048 + lane;
                    __syncthreads();
                    {
                        int l2 = lane; asm volatile("" : "+v"(l2));
                        const int qq = l2 >> 3, seg = l2 & 7, q = wave * 8 + qq, cur = qt;
                        unsigned key[8];
#pragma unroll
                        for (int k = 0; k < 8; ++k) { const int sb = 8 * seg + k; unsigned v = 0u;
#pragma unroll
                            for (int dn = -1; dn <= 3; ++dn) { const int n = 4 * sb + dn; if (n >= 0 && n < 255) v += IMP[n * 64 + q]; }
                            const bool forced = (sb == 0) || (sb == cur) || (sb == cur - 1);
                            key[k] = (sb <= cur) ? ((forced ? 0xffffff80u : ((v >> 7) << 7)) | (unsigned)(64 - sb)) : 0u; __builtin_amdgcn_sched_barrier(0); }
                        unsigned T = 0u;
                        for (int bit = 31; bit >= 0; --bit) { const unsigned cand = T | (1u << bit); int c = 0;
#pragma unroll
                            for (int k = 0; k < 8; ++k) c += (key[k] >= cand) ? 1 : 0;
                            c += __builtin_amdgcn_update_dpp(0, c, 0xB1, 0xf, 0xf, false);
                            c += __builtin_amdgcn_update_dpp(0, c, 0x4E, 0xf, 0xf, false);
                            c += __builtin_amdgcn_update_dpp(0, c, 0x141, 0xf, 0xf, false);
                            if (c >= 16) T = cand; }
                        unsigned byte = 0u;
#pragma unroll
                        for (int k = 0; k < 8; ++k) byte |= (key[k] != 0u && key[k] >= T) ? (1u << k) : 0u;
                        ((LAS unsigned char*)SELM)[q * 8 + seg] = (unsigned char)byte;
                    }
                    __syncthreads();
#pragma unroll
                    for (int i = 0; i < 16; ++i) { STASH[i * 64] = oacc[0][i]; STASH[(16 + i) * 64] = oacc[1][i]; }
                    { float own[8], oth[8]; const float* cs = ROPE64 + row * 16; u32x4 w = __builtin_bit_cast(u32x4, qf[0]); unpack8(w, own);
#pragma unroll
                      for (int jj = 0; jj < 8; ++jj) oth[jj] = __shfl_xor(own[jj], 32);
#pragma unroll
                      for (int jj = 0; jj < 8; ++jj) own[jj] = h ? own[jj] * cs[jj] + oth[jj] * cs[8 + jj] : own[jj] * cs[jj] - oth[jj] * cs[8 + jj];
                      qf[0] = __builtin_bit_cast(bf16x8, pack8f(own)); }
                    const att::LpOff lpo = att::lp_offsets(lane, wave, C_WP * 2);
                    {
                        const unsigned long long mymask = SELM[ql]; const unsigned long long un0 = SELM[lane];
                        unsigned ul = (unsigned)un0, uh = (unsigned)(un0 >> 32);
#pragma unroll
                        for (int o = 1; o < 64; o <<= 1) { ul |= __shfl_xor(ul, o); uh |= __shfl_xor(uh, o); }
                        const unsigned ulo = (unsigned)__builtin_amdgcn_readfirstlane((int)ul), uhi = (unsigned)__builtin_amdgcn_readfirstlane((int)uh);
                        const unsigned long long U = ((unsigned long long)uhi << 32) | ulo;
                        if (wave == 0 && ((U >> lane) & 1ull)) TL[__builtin_amdgcn_mbcnt_hi(uhi, __builtin_amdgcn_mbcnt_lo(ulo, 0u))] = lane;
                        f32x16 oo[2]; float ll = 0.f;
#pragma unroll
                        for (int i = 0; i < 16; ++i) { oo[0][i] = 0.f; oo[1][i] = 0.f; }
                        const bf16_t* kbase = RAW + (size_t)b * SEQ * C_WP + 1536 + g * 64;
                        __syncthreads();
{ auto go_ = [&](auto hs_) { constexpr bool HS = decltype(hs_)::value;
                        att::kv_pipeline_dma2<0>(lds, __builtin_popcountll(U), wave, lane, qf, lpo,
                            [&](int tt, const bf16_t*& kb, size_t& kp, const bf16_t*& vb, size_t& vp) { const int sblk = __builtin_amdgcn_readfirstlane(TL[tt]); kb = kbase + (size_t)(64 * sblk) * C_WP; kp = C_WP; vb = kb + 256; vp = C_WP; },
                            [&](int tt, f32x16 (&p)[2], const LAS unsigned char* buf, const LAS unsigned char* nbuf, f32x16 (&pn)[2], int) { const int sblk = __builtin_amdgcn_readfirstlane(TL[tt]);
                                const bool sel = (mymask >> sblk) & 1ull; const int lim = t - 64 * sblk - 4 * h;
                                if (sblk == qt) att::fused_e<1, HS, LP_NSA>(oo, ll, p, buf, lane, sel, shiftS, [&](int koff) { return koff <= lim; }, 0u, 0u, qf, nbuf, pn, lpo);
                                else att::fused_e<0, HS, LP_NSA>(oo, ll, p, buf, lane, sel, shiftS, [](int) { return true; }, 0u, 0u, qf, nbuf, pn, lpo); },
                            att::NoXtra());
 }; if (shiftS == 0.f) go_(std::false_type{}); else go_(std::true_type{}); }
                        const float lt = ll + __shfl_xor(ll, 32); const float f = lt > 0.f ? GT[row * 48 + hd * 3 + 1] / lt : 0.f;
#pragma unroll
                        for (int i = 0; i < 16; ++i) { STASH[i * 64] += oo[0][i] * f; STASH[(16 + i) * 64] += oo[1][i] * f; }
                    }
                    {
                        const int tw0 = qt >= 8 ? qt - 8 : 0, ntw = qt - tw0 + 1;
                        f32x16 oo[2]; float ll = 0.f;
#pragma unroll
                        for (int i = 0; i < 16; ++i) { oo[0][i] = 0.f; oo[1][i] = 0.f; }
                        const bf16_t* kbase = RAW + (size_t)b * SEQ * C_WP + 2048 + g * 64;
{ auto go_ = [&](auto hs_) { constexpr bool HS = decltype(hs_)::value;
                        att::kv_pipeline_dma2<0>(lds, ntw, wave, lane, qf, lpo,
                            [&](int tt, const bf16_t*& kb, size_t& kp, const bf16_t*& vb, size_t& vp) { kb = kbase + (size_t)(64 * (tw0 + tt)) * C_WP; kp = C_WP; vb = kb + 256; vp = C_WP; },
                            [&](int tt, f32x16 (&p)[2], const LAS unsigned char* buf, const LAS unsigned char* nbuf, f32x16 (&pn)[2], int) { const int tw = tw0 + tt; const int d0 = t - 64 * tw - 4 * h;
                                if (tw == qt || (qt >= 8 && tw == qt - 8)) att::fused_e<1, HS, LP_NSA>(oo, ll, p, buf, lane, true, shiftW, [&](int koff) { const int dist = d0 - koff; return dist >= 0 && dist < 512; }, 0u, 0u, qf, nbuf, pn, lpo);
                                else att::fused_e<0, HS, LP_NSA>(oo, ll, p, buf, lane, true, shiftW, [](int) { return true; }, 0u, 0u, qf, nbuf, pn, lpo); },
                            att::NoXtra());
 }; if (shiftW == 0.f) go_(std::false_type{}); else go_(std::true_type{}); }
                        const float lt = ll + __shfl_xor(ll, 32); const float f = lt > 0.f ? GT[row * 48 + hd * 3 + 2] / lt : 0.f;
#pragma unroll
                        for (int i = 0; i < 16; ++i) { oo[0][i] = STASH[i * 64] + oo[0][i] * f; oo[1][i] = STASH[(16 + i) * 64] + oo[1][i] * f; }
#if defined(PROBE_NSA)
                        if (rep_ == 0)
#endif
                        att::store_o_t<64>(oo, 1.0f, OATT + ((size_t)b * SEQ + qt * 64 + qs * 32) * 1024 + hd * 64, 1024, lds + wave * 4608, lane);
                    }
                    __syncthreads();
                }
            }
            SEAM(pb + 3);
        }
        if (RUN(pb + 4)) for (int rep_ = 0; rep_ < REPS(pb + 4); ++rep_) {
            int lane = (int)__builtin_amdgcn_mbcnt_hi(~0u, __builtin_amdgcn_mbcnt_lo(~0u, 0u)); asm volatile("" : "+v"(lane)); const int tid = wave * 64 + lane;
            if (L == 0) {
                pg8::Gemm g{OATT, W_ABO, MTOK, DM, DM}; pg8::StaticOrder S; S.init(MTOK, DM, G, bid);
                pg8::EpiResid<false> E{out, XB, RSQ};
                pg8::gemm_phase<pg8::EpiResid<false>, pg8::StaticOrder, true, true>(lds, g, S, E, wave);
            }
            if (L == 1) {
                pg8::Gemm g{OATT, W_CO, MTOK, DM, DM}; pg8::StaticOrder S; S.init(MTOK, DM, G, bid);
                pg8::EpiResid<false> E{out, XB, RSQ};
                pg8::gemm_phase<pg8::EpiResid<false>, pg8::StaticOrder, true, true>(lds, g, S, E, wave);
            }
            SEAM(pb + 4);
        }
        if (RUN(pb + 5)) for (int rep_ = 0; rep_ < REPS(pb + 5); ++rep_) {
            int lane = (int)__builtin_amdgcn_mbcnt_hi(~0u, __builtin_amdgcn_mbcnt_lo(~0u, 0u)); asm volatile("" : "+v"(lane)); const int tid = wave * 64 + lane;
            pg8::Gemm g{XB, W_MQ + (size_t)L * 512 * DM, MTOK, 512, DM}; pg8::StaticOrder S; S.init(MTOK, 512, G, bid);
            pg8::EpiPlain E{MQB, 512};
            pg8::gemm_phase<pg8::EpiPlain, pg8::StaticOrder, true, true>(lds, g, S, E, wave);
            SEAM(pb + 5);
        }
        if (RUN(pb + 6)) for (int rep_ = 0; rep_ < REPS(pb + 6); ++rep_) {
            int lane = (int)__builtin_amdgcn_mbcnt_hi(~0u, __builtin_amdgcn_mbcnt_lo(~0u, 0u)); asm volatile("" : "+v"(lane)); const int tid = wave * 64 + lane;
            const float shiftM = [&] { float gq = 0.f, gk = 0.f; for (int i = 0; i < 128; ++i) { gq = fmaxf(gq, fabsf(mem_q_norm[L * 128 + i])); gk = fmaxf(gk, fabsf(mem_k_norm[L * 128 + i])); }
                                       const float B = 11.3137085f * LOG2E * gq * gk * 1.02f; return B > 60.f ? B - 60.f : 0.f; }();
            const int upb = (512 % G == 0) ? 512 / G : 0; int cur_pair = -1;
            for (int k = 0; ; ++k) {
                const int u = upb ? bid * upb + k : bid + k * G; if ((upb && k >= upb) || u >= BATCH * 4 * 16) break;
                const int b = u >> 6, hh = (u >> 4) & 3, qb = u & 15;
                const int r = lane & 31, h = lane >> 5;
                const int row = b * SEQ + qb * 256 + wave * 32 + r;
                if ((u >> 4) != cur_pair) { cur_pair = u >> 4;
                    __syncthreads();
                    const bf16_t* kbase = KVRAW + (size_t)(b * NMEM) * 2048 + L * 1024 + hh * 128;
#pragma unroll
                    for (int i = 0; i < 8; ++i) { const int idx = tid + 512 * i, rw = idx >> 4, c = idx & 15;
                        *(LAS u32x4*)(lds + rw * 272 + c * 16) = *(const u32x4*)(kbase + (size_t)rw * 2048 + c * 8);
                        *(LAS u32x4*)(lds + 69632 + rw * 320 + c * 16) = *(const u32x4*)(kbase + (size_t)rw * 2048 + 512 + c * 8); }
                    __syncthreads(); }
                const float rs = row_rstd(RSQ, row);
                bf16x8 qf[8]; float ssq = 0.f;
                const bf16_t* qrow = MQB + (size_t)row * 512 + hh * 128 + 8 * h;
#pragma unroll
                for (int s2 = 0; s2 < 8; ++s2) { qf[s2] = *(const bf16x8*)(qrow + 16 * s2);
#pragma unroll
                    for (int j = 0; j < 8; ++j) { const float f = bf2f((unsigned short)qf[s2][j]) * rs; ssq += f * f; } }
                ssq += __shfl_xor(ssq, 32);
                const float qs = rs * __builtin_amdgcn_rsqf(ssq * (1.0f / 128.0f) + RMS_EPS) * (0.08838834764831845f * LOG2E);
#pragma unroll
                for (int s2 = 0; s2 < 8; ++s2) { const float* gn = mem_q_norm + L * 128 + 16 * s2 + 8 * h; const f32x4 ga = *(const f32x4*)gn, gb = *(const f32x4*)(gn + 4); u32x4 w;
#pragma unroll
                    for (int j = 0; j < 4; ++j) { const float g0_ = j < 2 ? ga[2 * j] : gb[2 * j - 4], g1_ = j < 2 ? ga[2 * j + 1] : gb[2 * j - 3];
                        w[j] = pk2(bf2f((unsigned short)qf[s2][2 * j]) * qs * g0_, bf2f((unsigned short)qf[s2][2 * j + 1]) * qs * g1_); }
                    qf[s2] = __builtin_bit_cast(bf16x8, w); }
                f32x16 oo[4]; float ll = 0.f;
#pragma unroll
                for (int d = 0; d < 4; ++d)
#pragma unroll
                    for (int i = 0; i < 16; ++i) oo[d][i] = 0.f;
#pragma unroll 1
                for (int tt = 0; tt < 4; ++tt) {
                    f32x16 p[2]; att::tile_scores<128>(p, qf, lds + tt * 64 * 272, lane);
                    float ls = 0.f;
#pragma unroll
                    for (int kt = 0; kt < 2; ++kt)
#pragma unroll
                        for (int i = 0; i < 16; ++i) { const float e = __builtin_amdgcn_exp2f(p[kt][i] - shiftM); p[kt][i] = e; ls += e; }
                    ll += ls;
                    att::tile_pv<128>(oo, p, lds + 69632 + tt * 64 * 320 - att::Geo<128>::KB, lane); }
                const float lt = ll + __shfl_xor(ll, 32);
                att::store_o<128>(oo, 1.0f / lt, OMEM + (size_t)row * 512 + hh * 128, lane);
            }
            SEAM(pb + 6);
        }
        if (RUN(pb + 7)) for (int rep_ = 0; rep_ < REPS(pb + 7); ++rep_) {
            int lane = (int)__builtin_amdgcn_mbcnt_hi(~0u, __builtin_amdgcn_mbcnt_lo(~0u, 0u)); asm volatile("" : "+v"(lane)); const int tid = wave * 64 + lane;
            pg8::Gemm g{OMEM, W_MO + (size_t)L * DM * 512, MTOK, DM, 512}; pg8::StaticOrder S; S.init(MTOK, DM, G, bid);
            pg8::EpiResid<false> E{out, XB, RSQ};
            pg8::gemm_phase<pg8::EpiResid<false>, pg8::StaticOrder, true, true>(lds, g, S, E, wave);
            SEAM(pb + 7);
        }
        if (RUN(pb + 8)) for (int rep_ = 0; rep_ < REPS(pb + 8); ++rep_) {
            int lane = (int)__builtin_amdgcn_mbcnt_hi(~0u, __builtin_amdgcn_mbcnt_lo(~0u, 0u)); asm volatile("" : "+v"(lane)); const int tid = wave * 64 + lane;
            pg8::Gemm g{XB, W_FI + (size_t)L * 5632 * DM, MTOK, 5632, DM}; pg8::StaticOrder S; S.init(MTOK, 5632, G, bid);
            pg8::EpiSwiGLU E{RSQ, HID};
            pg8::gemm_phase<pg8::EpiSwiGLU, pg8::StaticOrder, true, true>(lds, g, S, E, wave);
#ifdef PROBE_DUP_FFN
            if (L == 0) { __syncthreads(); pg8::gemm_phase<pg8::EpiSwiGLU, pg8::StaticOrder, true, true>(lds, g, S, E, wave); }
#endif
            SEAM(pb + 8);
        }
        if (RUN(pb + 9)) for (int rep_ = 0; rep_ < REPS(pb + 9); ++rep_) {
            int lane = (int)__builtin_amdgcn_mbcnt_hi(~0u, __builtin_amdgcn_mbcnt_lo(~0u, 0u)); asm volatile("" : "+v"(lane)); const int tid = wave * 64 + lane;
            pg8::Gemm g{HID, W_FO + (size_t)L * DM * DFF, MTOK, DM, DFF}; pg8::StaticOrder S; S.init(MTOK, DM, G, bid);
            if (L == 0) { pg8::EpiResid<false> E{out, XB, RSQ}; pg8::gemm_phase<pg8::EpiResid<false>, pg8::StaticOrder, true, true>(lds, g, S, E, wave); }
            else { pg8::EpiResid<true> E{out, XB, RSQ}; pg8::gemm_phase<pg8::EpiResid<true>, pg8::StaticOrder, true, true>(lds, g, S, E, wave); }
            SEAM(pb + 9);
        }
}

__global__ void __launch_bounds__(NWAVES * 64, 2) fwd_kernel(Args args) {
    extern __shared__ __attribute__((aligned(16))) unsigned char lds_raw[];
    LAS unsigned char* lds = (LAS unsigned char*)(unsigned)__builtin_amdgcn_readfirstlane((int)(unsigned)(size_t)(LAS unsigned char*)lds_raw);
    volatile LAS unsigned* MISC = (volatile LAS unsigned*)(lds + LDS_MISC);
    const int tid = threadIdx.x, lane = tid & 63, wave = __builtin_amdgcn_readfirstlane(tid >> 6);
    const int G = gridDim.x, bid = blockIdx.x;
    unsigned* ctl = (unsigned*)(args.ws + WS_CTL);
    for (int u = tid; u < (LDS_BYTES - LDS_MISC) / 4; u += NWAVES * 64) ((LAS unsigned*)(lds + LDS_MISC))[u] = 0u;
    __syncthreads();
    XcdBarrier bar = xcd_barrier_post(ctl + CW_BAR + args.li * XCD_BAR_WORDS, MISC + 8);
    const int lo = args.ph_lo, hi = args.ph_hi;

    if (RUN(0)) for (int rep_ = 0; rep_ < REPS(0); ++rep_) {
        LAS float* scr = (LAS float*)(lds + wave * 16384);
        const int gw = bid * NWAVES + wave, NGW = G * NWAVES;
        constexpr int I_AB = 16 * (AB_WP / 32), I_C = 16 * (C_WP / 32), I_O = 16 * 32, I_MQ = 16 * 16, I_KV = 16 * 32, I_MO = 8 * 32, I_FI = 16 * (5632 / 32), I_FO = (DFF / 64) * 32;
        constexpr int NITEMS = I_AB + I_C + 2 * I_O + 2 * I_MQ + 2 * I_KV + 2 * I_MO + 2 * I_FI + 2 * I_FO;
        for (int it = gw; it < NITEMS; it += NGW) {
            int r = it;
            if (r < I_AB) { const int nbn = AB_WP / 32; transpose_item(ab_w_in, DM, AB_W, W_AB, norm_mix, scr, r / nbn, r % nbn, lane, CMapProj0{}); continue; } r -= I_AB;
            if (r < I_C) { const int nbn = C_WP / 32; transpose_item(nsa_w_in, DM, C_W, W_C, norm_mix + DM, scr, r / nbn, r % nbn, lane, CMapProj1{}); continue; } r -= I_C;
            if (r < I_O) { transpose_item(ab_w_out, DM, DM, W_ABO, nullptr, scr, r / 32, r % 32, lane, CMapId{DM}); continue; } r -= I_O;
            if (r < I_O) { transpose_item(nsa_w_out, DM, DM, W_CO, nullptr, scr, r / 32, r % 32, lane, CMapId{DM}); continue; } r -= I_O;
            if (r < 2 * I_MQ) { const int L = r / I_MQ; r %= I_MQ; transpose_item(mem_w_q + (size_t)L * DM * 512, DM, 512, W_MQ + (size_t)L * 512 * DM, norm_mem + L * DM, scr, r / 16, r % 16, lane, CMapId{512}); continue; } r -= 2 * I_MQ;
            if (r < 2 * I_KV) { const int L = r / I_KV; r %= I_KV; transpose_item(mem_w_kv + (size_t)L * DM * 1024, DM, 1024, W_KV + (size_t)L * 1024 * DM, norm_mem_src + L * DM, scr, r / 32, r % 32, lane, CMapId{1024}); continue; } r -= 2 * I_KV;
            if (r < 2 * I_MO) { const int L = r / I_MO; r %= I_MO; transpose_item(mem_w_o + (size_t)L * 512 * DM, 512, DM, W_MO + (size_t)L * DM * 512, nullptr, scr, r / 32, r % 32, lane, CMapId{DM}); continue; } r -= 2 * I_MO;
            if (r < 2 * I_FI) { const int L = r / I_FI; r %= I_FI; const int nbn = 5632 / 32; transpose_item(ffn_w_in + (size_t)L * DM * 5632, DM, 5632, W_FI + (size_t)L * 5632 * DM, norm_ffn + L * DM, scr, r / nbn, r % nbn, lane, CMapFfn{}); continue; } r -= 2 * I_FI;
            { const int L = r / I_FO; r %= I_FO; transpose_item(ffn_w_out + (size_t)L * DFF * DM, DFF, DM, W_FO + (size_t)L * DM * DFF, nullptr, scr, r / 32, r % 32, lane, CMapId{DM}); }
        }
        for (int m = gw; m < MTOK; m += 4 * NGW) {
            int mr[4]; f32x4 v[4][4]; float sq[4];
#pragma unroll
            for (int q = 0; q < 4; ++q) { mr[q] = m + q * NGW < MTOK ? m + q * NGW : m; const f32x4* xr = (const f32x4*)(x_in + (size_t)mr[q] * DM) + lane;
#pragma unroll
                for (int j = 0; j < 4; ++j) v[q][j] = xr[64 * j]; }
#pragma unroll
            for (int q = 0; q < 4; ++q) { float a = 0.f;
#pragma unroll
                for (int j = 0; j < 4; ++j) a += (v[q][j][0] * v[q][j][0] + v[q][j][1] * v[q][j][1]) + (v[q][j][2] * v[q][j][2] + v[q][j][3] * v[q][j][3]);
                sq[q] = a; }
#pragma unroll
            for (int o = 1; o < 64; o <<= 1) {
#pragma unroll
                for (int q = 0; q < 4; ++q) sq[q] += __shfl_xor(sq[q], o); }
#pragma unroll
            for (int q = 0; q < 4; ++q) { u32x2* xbr = (u32x2*)(XB + (size_t)mr[q] * DM) + lane;
#pragma unroll
                for (int j = 0; j < 4; ++j) { u32x2 w; w.x = pk2(v[q][j][0], v[q][j][1]); w.y = pk2(v[q][j][2], v[q][j][3]); xbr[64 * j] = w; }
                if (lane < 16) RSQ[(size_t)mr[q] * 16 + lane] = (lane == 0) ? sq[q] : 0.f; }
        }
        for (int i = bid * 512 + tid; i < MTOK * 12; i += G * 512) {
            const int m = i / 12, k = i % 12;
            const float f64t[8] = {1.0f, 0.19392274474868576f, 0.03760603093086393f, 0.007292664737217109f, 0.001414213562373095f, 0.0002742481756762073f, 5.318295896944988e-05f, 1.031338537721246e-05f};
            float fr;
            if (k < 8) fr = f64t[k]; else { const int q = k - 8; fr = (q == 0) ? 1.0f : (q == 1) ? 0.03760603093086393f : (q == 2) ? 0.001414213562373095f : 5.318295896944988e-05f; }
            const float ang = (float)positions[m] * fr;
            const double rev = (double)ang * 0.15915494309189535; const float frac = (float)(rev - __builtin_rint(rev));
            const float c = __builtin_amdgcn_cosf(frac), sn = __builtin_amdgcn_sinf(frac);
            if (k < 8) { ROPE64[(size_t)m * 16 + k] = c; ROPE64[(size_t)m * 16 + 8 + k] = sn; } else { ROPE32[(size_t)m * 8 + (k - 8)] = c; ROPE32[(size_t)m * 8 + 4 + (k - 8)] = sn; }
        }
        for (int it = gw; it < 128; it += NGW) { const int kv = it >> 6, r = it & 63;
            transpose_item(kv ? nsa_cmp_w1_v : nsa_cmp_w1_k, 2048, 64, W1T + (size_t)kv * 64 * 2048, nullptr, scr, r >> 1, r & 1, lane, CMapId{64}); }
        for (int it = (NGW - 1 - gw); it < 128; it += NGW) { const int kv = it >> 6, c = it & 63; const float* pe = kv ? nsa_cmp_pos_v : nsa_cmp_pos_k; const float* w1 = kv ? nsa_cmp_w1_v : nsa_cmp_w1_k;
            float a = 0.f;
            for (int k0 = 0; k0 < 2048; k0 += 512) { float pv[8], wv[8];
#pragma unroll
                for (int j = 0; j < 8; ++j) { const int k = k0 + 64 * j + lane; pv[j] = pe[k]; wv[j] = w1[(size_t)k * 64 + c]; }
#pragma unroll
                for (int j = 0; j < 8; ++j) a += pv[j] * wv[j]; }
            a = wave_sum(a); if (lane == 0) POSW1[kv * 64 + c] = a; }
        for (int m = gw; m < MMEM; m += NGW) {
            const f32x4* xr = (const f32x4*)(mem_in + (size_t)m * DM) + lane; f32x4 v[4]; float s = 0.f;
#pragma unroll
            for (int j = 0; j < 4; ++j) { v[j] = xr[64 * j]; s += (v[j][0] * v[j][0] + v[j][1] * v[j][1]) + (v[j][2] * v[j][2] + v[j][3] * v[j][3]); }
            s = wave_sum(s);
            u32x2* xbr = (u32x2*)(MEMB + (size_t)m * DM) + lane;
#pragma unroll
            for (int j = 0; j < 4; ++j) { u32x2 w; w.x = pk2(v[j][0], v[j][1]); w.y = pk2(v[j][2], v[j][3]); xbr[64 * j] = w; }
            if (lane == 0) MRS[m] = __builtin_amdgcn_rsqf(s * (1.0f / 1024.0f) + RMS_EPS);
        }
        SEAM(0);
    }

    layer_phases<0>(args, lds, bar, lo, hi, wave);
    layer_phases<1>(args, lds, bar, lo, hi, wave);
#undef RUN
#undef SEAM
}
#undef INF_
#undef x_in
#undef mem_in
#undef positions
#undef norm_mix
#undef norm_mem
#undef norm_mem_src
#undef norm_ffn
#undef ab_w_in
#undef ab_w_out
#undef nsa_w_in
#undef nsa_w_out
#undef mem_w_q
#undef mem_w_kv
#undef mem_w_o
#undef ffn_w_in
#undef ffn_w_out
#undef out
#undef WSB
#undef W_AB
#undef W_C
#undef W_ABO
#undef W_CO
#undef W_MQ
#undef W_KV
#undef W_MO
#undef W_FI
#undef W_FO
#undef XB
#undef RSQ
#undef HID
#undef MEMB
#undef KVRAW
#undef MRS
#undef MQB
#undef OMEM
#undef mem_q_norm
#undef RAW
#undef OATT
#undef ROPE64
#undef ROPE32
#undef W1T
#undef POSW1
#undef KCMP
#undef VCMP
#undef GT
#undef nsa_q_norm
#undef SCR
#undef BMK
#undef KMEAN
#undef IWB
#undef dsa_q_norm
#undef dsa_k_norm
#undef moba_q_norm
#undef moba_k_norm
#undef nsa_kcmp_norm
#undef nsa_ksel_norm
#undef nsa_kwin_norm
#undef nsa_cmp_pos_k
#undef nsa_cmp_pos_v
#undef nsa_cmp_w1_k
#undef nsa_cmp_w2_k
#undef nsa_cmp_w1_v
#undef nsa_cmp_w2_v
#undef mem_k_norm

extern "C" void kernel_launch(void* const* d_in, const int* in_sizes, int n_in, void* d_out, int out_size, void* d_ws, size_t ws_size, hipStream_t stream) {
    static int grid = 0;
    if (grid == 0) {
        if (n_in != 32 || out_size != MTOK * DM || ws_size < WS_END) { fprintf(stderr, "kernel_launch: unexpected shapes (n_in %d out %d ws %zu)\n", n_in, out_size, ws_size); grid = -1; return; }
        int dev = 0, cus = 0, per_cu = 0;
        if (hipGetDevice(&dev) != hipSuccess || hipDeviceGetAttribute(&cus, hipDeviceAttributeMultiprocessorCount, dev) != hipSuccess) { grid = -1; return; }
        if (hipFuncSetAttribute((const void*)fwd_kernel, hipFuncAttributeMaxDynamicSharedMemorySize, LDS_BYTES) != hipSuccess) { fprintf(stderr, "kernel_launch: hipFuncSetAttribute failed\n"); grid = -1; return; }
        if (hipOccupancyMaxActiveBlocksPerMultiprocessor(&per_cu, (const void*)fwd_kernel, NWAVES * 64, LDS_BYTES) != hipSuccess || per_cu < 1) fprintf(stderr, "kernel_launch: occupancy query says %d\n", per_cu);
        (void)hipGetLastError();
        grid = cus;
    }
    if (grid < 0) return;
    if (hipMemsetAsync((char*)d_ws + WS_CTL, 0, CTL_ZERO_BYTES, stream) != hipSuccess) return;
    Args a{};
    for (int i = 0; i < 32; ++i) a.in[i] = d_in[i];
    a.out = (float*)d_out; a.ws = (unsigned char*)d_ws; a.pad = 0;
    const int NPH = 21;
#if 0
    for (int p = 0; p < NPH; ++p) { a.ph_lo = p; a.ph_hi = p + 1; a.li = 0; hipLaunchKernelGGL(fwd_kernel, dim3(grid), dim3(NWAVES * 64), LDS_BYTES, stream, a); }
#else
    a.ph_lo = 0; a.ph_hi = NPH; a.li = 0; hipLaunchKernelGGL(fwd_kernel, dim3(grid), dim3(NWAVES * 64), LDS_BYTES, stream, a);
#endif
}
```
